# Optimizing an MI355X kernel written in HIP

```python
import jax, jax.numpy as jnp
from jax import lax
import numpy as np

D_MODEL = 1024
BATCH = 16
SEQ = 2048
DEPTH = 2

GRID_W = 64
CTX_LEN = 256
MIX_WIDTH = D_MODEL
NA_HEAD_DIM = 64
NA_WIDTH = MIX_WIDTH // 2
NA_HEADS = NA_WIDTH // NA_HEAD_DIM
NB_ROWS = 8
NB_COLS = 16
QB_COLS = 16
KB_COLS = QB_COLS + NB_COLS
CONV_CH = MIX_WIDTH // 4
CONV_WIDTH = 31
RET_WIDTH = MIX_WIDTH // 4
RET_HEADS = 4
RET_V_DIM = RET_WIDTH // RET_HEADS
RET_QK_DIM = RET_V_DIM // 2
RET_QK_WIDTH = RET_HEADS * RET_QK_DIM
RET_DECAY_BASE = 5.0
CHUNK = 128
IN_WIDTH = 3 * NA_WIDTH + 2 * CONV_CH + 2 * RET_QK_WIDTH + 3 * RET_WIDTH
D_FF = 2816
N_EXPERTS = 8
TOP_K = 2
D_FF_EXPERT = 3584
ROPE_BASE = 10000.0
EPS = 1e-6
NEG_INF = -1e30

kernel_name = "hybrid_na_conv_retention_moe_dit"


def _in_layout():
    names = ("na_q", "na_k", "na_v", "conv_glu", "ret_q", "ret_k", "ret_v", "ret_gf", "ret_gb")
    sizes = (NA_WIDTH, NA_WIDTH, NA_WIDTH, 2 * CONV_CH, RET_QK_WIDTH, RET_QK_WIDTH,
             RET_WIDTH, RET_WIDTH, RET_WIDTH)
    out, start = {}, 0
    for n, s in zip(names, sizes):
        out[n] = (start, s)
        start += s
    return out


def _cols(a, span):
    s, n = span
    return a[..., s:s + n]


def _heads(a, n_heads):
    b, l, _ = a.shape
    return a.reshape(b, l, n_heads, -1).transpose(0, 2, 1, 3)


def _merge(a):
    b, h, l, d = a.shape
    return a.transpose(0, 2, 1, 3).reshape(b, l, h * d)


def _flip(a):
    return a[:, :, ::-1]


def _rmsnorm(x, g):
    xf = x.astype(jnp.float32)
    y = xf * lax.rsqrt(jnp.mean(xf * xf, axis=-1, keepdims=True) + EPS)
    return (y * g.astype(jnp.float32)).astype(x.dtype)


def _layernorm(x, g, b):
    xf = x.astype(jnp.float32)
    mu = jnp.mean(xf, axis=-1, keepdims=True)
    var = jnp.mean(jnp.square(xf - mu), axis=-1, keepdims=True)
    y = (xf - mu) * lax.rsqrt(var + EPS) * g.astype(jnp.float32) + b.astype(jnp.float32)
    return y.astype(x.dtype)


def _adaln(cvec, w_mod, b_mod, n):
    m = jax.nn.silu(cvec) @ w_mod[:, :n * D_MODEL] + b_mod[:n * D_MODEL]
    return jnp.split(m[..., None, :], n, axis=-1)


def _modulate(h, g, shift, scale):
    return _rmsnorm(h, g) * (1.0 + scale) + shift


def _axial_rope(t_len, dim):
    t = jnp.arange(t_len)
    row = (t // GRID_W).astype(jnp.float32)
    col = (t % GRID_W).astype(jnp.float32)
    axis_dim = dim // 2
    inv = ROPE_BASE ** (-jnp.arange(0, axis_dim, 2, dtype=jnp.float32) / axis_dim)
    ang = jnp.concatenate([row[:, None] * inv, col[:, None] * inv], axis=-1)
    return jnp.cos(ang), jnp.sin(ang)


def _rope(x, cos, sin):
    x1, x2 = jnp.split(x, 2, axis=-1)
    return jnp.concatenate([x1 * cos - x2 * sin, x2 * cos + x1 * sin], axis=-1)


def _neighbourhood_attention(q, k, v, k_ctx, v_ctx, rpb):
    b, h, t, dh = q.shape
    rows = t // GRID_W
    wr = min(NB_ROWS, rows)
    ncb = GRID_W // QB_COLS
    r = np.arange(rows)
    key_rows = np.clip(r - wr // 2, 0, rows - wr)[:, None] + np.arange(wr)[None, :]
    qcol = np.arange(GRID_W).reshape(ncb, QB_COLS)
    kc0 = np.clip(qcol[:, 0] - NB_COLS // 2, 0, GRID_W - KB_COLS)
    key_cols = kc0[:, None] + np.arange(KB_COLS)[None, :]
    win_c0 = np.clip(qcol - NB_COLS // 2, 0, GRID_W - NB_COLS)
    kcol = key_cols[:, None, :]
    col_ok = (kcol >= win_c0[..., None]) & (kcol < win_c0[..., None] + NB_COLS)
    dr = key_rows - r[:, None] + NB_ROWS - 1
    dc = np.clip(kcol - qcol[..., None] + NB_COLS - 1, 0, 2 * NB_COLS - 2)
    bias = rpb.astype(jnp.float32)[:, dr[:, None, None, :, None], dc[None, :, :, None, :]]
    bias = jnp.where(col_ok[None, None, :, :, None, :], bias, NEG_INF)

    ridx = key_rows[:, None, :, None]
    cidx = key_cols[None, :, None, :]
    kg = k.reshape(b, h, rows, GRID_W, dh)[:, :, ridx, cidx]
    vg = v.reshape(b, h, rows, GRID_W, dh)[:, :, ridx, cidx]
    qb = q.reshape(b, h, rows, ncb, QB_COLS, dh) * (dh ** -0.5)
    s_loc = jnp.einsum("bhrnqd,bhrnwkd->bhrnqwk", qb, kg).astype(jnp.float32) + bias
    n_loc = wr * KB_COLS
    s_loc = s_loc.reshape(b, h, rows, ncb, QB_COLS, n_loc)
    s_ctx = jnp.einsum("bhrnqd,bhcd->bhrnqc", qb, k_ctx).astype(jnp.float32)
    p = jax.nn.softmax(jnp.concatenate([s_loc, s_ctx], axis=-1), axis=-1).astype(v.dtype)
    p_loc = p[..., :n_loc].reshape(b, h, rows, ncb, QB_COLS, wr, KB_COLS)
    o = (jnp.einsum("bhrnqwk,bhrnwkd->bhrnqd", p_loc, vg)
         + jnp.einsum("bhrnqc,bhcd->bhrnqd", p[..., n_loc:], v_ctx))
    return o.reshape(b, h, t, dh)


def _context_attention(q, k, v):
    s = jnp.einsum("bhid,bhjd->bhij", q * (q.shape[-1] ** -0.5), k).astype(jnp.float32)
    p = jax.nn.softmax(s, axis=-1).astype(v.dtype)
    return jnp.einsum("bhij,bhjd->bhid", p, v)


def _conv_module(u, conv_w, conv_b, ln_w, ln_b):
    a, g = jnp.split(u, 2, axis=-1)
    y = a * jax.nn.sigmoid(g)
    y = lax.conv_general_dilated(
        y, conv_w[:, None, :].astype(y.dtype), window_strides=(1,),
        padding=[(CONV_WIDTH // 2, CONV_WIDTH // 2)],
        dimension_numbers=("NWC", "WIO", "NWC"), feature_group_count=CONV_CH) + conv_b
    return jax.nn.silu(_layernorm(y, ln_w, ln_b))


def _retention_chunked(q, k, v, gamma, s0):
    b, h, t, _ = q.shape
    dv = v.shape[-1]
    n_chunks = t // CHUNK
    lg = jnp.log(gamma)[:, None]
    pos = jnp.arange(CHUNK, dtype=jnp.float32)
    diff = pos[:, None] - pos[None, :]
    intra = jnp.where(diff >= 0, jnp.exp(lg[:, :, None] * jnp.maximum(diff, 0.0)), 0.0)
    q_dec = jnp.exp(lg * (pos + 1.0))[..., None]
    k_dec = jnp.exp(lg * (CHUNK - 1.0 - pos))[..., None]
    c_dec = jnp.exp(lg[:, 0] * CHUNK)[:, None, None]

    def to_chunks(a):
        return jnp.moveaxis(a.reshape(b, h, n_chunks, CHUNK, a.shape[-1]), 2, 0)

    def step(s, xs):
        qc, kc, vc = xs
        inner = jnp.einsum("bhid,bhjd->bhij", qc, kc) * intra
        o = (jnp.einsum("bhij,bhje->bhie", inner, vc)
             + jnp.einsum("bhid,bhde->bhie", qc * q_dec, s))
        s = c_dec * s + jnp.einsum("bhjd,bhje->bhde", kc * k_dec, vc)
        return s, o

    s_fin, o = lax.scan(step, s0, (to_chunks(q), to_chunks(k), to_chunks(v)))
    return jnp.moveaxis(o, 0, 2).reshape(b, h, t, dv), s_fin


def _retention_state(k, v, gamma):
    t = k.shape[2]
    w = jnp.exp(jnp.log(gamma)[:, None] * (t - 1.0 - jnp.arange(t, dtype=jnp.float32)))
    return jnp.einsum("bhtd,bhte->bhde", k * w[..., None], v)


def _head_norm(o, g):
    mu = jnp.mean(o, axis=-1, keepdims=True)
    var = jnp.mean(jnp.square(o - mu), axis=-1, keepdims=True)
    return _merge((o - mu) * lax.rsqrt(var + EPS)) * g.astype(jnp.float32)


def _bidir_retention(q, k, v, g_f, g_b, s0, gamma, gn_w):
    o_f, s_f = _retention_chunked(q, k, v, gamma[0], s0[0])
    o_b, s_b = _retention_chunked(_flip(q), _flip(k), _flip(v), gamma[1], s0[1])
    y = (jax.nn.silu(g_f.astype(jnp.float32)) * _head_norm(o_f, gn_w)
         + jax.nn.silu(g_b.astype(jnp.float32)) * _head_norm(_flip(o_b), gn_w))
    return y, (s_f, s_b)


def _mixer(ux, uc, w_in, w_out, rpb, conv_w, conv_b, conv_ln_w, conv_ln_b, ret_decay, ret_gn_w,
           cos, sin, need_ctx_out):
    f32 = jnp.float32
    lay = _in_layout()
    px = ux @ w_in
    col_x = lambda name: _cols(px, lay[name])
    if need_ctx_out:
        pc = uc @ w_in
        col_c = lambda name: _cols(pc, lay[name])
    else:
        col_c = lambda name: uc @ _cols(w_in, lay[name])

    k_na_c = _heads(col_c("na_k"), NA_HEADS)
    v_na_c = _heads(col_c("na_v"), NA_HEADS)
    y_na = _merge(_neighbourhood_attention(
        _heads(col_x("na_q"), NA_HEADS), _heads(col_x("na_k"), NA_HEADS),
        _heads(col_x("na_v"), NA_HEADS), k_na_c, v_na_c, rpb))

    y_conv = _conv_module(col_x("conv_glu"), conv_w, conv_b, conv_ln_w, conv_ln_b)

    gamma = 1.0 - jnp.exp2(-ret_decay.astype(f32))
    k_scale = RET_QK_DIM ** -0.5
    kc = _heads(col_c("ret_k"), RET_HEADS).astype(f32) * k_scale
    vc = _heads(col_c("ret_v"), RET_HEADS).astype(f32)
    if need_ctx_out:
        qc = _heads(col_c("ret_q"), RET_HEADS).astype(f32)
        zero = jnp.zeros(kc.shape[:2] + (RET_QK_DIM, RET_V_DIM), f32)
        y_ret_c, s_ctx = _bidir_retention(qc, kc, vc, col_c("ret_gf"), col_c("ret_gb"),
                                          (zero, zero), gamma, ret_gn_w)
    else:
        s_ctx = (_retention_state(kc, vc, gamma[0]),
                 _retention_state(_flip(kc), _flip(vc), gamma[1]))
    q = _rope(_heads(col_x("ret_q"), RET_HEADS).astype(f32), cos, sin)
    k = _rope(_heads(col_x("ret_k"), RET_HEADS).astype(f32), cos, sin) * k_scale
    v = _heads(col_x("ret_v"), RET_HEADS).astype(f32)
    y_ret, _ = _bidir_retention(q, k, v, col_x("ret_gf"), col_x("ret_gb"), s_ctx, gamma, ret_gn_w)

    y_lat = jnp.concatenate([y_na, y_conv, y_ret.astype(ux.dtype)], axis=-1) @ w_out
    if not need_ctx_out:
        return y_lat, None
    y_na_c = _merge(_context_attention(_heads(col_c("na_q"), NA_HEADS), k_na_c, v_na_c))
    y_conv_c = _conv_module(col_c("conv_glu"), conv_w, conv_b, conv_ln_w, conv_ln_b)
    y_ctx = jnp.concatenate([y_na_c, y_conv_c, y_ret_c.astype(uc.dtype)], axis=-1) @ w_out
    return y_lat, y_ctx


def _swiglu(h, w_gate, w_up, w_down):
    return (jax.nn.silu(h @ w_gate) * (h @ w_up)) @ w_down


def _moe(h, router_w, router_b, w_gate, w_up, w_down):
    logits = (h @ router_w).astype(jnp.float32) + router_b.astype(jnp.float32)
    top_v, top_i = lax.top_k(logits, TOP_K)
    top_p = jax.nn.softmax(top_v, axis=-1)
    combine = jnp.sum(jax.nn.one_hot(top_i, N_EXPERTS, dtype=jnp.float32) * top_p[..., None],
                      axis=-2).astype(h.dtype)
    y = jnp.zeros_like(h)
    for e in range(N_EXPERTS):
        y = y + combine[..., e:e + 1] * _swiglu(h, w_gate[e], w_up[e], w_down[e])
    return y


def setup_inputs(seed: int = 0) -> dict:
    key = jax.random.key(seed)
    ks = iter(jax.random.split(key, 32))
    f32 = jnp.float32
    nrm = lambda shape, s: jax.random.normal(next(ks), shape, f32) * s
    n_dense = (DEPTH + 1) // 2
    n_moe = DEPTH // 2
    return {
        "x": nrm((BATCH, SEQ, D_MODEL), 1.0),
        "c": nrm((BATCH, D_MODEL), 1.0),
        "ctx": nrm((BATCH, CTX_LEN, D_MODEL), 1.0),
        "c_ctx": nrm((D_MODEL,), 1.0),
        "w_mod": nrm((DEPTH, D_MODEL, 6 * D_MODEL), 0.5 * D_MODEL ** -0.5),
        "b_mod": nrm((DEPTH, 6 * D_MODEL), 0.02),
        "norm1_w": 1.0 + nrm((DEPTH, D_MODEL), 0.05),
        "norm2_w": 1.0 + nrm((DEPTH, D_MODEL), 0.05),
        "w_in": nrm((DEPTH, D_MODEL, IN_WIDTH), D_MODEL ** -0.5),
        "w_out": nrm((DEPTH, MIX_WIDTH, D_MODEL), MIX_WIDTH ** -0.5),
        "na_rpb": nrm((DEPTH, NA_HEADS, 2 * NB_ROWS - 1, 2 * NB_COLS - 1), 0.2),
        "conv_w": nrm((DEPTH, CONV_WIDTH, CONV_CH), CONV_WIDTH ** -0.5),
        "conv_b": nrm((DEPTH, CONV_CH), 0.02),
        "conv_ln_w": 1.0 + nrm((DEPTH, CONV_CH), 0.05),
        "conv_ln_b": nrm((DEPTH, CONV_CH), 0.02),
        "ret_decay": RET_DECAY_BASE + jnp.arange(RET_HEADS, dtype=f32) + nrm((DEPTH, 2, RET_HEADS), 0.1),
        "ret_gn_w": 1.0 + nrm((DEPTH, RET_WIDTH), 0.05),
        "ffn_w_gate": nrm((n_dense, D_MODEL, D_FF), D_MODEL ** -0.5),
        "ffn_w_up": nrm((n_dense, D_MODEL, D_FF), D_MODEL ** -0.5),
        "ffn_w_down": nrm((n_dense, D_FF, D_MODEL), D_FF ** -0.5),
        "moe_router": nrm((n_moe, D_MODEL, N_EXPERTS), D_MODEL ** -0.5),
        "moe_router_b": nrm((n_moe, N_EXPERTS), 0.01),
        "moe_w_gate": nrm((n_moe, N_EXPERTS, D_MODEL, D_FF_EXPERT), D_MODEL ** -0.5),
        "moe_w_up": nrm((n_moe, N_EXPERTS, D_MODEL, D_FF_EXPERT), D_MODEL ** -0.5),
        "moe_w_down": nrm((n_moe, N_EXPERTS, D_FF_EXPERT, D_MODEL), D_FF_EXPERT ** -0.5),
        "final_norm_w": 1.0 + nrm((D_MODEL,), 0.05),
    }


def reference(x, c, ctx, c_ctx, w_mod, b_mod, norm1_w, norm2_w, w_in, w_out, na_rpb, conv_w, conv_b,
              conv_ln_w, conv_ln_b, ret_decay, ret_gn_w, ffn_w_gate, ffn_w_up, ffn_w_down,
              moe_router, moe_router_b, moe_w_gate, moe_w_up, moe_w_down, final_norm_w):
    n_ctx = ctx.shape[1]
    cos, sin = _axial_rope(x.shape[1], RET_QK_DIM)
    h_lat, h_ctx = x, ctx
    for l in range(DEPTH):
        last = l == DEPTH - 1
        sh1, sc1, g1, sh2, sc2, g2 = _adaln(c, w_mod[l], b_mod[l], 6)
        if last:
            csh1, csc1 = _adaln(c_ctx, w_mod[l], b_mod[l], 2)
        else:
            csh1, csc1, cg1, csh2, csc2, cg2 = _adaln(c_ctx, w_mod[l], b_mod[l], 6)
        ux = _modulate(h_lat, norm1_w[l], sh1, sc1)
        uc = _modulate(h_ctx, norm1_w[l], csh1, csc1)
        y_lat, y_ctx = _mixer(ux, uc, w_in[l], w_out[l], na_rpb[l], conv_w[l], conv_b[l],
                              conv_ln_w[l], conv_ln_b[l], ret_decay[l], ret_gn_w[l],
                              cos, sin, not last)
        h_lat = h_lat + g1 * y_lat
        if last:
            u = _modulate(h_lat, norm2_w[l], sh2, sc2)
        else:
            h_ctx = h_ctx + cg1 * y_ctx
            u = jnp.concatenate([_modulate(h_ctx, norm2_w[l], csh2, csc2),
                                 _modulate(h_lat, norm2_w[l], sh2, sc2)], axis=1)
        if l % 2 == 0:
            f = _swiglu(u, ffn_w_gate[l // 2], ffn_w_up[l // 2], ffn_w_down[l // 2])
        else:
            f = _moe(u, moe_router[l // 2], moe_router_b[l // 2], moe_w_gate[l // 2],
                     moe_w_up[l // 2], moe_w_down[l // 2])
        if last:
            h_lat = h_lat + g2 * f
        else:
            h_ctx = h_ctx + cg2 * f[:, :n_ctx]
            h_lat = h_lat + g2 * f[:, n_ctx:]
    return _rmsnorm(h_lat, final_norm_w)
```

```cpp
#include <hip/hip_runtime.h>
#include <cstdio>
#include <cstdint>

#ifndef MK_PER_PHASE
#define MK_PER_PHASE 0
#endif

#define LAS __attribute__((address_space(3)))
#define GAS __attribute__((address_space(1)))
#define DI __device__ __forceinline__
typedef unsigned short bf16;
typedef short bf16x8 __attribute__((ext_vector_type(8)));
typedef short s16x4 __attribute__((ext_vector_type(4)));
typedef float f32x4 __attribute__((ext_vector_type(4)));
typedef float f32x16 __attribute__((ext_vector_type(16)));
typedef unsigned u32x4 __attribute__((ext_vector_type(4)));
typedef unsigned u32x2 __attribute__((ext_vector_type(2)));
typedef float f32x2_t __attribute__((ext_vector_type(2)));
typedef __bf16 bf16x2_t __attribute__((ext_vector_type(2)));
typedef short v4i16_t __attribute__((ext_vector_type(4)));

constexpr int DM = 1024, NB = 16, SEQ = 2048, CTXL = 256, GW = 64;
constexpr int NLAT = NB * SEQ, NCTX = NB * CTXL, NTOK = NLAT + NCTX;
constexpr int INW = 3072, DFF = 2816, NE = 8, DFE = 3584;
constexpr int C_NAQ = 0, C_NAK = 512, C_NAV = 1024, C_CONV = 1536, C_RQ = 2048, C_RK = 2176, C_RV = 2304, C_GF = 2560, C_GB = 2816;
constexpr float EPS = 1e-6f;
constexpr float LOG2E = 1.4426950408889634f;

constexpr size_t MiB = 1u << 20;
constexpr size_t WS_CTL = 0, CTL_ZERO_BYTES = 64 * 1024;
constexpr size_t WS_MODLAT = 1 * MiB;
constexpr size_t WS_MODCTX = WS_MODLAT + 2 * 16 * 6144 * 4;
constexpr size_t WS_ROPE = WS_MODCTX + 2 * 6144 * 4;
constexpr size_t WS_PTOK = 2 * MiB;
constexpr size_t WS_SEGCNT = WS_PTOK + 32768 * 2 * 4;
constexpr size_t WS_META = WS_SEGCNT + 256 * 2 * 8 * 4;
constexpr size_t WS_SEGLIST = 3 * MiB;
constexpr size_t WS_ROWMAP = 5 * MiB;
constexpr int MOE_ROWS = 34816;
constexpr size_t WS_PROW = WS_ROWMAP + 512 * 1024;
constexpr size_t WS_SUMLAT = 6 * MiB;
constexpr size_t WS_SUMCTX = 22 * MiB;
constexpr size_t WS_WIN = 24 * MiB;
constexpr size_t WS_WOUT = WS_WIN + (size_t)2 * 3072 * 1024 * 2;
constexpr size_t WS_WGU = WS_WOUT + (size_t)2 * 1024 * 1024 * 2;
constexpr size_t WS_WD = WS_WGU + (size_t)5632 * 1024 * 2;
constexpr size_t WS_MGU = WS_WD + (size_t)1024 * 2816 * 2;
constexpr size_t WS_MD = WS_MGU + (size_t)8 * 7168 * 1024 * 2;
constexpr size_t WS_HCTX = WS_MD + (size_t)8 * 1024 * 3584 * 2;
constexpr size_t WS_U = WS_HCTX + (size_t)NCTX * DM * 4;
constexpr size_t WS_P = WS_U + (size_t)NTOK * DM * 2;
constexpr size_t WS_END = WS_P + (size_t)MOE_ROWS * DFE * 2;
static_assert((size_t)NTOK * INW * 2 <= (size_t)MOE_ROWS * DFE * 2, "P region");
static_assert(WS_WIN % 256 == 0 && WS_WOUT % 256 == 0 && WS_WGU % 256 == 0 && WS_WD % 256 == 0 && WS_MGU % 256 == 0 && WS_MD % 256 == 0 && WS_HCTX % 256 == 0 && WS_U % 256 == 0 && WS_P % 256 == 0, "align");

constexpr int RING_BYTES = 131072;
constexpr int AUX_OFF = RING_BYTES;
constexpr int AUX_TAB = AUX_OFF + 1024;
constexpr int LDS_BYTES = 147456;

DI unsigned pk2(float lo, float hi) { f32x2_t v = {lo, hi}; bf16x2_t b = __builtin_convertvector(v, bf16x2_t); return __builtin_bit_cast(unsigned, b); }
DI float bflo(unsigned u) { return __uint_as_float(u << 16); }
DI float bfhi(unsigned u) { return __uint_as_float(u & 0xffff0000u); }
DI float wave_sum(float v) {
#pragma unroll
    for (int o = 1; o < 64; o <<= 1) v += __shfl_xor(v, o);
    return v;
}
DI float fast_exp2(float x) { return __builtin_amdgcn_exp2f(x); }
DI float fast_rcp(float x) { return __builtin_amdgcn_rcpf(x); }
DI float sigmoidf_(float x) { return fast_rcp(1.0f + fast_exp2(-x * LOG2E)); }
DI int crow(int reg, int h) { return (reg & 3) + 8 * (reg >> 2) + 4 * h; }
#define MFMA32(a, b, c) __builtin_amdgcn_mfma_f32_32x32x16_bf16((a), (b), (c), 0, 0, 0)
DI s16x4 trread(LAS const unsigned char* p) { return __builtin_bit_cast(s16x4, __builtin_amdgcn_ds_read_tr16_b64_v4i16((LAS v4i16_t*)p)); }
DI int ld_i32_coherent(const int* p) { return (int)__hip_atomic_load((const unsigned*)p, __ATOMIC_RELAXED, __HIP_MEMORY_SCOPE_AGENT); }

namespace pg8 {
#define PG8_LAS __attribute__((address_space(3)))
typedef unsigned short bf16_t;
constexpr int BM = 256, BK = 64, HALF = 128, HTB = HALF * BK * 2, STAGE_BYTES = 8 * HTB, NXCD = 8, WGM = 8;
__host__ __device__ __forceinline__ int lds_byte(int r, int c) { const int st = (r >> 4) * 2 + (c >> 5), rr = r & 15, cc = c & 31, ob = rr * 64 + cc * 2; return st * 1024 + (ob ^ (((ob >> 9) & 1) << 5)); }
__host__ __device__ __forceinline__ void stage_rc(int b, int& R, int& C) { const int st = b / 1024, sb = b % 1024, swz = sb ^ (((sb >> 9) & 1) << 5); R = (st >> 1) * 16 + swz / 64; C = (st & 1) * 32 + (swz % 64) / 2; }
__host__ __device__ __forceinline__ int perm32(int rho) { const int n = rho >> 4, i = rho & 15; return 8 * (i >> 2) + 4 * n + (i & 3); }
struct Unit { int pm, pn; };
struct StaticOrder {
    int nM, nN, nwg, G, c;
    __device__ void init(int M, int N, int G_, int c_) { nM = M / BM; nN = N / BM; nwg = nM * nN; G = G_; c = c_; }
    __device__ bool next(int i, Unit& u) const {
        const long L = (long)i * G + c; if (L >= nwg) return false;
        int wgid = (int)L; { const int q = nwg / NXCD, r = nwg % NXCD, xcd = wgid % NXCD, off = wgid / NXCD; wgid = (xcd < r ? xcd * (q + 1) : r * (q + 1) + (xcd - r) * q) + off; }
        const int nig = WGM * nN, gid = wgid / nig, fm = gid * WGM, gsz = (nM - fm) < WGM ? (nM - fm) : WGM;
        u.pm = fm + ((wgid % nig) % gsz); u.pn = (wgid % nig) / gsz; return true;
    }
};
struct RowsLinear { static constexpr bool GATHER = false; };
struct RowsGather {
    static constexpr bool GATHER = true;
    const int* rowmap; int row_add;
    __device__ __forceinline__ void offs(const Unit& u, const int (&R)[2], const int (&C)[2], int K, unsigned (&o)[2][2]) const {
#pragma unroll
        for (int h = 0; h < 2; ++h)
#pragma unroll
            for (int i = 0; i < 2; ++i) { int t = rowmap[u.pm * BM + h * HALF + R[i]]; t = t < 0 ? 0 : t;
                o[h][i] = (unsigned)(((size_t)(t + row_add) * (size_t)K + (size_t)C[i]) * 2u); }
#pragma unroll
        for (int h = 0; h < 2; ++h)
#pragma unroll
            for (int i = 0; i < 2; ++i) asm volatile("" : "+v"(o[h][i]));
    }
};

template <class Epi, class Sched, class ARows, bool ALIGN_EPI>
__device__ __forceinline__ void gemm_phase(PG8_LAS unsigned char* lds, int tid, const bf16_t* A, const bf16_t* Bt, int K, const Sched& S, const Epi& E, const ARows& AR) {
    constexpr bool GATHER = ARows::GATHER;
    const int wid = __builtin_amdgcn_readfirstlane(tid >> 6), lane = tid & 63, wr = wid >> 2, wc = wid & 3, fr = lane & 15, fq = lane >> 4;
    const int nt = K / BK;
    int RA[2], CA[2]; unsigned voffA[2], voffB[2];
#pragma unroll
    for (int i = 0; i < 2; ++i) { int R, C; stage_rc(tid * 16 + i * 8192, R, C); const int Rb = Epi::PERM ? ((R & ~31) + perm32(R & 31)) : R;
        RA[i] = R; CA[i] = C; voffA[i] = (unsigned)(R * K + C) * 2u; voffB[i] = (unsigned)(Rb * K + C) * 2u; }
    const size_t kstep = (size_t)(BK * 2);
    const size_t hstep = (size_t)HALF * K * 2;
    const size_t tstep = 2 * hstep;
    const unsigned ldsw = (unsigned)wid * 1024u;
    const int aoff = lds_byte(wr * 64 + fr, fq * 8), boff = lds_byte(wc * 32 + fr, fq * 8);
    const char* Ab = (const char*)A;
#define PG8_SA(b, h) (((b) * 2 + (h)) * HTB)
#define PG8_SB(b, h) ((4 + (b) * 2 + (h)) * HTB)
#define PG8_STAGE(bufoff, gbase, voff) do { _Pragma("unroll") for (int _i = 0; _i < 2; ++_i) \
        __builtin_amdgcn_global_load_lds((const unsigned*)((const char*)(gbase) + (voff)[_i]), (PG8_LAS unsigned*)(lds + (bufoff) + ldsw + _i * 8192), 16, 0, 0); } while (0)
#define PG8_STAGEA(bufoff, h, plin, kb) do { if constexpr (GATHER) PG8_STAGE(bufoff, Ab + (kb), curA[h]); else PG8_STAGE(bufoff, (plin) + (h) * hstep, voffA); } while (0)
#define PG8_LDA(dst, b, h) do { _Pragma("unroll") for (int m = 0; m < 4; ++m) _Pragma("unroll") for (int k = 0; k < 2; ++k) dst[m][k] = *(const PG8_LAS bf16x8*)(lds + PG8_SA(b, h) + aoff + m * 2048 + k * 1024); } while (0)
#define PG8_LDB(dst, b, h) do { _Pragma("unroll") for (int n = 0; n < 2; ++n) _Pragma("unroll") for (int k = 0; k < 2; ++k) dst[n][k] = *(const PG8_LAS bf16x8*)(lds + PG8_SB(b, h) + boff + n * 2048 + k * 1024); } while (0)
#define PG8_MMA(ai, bj, At, Bt_) do { __builtin_amdgcn_s_setprio(1); _Pragma("unroll") for (int m = 0; m < 4; ++m) _Pragma("unroll") for (int n = 0; n < 2; ++n) _Pragma("unroll") for (int k = 0; k < 2; ++k) \
        acc[ai][bj][m][n] = __builtin_amdgcn_mfma_f32_16x16x32_bf16(Bt_[n][k], At[m][k], acc[ai][bj][m][n], 0, 0, 0); __builtin_amdgcn_s_setprio(0); } while (0)
#define PG8_WAIT_V(n) asm volatile("s_waitcnt vmcnt(" #n ")" ::: "memory")
#define PG8_WAIT_L(n) asm volatile("s_waitcnt lgkmcnt(" #n ")" ::: "memory")
#define PG8_BAR __builtin_amdgcn_s_barrier()
#define PG8_SCHED __builtin_amdgcn_sched_barrier(0)
    Unit cur, nxt; int ui = 0;
    if (!S.next(0, cur)) return;
    f32x4 acc[2][2][4][2];
#pragma unroll
    for (int a = 0; a < 2; ++a)
#pragma unroll
        for (int b = 0; b < 2; ++b)
#pragma unroll
            for (int m = 0; m < 4; ++m)
#pragma unroll
                for (int n = 0; n < 2; ++n) acc[a][b][m][n] = (f32x4){0.f, 0.f, 0.f, 0.f};
    bf16x8 At[4][2], B0[2][2], B1[2][2];
    unsigned curA[2][2] = {{0u, 0u}, {0u, 0u}}, nxtA[2][2] = {{0u, 0u}, {0u, 0u}};
    if constexpr (GATHER) AR.offs(cur, RA, CA, K, curA);
    const char* cA = GATHER ? Ab : Ab + (size_t)cur.pm * tstep;
    const char* cB = (const char*)Bt + (size_t)cur.pn * tstep;
    PG8_STAGE(PG8_SB(0, 0), cB, voffB); PG8_STAGE(PG8_SB(0, 1), cB + hstep, voffB); PG8_STAGEA(PG8_SA(0, 0), 0, cA, 0); PG8_STAGEA(PG8_SA(0, 1), 1, cA, 0);
    if (wr == 1) PG8_BAR;
    PG8_WAIT_V(2); PG8_BAR;
    PG8_STAGE(PG8_SB(1, 0), cB + kstep, voffB); PG8_STAGEA(PG8_SA(1, 0), 0, cA + kstep, kstep); PG8_STAGE(PG8_SB(1, 1), cB + hstep + kstep, voffB);
    PG8_WAIT_V(6); PG8_BAR;
    for (;;) {
        const bool has_next = S.next(ui + 1, nxt);
        if constexpr (GATHER) {
            if (has_next) AR.offs(nxt, RA, CA, K, nxtA);
            else {
#pragma unroll
                for (int h = 0; h < 2; ++h)
#pragma unroll
                    for (int i = 0; i < 2; ++i) nxtA[h][i] = curA[h][i];
            }
        }
        const char* nA = GATHER ? Ab : (has_next ? Ab + (size_t)nxt.pm * tstep : cA);
        const char* nB = has_next ? (const char*)Bt + (size_t)nxt.pn * tstep : cB;
        for (int t = 0; t < nt; t += 2) {
            const bool last = (t == nt - 2);
            const size_t k1 = (size_t)(t + 1) * kstep, k2 = last ? 0 : (size_t)(t + 2) * kstep, k3 = k2 + kstep;
            const char* a1 = cA + k1;
            const char* a2 = last ? nA : cA + k2; const char* b2 = last ? nB : cB + k2;
            const char* a3 = a2 + kstep; const char* b3 = b2 + kstep;
            PG8_LDB(B0, 0, 0); PG8_LDB(B1, 0, 1); PG8_SCHED; PG8_LDA(At, 0, 0); PG8_STAGEA(PG8_SA(1, 1), 1, a1, k1);
            if constexpr (GATHER) { if (last) {
#pragma unroll
                for (int h = 0; h < 2; ++h)
#pragma unroll
                    for (int i = 0; i < 2; ++i) curA[h][i] = nxtA[h][i]; } }
            PG8_WAIT_V(8); PG8_WAIT_L(0); PG8_BAR; PG8_MMA(0, 0, At, B0); PG8_MMA(0, 1, At, B1); PG8_BAR; PG8_SCHED;
            PG8_LDA(At, 0, 1); PG8_STAGE(PG8_SB(0, 0), b2, voffB); PG8_STAGE(PG8_SB(0, 1), b2 + hstep, voffB); PG8_STAGEA(PG8_SA(0, 0), 0, a2, k2);
            PG8_WAIT_V(8); PG8_WAIT_L(0); PG8_BAR; PG8_MMA(1, 0, At, B0); PG8_MMA(1, 1, At, B1); PG8_BAR; PG8_SCHED;
            PG8_LDB(B0, 1, 0); PG8_LDB(B1, 1, 1); PG8_SCHED; PG8_LDA(At, 1, 0); PG8_STAGEA(PG8_SA(0, 1), 1, a2, k2);
            PG8_WAIT_V(8); PG8_WAIT_L(0); PG8_BAR; PG8_MMA(0, 0, At, B0); PG8_MMA(0, 1, At, B1); PG8_BAR; PG8_SCHED;
            PG8_LDA(At, 1, 1); PG8_STAGE(PG8_SB(1, 0), b3, voffB); PG8_STAGE(PG8_SB(1, 1), b3 + hstep, voffB); PG8_STAGEA(PG8_SA(1, 0), 0, a3, k3);
            PG8_WAIT_V(8); PG8_WAIT_L(0); PG8_BAR; PG8_MMA(1, 0, At, B0); PG8_MMA(1, 1, At, B1); PG8_BAR; PG8_SCHED;
        }
        if constexpr (ALIGN_EPI) { if (wr == 0) PG8_BAR; }
        E(acc, cur, wr, wc, fr, fq);
        if (!has_next) break;
#pragma unroll
        for (int a = 0; a < 2; ++a)
#pragma unroll
            for (int b = 0; b < 2; ++b)
#pragma unroll
                for (int m = 0; m < 4; ++m)
#pragma unroll
                    for (int n = 0; n < 2; ++n) acc[a][b][m][n] = (f32x4){0.f, 0.f, 0.f, 0.f};
        cur = nxt; cA = nA; cB = nB; ++ui;
        if constexpr (ALIGN_EPI) { if (wr == 1) PG8_BAR; }
    }
    PG8_WAIT_V(0);
    if constexpr (!ALIGN_EPI) { if (wr == 0) PG8_BAR; }
    PG8_BAR;
#undef PG8_SA
#undef PG8_SB
#undef PG8_STAGE
#undef PG8_STAGEA
#undef PG8_LDA
#undef PG8_LDB
#undef PG8_MMA
#undef PG8_WAIT_V
#undef PG8_WAIT_L
#undef PG8_BAR
#undef PG8_SCHED
}

#define PG8_OPAQUE(x) asm volatile("" : "+v"(x))
struct EpiStoreBf16 {
    static constexpr bool PERM = true;
    bf16_t* O; int ldc;
    __device__ __forceinline__ void operator()(const f32x4 (&acc)[2][2][4][2], const Unit& u, int wr, int wc, int fr, int fq) const {
        char* base = (char*)(O + (size_t)(u.pm * BM) * ldc + u.pn * BM);
        unsigned lb = (unsigned)((wr * 64 + fr) * ldc + wc * 32 + 8 * fq) * 2u; PG8_OPAQUE(lb);
        const unsigned rstep = (unsigned)ldc * 32u;
#pragma unroll
        for (int ai = 0; ai < 2; ++ai)
#pragma unroll
            for (int m = 0; m < 4; ++m) { const unsigned ro = lb + (unsigned)(ai * 8 + m) * rstep;
#pragma unroll
                for (int bj = 0; bj < 2; ++bj) { const f32x4 v0 = acc[ai][bj][m][0], v1 = acc[ai][bj][m][1];
                    u32x4 w; w.x = pk2(v0[0], v0[1]); w.y = pk2(v0[2], v0[3]); w.z = pk2(v1[0], v1[1]); w.w = pk2(v1[2], v1[3]);
                    *(u32x4*)(base + ro + bj * (HALF * 2)) = w; } }
    }
};
struct EpiResGate {
    static constexpr bool PERM = false;
    const float* src_ctx; const float* src_lat; float* dst_ctx; float* dst_lat; const float* gate_lat; const float* gate_ctx; int row_base;
    __device__ __forceinline__ void operator()(const f32x4 (&acc)[2][2][4][2], const Unit& u, int wr, int wc, int fr, int fq) const {
        const int rowu = row_base + u.pm * BM; const bool isctx = rowu < NCTX;
        const char* src = (const char*)(isctx ? src_ctx + (size_t)rowu * DM : src_lat + (size_t)(rowu - NCTX) * DM) + u.pn * (BM * 4);
        char* dst = (char*)(isctx ? dst_ctx + (size_t)rowu * DM : dst_lat + (size_t)(rowu - NCTX) * DM) + u.pn * (BM * 4);
        const float* gate = (isctx ? gate_ctx : gate_lat + (size_t)((rowu - NCTX) / SEQ) * 6144) + u.pn * BM;
        const int cl = wc * 32 + 4 * fq;
        f32x4 sc[2][2][4][2];
#pragma unroll
        for (int bj = 0; bj < 2; ++bj)
#pragma unroll
            for (int n = 0; n < 2; ++n) { const f32x4 gv = *(const f32x4*)(gate + cl + bj * HALF + n * 16);
#pragma unroll
                for (int ai = 0; ai < 2; ++ai)
#pragma unroll
                    for (int m = 0; m < 4; ++m) sc[ai][bj][m][n] = acc[ai][bj][m][n] * gv; }
        unsigned lb = (unsigned)((wr * 64 + fr) * DM + cl) * 4u; PG8_OPAQUE(lb);
#pragma unroll
        for (int ai = 0; ai < 2; ++ai)
#pragma unroll
            for (int m = 0; m < 4; ++m) { const unsigned ro = lb + (unsigned)(ai * 8 + m) * (16u * DM * 4u);
#pragma unroll
                for (int bj = 0; bj < 2; ++bj)
#pragma unroll
                    for (int n = 0; n < 2; ++n) { const unsigned o = ro + (unsigned)(bj * HALF + n * 16) * 4u; const f32x4 s = *(const f32x4*)(src + o);
                        *(f32x4*)(dst + o) = s + sc[ai][bj][m][n]; }
                asm volatile("" ::: "memory"); }
    }
};
template <bool MOE> struct EpiSwiglu {
    static constexpr bool PERM = true;
    bf16_t* O; int ldc; int ncol; const float* prow;
    __device__ __forceinline__ void operator()(const f32x4 (&acc)[2][2][4][2], const Unit& u, int wr, int wc, int fr, int fq) const {
        const int pnl = MOE ? (u.pn % ncol) : u.pn;
        char* base = (char*)(O + (size_t)(u.pm * BM) * ldc + pnl * HALF);
        unsigned lb = (unsigned)((wr * 64 + fr) * ldc + wc * 32 + 8 * fq) * 2u; PG8_OPAQUE(lb);
        const unsigned rstep = (unsigned)ldc * 32u;
        const float* pr = MOE ? prow + u.pm * BM : nullptr;
        unsigned pl = (unsigned)(wr * 64 + fr) * 4u; PG8_OPAQUE(pl);
#pragma unroll
        for (int ai = 0; ai < 2; ++ai)
#pragma unroll
            for (int m = 0; m < 4; ++m) {
                float pw = 1.0f; if (MOE) pw = *(const float*)((const char*)pr + pl + (unsigned)(ai * 8 + m) * 64u);
                float hv[8];
#pragma unroll
                for (int n = 0; n < 2; ++n)
#pragma unroll
                    for (int j = 0; j < 4; ++j) { const float g = acc[ai][0][m][n][j], up = acc[ai][1][m][n][j]; hv[n * 4 + j] = g * sigmoidf_(g) * up * pw; }
                u32x4 w; w.x = pk2(hv[0], hv[1]); w.y = pk2(hv[2], hv[3]); w.z = pk2(hv[4], hv[5]); w.w = pk2(hv[6], hv[7]);
                *(u32x4*)(base + lb + (unsigned)(ai * 8 + m) * rstep) = w; }
    }
};
struct EpiMoeScatter {
    static constexpr bool PERM = false;
    const int* rowmap; float* hlat; const float* gate_lat; int ncol;
    __device__ __forceinline__ void operator()(const f32x4 (&acc)[2][2][4][2], const Unit& u, int wr, int wc, int fr, int fq) const {
        const int pnl = u.pn % ncol; const int col0 = pnl * BM + wc * 32 + 4 * fq;
        const int* rm = rowmap + u.pm * BM;
        unsigned pl = (unsigned)(wr * 64 + fr) * 4u; PG8_OPAQUE(pl);
#pragma unroll
        for (int ai = 0; ai < 2; ++ai)
#pragma unroll
            for (int m = 0; m < 4; ++m) { const int tok = *(const int*)((const char*)rm + pl + (unsigned)(ai * 8 + m) * 64u);
                if (tok >= 0) { float* dst = hlat + (size_t)tok * DM + col0; const float* gate = gate_lat + (size_t)(tok / SEQ) * 6144 + col0;
#pragma unroll
                    for (int bj = 0; bj < 2; ++bj)
#pragma unroll
                        for (int n = 0; n < 2; ++n) { const f32x4 s = *(const f32x4*)(dst + bj * HALF + n * 16); const f32x4 gv = *(const f32x4*)(gate + bj * HALF + n * 16);
                            *(f32x4*)(dst + bj * HALF + n * 16) = s + gv * acc[ai][bj][m][n]; } }
                asm volatile("" ::: "memory"); }
    }
};
struct MoeOrder {
    int NT, ncol, G, c; const PG8_LAS int* texp;
    __device__ bool next(int i, Unit& u) const {
        const long L = (long)i * G + c; if (L >= (long)NT * ncol) return false;
        const int t = (int)(L / ncol), pnl = (int)(L % ncol);
        const int e = __builtin_amdgcn_readfirstlane(texp[t]);
        u.pm = t; u.pn = e * ncol + pnl; return true;
    }
};
}

#define XB_TMO      128
#define XB_XCNT(j)  (256  + 64 * (j))
#define XB_XSUB(j)  (1280 + 64 * (j))
#define XB_XGEN(j)  (2304 + 64 * (j))
#define XB_TOP      3328
#define XB_TOPGEN   3392
#define XCD_BAR_WORDS 3456
#define XB_SPIN_CAP (1u << 18)
DI unsigned xb_ld(unsigned* p)              { return __hip_atomic_load(p, __ATOMIC_RELAXED, __HIP_MEMORY_SCOPE_AGENT); }
DI unsigned xb_add(unsigned* p, unsigned v) { return __hip_atomic_fetch_add(p, v, __ATOMIC_RELAXED, __HIP_MEMORY_SCOPE_AGENT); }
DI unsigned xb_xcc_id() { return (unsigned)__builtin_amdgcn_s_getreg((3 << 11) | 20) & 0xFu; }
#define XB_SPIN(cond, bar) do { unsigned _sp = 0; while (cond) { __builtin_amdgcn_s_sleep(1); \
    if ((++_sp & 255u) == 0u) { if (xb_ld(&(bar)[XB_TMO])) break; if (_sp > XB_SPIN_CAP) { atomicAdd(&(bar)[XB_TMO], 1u); break; } } } } while (0)
struct XcdBarrier { unsigned* bar; unsigned x; volatile LAS unsigned* st; };
DI XcdBarrier xcd_barrier_post(unsigned* bar, volatile LAS unsigned* st) {
    XcdBarrier b; b.bar = bar; b.x = xb_xcc_id(); b.st = st;
    if (threadIdx.x == 0) (void)xb_add(&bar[XB_XCNT(b.x)], 1u);
    return b;
}
DI void xcd_barrier_complete(unsigned* bar, unsigned x, unsigned& nloc, unsigned& nx) {
    const unsigned G = gridDim.x * gridDim.y * gridDim.z;
    unsigned sum, cnt, mine, sp = 0u;
    for (;;) {
        sum = 0u; cnt = 0u; mine = 0u;
#pragma unroll
        for (unsigned j = 0; j < 16; ++j) { const unsigned c = xb_ld(&bar[XB_XCNT(j)]); sum += c; cnt += (c > 0u) ? 1u : 0u; mine = (j == x) ? c : mine; }
        if (sum == G) break;
        __builtin_amdgcn_s_sleep(1);
        if ((++sp & 255u) == 0u) { if (xb_ld(&bar[XB_TMO])) break; if (sp > XB_SPIN_CAP) { atomicAdd(&bar[XB_TMO], 1u); break; } }
    }
    nloc = mine > 0u ? mine : 1u; nx = cnt > 0u ? cnt : 1u;
}
DI void xcd_barrier(const XcdBarrier& b) {
    asm volatile("s_waitcnt vmcnt(0)" ::: "memory");
    __syncthreads();
    if (threadIdx.x == 0) {
        unsigned* bar = b.bar;
        __builtin_amdgcn_s_waitcnt(0);
        unsigned nloc = b.st[0], nx = b.st[1];
        if (nloc == 0u) { xcd_barrier_complete(bar, b.x, nloc, nx); b.st[0] = nloc; b.st[1] = nx; }
        const unsigned old = xb_add(&bar[XB_XSUB(b.x)], 1u);
        const unsigned gen = old / nloc;
        if (old + 1u == (gen + 1u) * nloc) {
            __builtin_amdgcn_fence(__ATOMIC_RELEASE, "agent");
            asm volatile("s_waitcnt vmcnt(0)" ::: "memory");
            const unsigned og = xb_add(&bar[XB_TOP], 1u);
            const unsigned tg = og / nx;
            if (og + 1u == (tg + 1u) * nx) xb_add(&bar[XB_TOPGEN], 1u);
            else XB_SPIN(xb_ld(&bar[XB_TOPGEN]) == tg, bar);
            __builtin_amdgcn_fence(__ATOMIC_ACQUIRE, "agent");
            xb_add(&bar[XB_XGEN(b.x)], 1u);
            asm volatile("s_waitcnt vmcnt(0)" ::: "memory");
        } else {
            XB_SPIN(xb_ld(&bar[XB_XGEN(b.x)]) == gen, bar);
            __builtin_amdgcn_fence(__ATOMIC_ACQUIRE, "agent");
            asm volatile("s_waitcnt vmcnt(0)" ::: "memory");
        }
    }
    __syncthreads();
}

struct Params { const float* in[26]; float* out; unsigned char* ws; int ph_lo, ph_hi, pad0, pad1; };
enum { I_X = 0, I_C, I_CTX, I_CCTX, I_WMOD, I_BMOD, I_N1W, I_N2W, I_WIN, I_WOUT, I_RPB, I_CONVW, I_CONVB, I_CLNW, I_CLNB, I_RDEC, I_RGNW,
       I_FG, I_FU, I_FD, I_MR, I_MRB, I_MG, I_MU, I_MDN, I_FNW };
constexpr int PH_P0 = 0, PH_FINAL = 20, N_PHASES = 21;

typedef __attribute__((address_space(4))) const unsigned char* karg_t;
struct KIn {
    karg_t ka;
    DI const float* operator[](int k) const { return *(const float* __attribute__((address_space(4))) const*)(ka + 8 * k); }
};
struct Frame {
    LAS unsigned char* lds;
    int tid, lane, wave, G, bid;
    KIn in; float* out; unsigned char* ws;
};
DI Frame phase_frame(const Frame& F0) {
    Frame F; karg_t ka = F0.in.ka; asm volatile("" : "+s"(ka)); F.in.ka = ka;
    F.out = *(float* __attribute__((address_space(4))) const*)(ka + 208);
    F.ws = *(unsigned char* __attribute__((address_space(4))) const*)(ka + 216);
    int tid = F0.tid, G = F0.G, bid = F0.bid; unsigned ldsb = (unsigned)(size_t)F0.lds;
    asm volatile("" : "+v"(tid)); asm volatile("" : "+s"(G)); asm volatile("" : "+s"(bid)); asm volatile("" : "+s"(ldsb));
    F.tid = tid; F.lane = tid & 63; F.wave = __builtin_amdgcn_readfirstlane(tid >> 6); F.G = G; F.bid = bid; F.lds = (LAS unsigned char*)(size_t)ldsb;
    return F;
}

DI void p0_transpose_item(const float* W, int K, int N, bf16* WT, int k0, int n0, int dst_row0, LAS float* scr, int lane) {
#pragma unroll 8
    for (int i = 0; i < 32; ++i) { const int kk = 2 * i + (lane >> 5); scr[kk * 33 + (lane & 31)] = W[(size_t)(k0 + kk) * N + n0 + (lane & 31)]; }
    asm volatile("s_waitcnt lgkmcnt(0)" ::: "memory");
    const int c = lane & 7;
#pragma unroll
    for (int j = 0; j < 4; ++j) { const int n = (lane >> 3) + 8 * j; const LAS float* s = scr + (8 * c) * 33 + n;
        u32x4 o; o.x = pk2(s[0 * 33], s[1 * 33]); o.y = pk2(s[2 * 33], s[3 * 33]); o.z = pk2(s[4 * 33], s[5 * 33]); o.w = pk2(s[6 * 33], s[7 * 33]);
        *(u32x4*)(WT + (size_t)(dst_row0 + n) * K + k0 + 8 * c) = o; }
    asm volatile("s_waitcnt lgkmcnt(0)" ::: "memory");
}
DI void p0_convert_plain(Frame& F, const float* W, int K, int N, bf16* WT, int item, LAS float* scr) {
    const int nblk = N / 32, kb = item / nblk, nb = item % nblk;
    p0_transpose_item(W, K, N, WT, 64 * kb, 32 * nb, 32 * nb, scr, F.lane);
}
DI void p0_convert_gu(Frame& F, const float* W, int K, int N, bf16* WT, int item, int up, LAS float* scr) {
    const int nblk = N / 32, kb = item / nblk, nb = item % nblk, n0 = 32 * nb;
    p0_transpose_item(W, K, N, WT, 64 * kb, n0, 256 * (n0 / 128) + (n0 % 128) + (up ? 128 : 0), scr, F.lane);
}
DI void p0_prologue(Frame& F) {
    {
        LAS float* Sx = (LAS float*)F.lds;
        LAS float* red = (LAS float*)(F.lds + 81920);
        bool staged = false;
        for (int unit = F.bid; unit < 192; unit += F.G) {
            if (!staged) {
                for (int idx = F.tid; idx < 17 * 1024; idx += 512) { const int r = idx / 1024, k = idx % 1024;
                    const float v = r < 16 ? F.in[I_C][r * 1024 + k] : F.in[I_CCTX][k]; Sx[k * 20 + r] = v * sigmoidf_(v); }
                staged = true; __syncthreads();
            }
            const int l = unit / 96, n0 = (unit % 96) * 64;
            const float* Wm = F.in[I_WMOD] + (size_t)l * 1024 * 6144 + n0 + F.lane;
            float acc[17];
#pragma unroll
            for (int r = 0; r < 17; ++r) acc[r] = 0.f;
            const int kb = F.wave * 128;
#pragma unroll 4
            for (int k = 0; k < 128; ++k) { const float wv = Wm[(size_t)(kb + k) * 6144]; const LAS float* sp = Sx + (kb + k) * 20;
                const f32x4 s0 = *(const LAS f32x4*)(sp), s1 = *(const LAS f32x4*)(sp + 4), s2 = *(const LAS f32x4*)(sp + 8), s3 = *(const LAS f32x4*)(sp + 12); const float s4 = sp[16];
                acc[0] += s0[0] * wv; acc[1] += s0[1] * wv; acc[2] += s0[2] * wv; acc[3] += s0[3] * wv; acc[4] += s1[0] * wv; acc[5] += s1[1] * wv; acc[6] += s1[2] * wv; acc[7] += s1[3] * wv;
                acc[8] += s2[0] * wv; acc[9] += s2[1] * wv; acc[10] += s2[2] * wv; acc[11] += s2[3] * wv; acc[12] += s3[0] * wv; acc[13] += s3[1] * wv; acc[14] += s3[2] * wv; acc[15] += s3[3] * wv;
                acc[16] += s4 * wv; }
#pragma unroll
            for (int r = 0; r < 17; ++r) red[(F.wave * 17 + r) * 64 + F.lane] = acc[r];
            __syncthreads();
            for (int idx = F.tid; idx < 17 * 64; idx += 512) { const int r = idx / 64, ln = idx % 64; float s = F.in[I_BMOD][l * 6144 + n0 + ln];
#pragma unroll
                for (int w = 0; w < 8; ++w) s += red[(w * 17 + r) * 64 + ln];
                if (r < 16) ((float*)(F.ws + WS_MODLAT))[((size_t)l * 16 + r) * 6144 + n0 + ln] = s; else ((float*)(F.ws + WS_MODCTX))[(size_t)l * 6144 + n0 + ln] = s; }
            __syncthreads();
        }
        __syncthreads();
    }
    if (F.bid == 0) { const int pos = F.tid >> 3, j = F.tid & 7; const float inv = exp2f(-(float)j * 0.125f * 13.287712379549449f); const float ang = (float)pos * inv;
        float* tab = (float*)(F.ws + WS_ROPE); tab[(pos * 8 + j) * 2] = cosf(ang); tab[(pos * 8 + j) * 2 + 1] = sinf(ang); }
    {
        LAS float* scr = (LAS float*)(F.lds + F.wave * 16384);
        const int gw = F.bid * 8 + F.wave, NGW = F.G * 8;
        constexpr int I_IN = 16 * 96, I_OUT = 16 * 32, I_G = 16 * 88, I_D = 44 * 32, I_MGI = 16 * 112, I_MDI = 56 * 32;
        constexpr int NITEMS = 2 * I_IN + 2 * I_OUT + 2 * I_G + I_D + 16 * I_MGI + 8 * I_MDI;
        for (int it = gw; it < NITEMS; it += NGW) {
            int r = it;
            if (r < 2 * I_IN) { const int l = r / I_IN; p0_convert_plain(F, F.in[I_WIN] + (size_t)l * 1024 * 3072, 1024, 3072, (bf16*)(F.ws + WS_WIN) + (size_t)l * 3072 * 1024, r % I_IN, scr); continue; } r -= 2 * I_IN;
            if (r < 2 * I_OUT) { const int l = r / I_OUT; p0_convert_plain(F, F.in[I_WOUT] + (size_t)l * 1024 * 1024, 1024, 1024, (bf16*)(F.ws + WS_WOUT) + (size_t)l * 1024 * 1024, r % I_OUT, scr); continue; } r -= 2 * I_OUT;
            if (r < I_G) { p0_convert_gu(F, F.in[I_FG], 1024, 2816, (bf16*)(F.ws + WS_WGU), r, 0, scr); continue; } r -= I_G;
            if (r < I_G) { p0_convert_gu(F, F.in[I_FU], 1024, 2816, (bf16*)(F.ws + WS_WGU), r, 1, scr); continue; } r -= I_G;
            if (r < I_D) { p0_convert_plain(F, F.in[I_FD], 2816, 1024, (bf16*)(F.ws + WS_WD), r, scr); continue; } r -= I_D;
            if (r < 8 * I_MGI) { const int e = r / I_MGI; p0_convert_gu(F, F.in[I_MG] + (size_t)e * 1024 * 3584, 1024, 3584, (bf16*)(F.ws + WS_MGU) + (size_t)e * 7168 * 1024, r % I_MGI, 0, scr); continue; } r -= 8 * I_MGI;
            if (r < 8 * I_MGI) { const int e = r / I_MGI; p0_convert_gu(F, F.in[I_MU] + (size_t)e * 1024 * 3584, 1024, 3584, (bf16*)(F.ws + WS_MGU) + (size_t)e * 7168 * 1024, r % I_MGI, 1, scr); continue; } r -= 8 * I_MGI;
            { const int e = r / I_MDI; p0_convert_plain(F, F.in[I_MDN] + (size_t)e * 3584 * 1024, 3584, 1024, (bf16*)(F.ws + WS_MD) + (size_t)e * 1024 * 3584, r % I_MDI, scr); }
        }
    }
}

DI void norm_row(Frame& F, const float* srow, const float* g, const float* sc, const float* sh, bf16* orow, f32x4 (&y)[4]) {
    const f32x4* xr = (const f32x4*)srow + F.lane;
    f32x4 v[4]; float s = 0.f;
#pragma unroll
    for (int j = 0; j < 4; ++j) { v[j] = xr[64 * j]; s += (v[j].x * v[j].x + v[j].y * v[j].y) + (v[j].z * v[j].z + v[j].w * v[j].w); }
    const float rstd = 1.0f / sqrtf(wave_sum(s) * (1.0f / DM) + EPS);
    u32x2* o8 = (u32x2*)orow + F.lane;
#pragma unroll
    for (int j = 0; j < 4; ++j) { const f32x4 gv = ((const f32x4*)g)[F.lane + 64 * j], sv = ((const f32x4*)sc)[F.lane + 64 * j], hv = ((const f32x4*)sh)[F.lane + 64 * j];
        y[j] = (v[j] * rstd) * gv * (sv + 1.0f) + hv;
        u32x2 w; w.x = pk2(y[j].x, y[j].y); w.y = pk2(y[j].z, y[j].w); o8[64 * j] = w; }
}
DI void norm_phase(Frame& F, int l, int which, bool first, int row_lo) {
    const float* g = F.in[which == 1 ? I_N1W : I_N2W] + l * DM;
    const float* modlat = (const float*)(F.ws + WS_MODLAT) + (size_t)l * 16 * 6144;
    const float* modctx = (const float*)(F.ws + WS_MODCTX) + (size_t)l * 6144;
    const int ish = which == 1 ? 0 : 3, isc = which == 1 ? 1 : 4;
    const float* sctx = first ? F.in[I_CTX] : (const float*)(F.ws + WS_HCTX);
    const float* slat = first ? F.in[I_X] : F.out;
    bf16* U = (bf16*)(F.ws + WS_U);
    const int gw = F.bid * 8 + F.wave, NGW = F.G * 8;
    for (int row = row_lo + gw; row < NTOK; row += NGW) {
        const bool isctx = row < NCTX;
        const float* src = isctx ? sctx + (size_t)row * DM : slat + (size_t)(row - NCTX) * DM;
        const float* mod = isctx ? modctx : modlat + (size_t)((row - NCTX) / SEQ) * 6144;
        f32x4 y[4];
        norm_row(F, src, g, mod + isc * DM, mod + ish * DM, U + (size_t)row * DM, y);
    }
}
DI void norm_moe_phase(Frame& F) {
    const int l = 1;
    const float* g = F.in[I_N2W] + l * DM;
    const float* modlat = (const float*)(F.ws + WS_MODLAT) + (size_t)l * 16 * 6144;
    bf16* U = (bf16*)(F.ws + WS_U);
    LAS float* Rw = (LAS float*)F.lds;
    LAS int* sel = (LAS int*)(F.lds + 32768);
    for (int idx = F.tid; idx < 8192; idx += 512) Rw[idx] = F.in[I_MR][idx];
    __syncthreads();
    float rb[8];
#pragma unroll
    for (int e = 0; e < 8; ++e) rb[e] = F.in[I_MRB][e];
    for (int seg = F.bid; seg < 256; seg += F.G) {
        for (int i = 0; i < 16; ++i) {
            const int tl = F.wave * 16 + i, tok = seg * 128 + tl;
            const float* mod = modlat + (size_t)(tok / SEQ) * 6144;
            f32x4 y[4];
            norm_row(F, F.out + (size_t)tok * DM, g, mod + 4 * DM, mod + 3 * DM, U + (size_t)(NCTX + tok) * DM, y);
            float lg[8];
#pragma unroll
            for (int e = 0; e < 8; ++e) lg[e] = 0.f;
#pragma unroll
            for (int j = 0; j < 4; ++j)
#pragma unroll
                for (int q = 0; q < 4; ++q) { const int k = 256 * j + 4 * F.lane + q; const f32x4 r0 = *(const LAS f32x4*)(Rw + k * 8), r1 = *(const LAS f32x4*)(Rw + k * 8 + 4); const float yv = y[j][q];
                    lg[0] += yv * r0[0]; lg[1] += yv * r0[1]; lg[2] += yv * r0[2]; lg[3] += yv * r0[3]; lg[4] += yv * r1[0]; lg[5] += yv * r1[1]; lg[6] += yv * r1[2]; lg[7] += yv * r1[3]; }
#pragma unroll
            for (int e = 0; e < 8; ++e) lg[e] = wave_sum(lg[e]) + rb[e];
            int e1 = 0; float v1 = lg[0];
#pragma unroll
            for (int e = 1; e < 8; ++e) if (lg[e] > v1) { v1 = lg[e]; e1 = e; }
            int e2 = -1; float v2 = -3.0e38f;
#pragma unroll
            for (int e = 0; e < 8; ++e) if (e != e1 && lg[e] > v2) { v2 = lg[e]; e2 = e; }
            const float ex = __expf(v2 - v1), p1 = 1.0f / (1.0f + ex), p2 = ex / (1.0f + ex);
            if (F.lane == 0) { sel[tl * 2] = e1; sel[tl * 2 + 1] = e2; float* pt = (float*)(F.ws + WS_PTOK) + (size_t)tok * 2; pt[0] = p1; pt[1] = p2; }
        }
        __syncthreads();
        if (F.tid < 16) { const int s = F.tid >> 3, e = F.tid & 7; int cnt = 0; int* lst = (int*)(F.ws + WS_SEGLIST) + ((size_t)(seg * 2 + s) * 8 + e) * 128;
            for (int i = 0; i < 128; ++i) if (sel[i * 2 + s] == e) lst[cnt++] = seg * 128 + i;
            ((int*)(F.ws + WS_SEGCNT))[(seg * 2 + s) * 8 + e] = cnt; }
        __syncthreads();
    }
}
DI void moe_route_phase(Frame& F) {
    LAS int* cn = (LAS int*)F.lds;
    LAS int* offs = cn + 2048;
    LAS int* tb = offs + 256;
    for (int unit = F.bid; unit < 16; unit += F.G) {
        const int s = unit >> 3, e = unit & 7;
        const int* segcnt = (const int*)(F.ws + WS_SEGCNT);
        for (int idx = F.tid; idx < 2048; idx += 512) { const int ee = idx >> 8, gsg = idx & 255; cn[idx] = segcnt[(gsg * 2 + s) * 8 + ee]; }
        __syncthreads();
        if (F.tid < 8) { int tot = 0; for (int gsg = 0; gsg < 256; ++gsg) tot += cn[F.tid * 256 + gsg]; tb[16 + F.tid] = tot; }
        if (F.tid == 64) { int run = 0; for (int gsg = 0; gsg < 256; ++gsg) { offs[gsg] = run; run += cn[e * 256 + gsg]; } }
        __syncthreads();
        if (F.tid == 0) { int run = 0; for (int ee = 0; ee < 8; ++ee) { tb[ee] = run; run += (tb[16 + ee] + 255) / 256; } tb[8] = run; }
        __syncthreads();
        int* rowmap = (int*)(F.ws + WS_ROWMAP) + (size_t)s * MOE_ROWS;
        float* prow = (float*)(F.ws + WS_PROW) + (size_t)s * MOE_ROWS;
        const float* ptok = (const float*)(F.ws + WS_PTOK);
        const int base = tb[e] * 256, tot = tb[16 + e], ntile = (tot + 255) / 256;
        if (F.tid < 256) { const int gsg = F.tid; const int c = cn[e * 256 + gsg]; const int* lst = (const int*)(F.ws + WS_SEGLIST) + ((size_t)(gsg * 2 + s) * 8 + e) * 128;
            for (int i = 0; i < c; ++i) { const int tok = lst[i]; rowmap[base + offs[gsg] + i] = tok; prow[base + offs[gsg] + i] = ptok[(size_t)tok * 2 + s]; } }
        for (int i = tot + F.tid; i < ntile * 256; i += 512) { rowmap[base + i] = -1; prow[base + i] = 0.f; }
        if (e == 0) { int* meta = (int*)(F.ws + WS_META) + s * 256;
            if (F.tid == 0) meta[0] = tb[8];
            if (F.tid < 8) { const int t0 = tb[F.tid], t1 = tb[F.tid + 1]; for (int t = t0; t < t1; ++t) meta[1 + t] = F.tid; } }
        __syncthreads();
    }
}
DI void final_phase(Frame& F) {
    const float* g = F.in[I_FNW];
    const int gw = F.bid * 8 + F.wave, NGW = F.G * 8;
    for (int row = gw; row < NLAT; row += NGW) {
        f32x4* xr = (f32x4*)(F.out + (size_t)row * DM) + F.lane;
        f32x4 v[4]; float s = 0.f;
#pragma unroll
        for (int j = 0; j < 4; ++j) { v[j] = xr[64 * j]; s += (v[j].x * v[j].x + v[j].y * v[j].y) + (v[j].z * v[j].z + v[j].w * v[j].w); }
        const float rstd = 1.0f / sqrtf(wave_sum(s) * (1.0f / DM) + EPS);
#pragma unroll
        for (int j = 0; j < 4; ++j) { const f32x4 gv = ((const f32x4*)g)[F.lane + 64 * j]; xr[64 * j] = (v[j] * rstd) * gv; }
    }
}

DI void conv_unit(Frame& F, int l, int row0, int t0, int slen) {
    const bf16* PX = (const bf16*)(F.ws + WS_P);
    bf16* YC = (bf16*)(F.ws + WS_U);
    LAS float* Y = (LAS float*)F.lds;
    for (int it = F.tid; it < 94 * 32; it += 512) { const int rr = it >> 5, cc = it & 31; const int t = t0 - 15 + rr;
        f32x4 o0 = (f32x4){0.f, 0.f, 0.f, 0.f}, o1 = o0;
        if (t >= 0 && t < slen) { const bf16* p = PX + (size_t)(row0 + t) * INW + C_CONV + 8 * cc; const u32x4 av = *(const u32x4*)p, gv = *(const u32x4*)(p + 256);
            o0[0] = bflo(av.x) * sigmoidf_(bflo(gv.x)); o0[1] = bfhi(av.x) * sigmoidf_(bfhi(gv.x)); o0[2] = bflo(av.y) * sigmoidf_(bflo(gv.y)); o0[3] = bfhi(av.y) * sigmoidf_(bfhi(gv.y));
            o1[0] = bflo(av.z) * sigmoidf_(bflo(gv.z)); o1[1] = bfhi(av.z) * sigmoidf_(bfhi(gv.z)); o1[2] = bflo(av.w) * sigmoidf_(bflo(gv.w)); o1[3] = bfhi(av.w) * sigmoidf_(bfhi(gv.w)); }
        *(LAS f32x4*)(Y + rr * 256 + 8 * cc) = o0; *(LAS f32x4*)(Y + rr * 256 + 8 * cc + 4) = o1; }
    __syncthreads();
    const int c = F.tid & 255, half = F.tid >> 8;
    float w[31];
#pragma unroll
    for (int k = 0; k < 31; ++k) w[k] = F.in[I_CONVW][(size_t)l * 31 * 256 + k * 256 + c];
    float acc[32];
    const float cb = F.in[I_CONVB][l * 256 + c];
#pragma unroll
    for (int o = 0; o < 32; ++o) acc[o] = cb;
#pragma unroll
    for (int kk = 0; kk < 62; ++kk) { const float yv = Y[(32 * half + kk) * 256 + c];
#pragma unroll
        for (int o = 0; o < 32; ++o) { const int tap = kk - o; if (tap >= 0 && tap < 31) acc[o] += yv * w[tap]; } }
    __syncthreads();
#pragma unroll
    for (int o = 0; o < 32; ++o) Y[(32 * half + o) * 256 + c] = acc[o];
    __syncthreads();
    const f32x4 lw = ((const f32x4*)(F.in[I_CLNW] + l * 256))[F.lane], lb = ((const f32x4*)(F.in[I_CLNB] + l * 256))[F.lane];
    for (int i = 0; i < 8; ++i) { const int tl = F.wave * 8 + i; const f32x4 v = *(const LAS f32x4*)(Y + tl * 256 + 4 * F.lane);
        const float mu = wave_sum((v.x + v.y) + (v.z + v.w)) * (1.0f / 256.0f); const f32x4 d = v - mu;
        const float var = wave_sum((d.x * d.x + d.y * d.y) + (d.z * d.z + d.w * d.w)) * (1.0f / 256.0f); const float rstd = 1.0f / sqrtf(var + EPS);
        f32x4 z = d * rstd * lw + lb; z.x *= sigmoidf_(z.x); z.y *= sigmoidf_(z.y); z.z *= sigmoidf_(z.z); z.w *= sigmoidf_(z.w);
        u32x2 o; o.x = pk2(z.x, z.y); o.y = pk2(z.z, z.w);
        *(u32x2*)(YC + (size_t)(row0 + t0 + tl) * DM + 512 + 4 * F.lane) = o; }
    __syncthreads();
}
DI void ret_consts(Frame& F, int l, int hh, float& lg2f, float& lg2b) {
    const float df = F.in[I_RDEC][(l * 2 + 0) * 4 + hh], db = F.in[I_RDEC][(l * 2 + 1) * 4 + hh];
    lg2f = log2f(1.0f - exp2f(-df)); lg2b = log2f(1.0f - exp2f(-db));
}
DI void ret_load_rope(Frame& F, const bf16* p, int hp, bool lat, int tg, float (&x1)[8], float (&x2)[8]) {
    const u32x4 a = *(const u32x4*)(p + 8 * hp), b = *(const u32x4*)(p + 16 + 8 * hp);
    x1[0] = bflo(a.x); x1[1] = bfhi(a.x); x1[2] = bflo(a.y); x1[3] = bfhi(a.y); x1[4] = bflo(a.z); x1[5] = bfhi(a.z); x1[6] = bflo(a.w); x1[7] = bfhi(a.w);
    x2[0] = bflo(b.x); x2[1] = bfhi(b.x); x2[2] = bflo(b.y); x2[3] = bfhi(b.y); x2[4] = bflo(b.z); x2[5] = bfhi(b.z); x2[6] = bflo(b.w); x2[7] = bfhi(b.w);
    if (lat) { const int pos = hp == 0 ? (tg >> 6) : (tg & 63); const f32x4* tab = (const f32x4*)((const float*)(F.ws + WS_ROPE) + pos * 16);
#pragma unroll
        for (int jj = 0; jj < 4; ++jj) { const f32x4 cs = tab[jj];
            { const float a1 = x1[2 * jj], a2 = x2[2 * jj]; x1[2 * jj] = a1 * cs[0] - a2 * cs[1]; x2[2 * jj] = a2 * cs[0] + a1 * cs[1]; }
            { const float a1 = x1[2 * jj + 1], a2 = x2[2 * jj + 1]; x1[2 * jj + 1] = a1 * cs[2] - a2 * cs[3]; x2[2 * jj + 1] = a2 * cs[2] + a1 * cs[3]; } } }
}
DI void ret_unit_decode(int su, bool& isctx, int& b, int& hh, int& n) {
    isctx = su >= 1024; if (!isctx) { b = su >> 6; hh = (su >> 4) & 3; n = su & 15; } else { const int v = su - 1024; b = v >> 3; hh = (v >> 1) & 3; n = v & 1; }
}
DI void ret_summary_pair(Frame& F, int l, int it) {
    const bf16* PX = (const bf16*)(F.ws + WS_P);
    const int sub = F.wave >> 2, st = F.tid & 255, su = 2 * it + sub;
    bool isctx; int b, hh, n; ret_unit_decode(su, isctx, b, hh, n);
    const int row0 = isctx ? (b * CTXL + n * 128) : (NCTX + b * SEQ + n * 128);
    float lg2f, lg2b; ret_consts(F, l, hh, lg2f, lg2b);
    LAS unsigned char* base = F.lds + sub * 40960;
    LAS unsigned char* Vimg = base;
    LAS unsigned char* Kf = base + 18432;
    LAS unsigned char* Kb = base + 18432 + 10240;
    { const int tok = st >> 1, hp = st & 1; float x1[8], x2[8];
      ret_load_rope(F, PX + (size_t)(row0 + tok) * INW + C_RK + 32 * hh, hp, !isctx, n * 128 + tok, x1, x2);
      const float ks = 0.17677669529663687f;
      const float wf = fast_exp2(lg2f * (float)(127 - tok)) * ks, wb = fast_exp2(lg2b * (float)tok) * ks;
      u32x4 o;
      o.x = pk2(x1[0] * wf, x1[1] * wf); o.y = pk2(x1[2] * wf, x1[3] * wf); o.z = pk2(x1[4] * wf, x1[5] * wf); o.w = pk2(x1[6] * wf, x1[7] * wf); *(LAS u32x4*)(Kf + tok * 80 + 16 * hp) = o;
      o.x = pk2(x2[0] * wf, x2[1] * wf); o.y = pk2(x2[2] * wf, x2[3] * wf); o.z = pk2(x2[4] * wf, x2[5] * wf); o.w = pk2(x2[6] * wf, x2[7] * wf); *(LAS u32x4*)(Kf + tok * 80 + 32 + 16 * hp) = o;
      o.x = pk2(x1[0] * wb, x1[1] * wb); o.y = pk2(x1[2] * wb, x1[3] * wb); o.z = pk2(x1[4] * wb, x1[5] * wb); o.w = pk2(x1[6] * wb, x1[7] * wb); *(LAS u32x4*)(Kb + tok * 80 + 16 * hp) = o;
      o.x = pk2(x2[0] * wb, x2[1] * wb); o.y = pk2(x2[2] * wb, x2[3] * wb); o.z = pk2(x2[4] * wb, x2[5] * wb); o.w = pk2(x2[6] * wb, x2[7] * wb); *(LAS u32x4*)(Kb + tok * 80 + 32 + 16 * hp) = o;
      const bf16* vp = PX + (size_t)(row0 + tok) * INW + C_RV + 64 * hh + 32 * hp;
#pragma unroll
      for (int q = 0; q < 4; ++q) *(LAS u32x4*)(Vimg + tok * 144 + 64 * hp + 16 * q) = *(const u32x4*)(vp + 8 * q); }
    __syncthreads();
    { const int role = F.wave & 3, dir = role >> 1, et = role & 1;
      const int l32 = F.lane & 31, h = F.lane >> 5, grp = (F.lane >> 4) & 1, i16 = F.lane & 15, q = i16 >> 2, p = i16 & 3;
      LAS unsigned char* Kimg = dir ? Kb : Kf;
      f32x16 acc;
#pragma unroll
      for (int i = 0; i < 16; ++i) acc[i] = 0.f;
#pragma unroll
      for (int s = 0; s < 8; ++s) { const int r0 = 16 * s + 8 * h + q;
          const s16x4 alo = trread(Vimg + r0 * 144 + (32 * et + 16 * grp + 4 * p) * 2), ahi = trread(Vimg + (r0 + 4) * 144 + (32 * et + 16 * grp + 4 * p) * 2);
          const s16x4 blo = trread(Kimg + r0 * 80 + (16 * grp + 4 * p) * 2), bhi = trread(Kimg + (r0 + 4) * 80 + (16 * grp + 4 * p) * 2);
          const bf16x8 a = __builtin_shufflevector(alo, ahi, 0, 1, 2, 3, 4, 5, 6, 7), bb = __builtin_shufflevector(blo, bhi, 0, 1, 2, 3, 4, 5, 6, 7);
          acc = MFMA32(a, bb, acc); }
      float* S = isctx ? (float*)(F.ws + WS_SUMCTX) + ((size_t)((b * 4 + hh) * 2 + n) * 2 + dir) * 2048 : (float*)(F.ws + WS_SUMLAT) + ((size_t)((b * 4 + hh) * 16 + n) * 2 + dir) * 2048;
#pragma unroll
      for (int i = 0; i < 16; ++i) S[(32 * et + crow(i, h)) * 32 + l32] = acc[i]; }
    __syncthreads();
}
DI void ca_phase(Frame& F, int l) {
    const int nconv = l == 0 ? 576 : 512;
    for (int u = F.bid; u < nconv; u += F.G) {
        int v = u; if (l != 0) v += 64;
        if (v < 64) conv_unit(F, l, (v >> 2) * CTXL, (v & 3) * 64, CTXL);
        else { v -= 64; conv_unit(F, l, NCTX + (v >> 5) * SEQ, (v & 31) * 64, SEQ); }
    }
    for (int it = F.bid; it < 576; it += F.G) ret_summary_pair(F, l, it);
}

DI void attn_stage(Frame& F, const bf16* PX, int keyrow0, int hh, LAS unsigned char* Kimg, LAS unsigned char* Vimg) {
    const int key = F.tid >> 3, ch = F.tid & 7;
    const bf16* p = PX + (size_t)(keyrow0 + key) * INW + 64 * hh + 8 * ch;
    const u32x4 kv = *(const u32x4*)(p + C_NAK), vv = *(const u32x4*)(p + C_NAV);
    *(LAS u32x4*)(Kimg + key * 144 + 16 * ch) = kv; *(LAS u32x4*)(Vimg + key * 144 + 16 * ch) = vv;
}
template <bool BIAS>
DI void attn_tile(LAS const unsigned char* Kimg, LAS const unsigned char* Vimg, int kt, const bf16x8 (&qf)[4], f32x16& o0, f32x16& o1, float& mrun, float& lrun,
                  int lane, LAS const float* btab  , int qcol, int winc0) {
    const int l32 = lane & 31, h = lane >> 5, grp = (lane >> 4) & 1, i16 = lane & 15, q = i16 >> 2, p = i16 & 3;
    f32x16 s;
#pragma unroll
    for (int i = 0; i < 16; ++i) s[i] = 0.f;
#pragma unroll
    for (int si = 0; si < 4; ++si) { const bf16x8 a = *(const LAS bf16x8*)(Kimg + (32 * kt + l32) * 144 + (16 * si + 8 * h) * 2); s = MFMA32(a, qf[si], s); }
    const float c = 0.125f * LOG2E;
    float v[16]; float mx = -1.0e30f;
#pragma unroll
    for (int i = 0; i < 16; ++i) { float t = s[i] * c;
        if (BIAS) { const int kcol = 32 * kt + crow(i, h); const bool ok = (unsigned)(kcol - winc0) < 16u; const float bv = btab[kcol - qcol + 15]; t = ok ? t + bv : -1.0e30f; }
        v[i] = t; mx = fmaxf(mx, t); }
    mx = fmaxf(mx, __shfl_xor(mx, 32));
    const float mnew = fmaxf(mrun, mx);
    const float alpha = fast_exp2(mrun - mnew);
    if (__any(alpha != 1.0f)) {
#pragma unroll
        for (int i = 0; i < 16; ++i) { o0[i] *= alpha; o1[i] *= alpha; }
        lrun *= alpha; }
    mrun = mnew;
    float ps = 0.f; float pp[16];
#pragma unroll
    for (int i = 0; i < 16; ++i) { pp[i] = fast_exp2(v[i] - mnew); ps += pp[i]; }
    lrun += ps;
    bf16x8 pf[2];
#pragma unroll
    for (int s2 = 0; s2 < 2; ++s2) { u32x4 w; w.x = pk2(pp[8 * s2], pp[8 * s2 + 1]); w.y = pk2(pp[8 * s2 + 2], pp[8 * s2 + 3]); w.z = pk2(pp[8 * s2 + 4], pp[8 * s2 + 5]); w.w = pk2(pp[8 * s2 + 6], pp[8 * s2 + 7]); pf[s2] = __builtin_bit_cast(bf16x8, w); }
#pragma unroll
    for (int s2 = 0; s2 < 2; ++s2) { const int r0 = 32 * kt + 16 * s2 + 4 * h + q;
#pragma unroll
        for (int et = 0; et < 2; ++et) { const int cb = (32 * et + 16 * grp + 4 * p) * 2;
            const s16x4 lo = trread(Vimg + r0 * 144 + cb), hi = trread(Vimg + (r0 + 8) * 144 + cb);
            const bf16x8 a = __builtin_shufflevector(lo, hi, 0, 1, 2, 3, 4, 5, 6, 7);
            if (et == 0) o0 = MFMA32(a, pf[s2], o0); else o1 = MFMA32(a, pf[s2], o1); } }
}
DI void attn_unit(Frame& F, int l, bool na, int b, int hh, int rg) {
    const bf16* PX = (const bf16*)(F.ws + WS_P);
    bf16* YC = (bf16*)(F.ws + WS_U);
    LAS unsigned char* Kimg = F.lds; LAS unsigned char* Vimg = F.lds + 9216; LAS float* btab = (LAS float*)(F.lds + 18432);
    const int l32 = F.lane & 31, h = F.lane >> 5;
    int qrow, r = 0, qcol = 0, winc0 = 0;
    if (na) { r = 4 * rg + (F.wave >> 1); qcol = 32 * (F.wave & 1) + l32; qrow = NCTX + b * SEQ + r * GW + qcol; int w0 = qcol - 8; w0 = w0 < 0 ? 0 : (w0 > 48 ? 48 : w0); winc0 = w0; }
    else qrow = b * CTXL + 32 * F.wave + l32;
    bf16x8 qf[4];
#pragma unroll
    for (int si = 0; si < 4; ++si) qf[si] = *(const bf16x8*)(PX + (size_t)qrow * INW + C_NAQ + 64 * hh + 16 * si + 8 * h);
    if (na) { for (int idx = F.tid; idx < 48 + 15 * 31 + 64; idx += 512) { float v = 0.f; if (idx >= 48 && idx < 48 + 465) v = F.in[I_RPB][((size_t)l * 8 + hh) * 465 + (idx - 48)] * LOG2E; btab[idx] = v; } }
    f32x16 o0, o1;
#pragma unroll
    for (int i = 0; i < 16; ++i) { o0[i] = 0.f; o1[i] = 0.f; }
    float mrun = -1.0e30f, lrun = 0.f;
    for (int st = 0; st < 4; ++st) {
        __syncthreads();
        attn_stage(F, PX, b * CTXL + 64 * st, hh, Kimg, Vimg);
        __syncthreads();
        attn_tile<false>(Kimg, Vimg, 0, qf, o0, o1, mrun, lrun, F.lane, btab, 0, 0);
        attn_tile<false>(Kimg, Vimg, 1, qf, o0, o1, mrun, lrun, F.lane, btab, 0, 0);
    }
    if (na) {
        const int rlo = 4 * rg, rhi = 4 * rg + 3;
        int ylo = rlo - 4; ylo = ylo < 0 ? 0 : (ylo > 24 ? 24 : ylo);
        int yhi = rhi - 4; yhi = yhi < 0 ? 0 : (yhi > 24 ? 24 : yhi); yhi += 8;
        int mylo = r - 4; mylo = mylo < 0 ? 0 : (mylo > 24 ? 24 : mylo);
        for (int y = ylo; y < yhi; ++y) {
            __syncthreads();
            attn_stage(F, PX, NCTX + b * SEQ + y * GW, hh, Kimg, Vimg);
            __syncthreads();
            if (y >= mylo && y < mylo + 8) {
                LAS const float* bt = btab + 48 + (y - r + 7) * 31;
                attn_tile<true>(Kimg, Vimg, 0, qf, o0, o1, mrun, lrun, F.lane, bt, qcol, winc0);
                attn_tile<true>(Kimg, Vimg, 1, qf, o0, o1, mrun, lrun, F.lane, bt, qcol, winc0);
            }
        }
    }
    const float ltot = lrun + __shfl_xor(lrun, 32);
    const float inv = 1.0f / ltot;
    bf16* orow = YC + (size_t)qrow * DM + 64 * hh;
#pragma unroll
    for (int gq = 0; gq < 4; ++gq) { u32x2 w;
        w.x = pk2(o0[4 * gq] * inv, o0[4 * gq + 1] * inv); w.y = pk2(o0[4 * gq + 2] * inv, o0[4 * gq + 3] * inv); *(u32x2*)(orow + 8 * gq + 4 * h) = w;
        w.x = pk2(o1[4 * gq] * inv, o1[4 * gq + 1] * inv); w.y = pk2(o1[4 * gq + 2] * inv, o1[4 * gq + 3] * inv); *(u32x2*)(orow + 32 + 8 * gq + 4 * h) = w; }
    __syncthreads();
}
DI void ret_out_unit(Frame& F, int l, int su) {
    const bf16* PX = (const bf16*)(F.ws + WS_P);
    bf16* YC = (bf16*)(F.ws + WS_U);
    bool isctx; int b, hh, n; ret_unit_decode(su, isctx, b, hh, n);
    const int row0 = isctx ? (b * CTXL + n * 128) : (NCTX + b * SEQ + n * 128);
    float lg2f, lg2b; ret_consts(F, l, hh, lg2f, lg2b);
    LAS unsigned char* Kimg = F.lds;
    LAS unsigned char* Vimg = F.lds + 10240;
    LAS unsigned char* Stf = F.lds + 28672;
    LAS unsigned char* Stb = F.lds + 33792;
    LAS float* Ob = (LAS float*)(F.lds + 38912);
    if (F.tid < 256) { const int tok = F.tid >> 1, hp = F.tid & 1; float x1[8], x2[8];
        ret_load_rope(F, PX + (size_t)(row0 + tok) * INW + C_RK + 32 * hh, hp, !isctx, n * 128 + tok, x1, x2);
        const float ks = 0.17677669529663687f; u32x4 o;
        o.x = pk2(x1[0] * ks, x1[1] * ks); o.y = pk2(x1[2] * ks, x1[3] * ks); o.z = pk2(x1[4] * ks, x1[5] * ks); o.w = pk2(x1[6] * ks, x1[7] * ks); *(LAS u32x4*)(Kimg + tok * 80 + 16 * hp) = o;
        o.x = pk2(x2[0] * ks, x2[1] * ks); o.y = pk2(x2[2] * ks, x2[3] * ks); o.z = pk2(x2[4] * ks, x2[5] * ks); o.w = pk2(x2[6] * ks, x2[7] * ks); *(LAS u32x4*)(Kimg + tok * 80 + 32 + 16 * hp) = o; }
    { const int tok = F.tid >> 2, ch = F.tid & 3; const bf16* vp = PX + (size_t)(row0 + tok) * INW + C_RV + 64 * hh + 16 * ch;
        *(LAS u32x4*)(Vimg + tok * 144 + 32 * ch) = *(const u32x4*)vp; *(LAS u32x4*)(Vimg + tok * 144 + 32 * ch + 16) = *(const u32x4*)(vp + 8); }
    { const float cf = fast_exp2(lg2f * 128.0f), cb = fast_exp2(lg2b * 128.0f);
      const float* SC = (const float*)(F.ws + WS_SUMCTX) + (size_t)((b * 4 + hh) * 2) * 2 * 2048;
      const float* SL = (const float*)(F.ws + WS_SUMLAT) + (size_t)((b * 4 + hh) * 16) * 2 * 2048;
      f32x4 sf = (f32x4){0.f, 0.f, 0.f, 0.f}, sb = sf; const int eo = 4 * F.tid;
      if (!isctx) {
          sf = *(const f32x4*)(SC + (0 * 2 + 0) * 2048 + eo); sf = sf * cf + *(const f32x4*)(SC + (1 * 2 + 0) * 2048 + eo);
          for (int m = 0; m < n; ++m) sf = sf * cf + *(const f32x4*)(SL + (size_t)(m * 2 + 0) * 2048 + eo);
          sb = *(const f32x4*)(SC + (1 * 2 + 1) * 2048 + eo); sb = sb * cb + *(const f32x4*)(SC + (0 * 2 + 1) * 2048 + eo);
          for (int m = 15; m > n; --m) sb = sb * cb + *(const f32x4*)(SL + (size_t)(m * 2 + 1) * 2048 + eo);
      } else {
          if (n == 1) sf = *(const f32x4*)(SC + (0 * 2 + 0) * 2048 + eo);
          if (n == 0) sb = *(const f32x4*)(SC + (1 * 2 + 1) * 2048 + eo);
      }
      const int e = eo >> 5, d = eo & 31; u32x2 w;
      w.x = pk2(sf[0], sf[1]); w.y = pk2(sf[2], sf[3]); *(LAS u32x2*)(Stf + e * 80 + d * 2) = w;
      w.x = pk2(sb[0], sb[1]); w.y = pk2(sb[2], sb[3]); *(LAS u32x2*)(Stb + e * 80 + d * 2) = w; }
    const int dir = F.wave >> 2, qb = F.wave & 3, l32 = F.lane & 31, h = F.lane >> 5, grp = (F.lane >> 4) & 1, i16 = F.lane & 15, q = i16 >> 2, p = i16 & 3;
    const int iq = 32 * qb + l32;
    bf16x8 qf[2], qd[2];
    { float x1[8], x2[8]; ret_load_rope(F, PX + (size_t)(row0 + iq) * INW + C_RQ + 32 * hh, h, !isctx, n * 128 + iq, x1, x2);
      const float dec = dir == 0 ? fast_exp2(lg2f * (float)(iq + 1)) : fast_exp2(lg2b * (float)(128 - iq));
      u32x4 w;
      w.x = pk2(x1[0], x1[1]); w.y = pk2(x1[2], x1[3]); w.z = pk2(x1[4], x1[5]); w.w = pk2(x1[6], x1[7]); qf[0] = __builtin_bit_cast(bf16x8, w);
      w.x = pk2(x2[0], x2[1]); w.y = pk2(x2[2], x2[3]); w.z = pk2(x2[4], x2[5]); w.w = pk2(x2[6], x2[7]); qf[1] = __builtin_bit_cast(bf16x8, w);
      w.x = pk2(x1[0] * dec, x1[1] * dec); w.y = pk2(x1[2] * dec, x1[3] * dec); w.z = pk2(x1[4] * dec, x1[5] * dec); w.w = pk2(x1[6] * dec, x1[7] * dec); qd[0] = __builtin_bit_cast(bf16x8, w);
      w.x = pk2(x2[0] * dec, x2[1] * dec); w.y = pk2(x2[2] * dec, x2[3] * dec); w.z = pk2(x2[4] * dec, x2[5] * dec); w.w = pk2(x2[6] * dec, x2[7] * dec); qd[1] = __builtin_bit_cast(bf16x8, w); }
    __syncthreads();
    f32x16 o0, o1;
#pragma unroll
    for (int i = 0; i < 16; ++i) { o0[i] = 0.f; o1[i] = 0.f; }
    { LAS const unsigned char* St = dir ? Stb : Stf;
#pragma unroll
      for (int s = 0; s < 2; ++s) { const bf16x8 a0 = *(const LAS bf16x8*)(St + l32 * 80 + (16 * s + 8 * h) * 2), a1 = *(const LAS bf16x8*)(St + (32 + l32) * 80 + (16 * s + 8 * h) * 2);
          o0 = MFMA32(a0, qd[s], o0); o1 = MFMA32(a1, qd[s], o1); } }
    const float lgd = dir ? lg2b : lg2f;
    const int kt_lo = dir ? qb : 0, kt_hi = dir ? 3 : qb;
    for (int kt = kt_lo; kt <= kt_hi; ++kt) {
        f32x16 s;
#pragma unroll
        for (int i = 0; i < 16; ++i) s[i] = 0.f;
#pragma unroll
        for (int si = 0; si < 2; ++si) { const bf16x8 a = *(const LAS bf16x8*)(Kimg + (32 * kt + l32) * 80 + (16 * si + 8 * h) * 2); s = MFMA32(a, qf[si], s); }
        float pp[16];
#pragma unroll
        for (int i = 0; i < 16; ++i) { const int j = 32 * kt + crow(i, h); const int diff = dir ? (j - iq) : (iq - j); pp[i] = diff >= 0 ? s[i] * fast_exp2(lgd * (float)diff) : 0.f; }
        bf16x8 pf[2];
#pragma unroll
        for (int s2 = 0; s2 < 2; ++s2) { u32x4 w; w.x = pk2(pp[8 * s2], pp[8 * s2 + 1]); w.y = pk2(pp[8 * s2 + 2], pp[8 * s2 + 3]); w.z = pk2(pp[8 * s2 + 4], pp[8 * s2 + 5]); w.w = pk2(pp[8 * s2 + 6], pp[8 * s2 + 7]); pf[s2] = __builtin_bit_cast(bf16x8, w); }
#pragma unroll
        for (int s2 = 0; s2 < 2; ++s2) { const int r0 = 32 * kt + 16 * s2 + 4 * h + q;
#pragma unroll
            for (int et = 0; et < 2; ++et) { const int cb = (32 * et + 16 * grp + 4 * p) * 2;
                const s16x4 lo = trread(Vimg + r0 * 144 + cb), hi = trread(Vimg + (r0 + 8) * 144 + cb);
                const bf16x8 a = __builtin_shufflevector(lo, hi, 0, 1, 2, 3, 4, 5, 6, 7);
                if (et == 0) o0 = MFMA32(a, pf[s2], o0); else o1 = MFMA32(a, pf[s2], o1); } }
    }
    float sm = 0.f;
#pragma unroll
    for (int i = 0; i < 16; ++i) sm += o0[i] + o1[i];
    sm += __shfl_xor(sm, 32);
    const float mu = sm * (1.0f / 64.0f);
    float vs = 0.f;
#pragma unroll
    for (int i = 0; i < 16; ++i) { const float d0 = o0[i] - mu, d1 = o1[i] - mu; vs += d0 * d0 + d1 * d1; }
    vs += __shfl_xor(vs, 32);
    const float rstd = 1.0f / sqrtf(vs * (1.0f / 64.0f) + EPS);
    const bf16* gp = PX + (size_t)(row0 + iq) * INW + (dir ? C_GB : C_GF) + 64 * hh;
    const float* gn = F.in[I_RGNW] + l * 256 + 64 * hh;
    float val[32];
#pragma unroll
    for (int et = 0; et < 2; ++et)
#pragma unroll
        for (int gq = 0; gq < 4; ++gq) { const int e0 = 32 * et + 8 * gq + 4 * h; const u32x2 gg = *(const u32x2*)(gp + e0); const f32x4 gw = *(const f32x4*)(gn + e0);
            const float g0 = bflo(gg.x), g1 = bfhi(gg.x), g2 = bflo(gg.y), g3 = bfhi(gg.y);
            const float a0 = et ? o1[4 * gq] : o0[4 * gq], a1 = et ? o1[4 * gq + 1] : o0[4 * gq + 1], a2 = et ? o1[4 * gq + 2] : o0[4 * gq + 2], a3 = et ? o1[4 * gq + 3] : o0[4 * gq + 3];
            val[et * 16 + 4 * gq] = (a0 - mu) * rstd * gw[0] * g0 * sigmoidf_(g0); val[et * 16 + 4 * gq + 1] = (a1 - mu) * rstd * gw[1] * g1 * sigmoidf_(g1);
            val[et * 16 + 4 * gq + 2] = (a2 - mu) * rstd * gw[2] * g2 * sigmoidf_(g2); val[et * 16 + 4 * gq + 3] = (a3 - mu) * rstd * gw[3] * g3 * sigmoidf_(g3); }
    if (dir == 0) {
#pragma unroll
        for (int et = 0; et < 2; ++et)
#pragma unroll
            for (int gq = 0; gq < 4; ++gq)
#pragma unroll
                for (int j = 0; j < 4; ++j) Ob[iq * 65 + 32 * et + 8 * gq + 4 * h + j] = val[et * 16 + 4 * gq + j];
    }
    __syncthreads();
    if (dir == 1) { bf16* orow = YC + (size_t)(row0 + iq) * DM + 768 + 64 * hh;
#pragma unroll
        for (int et = 0; et < 2; ++et)
#pragma unroll
            for (int gq = 0; gq < 4; ++gq) { const int e0 = 32 * et + 8 * gq + 4 * h; float t[4];
#pragma unroll
                for (int j = 0; j < 4; ++j) t[j] = val[et * 16 + 4 * gq + j] + Ob[iq * 65 + e0 + j];
                u32x2 w; w.x = pk2(t[0], t[1]); w.y = pk2(t[2], t[3]); *(u32x2*)(orow + e0) = w; } }
    __syncthreads();
}
DI void cb_phase(Frame& F, int l) {
    const int nattn = l == 0 ? 1152 : 1024;
    for (int u = F.bid; u < nattn; u += F.G) {
        if (u < 1024) attn_unit(F, l, true, u >> 6, (u >> 3) & 7, u & 7);
        else { const int v = u - 1024; attn_unit(F, l, false, v >> 3, v & 7, 0); }
    }
    const int nret = l == 0 ? 1152 : 1024;
    for (int u = F.bid; u < nret; u += F.G) ret_out_unit(F, l, u);
}

static_assert(sizeof(Params) == 240, "kernarg layout: in[26] at 0, out at 208, ws at 216, ph_lo at 224, ph_hi at 228");
__global__ void __launch_bounds__(512, 2) fwd_kernel(Params prm) {
    extern __shared__ __attribute__((aligned(16))) unsigned char lds_raw[];
    Frame F;
    F.lds = (LAS unsigned char*)lds_raw;
    F.tid = threadIdx.x; F.lane = F.tid & 63; F.wave = __builtin_amdgcn_readfirstlane(F.tid >> 6);
    F.G = gridDim.x; F.bid = blockIdx.x;
    F.in.ka = (karg_t)__builtin_amdgcn_kernarg_segment_ptr(); F.out = prm.out; F.ws = prm.ws;
    volatile LAS unsigned* MISC = (volatile LAS unsigned*)(F.lds + AUX_OFF);
    if (F.tid < 64) MISC[F.tid] = 0u;
    __syncthreads();
    XcdBarrier bar; bar.bar = (unsigned*)(prm.ws + WS_CTL) + 1024; bar.x = 0; bar.st = nullptr;
    const int lo = prm.ph_lo, hi = prm.ph_hi;
    if (hi - lo > 1) bar = xcd_barrier_post((unsigned*)(prm.ws + WS_CTL) + 1024, MISC + 8);
#ifdef ONLY_PHASE
#define IN(k) ((k) == ONLY_PHASE && lo <= (k) && (k) < hi)
#else
#define IN(k) (lo <= (k) && (k) < hi)
#endif
#define SEAM(k) do { if (IN(k) && IN((k) + 1)) { XcdBarrier bb_ = bar; asm volatile("" : "+s"(bb_.bar)); xcd_barrier(bb_); } } while (0)
#define GLDS(P) ((LAS unsigned char*)(P).lds)
#define WSB(P, off) ((const pg8::bf16_t*)((P).ws + (off)))

    if (IN(0)) { Frame P = phase_frame(F); p0_prologue(P); } SEAM(0);
#pragma unroll 1
    for (int l = 0; l < 2; ++l) {
        const int pb = l == 0 ? 1 : 9;
        if (IN(pb + 0)) { Frame P = phase_frame(F); norm_phase(P, l, 1, l == 0, 0); } SEAM(pb + 0);
        if (IN(pb + 1)) {
            Frame P = phase_frame(F);
            pg8::StaticOrder S; S.init(NTOK, INW, P.G, P.bid);
            pg8::EpiStoreBf16 E{(pg8::bf16_t*)(P.ws + WS_P), INW};
            pg8::gemm_phase<pg8::EpiStoreBf16, pg8::StaticOrder, pg8::RowsLinear, true>(GLDS(P), P.tid, WSB(P, WS_U), WSB(P, WS_WIN) + (size_t)l * INW * DM, DM, S, E, pg8::RowsLinear{});
        } SEAM(pb + 1);
        if (IN(pb + 2)) { Frame P = phase_frame(F); ca_phase(P, l); } SEAM(pb + 2);
        if (IN(pb + 3)) { Frame P = phase_frame(F); cb_phase(P, l); } SEAM(pb + 3);
        if (IN(pb + 4)) {
            Frame P = phase_frame(F);
            const int rb = l == 0 ? 0 : NCTX;
            const float* modlat = (const float*)(P.ws + WS_MODLAT) + (size_t)l * 16 * 6144;
            const float* modctx = (const float*)(P.ws + WS_MODCTX) + (size_t)l * 6144;
            float* hctx = (float*)(P.ws + WS_HCTX);
            pg8::StaticOrder S; S.init(NTOK - rb, DM, P.G, P.bid);
            pg8::EpiResGate E{l == 0 ? P.in[I_CTX] : hctx, l == 0 ? P.in[I_X] : P.out, hctx, P.out, modlat + 2 * DM, modctx + 2 * DM, rb};
            pg8::gemm_phase<pg8::EpiResGate, pg8::StaticOrder, pg8::RowsLinear, true>(GLDS(P), P.tid, WSB(P, WS_U) + (size_t)rb * DM, WSB(P, WS_WOUT) + (size_t)l * DM * DM, DM, S, E, pg8::RowsLinear{});
        } SEAM(pb + 4);
        if (l == 0) {
            if (IN(6)) { Frame P = phase_frame(F); norm_phase(P, 0, 2, false, 0); } SEAM(6);
            if (IN(7)) {
                Frame P = phase_frame(F);
                pg8::StaticOrder S; S.init(NTOK, 2 * DFF, P.G, P.bid);
                pg8::EpiSwiglu<false> E{(pg8::bf16_t*)(P.ws + WS_P), DFF, 0, nullptr};
                pg8::gemm_phase<pg8::EpiSwiglu<false>, pg8::StaticOrder, pg8::RowsLinear, true>(GLDS(P), P.tid, WSB(P, WS_U), WSB(P, WS_WGU), DM, S, E, pg8::RowsLinear{});
            } SEAM(7);
            if (IN(8)) {
                Frame P = phase_frame(F);
                const float* modlat = (const float*)(P.ws + WS_MODLAT);
                const float* modctx = (const float*)(P.ws + WS_MODCTX);
                float* hctx = (float*)(P.ws + WS_HCTX);
                pg8::StaticOrder S; S.init(NTOK, DM, P.G, P.bid);
                pg8::EpiResGate E{hctx, P.out, hctx, P.out, modlat + 5 * DM, modctx + 5 * DM, 0};
                pg8::gemm_phase<pg8::EpiResGate, pg8::StaticOrder, pg8::RowsLinear, true>(GLDS(P), P.tid, WSB(P, WS_P), WSB(P, WS_WD), DFF, S, E, pg8::RowsLinear{});
            } SEAM(8);
        } else {
            if (IN(14)) { Frame P = phase_frame(F); norm_moe_phase(P); } SEAM(14);
            if (IN(15)) { Frame P = phase_frame(F); moe_route_phase(P); } SEAM(15);
#pragma unroll 1
            for (int s = 0; s < 2; ++s) {
                LAS int* texp = (LAS int*)(F.lds + AUX_TAB);
                if (IN(16 + 2 * s) || IN(17 + 2 * s)) {
                    Frame P = phase_frame(F);
                    const int* meta = (const int*)(P.ws + WS_META) + s * 256;
                    __syncthreads();
                    if (P.tid < 256) texp[P.tid] = ld_i32_coherent(meta + P.tid);
                    __syncthreads();
                }
                if (IN(16 + 2 * s)) {
                    Frame P = phase_frame(F);
                    const int* rowmap = (const int*)(P.ws + WS_ROWMAP) + (size_t)s * MOE_ROWS;
                    const int NT = __builtin_amdgcn_readfirstlane(texp[0]);
                    pg8::MoeOrder S{NT, 28, P.G, P.bid, (const LAS int*)(texp + 1)};
                    pg8::EpiSwiglu<true> E{(pg8::bf16_t*)(P.ws + WS_P), DFE, 28, (const float*)(P.ws + WS_PROW) + (size_t)s * MOE_ROWS};
                    pg8::gemm_phase<pg8::EpiSwiglu<true>, pg8::MoeOrder, pg8::RowsGather, true>(GLDS(P), P.tid, WSB(P, WS_U), WSB(P, WS_MGU), DM, S, E, pg8::RowsGather{rowmap, NCTX});
                } SEAM(16 + 2 * s);
                if (IN(17 + 2 * s)) {
                    Frame P = phase_frame(F);
                    const int* rowmap = (const int*)(P.ws + WS_ROWMAP) + (size_t)s * MOE_ROWS;
                    const float* modlat = (const float*)(P.ws + WS_MODLAT) + (size_t)16 * 6144;
                    const int NT = __builtin_amdgcn_readfirstlane(texp[0]);
                    pg8::MoeOrder S{NT, 4, P.G, P.bid, (const LAS int*)(texp + 1)};
                    pg8::EpiMoeScatter E{rowmap, P.out, modlat + 5 * DM, 4};
                    pg8::gemm_phase<pg8::EpiMoeScatter, pg8::MoeOrder, pg8::RowsLinear, true>(GLDS(P), P.tid, WSB(P, WS_P), WSB(P, WS_MD), DFE, S, E, pg8::RowsLinear{});
                } SEAM(17 + 2 * s);
            }
        }
    }
    if (IN(PH_FINAL)) { Frame P = phase_frame(F); final_phase(P); }
#undef IN
#undef SEAM
}

extern "C" void kernel_launch(void* const* d_in, const int* in_sizes, int n_in, void* d_out, int out_size, void* d_ws, size_t ws_size, hipStream_t stream) {
    static int grid = 0;
    if (grid == 0) {
        if (n_in != 26 || in_sizes[0] != NLAT * DM || out_size != NLAT * DM || ws_size < WS_END) {
            fprintf(stderr, "kernel_launch: unexpected shapes (n_in %d, in0 %d, out %d, ws %zu, need %zu); nothing launched\n", n_in, n_in > 0 ? in_sizes[0] : -1, out_size, ws_size, (size_t)WS_END); grid = -1; return; }
        int dev = 0, cus = 0, per_cu = 0;
        if (hipGetDevice(&dev) != hipSuccess || hipDeviceGetAttribute(&cus, hipDeviceAttributeMultiprocessorCount, dev) != hipSuccess) { grid = -1; return; }
        if (hipFuncSetAttribute((const void*)fwd_kernel, hipFuncAttributeMaxDynamicSharedMemorySize, LDS_BYTES) != hipSuccess) { fprintf(stderr, "kernel_launch: hipFuncSetAttribute failed\n"); grid = -1; return; }
        if (hipOccupancyMaxActiveBlocksPerMultiprocessor(&per_cu, (const void*)fwd_kernel, 512, LDS_BYTES) != hipSuccess || per_cu < 1)
            fprintf(stderr, "kernel_launch: note: occupancy query reports %d workgroups per CU\n", per_cu);
        (void)hipGetLastError();
        grid = cus;
    }
    if (grid < 0) return;
    if (hipMemsetAsync((char*)d_ws + WS_CTL, 0, CTL_ZERO_BYTES, stream) != hipSuccess) return;
    Params p{};
    for (int i = 0; i < 26; ++i) p.in[i] = (const float*)d_in[i];
    p.out = (float*)d_out; p.ws = (unsigned char*)d_ws;
#if MK_PER_PHASE
    for (int ph = 0; ph < N_PHASES; ++ph) { p.ph_lo = ph; p.ph_hi = ph + 1; hipLaunchKernelGGL(fwd_kernel, dim3(grid), dim3(512), LDS_BYTES, stream, p); }
#else
    p.ph_lo = 0; p.ph_hi = N_PHASES;
    hipLaunchKernelGGL(fwd_kernel, dim3(grid), dim3(512), LDS_BYTES, stream, p);
#endif
}
```

```cpp
#include <hip/hip_runtime.h>
#include <cstdio>
#include <cstdint>

#ifndef MK_PER_PHASE
#define MK_PER_PHASE 0
#endif

#define LAS __attribute__((address_space(3)))
#define GAS __attribute__((address_space(1)))
#define DI __device__ __forceinline__
typedef unsigned short bf16;
typedef short bf16x8 __attribute__((ext_vector_type(8)));
typedef short s16x4 __attribute__((ext_vector_type(4)));
typedef float f32x4 __attribute__((ext_vector_type(4)));
typedef float f32x16 __attribute__((ext_vector_type(16)));
typedef unsigned u32x4 __attribute__((ext_vector_type(4)));
typedef unsigned u32x2 __attribute__((ext_vector_type(2)));
typedef float f32x2_t __attribute__((ext_vector_type(2)));
typedef __bf16 bf16x2_t __attribute__((ext_vector_type(2)));
typedef short v4i16_t __attribute__((ext_vector_type(4)));

constexpr int DM = 1024, NB = 16, SEQ = 2048, CTXL = 256, GW = 64;
constexpr int NLAT = NB * SEQ, NCTX = NB * CTXL, NTOK = NLAT + NCTX;
constexpr int INW = 3072, DFF = 2816, NE = 8, DFE = 3584;
constexpr int C_NAQ = 0, C_NAK = 512, C_NAV = 1024, C_CONV = 1536, C_RQ = 2048, C_RK = 2176, C_RV = 2304, C_GF = 2560, C_GB = 2816;
constexpr float EPS = 1e-6f;
constexpr float LOG2E = 1.4426950408889634f;

constexpr size_t MiB = 1u << 20;
constexpr size_t WS_CTL = 0, CTL_ZERO_BYTES = 64 * 1024;
constexpr size_t WS_MODLAT = 1 * MiB;
constexpr size_t WS_MODCTX = WS_MODLAT + 2 * 16 * 6144 * 4;
constexpr size_t WS_ROPE = WS_MODCTX + 2 * 6144 * 4;
constexpr size_t WS_PTOK = 2 * MiB;
constexpr size_t WS_SEGCNT = WS_PTOK + 32768 * 2 * 4;
constexpr size_t WS_META = WS_SEGCNT + 256 * 2 * 8 * 4;
constexpr size_t WS_SEGLIST = 3 * MiB;
constexpr size_t WS_ROWMAP = 5 * MiB;
constexpr int MOE_ROWS = 34816;
constexpr size_t WS_PROW = WS_ROWMAP + 512 * 1024;
constexpr size_t WS_SUMLAT = 6 * MiB;
constexpr size_t WS_SUMCTX = 22 * MiB;
constexpr size_t WS_WIN = 24 * MiB;
constexpr size_t WS_WOUT = WS_WIN + (size_t)2 * 3072 * 1024 * 2;
constexpr size_t WS_WGU = WS_WOUT + (size_t)2 * 1024 * 1024 * 2;
constexpr size_t WS_WD = WS_WGU + (size_t)5632 * 1024 * 2;
constexpr size_t WS_MGU = WS_WD + (size_t)1024 * 2816 * 2;
constexpr size_t WS_MD = WS_MGU + (size_t)8 * 7168 * 1024 * 2;
constexpr size_t WS_HCTX = WS_MD + (size_t)8 * 1024 * 3584 * 2;
constexpr size_t WS_U = WS_HCTX + (size_t)NCTX * DM * 4;
constexpr size_t WS_P = WS_U + (size_t)NTOK * DM * 2;
constexpr size_t WS_END = WS_P + (size_t)MOE_ROWS * DFE * 2;
static_assert((size_t)NTOK * INW * 2 <= (size_t)MOE_ROWS * DFE * 2, "P region");
static_assert(WS_WIN % 256 == 0 && WS_WOUT % 256 == 0 && WS_WGU % 256 == 0 && WS_WD % 256 == 0 && WS_MGU % 256 == 0 && WS_MD % 256 == 0 && WS_HCTX % 256 == 0 && WS_U % 256 == 0 && WS_P % 256 == 0, "align");

constexpr int RING_BYTES = 131072;
constexpr int AUX_OFF = RING_BYTES;
constexpr int AUX_TAB = AUX_OFF + 1024;
constexpr int LDS_BYTES = 147456;

DI unsigned pk2(float lo, float hi) { f32x2_t v = {lo, hi}; bf16x2_t b = __builtin_convertvector(v, bf16x2_t); return __builtin_bit_cast(unsigned, b); }
DI float bflo(unsigned u) { return __uint_as_float(u << 16); }
DI float bfhi(unsigned u) { return __uint_as_float(u & 0xffff0000u); }
DI float wave_sum(float v) {
#pragma unroll
    for (int o = 1; o < 64; o <<= 1) v += __shfl_xor(v, o);
    return v;
}
DI float fast_exp2(float x) { return __builtin_amdgcn_exp2f(x); }
DI float fast_rcp(float x) { return __builtin_amdgcn_rcpf(x); }
DI float sigmoidf_(float x) { return fast_rcp(1.0f + fast_exp2(-x * LOG2E)); }
DI int crow(int reg, int h) { return (reg & 3) + 8 * (reg >> 2) + 4 * h; }
#define MFMA32(a, b, c) __builtin_amdgcn_mfma_f32_32x32x16_bf16((a), (b), (c), 0, 0, 0)
DI s16x4 trread(LAS const unsigned char* p) { return __builtin_bit_cast(s16x4, __builtin_amdgcn_ds_read_tr16_b64_v4i16((LAS v4i16_t*)p)); }
DI int ld_i32_coherent(const int* p) { return (int)__hip_atomic_load((const unsigned*)p, __ATOMIC_RELAXED, __HIP_MEMORY_SCOPE_AGENT); }

namespace pg8 {
#define PG8_LAS __attribute__((address_space(3)))
typedef unsigned short bf16_t;
constexpr int BM = 256, BK = 64, HALF = 128, HTB = HALF * BK * 2, STAGE_BYTES = 8 * HTB, NXCD = 8, WGM = 8;
__host__ __device__ __forceinline__ int lds_byte(int r, int c) { const int st = (r >> 4) * 2 + (c >> 5), rr = r & 15, cc = c & 31, ob = rr * 64 + cc * 2; return st * 1024 + (ob ^ (((ob >> 9) & 1) << 5)); }
__host__ __device__ __forceinline__ void stage_rc(int b, int& R, int& C) { const int st = b / 1024, sb = b % 1024, swz = sb ^ (((sb >> 9) & 1) << 5); R = (st >> 1) * 16 + swz / 64; C = (st & 1) * 32 + (swz % 64) / 2; }
__host__ __device__ __forceinline__ int perm32(int rho) { const int n = rho >> 4, i = rho & 15; return 8 * (i >> 2) + 4 * n + (i & 3); }
struct Unit { int pm, pn; };
struct StaticOrder {
    int nM, nN, nwg, G, c;
    __device__ void init(int M, int N, int G_, int c_) { nM = M / BM; nN = N / BM; nwg = nM * nN; G = G_; c = c_; }
    __device__ bool next(int i, Unit& u) const {
        const long L = (long)i * G + c; if (L >= nwg) return false;
        int wgid = (int)L; { const int q = nwg / NXCD, r = nwg % NXCD, xcd = wgid % NXCD, off = wgid / NXCD; wgid = (xcd < r ? xcd * (q + 1) : r * (q + 1) + (xcd - r) * q) + off; }
        const int nig = WGM * nN, gid = wgid / nig, fm = gid * WGM, gsz = (nM - fm) < WGM ? (nM - fm) : WGM;
        u.pm = fm + ((wgid % nig) % gsz); u.pn = (wgid % nig) / gsz; return true;
    }
};
struct RowsLinear { static constexpr bool GATHER = false; };
struct RowsGather {
    static constexpr bool GATHER = true;
    const int* rowmap; int row_add;
    __device__ __forceinline__ void offs(const Unit& u, const int (&R)[2], const int (&C)[2], int K, unsigned (&o)[2][2]) const {
#pragma unroll
        for (int h = 0; h < 2; ++h)
#pragma unroll
            for (int i = 0; i < 2; ++i) { int t = rowmap[u.pm * BM + h * HALF + R[i]]; t = t < 0 ? 0 : t;
                o[h][i] = (unsigned)(((size_t)(t + row_add) * (size_t)K + (size_t)C[i]) * 2u); }
#pragma unroll
        for (int h = 0; h < 2; ++h)
#pragma unroll
            for (int i = 0; i < 2; ++i) asm volatile("" : "+v"(o[h][i]));
    }
};

template <class Epi, class Sched, class ARows, bool ALIGN_EPI>
__device__ __forceinline__ void gemm_phase(PG8_LAS unsigned char* lds, int tid, const bf16_t* A, const bf16_t* Bt, int K, const Sched& S, const Epi& E, const ARows& AR) {
    constexpr bool GATHER = ARows::GATHER;
    const int wid = __builtin_amdgcn_readfirstlane(tid >> 6), lane = tid & 63, wr = wid >> 2, wc = wid & 3, fr = lane & 15, fq = lane >> 4;
    const int nt = K / BK;
    int RA[2], CA[2]; unsigned voffA[2], voffB[2];
#pragma unroll
    for (int i = 0; i < 2; ++i) { int R, C; stage_rc(tid * 16 + i * 8192, R, C); const int Rb = Epi::PERM ? ((R & ~31) + perm32(R & 31)) : R;
        RA[i] = R; CA[i] = C; voffA[i] = (unsigned)(R * K + C) * 2u; voffB[i] = (unsigned)(Rb * K + C) * 2u; }
    const size_t kstep = (size_t)(BK * 2);
    const size_t hstep = (size_t)HALF * K * 2;
    const size_t tstep = 2 * hstep;
    const unsigned ldsw = (unsigned)wid * 1024u;
    const int aoff = lds_byte(wr * 64 + fr, fq * 8), boff = lds_byte(wc * 32 + fr, fq * 8);
    const char* Ab = (const char*)A;
#define PG8_SA(b, h) (((b) * 2 + (h)) * HTB)
#define PG8_SB(b, h) ((4 + (b) * 2 + (h)) * HTB)
#define PG8_STAGE(bufoff, gbase, voff) do { _Pragma("unroll") for (int _i = 0; _i < 2; ++_i) \
        __builtin_amdgcn_global_load_lds((const unsigned*)((const char*)(gbase) + (voff)[_i]), (PG8_LAS unsigned*)(lds + (bufoff) + ldsw + _i * 8192), 16, 0, 0); } while (0)
#define PG8_STAGEA(bufoff, h, plin, kb) do { if constexpr (GATHER) PG8_STAGE(bufoff, Ab + (kb), curA[h]); else PG8_STAGE(bufoff, (plin) + (h) * hstep, voffA); } while (0)
#define PG8_LDA(dst, b, h) do { _Pragma("unroll") for (int m = 0; m < 4; ++m) _Pragma("unroll") for (int k = 0; k < 2; ++k) dst[m][k] = *(const PG8_LAS bf16x8*)(lds + PG8_SA(b, h) + aoff + m * 2048 + k * 1024); } while (0)
#define PG8_LDB(dst, b, h) do { _Pragma("unroll") for (int n = 0; n < 2; ++n) _Pragma("unroll") for (int k = 0; k < 2; ++k) dst[n][k] = *(const PG8_LAS bf16x8*)(lds + PG8_SB(b, h) + boff + n * 2048 + k * 1024); } while (0)
#define PG8_MMA(ai, bj, At, Bt_) do { __builtin_amdgcn_s_setprio(1); _Pragma("unroll") for (int m = 0; m < 4; ++m) _Pragma("unroll") for (int n = 0; n < 2; ++n) _Pragma("unroll") for (int k = 0; k < 2; ++k) \
        acc[ai][bj][m][n] = __builtin_amdgcn_mfma_f32_16x16x32_bf16(Bt_[n][k], At[m][k], acc[ai][bj][m][n], 0, 0, 0); __builtin_amdgcn_s_setprio(0); } while (0)
#define PG8_WAIT_V(n) asm volatile("s_waitcnt vmcnt(" #n ")" ::: "memory")
#define PG8_WAIT_L(n) asm volatile("s_waitcnt lgkmcnt(" #n ")" ::: "memory")
#define PG8_BAR __builtin_amdgcn_s_barrier()
#define PG8_SCHED __builtin_amdgcn_sched_barrier(0)
    Unit cur, nxt; int ui = 0;
    if (!S.next(0, cur)) return;
    f32x4 acc[2][2][4][2];
#pragma unroll
    for (int a = 0; a < 2; ++a)
#pragma unroll
        for (int b = 0; b < 2; ++b)
#pragma unroll
            for (int m = 0; m < 4; ++m)
#pragma unroll
                for (int n = 0; n < 2; ++n) acc[a][b][m][n] = (f32x4){0.f, 0.f, 0.f, 0.f};
    bf16x8 At[4][2], B0[2][2], B1[2][2];
    unsigned curA[2][2] = {{0u, 0u}, {0u, 0u}}, nxtA[2][2] = {{0u, 0u}, {0u, 0u}};
    if constexpr (GATHER) AR.offs(cur, RA, CA, K, curA);
    const char* cA = GATHER ? Ab : Ab + (size_t)cur.pm * tstep;
    const char* cB = (const char*)Bt + (size_t)cur.pn * tstep;
    PG8_STAGE(PG8_SB(0, 0), cB, voffB); PG8_STAGE(PG8_SB(0, 1), cB + hstep, voffB); PG8_STAGEA(PG8_SA(0, 0), 0, cA, 0); PG8_STAGEA(PG8_SA(0, 1), 1, cA, 0);
    if (wr == 1) PG8_BAR;
    PG8_WAIT_V(2); PG8_BAR;
    PG8_STAGE(PG8_SB(1, 0), cB + kstep, voffB); PG8_STAGEA(PG8_SA(1, 0), 0, cA + kstep, kstep); PG8_STAGE(PG8_SB(1, 1), cB + hstep + kstep, voffB);
    PG8_WAIT_V(6); PG8_BAR;
    for (;;) {
        const bool has_next = S.next(ui + 1, nxt);
        if constexpr (GATHER) {
            if (has_next) AR.offs(nxt, RA, CA, K, nxtA);
            else {
#pragma unroll
                for (int h = 0; h < 2; ++h)
#pragma unroll
                    for (int i = 0; i < 2; ++i) nxtA[h][i] = curA[h][i];
            }
        }
        const char* nA = GATHER ? Ab : (has_next ? Ab + (size_t)nxt.pm * tstep : cA);
        const char* nB = has_next ? (const char*)Bt + (size_t)nxt.pn * tstep : cB;
        for (int t = 0; t < nt; t += 2) {
            const bool last = (t == nt - 2);
            const size_t k1 = (size_t)(t + 1) * kstep, k2 = last ? 0 : (size_t)(t + 2) * kstep, k3 = k2 + kstep;
            const char* a1 = cA + k1;
            const char* a2 = last ? nA : cA + k2; const char* b2 = last ? nB : cB + k2;
            const char* a3 = a2 + kstep; const char* b3 = b2 + kstep;
            PG8_LDB(B0, 0, 0); PG8_LDB(B1, 0, 1); PG8_SCHED; PG8_LDA(At, 0, 0); PG8_STAGEA(PG8_SA(1, 1), 1, a1, k1);
            if constexpr (GATHER) { if (last) {
#pragma unroll
                for (int h = 0; h < 2; ++h)
#pragma unroll
                    for (int i = 0; i < 2; ++i) curA[h][i] = nxtA[h][i]; } }
            PG8_WAIT_V(8); PG8_WAIT_L(0); PG8_BAR; PG8_MMA(0, 0, At, B0); PG8_MMA(0, 1, At, B1); PG8_BAR; PG8_SCHED;
            PG8_LDA(At, 0, 1); PG8_STAGE(PG8_SB(0, 0), b2, voffB); PG8_STAGE(PG8_SB(0, 1), b2 + hstep, voffB); PG8_STAGEA(PG8_SA(0, 0), 0, a2, k2);
            PG8_WAIT_V(8); PG8_WAIT_L(0); PG8_BAR; PG8_MMA(1, 0, At, B0); PG8_MMA(1, 1, At, B1); PG8_BAR; PG8_SCHED;
            PG8_LDB(B0, 1, 0); PG8_LDB(B1, 1, 1); PG8_SCHED; PG8_LDA(At, 1, 0); PG8_STAGEA(PG8_SA(0, 1), 1, a2, k2);
            PG8_WAIT_V(8); PG8_WAIT_L(0); PG8_BAR; PG8_MMA(0, 0, At, B0); PG8_MMA(0, 1, At, B1); PG8_BAR; PG8_SCHED;
            PG8_LDA(At, 1, 1); PG8_STAGE(PG8_SB(1, 0), b3, voffB); PG8_STAGE(PG8_SB(1, 1), b3 + hstep, voffB); PG8_STAGEA(PG8_SA(1, 0), 0, a3, k3);
            PG8_WAIT_V(8); PG8_WAIT_L(0); PG8_BAR; PG8_MMA(1, 0, At, B0); PG8_MMA(1, 1, At, B1); PG8_BAR; PG8_SCHED;
        }
        if constexpr (ALIGN_EPI) { if (wr == 0) PG8_BAR; }
        E(acc, cur, wr, wc, fr, fq);
        if (!has_next) break;
#pragma unroll
        for (int a = 0; a < 2; ++a)
#pragma unroll
            for (int b = 0; b < 2; ++b)
#pragma unroll
                for (int m = 0; m < 4; ++m)
#pragma unroll
                    for (int n = 0; n < 2; ++n) acc[a][b][m][n] = (f32x4){0.f, 0.f, 0.f, 0.f};
        cur = nxt; cA = nA; cB = nB; ++ui;
        if constexpr (ALIGN_EPI) { if (wr == 1) PG8_BAR; }
    }
    PG8_WAIT_V(0);
    if constexpr (!ALIGN_EPI) { if (wr == 0) PG8_BAR; }
    PG8_BAR;
#undef PG8_SA
#undef PG8_SB
#undef PG8_STAGE
#undef PG8_STAGEA
#undef PG8_LDA
#undef PG8_LDB
#undef PG8_MMA
#undef PG8_WAIT_V
#undef PG8_WAIT_L
#undef PG8_BAR
#undef PG8_SCHED
}

#define PG8_OPAQUE(x) asm volatile("" : "+v"(x))
struct EpiStoreBf16 {
    static constexpr bool PERM = true;
    bf16_t* O; int ldc;
    __device__ __forceinline__ void operator()(const f32x4 (&acc)[2][2][4][2], const Unit& u, int wr, int wc, int fr, int fq) const {
        char* base = (char*)(O + (size_t)(u.pm * BM) * ldc + u.pn * BM);
        unsigned lb = (unsigned)((wr * 64 + fr) * ldc + wc * 32 + 8 * fq) * 2u; PG8_OPAQUE(lb);
        const unsigned rstep = (unsigned)ldc * 32u;
#pragma unroll
        for (int ai = 0; ai < 2; ++ai)
#pragma unroll
            for (int m = 0; m < 4; ++m) { const unsigned ro = lb + (unsigned)(ai * 8 + m) * rstep;
#pragma unroll
                for (int bj = 0; bj < 2; ++bj) { const f32x4 v0 = acc[ai][bj][m][0], v1 = acc[ai][bj][m][1];
                    u32x4 w; w.x = pk2(v0[0], v0[1]); w.y = pk2(v0[2], v0[3]); w.z = pk2(v1[0], v1[1]); w.w = pk2(v1[2], v1[3]);
                    *(u32x4*)(base + ro + bj * (HALF * 2)) = w; } }
    }
};
struct EpiResGate {
    static constexpr bool PERM = false;
    const float* src_ctx; const float* src_lat; float* dst_ctx; float* dst_lat; const float* gate_lat; const float* gate_ctx; int row_base;
    __device__ __forceinline__ void operator()(const f32x4 (&acc)[2][2][4][2], const Unit& u, int wr, int wc, int fr, int fq) const {
        const int rowu = row_base + u.pm * BM; const bool isctx = rowu < NCTX;
        const char* src = (const char*)(isctx ? src_ctx + (size_t)rowu * DM : src_lat + (size_t)(rowu - NCTX) * DM) + u.pn * (BM * 4);
        char* dst = (char*)(isctx ? dst_ctx + (size_t)rowu * DM : dst_lat + (size_t)(rowu - NCTX) * DM) + u.pn * (BM * 4);
        const float* gate = (isctx ? gate_ctx : gate_lat + (size_t)((rowu - NCTX) / SEQ) * 6144) + u.pn * BM;
        const int cl = wc * 32 + 4 * fq;
        f32x4 sc[2][2][4][2];
#pragma unroll
        for (int bj = 0; bj < 2; ++bj)
#pragma unroll
            for (int n = 0; n < 2; ++n) { const f32x4 gv = *(const f32x4*)(gate + cl + bj * HALF + n * 16);
#pragma unroll
                for (int ai = 0; ai < 2; ++ai)
#pragma unroll
                    for (int m = 0; m < 4; ++m) sc[ai][bj][m][n] = acc[ai][bj][m][n] * gv; }
        unsigned lb = (unsigned)((wr * 64 + fr) * DM + cl) * 4u; PG8_OPAQUE(lb);
#pragma unroll
        for (int ai = 0; ai < 2; ++ai)
#pragma unroll
            for (int m = 0; m < 4; ++m) { const unsigned ro = lb + (unsigned)(ai * 8 + m) * (16u * DM * 4u);
#pragma unroll
                for (int bj = 0; bj < 2; ++bj)
#pragma unroll
                    for (int n = 0; n < 2; ++n) { const unsigned o = ro + (unsigned)(bj * HALF + n * 16) * 4u; const f32x4 s = *(const f32x4*)(src + o);
                        *(f32x4*)(dst + o) = s + sc[ai][bj][m][n]; }
                asm volatile("" ::: "memory"); }
    }
};
template <bool MOE> struct EpiSwiglu {
    static constexpr bool PERM = true;
    bf16_t* O; int ldc; int ncol; const float* prow;
    __device__ __forceinline__ void operator()(const f32x4 (&acc)[2][2][4][2], const Unit& u, int wr, int wc, int fr, int fq) const {
        const int pnl = MOE ? (u.pn % ncol) : u.pn;
        char* base = (char*)(O + (size_t)(u.pm * BM) * ldc + pnl * HALF);
        unsigned lb = (unsigned)((wr * 64 + fr) * ldc + wc * 32 + 8 * fq) * 2u; PG8_OPAQUE(lb);
        const unsigned rstep = (unsigned)ldc * 32u;
        const float* pr = MOE ? prow + u.pm * BM : nullptr;
        unsigned pl = (unsigned)(wr * 64 + fr) * 4u; PG8_OPAQUE(pl);
#pragma unroll
        for (int ai = 0; ai < 2; ++ai)
#pragma unroll
            for (int m = 0; m < 4; ++m) {
                float pw = 1.0f; if (MOE) pw = *(const float*)((const char*)pr + pl + (unsigned)(ai * 8 + m) * 64u);
                float hv[8];
#pragma unroll
                for (int n = 0; n < 2; ++n)
#pragma unroll
                    for (int j = 0; j < 4; ++j) { const float g = acc[ai][0][m][n][j], up = acc[ai][1][m][n][j]; hv[n * 4 + j] = g * sigmoidf_(g) * up * pw; }
                u32x4 w; w.x = pk2(hv[0], hv[1]); w.y = pk2(hv[2], hv[3]); w.z = pk2(hv[4], hv[5]); w.w = pk2(hv[6], hv[7]);
                *(u32x4*)(base + lb + (unsigned)(ai * 8 + m) * rstep) = w; }
    }
};
struct EpiMoeScatter {
    static constexpr bool PERM = false;
    const int* rowmap; float* hlat; const float* gate_lat; int ncol;
    __device__ __forceinline__ void operator()(const f32x4 (&acc)[2][2][4][2], const Unit& u, int wr, int wc, int fr, int fq) const {
        const int pnl = u.pn % ncol; const int col0 = pnl * BM + wc * 32 + 4 * fq;
        const int* rm = rowmap + u.pm * BM;
        unsigned pl = (unsigned)(wr * 64 + fr) * 4u; PG8_OPAQUE(pl);
#pragma unroll
        for (int ai = 0; ai < 2; ++ai)
#pragma unroll
            for (int m = 0; m < 4; ++m) { const int tok = *(const int*)((const char*)rm + pl + (unsigned)(ai * 8 + m) * 64u);
                if (tok >= 0) { float* dst = hlat + (size_t)tok * DM + col0; const float* gate = gate_lat + (size_t)(tok / SEQ) * 6144 + col0;
#pragma unroll
                    for (int bj = 0; bj < 2; ++bj)
#pragma unroll
                        for (int n = 0; n < 2; ++n) { const f32x4 s = *(const f32x4*)(dst + bj * HALF + n * 16); const f32x4 gv = *(const f32x4*)(gate + bj * HALF + n * 16);
                            *(f32x4*)(dst + bj * HALF + n * 16) = s + gv * acc[ai][bj][m][n]; } }
                asm volatile("" ::: "memory"); }
    }
};
struct MoeOrder {
    int NT, ncol, G, c; const PG8_LAS int* texp;
    __device__ bool next(int i, Unit& u) const {
        const long L = (long)i * G + c; if (L >= (long)NT * ncol) return false;
        const int t = (int)(L / ncol), pnl = (int)(L % ncol);
        const int e = __builtin_amdgcn_readfirstlane(texp[t]);
        u.pm = t; u.pn = e * ncol + pnl; return true;
    }
};
}

#define XB_TMO      128
#define XB_XCNT(j)  (256  + 64 * (j))
#define XB_XSUB(j)  (1280 + 64 * (j))
#define XB_XGEN(j)  (2304 + 64 * (j))
#define XB_TOP      3328
#define XB_TOPGEN   3392
#define XCD_BAR_WORDS 3456
#define XB_SPIN_CAP (1u << 18)
DI unsigned xb_ld(unsigned* p)              { return __hip_atomic_load(p, __ATOMIC_RELAXED, __HIP_MEMORY_SCOPE_AGENT); }
DI unsigned xb_add(unsigned* p, unsigned v) { return __hip_atomic_fetch_add(p, v, __ATOMIC_RELAXED, __HIP_MEMORY_SCOPE_AGENT); }
DI unsigned xb_xcc_id() { return (unsigned)__builtin_amdgcn_s_getreg((3 << 11) | 20) & 0xFu; }
#define XB_SPIN(cond, bar) do { unsigned _sp = 0; while (cond) { __builtin_amdgcn_s_sleep(1); \
    if ((++_sp & 255u) == 0u) { if (xb_ld(&(bar)[XB_TMO])) break; if (_sp > XB_SPIN_CAP) { atomicAdd(&(bar)[XB_TMO], 1u); break; } } } } while (0)
struct XcdBarrier { unsigned* bar; unsigned x; volatile LAS unsigned* st; };
DI XcdBarrier xcd_barrier_post(unsigned* bar, volatile LAS unsigned* st) {
    XcdBarrier b; b.bar = bar; b.x = xb_xcc_id(); b.st = st;
    if (threadIdx.x == 0) (void)xb_add(&bar[XB_XCNT(b.x)], 1u);
    return b;
}
DI void xcd_barrier_complete(unsigned* bar, unsigned x, unsigned& nloc, unsigned& nx) {
    const unsigned G = gridDim.x * gridDim.y * gridDim.z;
    unsigned sum, cnt, mine, sp = 0u;
    for (;;) {
        sum = 0u; cnt = 0u; mine = 0u;
#pragma unroll
        for (unsigned j = 0; j < 16; ++j) { const unsigned c = xb_ld(&bar[XB_XCNT(j)]); sum += c; cnt += (c > 0u) ? 1u : 0u; mine = (j == x) ? c : mine; }
        if (sum == G) break;
        __builtin_amdgcn_s_sleep(1);
        if ((++sp & 255u) == 0u) { if (xb_ld(&bar[XB_TMO])) break; if (sp > XB_SPIN_CAP) { atomicAdd(&bar[XB_TMO], 1u); break; } }
    }
    nloc = mine > 0u ? mine : 1u; nx = cnt > 0u ? cnt : 1u;
}
DI void xcd_barrier(const XcdBarrier& b) {
    asm volatile("s_waitcnt vmcnt(0)" ::: "memory");
    __syncthreads();
    if (threadIdx.x == 0) {
        unsigned* bar = b.bar;
        __builtin_amdgcn_s_waitcnt(0);
        unsigned nloc = b.st[0], nx = b.st[1];
        if (nloc == 0u) { xcd_barrier_complete(bar, b.x, nloc, nx); b.st[0] = nloc; b.st[1] = nx; }
        const unsigned old = xb_add(&bar[XB_XSUB(b.x)], 1u);
        const unsigned gen = old / nloc;
        if (old + 1u == (gen + 1u) * nloc) {
            __builtin_amdgcn_fence(__ATOMIC_RELEASE, "agent");
            asm volatile("s_waitcnt vmcnt(0)" ::: "memory");
            const unsigned og = xb_add(&bar[XB_TOP], 1u);
            const unsigned tg = og / nx;
            if (og + 1u == (tg + 1u) * nx) xb_add(&bar[XB_TOPGEN], 1u);
            else XB_SPIN(xb_ld(&bar[XB_TOPGEN]) == tg, bar);
            __builtin_amdgcn_fence(__ATOMIC_ACQUIRE, "agent");
            xb_add(&bar[XB_XGEN(b.x)], 1u);
            asm volatile("s_waitcnt vmcnt(0)" ::: "memory");
        } else {
            XB_SPIN(xb_ld(&bar[XB_XGEN(b.x)]) == gen, bar);
            __builtin_amdgcn_fence(__ATOMIC_ACQUIRE, "agent");
            asm volatile("s_waitcnt vmcnt(0)" ::: "memory");
        }
    }
    __syncthreads();
}

struct Params { const float* in[26]; float* out; unsigned char* ws; int ph_lo, ph_hi, pad0, pad1; };
enum { I_X = 0, I_C, I_CTX, I_CCTX, I_WMOD, I_BMOD, I_N1W, I_N2W, I_WIN, I_WOUT, I_RPB, I_CONVW, I_CONVB, I_CLNW, I_CLNB, I_RDEC, I_RGNW,
       I_FG, I_FU, I_FD, I_MR, I_MRB, I_MG, I_MU, I_MDN, I_FNW };
constexpr int PH_P0 = 0, PH_FINAL = 20, N_PHASES = 21;

typedef __attribute__((address_space(4))) const unsigned char* karg_t;
struct KIn {
    karg_t ka;
    DI const float* operator[](int k) const { return *(const float* __attribute__((address_space(4))) const*)(ka + 8 * k); }
};
struct Frame {
    LAS unsigned char* lds;
    int tid, lane, wave, G, bid, vb;
    KIn in; float* out; unsigned char* ws;
};
DI Frame phase_frame(const Frame& F0) {
    Frame F; karg_t ka = F0.in.ka; asm volatile("" : "+s"(ka)); F.in.ka = ka;
    F.out = *(float* __attribute__((address_space(4))) const*)(ka + 208);
    F.ws = *(unsigned char* __attribute__((address_space(4))) const*)(ka + 216);
    int tid = F0.tid, G = F0.G, bid = F0.bid; unsigned ldsb = (unsigned)(size_t)F0.lds;
    asm volatile("" : "+v"(tid)); asm volatile("" : "+s"(G)); asm volatile("" : "+s"(bid)); asm volatile("" : "+s"(ldsb));
    F.tid = tid; F.lane = tid & 63; F.wave = __builtin_amdgcn_readfirstlane(tid >> 6); F.G = G; F.bid = bid; F.lds = (LAS unsigned char*)(size_t)ldsb;
    F.vb = (G % 8 == 0) ? (bid % 8) * (G / 8) + bid / 8 : bid;
    return F;
}

DI void p0_transpose_item(const float* W, int K, int N, bf16* WT, int k0, int n0, int dst_row0, LAS float* scr, int lane) {
#pragma unroll 8
    for (int i = 0; i < 32; ++i) { const int kk = 2 * i + (lane >> 5); scr[kk * 33 + (lane & 31)] = W[(size_t)(k0 + kk) * N + n0 + (lane & 31)]; }
    asm volatile("s_waitcnt lgkmcnt(0)" ::: "memory");
    const int c = lane & 7;
#pragma unroll
    for (int j = 0; j < 4; ++j) { const int n = (lane >> 3) + 8 * j; const LAS float* s = scr + (8 * c) * 33 + n;
        u32x4 o; o.x = pk2(s[0 * 33], s[1 * 33]); o.y = pk2(s[2 * 33], s[3 * 33]); o.z = pk2(s[4 * 33], s[5 * 33]); o.w = pk2(s[6 * 33], s[7 * 33]);
        *(u32x4*)(WT + (size_t)(dst_row0 + n) * K + k0 + 8 * c) = o; }
    asm volatile("s_waitcnt lgkmcnt(0)" ::: "memory");
}
DI void p0_convert_plain(Frame& F, const float* W, int K, int N, bf16* WT, int item, LAS float* scr) {
    const int nblk = N / 32, kb = item / nblk, nb = item % nblk;
    p0_transpose_item(W, K, N, WT, 64 * kb, 32 * nb, 32 * nb, scr, F.lane);
}
DI void p0_convert_gu(Frame& F, const float* W, int K, int N, bf16* WT, int item, int up, LAS float* scr) {
    const int nblk = N / 32, kb = item / nblk, nb = item % nblk, n0 = 32 * nb;
    p0_transpose_item(W, K, N, WT, 64 * kb, n0, 256 * (n0 / 128) + (n0 % 128) + (up ? 128 : 0), scr, F.lane);
}
DI void p0_prologue(Frame& F) {
    {
        LAS float* Sx = (LAS float*)F.lds;
        LAS float* red = (LAS float*)(F.lds + 81920);
        bool staged = false;
        for (int unit = F.bid; unit < 192; unit += F.G) {
            if (!staged) {
                for (int idx = F.tid; idx < 17 * 1024; idx += 512) { const int r = idx / 1024, k = idx % 1024;
                    const float v = r < 16 ? F.in[I_C][r * 1024 + k] : F.in[I_CCTX][k]; Sx[k * 20 + r] = v * sigmoidf_(v); }
                staged = true; __syncthreads();
            }
            const int l = unit / 96, n0 = (unit % 96) * 64;
            const float* Wm = F.in[I_WMOD] + (size_t)l * 1024 * 6144 + n0 + F.lane;
            float acc[17];
#pragma unroll
            for (int r = 0; r < 17; ++r) acc[r] = 0.f;
            const int kb = F.wave * 128;
#pragma unroll 4
            for (int k = 0; k < 128; ++k) { const float wv = Wm[(size_t)(kb + k) * 6144]; const LAS float* sp = Sx + (kb + k) * 20;
                const f32x4 s0 = *(const LAS f32x4*)(sp), s1 = *(const LAS f32x4*)(sp + 4), s2 = *(const LAS f32x4*)(sp + 8), s3 = *(const LAS f32x4*)(sp + 12); const float s4 = sp[16];
                acc[0] += s0[0] * wv; acc[1] += s0[1] * wv; acc[2] += s0[2] * wv; acc[3] += s0[3] * wv; acc[4] += s1[0] * wv; acc[5] += s1[1] * wv; acc[6] += s1[2] * wv; acc[7] += s1[3] * wv;
                acc[8] += s2[0] * wv; acc[9] += s2[1] * wv; acc[10] += s2[2] * wv; acc[11] += s2[3] * wv; acc[12] += s3[0] * wv; acc[13] += s3[1] * wv; acc[14] += s3[2] * wv; acc[15] += s3[3] * wv;
                acc[16] += s4 * wv; }
#pragma unroll
            for (int r = 0; r < 17; ++r) red[(F.wave * 17 + r) * 64 + F.lane] = acc[r];
            __syncthreads();
            for (int idx = F.tid; idx < 17 * 64; idx += 512) { const int r = idx / 64, ln = idx % 64; float s = F.in[I_BMOD][l * 6144 + n0 + ln];
#pragma unroll
                for (int w = 0; w < 8; ++w) s += red[(w * 17 + r) * 64 + ln];
                if (r < 16) ((float*)(F.ws + WS_MODLAT))[((size_t)l * 16 + r) * 6144 + n0 + ln] = s; else ((float*)(F.ws + WS_MODCTX))[(size_t)l * 6144 + n0 + ln] = s; }
            __syncthreads();
        }
        __syncthreads();
    }
    if (F.bid == 0) { const int pos = F.tid >> 3, j = F.tid & 7; const float inv = exp2f(-(float)j * 0.125f * 13.287712379549449f); const float ang = (float)pos * inv;
        float* tab = (float*)(F.ws + WS_ROPE); tab[(pos * 8 + j) * 2] = cosf(ang); tab[(pos * 8 + j) * 2 + 1] = sinf(ang); }
    {
        LAS float* scr = (LAS float*)(F.lds + F.wave * 16384);
        const int gw = F.bid * 8 + F.wave, NGW = F.G * 8;
        constexpr int I_IN = 16 * 96, I_OUT = 16 * 32, I_G = 16 * 88, I_D = 44 * 32, I_MGI = 16 * 112, I_MDI = 56 * 32;
        constexpr int NITEMS = 2 * I_IN + 2 * I_OUT + 2 * I_G + I_D + 16 * I_MGI + 8 * I_MDI;
        for (int it = gw; it < NITEMS; it += NGW) {
            int r = it;
            if (r < 2 * I_IN) { const int l = r / I_IN; p0_convert_plain(F, F.in[I_WIN] + (size_t)l * 1024 * 3072, 1024, 3072, (bf16*)(F.ws + WS_WIN) + (size_t)l * 3072 * 1024, r % I_IN, scr); continue; } r -= 2 * I_IN;
            if (r < 2 * I_OUT) { const int l = r / I_OUT; p0_convert_plain(F, F.in[I_WOUT] + (size_t)l * 1024 * 1024, 1024, 1024, (bf16*)(F.ws + WS_WOUT) + (size_t)l * 1024 * 1024, r % I_OUT, scr); continue; } r -= 2 * I_OUT;
            if (r < I_G) { p0_convert_gu(F, F.in[I_FG], 1024, 2816, (bf16*)(F.ws + WS_WGU), r, 0, scr); continue; } r -= I_G;
            if (r < I_G) { p0_convert_gu(F, F.in[I_FU], 1024, 2816, (bf16*)(F.ws + WS_WGU), r, 1, scr); continue; } r -= I_G;
            if (r < I_D) { p0_convert_plain(F, F.in[I_FD], 2816, 1024, (bf16*)(F.ws + WS_WD), r, scr); continue; } r -= I_D;
            if (r < 8 * I_MGI) { const int e = r / I_MGI; p0_convert_gu(F, F.in[I_MG] + (size_t)e * 1024 * 3584, 1024, 3584, (bf16*)(F.ws + WS_MGU) + (size_t)e * 7168 * 1024, r % I_MGI, 0, scr); continue; } r -= 8 * I_MGI;
            if (r < 8 * I_MGI) { const int e = r / I_MGI; p0_convert_gu(F, F.in[I_MU] + (size_t)e * 1024 * 3584, 1024, 3584, (bf16*)(F.ws + WS_MGU) + (size_t)e * 7168 * 1024, r % I_MGI, 1, scr); continue; } r -= 8 * I_MGI;
            { const int e = r / I_MDI; p0_convert_plain(F, F.in[I_MDN] + (size_t)e * 3584 * 1024, 3584, 1024, (bf16*)(F.ws + WS_MD) + (size_t)e * 1024 * 3584, r % I_MDI, scr); }
        }
    }
}

DI void norm_row(Frame& F, const float* srow, const float* g, const float* sc, const float* sh, bf16* orow, f32x4 (&y)[4]) {
    const f32x4* xr = (const f32x4*)srow + F.lane;
    f32x4 v[4]; float s = 0.f;
#pragma unroll
    for (int j = 0; j < 4; ++j) { v[j] = xr[64 * j]; s += (v[j].x * v[j].x + v[j].y * v[j].y) + (v[j].z * v[j].z + v[j].w * v[j].w); }
    const float rstd = 1.0f / sqrtf(wave_sum(s) * (1.0f / DM) + EPS);
    u32x2* o8 = (u32x2*)orow + F.lane;
#pragma unroll
    for (int j = 0; j < 4; ++j) { const f32x4 gv = ((const f32x4*)g)[F.lane + 64 * j], sv = ((const f32x4*)sc)[F.lane + 64 * j], hv = ((const f32x4*)sh)[F.lane + 64 * j];
        y[j] = (v[j] * rstd) * gv * (sv + 1.0f) + hv;
        u32x2 w; w.x = pk2(y[j].x, y[j].y); w.y = pk2(y[j].z, y[j].w); o8[64 * j] = w; }
}
DI void norm_phase(Frame& F, int l, int which, bool first, int row_lo) {
    const float* g = F.in[which == 1 ? I_N1W : I_N2W] + l * DM;
    const float* modlat = (const float*)(F.ws + WS_MODLAT) + (size_t)l * 16 * 6144;
    const float* modctx = (const float*)(F.ws + WS_MODCTX) + (size_t)l * 6144;
    const int ish = which == 1 ? 0 : 3, isc = which == 1 ? 1 : 4;
    const float* sctx = first ? F.in[I_CTX] : (const float*)(F.ws + WS_HCTX);
    const float* slat = first ? F.in[I_X] : F.out;
    bf16* U = (bf16*)(F.ws + WS_U);
    const int gw = F.bid * 8 + F.wave, NGW = F.G * 8;
    for (int row = row_lo + gw; row < NTOK; row += NGW) {
        const bool isctx = row < NCTX;
        const float* src = isctx ? sctx + (size_t)row * DM : slat + (size_t)(row - NCTX) * DM;
        const float* mod = isctx ? modctx : modlat + (size_t)((row - NCTX) / SEQ) * 6144;
        f32x4 y[4];
        norm_row(F, src, g, mod + isc * DM, mod + ish * DM, U + (size_t)row * DM, y);
    }
}
DI void norm_moe_phase(Frame& F) {
    const int l = 1;
    const float* g = F.in[I_N2W] + l * DM;
    const float* modlat = (const float*)(F.ws + WS_MODLAT) + (size_t)l * 16 * 6144;
    bf16* U = (bf16*)(F.ws + WS_U);
    LAS float* Rw = (LAS float*)F.lds;
    LAS int* sel = (LAS int*)(F.lds + 32768);
    for (int idx = F.tid; idx < 8192; idx += 512) Rw[idx] = F.in[I_MR][idx];
    __syncthreads();
    float rb[8];
#pragma unroll
    for (int e = 0; e < 8; ++e) rb[e] = F.in[I_MRB][e];
    for (int seg = F.bid; seg < 256; seg += F.G) {
        for (int i = 0; i < 16; ++i) {
            const int tl = F.wave * 16 + i, tok = seg * 128 + tl;
            const float* mod = modlat + (size_t)(tok / SEQ) * 6144;
            f32x4 y[4];
            norm_row(F, F.out + (size_t)tok * DM, g, mod + 4 * DM, mod + 3 * DM, U + (size_t)(NCTX + tok) * DM, y);
            float lg[8];
#pragma unroll
            for (int e = 0; e < 8; ++e) lg[e] = 0.f;
#pragma unroll
            for (int j = 0; j < 4; ++j)
#pragma unroll
                for (int q = 0; q < 4; ++q) { const int k = 256 * j + 4 * F.lane + q; const f32x4 r0 = *(const LAS f32x4*)(Rw + k * 8), r1 = *(const LAS f32x4*)(Rw + k * 8 + 4); const float yv = y[j][q];
                    lg[0] += yv * r0[0]; lg[1] += yv * r0[1]; lg[2] += yv * r0[2]; lg[3] += yv * r0[3]; lg[4] += yv * r1[0]; lg[5] += yv * r1[1]; lg[6] += yv * r1[2]; lg[7] += yv * r1[3]; }
#pragma unroll
            for (int e = 0; e < 8; ++e) lg[e] = wave_sum(lg[e]) + rb[e];
            int e1 = 0; float v1 = lg[0];
#pragma unroll
            for (int e = 1; e < 8; ++e) if (lg[e] > v1) { v1 = lg[e]; e1 = e; }
            int e2 = -1; float v2 = -3.0e38f;
#pragma unroll
            for (int e = 0; e < 8; ++e) if (e != e1 && lg[e] > v2) { v2 = lg[e]; e2 = e; }
            const float ex = __expf(v2 - v1), p1 = 1.0f / (1.0f + ex), p2 = ex / (1.0f + ex);
            if (F.lane == 0) { sel[tl * 2] = e1; sel[tl * 2 + 1] = e2; float* pt = (float*)(F.ws + WS_PTOK) + (size_t)tok * 2; pt[0] = p1; pt[1] = p2; }
        }
        __syncthreads();
        if (F.tid < 16) { const int s = F.tid >> 3, e = F.tid & 7; int cnt = 0; int* lst = (int*)(F.ws + WS_SEGLIST) + ((size_t)(seg * 2 + s) * 8 + e) * 128;
            for (int i = 0; i < 128; ++i) if (sel[i * 2 + s] == e) lst[cnt++] = seg * 128 + i;
            ((int*)(F.ws + WS_SEGCNT))[(seg * 2 + s) * 8 + e] = cnt; }
        __syncthreads();
    }
}
DI void moe_route_phase(Frame& F) {
    LAS int* cn = (LAS int*)F.lds;
    LAS int* offs = cn + 2048;
    LAS int* tb = offs + 256;
    for (int unit = F.bid; unit < 16; unit += F.G) {
        const int s = unit >> 3, e = unit & 7;
        const int* segcnt = (const int*)(F.ws + WS_SEGCNT);
        for (int idx = F.tid; idx < 2048; idx += 512) { const int ee = idx >> 8, gsg = idx & 255; cn[idx] = segcnt[(gsg * 2 + s) * 8 + ee]; }
        __syncthreads();
        if (F.tid < 8) { int tot = 0; for (int gsg = 0; gsg < 256; ++gsg) tot += cn[F.tid * 256 + gsg]; tb[16 + F.tid] = tot; }
        if (F.tid == 64) { int run = 0; for (int gsg = 0; gsg < 256; ++gsg) { offs[gsg] = run; run += cn[e * 256 + gsg]; } }
        __syncthreads();
        if (F.tid == 0) { int run = 0; for (int ee = 0; ee < 8; ++ee) { tb[ee] = run; run += (tb[16 + ee] + 255) / 256; } tb[8] = run; }
        __syncthreads();
        int* rowmap = (int*)(F.ws + WS_ROWMAP) + (size_t)s * MOE_ROWS;
        float* prow = (float*)(F.ws + WS_PROW) + (size_t)s * MOE_ROWS;
        const float* ptok = (const float*)(F.ws + WS_PTOK);
        const int base = tb[e] * 256, tot = tb[16 + e], ntile = (tot + 255) / 256;
        if (F.tid < 256) { const int gsg = F.tid; const int c = cn[e * 256 + gsg]; const int* lst = (const int*)(F.ws + WS_SEGLIST) + ((size_t)(gsg * 2 + s) * 8 + e) * 128;
            for (int i = 0; i < c; ++i) { const int tok = lst[i]; rowmap[base + offs[gsg] + i] = tok; prow[base + offs[gsg] + i] = ptok[(size_t)tok * 2 + s]; } }
        for (int i = tot + F.tid; i < ntile * 256; i += 512) { rowmap[base + i] = -1; prow[base + i] = 0.f; }
        if (e == 0) { int* meta = (int*)(F.ws + WS_META) + s * 256;
            if (F.tid == 0) meta[0] = tb[8];
            if (F.tid < 8) { const int t0 = tb[F.tid], t1 = tb[F.tid + 1]; for (int t = t0; t < t1; ++t) meta[1 + t] = F.tid; } }
        __syncthreads();
    }
}
DI void final_phase(Frame& F) {
    const float* g = F.in[I_FNW];
    const int gw = F.bid * 8 + F.wave, NGW = F.G * 8;
    for (int row = gw; row < NLAT; row += NGW) {
        f32x4* xr = (f32x4*)(F.out + (size_t)row * DM) + F.lane;
        f32x4 v[4]; float s = 0.f;
#pragma unroll
        for (int j = 0; j < 4; ++j) { v[j] = xr[64 * j]; s += (v[j].x * v[j].x + v[j].y * v[j].y) + (v[j].z * v[j].z + v[j].w * v[j].w); }
        const float rstd = 1.0f / sqrtf(wave_sum(s) * (1.0f / DM) + EPS);
#pragma unroll
        for (int j = 0; j < 4; ++j) { const f32x4 gv = ((const f32x4*)g)[F.lane + 64 * j]; xr[64 * j] = (v[j] * rstd) * gv; }
    }
}

DI void conv_unit(Frame& F, int l, int row0, int t0, int slen) {
    const bf16* PX = (const bf16*)(F.ws + WS_P);
    bf16* YC = (bf16*)(F.ws + WS_U);
    LAS float* Y = (LAS float*)F.lds;
    { u32x4 av[6], gv[6];
#pragma unroll
      for (int k = 0; k < 6; ++k) { const int it = F.tid + 512 * k; const int rr = it >> 5, cc = it & 31; const int t = t0 - 15 + rr;
          av[k] = (u32x4){0u, 0u, 0u, 0u}; gv[k] = av[k];
          if (it < 94 * 32 && t >= 0 && t < slen) { const bf16* p = PX + (size_t)(row0 + t) * INW + C_CONV + 8 * cc; av[k] = *(const u32x4*)p; gv[k] = *(const u32x4*)(p + 256); } }
#pragma unroll
      for (int k = 0; k < 6; ++k) { const int it = F.tid + 512 * k; const int rr = it >> 5, cc = it & 31;
          if (it < 94 * 32) { f32x4 o0, o1;
              o0[0] = bflo(av[k].x) * sigmoidf_(bflo(gv[k].x)); o0[1] = bfhi(av[k].x) * sigmoidf_(bfhi(gv[k].x)); o0[2] = bflo(av[k].y) * sigmoidf_(bflo(gv[k].y)); o0[3] = bfhi(av[k].y) * sigmoidf_(bfhi(gv[k].y));
              o1[0] = bflo(av[k].z) * sigmoidf_(bflo(gv[k].z)); o1[1] = bfhi(av[k].z) * sigmoidf_(bfhi(gv[k].z)); o1[2] = bflo(av[k].w) * sigmoidf_(bflo(gv[k].w)); o1[3] = bfhi(av[k].w) * sigmoidf_(bfhi(gv[k].w));
              *(LAS f32x4*)(Y + rr * 256 + 8 * cc) = o0; *(LAS f32x4*)(Y + rr * 256 + 8 * cc + 4) = o1; } } }
    __syncthreads();
    const int c = F.tid & 255, half = F.tid >> 8;
    float w[31];
#pragma unroll
    for (int k = 0; k < 31; ++k) w[k] = F.in[I_CONVW][(size_t)l * 31 * 256 + k * 256 + c];
    float acc[32];
    const float cb = F.in[I_CONVB][l * 256 + c];
#pragma unroll
    for (int o = 0; o < 32; ++o) acc[o] = cb;
#pragma unroll
    for (int kk = 0; kk < 62; ++kk) { const float yv = Y[(32 * half + kk) * 256 + c];
#pragma unroll
        for (int o = 0; o < 32; ++o) { const int tap = kk - o; if (tap >= 0 && tap < 31) acc[o] += yv * w[tap]; } }
    __syncthreads();
#pragma unroll
    for (int o = 0; o < 32; ++o) Y[(32 * half + o) * 256 + c] = acc[o];
    __syncthreads();
    const f32x4 lw = ((const f32x4*)(F.in[I_CLNW] + l * 256))[F.lane], lb = ((const f32x4*)(F.in[I_CLNB] + l * 256))[F.lane];
    for (int i = 0; i < 8; ++i) { const int tl = F.wave * 8 + i; const f32x4 v = *(const LAS f32x4*)(Y + tl * 256 + 4 * F.lane);
        const float mu = wave_sum((v.x + v.y) + (v.z + v.w)) * (1.0f / 256.0f); const f32x4 d = v - mu;
        const float var = wave_sum((d.x * d.x + d.y * d.y) + (d.z * d.z + d.w * d.w)) * (1.0f / 256.0f); const float rstd = 1.0f / sqrtf(var + EPS);
        f32x4 z = d * rstd * lw + lb; z.x *= sigmoidf_(z.x); z.y *= sigmoidf_(z.y); z.z *= sigmoidf_(z.z); z.w *= sigmoidf_(z.w);
        u32x2 o; o.x = pk2(z.x, z.y); o.y = pk2(z.z, z.w);
        *(u32x2*)(YC + (size_t)(row0 + t0 + tl) * DM + 512 + 4 * F.lane) = o; }
    __syncthreads();
}
DI void ret_consts(Frame& F, int l, int hh, float& lg2f, float& lg2b) {
    const float df = F.in[I_RDEC][(l * 2 + 0) * 4 + hh], db = F.in[I_RDEC][(l * 2 + 1) * 4 + hh];
    lg2f = log2f(1.0f - exp2f(-df)); lg2b = log2f(1.0f - exp2f(-db));
}
constexpr int ROPE_LDS = AUX_OFF + 4096;
DI void rope_to_lds(Frame& F) { const float* tab = (const float*)(F.ws + WS_ROPE); LAS float* rt = (LAS float*)(F.lds + ROPE_LDS); for (int i = F.tid; i < 1024; i += 512) rt[i] = tab[i]; __syncthreads(); }
DI void unpack8(const u32x4& a, float (&x)[8]) { x[0] = bflo(a.x); x[1] = bfhi(a.x); x[2] = bflo(a.y); x[3] = bfhi(a.y); x[4] = bflo(a.z); x[5] = bfhi(a.z); x[6] = bflo(a.w); x[7] = bfhi(a.w); }
DI void rope_apply(Frame& F, const u32x4& a, const u32x4& b, int hp, bool lat, int tg, float (&x1)[8], float (&x2)[8]) {
    unpack8(a, x1); unpack8(b, x2);
    if (lat) { const int pos = hp == 0 ? (tg >> 6) : (tg & 63); LAS const f32x4* tab = (LAS const f32x4*)(F.lds + ROPE_LDS) + pos * 4;
#pragma unroll
        for (int jj = 0; jj < 4; ++jj) { const f32x4 cs = tab[jj];
            { const float a1 = x1[2 * jj], a2 = x2[2 * jj]; x1[2 * jj] = a1 * cs[0] - a2 * cs[1]; x2[2 * jj] = a2 * cs[0] + a1 * cs[1]; }
            { const float a1 = x1[2 * jj + 1], a2 = x2[2 * jj + 1]; x1[2 * jj + 1] = a1 * cs[2] - a2 * cs[3]; x2[2 * jj + 1] = a2 * cs[2] + a1 * cs[3]; } } }
}
DI void ret_unit_decode(int su, bool& isctx, int& b, int& hh, int& n) {
    isctx = su >= 1024; if (!isctx) { b = su >> 6; hh = (su >> 4) & 3; n = su & 15; } else { const int v = su - 1024; b = v >> 3; hh = (v >> 1) & 3; n = v & 1; }
}
DI void ret_summary_pair(Frame& F, int l, int it) {
    const bf16* PX = (const bf16*)(F.ws + WS_P);
    const int sub = F.wave >> 2, st = F.tid & 255, su = 2 * it + sub;
    bool isctx; int b, hh, n; ret_unit_decode(su, isctx, b, hh, n);
    const int row0 = isctx ? (b * CTXL + n * 128) : (NCTX + b * SEQ + n * 128);
    float lg2f, lg2b; ret_consts(F, l, hh, lg2f, lg2b);
    LAS unsigned char* base = F.lds + sub * 40960;
    LAS unsigned char* Vimg = base;
    LAS unsigned char* Kf = base + 18432;
    LAS unsigned char* Kb = base + 18432 + 10240;
    { const int tok = st >> 1, hp = st & 1; float x1[8], x2[8];
      const bf16* kp = PX + (size_t)(row0 + tok) * INW + C_RK + 32 * hh; const bf16* vp = PX + (size_t)(row0 + tok) * INW + C_RV + 64 * hh + 32 * hp;
      const u32x4 kra = *(const u32x4*)(kp + 8 * hp), krb = *(const u32x4*)(kp + 16 + 8 * hp);
      u32x4 vr[4];
#pragma unroll
      for (int q = 0; q < 4; ++q) vr[q] = *(const u32x4*)(vp + 8 * q);
      rope_apply(F, kra, krb, hp, !isctx, n * 128 + tok, x1, x2);
      const float ks = 0.17677669529663687f;
      const float wf = fast_exp2(lg2f * (float)(127 - tok)) * ks, wb = fast_exp2(lg2b * (float)tok) * ks;
      u32x4 o;
      o.x = pk2(x1[0] * wf, x1[1] * wf); o.y = pk2(x1[2] * wf, x1[3] * wf); o.z = pk2(x1[4] * wf, x1[5] * wf); o.w = pk2(x1[6] * wf, x1[7] * wf); *(LAS u32x4*)(Kf + tok * 80 + 16 * hp) = o;
      o.x = pk2(x2[0] * wf, x2[1] * wf); o.y = pk2(x2[2] * wf, x2[3] * wf); o.z = pk2(x2[4] * wf, x2[5] * wf); o.w = pk2(x2[6] * wf, x2[7] * wf); *(LAS u32x4*)(Kf + tok * 80 + 32 + 16 * hp) = o;
      o.x = pk2(x1[0] * wb, x1[1] * wb); o.y = pk2(x1[2] * wb, x1[3] * wb); o.z = pk2(x1[4] * wb, x1[5] * wb); o.w = pk2(x1[6] * wb, x1[7] * wb); *(LAS u32x4*)(Kb + tok * 80 + 16 * hp) = o;
      o.x = pk2(x2[0] * wb, x2[1] * wb); o.y = pk2(x2[2] * wb, x2[3] * wb); o.z = pk2(x2[4] * wb, x2[5] * wb); o.w = pk2(x2[6] * wb, x2[7] * wb); *(LAS u32x4*)(Kb + tok * 80 + 32 + 16 * hp) = o;
#pragma unroll
      for (int q = 0; q < 4; ++q) *(LAS u32x4*)(Vimg + tok * 144 + 64 * hp + 16 * q) = vr[q]; }
    __syncthreads();
    { const int role = F.wave & 3, dir = role >> 1, et = role & 1;
      const int l32 = F.lane & 31, h = F.lane >> 5, grp = (F.lane >> 4) & 1, i16 = F.lane & 15, q = i16 >> 2, p = i16 & 3;
      LAS unsigned char* Kimg = dir ? Kb : Kf;
      f32x16 acc;
#pragma unroll
      for (int i = 0; i < 16; ++i) acc[i] = 0.f;
#pragma unroll
      for (int s = 0; s < 8; ++s) { const int r0 = 16 * s + 8 * h + q;
          const s16x4 alo = trread(Vimg + r0 * 144 + (32 * et + 16 * grp + 4 * p) * 2), ahi = trread(Vimg + (r0 + 4) * 144 + (32 * et + 16 * grp + 4 * p) * 2);
          const s16x4 blo = trread(Kimg + r0 * 80 + (16 * grp + 4 * p) * 2), bhi = trread(Kimg + (r0 + 4) * 80 + (16 * grp + 4 * p) * 2);
          const bf16x8 a = __builtin_shufflevector(alo, ahi, 0, 1, 2, 3, 4, 5, 6, 7), bb = __builtin_shufflevector(blo, bhi, 0, 1, 2, 3, 4, 5, 6, 7);
          acc = MFMA32(a, bb, acc); }
      float* S = isctx ? (float*)(F.ws + WS_SUMCTX) + ((size_t)((b * 4 + hh) * 2 + n) * 2 + dir) * 2048 : (float*)(F.ws + WS_SUMLAT) + ((size_t)((b * 4 + hh) * 16 + n) * 2 + dir) * 2048;
#pragma unroll
      for (int i = 0; i < 16; ++i) S[(32 * et + crow(i, h)) * 32 + l32] = acc[i]; }
    __syncthreads();
}
DI void ca_phase(Frame& F, int l) {
    rope_to_lds(F);
    const int nconv = l == 0 ? 576 : 512;
    for (int u = F.vb; u < nconv; u += F.G) {
        int v = u; if (l != 0) v += 64;
        if (v < 64) conv_unit(F, l, (v >> 2) * CTXL, (v & 3) * 64, CTXL);
        else { v -= 64; conv_unit(F, l, NCTX + (v >> 5) * SEQ, (v & 31) * 64, SEQ); }
    }
    for (int it = F.vb; it < 576; it += F.G) ret_summary_pair(F, l, it);
}

constexpr int ATT_BUF = 18432, ATT_BT = 2 * ATT_BUF, ATT_NEG = 640;
DI void attn_fetch(Frame& F, const bf16* PX, int keyrow0, int hh, u32x4& kv, u32x4& vv) {
    const int key = F.tid >> 3, ch = F.tid & 7;
    const bf16* p = PX + (size_t)(keyrow0 + key) * INW + 64 * hh + 8 * ch;
    kv = *(const u32x4*)(p + C_NAK); vv = *(const u32x4*)(p + C_NAV);
}
DI void attn_put(Frame& F, LAS unsigned char* buf, const u32x4& kv, const u32x4& vv) {
    const int key = F.tid >> 3, ch = F.tid & 7;
    *(LAS u32x4*)(buf + key * 144 + 16 * ch) = kv; *(LAS u32x4*)(buf + 9216 + key * 144 + 16 * ch) = vv;
}
template <bool BIAS>
DI void attn_tile(LAS const unsigned char* buf, int koff, const bf16x8 (&qf)[4], f32x16& o0, f32x16& o1, f32x16& o2, float& mrun, int lane,
                  LAS const float* bt  , const float (&pen)[16]) {
    LAS const unsigned char* Kimg = buf; LAS const unsigned char* Vimg = buf + 9216;
    const int l32 = lane & 31, h = lane >> 5, grp = (lane >> 4) & 1, i16 = lane & 15, q = i16 >> 2, p = i16 & 3;
    f32x16 s;
#pragma unroll
    for (int i = 0; i < 16; ++i) s[i] = 0.f;
#pragma unroll
    for (int si = 0; si < 4; ++si) { const bf16x8 a = *(const LAS bf16x8*)(Kimg + (koff + l32) * 144 + (16 * si + 8 * h) * 2); s = MFMA32(a, qf[si], s); }
    const float c = 0.125f * LOG2E;
    float v[16]; float mx = -1.0e30f;
#pragma unroll
    for (int i = 0; i < 16; ++i) { float t;
        if (BIAS) t = __builtin_fmaf(s[i], c, bt[(i & 3) + 8 * (i >> 2)]) + pen[i]; else t = s[i] * c;
        v[i] = t; mx = fmaxf(mx, t); }
    mx = fmaxf(mx, __shfl_xor(mx, 32));
    const float mnew = fmaxf(mrun, mx);
    const float alpha = fast_exp2(mrun - mnew);
    if (__any(alpha != 1.0f)) {
#pragma unroll
        for (int i = 0; i < 16; ++i) { o0[i] *= alpha; o1[i] *= alpha; o2[i] *= alpha; } }
    mrun = mnew;
    float pp[16];
#pragma unroll
    for (int i = 0; i < 16; ++i) pp[i] = fast_exp2(v[i] - mnew);
    bf16x8 pf[2];
#pragma unroll
    for (int s2 = 0; s2 < 2; ++s2) { u32x4 w; w.x = pk2(pp[8 * s2], pp[8 * s2 + 1]); w.y = pk2(pp[8 * s2 + 2], pp[8 * s2 + 3]); w.z = pk2(pp[8 * s2 + 4], pp[8 * s2 + 5]); w.w = pk2(pp[8 * s2 + 6], pp[8 * s2 + 7]); pf[s2] = __builtin_bit_cast(bf16x8, w); }
    const u32x4 onesw = (u32x4){0x3f803f80u, 0x3f803f80u, 0x3f803f80u, 0x3f803f80u}; const bf16x8 ones = __builtin_bit_cast(bf16x8, onesw);
#pragma unroll
    for (int s2 = 0; s2 < 2; ++s2) { const int r0 = koff + 16 * s2 + 4 * h + q;
#pragma unroll
        for (int et = 0; et < 2; ++et) { const int cb = (32 * et + 16 * grp + 4 * p) * 2;
            const s16x4 lo = trread(Vimg + r0 * 144 + cb), hi = trread(Vimg + (r0 + 8) * 144 + cb);
            const bf16x8 a = __builtin_shufflevector(lo, hi, 0, 1, 2, 3, 4, 5, 6, 7);
            if (et == 0) o0 = MFMA32(a, pf[s2], o0); else o1 = MFMA32(a, pf[s2], o1); }
        o2 = MFMA32(ones, pf[s2], o2); }
}
DI void attn_unit(Frame& F, int l, bool na, int b, int hh, int rg) {
    const bf16* PX = (const bf16*)(F.ws + WS_P);
    bf16* YC = (bf16*)(F.ws + WS_U);
    LAS float* btab = (LAS float*)(F.lds + ATT_BT);
    const int l32 = F.lane & 31, h = F.lane >> 5;
    int qrow, r = 0, qcol = 0, kc0 = 0, ra = 0;
    float pen[16];
#pragma unroll
    for (int i = 0; i < 16; ++i) pen[i] = 0.f;
    if (na) { const int rp = F.wave >> 2, n = F.wave & 3; ra = 4 * rg + 2 * rp; r = ra + (l32 >> 4); qcol = 16 * n + (l32 & 15); qrow = NCTX + b * SEQ + r * GW + qcol;
        int w0 = qcol - 8; w0 = w0 < 0 ? 0 : (w0 > 48 ? 48 : w0); kc0 = 16 * n - 8; kc0 = kc0 < 0 ? 0 : (kc0 > 32 ? 32 : kc0);
#pragma unroll
        for (int i = 0; i < 16; ++i) pen[i] = ((unsigned)(kc0 + crow(i, h) - w0) < 16u) ? 0.f : -1.0e30f; }
    else qrow = b * CTXL + 32 * F.wave + l32;
    bf16x8 qf[4];
#pragma unroll
    for (int si = 0; si < 4; ++si) qf[si] = *(const bf16x8*)(PX + (size_t)qrow * INW + C_NAQ + 64 * hh + 16 * si + 8 * h);
    if (na) { for (int idx = F.tid; idx < ATT_NEG + 128; idx += 512) { float v = 0.f; if (idx >= 48 && idx < 48 + 465) v = F.in[I_RPB][((size_t)l * 8 + hh) * 465 + (idx - 48)] * LOG2E; if (idx >= ATT_NEG) v = -1.0e30f; btab[idx] = v; } }
    f32x16 o0, o1, o2;
#pragma unroll
    for (int i = 0; i < 16; ++i) { o0[i] = 0.f; o1[i] = 0.f; o2[i] = 0.f; }
    float mrun = -1.0e30f;
    int ylo = 0, nsteps = 4;
    if (na) { const int rlo = 4 * rg, rhi = 4 * rg + 3;
        ylo = rlo - 4; ylo = ylo < 0 ? 0 : (ylo > 24 ? 24 : ylo);
        int yhi = rhi - 4; yhi = yhi < 0 ? 0 : (yhi > 24 ? 24 : yhi); yhi += 8; nsteps = 4 + (yhi - ylo); }
    int sa = ra - 4; sa = sa < 0 ? 0 : (sa > 24 ? 24 : sa);
    int sb = ra + 1 - 4; sb = sb < 0 ? 0 : (sb > 24 ? 24 : sb);
    const int mylo = (l32 >> 4) ? sb : sa;
    const int cbase = kc0 + 4 * h - qcol + 15;
#define ATT_ROW0(sx) ((sx) < 4 ? b * CTXL + 64 * (sx) : NCTX + b * SEQ + (ylo + (sx) - 4) * GW)
#define ATT_COMPUTE(buf, sx) do { if ((sx) < 4) { attn_tile<false>(buf, 0, qf, o0, o1, o2, mrun, F.lane, btab, pen); attn_tile<false>(buf, 32, qf, o0, o1, o2, mrun, F.lane, btab, pen); } \
        else { const int y = ylo + (sx) - 4; if (y >= sa && y < sb + 8) { const bool rowok = (unsigned)(y - mylo) < 8u; \
            LAS const float* bt = btab + (rowok ? 48 + (y - r + 7) * 31 + cbase : ATT_NEG); attn_tile<true>(buf, kc0, qf, o0, o1, o2, mrun, F.lane, bt, pen); } } } while (0)
    u32x4 kvA, vvA, kvB, vvB;
    attn_fetch(F, PX, ATT_ROW0(0), hh, kvA, vvA);
    attn_fetch(F, PX, ATT_ROW0(1), hh, kvB, vvB);
    for (int st = 0; st < nsteps; st += 2) {
        LAS unsigned char* buf0 = F.lds; LAS unsigned char* buf1 = F.lds + ATT_BUF;
        attn_put(F, buf0, kvA, vvA);
        if (st + 2 < nsteps) attn_fetch(F, PX, ATT_ROW0(st + 2), hh, kvA, vvA);
        __syncthreads();
        ATT_COMPUTE(buf0, st);
        if (st + 1 < nsteps) {
            attn_put(F, buf1, kvB, vvB);
            if (st + 3 < nsteps) attn_fetch(F, PX, ATT_ROW0(st + 3), hh, kvB, vvB);
            __syncthreads();
            ATT_COMPUTE(buf1, st + 1);
        }
    }
#undef ATT_ROW0
#undef ATT_COMPUTE
    const float inv = 1.0f / o2[0];
    bf16* orow = YC + (size_t)qrow * DM + 64 * hh;
#pragma unroll
    for (int gq = 0; gq < 4; ++gq) { u32x2 w;
        w.x = pk2(o0[4 * gq] * inv, o0[4 * gq + 1] * inv); w.y = pk2(o0[4 * gq + 2] * inv, o0[4 * gq + 3] * inv); *(u32x2*)(orow + 8 * gq + 4 * h) = w;
        w.x = pk2(o1[4 * gq] * inv, o1[4 * gq + 1] * inv); w.y = pk2(o1[4 * gq + 2] * inv, o1[4 * gq + 3] * inv); *(u32x2*)(orow + 32 + 8 * gq + 4 * h) = w; }
    __syncthreads();
}
DI void ret_out_unit(Frame& F, int l, int su) {
    const bf16* PX = (const bf16*)(F.ws + WS_P);
    bf16* YC = (bf16*)(F.ws + WS_U);
    bool isctx; int b, hh, n; ret_unit_decode(su, isctx, b, hh, n);
    const int row0 = isctx ? (b * CTXL + n * 128) : (NCTX + b * SEQ + n * 128);
    float lg2f, lg2b; ret_consts(F, l, hh, lg2f, lg2b);
    LAS unsigned char* Kimg = F.lds;
    LAS unsigned char* Vimg = F.lds + 10240;
    LAS unsigned char* Stf = F.lds + 28672;
    LAS unsigned char* Stb = F.lds + 33792;
    LAS float* Ob = (LAS float*)(F.lds + 38912);
    const int dir = F.wave >> 2, qb = F.wave & 3, l32 = F.lane & 31, h = F.lane >> 5, grp = (F.lane >> 4) & 1, i16 = F.lane & 15, q = i16 >> 2, p = i16 & 3;
    const int iq = 32 * qb + l32;
    const int ktok = (F.tid & 255) >> 1, khp = F.tid & 1;
    const bf16* kp = PX + (size_t)(row0 + ktok) * INW + C_RK + 32 * hh;
    const u32x4 kra = *(const u32x4*)(kp + 8 * khp), krb = *(const u32x4*)(kp + 16 + 8 * khp);
    const int vtok = F.tid >> 2, vch = F.tid & 3; const bf16* vp = PX + (size_t)(row0 + vtok) * INW + C_RV + 64 * hh + 16 * vch;
    const u32x4 vra = *(const u32x4*)vp, vrb = *(const u32x4*)(vp + 8);
    const bf16* qp = PX + (size_t)(row0 + iq) * INW + C_RQ + 32 * hh;
    const u32x4 qra = *(const u32x4*)(qp + 8 * h), qrb = *(const u32x4*)(qp + 16 + 8 * h);
    const bf16* gp = PX + (size_t)(row0 + iq) * INW + (dir ? C_GB : C_GF) + 64 * hh;
    u32x2 gg[8];
#pragma unroll
    for (int et = 0; et < 2; ++et)
#pragma unroll
        for (int gq = 0; gq < 4; ++gq) gg[et * 4 + gq] = *(const u32x2*)(gp + 32 * et + 8 * gq + 4 * h);
    const float cf = fast_exp2(lg2f * 128.0f), cb = fast_exp2(lg2b * 128.0f);
    const float* SC = (const float*)(F.ws + WS_SUMCTX) + (size_t)((b * 4 + hh) * 2) * 2 * 2048;
    const float* SL = (const float*)(F.ws + WS_SUMLAT) + (size_t)((b * 4 + hh) * 16) * 2 * 2048;
    f32x4 sf = (f32x4){0.f, 0.f, 0.f, 0.f}, sb = sf; const int eo = 4 * F.tid;
    if (!isctx) {
        f32x4 t[16];
#pragma unroll
        for (int m = 0; m < 16; ++m) t[m] = *(const f32x4*)(SL + (size_t)(m * 2 + (m <= n ? 0 : 1)) * 2048 + eo);
        const f32x4 c00 = *(const f32x4*)(SC + (0 * 2 + 0) * 2048 + eo), c10 = *(const f32x4*)(SC + (1 * 2 + 0) * 2048 + eo);
        const f32x4 c11 = *(const f32x4*)(SC + (1 * 2 + 1) * 2048 + eo), c01 = *(const f32x4*)(SC + (0 * 2 + 1) * 2048 + eo);
        sf = c00 * cf + c10;
#pragma unroll
        for (int m = 0; m < 16; ++m) { const f32x4 nv = sf * cf + t[m]; sf = (m < n) ? nv : sf; }
        sb = c11 * cb + c01;
#pragma unroll
        for (int m = 15; m >= 0; --m) { const f32x4 nv = sb * cb + t[m]; sb = (m > n) ? nv : sb; }
    } else {
        if (n == 1) sf = *(const f32x4*)(SC + (0 * 2 + 0) * 2048 + eo);
        if (n == 0) sb = *(const f32x4*)(SC + (1 * 2 + 1) * 2048 + eo);
    }
    if (F.tid < 256) { float x1[8], x2[8]; rope_apply(F, kra, krb, khp, !isctx, n * 128 + ktok, x1, x2);
        const float ks = 0.17677669529663687f; u32x4 o;
        o.x = pk2(x1[0] * ks, x1[1] * ks); o.y = pk2(x1[2] * ks, x1[3] * ks); o.z = pk2(x1[4] * ks, x1[5] * ks); o.w = pk2(x1[6] * ks, x1[7] * ks); *(LAS u32x4*)(Kimg + ktok * 80 + 16 * khp) = o;
        o.x = pk2(x2[0] * ks, x2[1] * ks); o.y = pk2(x2[2] * ks, x2[3] * ks); o.z = pk2(x2[4] * ks, x2[5] * ks); o.w = pk2(x2[6] * ks, x2[7] * ks); *(LAS u32x4*)(Kimg + ktok * 80 + 32 + 16 * khp) = o; }
    *(LAS u32x4*)(Vimg + vtok * 144 + 32 * vch) = vra; *(LAS u32x4*)(Vimg + vtok * 144 + 32 * vch + 16) = vrb;
    { const int e = eo >> 5, d = eo & 31; u32x2 w;
      w.x = pk2(sf[0], sf[1]); w.y = pk2(sf[2], sf[3]); *(LAS u32x2*)(Stf + e * 80 + d * 2) = w;
      w.x = pk2(sb[0], sb[1]); w.y = pk2(sb[2], sb[3]); *(LAS u32x2*)(Stb + e * 80 + d * 2) = w; }
    bf16x8 qf[2], qd[2];
    { float x1[8], x2[8]; rope_apply(F, qra, qrb, h, !isctx, n * 128 + iq, x1, x2);
      const float dec = dir == 0 ? fast_exp2(lg2f * (float)(iq + 1)) : fast_exp2(lg2b * (float)(128 - iq));
      u32x4 w;
      w.x = pk2(x1[0], x1[1]); w.y = pk2(x1[2], x1[3]); w.z = pk2(x1[4], x1[5]); w.w = pk2(x1[6], x1[7]); qf[0] = __builtin_bit_cast(bf16x8, w);
      w.x = pk2(x2[0], x2[1]); w.y = pk2(x2[2], x2[3]); w.z = pk2(x2[4], x2[5]); w.w = pk2(x2[6], x2[7]); qf[1] = __builtin_bit_cast(bf16x8, w);
      w.x = pk2(x1[0] * dec, x1[1] * dec); w.y = pk2(x1[2] * dec, x1[3] * dec); w.z = pk2(x1[4] * dec, x1[5] * dec); w.w = pk2(x1[6] * dec, x1[7] * dec); qd[0] = __builtin_bit_cast(bf16x8, w);
      w.x = pk2(x2[0] * dec, x2[1] * dec); w.y = pk2(x2[2] * dec, x2[3] * dec); w.z = pk2(x2[4] * dec, x2[5] * dec); w.w = pk2(x2[6] * dec, x2[7] * dec); qd[1] = __builtin_bit_cast(bf16x8, w); }
    __syncthreads();
    f32x16 o0, o1;
#pragma unroll
    for (int i = 0; i < 16; ++i) { o0[i] = 0.f; o1[i] = 0.f; }
    { LAS const unsigned char* St = dir ? Stb : Stf;
#pragma unroll
      for (int s = 0; s < 2; ++s) { const bf16x8 a0 = *(const LAS bf16x8*)(St + l32 * 80 + (16 * s + 8 * h) * 2), a1 = *(const LAS bf16x8*)(St + (32 + l32) * 80 + (16 * s + 8 * h) * 2);
          o0 = MFMA32(a0, qd[s], o0); o1 = MFMA32(a1, qd[s], o1); } }
    const float lgd = dir ? lg2b : lg2f;
    const int kt_lo = dir ? qb : 0, kt_hi = dir ? 3 : qb;
    for (int kt = kt_lo; kt <= kt_hi; ++kt) {
        f32x16 s;
#pragma unroll
        for (int i = 0; i < 16; ++i) s[i] = 0.f;
#pragma unroll
        for (int si = 0; si < 2; ++si) { const bf16x8 a = *(const LAS bf16x8*)(Kimg + (32 * kt + l32) * 80 + (16 * si + 8 * h) * 2); s = MFMA32(a, qf[si], s); }
        float pp[16];
#pragma unroll
        for (int i = 0; i < 16; ++i) { const int j = 32 * kt + crow(i, h); const int diff = dir ? (j - iq) : (iq - j); pp[i] = diff >= 0 ? s[i] * fast_exp2(lgd * (float)diff) : 0.f; }
        bf16x8 pf[2];
#pragma unroll
        for (int s2 = 0; s2 < 2; ++s2) { u32x4 w; w.x = pk2(pp[8 * s2], pp[8 * s2 + 1]); w.y = pk2(pp[8 * s2 + 2], pp[8 * s2 + 3]); w.z = pk2(pp[8 * s2 + 4], pp[8 * s2 + 5]); w.w = pk2(pp[8 * s2 + 6], pp[8 * s2 + 7]); pf[s2] = __builtin_bit_cast(bf16x8, w); }
#pragma unroll
        for (int s2 = 0; s2 < 2; ++s2) { const int r0 = 32 * kt + 16 * s2 + 4 * h + q;
#pragma unroll
            for (int et = 0; et < 2; ++et) { const int cb = (32 * et + 16 * grp + 4 * p) * 2;
                const s16x4 lo = trread(Vimg + r0 * 144 + cb), hi = trread(Vimg + (r0 + 8) * 144 + cb);
                const bf16x8 a = __builtin_shufflevector(lo, hi, 0, 1, 2, 3, 4, 5, 6, 7);
                if (et == 0) o0 = MFMA32(a, pf[s2], o0); else o1 = MFMA32(a, pf[s2], o1); } }
    }
    float sm = 0.f;
#pragma unroll
    for (int i = 0; i < 16; ++i) sm += o0[i] + o1[i];
    sm += __shfl_xor(sm, 32);
    const float mu = sm * (1.0f / 64.0f);
    float vs = 0.f;
#pragma unroll
    for (int i = 0; i < 16; ++i) { const float d0 = o0[i] - mu, d1 = o1[i] - mu; vs += d0 * d0 + d1 * d1; }
    vs += __shfl_xor(vs, 32);
    const float rstd = 1.0f / sqrtf(vs * (1.0f / 64.0f) + EPS);
    const float* gn = F.in[I_RGNW] + l * 256 + 64 * hh;
    float val[32];
#pragma unroll
    for (int et = 0; et < 2; ++et)
#pragma unroll
        for (int gq = 0; gq < 4; ++gq) { const int e0 = 32 * et + 8 * gq + 4 * h; const u32x2 ggv = gg[et * 4 + gq]; const f32x4 gw = *(const f32x4*)(gn + e0);
            const float g0 = bflo(ggv.x), g1 = bfhi(ggv.x), g2 = bflo(ggv.y), g3 = bfhi(ggv.y);
            const float a0 = et ? o1[4 * gq] : o0[4 * gq], a1 = et ? o1[4 * gq + 1] : o0[4 * gq + 1], a2 = et ? o1[4 * gq + 2] : o0[4 * gq + 2], a3 = et ? o1[4 * gq + 3] : o0[4 * gq + 3];
            val[et * 16 + 4 * gq] = (a0 - mu) * rstd * gw[0] * g0 * sigmoidf_(g0); val[et * 16 + 4 * gq + 1] = (a1 - mu) * rstd * gw[1] * g1 * sigmoidf_(g1);
            val[et * 16 + 4 * gq + 2] = (a2 - mu) * rstd * gw[2] * g2 * sigmoidf_(g2); val[et * 16 + 4 * gq + 3] = (a3 - mu) * rstd * gw[3] * g3 * sigmoidf_(g3); }
    if (dir == 0) {
#pragma unroll
        for (int et = 0; et < 2; ++et)
#pragma unroll
            for (int gq = 0; gq < 4; ++gq)
#pragma unroll
                for (int j = 0; j < 4; ++j) Ob[iq * 65 + 32 * et + 8 * gq + 4 * h + j] = val[et * 16 + 4 * gq + j];
    }
    __syncthreads();
    if (dir == 1) { bf16* orow = YC + (size_t)(row0 + iq) * DM + 768 + 64 * hh;
#pragma unroll
        for (int et = 0; et < 2; ++et)
#pragma unroll
            for (int gq = 0; gq < 4; ++gq) { const int e0 = 32 * et + 8 * gq + 4 * h; float t[4];
#pragma unroll
                for (int j = 0; j < 4; ++j) t[j] = val[et * 16 + 4 * gq + j] + Ob[iq * 65 + e0 + j];
                u32x2 w; w.x = pk2(t[0], t[1]); w.y = pk2(t[2], t[3]); *(u32x2*)(orow + e0) = w; } }
    __syncthreads();
}
#ifndef PROBE_SUB
#define PROBE_SUB 0
#endif
DI void cb_phase(Frame& F, int l) {
    rope_to_lds(F);
    const int nattn = l == 0 ? 1152 : 1024;
    for (int rep = 0; rep < ((PROBE_SUB & 1) ? 2 : 1); ++rep)
    for (int u = F.vb; u < nattn; u += F.G) {
        if (u < 1024) attn_unit(F, l, true, u >> 6, (u >> 3) & 7, u & 7);
        else { const int v = u - 1024; attn_unit(F, l, false, v >> 3, v & 7, 0); }
    }
    const int nret = l == 0 ? 1152 : 1024;
    for (int rep = 0; rep < ((PROBE_SUB & 2) ? 2 : 1); ++rep)
    for (int u = F.vb; u < nret; u += F.G) ret_out_unit(F, l, u);
}

static_assert(sizeof(Params) == 240, "kernarg layout: in[26] at 0, out at 208, ws at 216, ph_lo at 224, ph_hi at 228");
__global__ void __launch_bounds__(512, 2) fwd_kernel(Params prm) {
    extern __shared__ __attribute__((aligned(16))) unsigned char lds_raw[];
    Frame F;
    F.lds = (LAS unsigned char*)lds_raw;
    F.tid = threadIdx.x; F.lane = F.tid & 63; F.wave = __builtin_amdgcn_readfirstlane(F.tid >> 6);
    F.G = gridDim.x; F.bid = blockIdx.x; F.vb = F.bid;
    F.in.ka = (karg_t)__builtin_amdgcn_kernarg_segment_ptr(); F.out = prm.out; F.ws = prm.ws;
    volatile LAS unsigned* MISC = (volatile LAS unsigned*)(F.lds + AUX_OFF);
    if (F.tid < 64) MISC[F.tid] = 0u;
    __syncthreads();
    XcdBarrier bar; bar.bar = (unsigned*)(prm.ws + WS_CTL) + 1024; bar.x = 0; bar.st = nullptr;
    const int lo = prm.ph_lo, hi = prm.ph_hi;
    if (hi - lo > 1) bar = xcd_barrier_post((unsigned*)(prm.ws + WS_CTL) + 1024, MISC + 8);
#ifdef ONLY_PHASE
#define IN(k) ((k) == ONLY_PHASE && lo <= (k) && (k) < hi)
#else
#define IN(k) (lo <= (k) && (k) < hi)
#endif
#ifndef PROBE_MASK
#define PROBE_MASK 0u
#endif
#define NREP(k) (((PROBE_MASK >> (k)) & 1u) ? 2 : 1)
#define SEAM(k) do { if (IN(k) && IN((k) + 1)) { XcdBarrier bb_ = bar; asm volatile("" : "+s"(bb_.bar)); xcd_barrier(bb_); } } while (0)
#define GLDS(P) ((LAS unsigned char*)(P).lds)
#define WSB(P, off) ((const pg8::bf16_t*)((P).ws + (off)))

    if (IN(0)) for (int rep_ = 0; rep_ < NREP(0); ++rep_) { if (rep_) __syncthreads(); Frame P = phase_frame(F); p0_prologue(P); } SEAM(0);
#pragma unroll 1
    for (int l = 0; l < 2; ++l) {
        const int pb = l == 0 ? 1 : 9;
        if (IN(pb + 0)) for (int rep_ = 0; rep_ < NREP(pb + 0); ++rep_) { if (rep_) __syncthreads(); Frame P = phase_frame(F); norm_phase(P, l, 1, l == 0, 0); } SEAM(pb + 0);
        if (IN(pb + 1)) for (int rep_ = 0; rep_ < NREP(pb + 1); ++rep_) { if (rep_) __syncthreads();
            Frame P = phase_frame(F);
            pg8::StaticOrder S; S.init(NTOK, INW, P.G, P.bid);
            pg8::EpiStoreBf16 E{(pg8::bf16_t*)(P.ws + WS_P), INW};
            pg8::gemm_phase<pg8::EpiStoreBf16, pg8::StaticOrder, pg8::RowsLinear, true>(GLDS(P), P.tid, WSB(P, WS_U), WSB(P, WS_WIN) + (size_t)l * INW * DM, DM, S, E, pg8::RowsLinear{});
        } SEAM(pb + 1);
        if (IN(pb + 2)) for (int rep_ = 0; rep_ < NREP(pb + 2); ++rep_) { if (rep_) __syncthreads(); Frame P = phase_frame(F); ca_phase(P, l); } SEAM(pb + 2);
        if (IN(pb + 3)) for (int rep_ = 0; rep_ < NREP(pb + 3); ++rep_) { if (rep_) __syncthreads(); Frame P = phase_frame(F); cb_phase(P, l); } SEAM(pb + 3);
        if (IN(pb + 4)) {
            Frame P = phase_frame(F);
            const int rb = l == 0 ? 0 : NCTX;
            const float* modlat = (const float*)(P.ws + WS_MODLAT) + (size_t)l * 16 * 6144;
            const float* modctx = (const float*)(P.ws + WS_MODCTX) + (size_t)l * 6144;
            float* hctx = (float*)(P.ws + WS_HCTX);
            pg8::StaticOrder S; S.init(NTOK - rb, DM, P.G, P.bid);
            pg8::EpiResGate E{l == 0 ? P.in[I_CTX] : hctx, l == 0 ? P.in[I_X] : P.out, hctx, P.out, modlat + 2 * DM, modctx + 2 * DM, rb};
            pg8::gemm_phase<pg8::EpiResGate, pg8::StaticOrder, pg8::RowsLinear, true>(GLDS(P), P.tid, WSB(P, WS_U) + (size_t)rb * DM, WSB(P, WS_WOUT) + (size_t)l * DM * DM, DM, S, E, pg8::RowsLinear{});
        } SEAM(pb + 4);
        if (l == 0) {
            if (IN(6)) for (int rep_ = 0; rep_ < NREP(6); ++rep_) { if (rep_) __syncthreads(); Frame P = phase_frame(F); norm_phase(P, 0, 2, false, 0); } SEAM(6);
            if (IN(7)) for (int rep_ = 0; rep_ < NREP(7); ++rep_) { if (rep_) __syncthreads();
                Frame P = phase_frame(F);
                pg8::StaticOrder S; S.init(NTOK, 2 * DFF, P.G, P.bid);
                pg8::EpiSwiglu<false> E{(pg8::bf16_t*)(P.ws + WS_P), DFF, 0, nullptr};
                pg8::gemm_phase<pg8::EpiSwiglu<false>, pg8::StaticOrder, pg8::RowsLinear, true>(GLDS(P), P.tid, WSB(P, WS_U), WSB(P, WS_WGU), DM, S, E, pg8::RowsLinear{});
            } SEAM(7);
            if (IN(8)) {
                Frame P = phase_frame(F);
                const float* modlat = (const float*)(P.ws + WS_MODLAT);
                const float* modctx = (const float*)(P.ws + WS_MODCTX);
                float* hctx = (float*)(P.ws + WS_HCTX);
                pg8::StaticOrder S; S.init(NTOK, DM, P.G, P.bid);
                pg8::EpiResGate E{hctx, P.out, hctx, P.out, modlat + 5 * DM, modctx + 5 * DM, 0};
                pg8::gemm_phase<pg8::EpiResGate, pg8::StaticOrder, pg8::RowsLinear, true>(GLDS(P), P.tid, WSB(P, WS_P), WSB(P, WS_WD), DFF, S, E, pg8::RowsLinear{});
            } SEAM(8);
        } else {
            if (IN(14)) for (int rep_ = 0; rep_ < NREP(14); ++rep_) { if (rep_) __syncthreads(); Frame P = phase_frame(F); norm_moe_phase(P); } SEAM(14);
            if (IN(15)) for (int rep_ = 0; rep_ < NREP(15); ++rep_) { if (rep_) __syncthreads(); Frame P = phase_frame(F); moe_route_phase(P); } SEAM(15);
#pragma unroll 1
            for (int s = 0; s < 2; ++s) {
                LAS int* texp = (LAS int*)(F.lds + AUX_TAB);
                if (IN(16 + 2 * s) || IN(17 + 2 * s)) {
                    Frame P = phase_frame(F);
                    const int* meta = (const int*)(P.ws + WS_META) + s * 256;
                    __syncthreads();
                    if (P.tid < 256) texp[P.tid] = ld_i32_coherent(meta + P.tid);
                    __syncthreads();
                }
                if (IN(16 + 2 * s)) for (int rep_ = 0; rep_ < NREP(16 + 2 * s); ++rep_) { if (rep_) __syncthreads();
                    Frame P = phase_frame(F);
                    const int* rowmap = (const int*)(P.ws + WS_ROWMAP) + (size_t)s * MOE_ROWS;
                    const int NT = __builtin_amdgcn_readfirstlane(texp[0]);
                    pg8::MoeOrder S{NT, 28, P.G, P.bid, (const LAS int*)(texp + 1)};
                    pg8::EpiSwiglu<true> E{(pg8::bf16_t*)(P.ws + WS_P), DFE, 28, (const float*)(P.ws + WS_PROW) + (size_t)s * MOE_ROWS};
                    pg8::gemm_phase<pg8::EpiSwiglu<true>, pg8::MoeOrder, pg8::RowsGather, true>(GLDS(P), P.tid, WSB(P, WS_U), WSB(P, WS_MGU), DM, S, E, pg8::RowsGather{rowmap, NCTX});
                } SEAM(16 + 2 * s);
                if (IN(17 + 2 * s)) {
                    Frame P = phase_frame(F);
                    const int* rowmap = (const int*)(P.ws + WS_ROWMAP) + (size_t)s * MOE_ROWS;
                    const float* modlat = (const float*)(P.ws + WS_MODLAT) + (size_t)16 * 6144;
                    const int NT = __builtin_amdgcn_readfirstlane(texp[0]);
                    pg8::MoeOrder S{NT, 4, P.G, P.bid, (const LAS int*)(texp + 1)};
                    pg8::EpiMoeScatter E{rowmap, P.out, modlat + 5 * DM, 4};
                    pg8::gemm_phase<pg8::EpiMoeScatter, pg8::MoeOrder, pg8::RowsLinear, true>(GLDS(P), P.tid, WSB(P, WS_P), WSB(P, WS_MD), DFE, S, E, pg8::RowsLinear{});
                } SEAM(17 + 2 * s);
            }
        }
    }
    if (IN(PH_FINAL)) { Frame P = phase_frame(F); final_phase(P); }
#undef IN
#undef SEAM
}

extern "C" void kernel_launch(void* const* d_in, const int* in_sizes, int n_in, void* d_out, int out_size, void* d_ws, size_t ws_size, hipStream_t stream) {
    static int grid = 0;
    if (grid == 0) {
        if (n_in != 26 || in_sizes[0] != NLAT * DM || out_size != NLAT * DM || ws_size < WS_END) {
            fprintf(stderr, "kernel_launch: unexpected shapes (n_in %d, in0 %d, out %d, ws %zu, need %zu); nothing launched\n", n_in, n_in > 0 ? in_sizes[0] : -1, out_size, ws_size, (size_t)WS_END); grid = -1; return; }
        int dev = 0, cus = 0, per_cu = 0;
        if (hipGetDevice(&dev) != hipSuccess || hipDeviceGetAttribute(&cus, hipDeviceAttributeMultiprocessorCount, dev) != hipSuccess) { grid = -1; return; }
        if (hipFuncSetAttribute((const void*)fwd_kernel, hipFuncAttributeMaxDynamicSharedMemorySize, LDS_BYTES) != hipSuccess) { fprintf(stderr, "kernel_launch: hipFuncSetAttribute failed\n"); grid = -1; return; }
        if (hipOccupancyMaxActiveBlocksPerMultiprocessor(&per_cu, (const void*)fwd_kernel, 512, LDS_BYTES) != hipSuccess || per_cu < 1)
            fprintf(stderr, "kernel_launch: note: occupancy query reports %d workgroups per CU\n", per_cu);
        (void)hipGetLastError();
        grid = cus;
    }
    if (grid < 0) return;
    if (hipMemsetAsync((char*)d_ws + WS_CTL, 0, CTL_ZERO_BYTES, stream) != hipSuccess) return;
    Params p{};
    for (int i = 0; i < 26; ++i) p.in[i] = (const float*)d_in[i];
    p.out = (float*)d_out; p.ws = (unsigned char*)d_ws;
#if MK_PER_PHASE
    for (int ph = 0; ph < N_PHASES; ++ph) { p.ph_lo = ph; p.ph_hi = ph + 1; hipLaunchKernelGGL(fwd_kernel, dim3(grid), dim3(512), LDS_BYTES, stream, p); }
#else
    p.ph_lo = 0; p.ph_hi = N_PHASES;
    hipLaunchKernelGGL(fwd_kernel, dim3(grid), dim3(512), LDS_BYTES, stream, p);
#endif
}
```

```cpp
#include <hip/hip_runtime.h>
#include <cstdio>
#include <cstdint>

#ifndef MK_PER_PHASE
#define MK_PER_PHASE 0
#endif

#define LAS __attribute__((address_space(3)))
#define GAS __attribute__((address_space(1)))
#define DI __device__ __forceinline__
typedef unsigned short bf16;
typedef short bf16x8 __attribute__((ext_vector_type(8)));
typedef short s16x4 __attribute__((ext_vector_type(4)));
typedef float f32x4 __attribute__((ext_vector_type(4)));
typedef float f32x16 __attribute__((ext_vector_type(16)));
typedef unsigned u32x4 __attribute__((ext_vector_type(4)));
typedef unsigned u32x2 __attribute__((ext_vector_type(2)));
typedef float f32x2_t __attribute__((ext_vector_type(2)));
typedef __bf16 bf16x2_t __attribute__((ext_vector_type(2)));
typedef short v4i16_t __attribute__((ext_vector_type(4)));

constexpr int DM = 1024, NB = 16, SEQ = 2048, CTXL = 256, GW = 64;
constexpr int NLAT = NB * SEQ, NCTX = NB * CTXL, NTOK = NLAT + NCTX;
constexpr int INW = 3072, DFF = 2816, NE = 8, DFE = 3584;
constexpr int C_NAQ = 0, C_NAK = 512, C_NAV = 1024, C_CONV = 1536, C_RQ = 2048, C_RK = 2176, C_RV = 2304, C_GF = 2560, C_GB = 2816;
constexpr float EPS = 1e-6f;
constexpr float LOG2E = 1.4426950408889634f;

constexpr size_t MiB = 1u << 20;
constexpr size_t WS_CTL = 0, CTL_ZERO_BYTES = 64 * 1024;
constexpr size_t WS_MODLAT = 1 * MiB;
constexpr size_t WS_MODCTX = WS_MODLAT + 2 * 16 * 6144 * 4;
constexpr size_t WS_ROPE = WS_MODCTX + 2 * 6144 * 4;
constexpr size_t WS_PTOK = 2 * MiB;
constexpr size_t WS_SEGCNT = WS_PTOK + 32768 * 2 * 4;
constexpr size_t WS_META = WS_SEGCNT + 256 * 2 * 8 * 4;
constexpr size_t WS_SEGLIST = 3 * MiB;
constexpr size_t WS_ROWMAP = 5 * MiB;
constexpr int MOE_ROWS = 34816;
constexpr size_t WS_PROW = WS_ROWMAP + 512 * 1024;
constexpr size_t WS_SUMLAT = 6 * MiB;
constexpr size_t WS_SUMCTX = 22 * MiB;
constexpr size_t WS_WIN = 24 * MiB;
constexpr size_t WS_WOUT = WS_WIN + (size_t)2 * 3072 * 1024 * 2;
constexpr size_t WS_WGU = WS_WOUT + (size_t)2 * 1024 * 1024 * 2;
constexpr size_t WS_WD = WS_WGU + (size_t)5632 * 1024 * 2;
constexpr size_t WS_MGU = WS_WD + (size_t)1024 * 2816 * 2;
constexpr size_t WS_MD = WS_MGU + (size_t)8 * 7168 * 1024 * 2;
constexpr size_t WS_HCTX = WS_MD + (size_t)8 * 1024 * 3584 * 2;
constexpr size_t WS_U = WS_HCTX + (size_t)NCTX * DM * 4;
constexpr size_t WS_P = WS_U + (size_t)NTOK * DM * 2;
constexpr size_t WS_END = WS_P + (size_t)MOE_ROWS * DFE * 2;
static_assert((size_t)NTOK * INW * 2 <= (size_t)MOE_ROWS * DFE * 2, "P region");
static_assert(WS_WIN % 256 == 0 && WS_WOUT % 256 == 0 && WS_WGU % 256 == 0 && WS_WD % 256 == 0 && WS_MGU % 256 == 0 && WS_MD % 256 == 0 && WS_HCTX % 256 == 0 && WS_U % 256 == 0 && WS_P % 256 == 0, "align");

constexpr int RING_BYTES = 131072;
constexpr int AUX_OFF = RING_BYTES;
constexpr int AUX_TAB = AUX_OFF + 1024;
constexpr int LDS_BYTES = 147456;

#ifndef MOE_FP8
#define MOE_FP8 1
#endif
constexpr int SCL_U = 0x7c7c7c7c, SCL_WGU = 0x79797979, SCL_H = 0x7c7c7c7c, SCL_WD = 0x78787878;
constexpr float QS_U = 8.0f, QS_WGU = 64.0f, QS_H = 8.0f, QS_WD = 128.0f;
DI unsigned pk2(float lo, float hi) { f32x2_t v = {lo, hi}; bf16x2_t b = __builtin_convertvector(v, bf16x2_t); return __builtin_bit_cast(unsigned, b); }
DI float clamp448(float x) { return __builtin_fminf(__builtin_fmaxf(x, -448.0f), 448.0f); }
DI unsigned pk4_fp8(float a, float b, float c, float d) { int w = 0; w = __builtin_amdgcn_cvt_pk_fp8_f32(clamp448(a), clamp448(b), w, false); w = __builtin_amdgcn_cvt_pk_fp8_f32(clamp448(c), clamp448(d), w, true); return (unsigned)w; }
DI float bflo(unsigned u) { return __uint_as_float(u << 16); }
DI float bfhi(unsigned u) { return __uint_as_float(u & 0xffff0000u); }
DI float wave_sum(float v) {
#pragma unroll
    for (int o = 1; o < 64; o <<= 1) v += __shfl_xor(v, o);
    return v;
}
DI float fast_exp2(float x) { return __builtin_amdgcn_exp2f(x); }
DI float fast_rcp(float x) { return __builtin_amdgcn_rcpf(x); }
DI float sigmoidf_(float x) { return fast_rcp(1.0f + fast_exp2(-x * LOG2E)); }
DI int crow(int reg, int h) { return (reg & 3) + 8 * (reg >> 2) + 4 * h; }
#define MFMA32(a, b, c) __builtin_amdgcn_mfma_f32_32x32x16_bf16((a), (b), (c), 0, 0, 0)
DI s16x4 trread(LAS const unsigned char* p) { return __builtin_bit_cast(s16x4, __builtin_amdgcn_ds_read_tr16_b64_v4i16((LAS v4i16_t*)p)); }
DI int ld_i32_coherent(const int* p) { return (int)__hip_atomic_load((const unsigned*)p, __ATOMIC_RELAXED, __HIP_MEMORY_SCOPE_AGENT); }

namespace pg8 {
#define PG8_LAS __attribute__((address_space(3)))
typedef unsigned short bf16_t;
constexpr int BM = 256, BK = 64, HALF = 128, HTB = HALF * BK * 2, STAGE_BYTES = 8 * HTB, NXCD = 8, WGM = 8;
__host__ __device__ __forceinline__ int lds_byte(int r, int c) { const int st = (r >> 4) * 2 + (c >> 5), rr = r & 15, cc = c & 31, ob = rr * 64 + cc * 2; return st * 1024 + (ob ^ (((ob >> 9) & 1) << 5)); }
__host__ __device__ __forceinline__ void stage_rc(int b, int& R, int& C) { const int st = b / 1024, sb = b % 1024, swz = sb ^ (((sb >> 9) & 1) << 5); R = (st >> 1) * 16 + swz / 64; C = (st & 1) * 32 + (swz % 64) / 2; }
__host__ __device__ __forceinline__ int perm32(int rho) { const int n = rho >> 4, i = rho & 15; return 8 * (i >> 2) + 4 * n + (i & 3); }
struct Unit { int pm, pn; };
struct StaticOrder {
    int nM, nN, nwg, G, c;
    __device__ void init(int M, int N, int G_, int c_) { nM = M / BM; nN = N / BM; nwg = nM * nN; G = G_; c = c_; }
    __device__ bool next(int i, Unit& u) const {
        const long L = (long)i * G + c; if (L >= nwg) return false;
        int wgid = (int)L; { const int q = nwg / NXCD, r = nwg % NXCD, xcd = wgid % NXCD, off = wgid / NXCD; wgid = (xcd < r ? xcd * (q + 1) : r * (q + 1) + (xcd - r) * q) + off; }
        const int nig = WGM * nN, gid = wgid / nig, fm = gid * WGM, gsz = (nM - fm) < WGM ? (nM - fm) : WGM;
        u.pm = fm + ((wgid % nig) % gsz); u.pn = (wgid % nig) / gsz; return true;
    }
};
struct RowsLinear { static constexpr bool GATHER = false; };
struct RowsLinearOff {
    static constexpr bool GATHER = true;
    __device__ __forceinline__ void offs(const Unit& u, const int (&R)[2], const int (&C)[2], int pitch, unsigned (&o)[2][2]) const {
#pragma unroll
        for (int h = 0; h < 2; ++h)
#pragma unroll
            for (int i = 0; i < 2; ++i) { o[h][i] = (unsigned)(u.pm * BM + h * HALF + R[i]) * (unsigned)pitch + (unsigned)C[i] * 2u; asm volatile("" : "+v"(o[h][i])); }
    }
};
struct RowsGather {
    static constexpr bool GATHER = true;
    const int* rowmap; int row_add;
    __device__ __forceinline__ void offs(const Unit& u, const int (&R)[2], const int (&C)[2], int pitch, unsigned (&o)[2][2]) const {
#pragma unroll
        for (int h = 0; h < 2; ++h)
#pragma unroll
            for (int i = 0; i < 2; ++i) { int t = rowmap[u.pm * BM + h * HALF + R[i]]; t = t < 0 ? 0 : t;
                o[h][i] = (unsigned)((size_t)(t + row_add) * (size_t)pitch + (size_t)C[i] * 2u); }
#pragma unroll
        for (int h = 0; h < 2; ++h)
#pragma unroll
            for (int i = 0; i < 2; ++i) asm volatile("" : "+v"(o[h][i]));
    }
};

typedef int i32x8 __attribute__((ext_vector_type(8)));
typedef int i32x4v __attribute__((ext_vector_type(4)));
template <class Epi, class Sched, class ARows, bool ALIGN_EPI, bool FP8 = false>
__device__ __forceinline__ void gemm_phase(PG8_LAS unsigned char* lds, int tid, const void* A, const void* Bt, int pitch, const Sched& S, const Epi& E, const ARows& AR, int sclA = 0x7f7f7f7f, int sclB = 0x7f7f7f7f) {
    constexpr bool GATHER = ARows::GATHER;
    const int wid = __builtin_amdgcn_readfirstlane(tid >> 6), lane = tid & 63, wr = wid >> 2, wc = wid & 3, fr = lane & 15, fq = lane >> 4;
    const int nt = pitch / (BK * 2);
    int RA[2], CA[2]; unsigned voffA[2], voffB[2];
#pragma unroll
    for (int i = 0; i < 2; ++i) { int R, C; stage_rc(tid * 16 + i * 8192, R, C); const int Rb = Epi::PERM ? ((R & ~31) + perm32(R & 31)) : R;
        RA[i] = R; CA[i] = C; voffA[i] = (unsigned)(R * pitch + C * 2); voffB[i] = (unsigned)(Rb * pitch + C * 2); }
#pragma unroll
    for (int i = 0; i < 2; ++i) { asm volatile("" : "+v"(voffA[i])); asm volatile("" : "+v"(voffB[i])); }
    const size_t kstep = (size_t)(BK * 2);
    const size_t hstep = (size_t)HALF * pitch;
    const size_t tstep = 2 * hstep;
    const unsigned ldsw = (unsigned)wid * 1024u;
    const int aoff = lds_byte(wr * 64 + fr, fq * 8), boff = lds_byte(wc * 32 + fr, fq * 8);
    const char* Ab = (const char*)A;
#define PG8_SA(b, h) (((b) * 2 + (h)) * HTB)
#define PG8_SB(b, h) ((4 + (b) * 2 + (h)) * HTB)
#define PG8_STAGE(bufoff, gbase, voff) do { _Pragma("unroll") for (int _i = 0; _i < 2; ++_i) \
        __builtin_amdgcn_global_load_lds((const unsigned*)((const char*)(gbase) + (voff)[_i]), (PG8_LAS unsigned*)(lds + (bufoff) + ldsw + _i * 8192), 16, 0, 0); } while (0)
#define PG8_STAGEA(bufoff, h, plin, kb) do { if constexpr (GATHER) PG8_STAGE(bufoff, Ab + (kb), curA[h]); else PG8_STAGE(bufoff, (plin) + (h) * hstep, voffA); } while (0)
#define PG8_LDA(dst, b, h) do { _Pragma("unroll") for (int m = 0; m < 4; ++m) _Pragma("unroll") for (int k = 0; k < 2; ++k) dst[m][k] = *(const PG8_LAS bf16x8*)(lds + PG8_SA(b, h) + aoff + m * 2048 + k * 1024); } while (0)
#define PG8_LDB(dst, b, h) do { _Pragma("unroll") for (int n = 0; n < 2; ++n) _Pragma("unroll") for (int k = 0; k < 2; ++k) dst[n][k] = *(const PG8_LAS bf16x8*)(lds + PG8_SB(b, h) + boff + n * 2048 + k * 1024); } while (0)
#define PG8_CAT(x0, x1) __builtin_shufflevector(__builtin_bit_cast(i32x4v, x0), __builtin_bit_cast(i32x4v, x1), 0, 1, 2, 3, 4, 5, 6, 7)
#define PG8_MMA(ai, bj, At, Bt_) do { __builtin_amdgcn_s_setprio(1); \
        if constexpr (FP8) { _Pragma("unroll") for (int m = 0; m < 4; ++m) _Pragma("unroll") for (int n = 0; n < 2; ++n) \
            acc[ai][bj][m][n] = __builtin_amdgcn_mfma_scale_f32_16x16x128_f8f6f4(PG8_CAT(Bt_[n][0], Bt_[n][1]), PG8_CAT(At[m][0], At[m][1]), acc[ai][bj][m][n], 0, 0, 0, sclB, 0, sclA); } \
        else { _Pragma("unroll") for (int m = 0; m < 4; ++m) _Pragma("unroll") for (int n = 0; n < 2; ++n) _Pragma("unroll") for (int k = 0; k < 2; ++k) \
            acc[ai][bj][m][n] = __builtin_amdgcn_mfma_f32_16x16x32_bf16(Bt_[n][k], At[m][k], acc[ai][bj][m][n], 0, 0, 0); } \
        __builtin_amdgcn_s_setprio(0); } while (0)
#define PG8_WAIT_V(n) asm volatile("s_waitcnt vmcnt(" #n ")" ::: "memory")
#define PG8_WAIT_L(n) asm volatile("s_waitcnt lgkmcnt(" #n ")" ::: "memory")
#define PG8_BAR __builtin_amdgcn_s_barrier()
#define PG8_SCHED __builtin_amdgcn_sched_barrier(0)
    Unit cur, nxt; int ui = 0;
    if (!S.next(0, cur)) return;
    f32x4 acc[2][2][4][2];
#pragma unroll
    for (int a = 0; a < 2; ++a)
#pragma unroll
        for (int b = 0; b < 2; ++b)
#pragma unroll
            for (int m = 0; m < 4; ++m)
#pragma unroll
                for (int n = 0; n < 2; ++n) acc[a][b][m][n] = (f32x4){0.f, 0.f, 0.f, 0.f};
    bf16x8 At[4][2], B0[2][2], B1[2][2];
    unsigned curA[2][2] = {{0u, 0u}, {0u, 0u}}, nxtA[2][2] = {{0u, 0u}, {0u, 0u}};
    if constexpr (GATHER) AR.offs(cur, RA, CA, pitch, curA);
    const char* cA = GATHER ? Ab : Ab + (size_t)cur.pm * tstep;
    const char* cB = (const char*)Bt + (size_t)cur.pn * tstep;
    PG8_STAGE(PG8_SB(0, 0), cB, voffB); PG8_STAGE(PG8_SB(0, 1), cB + hstep, voffB); PG8_STAGEA(PG8_SA(0, 0), 0, cA, 0); PG8_STAGEA(PG8_SA(0, 1), 1, cA, 0);
    if (wr == 1) PG8_BAR;
    PG8_WAIT_V(2); PG8_BAR;
    PG8_STAGE(PG8_SB(1, 0), cB + kstep, voffB); PG8_STAGEA(PG8_SA(1, 0), 0, cA + kstep, kstep); PG8_STAGE(PG8_SB(1, 1), cB + hstep + kstep, voffB);
    PG8_WAIT_V(6); PG8_BAR;
    for (;;) {
        const bool has_next = S.next(ui + 1, nxt);
        if constexpr (GATHER) {
            if (has_next) AR.offs(nxt, RA, CA, pitch, nxtA);
            else {
#pragma unroll
                for (int h = 0; h < 2; ++h)
#pragma unroll
                    for (int i = 0; i < 2; ++i) nxtA[h][i] = curA[h][i];
            }
        }
        const char* nA = GATHER ? Ab : (has_next ? Ab + (size_t)nxt.pm * tstep : cA);
        const char* nB = has_next ? (const char*)Bt + (size_t)nxt.pn * tstep : cB;
        for (int t = 0; t < nt; t += 2) {
            const bool last = (t == nt - 2);
            const size_t k1 = (size_t)(t + 1) * kstep, k2 = last ? 0 : (size_t)(t + 2) * kstep, k3 = k2 + kstep;
            const char* a1 = cA + k1;
            const char* a2 = last ? nA : cA + k2; const char* b2 = last ? nB : cB + k2;
            const char* a3 = a2 + kstep; const char* b3 = b2 + kstep;
            PG8_LDB(B0, 0, 0); PG8_LDB(B1, 0, 1); PG8_SCHED; PG8_LDA(At, 0, 0); PG8_STAGEA(PG8_SA(1, 1), 1, a1, k1);
            if constexpr (GATHER) { if (last) {
#pragma unroll
                for (int h = 0; h < 2; ++h)
#pragma unroll
                    for (int i = 0; i < 2; ++i) curA[h][i] = nxtA[h][i]; } }
            PG8_WAIT_V(8); PG8_WAIT_L(0); PG8_BAR; PG8_MMA(0, 0, At, B0); PG8_MMA(0, 1, At, B1); PG8_BAR; PG8_SCHED;
            PG8_LDA(At, 0, 1); PG8_STAGE(PG8_SB(0, 0), b2, voffB); PG8_STAGE(PG8_SB(0, 1), b2 + hstep, voffB); PG8_STAGEA(PG8_SA(0, 0), 0, a2, k2);
            PG8_WAIT_V(8); PG8_WAIT_L(0); PG8_BAR; PG8_MMA(1, 0, At, B0); PG8_MMA(1, 1, At, B1); PG8_BAR; PG8_SCHED;
            PG8_LDB(B0, 1, 0); PG8_LDB(B1, 1, 1); PG8_SCHED; PG8_LDA(At, 1, 0); PG8_STAGEA(PG8_SA(0, 1), 1, a2, k2);
            PG8_WAIT_V(8); PG8_WAIT_L(0); PG8_BAR; PG8_MMA(0, 0, At, B0); PG8_MMA(0, 1, At, B1); PG8_BAR; PG8_SCHED;
            PG8_LDA(At, 1, 1); PG8_STAGE(PG8_SB(1, 0), b3, voffB); PG8_STAGE(PG8_SB(1, 1), b3 + hstep, voffB); PG8_STAGEA(PG8_SA(1, 0), 0, a3, k3);
            PG8_WAIT_V(8); PG8_WAIT_L(0); PG8_BAR; PG8_MMA(1, 0, At, B0); PG8_MMA(1, 1, At, B1); PG8_BAR; PG8_SCHED;
        }
        if constexpr (ALIGN_EPI) { if (wr == 0) PG8_BAR; }
        E(acc, cur, wr, wc, fr, fq);
        if (!has_next) break;
#pragma unroll
        for (int a = 0; a < 2; ++a)
#pragma unroll
            for (int b = 0; b < 2; ++b)
#pragma unroll
                for (int m = 0; m < 4; ++m)
#pragma unroll
                    for (int n = 0; n < 2; ++n) acc[a][b][m][n] = (f32x4){0.f, 0.f, 0.f, 0.f};
        cur = nxt; cA = nA; cB = nB; ++ui;
        if constexpr (ALIGN_EPI) { if (wr == 1) PG8_BAR; }
    }
    PG8_WAIT_V(0);
    if constexpr (!ALIGN_EPI) { if (wr == 0) PG8_BAR; }
    PG8_BAR;
#undef PG8_SA
#undef PG8_SB
#undef PG8_STAGE
#undef PG8_STAGEA
#undef PG8_LDA
#undef PG8_LDB
#undef PG8_MMA
#undef PG8_CAT
#undef PG8_WAIT_V
#undef PG8_WAIT_L
#undef PG8_BAR
#undef PG8_SCHED
}

#define PG8_OPAQUE(x) asm volatile("" : "+v"(x))
struct EpiStoreBf16 {
    static constexpr bool PERM = true;
    bf16_t* O; int ldc;
    __device__ __forceinline__ void operator()(const f32x4 (&acc)[2][2][4][2], const Unit& u, int wr, int wc, int fr, int fq) const {
        char* base = (char*)(O + (size_t)(u.pm * BM) * ldc + u.pn * BM);
        unsigned lb = (unsigned)((wr * 64 + fr) * ldc + wc * 32 + 8 * fq) * 2u; PG8_OPAQUE(lb);
        const unsigned rstep = (unsigned)ldc * 32u;
#pragma unroll
        for (int ai = 0; ai < 2; ++ai)
#pragma unroll
            for (int m = 0; m < 4; ++m) { const unsigned ro = lb + (unsigned)(ai * 8 + m) * rstep;
#pragma unroll
                for (int bj = 0; bj < 2; ++bj) { const f32x4 v0 = acc[ai][bj][m][0], v1 = acc[ai][bj][m][1];
                    u32x4 w; w.x = pk2(v0[0], v0[1]); w.y = pk2(v0[2], v0[3]); w.z = pk2(v1[0], v1[1]); w.w = pk2(v1[2], v1[3]);
                    *(u32x4*)(base + ro + bj * (HALF * 2)) = w; } }
    }
};
struct EpiResGate {
    static constexpr bool PERM = false;
    const float* src_ctx; const float* src_lat; float* dst_ctx; float* dst_lat; const float* gate_lat; const float* gate_ctx; int row_base;
    __device__ __forceinline__ void operator()(const f32x4 (&acc)[2][2][4][2], const Unit& u, int wr, int wc, int fr, int fq) const {
        const int rowu = row_base + u.pm * BM; const bool isctx = rowu < NCTX;
        const char* src = (const char*)(isctx ? src_ctx + (size_t)rowu * DM : src_lat + (size_t)(rowu - NCTX) * DM) + u.pn * (BM * 4);
        char* dst = (char*)(isctx ? dst_ctx + (size_t)rowu * DM : dst_lat + (size_t)(rowu - NCTX) * DM) + u.pn * (BM * 4);
        const float* gate = (isctx ? gate_ctx : gate_lat + (size_t)((rowu - NCTX) / SEQ) * 6144) + u.pn * BM;
        const int cl = wc * 32 + 4 * fq;
        f32x4 sc[2][2][4][2];
#pragma unroll
        for (int bj = 0; bj < 2; ++bj)
#pragma unroll
            for (int n = 0; n < 2; ++n) { const f32x4 gv = *(const f32x4*)(gate + cl + bj * HALF + n * 16);
#pragma unroll
                for (int ai = 0; ai < 2; ++ai)
#pragma unroll
                    for (int m = 0; m < 4; ++m) sc[ai][bj][m][n] = acc[ai][bj][m][n] * gv; }
        unsigned lb = (unsigned)((wr * 64 + fr) * DM + cl) * 4u; PG8_OPAQUE(lb);
#pragma unroll
        for (int ai = 0; ai < 2; ++ai)
#pragma unroll
            for (int m = 0; m < 4; ++m) { const unsigned ro = lb + (unsigned)(ai * 8 + m) * (16u * DM * 4u);
#pragma unroll
                for (int bj = 0; bj < 2; ++bj)
#pragma unroll
                    for (int n = 0; n < 2; ++n) { const unsigned o = ro + (unsigned)(bj * HALF + n * 16) * 4u; const f32x4 s = *(const f32x4*)(src + o);
                        *(f32x4*)(dst + o) = s + sc[ai][bj][m][n]; }
                asm volatile("" ::: "memory"); }
    }
};
template <bool MOE> struct EpiSwiglu {
    static constexpr bool PERM = true;
    static constexpr bool OUT8 = MOE && (MOE_FP8 != 0);
    bf16_t* O; int ldc; int ncol; const float* prow;
    __device__ __forceinline__ void operator()(const f32x4 (&acc)[2][2][4][2], const Unit& u, int wr, int wc, int fr, int fq) const {
        const int pnl = MOE ? (u.pn % ncol) : u.pn;
        constexpr int ES = OUT8 ? 1 : 2;
        char* base = (char*)O + ((size_t)(u.pm * BM) * ldc + pnl * HALF) * ES;
        unsigned lb = (unsigned)((wr * 64 + fr) * ldc + wc * 32 + 8 * fq) * ES; PG8_OPAQUE(lb);
        const unsigned rstep = (unsigned)ldc * 16u * ES;
        const float* pr = MOE ? prow + u.pm * BM : nullptr;
        unsigned pl = (unsigned)(wr * 64 + fr) * 4u; PG8_OPAQUE(pl);
#pragma unroll
        for (int ai = 0; ai < 2; ++ai)
#pragma unroll
            for (int m = 0; m < 4; ++m) {
                float pw = 1.0f; if (MOE) pw = *(const float*)((const char*)pr + pl + (unsigned)(ai * 8 + m) * 64u);
                if (OUT8) pw *= QS_H;
                float hv[8];
#pragma unroll
                for (int n = 0; n < 2; ++n)
#pragma unroll
                    for (int j = 0; j < 4; ++j) { const float g = acc[ai][0][m][n][j], up = acc[ai][1][m][n][j]; hv[n * 4 + j] = g * sigmoidf_(g) * up * pw; }
                if constexpr (OUT8) { u32x2 w; w.x = pk4_fp8(hv[0], hv[1], hv[2], hv[3]); w.y = pk4_fp8(hv[4], hv[5], hv[6], hv[7]);
                    *(u32x2*)(base + lb + (unsigned)(ai * 8 + m) * rstep) = w; }
                else { u32x4 w; w.x = pk2(hv[0], hv[1]); w.y = pk2(hv[2], hv[3]); w.z = pk2(hv[4], hv[5]); w.w = pk2(hv[6], hv[7]);
                    *(u32x4*)(base + lb + (unsigned)(ai * 8 + m) * rstep) = w; } }
    }
};
struct EpiMoeScatter {
    static constexpr bool PERM = false;
    const int* rowmap; float* hlat; const float* gate_lat; int ncol;
    __device__ __forceinline__ void operator()(const f32x4 (&acc)[2][2][4][2], const Unit& u, int wr, int wc, int fr, int fq) const {
        const int pnl = u.pn % ncol;
        const int* rm = rowmap + u.pm * BM;
        char* hb = (char*)hlat + pnl * (BM * 4); const char* gb = (const char*)gate_lat + pnl * (BM * 4);
        unsigned pl = (unsigned)(wr * 64 + fr) * 4u; PG8_OPAQUE(pl);
        unsigned cb = (unsigned)(wc * 32 + 4 * fq) * 4u; PG8_OPAQUE(cb);
#pragma unroll
        for (int ai = 0; ai < 2; ++ai)
#pragma unroll
            for (int m = 0; m < 4; ++m) { const int tok = *(const int*)((const char*)rm + pl + (unsigned)(ai * 8 + m) * 64u);
                if (tok >= 0) { const unsigned ro = (unsigned)tok * (DM * 4u) + cb, go = ((unsigned)tok >> 11) * (6144u * 4u) + cb;
#pragma unroll
                    for (int bj = 0; bj < 2; ++bj)
#pragma unroll
                        for (int n = 0; n < 2; ++n) { const unsigned o = (unsigned)(bj * HALF + n * 16) * 4u; const f32x4 sv = *(const f32x4*)(hb + ro + o); const f32x4 gv = *(const f32x4*)(gb + go + o);
                            *(f32x4*)(hb + ro + o) = sv + gv * acc[ai][bj][m][n]; } }
                asm volatile("" ::: "memory"); }
    }
};
struct MoeOrder {
    int NT, ncol, G, c; const PG8_LAS int* texp;
    __device__ bool next(int i, Unit& u) const {
        const long L = (long)i * G + c; if (L >= (long)NT * ncol) return false;
        const int t = (int)(L / ncol), pnl = (int)(L % ncol);
        const int e = __builtin_amdgcn_readfirstlane(texp[t]);
        u.pm = t; u.pn = e * ncol + pnl; return true;
    }
};
}

#define XB_TMO      128
#define XB_XCNT(j)  (256  + 64 * (j))
#define XB_XSUB(j)  (1280 + 64 * (j))
#define XB_XGEN(j)  (2304 + 64 * (j))
#define XB_TOP      3328
#define XB_TOPGEN   3392
#define XCD_BAR_WORDS 3456
#define XB_SPIN_CAP (1u << 18)
DI unsigned xb_ld(unsigned* p)              { return __hip_atomic_load(p, __ATOMIC_RELAXED, __HIP_MEMORY_SCOPE_AGENT); }
DI unsigned xb_add(unsigned* p, unsigned v) { return __hip_atomic_fetch_add(p, v, __ATOMIC_RELAXED, __HIP_MEMORY_SCOPE_AGENT); }
DI unsigned xb_xcc_id() { return (unsigned)__builtin_amdgcn_s_getreg((3 << 11) | 20) & 0xFu; }
#define XB_SPIN(cond, bar) do { unsigned _sp = 0; while (cond) { __builtin_amdgcn_s_sleep(1); \
    if ((++_sp & 255u) == 0u) { if (xb_ld(&(bar)[XB_TMO])) break; if (_sp > XB_SPIN_CAP) { atomicAdd(&(bar)[XB_TMO], 1u); break; } } } } while (0)
struct XcdBarrier { unsigned* bar; unsigned x; volatile LAS unsigned* st; };
DI XcdBarrier xcd_barrier_post(unsigned* bar, volatile LAS unsigned* st) {
    XcdBarrier b; b.bar = bar; b.x = xb_xcc_id(); b.st = st;
    if (threadIdx.x == 0) (void)xb_add(&bar[XB_XCNT(b.x)], 1u);
    return b;
}
DI void xcd_barrier_complete(unsigned* bar, unsigned x, unsigned& nloc, unsigned& nx) {
    const unsigned G = gridDim.x * gridDim.y * gridDim.z;
    unsigned sum, cnt, mine, sp = 0u;
    for (;;) {
        sum = 0u; cnt = 0u; mine = 0u;
#pragma unroll
        for (unsigned j = 0; j < 16; ++j) { const unsigned c = xb_ld(&bar[XB_XCNT(j)]); sum += c; cnt += (c > 0u) ? 1u : 0u; mine = (j == x) ? c : mine; }
        if (sum == G) break;
        __builtin_amdgcn_s_sleep(1);
        if ((++sp & 255u) == 0u) { if (xb_ld(&bar[XB_TMO])) break; if (sp > XB_SPIN_CAP) { atomicAdd(&bar[XB_TMO], 1u); break; } }
    }
    nloc = mine > 0u ? mine : 1u; nx = cnt > 0u ? cnt : 1u;
}
DI void xcd_barrier(const XcdBarrier& b) {
    asm volatile("s_waitcnt vmcnt(0)" ::: "memory");
    __syncthreads();
    if (threadIdx.x == 0) {
        unsigned* bar = b.bar;
        __builtin_amdgcn_s_waitcnt(0);
        unsigned nloc = b.st[0], nx = b.st[1];
        if (nloc == 0u) { xcd_barrier_complete(bar, b.x, nloc, nx); b.st[0] = nloc; b.st[1] = nx; }
        const unsigned old = xb_add(&bar[XB_XSUB(b.x)], 1u);
        const unsigned gen = old / nloc;
        if (old + 1u == (gen + 1u) * nloc) {
            __builtin_amdgcn_fence(__ATOMIC_RELEASE, "agent");
            asm volatile("s_waitcnt vmcnt(0)" ::: "memory");
            const unsigned og = xb_add(&bar[XB_TOP], 1u);
            const unsigned tg = og / nx;
            if (og + 1u == (tg + 1u) * nx) xb_add(&bar[XB_TOPGEN], 1u);
            else XB_SPIN(xb_ld(&bar[XB_TOPGEN]) == tg, bar);
            __builtin_amdgcn_fence(__ATOMIC_ACQUIRE, "agent");
            xb_add(&bar[XB_XGEN(b.x)], 1u);
            asm volatile("s_waitcnt vmcnt(0)" ::: "memory");
        } else {
            XB_SPIN(xb_ld(&bar[XB_XGEN(b.x)]) == gen, bar);
            __builtin_amdgcn_fence(__ATOMIC_ACQUIRE, "agent");
            asm volatile("s_waitcnt vmcnt(0)" ::: "memory");
        }
    }
    __syncthreads();
}

struct Params { const float* in[26]; float* out; unsigned char* ws; int ph_lo, ph_hi, pad0, pad1; };
enum { I_X = 0, I_C, I_CTX, I_CCTX, I_WMOD, I_BMOD, I_N1W, I_N2W, I_WIN, I_WOUT, I_RPB, I_CONVW, I_CONVB, I_CLNW, I_CLNB, I_RDEC, I_RGNW,
       I_FG, I_FU, I_FD, I_MR, I_MRB, I_MG, I_MU, I_MDN, I_FNW };
constexpr int PH_P0 = 0, PH_FINAL = 20, N_PHASES = 21;

typedef __attribute__((address_space(4))) const unsigned char* karg_t;
struct KIn {
    karg_t ka;
    DI const float* operator[](int k) const { return *(const float* __attribute__((address_space(4))) const*)(ka + 8 * k); }
};
struct Frame {
    LAS unsigned char* lds;
    int tid, lane, wave, G, bid, vb;
    KIn in; float* out; unsigned char* ws;
};
DI Frame phase_frame(const Frame& F0) {
    Frame F; karg_t ka = F0.in.ka; asm volatile("" : "+s"(ka)); F.in.ka = ka;
    F.out = *(float* __attribute__((address_space(4))) const*)(ka + 208);
    F.ws = *(unsigned char* __attribute__((address_space(4))) const*)(ka + 216);
    int tid = F0.tid, G = F0.G, bid = F0.bid; unsigned ldsb = (unsigned)(size_t)F0.lds;
    asm volatile("" : "+v"(tid)); asm volatile("" : "+s"(G)); asm volatile("" : "+s"(bid)); asm volatile("" : "+s"(ldsb));
    F.tid = tid; F.lane = tid & 63; F.wave = __builtin_amdgcn_readfirstlane(tid >> 6); F.G = G; F.bid = bid; F.lds = (LAS unsigned char*)(size_t)ldsb;
    F.vb = (G % 8 == 0) ? (bid % 8) * (G / 8) + bid / 8 : bid;
    return F;
}

DI void p0_transpose_item(const float* W, int K, int N, bf16* WT, int k0, int n0, int dst_row0, LAS float* scr, int lane) {
#pragma unroll 8
    for (int i = 0; i < 32; ++i) { const int kk = 2 * i + (lane >> 5); scr[kk * 33 + (lane & 31)] = W[(size_t)(k0 + kk) * N + n0 + (lane & 31)]; }
    asm volatile("s_waitcnt lgkmcnt(0)" ::: "memory");
    const int c = lane & 7;
#pragma unroll
    for (int j = 0; j < 4; ++j) { const int n = (lane >> 3) + 8 * j; const LAS float* s = scr + (8 * c) * 33 + n;
        u32x4 o; o.x = pk2(s[0 * 33], s[1 * 33]); o.y = pk2(s[2 * 33], s[3 * 33]); o.z = pk2(s[4 * 33], s[5 * 33]); o.w = pk2(s[6 * 33], s[7 * 33]);
        *(u32x4*)(WT + (size_t)(dst_row0 + n) * K + k0 + 8 * c) = o; }
    asm volatile("s_waitcnt lgkmcnt(0)" ::: "memory");
}
DI void p0_convert_plain(Frame& F, const float* W, int K, int N, bf16* WT, int item, LAS float* scr) {
    const int nblk = N / 32, kb = item / nblk, nb = item % nblk;
    p0_transpose_item(W, K, N, WT, 64 * kb, 32 * nb, 32 * nb, scr, F.lane);
}
DI void p0_convert_gu(Frame& F, const float* W, int K, int N, bf16* WT, int item, int up, LAS float* scr) {
    const int nblk = N / 32, kb = item / nblk, nb = item % nblk, n0 = 32 * nb;
    p0_transpose_item(W, K, N, WT, 64 * kb, n0, 256 * (n0 / 128) + (n0 % 128) + (up ? 128 : 0), scr, F.lane);
}
DI void conv_item64(const float* W, int K, int N, bf16* WT, int k0, int n0, int dst_row0, LAS unsigned* scr, int lane) {
    const float* wp = W + (size_t)k0 * N + n0 + lane;
    float v[64];
#pragma unroll
    for (int i = 0; i < 64; ++i) v[i] = wp[(size_t)i * N];
#pragma unroll
    for (int i = 0; i < 32; ++i) scr[i * 65 + lane] = pk2(v[2 * i], v[2 * i + 1]);
    asm volatile("s_waitcnt lgkmcnt(0)" ::: "memory");
    const int c = lane & 7;
#pragma unroll
    for (int j = 0; j < 8; ++j) { const int n = (lane >> 3) + 8 * j; const LAS unsigned* sp = scr + (4 * c) * 65 + n;
        u32x4 o; o.x = sp[0]; o.y = sp[65]; o.z = sp[130]; o.w = sp[195];
        *(u32x4*)(WT + (size_t)(dst_row0 + n) * K + k0 + 8 * c) = o; }
    asm volatile("s_waitcnt lgkmcnt(0)" ::: "memory");
}
DI void conv_item64_fp8(const float* W, int K, int N, unsigned char* WT, int k0, int n0, int dst_row0, float qs, LAS unsigned* scr, int lane) {
    const float* wp = W + (size_t)k0 * N + n0 + lane;
    float v[64];
#pragma unroll
    for (int i = 0; i < 64; ++i) v[i] = wp[(size_t)i * N];
#pragma unroll
    for (int i = 0; i < 16; ++i) scr[i * 65 + lane] = pk4_fp8(v[4 * i] * qs, v[4 * i + 1] * qs, v[4 * i + 2] * qs, v[4 * i + 3] * qs);
    asm volatile("s_waitcnt lgkmcnt(0)" ::: "memory");
    const int c = lane & 3;
#pragma unroll
    for (int j = 0; j < 4; ++j) { const int n = (lane >> 2) + 16 * j; const LAS unsigned* sp = scr + (4 * c) * 65 + n;
        u32x4 o; o.x = sp[0]; o.y = sp[65]; o.z = sp[130]; o.w = sp[195];
        *(u32x4*)(WT + (size_t)(dst_row0 + n) * K + k0 + 16 * c) = o; }
    asm volatile("s_waitcnt lgkmcnt(0)" ::: "memory");
}
constexpr int BG_ITEMS = 21504;
constexpr int BG_B0 = 0, BG_D0 = 1200, BG_E0 = 5200, BG_F0 = 8700, BG_B1 = 19700, BG_CL = 20900;
DI void bg_item(Frame& F, int g, LAS unsigned* scr) {
    if (g < 14336) { const int m = g / 896, e = m >> 1, up = m & 1, r = g % 896, kb = r / 56, nb = r % 56, n0 = 64 * nb; const int drow = 256 * (n0 / 128) + (n0 % 128) + (up ? 128 : 0);
#if MOE_FP8
        conv_item64_fp8(F.in[up ? I_MU : I_MG] + (size_t)e * 1024 * 3584, 1024, 3584, F.ws + WS_MGU + (size_t)e * 7168 * 1024, 64 * kb, n0, drow, QS_WGU, scr, F.lane);
#else
        conv_item64(F.in[up ? I_MU : I_MG] + (size_t)e * 1024 * 3584, 1024, 3584, (bf16*)(F.ws + WS_MGU) + (size_t)e * 7168 * 1024, 64 * kb, n0, drow, scr, F.lane);
#endif
    } else { const int gg = g - 14336, e = gg / 896, r = gg % 896, kb = r / 16, nb = r % 16;
#if MOE_FP8
        conv_item64_fp8(F.in[I_MDN] + (size_t)e * 3584 * 1024, 3584, 1024, F.ws + WS_MD + (size_t)e * 1024 * 3584, 64 * kb, 64 * nb, 64 * nb, QS_WD, scr, F.lane);
#else
        conv_item64(F.in[I_MDN] + (size_t)e * 3584 * 1024, 3584, 1024, (bf16*)(F.ws + WS_MD) + (size_t)e * 1024 * 3584, 64 * kb, 64 * nb, 64 * nb, scr, F.lane);
#endif
    }
}
DI void bg_convert_tail(Frame& F, int nwg, int lo, int hi) {
    const int nmax = (nwg + F.G - 1) / F.G, rem = nwg - (nmax - 1) * F.G;
    if (F.bid < rem || rem >= F.G) return;
    LAS unsigned* scr = (LAS unsigned*)(F.lds + F.wave * 8320);
    const int w = (F.bid - rem) * 8 + F.wave, nw = (F.G - rem) * 8;
    for (int g = lo + w; g < hi; g += nw) bg_item(F, g, scr);
}
DI void bg_convert_all(Frame& F, int lo, int hi) {
    LAS unsigned* scr = (LAS unsigned*)(F.lds + F.wave * 8320);
    for (int g = lo + F.bid * 8 + F.wave; g < hi; g += F.G * 8) bg_item(F, g, scr);
}
DI void p0_prologue(Frame& F) {
    {
        LAS float* Sx = (LAS float*)F.lds;
        LAS float* red = (LAS float*)(F.lds + 81920);
        bool staged = false;
        for (int unit = F.bid; unit < 192; unit += F.G) {
            if (!staged) {
                for (int idx = F.tid; idx < 17 * 1024; idx += 512) { const int r = idx / 1024, k = idx % 1024;
                    const float v = r < 16 ? F.in[I_C][r * 1024 + k] : F.in[I_CCTX][k]; Sx[k * 20 + r] = v * sigmoidf_(v); }
                staged = true; __syncthreads();
            }
            const int l = unit / 96, n0 = (unit % 96) * 64;
            const float* Wm = F.in[I_WMOD] + (size_t)l * 1024 * 6144 + n0 + F.lane;
            float acc[17];
#pragma unroll
            for (int r = 0; r < 17; ++r) acc[r] = 0.f;
            const int kb = F.wave * 128;
#pragma unroll 4
            for (int k = 0; k < 128; ++k) { const float wv = Wm[(size_t)(kb + k) * 6144]; const LAS float* sp = Sx + (kb + k) * 20;
                const f32x4 s0 = *(const LAS f32x4*)(sp), s1 = *(const LAS f32x4*)(sp + 4), s2 = *(const LAS f32x4*)(sp + 8), s3 = *(const LAS f32x4*)(sp + 12); const float s4 = sp[16];
                acc[0] += s0[0] * wv; acc[1] += s0[1] * wv; acc[2] += s0[2] * wv; acc[3] += s0[3] * wv; acc[4] += s1[0] * wv; acc[5] += s1[1] * wv; acc[6] += s1[2] * wv; acc[7] += s1[3] * wv;
                acc[8] += s2[0] * wv; acc[9] += s2[1] * wv; acc[10] += s2[2] * wv; acc[11] += s2[3] * wv; acc[12] += s3[0] * wv; acc[13] += s3[1] * wv; acc[14] += s3[2] * wv; acc[15] += s3[3] * wv;
                acc[16] += s4 * wv; }
#pragma unroll
            for (int r = 0; r < 17; ++r) red[(F.wave * 17 + r) * 64 + F.lane] = acc[r];
            __syncthreads();
            for (int idx = F.tid; idx < 17 * 64; idx += 512) { const int r = idx / 64, ln = idx % 64; float s = F.in[I_BMOD][l * 6144 + n0 + ln];
#pragma unroll
                for (int w = 0; w < 8; ++w) s += red[(w * 17 + r) * 64 + ln];
                if (r < 16) ((float*)(F.ws + WS_MODLAT))[((size_t)l * 16 + r) * 6144 + n0 + ln] = s; else ((float*)(F.ws + WS_MODCTX))[(size_t)l * 6144 + n0 + ln] = s; }
            __syncthreads();
        }
        __syncthreads();
    }
    if (F.bid == 0) { const int pos = F.tid >> 3, j = F.tid & 7; const float inv = exp2f(-(float)j * 0.125f * 13.287712379549449f); const float ang = (float)pos * inv;
        float* tab = (float*)(F.ws + WS_ROPE); tab[(pos * 8 + j) * 2] = cosf(ang); tab[(pos * 8 + j) * 2 + 1] = sinf(ang); }
    {
        LAS float* scr = (LAS float*)(F.lds + F.wave * 16384);
        const int gw = F.bid * 8 + F.wave, NGW = F.G * 8;
        constexpr int I_IN = 16 * 96, I_OUT = 16 * 32, I_G = 16 * 88, I_D = 44 * 32, I_MGI = 16 * 112, I_MDI = 56 * 32;
        constexpr int NITEMS = 2 * I_IN + 2 * I_OUT + 2 * I_G + I_D;
        for (int it = gw; it < NITEMS; it += NGW) {
            int r = it;
            if (r < 2 * I_IN) { const int l = r / I_IN; p0_convert_plain(F, F.in[I_WIN] + (size_t)l * 1024 * 3072, 1024, 3072, (bf16*)(F.ws + WS_WIN) + (size_t)l * 3072 * 1024, r % I_IN, scr); continue; } r -= 2 * I_IN;
            if (r < 2 * I_OUT) { const int l = r / I_OUT; p0_convert_plain(F, F.in[I_WOUT] + (size_t)l * 1024 * 1024, 1024, 1024, (bf16*)(F.ws + WS_WOUT) + (size_t)l * 1024 * 1024, r % I_OUT, scr); continue; } r -= 2 * I_OUT;
            if (r < I_G) { p0_convert_gu(F, F.in[I_FG], 1024, 2816, (bf16*)(F.ws + WS_WGU), r, 0, scr); continue; } r -= I_G;
            if (r < I_G) { p0_convert_gu(F, F.in[I_FU], 1024, 2816, (bf16*)(F.ws + WS_WGU), r, 1, scr); continue; } r -= I_G;
            p0_convert_plain(F, F.in[I_FD], 2816, 1024, (bf16*)(F.ws + WS_WD), r, scr);
        }
    }
}

struct NormVecs { f32x4 gs[4], sh[4]; };
DI void norm_load_vecs(Frame& F, const float* g, const float* mod, int isc, int ish, NormVecs& V) {
#pragma unroll
    for (int j = 0; j < 4; ++j) { const f32x4 gv = ((const f32x4*)g)[F.lane + 64 * j], sv = ((const f32x4*)(mod + isc * DM))[F.lane + 64 * j]; V.gs[j] = gv * (sv + 1.0f); V.sh[j] = ((const f32x4*)(mod + ish * DM))[F.lane + 64 * j]; }
}
DI void norm_load_row(Frame& F, const float* srow, f32x4 (&v)[4]) {
    const f32x4* xr = (const f32x4*)srow + F.lane;
#pragma unroll
    for (int j = 0; j < 4; ++j) v[j] = xr[64 * j];
}
DI float norm_ssq(const f32x4 (&v)[4]) { float s = 0.f;
#pragma unroll
    for (int j = 0; j < 4; ++j) s += (v[j].x * v[j].x + v[j].y * v[j].y) + (v[j].z * v[j].z + v[j].w * v[j].w);
    return s; }
DI void norm_finish(Frame& F, const f32x4 (&v)[4], float ssq_total, const NormVecs& V, bf16* orow, f32x4 (&y)[4]) {
    const float rstd = 1.0f / sqrtf(ssq_total * (1.0f / DM) + EPS);
    u32x2* o8 = (u32x2*)orow + F.lane;
#pragma unroll
    for (int j = 0; j < 4; ++j) { y[j] = (v[j] * rstd) * V.gs[j] + V.sh[j]; u32x2 w; w.x = pk2(y[j].x, y[j].y); w.y = pk2(y[j].z, y[j].w); o8[64 * j] = w; }
}
DI void norm_finish8(Frame& F, const f32x4 (&v)[4], float ssq_total, const NormVecs& V, unsigned char* orow, f32x4 (&y)[4]) {
    const float rstd = 1.0f / sqrtf(ssq_total * (1.0f / DM) + EPS);
    unsigned* o4 = (unsigned*)orow + F.lane;
#pragma unroll
    for (int j = 0; j < 4; ++j) { y[j] = (v[j] * rstd) * V.gs[j] + V.sh[j]; o4[64 * j] = pk4_fp8(y[j].x * QS_U, y[j].y * QS_U, y[j].z * QS_U, y[j].w * QS_U); }
}
DI void norm_phase(Frame& F, int l, int which, bool first, int row_lo) {
    const float* g = F.in[which == 1 ? I_N1W : I_N2W] + l * DM;
    const float* modlat = (const float*)(F.ws + WS_MODLAT) + (size_t)l * 16 * 6144;
    const float* modctx = (const float*)(F.ws + WS_MODCTX) + (size_t)l * 6144;
    const int ish = which == 1 ? 0 : 3, isc = which == 1 ? 1 : 4;
    const float* sctx = first ? F.in[I_CTX] : (const float*)(F.ws + WS_HCTX);
    const float* slat = first ? F.in[I_X] : F.out;
    bf16* U = (bf16*)(F.ws + WS_U);
    const int gw = F.bid * 8 + F.wave, NGW = F.G * 8;
    const int rpw = (NTOK - row_lo + NGW - 1) / NGW;
    const int r0 = row_lo + gw * rpw; int r1 = r0 + rpw; if (r1 > NTOK) r1 = NTOK;
    NormVecs V; int curb = -2;
    for (int row = r0; row < r1; row += 2) {
        const bool two = row + 1 < r1;
        const int rowb = two ? row + 1 : row;
        f32x4 va[4], vb[4];
        norm_load_row(F, row < NCTX ? sctx + (size_t)row * DM : slat + (size_t)(row - NCTX) * DM, va);
        norm_load_row(F, rowb < NCTX ? sctx + (size_t)rowb * DM : slat + (size_t)(rowb - NCTX) * DM, vb);
        float sa = norm_ssq(va), sb = norm_ssq(vb);
#pragma unroll
        for (int o = 1; o < 64; o <<= 1) { sa += __shfl_xor(sa, o); sb += __shfl_xor(sb, o); }
        f32x4 y[4];
        { const int bk = row < NCTX ? -1 : (row - NCTX) / SEQ; if (bk != curb) { norm_load_vecs(F, g, bk < 0 ? modctx : modlat + (size_t)bk * 6144, isc, ish, V); curb = bk; } }
        norm_finish(F, va, sa, V, U + (size_t)row * DM, y);
        if (two) { const int bk = rowb < NCTX ? -1 : (rowb - NCTX) / SEQ; if (bk != curb) { norm_load_vecs(F, g, bk < 0 ? modctx : modlat + (size_t)bk * 6144, isc, ish, V); curb = bk; }
            norm_finish(F, vb, sb, V, U + (size_t)rowb * DM, y); }
    }
}
DI void moe_route_row(Frame& F, const f32x4 (&y)[4], LAS const float* Rw, const float (&rb)[8], LAS int* sel, int tl, int tok) {
    float lg[8];
#pragma unroll
    for (int e = 0; e < 8; ++e) lg[e] = 0.f;
#pragma unroll
    for (int j = 0; j < 4; ++j)
#pragma unroll
        for (int q = 0; q < 4; ++q) { const int k = 256 * j + 4 * F.lane + q; const f32x4 r0 = *(const LAS f32x4*)(Rw + k * 8), r1 = *(const LAS f32x4*)(Rw + k * 8 + 4); const float yv = y[j][q];
            lg[0] += yv * r0[0]; lg[1] += yv * r0[1]; lg[2] += yv * r0[2]; lg[3] += yv * r0[3]; lg[4] += yv * r1[0]; lg[5] += yv * r1[1]; lg[6] += yv * r1[2]; lg[7] += yv * r1[3]; }
#pragma unroll
    for (int o = 1; o < 64; o <<= 1) {
#pragma unroll
        for (int e = 0; e < 8; ++e) lg[e] += __shfl_xor(lg[e], o); }
#pragma unroll
    for (int e = 0; e < 8; ++e) lg[e] += rb[e];
    int e1 = 0; float v1 = lg[0];
#pragma unroll
    for (int e = 1; e < 8; ++e) if (lg[e] > v1) { v1 = lg[e]; e1 = e; }
    int e2 = -1; float v2 = -3.0e38f;
#pragma unroll
    for (int e = 0; e < 8; ++e) if (e != e1 && lg[e] > v2) { v2 = lg[e]; e2 = e; }
    const float ex = __expf(v2 - v1), p1 = 1.0f / (1.0f + ex), p2 = ex / (1.0f + ex);
    if (F.lane == 0) { sel[tl * 2] = e1; sel[tl * 2 + 1] = e2; float* pt = (float*)(F.ws + WS_PTOK) + (size_t)tok * 2; pt[0] = p1; pt[1] = p2; }
}
DI void norm_moe_phase(Frame& F) {
    const int l = 1;
    const float* g = F.in[I_N2W] + l * DM;
    const float* modlat = (const float*)(F.ws + WS_MODLAT) + (size_t)l * 16 * 6144;
    bf16* U = (bf16*)(F.ws + WS_U);
    LAS float* Rw = (LAS float*)F.lds;
    LAS int* sel = (LAS int*)(F.lds + 32768);
    for (int idx = F.tid; idx < 8192; idx += 512) Rw[idx] = F.in[I_MR][idx];
    __syncthreads();
    float rb[8];
#pragma unroll
    for (int e = 0; e < 8; ++e) rb[e] = F.in[I_MRB][e];
    NormVecs V; int curb = -2;
    for (int seg = F.bid; seg < 256; seg += F.G) {
        const int bk = (seg * 128) / SEQ; if (bk != curb) { norm_load_vecs(F, g, modlat + (size_t)bk * 6144, 4, 3, V); curb = bk; }
        for (int i = 0; i < 16; i += 2) {
            const int tl = F.wave * 16 + i, tok = seg * 128 + tl;
            f32x4 va[4], vb[4];
            norm_load_row(F, F.out + (size_t)tok * DM, va); norm_load_row(F, F.out + (size_t)(tok + 1) * DM, vb);
            float sa = norm_ssq(va), sb = norm_ssq(vb);
#pragma unroll
            for (int o = 1; o < 64; o <<= 1) { sa += __shfl_xor(sa, o); sb += __shfl_xor(sb, o); }
            f32x4 y[4];
#if MOE_FP8
            norm_finish8(F, va, sa, V, (unsigned char*)U + (size_t)tok * DM, y); moe_route_row(F, y, Rw, rb, sel, tl, tok);
            norm_finish8(F, vb, sb, V, (unsigned char*)U + (size_t)(tok + 1) * DM, y); moe_route_row(F, y, Rw, rb, sel, tl + 1, tok + 1);
#else
            norm_finish(F, va, sa, V, U + (size_t)(NCTX + tok) * DM, y); moe_route_row(F, y, Rw, rb, sel, tl, tok);
            norm_finish(F, vb, sb, V, U + (size_t)(NCTX + tok + 1) * DM, y); moe_route_row(F, y, Rw, rb, sel, tl + 1, tok + 1);
#endif
        }
        __syncthreads();
        if (F.tid < 16) { const int s = F.tid >> 3, e = F.tid & 7; int cnt = 0; int* lst = (int*)(F.ws + WS_SEGLIST) + ((size_t)(seg * 2 + s) * 8 + e) * 128;
            for (int i = 0; i < 128; ++i) if (sel[i * 2 + s] == e) lst[cnt++] = seg * 128 + i;
            ((int*)(F.ws + WS_SEGCNT))[(seg * 2 + s) * 8 + e] = cnt; }
        __syncthreads();
    }
}
DI void moe_route_phase(Frame& F) {
    LAS int* cn = (LAS int*)F.lds;
    LAS int* offs = cn + 2048;
    LAS int* tb = offs + 256;
    for (int unit = F.bid; unit < 16; unit += F.G) {
        const int s = unit >> 3, e = unit & 7;
        const int* segcnt = (const int*)(F.ws + WS_SEGCNT);
        for (int idx = F.tid; idx < 2048; idx += 512) { const int ee = idx >> 8, gsg = idx & 255; cn[idx] = segcnt[(gsg * 2 + s) * 8 + ee]; }
        __syncthreads();
        if (F.tid < 8) { int tot = 0; for (int gsg = 0; gsg < 256; ++gsg) tot += cn[F.tid * 256 + gsg]; tb[16 + F.tid] = tot; }
        if (F.tid == 64) { int run = 0; for (int gsg = 0; gsg < 256; ++gsg) { offs[gsg] = run; run += cn[e * 256 + gsg]; } }
        __syncthreads();
        if (F.tid == 0) { int run = 0; for (int ee = 0; ee < 8; ++ee) { tb[ee] = run; run += (tb[16 + ee] + 255) / 256; } tb[8] = run; }
        __syncthreads();
        int* rowmap = (int*)(F.ws + WS_ROWMAP) + (size_t)s * MOE_ROWS;
        float* prow = (float*)(F.ws + WS_PROW) + (size_t)s * MOE_ROWS;
        const float* ptok = (const float*)(F.ws + WS_PTOK);
        const int base = tb[e] * 256, tot = tb[16 + e], ntile = (tot + 255) / 256;
        if (F.tid < 256) { const int gsg = F.tid; const int c = cn[e * 256 + gsg]; const int* lst = (const int*)(F.ws + WS_SEGLIST) + ((size_t)(gsg * 2 + s) * 8 + e) * 128;
            for (int i = 0; i < c; ++i) { const int tok = lst[i]; rowmap[base + offs[gsg] + i] = tok; prow[base + offs[gsg] + i] = ptok[(size_t)tok * 2 + s]; } }
        for (int i = tot + F.tid; i < ntile * 256; i += 512) { rowmap[base + i] = -1; prow[base + i] = 0.f; }
        if (e == 0) { int* meta = (int*)(F.ws + WS_META) + s * 256;
            if (F.tid == 0) meta[0] = tb[8];
            if (F.tid < 8) { const int t0 = tb[F.tid], t1 = tb[F.tid + 1]; for (int t = t0; t < t1; ++t) meta[1 + t] = F.tid; } }
        __syncthreads();
    }
}
DI void final_phase(Frame& F) {
    const float* g = F.in[I_FNW];
    f32x4 gv[4];
#pragma unroll
    for (int j = 0; j < 4; ++j) gv[j] = ((const f32x4*)g)[F.lane + 64 * j];
    const int gw = F.bid * 8 + F.wave, NGW = F.G * 8;
    const int rpw = (NLAT + NGW - 1) / NGW; const int r0 = gw * rpw; int r1 = r0 + rpw; if (r1 > NLAT) r1 = NLAT;
    for (int row = r0; row < r1; row += 2) {
        const bool two = row + 1 < r1; const int rowb = two ? row + 1 : row;
        f32x4 va[4], vb[4];
        norm_load_row(F, F.out + (size_t)row * DM, va); norm_load_row(F, F.out + (size_t)rowb * DM, vb);
        float sa = norm_ssq(va), sb = norm_ssq(vb);
#pragma unroll
        for (int o = 1; o < 64; o <<= 1) { sa += __shfl_xor(sa, o); sb += __shfl_xor(sb, o); }
        const float ra = 1.0f / sqrtf(sa * (1.0f / DM) + EPS), rbv = 1.0f / sqrtf(sb * (1.0f / DM) + EPS);
        f32x4* xa = (f32x4*)(F.out + (size_t)row * DM) + F.lane; f32x4* xb = (f32x4*)(F.out + (size_t)rowb * DM) + F.lane;
#pragma unroll
        for (int j = 0; j < 4; ++j) xa[64 * j] = (va[j] * ra) * gv[j];
        if (two) {
#pragma unroll
            for (int j = 0; j < 4; ++j) xb[64 * j] = (vb[j] * rbv) * gv[j]; }
    }
}

DI void conv_unit(Frame& F, int l, int row0, int t0, int slen) {
    const bf16* PX = (const bf16*)(F.ws + WS_P);
    bf16* YC = (bf16*)(F.ws + WS_U);
    LAS float* Y = (LAS float*)F.lds;
    { u32x4 av[6], gv[6];
#pragma unroll
      for (int k = 0; k < 6; ++k) { const int it = F.tid + 512 * k; const int rr = it >> 5, cc = it & 31; const int t = t0 - 15 + rr;
          av[k] = (u32x4){0u, 0u, 0u, 0u}; gv[k] = av[k];
          if (it < 94 * 32 && t >= 0 && t < slen) { const bf16* p = PX + (size_t)(row0 + t) * INW + C_CONV + 8 * cc; av[k] = *(const u32x4*)p; gv[k] = *(const u32x4*)(p + 256); } }
#pragma unroll
      for (int k = 0; k < 6; ++k) { const int it = F.tid + 512 * k; const int rr = it >> 5, cc = it & 31;
          if (it < 94 * 32) { f32x4 o0, o1;
              o0[0] = bflo(av[k].x) * sigmoidf_(bflo(gv[k].x)); o0[1] = bfhi(av[k].x) * sigmoidf_(bfhi(gv[k].x)); o0[2] = bflo(av[k].y) * sigmoidf_(bflo(gv[k].y)); o0[3] = bfhi(av[k].y) * sigmoidf_(bfhi(gv[k].y));
              o1[0] = bflo(av[k].z) * sigmoidf_(bflo(gv[k].z)); o1[1] = bfhi(av[k].z) * sigmoidf_(bfhi(gv[k].z)); o1[2] = bflo(av[k].w) * sigmoidf_(bflo(gv[k].w)); o1[3] = bfhi(av[k].w) * sigmoidf_(bfhi(gv[k].w));
              *(LAS f32x4*)(Y + rr * 256 + 8 * cc) = o0; *(LAS f32x4*)(Y + rr * 256 + 8 * cc + 4) = o1; } } }
    __syncthreads();
    const int c = F.tid & 255, half = F.tid >> 8;
    float w[31];
#pragma unroll
    for (int k = 0; k < 31; ++k) w[k] = F.in[I_CONVW][(size_t)l * 31 * 256 + k * 256 + c];
    float acc[32];
    const float cb = F.in[I_CONVB][l * 256 + c];
#pragma unroll
    for (int o = 0; o < 32; ++o) acc[o] = cb;
#pragma unroll
    for (int kk = 0; kk < 62; ++kk) { const float yv = Y[(32 * half + kk) * 256 + c];
#pragma unroll
        for (int o = 0; o < 32; ++o) { const int tap = kk - o; if (tap >= 0 && tap < 31) acc[o] += yv * w[tap]; } }
    __syncthreads();
#pragma unroll
    for (int o = 0; o < 32; ++o) Y[(32 * half + o) * 256 + c] = acc[o];
    __syncthreads();
    const f32x4 lw = ((const f32x4*)(F.in[I_CLNW] + l * 256))[F.lane], lb = ((const f32x4*)(F.in[I_CLNB] + l * 256))[F.lane];
    for (int i = 0; i < 8; ++i) { const int tl = F.wave * 8 + i; const f32x4 v = *(const LAS f32x4*)(Y + tl * 256 + 4 * F.lane);
        const float mu = wave_sum((v.x + v.y) + (v.z + v.w)) * (1.0f / 256.0f); const f32x4 d = v - mu;
        const float var = wave_sum((d.x * d.x + d.y * d.y) + (d.z * d.z + d.w * d.w)) * (1.0f / 256.0f); const float rstd = 1.0f / sqrtf(var + EPS);
        f32x4 z = d * rstd * lw + lb; z.x *= sigmoidf_(z.x); z.y *= sigmoidf_(z.y); z.z *= sigmoidf_(z.z); z.w *= sigmoidf_(z.w);
        u32x2 o; o.x = pk2(z.x, z.y); o.y = pk2(z.z, z.w);
        *(u32x2*)(YC + (size_t)(row0 + t0 + tl) * DM + 512 + 4 * F.lane) = o; }
    __syncthreads();
}
DI void ret_consts(Frame& F, int l, int hh, float& lg2f, float& lg2b) {
    const float df = F.in[I_RDEC][(l * 2 + 0) * 4 + hh], db = F.in[I_RDEC][(l * 2 + 1) * 4 + hh];
    lg2f = log2f(1.0f - exp2f(-df)); lg2b = log2f(1.0f - exp2f(-db));
}
constexpr int ROPE_LDS = AUX_OFF + 4096;
DI void rope_to_lds(Frame& F) { const float* tab = (const float*)(F.ws + WS_ROPE); LAS float* rt = (LAS float*)(F.lds + ROPE_LDS); for (int i = F.tid; i < 1024; i += 512) rt[i] = tab[i]; __syncthreads(); }
DI void unpack8(const u32x4& a, float (&x)[8]) { x[0] = bflo(a.x); x[1] = bfhi(a.x); x[2] = bflo(a.y); x[3] = bfhi(a.y); x[4] = bflo(a.z); x[5] = bfhi(a.z); x[6] = bflo(a.w); x[7] = bfhi(a.w); }
DI void rope_apply(Frame& F, const u32x4& a, const u32x4& b, int hp, bool lat, int tg, float (&x1)[8], float (&x2)[8]) {
    unpack8(a, x1); unpack8(b, x2);
    if (lat) { const int pos = hp == 0 ? (tg >> 6) : (tg & 63); LAS const f32x4* tab = (LAS const f32x4*)(F.lds + ROPE_LDS) + pos * 4;
#pragma unroll
        for (int jj = 0; jj < 4; ++jj) { const f32x4 cs = tab[jj];
            { const float a1 = x1[2 * jj], a2 = x2[2 * jj]; x1[2 * jj] = a1 * cs[0] - a2 * cs[1]; x2[2 * jj] = a2 * cs[0] + a1 * cs[1]; }
            { const float a1 = x1[2 * jj + 1], a2 = x2[2 * jj + 1]; x1[2 * jj + 1] = a1 * cs[2] - a2 * cs[3]; x2[2 * jj + 1] = a2 * cs[2] + a1 * cs[3]; } } }
}
DI void ret_unit_decode(int su, bool& isctx, int& b, int& hh, int& n) {
    isctx = su >= 1024; if (!isctx) { b = su >> 6; hh = (su >> 4) & 3; n = su & 15; } else { const int v = su - 1024; b = v >> 3; hh = (v >> 1) & 3; n = v & 1; }
}
DI void ret_summary_pair(Frame& F, int l, int it) {
    const bf16* PX = (const bf16*)(F.ws + WS_P);
    const int sub = F.wave >> 2, st = F.tid & 255, su = 2 * it + sub;
    bool isctx; int b, hh, n; ret_unit_decode(su, isctx, b, hh, n);
    const int row0 = isctx ? (b * CTXL + n * 128) : (NCTX + b * SEQ + n * 128);
    float lg2f, lg2b; ret_consts(F, l, hh, lg2f, lg2b);
    LAS unsigned char* base = F.lds + sub * 40960;
    LAS unsigned char* Vimg = base;
    LAS unsigned char* Kf = base + 18432;
    LAS unsigned char* Kb = base + 18432 + 10240;
    { const int tok = st >> 1, hp = st & 1; float x1[8], x2[8];
      const bf16* kp = PX + (size_t)(row0 + tok) * INW + C_RK + 32 * hh; const bf16* vp = PX + (size_t)(row0 + tok) * INW + C_RV + 64 * hh + 32 * hp;
      const u32x4 kra = *(const u32x4*)(kp + 8 * hp), krb = *(const u32x4*)(kp + 16 + 8 * hp);
      u32x4 vr[4];
#pragma unroll
      for (int q = 0; q < 4; ++q) vr[q] = *(const u32x4*)(vp + 8 * q);
      rope_apply(F, kra, krb, hp, !isctx, n * 128 + tok, x1, x2);
      const float ks = 0.17677669529663687f;
      const float wf = fast_exp2(lg2f * (float)(127 - tok)) * ks, wb = fast_exp2(lg2b * (float)tok) * ks;
      u32x4 o;
      o.x = pk2(x1[0] * wf, x1[1] * wf); o.y = pk2(x1[2] * wf, x1[3] * wf); o.z = pk2(x1[4] * wf, x1[5] * wf); o.w = pk2(x1[6] * wf, x1[7] * wf); *(LAS u32x4*)(Kf + tok * 80 + 16 * hp) = o;
      o.x = pk2(x2[0] * wf, x2[1] * wf); o.y = pk2(x2[2] * wf, x2[3] * wf); o.z = pk2(x2[4] * wf, x2[5] * wf); o.w = pk2(x2[6] * wf, x2[7] * wf); *(LAS u32x4*)(Kf + tok * 80 + 32 + 16 * hp) = o;
      o.x = pk2(x1[0] * wb, x1[1] * wb); o.y = pk2(x1[2] * wb, x1[3] * wb); o.z = pk2(x1[4] * wb, x1[5] * wb); o.w = pk2(x1[6] * wb, x1[7] * wb); *(LAS u32x4*)(Kb + tok * 80 + 16 * hp) = o;
      o.x = pk2(x2[0] * wb, x2[1] * wb); o.y = pk2(x2[2] * wb, x2[3] * wb); o.z = pk2(x2[4] * wb, x2[5] * wb); o.w = pk2(x2[6] * wb, x2[7] * wb); *(LAS u32x4*)(Kb + tok * 80 + 32 + 16 * hp) = o;
#pragma unroll
      for (int q = 0; q < 4; ++q) *(LAS u32x4*)(Vimg + tok * 144 + 64 * hp + 16 * q) = vr[q]; }
    __syncthreads();
    { const int role = F.wave & 3, dir = role >> 1, et = role & 1;
      const int l32 = F.lane & 31, h = F.lane >> 5, grp = (F.lane >> 4) & 1, i16 = F.lane & 15, q = i16 >> 2, p = i16 & 3;
      LAS unsigned char* Kimg = dir ? Kb : Kf;
      f32x16 acc;
#pragma unroll
      for (int i = 0; i < 16; ++i) acc[i] = 0.f;
#pragma unroll
      for (int s = 0; s < 8; ++s) { const int r0 = 16 * s + 8 * h + q;
          const s16x4 alo = trread(Vimg + r0 * 144 + (32 * et + 16 * grp + 4 * p) * 2), ahi = trread(Vimg + (r0 + 4) * 144 + (32 * et + 16 * grp + 4 * p) * 2);
          const s16x4 blo = trread(Kimg + r0 * 80 + (16 * grp + 4 * p) * 2), bhi = trread(Kimg + (r0 + 4) * 80 + (16 * grp + 4 * p) * 2);
          const bf16x8 a = __builtin_shufflevector(alo, ahi, 0, 1, 2, 3, 4, 5, 6, 7), bb = __builtin_shufflevector(blo, bhi, 0, 1, 2, 3, 4, 5, 6, 7);
          acc = MFMA32(a, bb, acc); }
      float* S = isctx ? (float*)(F.ws + WS_SUMCTX) + ((size_t)((b * 4 + hh) * 2 + n) * 2 + dir) * 2048 : (float*)(F.ws + WS_SUMLAT) + ((size_t)((b * 4 + hh) * 16 + n) * 2 + dir) * 2048;
#pragma unroll
      for (int i = 0; i < 16; ++i) S[(32 * et + crow(i, h)) * 32 + l32] = acc[i]; }
    __syncthreads();
}
DI void ca_phase(Frame& F, int l) {
    rope_to_lds(F);
    const int nconv = l == 0 ? 576 : 512;
    for (int u = F.vb; u < nconv; u += F.G) {
        int v = u; if (l != 0) v += 64;
        if (v < 64) conv_unit(F, l, (v >> 2) * CTXL, (v & 3) * 64, CTXL);
        else { v -= 64; conv_unit(F, l, NCTX + (v >> 5) * SEQ, (v & 31) * 64, SEQ); }
    }
    for (int it = F.vb; it < 576; it += F.G) ret_summary_pair(F, l, it);
}

constexpr int ATT_BUF = 18432, ATT_BT = 2 * ATT_BUF, ATT_NEG = 640;
DI void attn_fetch(Frame& F, const bf16* PX, int keyrow0, int hh, u32x4& kv, u32x4& vv) {
    const int key = F.tid >> 3, ch = F.tid & 7;
    const bf16* p = PX + (size_t)(keyrow0 + key) * INW + 64 * hh + 8 * ch;
    kv = *(const u32x4*)(p + C_NAK); vv = *(const u32x4*)(p + C_NAV);
}
DI void attn_put(Frame& F, LAS unsigned char* buf, const u32x4& kv, const u32x4& vv) {
    const int key = F.tid >> 3, ch = F.tid & 7;
    *(LAS u32x4*)(buf + key * 144 + 16 * ch) = kv; *(LAS u32x4*)(buf + 9216 + key * 144 + 16 * ch) = vv;
}
template <bool BIAS>
DI void attn_tile(LAS const unsigned char* buf, int koff, const bf16x8 (&qf)[4], f32x16& o0, f32x16& o1, f32x16& o2, float& mrun, int lane,
                  LAS const float* bt  , const float (&pen)[16]) {
    LAS const unsigned char* Kimg = buf; LAS const unsigned char* Vimg = buf + 9216;
    const int l32 = lane & 31, h = lane >> 5, grp = (lane >> 4) & 1, i16 = lane & 15, q = i16 >> 2, p = i16 & 3;
    f32x16 s;
#pragma unroll
    for (int i = 0; i < 16; ++i) s[i] = 0.f;
#pragma unroll
    for (int si = 0; si < 4; ++si) { const bf16x8 a = *(const LAS bf16x8*)(Kimg + (koff + l32) * 144 + (16 * si + 8 * h) * 2); s = MFMA32(a, qf[si], s); }
    const float c = 0.125f * LOG2E;
    float v[16]; float mx = -1.0e30f;
#pragma unroll
    for (int i = 0; i < 16; ++i) { float t;
        if (BIAS) t = __builtin_fmaf(s[i], c, bt[(i & 3) + 8 * (i >> 2)]) + pen[i]; else t = s[i] * c;
        v[i] = t; mx = fmaxf(mx, t); }
    mx = fmaxf(mx, __shfl_xor(mx, 32));
    const float mnew = fmaxf(mrun, mx);
    const float alpha = fast_exp2(mrun - mnew);
    if (__any(alpha != 1.0f)) {
#pragma unroll
        for (int i = 0; i < 16; ++i) { o0[i] *= alpha; o1[i] *= alpha; o2[i] *= alpha; } }
    mrun = mnew;
    float pp[16];
#pragma unroll
    for (int i = 0; i < 16; ++i) pp[i] = fast_exp2(v[i] - mnew);
    bf16x8 pf[2];
#pragma unroll
    for (int s2 = 0; s2 < 2; ++s2) { u32x4 w; w.x = pk2(pp[8 * s2], pp[8 * s2 + 1]); w.y = pk2(pp[8 * s2 + 2], pp[8 * s2 + 3]); w.z = pk2(pp[8 * s2 + 4], pp[8 * s2 + 5]); w.w = pk2(pp[8 * s2 + 6], pp[8 * s2 + 7]); pf[s2] = __builtin_bit_cast(bf16x8, w); }
    const u32x4 onesw = (u32x4){0x3f803f80u, 0x3f803f80u, 0x3f803f80u, 0x3f803f80u}; const bf16x8 ones = __builtin_bit_cast(bf16x8, onesw);
#pragma unroll
    for (int s2 = 0; s2 < 2; ++s2) { const int r0 = koff + 16 * s2 + 4 * h + q;
#pragma unroll
        for (int et = 0; et < 2; ++et) { const int cb = (32 * et + 16 * grp + 4 * p) * 2;
            const s16x4 lo = trread(Vimg + r0 * 144 + cb), hi = trread(Vimg + (r0 + 8) * 144 + cb);
            const bf16x8 a = __builtin_shufflevector(lo, hi, 0, 1, 2, 3, 4, 5, 6, 7);
            if (et == 0) o0 = MFMA32(a, pf[s2], o0); else o1 = MFMA32(a, pf[s2], o1); }
        o2 = MFMA32(ones, pf[s2], o2); }
}
DI void attn_unit(Frame& F, int l, bool na, int b, int hh, int rg) {
    const bf16* PX = (const bf16*)(F.ws + WS_P);
    bf16* YC = (bf16*)(F.ws + WS_U);
    LAS float* btab = (LAS float*)(F.lds + ATT_BT);
    const int l32 = F.lane & 31, h = F.lane >> 5;
    int qrow, r = 0, qcol = 0, kc0 = 0, ra = 0;
    float pen[16];
#pragma unroll
    for (int i = 0; i < 16; ++i) pen[i] = 0.f;
    if (na) { const int rp = F.wave >> 2, n = F.wave & 3; ra = 4 * rg + 2 * rp; r = ra + (l32 >> 4); qcol = 16 * n + (l32 & 15); qrow = NCTX + b * SEQ + r * GW + qcol;
        int w0 = qcol - 8; w0 = w0 < 0 ? 0 : (w0 > 48 ? 48 : w0); kc0 = 16 * n - 8; kc0 = kc0 < 0 ? 0 : (kc0 > 32 ? 32 : kc0);
#pragma unroll
        for (int i = 0; i < 16; ++i) pen[i] = ((unsigned)(kc0 + crow(i, h) - w0) < 16u) ? 0.f : -1.0e30f; }
    else qrow = b * CTXL + 32 * F.wave + l32;
    bf16x8 qf[4];
#pragma unroll
    for (int si = 0; si < 4; ++si) qf[si] = *(const bf16x8*)(PX + (size_t)qrow * INW + C_NAQ + 64 * hh + 16 * si + 8 * h);
    if (na) { for (int idx = F.tid; idx < ATT_NEG + 128; idx += 512) { float v = 0.f; if (idx >= 48 && idx < 48 + 465) v = F.in[I_RPB][((size_t)l * 8 + hh) * 465 + (idx - 48)] * LOG2E; if (idx >= ATT_NEG) v = -1.0e30f; btab[idx] = v; } }
    f32x16 o0, o1, o2;
#pragma unroll
    for (int i = 0; i < 16; ++i) { o0[i] = 0.f; o1[i] = 0.f; o2[i] = 0.f; }
    float mrun = -1.0e30f;
    int ylo = 0, nsteps = 4;
    if (na) { const int rlo = 4 * rg, rhi = 4 * rg + 3;
        ylo = rlo - 4; ylo = ylo < 0 ? 0 : (ylo > 24 ? 24 : ylo);
        int yhi = rhi - 4; yhi = yhi < 0 ? 0 : (yhi > 24 ? 24 : yhi); yhi += 8; nsteps = 4 + (yhi - ylo); }
    int sa = ra - 4; sa = sa < 0 ? 0 : (sa > 24 ? 24 : sa);
    int sb = ra + 1 - 4; sb = sb < 0 ? 0 : (sb > 24 ? 24 : sb);
    const int mylo = (l32 >> 4) ? sb : sa;
    const int cbase = kc0 + 4 * h - qcol + 15;
#define ATT_ROW0(sx) ((sx) < 4 ? b * CTXL + 64 * (sx) : NCTX + b * SEQ + (ylo + (sx) - 4) * GW)
#define ATT_COMPUTE(buf, sx) do { if ((sx) < 4) { attn_tile<false>(buf, 0, qf, o0, o1, o2, mrun, F.lane, btab, pen); attn_tile<false>(buf, 32, qf, o0, o1, o2, mrun, F.lane, btab, pen); } \
        else { const int y = ylo + (sx) - 4; if (y >= sa && y < sb + 8) { const bool rowok = (unsigned)(y - mylo) < 8u; \
            LAS const float* bt = btab + (rowok ? 48 + (y - r + 7) * 31 + cbase : ATT_NEG); attn_tile<true>(buf, kc0, qf, o0, o1, o2, mrun, F.lane, bt, pen); } } } while (0)
    u32x4 kvA, vvA, kvB, vvB;
    attn_fetch(F, PX, ATT_ROW0(0), hh, kvA, vvA);
    attn_fetch(F, PX, ATT_ROW0(1), hh, kvB, vvB);
    for (int st = 0; st < nsteps; st += 2) {
        LAS unsigned char* buf0 = F.lds; LAS unsigned char* buf1 = F.lds + ATT_BUF;
        attn_put(F, buf0, kvA, vvA);
        if (st + 2 < nsteps) attn_fetch(F, PX, ATT_ROW0(st + 2), hh, kvA, vvA);
        __syncthreads();
        ATT_COMPUTE(buf0, st);
        if (st + 1 < nsteps) {
            attn_put(F, buf1, kvB, vvB);
            if (st + 3 < nsteps) attn_fetch(F, PX, ATT_ROW0(st + 3), hh, kvB, vvB);
            __syncthreads();
            ATT_COMPUTE(buf1, st + 1);
        }
    }
#undef ATT_ROW0
#undef ATT_COMPUTE
    const float inv = 1.0f / o2[0];
    bf16* orow = YC + (size_t)qrow * DM + 64 * hh;
#pragma unroll
    for (int gq = 0; gq < 4; ++gq) { u32x2 w;
        w.x = pk2(o0[4 * gq] * inv, o0[4 * gq + 1] * inv); w.y = pk2(o0[4 * gq + 2] * inv, o0[4 * gq + 3] * inv); *(u32x2*)(orow + 8 * gq + 4 * h) = w;
        w.x = pk2(o1[4 * gq] * inv, o1[4 * gq + 1] * inv); w.y = pk2(o1[4 * gq + 2] * inv, o1[4 * gq + 3] * inv); *(u32x2*)(orow + 32 + 8 * gq + 4 * h) = w; }
    __syncthreads();
}
DI void ret_out_unit(Frame& F, int l, int su) {
    const bf16* PX = (const bf16*)(F.ws + WS_P);
    bf16* YC = (bf16*)(F.ws + WS_U);
    bool isctx; int b, hh, n; ret_unit_decode(su, isctx, b, hh, n);
    const int row0 = isctx ? (b * CTXL + n * 128) : (NCTX + b * SEQ + n * 128);
    float lg2f, lg2b; ret_consts(F, l, hh, lg2f, lg2b);
    LAS unsigned char* Kimg = F.lds;
    LAS unsigned char* Vimg = F.lds + 10240;
    LAS unsigned char* Stf = F.lds + 28672;
    LAS unsigned char* Stb = F.lds + 33792;
    LAS float* Ob = (LAS float*)(F.lds + 38912);
    const int dir = F.wave >> 2, qb = F.wave & 3, l32 = F.lane & 31, h = F.lane >> 5, grp = (F.lane >> 4) & 1, i16 = F.lane & 15, q = i16 >> 2, p = i16 & 3;
    const int iq = 32 * qb + l32;
    const int ktok = (F.tid & 255) >> 1, khp = F.tid & 1;
    const bf16* kp = PX + (size_t)(row0 + ktok) * INW + C_RK + 32 * hh;
    const u32x4 kra = *(const u32x4*)(kp + 8 * khp), krb = *(const u32x4*)(kp + 16 + 8 * khp);
    const int vtok = F.tid >> 2, vch = F.tid & 3; const bf16* vp = PX + (size_t)(row0 + vtok) * INW + C_RV + 64 * hh + 16 * vch;
    const u32x4 vra = *(const u32x4*)vp, vrb = *(const u32x4*)(vp + 8);
    const bf16* qp = PX + (size_t)(row0 + iq) * INW + C_RQ + 32 * hh;
    const u32x4 qra = *(const u32x4*)(qp + 8 * h), qrb = *(const u32x4*)(qp + 16 + 8 * h);
    const bf16* gp = PX + (size_t)(row0 + iq) * INW + (dir ? C_GB : C_GF) + 64 * hh;
    u32x2 gg[8];
#pragma unroll
    for (int et = 0; et < 2; ++et)
#pragma unroll
        for (int gq = 0; gq < 4; ++gq) gg[et * 4 + gq] = *(const u32x2*)(gp + 32 * et + 8 * gq + 4 * h);
    const float cf = fast_exp2(lg2f * 128.0f), cb = fast_exp2(lg2b * 128.0f);
    const float* SC = (const float*)(F.ws + WS_SUMCTX) + (size_t)((b * 4 + hh) * 2) * 2 * 2048;
    const float* SL = (const float*)(F.ws + WS_SUMLAT) + (size_t)((b * 4 + hh) * 16) * 2 * 2048;
    f32x4 sf = (f32x4){0.f, 0.f, 0.f, 0.f}, sb = sf; const int eo = 4 * F.tid;
    if (!isctx) {
        f32x4 t[16];
#pragma unroll
        for (int m = 0; m < 16; ++m) t[m] = *(const f32x4*)(SL + (size_t)(m * 2 + (m <= n ? 0 : 1)) * 2048 + eo);
        const f32x4 c00 = *(const f32x4*)(SC + (0 * 2 + 0) * 2048 + eo), c10 = *(const f32x4*)(SC + (1 * 2 + 0) * 2048 + eo);
        const f32x4 c11 = *(const f32x4*)(SC + (1 * 2 + 1) * 2048 + eo), c01 = *(const f32x4*)(SC + (0 * 2 + 1) * 2048 + eo);
        sf = c00 * cf + c10;
#pragma unroll
        for (int m = 0; m < 16; ++m) { const f32x4 nv = sf * cf + t[m]; sf = (m < n) ? nv : sf; }
        sb = c11 * cb + c01;
#pragma unroll
        for (int m = 15; m >= 0; --m) { const f32x4 nv = sb * cb + t[m]; sb = (m > n) ? nv : sb; }
    } else {
        if (n == 1) sf = *(const f32x4*)(SC + (0 * 2 + 0) * 2048 + eo);
        if (n == 0) sb = *(const f32x4*)(SC + (1 * 2 + 1) * 2048 + eo);
    }
    if (F.tid < 256) { float x1[8], x2[8]; rope_apply(F, kra, krb, khp, !isctx, n * 128 + ktok, x1, x2);
        const float ks = 0.17677669529663687f; u32x4 o;
        o.x = pk2(x1[0] * ks, x1[1] * ks); o.y = pk2(x1[2] * ks, x1[3] * ks); o.z = pk2(x1[4] * ks, x1[5] * ks); o.w = pk2(x1[6] * ks, x1[7] * ks); *(LAS u32x4*)(Kimg + ktok * 80 + 16 * khp) = o;
        o.x = pk2(x2[0] * ks, x2[1] * ks); o.y = pk2(x2[2] * ks, x2[3] * ks); o.z = pk2(x2[4] * ks, x2[5] * ks); o.w = pk2(x2[6] * ks, x2[7] * ks); *(LAS u32x4*)(Kimg + ktok * 80 + 32 + 16 * khp) = o; }
    *(LAS u32x4*)(Vimg + vtok * 144 + 32 * vch) = vra; *(LAS u32x4*)(Vimg + vtok * 144 + 32 * vch + 16) = vrb;
    { const int e = eo >> 5, d = eo & 31; u32x2 w;
      w.x = pk2(sf[0], sf[1]); w.y = pk2(sf[2], sf[3]); *(LAS u32x2*)(Stf + e * 80 + d * 2) = w;
      w.x = pk2(sb[0], sb[1]); w.y = pk2(sb[2], sb[3]); *(LAS u32x2*)(Stb + e * 80 + d * 2) = w; }
    bf16x8 qf[2], qd[2];
    { float x1[8], x2[8]; rope_apply(F, qra, qrb, h, !isctx, n * 128 + iq, x1, x2);
      const float dec = dir == 0 ? fast_exp2(lg2f * (float)(iq + 1)) : fast_exp2(lg2b * (float)(128 - iq));
      u32x4 w;
      w.x = pk2(x1[0], x1[1]); w.y = pk2(x1[2], x1[3]); w.z = pk2(x1[4], x1[5]); w.w = pk2(x1[6], x1[7]); qf[0] = __builtin_bit_cast(bf16x8, w);
      w.x = pk2(x2[0], x2[1]); w.y = pk2(x2[2], x2[3]); w.z = pk2(x2[4], x2[5]); w.w = pk2(x2[6], x2[7]); qf[1] = __builtin_bit_cast(bf16x8, w);
      w.x = pk2(x1[0] * dec, x1[1] * dec); w.y = pk2(x1[2] * dec, x1[3] * dec); w.z = pk2(x1[4] * dec, x1[5] * dec); w.w = pk2(x1[6] * dec, x1[7] * dec); qd[0] = __builtin_bit_cast(bf16x8, w);
      w.x = pk2(x2[0] * dec, x2[1] * dec); w.y = pk2(x2[2] * dec, x2[3] * dec); w.z = pk2(x2[4] * dec, x2[5] * dec); w.w = pk2(x2[6] * dec, x2[7] * dec); qd[1] = __builtin_bit_cast(bf16x8, w); }
    __syncthreads();
    f32x16 o0, o1;
#pragma unroll
    for (int i = 0; i < 16; ++i) { o0[i] = 0.f; o1[i] = 0.f; }
    { LAS const unsigned char* St = dir ? Stb : Stf;
#pragma unroll
      for (int s = 0; s < 2; ++s) { const bf16x8 a0 = *(const LAS bf16x8*)(St + l32 * 80 + (16 * s + 8 * h) * 2), a1 = *(const LAS bf16x8*)(St + (32 + l32) * 80 + (16 * s + 8 * h) * 2);
          o0 = MFMA32(a0, qd[s], o0); o1 = MFMA32(a1, qd[s], o1); } }
    const float lgd = dir ? lg2b : lg2f;
    const int kt_lo = dir ? qb : 0, kt_hi = dir ? 3 : qb;
    for (int kt = kt_lo; kt <= kt_hi; ++kt) {
        f32x16 s;
#pragma unroll
        for (int i = 0; i < 16; ++i) s[i] = 0.f;
#pragma unroll
        for (int si = 0; si < 2; ++si) { const bf16x8 a = *(const LAS bf16x8*)(Kimg + (32 * kt + l32) * 80 + (16 * si + 8 * h) * 2); s = MFMA32(a, qf[si], s); }
        float pp[16];
#pragma unroll
        for (int i = 0; i < 16; ++i) { const int j = 32 * kt + crow(i, h); const int diff = dir ? (j - iq) : (iq - j); pp[i] = diff >= 0 ? s[i] * fast_exp2(lgd * (float)diff) : 0.f; }
        bf16x8 pf[2];
#pragma unroll
        for (int s2 = 0; s2 < 2; ++s2) { u32x4 w; w.x = pk2(pp[8 * s2], pp[8 * s2 + 1]); w.y = pk2(pp[8 * s2 + 2], pp[8 * s2 + 3]); w.z = pk2(pp[8 * s2 + 4], pp[8 * s2 + 5]); w.w = pk2(pp[8 * s2 + 6], pp[8 * s2 + 7]); pf[s2] = __builtin_bit_cast(bf16x8, w); }
#pragma unroll
        for (int s2 = 0; s2 < 2; ++s2) { const int r0 = 32 * kt + 16 * s2 + 4 * h + q;
#pragma unroll
            for (int et = 0; et < 2; ++et) { const int cb = (32 * et + 16 * grp + 4 * p) * 2;
                const s16x4 lo = trread(Vimg + r0 * 144 + cb), hi = trread(Vimg + (r0 + 8) * 144 + cb);
                const bf16x8 a = __builtin_shufflevector(lo, hi, 0, 1, 2, 3, 4, 5, 6, 7);
                if (et == 0) o0 = MFMA32(a, pf[s2], o0); else o1 = MFMA32(a, pf[s2], o1); } }
    }
    float sm = 0.f;
#pragma unroll
    for (int i = 0; i < 16; ++i) sm += o0[i] + o1[i];
    sm += __shfl_xor(sm, 32);
    const float mu = sm * (1.0f / 64.0f);
    float vs = 0.f;
#pragma unroll
    for (int i = 0; i < 16; ++i) { const float d0 = o0[i] - mu, d1 = o1[i] - mu; vs += d0 * d0 + d1 * d1; }
    vs += __shfl_xor(vs, 32);
    const float rstd = 1.0f / sqrtf(vs * (1.0f / 64.0f) + EPS);
    const float* gn = F.in[I_RGNW] + l * 256 + 64 * hh;
    float val[32];
#pragma unroll
    for (int et = 0; et < 2; ++et)
#pragma unroll
        for (int gq = 0; gq < 4; ++gq) { const int e0 = 32 * et + 8 * gq + 4 * h; const u32x2 ggv = gg[et * 4 + gq]; const f32x4 gw = *(const f32x4*)(gn + e0);
            const float g0 = bflo(ggv.x), g1 = bfhi(ggv.x), g2 = bflo(ggv.y), g3 = bfhi(ggv.y);
            const float a0 = et ? o1[4 * gq] : o0[4 * gq], a1 = et ? o1[4 * gq + 1] : o0[4 * gq + 1], a2 = et ? o1[4 * gq + 2] : o0[4 * gq + 2], a3 = et ? o1[4 * gq + 3] : o0[4 * gq + 3];
            val[et * 16 + 4 * gq] = (a0 - mu) * rstd * gw[0] * g0 * sigmoidf_(g0); val[et * 16 + 4 * gq + 1] = (a1 - mu) * rstd * gw[1] * g1 * sigmoidf_(g1);
            val[et * 16 + 4 * gq + 2] = (a2 - mu) * rstd * gw[2] * g2 * sigmoidf_(g2); val[et * 16 + 4 * gq + 3] = (a3 - mu) * rstd * gw[3] * g3 * sigmoidf_(g3); }
    if (dir == 0) {
#pragma unroll
        for (int et = 0; et < 2; ++et)
#pragma unroll
            for (int gq = 0; gq < 4; ++gq)
#pragma unroll
                for (int j = 0; j < 4; ++j) Ob[iq * 65 + 32 * et + 8 * gq + 4 * h + j] = val[et * 16 + 4 * gq + j];
    }
    __syncthreads();
    if (dir == 1) { bf16* orow = YC + (size_t)(row0 + iq) * DM + 768 + 64 * hh;
#pragma unroll
        for (int et = 0; et < 2; ++et)
#pragma unroll
            for (int gq = 0; gq < 4; ++gq) { const int e0 = 32 * et + 8 * gq + 4 * h; float t[4];
#pragma unroll
                for (int j = 0; j < 4; ++j) t[j] = val[et * 16 + 4 * gq + j] + Ob[iq * 65 + e0 + j];
                u32x2 w; w.x = pk2(t[0], t[1]); w.y = pk2(t[2], t[3]); *(u32x2*)(orow + e0) = w; } }
    __syncthreads();
}
#ifndef PROBE_SUB
#define PROBE_SUB 0
#endif
DI void cb_phase(Frame& F, int l) {
    rope_to_lds(F);
    const int nattn = l == 0 ? 1152 : 1024;
    for (int rep = 0; rep < ((PROBE_SUB & 1) ? 2 : 1); ++rep)
    for (int u = F.vb; u < nattn; u += F.G) {
        if (u < 1024) attn_unit(F, l, true, u >> 6, (u >> 3) & 7, u & 7);
        else { const int v = u - 1024; attn_unit(F, l, false, v >> 3, v & 7, 0); }
    }
    const int nret = l == 0 ? 1152 : 1024;
    for (int rep = 0; rep < ((PROBE_SUB & 2) ? 2 : 1); ++rep)
    for (int u = F.vb; u < nret; u += F.G) ret_out_unit(F, l, u);
}

static_assert(sizeof(Params) == 240, "kernarg layout: in[26] at 0, out at 208, ws at 216, ph_lo at 224, ph_hi at 228");
__global__ void __launch_bounds__(512, 2) fwd_kernel(Params prm) {
    extern __shared__ __attribute__((aligned(16))) unsigned char lds_raw[];
    Frame F;
    F.lds = (LAS unsigned char*)lds_raw;
    F.tid = threadIdx.x; F.lane = F.tid & 63; F.wave = __builtin_amdgcn_readfirstlane(F.tid >> 6);
    F.G = gridDim.x; F.bid = blockIdx.x; F.vb = F.bid;
    F.in.ka = (karg_t)__builtin_amdgcn_kernarg_segment_ptr(); F.out = prm.out; F.ws = prm.ws;
    volatile LAS unsigned* MISC = (volatile LAS unsigned*)(F.lds + AUX_OFF);
    if (F.tid < 64) MISC[F.tid] = 0u;
    __syncthreads();
    XcdBarrier bar; bar.bar = (unsigned*)(prm.ws + WS_CTL) + 1024; bar.x = 0; bar.st = nullptr;
    const int lo = prm.ph_lo, hi = prm.ph_hi;
    if (hi - lo > 1) bar = xcd_barrier_post((unsigned*)(prm.ws + WS_CTL) + 1024, MISC + 8);
#ifdef ONLY_PHASE
#define IN(k) ((k) == ONLY_PHASE && lo <= (k) && (k) < hi)
#else
#define IN(k) (lo <= (k) && (k) < hi)
#endif
#ifndef PROBE_MASK
#define PROBE_MASK 0u
#endif
#define NREP(k) (((PROBE_MASK >> (k)) & 1u) ? 2 : 1)
#define SEAM(k) do { if (IN(k) && IN((k) + 1)) { XcdBarrier bb_ = bar; asm volatile("" : "+s"(bb_.bar)); xcd_barrier(bb_); } } while (0)
#define GLDS(P) ((LAS unsigned char*)(P).lds)
#define WSB(P, off) ((const pg8::bf16_t*)((P).ws + (off)))

    if (IN(0)) for (int rep_ = 0; rep_ < NREP(0); ++rep_) { if (rep_) __syncthreads(); Frame P = phase_frame(F); p0_prologue(P); } SEAM(0);
#pragma unroll 1
    for (int l = 0; l < 2; ++l) {
        const int pb = l == 0 ? 1 : 9;
        if (IN(pb + 0)) for (int rep_ = 0; rep_ < NREP(pb + 0); ++rep_) { if (rep_) __syncthreads(); Frame P = phase_frame(F); norm_phase(P, l, 1, l == 0, 0); } SEAM(pb + 0);
        if (IN(pb + 1)) for (int rep_ = 0; rep_ < NREP(pb + 1); ++rep_) { if (rep_) __syncthreads();
            Frame P = phase_frame(F);
            pg8::StaticOrder S; S.init(NTOK, INW, P.G, P.bid);
            pg8::EpiStoreBf16 E{(pg8::bf16_t*)(P.ws + WS_P), INW};
            pg8::gemm_phase<pg8::EpiStoreBf16, pg8::StaticOrder, pg8::RowsLinear, true>(GLDS(P), P.tid, WSB(P, WS_U), WSB(P, WS_WIN) + (size_t)l * INW * DM, 2 * DM, S, E, pg8::RowsLinear{});
            if (l == 0) bg_convert_tail(P, S.nwg, BG_B0, BG_D0); else bg_convert_tail(P, S.nwg, BG_B1, BG_CL);
        } SEAM(pb + 1);
        if (IN(pb + 2)) for (int rep_ = 0; rep_ < NREP(pb + 2); ++rep_) { if (rep_) __syncthreads(); Frame P = phase_frame(F); if (l == 1) { bg_convert_all(P, BG_CL, BG_ITEMS); __syncthreads(); } ca_phase(P, l); } SEAM(pb + 2);
        if (IN(pb + 3)) for (int rep_ = 0; rep_ < NREP(pb + 3); ++rep_) { if (rep_) __syncthreads(); Frame P = phase_frame(F); cb_phase(P, l); } SEAM(pb + 3);
        if (IN(pb + 4)) {
            Frame P = phase_frame(F);
            const int rb = l == 0 ? 0 : NCTX;
            const float* modlat = (const float*)(P.ws + WS_MODLAT) + (size_t)l * 16 * 6144;
            const float* modctx = (const float*)(P.ws + WS_MODCTX) + (size_t)l * 6144;
            float* hctx = (float*)(P.ws + WS_HCTX);
            pg8::StaticOrder S; S.init(NTOK - rb, DM, P.G, P.bid);
            pg8::EpiResGate E{l == 0 ? P.in[I_CTX] : hctx, l == 0 ? P.in[I_X] : P.out, hctx, P.out, modlat + 2 * DM, modctx + 2 * DM, rb};
            pg8::gemm_phase<pg8::EpiResGate, pg8::StaticOrder, pg8::RowsLinear, true>(GLDS(P), P.tid, WSB(P, WS_U) + (size_t)rb * DM, WSB(P, WS_WOUT) + (size_t)l * DM * DM, 2 * DM, S, E, pg8::RowsLinear{});
            if (l == 0) bg_convert_tail(P, S.nwg, BG_D0, BG_E0);
        } SEAM(pb + 4);
        if (l == 0) {
            if (IN(6)) for (int rep_ = 0; rep_ < NREP(6); ++rep_) { if (rep_) __syncthreads(); Frame P = phase_frame(F); norm_phase(P, 0, 2, false, 0); } SEAM(6);
            if (IN(7)) for (int rep_ = 0; rep_ < NREP(7); ++rep_) { if (rep_) __syncthreads();
                Frame P = phase_frame(F);
                pg8::StaticOrder S; S.init(NTOK, 2 * DFF, P.G, P.bid);
                pg8::EpiSwiglu<false> E{(pg8::bf16_t*)(P.ws + WS_P), DFF, 0, nullptr};
                pg8::gemm_phase<pg8::EpiSwiglu<false>, pg8::StaticOrder, pg8::RowsLinear, true>(GLDS(P), P.tid, WSB(P, WS_U), WSB(P, WS_WGU), 2 * DM, S, E, pg8::RowsLinear{});
                bg_convert_tail(P, S.nwg, BG_E0, BG_F0);
            } SEAM(7);
            if (IN(8)) {
                Frame P = phase_frame(F);
                const float* modlat = (const float*)(P.ws + WS_MODLAT);
                const float* modctx = (const float*)(P.ws + WS_MODCTX);
                float* hctx = (float*)(P.ws + WS_HCTX);
                pg8::StaticOrder S; S.init(NTOK, DM, P.G, P.bid);
                pg8::EpiResGate E{hctx, P.out, hctx, P.out, modlat + 5 * DM, modctx + 5 * DM, 0};
                pg8::gemm_phase<pg8::EpiResGate, pg8::StaticOrder, pg8::RowsLinear, true>(GLDS(P), P.tid, WSB(P, WS_P), WSB(P, WS_WD), 2 * DFF, S, E, pg8::RowsLinear{});
                bg_convert_tail(P, S.nwg, BG_F0, BG_B1);
            } SEAM(8);
        } else {
            if (IN(14)) for (int rep_ = 0; rep_ < NREP(14); ++rep_) { if (rep_) __syncthreads(); Frame P = phase_frame(F); norm_moe_phase(P); } SEAM(14);
            if (IN(15)) for (int rep_ = 0; rep_ < NREP(15); ++rep_) { if (rep_) __syncthreads(); Frame P = phase_frame(F); moe_route_phase(P); } SEAM(15);
#pragma unroll 1
            for (int s = 0; s < 2; ++s) {
                LAS int* texp = (LAS int*)(F.lds + AUX_TAB);
                if (IN(16 + 2 * s) || IN(17 + 2 * s)) {
                    Frame P = phase_frame(F);
                    const int* meta = (const int*)(P.ws + WS_META) + s * 256;
                    __syncthreads();
                    if (P.tid < 256) texp[P.tid] = ld_i32_coherent(meta + P.tid);
                    __syncthreads();
                }
                if (IN(16 + 2 * s)) for (int rep_ = 0; rep_ < NREP(16 + 2 * s); ++rep_) { if (rep_) __syncthreads();
                    Frame P = phase_frame(F);
                    const int* rowmap = (const int*)(P.ws + WS_ROWMAP) + (size_t)s * MOE_ROWS;
                    const int NT = __builtin_amdgcn_readfirstlane(texp[0]);
                    pg8::MoeOrder S{NT, 28, P.G, P.bid, (const LAS int*)(texp + 1)};
                    pg8::EpiSwiglu<true> E{(pg8::bf16_t*)(P.ws + WS_P), DFE, 28, (const float*)(P.ws + WS_PROW) + (size_t)s * MOE_ROWS};
#if MOE_FP8
                    pg8::gemm_phase<pg8::EpiSwiglu<true>, pg8::MoeOrder, pg8::RowsGather, true, true>(GLDS(P), P.tid, WSB(P, WS_U), WSB(P, WS_MGU), DM, S, E, pg8::RowsGather{rowmap, 0}, SCL_U, SCL_WGU);
#else
                    pg8::gemm_phase<pg8::EpiSwiglu<true>, pg8::MoeOrder, pg8::RowsGather, true>(GLDS(P), P.tid, WSB(P, WS_U), WSB(P, WS_MGU), 2 * DM, S, E, pg8::RowsGather{rowmap, NCTX});
#endif
                } SEAM(16 + 2 * s);
                if (IN(17 + 2 * s)) {
                    Frame P = phase_frame(F);
                    const int* rowmap = (const int*)(P.ws + WS_ROWMAP) + (size_t)s * MOE_ROWS;
                    const float* modlat = (const float*)(P.ws + WS_MODLAT) + (size_t)16 * 6144;
                    const int NT = __builtin_amdgcn_readfirstlane(texp[0]);
                    pg8::MoeOrder S{NT, 4, P.G, P.bid, (const LAS int*)(texp + 1)};
                    pg8::EpiMoeScatter E{rowmap, P.out, modlat + 5 * DM, 4};
#if MOE_FP8
                    pg8::gemm_phase<pg8::EpiMoeScatter, pg8::MoeOrder, pg8::RowsLinearOff, true, true>(GLDS(P), P.tid, WSB(P, WS_P), WSB(P, WS_MD), DFE, S, E, pg8::RowsLinearOff{}, SCL_H, SCL_WD);
#else
                    pg8::gemm_phase<pg8::EpiMoeScatter, pg8::MoeOrder, pg8::RowsLinear, true>(GLDS(P), P.tid, WSB(P, WS_P), WSB(P, WS_MD), 2 * DFE, S, E, pg8::RowsLinear{});
#endif
                } SEAM(17 + 2 * s);
            }
        }
    }
    if (IN(PH_FINAL)) { Frame P = phase_frame(F); final_phase(P); }
#undef IN
#undef SEAM
}

extern "C" void kernel_launch(void* const* d_in, const int* in_sizes, int n_in, void* d_out, int out_size, void* d_ws, size_t ws_size, hipStream_t stream) {
    static int grid = 0;
    if (grid == 0) {
        if (n_in != 26 || in_sizes[0] != NLAT * DM || out_size != NLAT * DM || ws_size < WS_END) {
            fprintf(stderr, "kernel_launch: unexpected shapes (n_in %d, in0 %d, out %d, ws %zu, need %zu); nothing launched\n", n_in, n_in > 0 ? in_sizes[0] : -1, out_size, ws_size, (size_t)WS_END); grid = -1; return; }
        int dev = 0, cus = 0, per_cu = 0;
        if (hipGetDevice(&dev) != hipSuccess || hipDeviceGetAttribute(&cus, hipDeviceAttributeMultiprocessorCount, dev) != hipSuccess) { grid = -1; return; }
        if (hipFuncSetAttribute((const void*)fwd_kernel, hipFuncAttributeMaxDynamicSharedMemorySize, LDS_BYTES) != hipSuccess) { fprintf(stderr, "kernel_launch: hipFuncSetAttribute failed\n"); grid = -1; return; }
        if (hipOccupancyMaxActiveBlocksPerMultiprocessor(&per_cu, (const void*)fwd_kernel, 512, LDS_BYTES) != hipSuccess || per_cu < 1)
            fprintf(stderr, "kernel_launch: note: occupancy query reports %d workgroups per CU\n", per_cu);
        (void)hipGetLastError();
        grid = cus;
    }
    if (grid < 0) return;
    if (hipMemsetAsync((char*)d_ws + WS_CTL, 0, CTL_ZERO_BYTES, stream) != hipSuccess) return;
    Params p{};
    for (int i = 0; i < 26; ++i) p.in[i] = (const float*)d_in[i];
    p.out = (float*)d_out; p.ws = (unsigned char*)d_ws;
#if MK_PER_PHASE
    for (int ph = 0; ph < N_PHASES; ++ph) { p.ph_lo = ph; p.ph_hi = ph + 1; hipLaunchKernelGGL(fwd_kernel, dim3(grid), dim3(512), LDS_BYTES, stream, p); }
#else
    p.ph_lo = 0; p.ph_hi = N_PHASES;
    hipLaunchKernelGGL(fwd_kernel, dim3(grid), dim3(512), LDS_BYTES, stream, p);
#endif
}
```

```cpp
#include <hip/hip_runtime.h>
#include <cstdio>
#include <cstdint>

#ifndef MK_PER_PHASE
#define MK_PER_PHASE 0
#endif

#define LAS __attribute__((address_space(3)))
#define GAS __attribute__((address_space(1)))
#define DI __device__ __forceinline__
typedef unsigned short bf16;
typedef short bf16x8 __attribute__((ext_vector_type(8)));
typedef short s16x4 __attribute__((ext_vector_type(4)));
typedef float f32x4 __attribute__((ext_vector_type(4)));
typedef float f32x16 __attribute__((ext_vector_type(16)));
typedef unsigned u32x4 __attribute__((ext_vector_type(4)));
typedef unsigned u32x2 __attribute__((ext_vector_type(2)));
typedef float f32x2_t __attribute__((ext_vector_type(2)));
typedef __bf16 bf16x2_t __attribute__((ext_vector_type(2)));
typedef short v4i16_t __attribute__((ext_vector_type(4)));

constexpr int DM = 1024, NB = 16, SEQ = 2048, CTXL = 256, GW = 64;
constexpr int NLAT = NB * SEQ, NCTX = NB * CTXL, NTOK = NLAT + NCTX;
constexpr int INW = 3072, DFF = 2816, NE = 8, DFE = 3584;
constexpr int C_NAQ = 0, C_NAK = 512, C_NAV = 1024, C_CONV = 1536, C_RQ = 2048, C_RK = 2176, C_RV = 2304, C_GF = 2560, C_GB = 2816;
constexpr float EPS = 1e-6f;
constexpr float LOG2E = 1.4426950408889634f;

constexpr size_t MiB = 1u << 20;
constexpr size_t WS_CTL = 0, CTL_ZERO_BYTES = 64 * 1024;
constexpr size_t WS_MODLAT = 1 * MiB;
constexpr size_t WS_MODCTX = WS_MODLAT + 2 * 16 * 6144 * 4;
constexpr size_t WS_ROPE = WS_MODCTX + 2 * 6144 * 4;
constexpr size_t WS_PTOK = 2 * MiB;
constexpr size_t WS_SEGCNT = WS_PTOK + 32768 * 2 * 4;
constexpr size_t WS_META = WS_SEGCNT + 256 * 2 * 8 * 4;
constexpr size_t WS_SEGLIST = 3 * MiB;
constexpr size_t WS_ROWMAP = 5 * MiB;
constexpr int MOE_ROWS = 34816;
constexpr size_t WS_PROW = WS_ROWMAP + 512 * 1024;
constexpr size_t WS_SUMLAT = 6 * MiB;
constexpr size_t WS_SUMCTX = 22 * MiB;
constexpr size_t WS_WIN = 24 * MiB;
constexpr size_t WS_WOUT = WS_WIN + (size_t)2 * 3072 * 1024 * 2;
constexpr size_t WS_WGU = WS_WOUT + (size_t)2 * 1024 * 1024 * 2;
constexpr size_t WS_WD = WS_WGU + (size_t)5632 * 1024 * 2;
constexpr size_t WS_MGU = WS_WD + (size_t)1024 * 2816 * 2;
constexpr size_t WS_MD = WS_MGU + (size_t)8 * 7168 * 1024 * 2;
constexpr size_t WS_HCTX = WS_MD + (size_t)8 * 1024 * 3584 * 2;
constexpr size_t WS_U = WS_HCTX + (size_t)NCTX * DM * 4;
constexpr size_t WS_P = WS_U + (size_t)NTOK * DM * 2;
constexpr size_t WS_END = WS_P + (size_t)MOE_ROWS * DFE * 2;
static_assert((size_t)NTOK * INW * 2 <= (size_t)MOE_ROWS * DFE * 2, "P region");
static_assert(WS_WIN % 256 == 0 && WS_WOUT % 256 == 0 && WS_WGU % 256 == 0 && WS_WD % 256 == 0 && WS_MGU % 256 == 0 && WS_MD % 256 == 0 && WS_HCTX % 256 == 0 && WS_U % 256 == 0 && WS_P % 256 == 0, "align");

constexpr int RING_BYTES = 131072;
constexpr int AUX_OFF = RING_BYTES;
constexpr int AUX_TAB = AUX_OFF + 1024;
constexpr int LDS_BYTES = 147456;

#ifndef MOE_FP8
#define MOE_FP8 1
#endif
#ifndef DENSE_FP8
#define DENSE_FP8 2
#endif
constexpr int SCL_U = 0x7c7c7c7c, SCL_WGU = 0x79797979, SCL_H = 0x7c7c7c7c, SCL_WD = 0x78787878;
constexpr float QS_U = 8.0f, QS_WGU = 64.0f, QS_H = 8.0f, QS_WD = 128.0f;
DI unsigned pk2(float lo, float hi) { f32x2_t v = {lo, hi}; bf16x2_t b = __builtin_convertvector(v, bf16x2_t); return __builtin_bit_cast(unsigned, b); }
DI float clamp448(float x) { return __builtin_fminf(__builtin_fmaxf(x, -448.0f), 448.0f); }
DI unsigned pk4_fp8(float a, float b, float c, float d) { int w = 0; w = __builtin_amdgcn_cvt_pk_fp8_f32(clamp448(a), clamp448(b), w, false); w = __builtin_amdgcn_cvt_pk_fp8_f32(clamp448(c), clamp448(d), w, true); return (unsigned)w; }
DI float bflo(unsigned u) { return __uint_as_float(u << 16); }
DI float bfhi(unsigned u) { return __uint_as_float(u & 0xffff0000u); }
DI float wave_sum(float v) {
#pragma unroll
    for (int o = 1; o < 64; o <<= 1) v += __shfl_xor(v, o);
    return v;
}
DI float fast_exp2(float x) { return __builtin_amdgcn_exp2f(x); }
DI float fast_rcp(float x) { return __builtin_amdgcn_rcpf(x); }
DI float sigmoidf_(float x) { return fast_rcp(1.0f + fast_exp2(-x * LOG2E)); }
DI int crow(int reg, int h) { return (reg & 3) + 8 * (reg >> 2) + 4 * h; }
#define MFMA32(a, b, c) __builtin_amdgcn_mfma_f32_32x32x16_bf16((a), (b), (c), 0, 0, 0)
DI s16x4 trread(LAS const unsigned char* p) { return __builtin_bit_cast(s16x4, __builtin_amdgcn_ds_read_tr16_b64_v4i16((LAS v4i16_t*)p)); }
DI int ld_i32_coherent(const int* p) { return (int)__hip_atomic_load((const unsigned*)p, __ATOMIC_RELAXED, __HIP_MEMORY_SCOPE_AGENT); }

namespace pg8 {
#define PG8_LAS __attribute__((address_space(3)))
typedef unsigned short bf16_t;
constexpr int BM = 256, BK = 64, HALF = 128, HTB = HALF * BK * 2, STAGE_BYTES = 8 * HTB, NXCD = 8, WGM = 8;
__host__ __device__ __forceinline__ int lds_byte(int r, int c) { const int st = (r >> 4) * 2 + (c >> 5), rr = r & 15, cc = c & 31, ob = rr * 64 + cc * 2; return st * 1024 + (ob ^ (((ob >> 9) & 1) << 5)); }
__host__ __device__ __forceinline__ void stage_rc(int b, int& R, int& C) { const int st = b / 1024, sb = b % 1024, swz = sb ^ (((sb >> 9) & 1) << 5); R = (st >> 1) * 16 + swz / 64; C = (st & 1) * 32 + (swz % 64) / 2; }
__host__ __device__ __forceinline__ int perm32(int rho) { const int n = rho >> 4, i = rho & 15; return 8 * (i >> 2) + 4 * n + (i & 3); }
struct Unit { int pm, pn; };
struct StaticOrder {
    int nM, nN, nwg, G, c;
    __device__ void init(int M, int N, int G_, int c_) { nM = M / BM; nN = N / BM; nwg = nM * nN; G = G_; c = c_; }
    __device__ bool next(int i, Unit& u) const {
        const long L = (long)i * G + c; if (L >= nwg) return false;
        int wgid = (int)L; { const int q = nwg / NXCD, r = nwg % NXCD, xcd = wgid % NXCD, off = wgid / NXCD; wgid = (xcd < r ? xcd * (q + 1) : r * (q + 1) + (xcd - r) * q) + off; }
        const int nig = WGM * nN, gid = wgid / nig, fm = gid * WGM, gsz = (nM - fm) < WGM ? (nM - fm) : WGM;
        u.pm = fm + ((wgid % nig) % gsz); u.pn = (wgid % nig) / gsz; return true;
    }
};
struct RowsLinear { static constexpr bool GATHER = false; };
struct RowsLinearOff {
    static constexpr bool GATHER = true;
    __device__ __forceinline__ void offs(const Unit& u, const int (&R)[2], const int (&C)[2], int pitch, unsigned (&o)[2][2]) const {
#pragma unroll
        for (int h = 0; h < 2; ++h)
#pragma unroll
            for (int i = 0; i < 2; ++i) { o[h][i] = (unsigned)(u.pm * BM + h * HALF + R[i]) * (unsigned)pitch + (unsigned)C[i] * 2u; asm volatile("" : "+v"(o[h][i])); }
    }
};
struct RowsGather {
    static constexpr bool GATHER = true;
    const int* rowmap; int row_add;
    __device__ __forceinline__ void offs(const Unit& u, const int (&R)[2], const int (&C)[2], int pitch, unsigned (&o)[2][2]) const {
#pragma unroll
        for (int h = 0; h < 2; ++h)
#pragma unroll
            for (int i = 0; i < 2; ++i) { int t = rowmap[u.pm * BM + h * HALF + R[i]]; t = t < 0 ? 0 : t;
                o[h][i] = (unsigned)((size_t)(t + row_add) * (size_t)pitch + (size_t)C[i] * 2u); }
#pragma unroll
        for (int h = 0; h < 2; ++h)
#pragma unroll
            for (int i = 0; i < 2; ++i) asm volatile("" : "+v"(o[h][i]));
    }
};

typedef int i32x8 __attribute__((ext_vector_type(8)));
typedef int i32x4v __attribute__((ext_vector_type(4)));
template <class Epi, class Sched, class ARows, bool ALIGN_EPI, bool FP8 = false>
__device__ __forceinline__ void gemm_phase(PG8_LAS unsigned char* lds, int tid, const void* A, const void* Bt, int pitch, const Sched& S, const Epi& E, const ARows& AR, int sclA = 0x7f7f7f7f, int sclB = 0x7f7f7f7f) {
    constexpr bool GATHER = ARows::GATHER;
    const int wid = __builtin_amdgcn_readfirstlane(tid >> 6), lane = tid & 63, wr = wid >> 2, wc = wid & 3, fr = lane & 15, fq = lane >> 4;
    const int nt = pitch / (BK * 2);
    int RA[2], CA[2]; unsigned voffA[2], voffB[2];
#pragma unroll
    for (int i = 0; i < 2; ++i) { int R, C; stage_rc(tid * 16 + i * 8192, R, C); const int Rb = Epi::PERM ? ((R & ~31) + perm32(R & 31)) : R;
        RA[i] = R; CA[i] = C; voffA[i] = (unsigned)(R * pitch + C * 2); voffB[i] = (unsigned)(Rb * pitch + C * 2); }
#pragma unroll
    for (int i = 0; i < 2; ++i) { asm volatile("" : "+v"(voffA[i])); asm volatile("" : "+v"(voffB[i])); }
    const size_t kstep = (size_t)(BK * 2);
    const size_t hstep = (size_t)HALF * pitch;
    const size_t tstep = 2 * hstep;
    const unsigned ldsw = (unsigned)wid * 1024u;
    const int aoff = lds_byte(wr * 64 + fr, fq * 8), boff = lds_byte(wc * 32 + fr, fq * 8);
    const char* Ab = (const char*)A;
#define PG8_SA(b, h) (((b) * 2 + (h)) * HTB)
#define PG8_SB(b, h) ((4 + (b) * 2 + (h)) * HTB)
#define PG8_STAGE(bufoff, gbase, voff) do { _Pragma("unroll") for (int _i = 0; _i < 2; ++_i) \
        __builtin_amdgcn_global_load_lds((const unsigned*)((const char*)(gbase) + (voff)[_i]), (PG8_LAS unsigned*)(lds + (bufoff) + ldsw + _i * 8192), 16, 0, 0); } while (0)
#define PG8_STAGEA(bufoff, h, plin, kb) do { if constexpr (GATHER) PG8_STAGE(bufoff, Ab + (kb), curA[h]); else PG8_STAGE(bufoff, (plin) + (h) * hstep, voffA); } while (0)
#define PG8_LDA(dst, b, h) do { _Pragma("unroll") for (int m = 0; m < 4; ++m) _Pragma("unroll") for (int k = 0; k < 2; ++k) dst[m][k] = *(const PG8_LAS bf16x8*)(lds + PG8_SA(b, h) + aoff + m * 2048 + k * 1024); } while (0)
#define PG8_LDB(dst, b, h) do { _Pragma("unroll") for (int n = 0; n < 2; ++n) _Pragma("unroll") for (int k = 0; k < 2; ++k) dst[n][k] = *(const PG8_LAS bf16x8*)(lds + PG8_SB(b, h) + boff + n * 2048 + k * 1024); } while (0)
#define PG8_CAT(x0, x1) __builtin_shufflevector(__builtin_bit_cast(i32x4v, x0), __builtin_bit_cast(i32x4v, x1), 0, 1, 2, 3, 4, 5, 6, 7)
#define PG8_MMA(ai, bj, At, Bt_) do { __builtin_amdgcn_s_setprio(1); \
        if constexpr (FP8) { _Pragma("unroll") for (int m = 0; m < 4; ++m) _Pragma("unroll") for (int n = 0; n < 2; ++n) \
            acc[ai][bj][m][n] = __builtin_amdgcn_mfma_scale_f32_16x16x128_f8f6f4(PG8_CAT(Bt_[n][0], Bt_[n][1]), PG8_CAT(At[m][0], At[m][1]), acc[ai][bj][m][n], 0, 0, 0, sclB, 0, sclA); } \
        else { _Pragma("unroll") for (int m = 0; m < 4; ++m) _Pragma("unroll") for (int n = 0; n < 2; ++n) _Pragma("unroll") for (int k = 0; k < 2; ++k) \
            acc[ai][bj][m][n] = __builtin_amdgcn_mfma_f32_16x16x32_bf16(Bt_[n][k], At[m][k], acc[ai][bj][m][n], 0, 0, 0); } \
        __builtin_amdgcn_s_setprio(0); } while (0)
#define PG8_WAIT_V(n) asm volatile("s_waitcnt vmcnt(" #n ")" ::: "memory")
#define PG8_WAIT_L(n) asm volatile("s_waitcnt lgkmcnt(" #n ")" ::: "memory")
#define PG8_BAR __builtin_amdgcn_s_barrier()
#define PG8_SCHED __builtin_amdgcn_sched_barrier(0)
    Unit cur, nxt; int ui = 0;
    if (!S.next(0, cur)) return;
    f32x4 acc[2][2][4][2];
#pragma unroll
    for (int a = 0; a < 2; ++a)
#pragma unroll
        for (int b = 0; b < 2; ++b)
#pragma unroll
            for (int m = 0; m < 4; ++m)
#pragma unroll
                for (int n = 0; n < 2; ++n) acc[a][b][m][n] = (f32x4){0.f, 0.f, 0.f, 0.f};
    bf16x8 At[4][2], B0[2][2], B1[2][2];
    unsigned curA[2][2] = {{0u, 0u}, {0u, 0u}}, nxtA[2][2] = {{0u, 0u}, {0u, 0u}};
    if constexpr (GATHER) AR.offs(cur, RA, CA, pitch, curA);
    const char* cA = GATHER ? Ab : Ab + (size_t)cur.pm * tstep;
    const char* cB = (const char*)Bt + (size_t)cur.pn * tstep;
    PG8_STAGE(PG8_SB(0, 0), cB, voffB); PG8_STAGE(PG8_SB(0, 1), cB + hstep, voffB); PG8_STAGEA(PG8_SA(0, 0), 0, cA, 0); PG8_STAGEA(PG8_SA(0, 1), 1, cA, 0);
    if (wr == 1) PG8_BAR;
    PG8_WAIT_V(2); PG8_BAR;
    PG8_STAGE(PG8_SB(1, 0), cB + kstep, voffB); PG8_STAGEA(PG8_SA(1, 0), 0, cA + kstep, kstep); PG8_STAGE(PG8_SB(1, 1), cB + hstep + kstep, voffB);
    PG8_WAIT_V(6); PG8_BAR;
    for (;;) {
        const bool has_next = S.next(ui + 1, nxt);
        if constexpr (GATHER) {
            if (has_next) AR.offs(nxt, RA, CA, pitch, nxtA);
            else {
#pragma unroll
                for (int h = 0; h < 2; ++h)
#pragma unroll
                    for (int i = 0; i < 2; ++i) nxtA[h][i] = curA[h][i];
            }
        }
        const char* nA = GATHER ? Ab : (has_next ? Ab + (size_t)nxt.pm * tstep : cA);
        const char* nB = has_next ? (const char*)Bt + (size_t)nxt.pn * tstep : cB;
        for (int t = 0; t < nt; t += 2) {
            const bool last = (t == nt - 2);
            const size_t k1 = (size_t)(t + 1) * kstep, k2 = last ? 0 : (size_t)(t + 2) * kstep, k3 = k2 + kstep;
            const char* a1 = cA + k1;
            const char* a2 = last ? nA : cA + k2; const char* b2 = last ? nB : cB + k2;
            const char* a3 = a2 + kstep; const char* b3 = b2 + kstep;
            PG8_LDB(B0, 0, 0); PG8_LDB(B1, 0, 1); PG8_SCHED; PG8_LDA(At, 0, 0); PG8_STAGEA(PG8_SA(1, 1), 1, a1, k1);
            if constexpr (GATHER) { if (last) {
#pragma unroll
                for (int h = 0; h < 2; ++h)
#pragma unroll
                    for (int i = 0; i < 2; ++i) curA[h][i] = nxtA[h][i]; } }
            PG8_WAIT_V(8); PG8_WAIT_L(0); PG8_BAR; PG8_MMA(0, 0, At, B0); PG8_MMA(0, 1, At, B1); PG8_BAR; PG8_SCHED;
            PG8_LDA(At, 0, 1); PG8_STAGE(PG8_SB(0, 0), b2, voffB); PG8_STAGE(PG8_SB(0, 1), b2 + hstep, voffB); PG8_STAGEA(PG8_SA(0, 0), 0, a2, k2);
            PG8_WAIT_V(8); PG8_WAIT_L(0); PG8_BAR; PG8_MMA(1, 0, At, B0); PG8_MMA(1, 1, At, B1); PG8_BAR; PG8_SCHED;
            PG8_LDB(B0, 1, 0); PG8_LDB(B1, 1, 1); PG8_SCHED; PG8_LDA(At, 1, 0); PG8_STAGEA(PG8_SA(0, 1), 1, a2, k2);
            PG8_WAIT_V(8); PG8_WAIT_L(0); PG8_BAR; PG8_MMA(0, 0, At, B0); PG8_MMA(0, 1, At, B1); PG8_BAR; PG8_SCHED;
            PG8_LDA(At, 1, 1); PG8_STAGE(PG8_SB(1, 0), b3, voffB); PG8_STAGE(PG8_SB(1, 1), b3 + hstep, voffB); PG8_STAGEA(PG8_SA(1, 0), 0, a3, k3);
            PG8_WAIT_V(8); PG8_WAIT_L(0); PG8_BAR; PG8_MMA(1, 0, At, B0); PG8_MMA(1, 1, At, B1); PG8_BAR; PG8_SCHED;
        }
        if constexpr (ALIGN_EPI) { if (wr == 0) PG8_BAR; }
        E(acc, cur, wr, wc, fr, fq);
        if (!has_next) break;
#pragma unroll
        for (int a = 0; a < 2; ++a)
#pragma unroll
            for (int b = 0; b < 2; ++b)
#pragma unroll
                for (int m = 0; m < 4; ++m)
#pragma unroll
                    for (int n = 0; n < 2; ++n) acc[a][b][m][n] = (f32x4){0.f, 0.f, 0.f, 0.f};
        cur = nxt; cA = nA; cB = nB; ++ui;
        if constexpr (ALIGN_EPI) { if (wr == 1) PG8_BAR; }
    }
    PG8_WAIT_V(0);
    if constexpr (!ALIGN_EPI) { if (wr == 0) PG8_BAR; }
    PG8_BAR;
#undef PG8_SA
#undef PG8_SB
#undef PG8_STAGE
#undef PG8_STAGEA
#undef PG8_LDA
#undef PG8_LDB
#undef PG8_MMA
#undef PG8_CAT
#undef PG8_WAIT_V
#undef PG8_WAIT_L
#undef PG8_BAR
#undef PG8_SCHED
}

#define PG8_OPAQUE(x) asm volatile("" : "+v"(x))
struct EpiStoreBf16 {
    static constexpr bool PERM = true;
    bf16_t* O; int ldc;
    __device__ __forceinline__ void operator()(const f32x4 (&acc)[2][2][4][2], const Unit& u, int wr, int wc, int fr, int fq) const {
        char* base = (char*)(O + (size_t)(u.pm * BM) * ldc + u.pn * BM);
        unsigned lb = (unsigned)((wr * 64 + fr) * ldc + wc * 32 + 8 * fq) * 2u; PG8_OPAQUE(lb);
        const unsigned rstep = (unsigned)ldc * 32u;
#pragma unroll
        for (int ai = 0; ai < 2; ++ai)
#pragma unroll
            for (int m = 0; m < 4; ++m) { const unsigned ro = lb + (unsigned)(ai * 8 + m) * rstep;
#pragma unroll
                for (int bj = 0; bj < 2; ++bj) { const f32x4 v0 = acc[ai][bj][m][0], v1 = acc[ai][bj][m][1];
                    u32x4 w; w.x = pk2(v0[0], v0[1]); w.y = pk2(v0[2], v0[3]); w.z = pk2(v1[0], v1[1]); w.w = pk2(v1[2], v1[3]);
                    *(u32x4*)(base + ro + bj * (HALF * 2)) = w; } }
    }
};
struct EpiResGate {
    static constexpr bool PERM = false;
    const float* src_ctx; const float* src_lat; float* dst_ctx; float* dst_lat; const float* gate_lat; const float* gate_ctx; int row_base;
    __device__ __forceinline__ void operator()(const f32x4 (&acc)[2][2][4][2], const Unit& u, int wr, int wc, int fr, int fq) const {
        const int rowu = row_base + u.pm * BM; const bool isctx = rowu < NCTX;
        const char* src = (const char*)(isctx ? src_ctx + (size_t)rowu * DM : src_lat + (size_t)(rowu - NCTX) * DM) + u.pn * (BM * 4);
        char* dst = (char*)(isctx ? dst_ctx + (size_t)rowu * DM : dst_lat + (size_t)(rowu - NCTX) * DM) + u.pn * (BM * 4);
        const float* gate = (isctx ? gate_ctx : gate_lat + (size_t)((rowu - NCTX) / SEQ) * 6144) + u.pn * BM;
        const int cl = wc * 32 + 4 * fq;
        f32x4 sc[2][2][4][2];
#pragma unroll
        for (int bj = 0; bj < 2; ++bj)
#pragma unroll
            for (int n = 0; n < 2; ++n) { const f32x4 gv = *(const f32x4*)(gate + cl + bj * HALF + n * 16);
#pragma unroll
                for (int ai = 0; ai < 2; ++ai)
#pragma unroll
                    for (int m = 0; m < 4; ++m) sc[ai][bj][m][n] = acc[ai][bj][m][n] * gv; }
        unsigned lb = (unsigned)((wr * 64 + fr) * DM + cl) * 4u; PG8_OPAQUE(lb);
#pragma unroll
        for (int ai = 0; ai < 2; ++ai)
#pragma unroll
            for (int m = 0; m < 4; ++m) { const unsigned ro = lb + (unsigned)(ai * 8 + m) * (16u * DM * 4u);
#pragma unroll
                for (int bj = 0; bj < 2; ++bj)
#pragma unroll
                    for (int n = 0; n < 2; ++n) { const unsigned o = ro + (unsigned)(bj * HALF + n * 16) * 4u; const f32x4 s = *(const f32x4*)(src + o);
                        *(f32x4*)(dst + o) = s + sc[ai][bj][m][n]; }
                asm volatile("" ::: "memory"); }
    }
};
template <bool MOE> struct EpiSwiglu {
    static constexpr bool PERM = true;
    static constexpr bool OUT8 = MOE ? (MOE_FP8 != 0) : (DENSE_FP8 != 0);
    bf16_t* O; int ldc; int ncol; const float* prow;
    __device__ __forceinline__ void operator()(const f32x4 (&acc)[2][2][4][2], const Unit& u, int wr, int wc, int fr, int fq) const {
        const int pnl = MOE ? (u.pn % ncol) : u.pn;
        constexpr int ES = OUT8 ? 1 : 2;
        char* base = (char*)O + ((size_t)(u.pm * BM) * ldc + pnl * HALF) * ES;
        unsigned lb = (unsigned)((wr * 64 + fr) * ldc + wc * 32 + 8 * fq) * ES; PG8_OPAQUE(lb);
        const unsigned rstep = (unsigned)ldc * 16u * ES;
        const float* pr = MOE ? prow + u.pm * BM : nullptr;
        unsigned pl = (unsigned)(wr * 64 + fr) * 4u; PG8_OPAQUE(pl);
#pragma unroll
        for (int ai = 0; ai < 2; ++ai)
#pragma unroll
            for (int m = 0; m < 4; ++m) {
                float pw = 1.0f; if (MOE) pw = *(const float*)((const char*)pr + pl + (unsigned)(ai * 8 + m) * 64u);
                if (OUT8) pw *= QS_H;
                float hv[8];
#pragma unroll
                for (int n = 0; n < 2; ++n)
#pragma unroll
                    for (int j = 0; j < 4; ++j) { const float g = acc[ai][0][m][n][j], up = acc[ai][1][m][n][j]; hv[n * 4 + j] = g * sigmoidf_(g) * up * pw; }
                if constexpr (OUT8) { u32x2 w; w.x = pk4_fp8(hv[0], hv[1], hv[2], hv[3]); w.y = pk4_fp8(hv[4], hv[5], hv[6], hv[7]);
                    *(u32x2*)(base + lb + (unsigned)(ai * 8 + m) * rstep) = w; }
                else { u32x4 w; w.x = pk2(hv[0], hv[1]); w.y = pk2(hv[2], hv[3]); w.z = pk2(hv[4], hv[5]); w.w = pk2(hv[6], hv[7]);
                    *(u32x4*)(base + lb + (unsigned)(ai * 8 + m) * rstep) = w; } }
    }
};
struct EpiMoeScatter {
    static constexpr bool PERM = false;
    const int* rowmap; float* hlat; const float* gate_lat; int ncol;
    __device__ __forceinline__ void operator()(const f32x4 (&acc)[2][2][4][2], const Unit& u, int wr, int wc, int fr, int fq) const {
        const int pnl = u.pn % ncol;
        const int* rm = rowmap + u.pm * BM;
        char* hb = (char*)hlat + pnl * (BM * 4); const char* gb = (const char*)gate_lat + pnl * (BM * 4);
        unsigned pl = (unsigned)(wr * 64 + fr) * 4u; PG8_OPAQUE(pl);
        unsigned cb = (unsigned)(wc * 32 + 4 * fq) * 4u; PG8_OPAQUE(cb);
#pragma unroll
        for (int ai = 0; ai < 2; ++ai)
#pragma unroll
            for (int m = 0; m < 4; ++m) { const int tok = *(const int*)((const char*)rm + pl + (unsigned)(ai * 8 + m) * 64u);
                if (tok >= 0) { const unsigned ro = (unsigned)tok * (DM * 4u) + cb, go = ((unsigned)tok >> 11) * (6144u * 4u) + cb;
#pragma unroll
                    for (int bj = 0; bj < 2; ++bj)
#pragma unroll
                        for (int n = 0; n < 2; ++n) { const unsigned o = (unsigned)(bj * HALF + n * 16) * 4u; const f32x4 sv = *(const f32x4*)(hb + ro + o); const f32x4 gv = *(const f32x4*)(gb + go + o);
                            *(f32x4*)(hb + ro + o) = sv + gv * acc[ai][bj][m][n]; } }
                asm volatile("" ::: "memory"); }
    }
};
struct MoeOrder {
    int NT, ncol, G, c; const PG8_LAS int* texp;
    __device__ bool next(int i, Unit& u) const {
        const long L = (long)i * G + c; if (L >= (long)NT * ncol) return false;
        const int t = (int)(L / ncol), pnl = (int)(L % ncol);
        const int e = __builtin_amdgcn_readfirstlane(texp[t]);
        u.pm = t; u.pn = e * ncol + pnl; return true;
    }
};
}

#define XB_TMO      128
#define XB_XCNT(j)  (256  + 64 * (j))
#define XB_XSUB(j)  (1280 + 64 * (j))
#define XB_XGEN(j)  (2304 + 64 * (j))
#define XB_TOP      3328
#define XB_TOPGEN   3392
#define XCD_BAR_WORDS 3456
#define XB_SPIN_CAP (1u << 18)
DI unsigned xb_ld(unsigned* p)              { return __hip_atomic_load(p, __ATOMIC_RELAXED, __HIP_MEMORY_SCOPE_AGENT); }
DI unsigned xb_add(unsigned* p, unsigned v) { return __hip_atomic_fetch_add(p, v, __ATOMIC_RELAXED, __HIP_MEMORY_SCOPE_AGENT); }
DI unsigned xb_xcc_id() { return (unsigned)__builtin_amdgcn_s_getreg((3 << 11) | 20) & 0xFu; }
#define XB_SPIN(cond, bar) do { unsigned _sp = 0; while (cond) { __builtin_amdgcn_s_sleep(1); \
    if ((++_sp & 255u) == 0u) { if (xb_ld(&(bar)[XB_TMO])) break; if (_sp > XB_SPIN_CAP) { atomicAdd(&(bar)[XB_TMO], 1u); break; } } } } while (0)
struct XcdBarrier { unsigned* bar; unsigned x; volatile LAS unsigned* st; };
DI XcdBarrier xcd_barrier_post(unsigned* bar, volatile LAS unsigned* st) {
    XcdBarrier b; b.bar = bar; b.x = xb_xcc_id(); b.st = st;
    if (threadIdx.x == 0) (void)xb_add(&bar[XB_XCNT(b.x)], 1u);
    return b;
}
DI void xcd_barrier_complete(unsigned* bar, unsigned x, unsigned& nloc, unsigned& nx) {
    const unsigned G = gridDim.x * gridDim.y * gridDim.z;
    unsigned sum, cnt, mine, sp = 0u;
    for (;;) {
        sum = 0u; cnt = 0u; mine = 0u;
#pragma unroll
        for (unsigned j = 0; j < 16; ++j) { const unsigned c = xb_ld(&bar[XB_XCNT(j)]); sum += c; cnt += (c > 0u) ? 1u : 0u; mine = (j == x) ? c : mine; }
        if (sum == G) break;
        __builtin_amdgcn_s_sleep(1);
        if ((++sp & 255u) == 0u) { if (xb_ld(&bar[XB_TMO])) break; if (sp > XB_SPIN_CAP) { atomicAdd(&bar[XB_TMO], 1u); break; } }
    }
    nloc = mine > 0u ? mine : 1u; nx = cnt > 0u ? cnt : 1u;
}
DI void xcd_barrier(const XcdBarrier& b) {
    asm volatile("s_waitcnt vmcnt(0)" ::: "memory");
    __syncthreads();
    if (threadIdx.x == 0) {
        unsigned* bar = b.bar;
        __builtin_amdgcn_s_waitcnt(0);
        unsigned nloc = b.st[0], nx = b.st[1];
        if (nloc == 0u) { xcd_barrier_complete(bar, b.x, nloc, nx); b.st[0] = nloc; b.st[1] = nx; }
        const unsigned old = xb_add(&bar[XB_XSUB(b.x)], 1u);
        const unsigned gen = old / nloc;
        if (old + 1u == (gen + 1u) * nloc) {
            __builtin_amdgcn_fence(__ATOMIC_RELEASE, "agent");
            asm volatile("s_waitcnt vmcnt(0)" ::: "memory");
            const unsigned og = xb_add(&bar[XB_TOP], 1u);
            const unsigned tg = og / nx;
            if (og + 1u == (tg + 1u) * nx) xb_add(&bar[XB_TOPGEN], 1u);
            else XB_SPIN(xb_ld(&bar[XB_TOPGEN]) == tg, bar);
            __builtin_amdgcn_fence(__ATOMIC_ACQUIRE, "agent");
            xb_add(&bar[XB_XGEN(b.x)], 1u);
            asm volatile("s_waitcnt vmcnt(0)" ::: "memory");
        } else {
            XB_SPIN(xb_ld(&bar[XB_XGEN(b.x)]) == gen, bar);
            __builtin_amdgcn_fence(__ATOMIC_ACQUIRE, "agent");
            asm volatile("s_waitcnt vmcnt(0)" ::: "memory");
        }
    }
    __syncthreads();
}

struct Params { const float* in[26]; float* out; unsigned char* ws; int ph_lo, ph_hi, pad0, pad1; };
enum { I_X = 0, I_C, I_CTX, I_CCTX, I_WMOD, I_BMOD, I_N1W, I_N2W, I_WIN, I_WOUT, I_RPB, I_CONVW, I_CONVB, I_CLNW, I_CLNB, I_RDEC, I_RGNW,
       I_FG, I_FU, I_FD, I_MR, I_MRB, I_MG, I_MU, I_MDN, I_FNW };
constexpr int PH_P0 = 0, PH_FINAL = 20, N_PHASES = 21;

typedef __attribute__((address_space(4))) const unsigned char* karg_t;
struct KIn {
    karg_t ka;
    DI const float* operator[](int k) const { return *(const float* __attribute__((address_space(4))) const*)(ka + 8 * k); }
};
struct Frame {
    LAS unsigned char* lds;
    int tid, lane, wave, G, bid, vb;
    KIn in; float* out; unsigned char* ws;
};
DI Frame phase_frame(const Frame& F0) {
    Frame F; karg_t ka = F0.in.ka; asm volatile("" : "+s"(ka)); F.in.ka = ka;
    F.out = *(float* __attribute__((address_space(4))) const*)(ka + 208);
    F.ws = *(unsigned char* __attribute__((address_space(4))) const*)(ka + 216);
    int tid = F0.tid, G = F0.G, bid = F0.bid; unsigned ldsb = (unsigned)(size_t)F0.lds;
    asm volatile("" : "+v"(tid)); asm volatile("" : "+s"(G)); asm volatile("" : "+s"(bid)); asm volatile("" : "+s"(ldsb));
    F.tid = tid; F.lane = tid & 63; F.wave = __builtin_amdgcn_readfirstlane(tid >> 6); F.G = G; F.bid = bid; F.lds = (LAS unsigned char*)(size_t)ldsb;
    F.vb = (G % 8 == 0) ? (bid % 8) * (G / 8) + bid / 8 : bid;
    return F;
}

DI void p0_transpose_item(const float* W, int K, int N, bf16* WT, int k0, int n0, int dst_row0, LAS float* scr, int lane) {
#pragma unroll 8
    for (int i = 0; i < 32; ++i) { const int kk = 2 * i + (lane >> 5); scr[kk * 33 + (lane & 31)] = W[(size_t)(k0 + kk) * N + n0 + (lane & 31)]; }
    asm volatile("s_waitcnt lgkmcnt(0)" ::: "memory");
    const int c = lane & 7;
#pragma unroll
    for (int j = 0; j < 4; ++j) { const int n = (lane >> 3) + 8 * j; const LAS float* s = scr + (8 * c) * 33 + n;
        u32x4 o; o.x = pk2(s[0 * 33], s[1 * 33]); o.y = pk2(s[2 * 33], s[3 * 33]); o.z = pk2(s[4 * 33], s[5 * 33]); o.w = pk2(s[6 * 33], s[7 * 33]);
        *(u32x4*)(WT + (size_t)(dst_row0 + n) * K + k0 + 8 * c) = o; }
    asm volatile("s_waitcnt lgkmcnt(0)" ::: "memory");
}
DI void p0_convert_plain(Frame& F, const float* W, int K, int N, bf16* WT, int item, LAS float* scr) {
    const int nblk = N / 32, kb = item / nblk, nb = item % nblk;
    p0_transpose_item(W, K, N, WT, 64 * kb, 32 * nb, 32 * nb, scr, F.lane);
}
DI void p0_convert_gu(Frame& F, const float* W, int K, int N, bf16* WT, int item, int up, LAS float* scr) {
    const int nblk = N / 32, kb = item / nblk, nb = item % nblk, n0 = 32 * nb;
    p0_transpose_item(W, K, N, WT, 64 * kb, n0, 256 * (n0 / 128) + (n0 % 128) + (up ? 128 : 0), scr, F.lane);
}
DI void conv_item64(const float* W, int K, int N, bf16* WT, int k0, int n0, int dst_row0, LAS unsigned* scr, int lane) {
    const float* wp = W + (size_t)k0 * N + n0 + lane;
    float v[64];
#pragma unroll
    for (int i = 0; i < 64; ++i) v[i] = wp[(size_t)i * N];
#pragma unroll
    for (int i = 0; i < 32; ++i) scr[i * 65 + lane] = pk2(v[2 * i], v[2 * i + 1]);
    asm volatile("s_waitcnt lgkmcnt(0)" ::: "memory");
    const int c = lane & 7;
#pragma unroll
    for (int j = 0; j < 8; ++j) { const int n = (lane >> 3) + 8 * j; const LAS unsigned* sp = scr + (4 * c) * 65 + n;
        u32x4 o; o.x = sp[0]; o.y = sp[65]; o.z = sp[130]; o.w = sp[195];
        *(u32x4*)(WT + (size_t)(dst_row0 + n) * K + k0 + 8 * c) = o; }
    asm volatile("s_waitcnt lgkmcnt(0)" ::: "memory");
}
DI void conv_item64_fp8(const float* W, int K, int N, unsigned char* WT, int k0, int n0, int dst_row0, float qs, LAS unsigned* scr, int lane) {
    const float* wp = W + (size_t)k0 * N + n0 + lane;
    float v[64];
#pragma unroll
    for (int i = 0; i < 64; ++i) v[i] = wp[(size_t)i * N];
#pragma unroll
    for (int i = 0; i < 16; ++i) scr[i * 65 + lane] = pk4_fp8(v[4 * i] * qs, v[4 * i + 1] * qs, v[4 * i + 2] * qs, v[4 * i + 3] * qs);
    asm volatile("s_waitcnt lgkmcnt(0)" ::: "memory");
    const int c = lane & 3;
#pragma unroll
    for (int j = 0; j < 4; ++j) { const int n = (lane >> 2) + 16 * j; const LAS unsigned* sp = scr + (4 * c) * 65 + n;
        u32x4 o; o.x = sp[0]; o.y = sp[65]; o.z = sp[130]; o.w = sp[195];
        *(u32x4*)(WT + (size_t)(dst_row0 + n) * K + k0 + 16 * c) = o; }
    asm volatile("s_waitcnt lgkmcnt(0)" ::: "memory");
}
constexpr int BG_ITEMS = 21504;
constexpr int BG_B0 = 0, BG_D0 = 1200, BG_E0 = 5200, BG_F0 = 8700, BG_B1 = 19700, BG_CL = 20900;
DI void bg_item(Frame& F, int g, LAS unsigned* scr) {
    if (g < 14336) { const int m = g / 896, e = m >> 1, up = m & 1, r = g % 896, kb = r / 56, nb = r % 56, n0 = 64 * nb; const int drow = 256 * (n0 / 128) + (n0 % 128) + (up ? 128 : 0);
#if MOE_FP8
        conv_item64_fp8(F.in[up ? I_MU : I_MG] + (size_t)e * 1024 * 3584, 1024, 3584, F.ws + WS_MGU + (size_t)e * 7168 * 1024, 64 * kb, n0, drow, QS_WGU, scr, F.lane);
#else
        conv_item64(F.in[up ? I_MU : I_MG] + (size_t)e * 1024 * 3584, 1024, 3584, (bf16*)(F.ws + WS_MGU) + (size_t)e * 7168 * 1024, 64 * kb, n0, drow, scr, F.lane);
#endif
    } else { const int gg = g - 14336, e = gg / 896, r = gg % 896, kb = r / 16, nb = r % 16;
#if MOE_FP8
        conv_item64_fp8(F.in[I_MDN] + (size_t)e * 3584 * 1024, 3584, 1024, F.ws + WS_MD + (size_t)e * 1024 * 3584, 64 * kb, 64 * nb, 64 * nb, QS_WD, scr, F.lane);
#else
        conv_item64(F.in[I_MDN] + (size_t)e * 3584 * 1024, 3584, 1024, (bf16*)(F.ws + WS_MD) + (size_t)e * 1024 * 3584, 64 * kb, 64 * nb, 64 * nb, scr, F.lane);
#endif
    }
}
DI void bg_convert_tail(Frame& F, int nwg, int lo, int hi) {
    const int nmax = (nwg + F.G - 1) / F.G, rem = nwg - (nmax - 1) * F.G;
    if (F.bid < rem || rem >= F.G) return;
    LAS unsigned* scr = (LAS unsigned*)(F.lds + F.wave * 8320);
    const int w = (F.bid - rem) * 8 + F.wave, nw = (F.G - rem) * 8;
    for (int g = lo + w; g < hi; g += nw) bg_item(F, g, scr);
}
DI void bg_convert_all(Frame& F, int lo, int hi) {
    LAS unsigned* scr = (LAS unsigned*)(F.lds + F.wave * 8320);
    for (int g = lo + F.bid * 8 + F.wave; g < hi; g += F.G * 8) bg_item(F, g, scr);
}
DI void p0_prologue(Frame& F) {
    {
        LAS float* Sx = (LAS float*)F.lds;
        LAS float* red = (LAS float*)(F.lds + 81920);
        bool staged = false;
        for (int unit = F.bid; unit < 192; unit += F.G) {
            if (!staged) {
                for (int idx = F.tid; idx < 17 * 1024; idx += 512) { const int r = idx / 1024, k = idx % 1024;
                    const float v = r < 16 ? F.in[I_C][r * 1024 + k] : F.in[I_CCTX][k]; Sx[k * 20 + r] = v * sigmoidf_(v); }
                staged = true; __syncthreads();
            }
            const int l = unit / 96, n0 = (unit % 96) * 64;
            const float* Wm = F.in[I_WMOD] + (size_t)l * 1024 * 6144 + n0 + F.lane;
            float acc[17];
#pragma unroll
            for (int r = 0; r < 17; ++r) acc[r] = 0.f;
            const int kb = F.wave * 128;
#pragma unroll 4
            for (int k = 0; k < 128; ++k) { const float wv = Wm[(size_t)(kb + k) * 6144]; const LAS float* sp = Sx + (kb + k) * 20;
                const f32x4 s0 = *(const LAS f32x4*)(sp), s1 = *(const LAS f32x4*)(sp + 4), s2 = *(const LAS f32x4*)(sp + 8), s3 = *(const LAS f32x4*)(sp + 12); const float s4 = sp[16];
                acc[0] += s0[0] * wv; acc[1] += s0[1] * wv; acc[2] += s0[2] * wv; acc[3] += s0[3] * wv; acc[4] += s1[0] * wv; acc[5] += s1[1] * wv; acc[6] += s1[2] * wv; acc[7] += s1[3] * wv;
                acc[8] += s2[0] * wv; acc[9] += s2[1] * wv; acc[10] += s2[2] * wv; acc[11] += s2[3] * wv; acc[12] += s3[0] * wv; acc[13] += s3[1] * wv; acc[14] += s3[2] * wv; acc[15] += s3[3] * wv;
                acc[16] += s4 * wv; }
#pragma unroll
            for (int r = 0; r < 17; ++r) red[(F.wave * 17 + r) * 64 + F.lane] = acc[r];
            __syncthreads();
            for (int idx = F.tid; idx < 17 * 64; idx += 512) { const int r = idx / 64, ln = idx % 64; float s = F.in[I_BMOD][l * 6144 + n0 + ln];
#pragma unroll
                for (int w = 0; w < 8; ++w) s += red[(w * 17 + r) * 64 + ln];
                if (r < 16) ((float*)(F.ws + WS_MODLAT))[((size_t)l * 16 + r) * 6144 + n0 + ln] = s; else ((float*)(F.ws + WS_MODCTX))[(size_t)l * 6144 + n0 + ln] = s; }
            __syncthreads();
        }
        __syncthreads();
    }
    if (F.bid == 0) { const int pos = F.tid >> 3, j = F.tid & 7; const float inv = exp2f(-(float)j * 0.125f * 13.287712379549449f); const float ang = (float)pos * inv;
        float* tab = (float*)(F.ws + WS_ROPE); tab[(pos * 8 + j) * 2] = cosf(ang); tab[(pos * 8 + j) * 2 + 1] = sinf(ang); }
    {
        LAS float* scr = (LAS float*)(F.lds + F.wave * 16384);
        const int gw = F.bid * 8 + F.wave, NGW = F.G * 8;
        constexpr int I_IN = 16 * 96, I_OUT = 16 * 32, I_G = 16 * 88, I_D = 44 * 32, I_MGI = 16 * 112, I_MDI = 56 * 32;
        constexpr int NITEMS = 2 * I_IN + 2 * I_OUT + (DENSE_FP8 == 1 ? 3 * 704 : (DENSE_FP8 == 2 ? 2 * I_G + 704 : 2 * I_G + I_D));
        for (int it = gw; it < NITEMS; it += NGW) {
            int r = it;
            if (r < 2 * I_IN) { const int l = r / I_IN; p0_convert_plain(F, F.in[I_WIN] + (size_t)l * 1024 * 3072, 1024, 3072, (bf16*)(F.ws + WS_WIN) + (size_t)l * 3072 * 1024, r % I_IN, scr); continue; } r -= 2 * I_IN;
            if (r < 2 * I_OUT) { const int l = r / I_OUT; p0_convert_plain(F, F.in[I_WOUT] + (size_t)l * 1024 * 1024, 1024, 1024, (bf16*)(F.ws + WS_WOUT) + (size_t)l * 1024 * 1024, r % I_OUT, scr); continue; } r -= 2 * I_OUT;
#if DENSE_FP8 == 2
            if (r < I_G) { p0_convert_gu(F, F.in[I_FG], 1024, 2816, (bf16*)(F.ws + WS_WGU), r, 0, scr); continue; } r -= I_G;
            if (r < I_G) { p0_convert_gu(F, F.in[I_FU], 1024, 2816, (bf16*)(F.ws + WS_WGU), r, 1, scr); continue; } r -= I_G;
            { const int kb = r / 16, nb = r % 16; conv_item64_fp8(F.in[I_FD], 2816, 1024, F.ws + WS_WD, 64 * kb, 64 * nb, 64 * nb, QS_WD, (LAS unsigned*)scr, F.lane); }
#elif DENSE_FP8 == 1
            { LAS unsigned* scr8 = (LAS unsigned*)scr;
              if (r < 1408) { const int up = r / 704, q = r % 704, kb = q / 44, nb = q % 44, n0 = 64 * nb;
                  conv_item64_fp8(F.in[up ? I_FU : I_FG], 1024, 2816, F.ws + WS_WGU, 64 * kb, n0, 256 * (n0 / 128) + (n0 % 128) + (up ? 128 : 0), QS_WGU, scr8, F.lane); }
              else { const int q = r - 1408, kb = q / 16, nb = q % 16; conv_item64_fp8(F.in[I_FD], 2816, 1024, F.ws + WS_WD, 64 * kb, 64 * nb, 64 * nb, QS_WD, scr8, F.lane); } }
#else
            if (r < I_G) { p0_convert_gu(F, F.in[I_FG], 1024, 2816, (bf16*)(F.ws + WS_WGU), r, 0, scr); continue; } r -= I_G;
            if (r < I_G) { p0_convert_gu(F, F.in[I_FU], 1024, 2816, (bf16*)(F.ws + WS_WGU), r, 1, scr); continue; } r -= I_G;
            p0_convert_plain(F, F.in[I_FD], 2816, 1024, (bf16*)(F.ws + WS_WD), r, scr);
#endif
        }
    }
}

struct NormVecs { f32x4 gs[4], sh[4]; };
DI void norm_load_vecs(Frame& F, const float* g, const float* mod, int isc, int ish, NormVecs& V) {
#pragma unroll
    for (int j = 0; j < 4; ++j) { const f32x4 gv = ((const f32x4*)g)[F.lane + 64 * j], sv = ((const f32x4*)(mod + isc * DM))[F.lane + 64 * j]; V.gs[j] = gv * (sv + 1.0f); V.sh[j] = ((const f32x4*)(mod + ish * DM))[F.lane + 64 * j]; }
}
DI void norm_load_row(Frame& F, const float* srow, f32x4 (&v)[4]) {
    const f32x4* xr = (const f32x4*)srow + F.lane;
#pragma unroll
    for (int j = 0; j < 4; ++j) v[j] = xr[64 * j];
}
DI float norm_ssq(const f32x4 (&v)[4]) { float s = 0.f;
#pragma unroll
    for (int j = 0; j < 4; ++j) s += (v[j].x * v[j].x + v[j].y * v[j].y) + (v[j].z * v[j].z + v[j].w * v[j].w);
    return s; }
DI void norm_finish(Frame& F, const f32x4 (&v)[4], float ssq_total, const NormVecs& V, bf16* orow, f32x4 (&y)[4]) {
    const float rstd = 1.0f / sqrtf(ssq_total * (1.0f / DM) + EPS);
    u32x2* o8 = (u32x2*)orow + F.lane;
#pragma unroll
    for (int j = 0; j < 4; ++j) { y[j] = (v[j] * rstd) * V.gs[j] + V.sh[j]; u32x2 w; w.x = pk2(y[j].x, y[j].y); w.y = pk2(y[j].z, y[j].w); o8[64 * j] = w; }
}
DI void norm_finish8(Frame& F, const f32x4 (&v)[4], float ssq_total, const NormVecs& V, unsigned char* orow, f32x4 (&y)[4]) {
    const float rstd = 1.0f / sqrtf(ssq_total * (1.0f / DM) + EPS);
    unsigned* o4 = (unsigned*)orow + F.lane;
#pragma unroll
    for (int j = 0; j < 4; ++j) { y[j] = (v[j] * rstd) * V.gs[j] + V.sh[j]; o4[64 * j] = pk4_fp8(y[j].x * QS_U, y[j].y * QS_U, y[j].z * QS_U, y[j].w * QS_U); }
}
DI void norm_phase(Frame& F, int l, int which, bool first, int row_lo, bool out8 = false) {
    const float* g = F.in[which == 1 ? I_N1W : I_N2W] + l * DM;
    const float* modlat = (const float*)(F.ws + WS_MODLAT) + (size_t)l * 16 * 6144;
    const float* modctx = (const float*)(F.ws + WS_MODCTX) + (size_t)l * 6144;
    const int ish = which == 1 ? 0 : 3, isc = which == 1 ? 1 : 4;
    const float* sctx = first ? F.in[I_CTX] : (const float*)(F.ws + WS_HCTX);
    const float* slat = first ? F.in[I_X] : F.out;
    bf16* U = (bf16*)(F.ws + WS_U);
    const int gw = F.bid * 8 + F.wave, NGW = F.G * 8;
    const int rpw = (NTOK - row_lo + NGW - 1) / NGW;
    const int r0 = row_lo + gw * rpw; int r1 = r0 + rpw; if (r1 > NTOK) r1 = NTOK;
    NormVecs V; int curb = -2;
    for (int row = r0; row < r1; row += 2) {
        const bool two = row + 1 < r1;
        const int rowb = two ? row + 1 : row;
        f32x4 va[4], vb[4];
        norm_load_row(F, row < NCTX ? sctx + (size_t)row * DM : slat + (size_t)(row - NCTX) * DM, va);
        norm_load_row(F, rowb < NCTX ? sctx + (size_t)rowb * DM : slat + (size_t)(rowb - NCTX) * DM, vb);
        float sa = norm_ssq(va), sb = norm_ssq(vb);
#pragma unroll
        for (int o = 1; o < 64; o <<= 1) { sa += __shfl_xor(sa, o); sb += __shfl_xor(sb, o); }
        f32x4 y[4];
        { const int bk = row < NCTX ? -1 : (row - NCTX) / SEQ; if (bk != curb) { norm_load_vecs(F, g, bk < 0 ? modctx : modlat + (size_t)bk * 6144, isc, ish, V); curb = bk; } }
        if (out8) norm_finish8(F, va, sa, V, (unsigned char*)U + (size_t)row * DM, y); else norm_finish(F, va, sa, V, U + (size_t)row * DM, y);
        if (two) { const int bk = rowb < NCTX ? -1 : (rowb - NCTX) / SEQ; if (bk != curb) { norm_load_vecs(F, g, bk < 0 ? modctx : modlat + (size_t)bk * 6144, isc, ish, V); curb = bk; }
            if (out8) norm_finish8(F, vb, sb, V, (unsigned char*)U + (size_t)rowb * DM, y); else norm_finish(F, vb, sb, V, U + (size_t)rowb * DM, y); }
    }
}
DI void moe_route_row(Frame& F, const f32x4 (&y)[4], LAS const float* Rw, const float (&rb)[8], LAS int* sel, int tl, int tok) {
    float lg[8];
#pragma unroll
    for (int e = 0; e < 8; ++e) lg[e] = 0.f;
#pragma unroll
    for (int j = 0; j < 4; ++j)
#pragma unroll
        for (int q = 0; q < 4; ++q) { const int k = 256 * j + 4 * F.lane + q; const f32x4 r0 = *(const LAS f32x4*)(Rw + k * 8), r1 = *(const LAS f32x4*)(Rw + k * 8 + 4); const float yv = y[j][q];
            lg[0] += yv * r0[0]; lg[1] += yv * r0[1]; lg[2] += yv * r0[2]; lg[3] += yv * r0[3]; lg[4] += yv * r1[0]; lg[5] += yv * r1[1]; lg[6] += yv * r1[2]; lg[7] += yv * r1[3]; }
#pragma unroll
    for (int o = 1; o < 64; o <<= 1) {
#pragma unroll
        for (int e = 0; e < 8; ++e) lg[e] += __shfl_xor(lg[e], o); }
#pragma unroll
    for (int e = 0; e < 8; ++e) lg[e] += rb[e];
    int e1 = 0; float v1 = lg[0];
#pragma unroll
    for (int e = 1; e < 8; ++e) if (lg[e] > v1) { v1 = lg[e]; e1 = e; }
    int e2 = -1; float v2 = -3.0e38f;
#pragma unroll
    for (int e = 0; e < 8; ++e) if (e != e1 && lg[e] > v2) { v2 = lg[e]; e2 = e; }
    const float ex = __expf(v2 - v1), p1 = 1.0f / (1.0f + ex), p2 = ex / (1.0f + ex);
    if (F.lane == 0) { sel[tl * 2] = e1; sel[tl * 2 + 1] = e2; float* pt = (float*)(F.ws + WS_PTOK) + (size_t)tok * 2; pt[0] = p1; pt[1] = p2; }
}
DI void norm_moe_phase(Frame& F) {
    const int l = 1;
    const float* g = F.in[I_N2W] + l * DM;
    const float* modlat = (const float*)(F.ws + WS_MODLAT) + (size_t)l * 16 * 6144;
    bf16* U = (bf16*)(F.ws + WS_U);
    LAS float* Rw = (LAS float*)F.lds;
    LAS int* sel = (LAS int*)(F.lds + 32768);
    for (int idx = F.tid; idx < 8192; idx += 512) Rw[idx] = F.in[I_MR][idx];
    __syncthreads();
    float rb[8];
#pragma unroll
    for (int e = 0; e < 8; ++e) rb[e] = F.in[I_MRB][e];
    NormVecs V; int curb = -2;
    for (int seg = F.bid; seg < 256; seg += F.G) {
        const int bk = (seg * 128) / SEQ; if (bk != curb) { norm_load_vecs(F, g, modlat + (size_t)bk * 6144, 4, 3, V); curb = bk; }
        for (int i = 0; i < 16; i += 2) {
            const int tl = F.wave * 16 + i, tok = seg * 128 + tl;
            f32x4 va[4], vb[4];
            norm_load_row(F, F.out + (size_t)tok * DM, va); norm_load_row(F, F.out + (size_t)(tok + 1) * DM, vb);
            float sa = norm_ssq(va), sb = norm_ssq(vb);
#pragma unroll
            for (int o = 1; o < 64; o <<= 1) { sa += __shfl_xor(sa, o); sb += __shfl_xor(sb, o); }
            f32x4 y[4];
#if MOE_FP8
            norm_finish8(F, va, sa, V, (unsigned char*)U + (size_t)tok * DM, y); moe_route_row(F, y, Rw, rb, sel, tl, tok);
            norm_finish8(F, vb, sb, V, (unsigned char*)U + (size_t)(tok + 1) * DM, y); moe_route_row(F, y, Rw, rb, sel, tl + 1, tok + 1);
#else
            norm_finish(F, va, sa, V, U + (size_t)(NCTX + tok) * DM, y); moe_route_row(F, y, Rw, rb, sel, tl, tok);
            norm_finish(F, vb, sb, V, U + (size_t)(NCTX + tok + 1) * DM, y); moe_route_row(F, y, Rw, rb, sel, tl + 1, tok + 1);
#endif
        }
        __syncthreads();
        if (F.tid < 16) { const int s = F.tid >> 3, e = F.tid & 7; int cnt = 0; int* lst = (int*)(F.ws + WS_SEGLIST) + ((size_t)(seg * 2 + s) * 8 + e) * 128;
            for (int i = 0; i < 128; ++i) if (sel[i * 2 + s] == e) lst[cnt++] = seg * 128 + i;
            ((int*)(F.ws + WS_SEGCNT))[(seg * 2 + s) * 8 + e] = cnt; }
        __syncthreads();
    }
}
DI void moe_route_phase(Frame& F) {
    LAS int* cn = (LAS int*)F.lds;
    LAS int* offs = cn + 2048;
    LAS int* tb = offs + 256;
    for (int unit = F.bid; unit < 16; unit += F.G) {
        const int s = unit >> 3, e = unit & 7;
        const int* segcnt = (const int*)(F.ws + WS_SEGCNT);
        for (int idx = F.tid; idx < 2048; idx += 512) { const int ee = idx >> 8, gsg = idx & 255; cn[idx] = segcnt[(gsg * 2 + s) * 8 + ee]; }
        __syncthreads();
        if (F.tid < 8) { int tot = 0; for (int gsg = 0; gsg < 256; ++gsg) tot += cn[F.tid * 256 + gsg]; tb[16 + F.tid] = tot; }
        if (F.tid == 64) { int run = 0; for (int gsg = 0; gsg < 256; ++gsg) { offs[gsg] = run; run += cn[e * 256 + gsg]; } }
        __syncthreads();
        if (F.tid == 0) { int run = 0; for (int ee = 0; ee < 8; ++ee) { tb[ee] = run; run += (tb[16 + ee] + 255) / 256; } tb[8] = run; }
        __syncthreads();
        int* rowmap = (int*)(F.ws + WS_ROWMAP) + (size_t)s * MOE_ROWS;
        float* prow = (float*)(F.ws + WS_PROW) + (size_t)s * MOE_ROWS;
        const float* ptok = (const float*)(F.ws + WS_PTOK);
        const int base = tb[e] * 256, tot = tb[16 + e], ntile = (tot + 255) / 256;
        if (F.tid < 256) { const int gsg = F.tid; const int c = cn[e * 256 + gsg]; const int* lst = (const int*)(F.ws + WS_SEGLIST) + ((size_t)(gsg * 2 + s) * 8 + e) * 128;
            for (int i = 0; i < c; ++i) { const int tok = lst[i]; rowmap[base + offs[gsg] + i] = tok; prow[base + offs[gsg] + i] = ptok[(size_t)tok * 2 + s]; } }
        for (int i = tot + F.tid; i < ntile * 256; i += 512) { rowmap[base + i] = -1; prow[base + i] = 0.f; }
        if (e == 0) { int* meta = (int*)(F.ws + WS_META) + s * 256;
            if (F.tid == 0) meta[0] = tb[8];
            if (F.tid < 8) { const int t0 = tb[F.tid], t1 = tb[F.tid + 1]; for (int t = t0; t < t1; ++t) meta[1 + t] = F.tid; } }
        __syncthreads();
    }
}
DI void final_phase(Frame& F) {
    const float* g = F.in[I_FNW];
    f32x4 gv[4];
#pragma unroll
    for (int j = 0; j < 4; ++j) gv[j] = ((const f32x4*)g)[F.lane + 64 * j];
    const int gw = F.bid * 8 + F.wave, NGW = F.G * 8;
    const int rpw = (NLAT + NGW - 1) / NGW; const int r0 = gw * rpw; int r1 = r0 + rpw; if (r1 > NLAT) r1 = NLAT;
    for (int row = r0; row < r1; row += 2) {
        const bool two = row + 1 < r1; const int rowb = two ? row + 1 : row;
        f32x4 va[4], vb[4];
        norm_load_row(F, F.out + (size_t)row * DM, va); norm_load_row(F, F.out + (size_t)rowb * DM, vb);
        float sa = norm_ssq(va), sb = norm_ssq(vb);
#pragma unroll
        for (int o = 1; o < 64; o <<= 1) { sa += __shfl_xor(sa, o); sb += __shfl_xor(sb, o); }
        const float ra = 1.0f / sqrtf(sa * (1.0f / DM) + EPS), rbv = 1.0f / sqrtf(sb * (1.0f / DM) + EPS);
        f32x4* xa = (f32x4*)(F.out + (size_t)row * DM) + F.lane; f32x4* xb = (f32x4*)(F.out + (size_t)rowb * DM) + F.lane;
#pragma unroll
        for (int j = 0; j < 4; ++j) xa[64 * j] = (va[j] * ra) * gv[j];
        if (two) {
#pragma unroll
            for (int j = 0; j < 4; ++j) xb[64 * j] = (vb[j] * rbv) * gv[j]; }
    }
}

DI void conv_unit(Frame& F, int l, int row0, int t0, int slen) {
    const bf16* PX = (const bf16*)(F.ws + WS_P);
    bf16* YC = (bf16*)(F.ws + WS_U);
    LAS float* Y = (LAS float*)F.lds;
    { u32x4 av[6], gv[6];
#pragma unroll
      for (int k = 0; k < 6; ++k) { const int it = F.tid + 512 * k; const int rr = it >> 5, cc = it & 31; const int t = t0 - 15 + rr;
          av[k] = (u32x4){0u, 0u, 0u, 0u}; gv[k] = av[k];
          if (it < 94 * 32 && t >= 0 && t < slen) { const bf16* p = PX + (size_t)(row0 + t) * INW + C_CONV + 8 * cc; av[k] = *(const u32x4*)p; gv[k] = *(const u32x4*)(p + 256); } }
#pragma unroll
      for (int k = 0; k < 6; ++k) { const int it = F.tid + 512 * k; const int rr = it >> 5, cc = it & 31;
          if (it < 94 * 32) { f32x4 o0, o1;
              o0[0] = bflo(av[k].x) * sigmoidf_(bflo(gv[k].x)); o0[1] = bfhi(av[k].x) * sigmoidf_(bfhi(gv[k].x)); o0[2] = bflo(av[k].y) * sigmoidf_(bflo(gv[k].y)); o0[3] = bfhi(av[k].y) * sigmoidf_(bfhi(gv[k].y));
              o1[0] = bflo(av[k].z) * sigmoidf_(bflo(gv[k].z)); o1[1] = bfhi(av[k].z) * sigmoidf_(bfhi(gv[k].z)); o1[2] = bflo(av[k].w) * sigmoidf_(bflo(gv[k].w)); o1[3] = bfhi(av[k].w) * sigmoidf_(bfhi(gv[k].w));
              *(LAS f32x4*)(Y + rr * 256 + 8 * cc) = o0; *(LAS f32x4*)(Y + rr * 256 + 8 * cc + 4) = o1; } } }
    __syncthreads();
    const int c = F.tid & 255, half = F.tid >> 8;
    float w[31];
#pragma unroll
    for (int k = 0; k < 31; ++k) w[k] = F.in[I_CONVW][(size_t)l * 31 * 256 + k * 256 + c];
    float acc[32];
    const float cb = F.in[I_CONVB][l * 256 + c];
#pragma unroll
    for (int o = 0; o < 32; ++o) acc[o] = cb;
#pragma unroll
    for (int kk = 0; kk < 62; ++kk) { const float yv = Y[(32 * half + kk) * 256 + c];
#pragma unroll
        for (int o = 0; o < 32; ++o) { const int tap = kk - o; if (tap >= 0 && tap < 31) acc[o] += yv * w[tap]; } }
    __syncthreads();
#pragma unroll
    for (int o = 0; o < 32; ++o) Y[(32 * half + o) * 256 + c] = acc[o];
    __syncthreads();
    const f32x4 lw = ((const f32x4*)(F.in[I_CLNW] + l * 256))[F.lane], lb = ((const f32x4*)(F.in[I_CLNB] + l * 256))[F.lane];
    for (int i = 0; i < 8; ++i) { const int tl = F.wave * 8 + i; const f32x4 v = *(const LAS f32x4*)(Y + tl * 256 + 4 * F.lane);
        const float mu = wave_sum((v.x + v.y) + (v.z + v.w)) * (1.0f / 256.0f); const f32x4 d = v - mu;
        const float var = wave_sum((d.x * d.x + d.y * d.y) + (d.z * d.z + d.w * d.w)) * (1.0f / 256.0f); const float rstd = 1.0f / sqrtf(var + EPS);
        f32x4 z = d * rstd * lw + lb; z.x *= sigmoidf_(z.x); z.y *= sigmoidf_(z.y); z.z *= sigmoidf_(z.z); z.w *= sigmoidf_(z.w);
        u32x2 o; o.x = pk2(z.x, z.y); o.y = pk2(z.z, z.w);
        *(u32x2*)(YC + (size_t)(row0 + t0 + tl) * DM + 512 + 4 * F.lane) = o; }
    __syncthreads();
}
DI void ret_consts(Frame& F, int l, int hh, float& lg2f, float& lg2b) {
    const float df = F.in[I_RDEC][(l * 2 + 0) * 4 + hh], db = F.in[I_RDEC][(l * 2 + 1) * 4 + hh];
    lg2f = log2f(1.0f - exp2f(-df)); lg2b = log2f(1.0f - exp2f(-db));
}
constexpr int ROPE_LDS = AUX_OFF + 4096;
DI void rope_to_lds(Frame& F) { const float* tab = (const float*)(F.ws + WS_ROPE); LAS float* rt = (LAS float*)(F.lds + ROPE_LDS); for (int i = F.tid; i < 1024; i += 512) rt[i] = tab[i]; __syncthreads(); }
DI void unpack8(const u32x4& a, float (&x)[8]) { x[0] = bflo(a.x); x[1] = bfhi(a.x); x[2] = bflo(a.y); x[3] = bfhi(a.y); x[4] = bflo(a.z); x[5] = bfhi(a.z); x[6] = bflo(a.w); x[7] = bfhi(a.w); }
DI void rope_apply(Frame& F, const u32x4& a, const u32x4& b, int hp, bool lat, int tg, float (&x1)[8], float (&x2)[8]) {
    unpack8(a, x1); unpack8(b, x2);
    if (lat) { const int pos = hp == 0 ? (tg >> 6) : (tg & 63); LAS const f32x4* tab = (LAS const f32x4*)(F.lds + ROPE_LDS) + pos * 4;
#pragma unroll
        for (int jj = 0; jj < 4; ++jj) { const f32x4 cs = tab[jj];
            { const float a1 = x1[2 * jj], a2 = x2[2 * jj]; x1[2 * jj] = a1 * cs[0] - a2 * cs[1]; x2[2 * jj] = a2 * cs[0] + a1 * cs[1]; }
            { const float a1 = x1[2 * jj + 1], a2 = x2[2 * jj + 1]; x1[2 * jj + 1] = a1 * cs[2] - a2 * cs[3]; x2[2 * jj + 1] = a2 * cs[2] + a1 * cs[3]; } } }
}
DI void ret_unit_decode(int su, bool& isctx, int& b, int& hh, int& n) {
    isctx = su >= 1024; if (!isctx) { b = su >> 6; hh = (su >> 4) & 3; n = su & 15; } else { const int v = su - 1024; b = v >> 3; hh = (v >> 1) & 3; n = v & 1; }
}
DI void ret_summary_pair(Frame& F, int l, int it) {
    const bf16* PX = (const bf16*)(F.ws + WS_P);
    const int sub = F.wave >> 2, st = F.tid & 255, su = 2 * it + sub;
    bool isctx; int b, hh, n; ret_unit_decode(su, isctx, b, hh, n);
    const int row0 = isctx ? (b * CTXL + n * 128) : (NCTX + b * SEQ + n * 128);
    float lg2f, lg2b; ret_consts(F, l, hh, lg2f, lg2b);
    LAS unsigned char* base = F.lds + sub * 40960;
    LAS unsigned char* Vimg = base;
    LAS unsigned char* Kf = base + 18432;
    LAS unsigned char* Kb = base + 18432 + 10240;
    { const int tok = st >> 1, hp = st & 1; float x1[8], x2[8];
      const bf16* kp = PX + (size_t)(row0 + tok) * INW + C_RK + 32 * hh; const bf16* vp = PX + (size_t)(row0 + tok) * INW + C_RV + 64 * hh + 32 * hp;
      const u32x4 kra = *(const u32x4*)(kp + 8 * hp), krb = *(const u32x4*)(kp + 16 + 8 * hp);
      u32x4 vr[4];
#pragma unroll
      for (int q = 0; q < 4; ++q) vr[q] = *(const u32x4*)(vp + 8 * q);
      rope_apply(F, kra, krb, hp, !isctx, n * 128 + tok, x1, x2);
      const float ks = 0.17677669529663687f;
      const float wf = fast_exp2(lg2f * (float)(127 - tok)) * ks, wb = fast_exp2(lg2b * (float)tok) * ks;
      u32x4 o;
      o.x = pk2(x1[0] * wf, x1[1] * wf); o.y = pk2(x1[2] * wf, x1[3] * wf); o.z = pk2(x1[4] * wf, x1[5] * wf); o.w = pk2(x1[6] * wf, x1[7] * wf); *(LAS u32x4*)(Kf + tok * 80 + 16 * hp) = o;
      o.x = pk2(x2[0] * wf, x2[1] * wf); o.y = pk2(x2[2] * wf, x2[3] * wf); o.z = pk2(x2[4] * wf, x2[5] * wf); o.w = pk2(x2[6] * wf, x2[7] * wf); *(LAS u32x4*)(Kf + tok * 80 + 32 + 16 * hp) = o;
      o.x = pk2(x1[0] * wb, x1[1] * wb); o.y = pk2(x1[2] * wb, x1[3] * wb); o.z = pk2(x1[4] * wb, x1[5] * wb); o.w = pk2(x1[6] * wb, x1[7] * wb); *(LAS u32x4*)(Kb + tok * 80 + 16 * hp) = o;
      o.x = pk2(x2[0] * wb, x2[1] * wb); o.y = pk2(x2[2] * wb, x2[3] * wb); o.z = pk2(x2[4] * wb, x2[5] * wb); o.w = pk2(x2[6] * wb, x2[7] * wb); *(LAS u32x4*)(Kb + tok * 80 + 32 + 16 * hp) = o;
#pragma unroll
      for (int q = 0; q < 4; ++q) *(LAS u32x4*)(Vimg + tok * 144 + 64 * hp + 16 * q) = vr[q]; }
    __syncthreads();
    { const int role = F.wave & 3, dir = role >> 1, et = role & 1;
      const int l32 = F.lane & 31, h = F.lane >> 5, grp = (F.lane >> 4) & 1, i16 = F.lane & 15, q = i16 >> 2, p = i16 & 3;
      LAS unsigned char* Kimg = dir ? Kb : Kf;
      f32x16 acc;
#pragma unroll
      for (int i = 0; i < 16; ++i) acc[i] = 0.f;
#pragma unroll
      for (int s = 0; s < 8; ++s) { const int r0 = 16 * s + 8 * h + q;
          const s16x4 alo = trread(Vimg + r0 * 144 + (32 * et + 16 * grp + 4 * p) * 2), ahi = trread(Vimg + (r0 + 4) * 144 + (32 * et + 16 * grp + 4 * p) * 2);
          const s16x4 blo = trread(Kimg + r0 * 80 + (16 * grp + 4 * p) * 2), bhi = trread(Kimg + (r0 + 4) * 80 + (16 * grp + 4 * p) * 2);
          const bf16x8 a = __builtin_shufflevector(alo, ahi, 0, 1, 2, 3, 4, 5, 6, 7), bb = __builtin_shufflevector(blo, bhi, 0, 1, 2, 3, 4, 5, 6, 7);
          acc = MFMA32(a, bb, acc); }
      float* S = isctx ? (float*)(F.ws + WS_SUMCTX) + ((size_t)((b * 4 + hh) * 2 + n) * 2 + dir) * 2048 : (float*)(F.ws + WS_SUMLAT) + ((size_t)((b * 4 + hh) * 16 + n) * 2 + dir) * 2048;
#pragma unroll
      for (int i = 0; i < 16; ++i) S[(32 * et + crow(i, h)) * 32 + l32] = acc[i]; }
    __syncthreads();
}
DI void ca_phase(Frame& F, int l) {
    rope_to_lds(F);
    const int nconv = l == 0 ? 576 : 512;
    for (int u = F.vb; u < nconv; u += F.G) {
        int v = u; if (l != 0) v += 64;
        if (v < 64) conv_unit(F, l, (v >> 2) * CTXL, (v & 3) * 64, CTXL);
        else { v -= 64; conv_unit(F, l, NCTX + (v >> 5) * SEQ, (v & 31) * 64, SEQ); }
    }
    for (int it = F.vb; it < 576; it += F.G) ret_summary_pair(F, l, it);
}

constexpr int ATT_BUF = 18432, ATT_BT = 2 * ATT_BUF, ATT_NEG = 640;
DI void attn_fetch(Frame& F, const bf16* PX, int keyrow0, int hh, u32x4& kv, u32x4& vv) {
    const int key = F.tid >> 3, ch = F.tid & 7;
    const bf16* p = PX + (size_t)(keyrow0 + key) * INW + 64 * hh + 8 * ch;
    kv = *(const u32x4*)(p + C_NAK); vv = *(const u32x4*)(p + C_NAV);
}
DI void attn_put(Frame& F, LAS unsigned char* buf, const u32x4& kv, const u32x4& vv) {
    const int key = F.tid >> 3, ch = F.tid & 7;
    *(LAS u32x4*)(buf + key * 144 + 16 * ch) = kv; *(LAS u32x4*)(buf + 9216 + key * 144 + 16 * ch) = vv;
}
template <bool BIAS>
DI void attn_tile(LAS const unsigned char* buf, int koff, const bf16x8 (&qf)[4], f32x16& o0, f32x16& o1, f32x16& o2, float& mrun, int lane,
                  LAS const float* bt  , const float (&pen)[16]) {
    LAS const unsigned char* Kimg = buf; LAS const unsigned char* Vimg = buf + 9216;
    const int l32 = lane & 31, h = lane >> 5, grp = (lane >> 4) & 1, i16 = lane & 15, q = i16 >> 2, p = i16 & 3;
    f32x16 s;
#pragma unroll
    for (int i = 0; i < 16; ++i) s[i] = 0.f;
#pragma unroll
    for (int si = 0; si < 4; ++si) { const bf16x8 a = *(const LAS bf16x8*)(Kimg + (koff + l32) * 144 + (16 * si + 8 * h) * 2); s = MFMA32(a, qf[si], s); }
    const float c = 0.125f * LOG2E;
    float v[16]; float mx = -1.0e30f;
#pragma unroll
    for (int i = 0; i < 16; ++i) { float t;
        if (BIAS) t = __builtin_fmaf(s[i], c, bt[(i & 3) + 8 * (i >> 2)]) + pen[i]; else t = s[i] * c;
        v[i] = t; mx = fmaxf(mx, t); }
    mx = fmaxf(mx, __shfl_xor(mx, 32));
    const float mnew = fmaxf(mrun, mx);
    const float alpha = fast_exp2(mrun - mnew);
    if (__any(alpha != 1.0f)) {
#pragma unroll
        for (int i = 0; i < 16; ++i) { o0[i] *= alpha; o1[i] *= alpha; o2[i] *= alpha; } }
    mrun = mnew;
    float pp[16];
#pragma unroll
    for (int i = 0; i < 16; ++i) pp[i] = fast_exp2(v[i] - mnew);
    bf16x8 pf[2];
#pragma unroll
    for (int s2 = 0; s2 < 2; ++s2) { u32x4 w; w.x = pk2(pp[8 * s2], pp[8 * s2 + 1]); w.y = pk2(pp[8 * s2 + 2], pp[8 * s2 + 3]); w.z = pk2(pp[8 * s2 + 4], pp[8 * s2 + 5]); w.w = pk2(pp[8 * s2 + 6], pp[8 * s2 + 7]); pf[s2] = __builtin_bit_cast(bf16x8, w); }
    const u32x4 onesw = (u32x4){0x3f803f80u, 0x3f803f80u, 0x3f803f80u, 0x3f803f80u}; const bf16x8 ones = __builtin_bit_cast(bf16x8, onesw);
#pragma unroll
    for (int s2 = 0; s2 < 2; ++s2) { const int r0 = koff + 16 * s2 + 4 * h + q;
#pragma unroll
        for (int et = 0; et < 2; ++et) { const int cb = (32 * et + 16 * grp + 4 * p) * 2;
            const s16x4 lo = trread(Vimg + r0 * 144 + cb), hi = trread(Vimg + (r0 + 8) * 144 + cb);
            const bf16x8 a = __builtin_shufflevector(lo, hi, 0, 1, 2, 3, 4, 5, 6, 7);
            if (et == 0) o0 = MFMA32(a, pf[s2], o0); else o1 = MFMA32(a, pf[s2], o1); }
        o2 = MFMA32(ones, pf[s2], o2); }
}
DI void attn_unit(Frame& F, int l, bool na, int b, int hh, int rg) {
    const bf16* PX = (const bf16*)(F.ws + WS_P);
    bf16* YC = (bf16*)(F.ws + WS_U);
    LAS float* btab = (LAS float*)(F.lds + ATT_BT);
    const int l32 = F.lane & 31, h = F.lane >> 5;
    int qrow, r = 0, qcol = 0, kc0 = 0, ra = 0;
    float pen[16];
#pragma unroll
    for (int i = 0; i < 16; ++i) pen[i] = 0.f;
    if (na) { const int rp = F.wave >> 2, n = F.wave & 3; ra = 4 * rg + 2 * rp; r = ra + (l32 >> 4); qcol = 16 * n + (l32 & 15); qrow = NCTX + b * SEQ + r * GW + qcol;
        int w0 = qcol - 8; w0 = w0 < 0 ? 0 : (w0 > 48 ? 48 : w0); kc0 = 16 * n - 8; kc0 = kc0 < 0 ? 0 : (kc0 > 32 ? 32 : kc0);
#pragma unroll
        for (int i = 0; i < 16; ++i) pen[i] = ((unsigned)(kc0 + crow(i, h) - w0) < 16u) ? 0.f : -1.0e30f; }
    else qrow = b * CTXL + 32 * F.wave + l32;
    bf16x8 qf[4];
#pragma unroll
    for (int si = 0; si < 4; ++si) qf[si] = *(const bf16x8*)(PX + (size_t)qrow * INW + C_NAQ + 64 * hh + 16 * si + 8 * h);
    if (na) { for (int idx = F.tid; idx < ATT_NEG + 128; idx += 512) { float v = 0.f; if (idx >= 48 && idx < 48 + 465) v = F.in[I_RPB][((size_t)l * 8 + hh) * 465 + (idx - 48)] * LOG2E; if (idx >= ATT_NEG) v = -1.0e30f; btab[idx] = v; } }
    f32x16 o0, o1, o2;
#pragma unroll
    for (int i = 0; i < 16; ++i) { o0[i] = 0.f; o1[i] = 0.f; o2[i] = 0.f; }
    float mrun = -1.0e30f;
    int ylo = 0, nsteps = 4;
    if (na) { const int rlo = 4 * rg, rhi = 4 * rg + 3;
        ylo = rlo - 4; ylo = ylo < 0 ? 0 : (ylo > 24 ? 24 : ylo);
        int yhi = rhi - 4; yhi = yhi < 0 ? 0 : (yhi > 24 ? 24 : yhi); yhi += 8; nsteps = 4 + (yhi - ylo); }
    int sa = ra - 4; sa = sa < 0 ? 0 : (sa > 24 ? 24 : sa);
    int sb = ra + 1 - 4; sb = sb < 0 ? 0 : (sb > 24 ? 24 : sb);
    const int mylo = (l32 >> 4) ? sb : sa;
    const int cbase = kc0 + 4 * h - qcol + 15;
#define ATT_ROW0(sx) ((sx) < 4 ? b * CTXL + 64 * (sx) : NCTX + b * SEQ + (ylo + (sx) - 4) * GW)
#define ATT_COMPUTE(buf, sx) do { if ((sx) < 4) { attn_tile<false>(buf, 0, qf, o0, o1, o2, mrun, F.lane, btab, pen); attn_tile<false>(buf, 32, qf, o0, o1, o2, mrun, F.lane, btab, pen); } \
        else { const int y = ylo + (sx) - 4; if (y >= sa && y < sb + 8) { const bool rowok = (unsigned)(y - mylo) < 8u; \
            LAS const float* bt = btab + (rowok ? 48 + (y - r + 7) * 31 + cbase : ATT_NEG); attn_tile<true>(buf, kc0, qf, o0, o1, o2, mrun, F.lane, bt, pen); } } } while (0)
    u32x4 kvA, vvA, kvB, vvB;
    attn_fetch(F, PX, ATT_ROW0(0), hh, kvA, vvA);
    attn_fetch(F, PX, ATT_ROW0(1), hh, kvB, vvB);
    for (int st = 0; st < nsteps; st += 2) {
        LAS unsigned char* buf0 = F.lds; LAS unsigned char* buf1 = F.lds + ATT_BUF;
        attn_put(F, buf0, kvA, vvA);
        if (st + 2 < nsteps) attn_fetch(F, PX, ATT_ROW0(st + 2), hh, kvA, vvA);
        __syncthreads();
        ATT_COMPUTE(buf0, st);
        if (st + 1 < nsteps) {
            attn_put(F, buf1, kvB, vvB);
            if (st + 3 < nsteps) attn_fetch(F, PX, ATT_ROW0(st + 3), hh, kvB, vvB);
            __syncthreads();
            ATT_COMPUTE(buf1, st + 1);
        }
    }
#undef ATT_ROW0
#undef ATT_COMPUTE
    const float inv = 1.0f / o2[0];
    bf16* orow = YC + (size_t)qrow * DM + 64 * hh;
#pragma unroll
    for (int gq = 0; gq < 4; ++gq) { u32x2 w;
        w.x = pk2(o0[4 * gq] * inv, o0[4 * gq + 1] * inv); w.y = pk2(o0[4 * gq + 2] * inv, o0[4 * gq + 3] * inv); *(u32x2*)(orow + 8 * gq + 4 * h) = w;
        w.x = pk2(o1[4 * gq] * inv, o1[4 * gq + 1] * inv); w.y = pk2(o1[4 * gq + 2] * inv, o1[4 * gq + 3] * inv); *(u32x2*)(orow + 32 + 8 * gq + 4 * h) = w; }
    __syncthreads();
}
DI void ret_out_unit(Frame& F, int l, int su) {
    const bf16* PX = (const bf16*)(F.ws + WS_P);
    bf16* YC = (bf16*)(F.ws + WS_U);
    bool isctx; int b, hh, n; ret_unit_decode(su, isctx, b, hh, n);
    const int row0 = isctx ? (b * CTXL + n * 128) : (NCTX + b * SEQ + n * 128);
    float lg2f, lg2b; ret_consts(F, l, hh, lg2f, lg2b);
    LAS unsigned char* Kimg = F.lds;
    LAS unsigned char* Vimg = F.lds + 10240;
    LAS unsigned char* Stf = F.lds + 28672;
    LAS unsigned char* Stb = F.lds + 33792;
    LAS float* Ob = (LAS float*)(F.lds + 38912);
    const int dir = F.wave >> 2, qb = F.wave & 3, l32 = F.lane & 31, h = F.lane >> 5, grp = (F.lane >> 4) & 1, i16 = F.lane & 15, q = i16 >> 2, p = i16 & 3;
    const int iq = 32 * qb + l32;
    const int ktok = (F.tid & 255) >> 1, khp = F.tid & 1;
    const bf16* kp = PX + (size_t)(row0 + ktok) * INW + C_RK + 32 * hh;
    const u32x4 kra = *(const u32x4*)(kp + 8 * khp), krb = *(const u32x4*)(kp + 16 + 8 * khp);
    const int vtok = F.tid >> 2, vch = F.tid & 3; const bf16* vp = PX + (size_t)(row0 + vtok) * INW + C_RV + 64 * hh + 16 * vch;
    const u32x4 vra = *(const u32x4*)vp, vrb = *(const u32x4*)(vp + 8);
    const bf16* qp = PX + (size_t)(row0 + iq) * INW + C_RQ + 32 * hh;
    const u32x4 qra = *(const u32x4*)(qp + 8 * h), qrb = *(const u32x4*)(qp + 16 + 8 * h);
    const bf16* gp = PX + (size_t)(row0 + iq) * INW + (dir ? C_GB : C_GF) + 64 * hh;
    u32x2 gg[8];
#pragma unroll
    for (int et = 0; et < 2; ++et)
#pragma unroll
        for (int gq = 0; gq < 4; ++gq) gg[et * 4 + gq] = *(const u32x2*)(gp + 32 * et + 8 * gq + 4 * h);
    const float cf = fast_exp2(lg2f * 128.0f), cb = fast_exp2(lg2b * 128.0f);
    const float* SC = (const float*)(F.ws + WS_SUMCTX) + (size_t)((b * 4 + hh) * 2) * 2 * 2048;
    const float* SL = (const float*)(F.ws + WS_SUMLAT) + (size_t)((b * 4 + hh) * 16) * 2 * 2048;
    f32x4 sf = (f32x4){0.f, 0.f, 0.f, 0.f}, sb = sf; const int eo = 4 * F.tid;
    if (!isctx) {
        f32x4 t[16];
#pragma unroll
        for (int m = 0; m < 16; ++m) t[m] = *(const f32x4*)(SL + (size_t)(m * 2 + (m <= n ? 0 : 1)) * 2048 + eo);
        const f32x4 c00 = *(const f32x4*)(SC + (0 * 2 + 0) * 2048 + eo), c10 = *(const f32x4*)(SC + (1 * 2 + 0) * 2048 + eo);
        const f32x4 c11 = *(const f32x4*)(SC + (1 * 2 + 1) * 2048 + eo), c01 = *(const f32x4*)(SC + (0 * 2 + 1) * 2048 + eo);
        sf = c00 * cf + c10;
#pragma unroll
        for (int m = 0; m < 16; ++m) { const f32x4 nv = sf * cf + t[m]; sf = (m < n) ? nv : sf; }
        sb = c11 * cb + c01;
#pragma unroll
        for (int m = 15; m >= 0; --m) { const f32x4 nv = sb * cb + t[m]; sb = (m > n) ? nv : sb; }
    } else {
        if (n == 1) sf = *(const f32x4*)(SC + (0 * 2 + 0) * 2048 + eo);
        if (n == 0) sb = *(const f32x4*)(SC + (1 * 2 + 1) * 2048 + eo);
    }
    if (F.tid < 256) { float x1[8], x2[8]; rope_apply(F, kra, krb, khp, !isctx, n * 128 + ktok, x1, x2);
        const float ks = 0.17677669529663687f; u32x4 o;
        o.x = pk2(x1[0] * ks, x1[1] * ks); o.y = pk2(x1[2] * ks, x1[3] * ks); o.z = pk2(x1[4] * ks, x1[5] * ks); o.w = pk2(x1[6] * ks, x1[7] * ks); *(LAS u32x4*)(Kimg + ktok * 80 + 16 * khp) = o;
        o.x = pk2(x2[0] * ks, x2[1] * ks); o.y = pk2(x2[2] * ks, x2[3] * ks); o.z = pk2(x2[4] * ks, x2[5] * ks); o.w = pk2(x2[6] * ks, x2[7] * ks); *(LAS u32x4*)(Kimg + ktok * 80 + 32 + 16 * khp) = o; }
    *(LAS u32x4*)(Vimg + vtok * 144 + 32 * vch) = vra; *(LAS u32x4*)(Vimg + vtok * 144 + 32 * vch + 16) = vrb;
    { const int e = eo >> 5, d = eo & 31; u32x2 w;
      w.x = pk2(sf[0], sf[1]); w.y = pk2(sf[2], sf[3]); *(LAS u32x2*)(Stf + e * 80 + d * 2) = w;
      w.x = pk2(sb[0], sb[1]); w.y = pk2(sb[2], sb[3]); *(LAS u32x2*)(Stb + e * 80 + d * 2) = w; }
    bf16x8 qf[2], qd[2];
    { float x1[8], x2[8]; rope_apply(F, qra, qrb, h, !isctx, n * 128 + iq, x1, x2);
      const float dec = dir == 0 ? fast_exp2(lg2f * (float)(iq + 1)) : fast_exp2(lg2b * (float)(128 - iq));
      u32x4 w;
      w.x = pk2(x1[0], x1[1]); w.y = pk2(x1[2], x1[3]); w.z = pk2(x1[4], x1[5]); w.w = pk2(x1[6], x1[7]); qf[0] = __builtin_bit_cast(bf16x8, w);
      w.x = pk2(x2[0], x2[1]); w.y = pk2(x2[2], x2[3]); w.z = pk2(x2[4], x2[5]); w.w = pk2(x2[6], x2[7]); qf[1] = __builtin_bit_cast(bf16x8, w);
      w.x = pk2(x1[0] * dec, x1[1] * dec); w.y = pk2(x1[2] * dec, x1[3] * dec); w.z = pk2(x1[4] * dec, x1[5] * dec); w.w = pk2(x1[6] * dec, x1[7] * dec); qd[0] = __builtin_bit_cast(bf16x8, w);
      w.x = pk2(x2[0] * dec, x2[1] * dec); w.y = pk2(x2[2] * dec, x2[3] * dec); w.z = pk2(x2[4] * dec, x2[5] * dec); w.w = pk2(x2[6] * dec, x2[7] * dec); qd[1] = __builtin_bit_cast(bf16x8, w); }
    __syncthreads();
    f32x16 o0, o1;
#pragma unroll
    for (int i = 0; i < 16; ++i) { o0[i] = 0.f; o1[i] = 0.f; }
    { LAS const unsigned char* St = dir ? Stb : Stf;
#pragma unroll
      for (int s = 0; s < 2; ++s) { const bf16x8 a0 = *(const LAS bf16x8*)(St + l32 * 80 + (16 * s + 8 * h) * 2), a1 = *(const LAS bf16x8*)(St + (32 + l32) * 80 + (16 * s + 8 * h) * 2);
          o0 = MFMA32(a0, qd[s], o0); o1 = MFMA32(a1, qd[s], o1); } }
    const float lgd = dir ? lg2b : lg2f;
    const int kt_lo = dir ? qb : 0, kt_hi = dir ? 3 : qb;
    for (int kt = kt_lo; kt <= kt_hi; ++kt) {
        f32x16 s;
#pragma unroll
        for (int i = 0; i < 16; ++i) s[i] = 0.f;
#pragma unroll
        for (int si = 0; si < 2; ++si) { const bf16x8 a = *(const LAS bf16x8*)(Kimg + (32 * kt + l32) * 80 + (16 * si + 8 * h) * 2); s = MFMA32(a, qf[si], s); }
        float pp[16];
#pragma unroll
        for (int i = 0; i < 16; ++i) { const int j = 32 * kt + crow(i, h); const int diff = dir ? (j - iq) : (iq - j); pp[i] = diff >= 0 ? s[i] * fast_exp2(lgd * (float)diff) : 0.f; }
        bf16x8 pf[2];
#pragma unroll
        for (int s2 = 0; s2 < 2; ++s2) { u32x4 w; w.x = pk2(pp[8 * s2], pp[8 * s2 + 1]); w.y = pk2(pp[8 * s2 + 2], pp[8 * s2 + 3]); w.z = pk2(pp[8 * s2 + 4], pp[8 * s2 + 5]); w.w = pk2(pp[8 * s2 + 6], pp[8 * s2 + 7]); pf[s2] = __builtin_bit_cast(bf16x8, w); }
#pragma unroll
        for (int s2 = 0; s2 < 2; ++s2) { const int r0 = 32 * kt + 16 * s2 + 4 * h + q;
#pragma unroll
            for (int et = 0; et < 2; ++et) { const int cb = (32 * et + 16 * grp + 4 * p) * 2;
                const s16x4 lo = trread(Vimg + r0 * 144 + cb), hi = trread(Vimg + (r0 + 8) * 144 + cb);
                const bf16x8 a = __builtin_shufflevector(lo, hi, 0, 1, 2, 3, 4, 5, 6, 7);
                if (et == 0) o0 = MFMA32(a, pf[s2], o0); else o1 = MFMA32(a, pf[s2], o1); } }
    }
    float sm = 0.f;
#pragma unroll
    for (int i = 0; i < 16; ++i) sm += o0[i] + o1[i];
    sm += __shfl_xor(sm, 32);
    const float mu = sm * (1.0f / 64.0f);
    float vs = 0.f;
#pragma unroll
    for (int i = 0; i < 16; ++i) { const float d0 = o0[i] - mu, d1 = o1[i] - mu; vs += d0 * d0 + d1 * d1; }
    vs += __shfl_xor(vs, 32);
    const float rstd = 1.0f / sqrtf(vs * (1.0f / 64.0f) + EPS);
    const float* gn = F.in[I_RGNW] + l * 256 + 64 * hh;
    float val[32];
#pragma unroll
    for (int et = 0; et < 2; ++et)
#pragma unroll
        for (int gq = 0; gq < 4; ++gq) { const int e0 = 32 * et + 8 * gq + 4 * h; const u32x2 ggv = gg[et * 4 + gq]; const f32x4 gw = *(const f32x4*)(gn + e0);
            const float g0 = bflo(ggv.x), g1 = bfhi(ggv.x), g2 = bflo(ggv.y), g3 = bfhi(ggv.y);
            const float a0 = et ? o1[4 * gq] : o0[4 * gq], a1 = et ? o1[4 * gq + 1] : o0[4 * gq + 1], a2 = et ? o1[4 * gq + 2] : o0[4 * gq + 2], a3 = et ? o1[4 * gq + 3] : o0[4 * gq + 3];
            val[et * 16 + 4 * gq] = (a0 - mu) * rstd * gw[0] * g0 * sigmoidf_(g0); val[et * 16 + 4 * gq + 1] = (a1 - mu) * rstd * gw[1] * g1 * sigmoidf_(g1);
            val[et * 16 + 4 * gq + 2] = (a2 - mu) * rstd * gw[2] * g2 * sigmoidf_(g2); val[et * 16 + 4 * gq + 3] = (a3 - mu) * rstd * gw[3] * g3 * sigmoidf_(g3); }
    if (dir == 0) {
#pragma unroll
        for (int et = 0; et < 2; ++et)
#pragma unroll
            for (int gq = 0; gq < 4; ++gq)
#pragma unroll
                for (int j = 0; j < 4; ++j) Ob[iq * 65 + 32 * et + 8 * gq + 4 * h + j] = val[et * 16 + 4 * gq + j];
    }
    __syncthreads();
    if (dir == 1) { bf16* orow = YC + (size_t)(row0 + iq) * DM + 768 + 64 * hh;
#pragma unroll
        for (int et = 0; et < 2; ++et)
#pragma unroll
            for (int gq = 0; gq < 4; ++gq) { const int e0 = 32 * et + 8 * gq + 4 * h; float t[4];
#pragma unroll
                for (int j = 0; j < 4; ++j) t[j] = val[et * 16 + 4 * gq + j] + Ob[iq * 65 + e0 + j];
                u32x2 w; w.x = pk2(t[0], t[1]); w.y = pk2(t[2], t[3]); *(u32x2*)(orow + e0) = w; } }
    __syncthreads();
}
#ifndef PROBE_SUB
#define PROBE_SUB 0
#endif
DI void cb_phase(Frame& F, int l) {
    rope_to_lds(F);
    const int nattn = l == 0 ? 1152 : 1024;
    for (int rep = 0; rep < ((PROBE_SUB & 1) ? 2 : 1); ++rep)
    for (int u = F.vb; u < nattn; u += F.G) {
        if (u < 1024) attn_unit(F, l, true, u >> 6, (u >> 3) & 7, u & 7);
        else { const int v = u - 1024; attn_unit(F, l, false, v >> 3, v & 7, 0); }
    }
    const int nret = l == 0 ? 1152 : 1024;
    for (int rep = 0; rep < ((PROBE_SUB & 2) ? 2 : 1); ++rep)
    for (int u = F.vb; u < nret; u += F.G) ret_out_unit(F, l, u);
}

static_assert(sizeof(Params) == 240, "kernarg layout: in[26] at 0, out at 208, ws at 216, ph_lo at 224, ph_hi at 228");
__global__ void __launch_bounds__(512, 2) fwd_kernel(Params prm) {
    extern __shared__ __attribute__((aligned(16))) unsigned char lds_raw[];
    Frame F;
    F.lds = (LAS unsigned char*)lds_raw;
    F.tid = threadIdx.x; F.lane = F.tid & 63; F.wave = __builtin_amdgcn_readfirstlane(F.tid >> 6);
    F.G = gridDim.x; F.bid = blockIdx.x; F.vb = F.bid;
    F.in.ka = (karg_t)__builtin_amdgcn_kernarg_segment_ptr(); F.out = prm.out; F.ws = prm.ws;
    volatile LAS unsigned* MISC = (volatile LAS unsigned*)(F.lds + AUX_OFF);
    if (F.tid < 64) MISC[F.tid] = 0u;
    __syncthreads();
    XcdBarrier bar; bar.bar = (unsigned*)(prm.ws + WS_CTL) + 1024; bar.x = 0; bar.st = nullptr;
    const int lo = prm.ph_lo, hi = prm.ph_hi;
    if (hi - lo > 1) bar = xcd_barrier_post((unsigned*)(prm.ws + WS_CTL) + 1024, MISC + 8);
#ifdef ONLY_PHASE
#define IN(k) ((k) == ONLY_PHASE && lo <= (k) && (k) < hi)
#else
#define IN(k) (lo <= (k) && (k) < hi)
#endif
#ifndef PROBE_MASK
#define PROBE_MASK 0u
#endif
#define NREP(k) (((PROBE_MASK >> (k)) & 1u) ? 2 : 1)
#define SEAM(k) do { if (IN(k) && IN((k) + 1)) { XcdBarrier bb_ = bar; asm volatile("" : "+s"(bb_.bar)); xcd_barrier(bb_); } } while (0)
#define GLDS(P) ((LAS unsigned char*)(P).lds)
#define WSB(P, off) ((const pg8::bf16_t*)((P).ws + (off)))

    if (IN(0)) for (int rep_ = 0; rep_ < NREP(0); ++rep_) { if (rep_) __syncthreads(); Frame P = phase_frame(F); p0_prologue(P); } SEAM(0);
#pragma unroll 1
    for (int l = 0; l < 2; ++l) {
        const int pb = l == 0 ? 1 : 9;
        if (IN(pb + 0)) for (int rep_ = 0; rep_ < NREP(pb + 0); ++rep_) { if (rep_) __syncthreads(); Frame P = phase_frame(F); norm_phase(P, l, 1, l == 0, 0); } SEAM(pb + 0);
        if (IN(pb + 1)) for (int rep_ = 0; rep_ < NREP(pb + 1); ++rep_) { if (rep_) __syncthreads();
            Frame P = phase_frame(F);
            pg8::StaticOrder S; S.init(NTOK, INW, P.G, P.bid);
            pg8::EpiStoreBf16 E{(pg8::bf16_t*)(P.ws + WS_P), INW};
            pg8::gemm_phase<pg8::EpiStoreBf16, pg8::StaticOrder, pg8::RowsLinear, true>(GLDS(P), P.tid, WSB(P, WS_U), WSB(P, WS_WIN) + (size_t)l * INW * DM, 2 * DM, S, E, pg8::RowsLinear{});
            if (l == 0) bg_convert_tail(P, S.nwg, BG_B0, BG_D0); else bg_convert_tail(P, S.nwg, BG_B1, BG_CL);
        } SEAM(pb + 1);
        if (IN(pb + 2)) for (int rep_ = 0; rep_ < NREP(pb + 2); ++rep_) { if (rep_) __syncthreads(); Frame P = phase_frame(F); if (l == 1) { bg_convert_all(P, BG_CL, BG_ITEMS); __syncthreads(); } ca_phase(P, l); } SEAM(pb + 2);
        if (IN(pb + 3)) for (int rep_ = 0; rep_ < NREP(pb + 3); ++rep_) { if (rep_) __syncthreads(); Frame P = phase_frame(F); cb_phase(P, l); } SEAM(pb + 3);
        if (IN(pb + 4)) {
            Frame P = phase_frame(F);
            const int rb = l == 0 ? 0 : NCTX;
            const float* modlat = (const float*)(P.ws + WS_MODLAT) + (size_t)l * 16 * 6144;
            const float* modctx = (const float*)(P.ws + WS_MODCTX) + (size_t)l * 6144;
            float* hctx = (float*)(P.ws + WS_HCTX);
            pg8::StaticOrder S; S.init(NTOK - rb, DM, P.G, P.bid);
            pg8::EpiResGate E{l == 0 ? P.in[I_CTX] : hctx, l == 0 ? P.in[I_X] : P.out, hctx, P.out, modlat + 2 * DM, modctx + 2 * DM, rb};
            pg8::gemm_phase<pg8::EpiResGate, pg8::StaticOrder, pg8::RowsLinear, true>(GLDS(P), P.tid, WSB(P, WS_U) + (size_t)rb * DM, WSB(P, WS_WOUT) + (size_t)l * DM * DM, 2 * DM, S, E, pg8::RowsLinear{});
            if (l == 0) bg_convert_tail(P, S.nwg, BG_D0, BG_E0);
        } SEAM(pb + 4);
        if (l == 0) {
            if (IN(6)) for (int rep_ = 0; rep_ < NREP(6); ++rep_) { if (rep_) __syncthreads(); Frame P = phase_frame(F); norm_phase(P, 0, 2, false, 0, DENSE_FP8 == 1); } SEAM(6);
            if (IN(7)) for (int rep_ = 0; rep_ < NREP(7); ++rep_) { if (rep_) __syncthreads();
                Frame P = phase_frame(F);
                pg8::StaticOrder S; S.init(NTOK, 2 * DFF, P.G, P.bid);
                pg8::EpiSwiglu<false> E{(pg8::bf16_t*)(P.ws + WS_P), DFF, 0, nullptr};
#if DENSE_FP8 == 1
                pg8::gemm_phase<pg8::EpiSwiglu<false>, pg8::StaticOrder, pg8::RowsLinearOff, true, true>(GLDS(P), P.tid, WSB(P, WS_U), WSB(P, WS_WGU), DM, S, E, pg8::RowsLinearOff{}, SCL_U, SCL_WGU);
#else
                pg8::gemm_phase<pg8::EpiSwiglu<false>, pg8::StaticOrder, pg8::RowsLinear, true>(GLDS(P), P.tid, WSB(P, WS_U), WSB(P, WS_WGU), 2 * DM, S, E, pg8::RowsLinear{});
#endif
                bg_convert_tail(P, S.nwg, BG_E0, BG_F0);
            } SEAM(7);
            if (IN(8)) {
                Frame P = phase_frame(F);
                const float* modlat = (const float*)(P.ws + WS_MODLAT);
                const float* modctx = (const float*)(P.ws + WS_MODCTX);
                float* hctx = (float*)(P.ws + WS_HCTX);
                pg8::StaticOrder S; S.init(NTOK, DM, P.G, P.bid);
                pg8::EpiResGate E{hctx, P.out, hctx, P.out, modlat + 5 * DM, modctx + 5 * DM, 0};
#if DENSE_FP8
                pg8::gemm_phase<pg8::EpiResGate, pg8::StaticOrder, pg8::RowsLinearOff, true, true>(GLDS(P), P.tid, WSB(P, WS_P), WSB(P, WS_WD), DFF, S, E, pg8::RowsLinearOff{}, SCL_H, SCL_WD);
#else
                pg8::gemm_phase<pg8::EpiResGate, pg8::StaticOrder, pg8::RowsLinear, true>(GLDS(P), P.tid, WSB(P, WS_P), WSB(P, WS_WD), 2 * DFF, S, E, pg8::RowsLinear{});
#endif
                bg_convert_tail(P, S.nwg, BG_F0, BG_B1);
            } SEAM(8);
        } else {
            if (IN(14)) for (int rep_ = 0; rep_ < NREP(14); ++rep_) { if (rep_) __syncthreads(); Frame P = phase_frame(F); norm_moe_phase(P); } SEAM(14);
            if (IN(15)) for (int rep_ = 0; rep_ < NREP(15); ++rep_) { if (rep_) __syncthreads(); Frame P = phase_frame(F); moe_route_phase(P); } SEAM(15);
#pragma unroll 1
            for (int s = 0; s < 2; ++s) {
                LAS int* texp = (LAS int*)(F.lds + AUX_TAB);
                if (IN(16 + 2 * s) || IN(17 + 2 * s)) {
                    Frame P = phase_frame(F);
                    const int* meta = (const int*)(P.ws + WS_META) + s * 256;
                    __syncthreads();
                    if (P.tid < 256) texp[P.tid] = ld_i32_coherent(meta + P.tid);
                    __syncthreads();
                }
                if (IN(16 + 2 * s)) for (int rep_ = 0; rep_ < NREP(16 + 2 * s); ++rep_) { if (rep_) __syncthreads();
                    Frame P = phase_frame(F);
                    const int* rowmap = (const int*)(P.ws + WS_ROWMAP) + (size_t)s * MOE_ROWS;
                    const int NT = __builtin_amdgcn_readfirstlane(texp[0]);
                    pg8::MoeOrder S{NT, 28, P.G, P.bid, (const LAS int*)(texp + 1)};
                    pg8::EpiSwiglu<true> E{(pg8::bf16_t*)(P.ws + WS_P), DFE, 28, (const float*)(P.ws + WS_PROW) + (size_t)s * MOE_ROWS};
#if MOE_FP8
                    pg8::gemm_phase<pg8::EpiSwiglu<true>, pg8::MoeOrder, pg8::RowsGather, true, true>(GLDS(P), P.tid, WSB(P, WS_U), WSB(P, WS_MGU), DM, S, E, pg8::RowsGather{rowmap, 0}, SCL_U, SCL_WGU);
#else
                    pg8::gemm_phase<pg8::EpiSwiglu<true>, pg8::MoeOrder, pg8::RowsGather, true>(GLDS(P), P.tid, WSB(P, WS_U), WSB(P, WS_MGU), 2 * DM, S, E, pg8::RowsGather{rowmap, NCTX});
#endif
                } SEAM(16 + 2 * s);
                if (IN(17 + 2 * s)) {
                    Frame P = phase_frame(F);
                    const int* rowmap = (const int*)(P.ws + WS_ROWMAP) + (size_t)s * MOE_ROWS;
                    const float* modlat = (const float*)(P.ws + WS_MODLAT) + (size_t)16 * 6144;
                    const int NT = __builtin_amdgcn_readfirstlane(texp[0]);
                    pg8::MoeOrder S{NT, 4, P.G, P.bid, (const LAS int*)(texp + 1)};
                    pg8::EpiMoeScatter E{rowmap, P.out, modlat + 5 * DM, 4};
#if MOE_FP8
                    pg8::gemm_phase<pg8::EpiMoeScatter, pg8::MoeOrder, pg8::RowsLinearOff, true, true>(GLDS(P), P.tid, WSB(P, WS_P), WSB(P, WS_MD), DFE, S, E, pg8::RowsLinearOff{}, SCL_H, SCL_WD);
#else
                    pg8::gemm_phase<pg8::EpiMoeScatter, pg8::MoeOrder, pg8::RowsLinear, true>(GLDS(P), P.tid, WSB(P, WS_P), WSB(P, WS_MD), 2 * DFE, S, E, pg8::RowsLinear{});
#endif
                } SEAM(17 + 2 * s);
            }
        }
    }
    if (IN(PH_FINAL)) { Frame P = phase_frame(F); final_phase(P); }
#undef IN
#undef SEAM
}

extern "C" void kernel_launch(void* const* d_in, const int* in_sizes, int n_in, void* d_out, int out_size, void* d_ws, size_t ws_size, hipStream_t stream) {
    static int grid = 0;
    if (grid == 0) {
        if (n_in != 26 || in_sizes[0] != NLAT * DM || out_size != NLAT * DM || ws_size < WS_END) {
            fprintf(stderr, "kernel_launch: unexpected shapes (n_in %d, in0 %d, out %d, ws %zu, need %zu); nothing launched\n", n_in, n_in > 0 ? in_sizes[0] : -1, out_size, ws_size, (size_t)WS_END); grid = -1; return; }
        int dev = 0, cus = 0, per_cu = 0;
        if (hipGetDevice(&dev) != hipSuccess || hipDeviceGetAttribute(&cus, hipDeviceAttributeMultiprocessorCount, dev) != hipSuccess) { grid = -1; return; }
        if (hipFuncSetAttribute((const void*)fwd_kernel, hipFuncAttributeMaxDynamicSharedMemorySize, LDS_BYTES) != hipSuccess) { fprintf(stderr, "kernel_launch: hipFuncSetAttribute failed\n"); grid = -1; return; }
        if (hipOccupancyMaxActiveBlocksPerMultiprocessor(&per_cu, (const void*)fwd_kernel, 512, LDS_BYTES) != hipSuccess || per_cu < 1)
            fprintf(stderr, "kernel_launch: note: occupancy query reports %d workgroups per CU\n", per_cu);
        (void)hipGetLastError();
        grid = cus;
    }
    if (grid < 0) return;
    if (hipMemsetAsync((char*)d_ws + WS_CTL, 0, CTL_ZERO_BYTES, stream) != hipSuccess) return;
    Params p{};
    for (int i = 0; i < 26; ++i) p.in[i] = (const float*)d_in[i];
    p.out = (float*)d_out; p.ws = (unsigned char*)d_ws;
#if MK_PER_PHASE
    for (int ph = 0; ph < N_PHASES; ++ph) { p.ph_lo = ph; p.ph_hi = ph + 1; hipLaunchKernelGGL(fwd_kernel, dim3(grid), dim3(512), LDS_BYTES, stream, p); }
#else
    p.ph_lo = 0; p.ph_hi = N_PHASES;
    hipLaunchKernelGGL(fwd_kernel, dim3(grid), dim3(512), LDS_BYTES, stream, p);
#endif
}
```

```cpp
#include <hip/hip_runtime.h>
#include <cstdio>
#include <cstdint>

#ifndef MK_PER_PHASE
#define MK_PER_PHASE 0
#endif

#define LAS __attribute__((address_space(3)))
#define GAS __attribute__((address_space(1)))
#define DI __device__ __forceinline__
typedef unsigned short bf16;
typedef short bf16x8 __attribute__((ext_vector_type(8)));
typedef short s16x4 __attribute__((ext_vector_type(4)));
typedef float f32x4 __attribute__((ext_vector_type(4)));
typedef float f32x16 __attribute__((ext_vector_type(16)));
typedef unsigned u32x4 __attribute__((ext_vector_type(4)));
typedef unsigned u32x2 __attribute__((ext_vector_type(2)));
typedef float f32x2_t __attribute__((ext_vector_type(2)));
typedef __bf16 bf16x2_t __attribute__((ext_vector_type(2)));
typedef short v4i16_t __attribute__((ext_vector_type(4)));

constexpr int DM = 1024, NB = 16, SEQ = 2048, CTXL = 256, GW = 64;
constexpr int NLAT = NB * SEQ, NCTX = NB * CTXL, NTOK = NLAT + NCTX;
constexpr int INW = 3072, DFF = 2816, NE = 8, DFE = 3584;
constexpr int C_NAQ = 0, C_NAK = 512, C_NAV = 1024, C_CONV = 1536, C_RQ = 2048, C_RK = 2176, C_RV = 2304, C_GF = 2560, C_GB = 2816;
constexpr float EPS = 1e-6f;
constexpr float LOG2E = 1.4426950408889634f;

constexpr size_t MiB = 1u << 20;
constexpr size_t WS_CTL = 0, CTL_ZERO_BYTES = 64 * 1024;
constexpr size_t WS_MODLAT = 1 * MiB;
constexpr size_t WS_MODCTX = WS_MODLAT + 2 * 16 * 6144 * 4;
constexpr size_t WS_ROPE = WS_MODCTX + 2 * 6144 * 4;
constexpr size_t WS_PTOK = 2 * MiB;
constexpr size_t WS_SEGCNT = WS_PTOK + 32768 * 2 * 4;
constexpr size_t WS_META = WS_SEGCNT + 256 * 2 * 8 * 4;
constexpr size_t WS_SEGLIST = 3 * MiB;
constexpr size_t WS_ROWMAP = 5 * MiB;
constexpr int MOE_ROWS = 34816;
constexpr size_t WS_PROW = WS_ROWMAP + 512 * 1024;
constexpr size_t WS_SUMLAT = 6 * MiB;
constexpr size_t WS_SUMCTX = 22 * MiB;
constexpr size_t WS_WIN = 24 * MiB;
constexpr size_t WS_WOUT = WS_WIN + (size_t)2 * 3072 * 1024 * 2;
constexpr size_t WS_WGU = WS_WOUT + (size_t)2 * 1024 * 1024 * 2;
constexpr size_t WS_WD = WS_WGU + (size_t)5632 * 1024 * 2;
constexpr size_t WS_MGU = WS_WD + (size_t)1024 * 2816 * 2;
constexpr size_t WS_MD = WS_MGU + (size_t)8 * 7168 * 1024 * 2;
constexpr size_t WS_HCTX = WS_MD + (size_t)8 * 1024 * 3584 * 2;
constexpr size_t WS_U = WS_HCTX + (size_t)NCTX * DM * 4;
constexpr size_t WS_P = WS_U + (size_t)NTOK * DM * 2;
constexpr size_t WS_END = WS_P + (size_t)MOE_ROWS * DFE * 2;
static_assert((size_t)NTOK * INW * 2 <= (size_t)MOE_ROWS * DFE * 2, "P region");
static_assert(WS_WIN % 256 == 0 && WS_WOUT % 256 == 0 && WS_WGU % 256 == 0 && WS_WD % 256 == 0 && WS_MGU % 256 == 0 && WS_MD % 256 == 0 && WS_HCTX % 256 == 0 && WS_U % 256 == 0 && WS_P % 256 == 0, "align");

constexpr int RING_BYTES = 131072;
constexpr int AUX_OFF = RING_BYTES;
constexpr int AUX_TAB = AUX_OFF + 1024;
constexpr int LDS_BYTES = 147456;

#ifndef MOE_FP8
#define MOE_FP8 1
#endif
#ifndef DENSE_FP8
#define DENSE_FP8 2
#endif
constexpr int SCL_U = 0x7c7c7c7c, SCL_WGU = 0x79797979, SCL_H = 0x7c7c7c7c, SCL_WD = 0x78787878;
constexpr float QS_U = 8.0f, QS_WGU = 64.0f, QS_H = 8.0f, QS_WD = 128.0f;
DI unsigned pk2(float lo, float hi) { f32x2_t v = {lo, hi}; bf16x2_t b = __builtin_convertvector(v, bf16x2_t); return __builtin_bit_cast(unsigned, b); }
DI float clamp448(float x) { return __builtin_fminf(__builtin_fmaxf(x, -448.0f), 448.0f); }
DI unsigned pk4_fp8(float a, float b, float c, float d) { int w = 0; w = __builtin_amdgcn_cvt_pk_fp8_f32(clamp448(a), clamp448(b), w, false); w = __builtin_amdgcn_cvt_pk_fp8_f32(clamp448(c), clamp448(d), w, true); return (unsigned)w; }
DI float bflo(unsigned u) { return __uint_as_float(u << 16); }
DI float bfhi(unsigned u) { return __uint_as_float(u & 0xffff0000u); }
DI float wave_sum(float v) {
#pragma unroll
    for (int o = 1; o < 64; o <<= 1) v += __shfl_xor(v, o);
    return v;
}
DI float fast_exp2(float x) { return __builtin_amdgcn_exp2f(x); }
DI float fast_rcp(float x) { return __builtin_amdgcn_rcpf(x); }
DI float sigmoidf_(float x) { return fast_rcp(1.0f + fast_exp2(-x * LOG2E)); }
DI int crow(int reg, int h) { return (reg & 3) + 8 * (reg >> 2) + 4 * h; }
#define MFMA32(a, b, c) __builtin_amdgcn_mfma_f32_32x32x16_bf16((a), (b), (c), 0, 0, 0)
DI s16x4 trread(LAS const unsigned char* p) { return __builtin_bit_cast(s16x4, __builtin_amdgcn_ds_read_tr16_b64_v4i16((LAS v4i16_t*)p)); }
DI int ld_i32_coherent(const int* p) { return (int)__hip_atomic_load((const unsigned*)p, __ATOMIC_RELAXED, __HIP_MEMORY_SCOPE_AGENT); }

namespace pg8 {
#define PG8_LAS __attribute__((address_space(3)))
typedef unsigned short bf16_t;
constexpr int BM = 256, BK = 64, HALF = 128, HTB = HALF * BK * 2, STAGE_BYTES = 8 * HTB, NXCD = 8, WGM = 8;
__host__ __device__ __forceinline__ int lds_byte(int r, int c) { const int st = (r >> 4) * 2 + (c >> 5), rr = r & 15, cc = c & 31, ob = rr * 64 + cc * 2; return st * 1024 + (ob ^ (((ob >> 9) & 1) << 5)); }
__host__ __device__ __forceinline__ void stage_rc(int b, int& R, int& C) { const int st = b / 1024, sb = b % 1024, swz = sb ^ (((sb >> 9) & 1) << 5); R = (st >> 1) * 16 + swz / 64; C = (st & 1) * 32 + (swz % 64) / 2; }
__host__ __device__ __forceinline__ int perm32(int rho) { const int n = rho >> 4, i = rho & 15; return 8 * (i >> 2) + 4 * n + (i & 3); }
struct Unit { int pm, pn; };
struct StaticOrder {
    int nM, nN, nwg, G, c;
    __device__ void init(int M, int N, int G_, int c_) { nM = M / BM; nN = N / BM; nwg = nM * nN; G = G_; c = c_; }
    __device__ bool next(int i, Unit& u) const {
        const long L = (long)i * G + c; if (L >= nwg) return false;
        int wgid = (int)L; { const int q = nwg / NXCD, r = nwg % NXCD, xcd = wgid % NXCD, off = wgid / NXCD; wgid = (xcd < r ? xcd * (q + 1) : r * (q + 1) + (xcd - r) * q) + off; }
        const int nig = WGM * nN, gid = wgid / nig, fm = gid * WGM, gsz = (nM - fm) < WGM ? (nM - fm) : WGM;
        u.pm = fm + ((wgid % nig) % gsz); u.pn = (wgid % nig) / gsz; return true;
    }
};
struct RowsLinear { static constexpr bool GATHER = false; };
struct RowsLinearOff {
    static constexpr bool GATHER = true;
    __device__ __forceinline__ void offs(const Unit& u, const int (&R)[2], const int (&C)[2], int pitch, unsigned (&o)[2][2]) const {
#pragma unroll
        for (int h = 0; h < 2; ++h)
#pragma unroll
            for (int i = 0; i < 2; ++i) { o[h][i] = (unsigned)(u.pm * BM + h * HALF + R[i]) * (unsigned)pitch + (unsigned)C[i] * 2u; asm volatile("" : "+v"(o[h][i])); }
    }
};
struct RowsGather {
    static constexpr bool GATHER = true;
    const int* rowmap; int row_add;
    __device__ __forceinline__ void offs(const Unit& u, const int (&R)[2], const int (&C)[2], int pitch, unsigned (&o)[2][2]) const {
#pragma unroll
        for (int h = 0; h < 2; ++h)
#pragma unroll
            for (int i = 0; i < 2; ++i) { int t = rowmap[u.pm * BM + h * HALF + R[i]]; t = t < 0 ? 0 : t;
                o[h][i] = (unsigned)((size_t)(t + row_add) * (size_t)pitch + (size_t)C[i] * 2u); }
#pragma unroll
        for (int h = 0; h < 2; ++h)
#pragma unroll
            for (int i = 0; i < 2; ++i) asm volatile("" : "+v"(o[h][i]));
    }
};

typedef int i32x8 __attribute__((ext_vector_type(8)));
typedef int i32x4v __attribute__((ext_vector_type(4)));
template <class Epi, class Sched, class ARows, bool ALIGN_EPI, bool FP8 = false>
__device__ __forceinline__ void gemm_phase(PG8_LAS unsigned char* lds, int tid, const void* A, const void* Bt, int pitch, const Sched& S, const Epi& E, const ARows& AR, int sclA = 0x7f7f7f7f, int sclB = 0x7f7f7f7f) {
    constexpr bool GATHER = ARows::GATHER;
    const int wid = __builtin_amdgcn_readfirstlane(tid >> 6), lane = tid & 63, wr = wid >> 2, wc = wid & 3, fr = lane & 15, fq = lane >> 4;
    const int nt = pitch / (BK * 2);
    int RA[2], CA[2]; unsigned voffA[2], voffB[2];
#pragma unroll
    for (int i = 0; i < 2; ++i) { int R, C; stage_rc(tid * 16 + i * 8192, R, C); const int Rb = Epi::PERM ? ((R & ~31) + perm32(R & 31)) : R;
        RA[i] = R; CA[i] = C; voffA[i] = (unsigned)(R * pitch + C * 2); voffB[i] = (unsigned)(Rb * pitch + C * 2); }
#pragma unroll
    for (int i = 0; i < 2; ++i) { asm volatile("" : "+v"(voffA[i])); asm volatile("" : "+v"(voffB[i])); }
    const size_t kstep = (size_t)(BK * 2);
    const size_t hstep = (size_t)HALF * pitch;
    const size_t tstep = 2 * hstep;
    const unsigned ldsw = (unsigned)wid * 1024u;
    const int aoff = lds_byte(wr * 64 + fr, fq * 8), boff = lds_byte(wc * 32 + fr, fq * 8);
    const char* Ab = (const char*)A;
#define PG8_SA(b, h) (((b) * 2 + (h)) * HTB)
#define PG8_SB(b, h) ((4 + (b) * 2 + (h)) * HTB)
#define PG8_STAGE(bufoff, gbase, voff) do { _Pragma("unroll") for (int _i = 0; _i < 2; ++_i) \
        __builtin_amdgcn_global_load_lds((const unsigned*)((const char*)(gbase) + (voff)[_i]), (PG8_LAS unsigned*)(lds + (bufoff) + ldsw + _i * 8192), 16, 0, 0); } while (0)
#define PG8_STAGEA(bufoff, h, plin, kb) do { if constexpr (GATHER) PG8_STAGE(bufoff, Ab + (kb), curA[h]); else PG8_STAGE(bufoff, (plin) + (h) * hstep, voffA); } while (0)
#define PG8_LDA(dst, b, h) do { _Pragma("unroll") for (int m = 0; m < 4; ++m) _Pragma("unroll") for (int k = 0; k < 2; ++k) dst[m][k] = *(const PG8_LAS bf16x8*)(lds + PG8_SA(b, h) + aoff + m * 2048 + k * 1024); } while (0)
#define PG8_LDB(dst, b, h) do { _Pragma("unroll") for (int n = 0; n < 2; ++n) _Pragma("unroll") for (int k = 0; k < 2; ++k) dst[n][k] = *(const PG8_LAS bf16x8*)(lds + PG8_SB(b, h) + boff + n * 2048 + k * 1024); } while (0)
#define PG8_CAT(x0, x1) __builtin_shufflevector(__builtin_bit_cast(i32x4v, x0), __builtin_bit_cast(i32x4v, x1), 0, 1, 2, 3, 4, 5, 6, 7)
#define PG8_MMA(ai, bj, At, Bt_) do { __builtin_amdgcn_s_setprio(1); \
        if constexpr (FP8) { _Pragma("unroll") for (int m = 0; m < 4; ++m) _Pragma("unroll") for (int n = 0; n < 2; ++n) \
            acc[ai][bj][m][n] = __builtin_amdgcn_mfma_scale_f32_16x16x128_f8f6f4(PG8_CAT(Bt_[n][0], Bt_[n][1]), PG8_CAT(At[m][0], At[m][1]), acc[ai][bj][m][n], 0, 0, 0, sclB, 0, sclA); } \
        else { _Pragma("unroll") for (int m = 0; m < 4; ++m) _Pragma("unroll") for (int n = 0; n < 2; ++n) _Pragma("unroll") for (int k = 0; k < 2; ++k) \
            acc[ai][bj][m][n] = __builtin_amdgcn_mfma_f32_16x16x32_bf16(Bt_[n][k], At[m][k], acc[ai][bj][m][n], 0, 0, 0); } \
        __builtin_amdgcn_s_setprio(0); } while (0)
#define PG8_WAIT_V(n) asm volatile("s_waitcnt vmcnt(" #n ")" ::: "memory")
#define PG8_WAIT_L(n) asm volatile("s_waitcnt lgkmcnt(" #n ")" ::: "memory")
#define PG8_BAR __builtin_amdgcn_s_barrier()
#define PG8_SCHED __builtin_amdgcn_sched_barrier(0)
    Unit cur, nxt; int ui = 0;
    if (!S.next(0, cur)) return;
    f32x4 acc[2][2][4][2];
#pragma unroll
    for (int a = 0; a < 2; ++a)
#pragma unroll
        for (int b = 0; b < 2; ++b)
#pragma unroll
            for (int m = 0; m < 4; ++m)
#pragma unroll
                for (int n = 0; n < 2; ++n) acc[a][b][m][n] = (f32x4){0.f, 0.f, 0.f, 0.f};
    bf16x8 At[4][2], B0[2][2], B1[2][2];
    unsigned curA[2][2] = {{0u, 0u}, {0u, 0u}}, nxtA[2][2] = {{0u, 0u}, {0u, 0u}};
    if constexpr (GATHER) AR.offs(cur, RA, CA, pitch, curA);
    const char* cA = GATHER ? Ab : Ab + (size_t)cur.pm * tstep;
    const char* cB = (const char*)Bt + (size_t)cur.pn * tstep;
    PG8_STAGE(PG8_SB(0, 0), cB, voffB); PG8_STAGE(PG8_SB(0, 1), cB + hstep, voffB); PG8_STAGEA(PG8_SA(0, 0), 0, cA, 0); PG8_STAGEA(PG8_SA(0, 1), 1, cA, 0);
    if (wr == 1) PG8_BAR;
    PG8_WAIT_V(2); PG8_BAR;
    PG8_STAGE(PG8_SB(1, 0), cB + kstep, voffB); PG8_STAGEA(PG8_SA(1, 0), 0, cA + kstep, kstep); PG8_STAGE(PG8_SB(1, 1), cB + hstep + kstep, voffB);
    PG8_WAIT_V(6); PG8_BAR;
    for (;;) {
        const bool has_next = S.next(ui + 1, nxt);
        if constexpr (GATHER) {
            if (has_next) AR.offs(nxt, RA, CA, pitch, nxtA);
            else {
#pragma unroll
                for (int h = 0; h < 2; ++h)
#pragma unroll
                    for (int i = 0; i < 2; ++i) nxtA[h][i] = curA[h][i];
            }
        }
        const char* nA = GATHER ? Ab : (has_next ? Ab + (size_t)nxt.pm * tstep : cA);
        const char* nB = has_next ? (const char*)Bt + (size_t)nxt.pn * tstep : cB;
        for (int t = 0; t < nt; t += 2) {
            const bool last = (t == nt - 2);
            const size_t k1 = (size_t)(t + 1) * kstep, k2 = last ? 0 : (size_t)(t + 2) * kstep, k3 = k2 + kstep;
            const char* a1 = cA + k1;
            const char* a2 = last ? nA : cA + k2; const char* b2 = last ? nB : cB + k2;
            const char* a3 = a2 + kstep; const char* b3 = b2 + kstep;
            PG8_LDB(B0, 0, 0); PG8_LDB(B1, 0, 1); PG8_SCHED; PG8_LDA(At, 0, 0); PG8_STAGEA(PG8_SA(1, 1), 1, a1, k1);
            if constexpr (GATHER) { if (last) {
#pragma unroll
                for (int h = 0; h < 2; ++h)
#pragma unroll
                    for (int i = 0; i < 2; ++i) curA[h][i] = nxtA[h][i]; } }
            PG8_WAIT_V(8); PG8_WAIT_L(0); PG8_BAR; PG8_MMA(0, 0, At, B0); PG8_MMA(0, 1, At, B1); PG8_BAR; PG8_SCHED;
            PG8_LDA(At, 0, 1); PG8_STAGE(PG8_SB(0, 0), b2, voffB); PG8_STAGE(PG8_SB(0, 1), b2 + hstep, voffB); PG8_STAGEA(PG8_SA(0, 0), 0, a2, k2);
            PG8_WAIT_V(8); PG8_WAIT_L(0); PG8_BAR; PG8_MMA(1, 0, At, B0); PG8_MMA(1, 1, At, B1); PG8_BAR; PG8_SCHED;
            PG8_LDB(B0, 1, 0); PG8_LDB(B1, 1, 1); PG8_SCHED; PG8_LDA(At, 1, 0); PG8_STAGEA(PG8_SA(0, 1), 1, a2, k2);
            PG8_WAIT_V(8); PG8_WAIT_L(0); PG8_BAR; PG8_MMA(0, 0, At, B0); PG8_MMA(0, 1, At, B1); PG8_BAR; PG8_SCHED;
            PG8_LDA(At, 1, 1); PG8_STAGE(PG8_SB(1, 0), b3, voffB); PG8_STAGE(PG8_SB(1, 1), b3 + hstep, voffB); PG8_STAGEA(PG8_SA(1, 0), 0, a3, k3);
            PG8_WAIT_V(8); PG8_WAIT_L(0); PG8_BAR; PG8_MMA(1, 0, At, B0); PG8_MMA(1, 1, At, B1); PG8_BAR; PG8_SCHED;
        }
        if constexpr (ALIGN_EPI) { if (wr == 0) PG8_BAR; }
        E(acc, cur, wr, wc, fr, fq);
        if (!has_next) break;
#pragma unroll
        for (int a = 0; a < 2; ++a)
#pragma unroll
            for (int b = 0; b < 2; ++b)
#pragma unroll
                for (int m = 0; m < 4; ++m)
#pragma unroll
                    for (int n = 0; n < 2; ++n) acc[a][b][m][n] = (f32x4){0.f, 0.f, 0.f, 0.f};
        cur = nxt; cA = nA; cB = nB; ++ui;
        if constexpr (ALIGN_EPI) { if (wr == 1) PG8_BAR; }
    }
    PG8_WAIT_V(0);
    if constexpr (!ALIGN_EPI) { if (wr == 0) PG8_BAR; }
    PG8_BAR;
#undef PG8_SA
#undef PG8_SB
#undef PG8_STAGE
#undef PG8_STAGEA
#undef PG8_LDA
#undef PG8_LDB
#undef PG8_MMA
#undef PG8_CAT
#undef PG8_WAIT_V
#undef PG8_WAIT_L
#undef PG8_BAR
#undef PG8_SCHED
}

#define PG8_OPAQUE(x) asm volatile("" : "+v"(x))
struct EpiStoreBf16 {
    static constexpr bool PERM = true;
    bf16_t* O; int ldc;
    __device__ __forceinline__ void operator()(const f32x4 (&acc)[2][2][4][2], const Unit& u, int wr, int wc, int fr, int fq) const {
        char* base = (char*)(O + (size_t)(u.pm * BM) * ldc + u.pn * BM);
        unsigned lb = (unsigned)((wr * 64 + fr) * ldc + wc * 32 + 8 * fq) * 2u; PG8_OPAQUE(lb);
        const unsigned rstep = (unsigned)ldc * 32u;
#pragma unroll
        for (int ai = 0; ai < 2; ++ai)
#pragma unroll
            for (int m = 0; m < 4; ++m) { const unsigned ro = lb + (unsigned)(ai * 8 + m) * rstep;
#pragma unroll
                for (int bj = 0; bj < 2; ++bj) { const f32x4 v0 = acc[ai][bj][m][0], v1 = acc[ai][bj][m][1];
                    u32x4 w; w.x = pk2(v0[0], v0[1]); w.y = pk2(v0[2], v0[3]); w.z = pk2(v1[0], v1[1]); w.w = pk2(v1[2], v1[3]);
                    *(u32x4*)(base + ro + bj * (HALF * 2)) = w; } }
    }
};
struct EpiResGate {
    static constexpr bool PERM = false;
    const float* src_ctx; const float* src_lat; float* dst_ctx; float* dst_lat; const float* gate_lat; const float* gate_ctx; int row_base;
    __device__ __forceinline__ void operator()(const f32x4 (&acc)[2][2][4][2], const Unit& u, int wr, int wc, int fr, int fq) const {
        const int rowu = row_base + u.pm * BM; const bool isctx = rowu < NCTX;
        const char* src = (const char*)(isctx ? src_ctx + (size_t)rowu * DM : src_lat + (size_t)(rowu - NCTX) * DM) + u.pn * (BM * 4);
        char* dst = (char*)(isctx ? dst_ctx + (size_t)rowu * DM : dst_lat + (size_t)(rowu - NCTX) * DM) + u.pn * (BM * 4);
        const float* gate = (isctx ? gate_ctx : gate_lat + (size_t)((rowu - NCTX) / SEQ) * 6144) + u.pn * BM;
        const int cl = wc * 32 + 4 * fq;
        f32x4 sc[2][2][4][2];
#pragma unroll
        for (int bj = 0; bj < 2; ++bj)
#pragma unroll
            for (int n = 0; n < 2; ++n) { const f32x4 gv = *(const f32x4*)(gate + cl + bj * HALF + n * 16);
#pragma unroll
                for (int ai = 0; ai < 2; ++ai)
#pragma unroll
                    for (int m = 0; m < 4; ++m) sc[ai][bj][m][n] = acc[ai][bj][m][n] * gv; }
        unsigned lb = (unsigned)((wr * 64 + fr) * DM + cl) * 4u; PG8_OPAQUE(lb);
#pragma unroll
        for (int ai = 0; ai < 2; ++ai)
#pragma unroll
            for (int m = 0; m < 4; ++m) { const unsigned ro = lb + (unsigned)(ai * 8 + m) * (16u * DM * 4u);
#pragma unroll
                for (int bj = 0; bj < 2; ++bj)
#pragma unroll
                    for (int n = 0; n < 2; ++n) { const unsigned o = ro + (unsigned)(bj * HALF + n * 16) * 4u; const f32x4 s = *(const f32x4*)(src + o);
                        *(f32x4*)(dst + o) = s + sc[ai][bj][m][n]; }
                asm volatile("" ::: "memory"); }
    }
};
template <bool MOE> struct EpiSwiglu {
    static constexpr bool PERM = true;
    static constexpr bool OUT8 = MOE ? (MOE_FP8 != 0) : (DENSE_FP8 != 0);
    bf16_t* O; int ldc; int ncol; const float* prow;
    __device__ __forceinline__ void operator()(const f32x4 (&acc)[2][2][4][2], const Unit& u, int wr, int wc, int fr, int fq) const {
        const int pnl = MOE ? (u.pn % ncol) : u.pn;
        constexpr int ES = OUT8 ? 1 : 2;
        char* base = (char*)O + ((size_t)(u.pm * BM) * ldc + pnl * HALF) * ES;
        unsigned lb = (unsigned)((wr * 64 + fr) * ldc + wc * 32 + 8 * fq) * ES; PG8_OPAQUE(lb);
        const unsigned rstep = (unsigned)ldc * 16u * ES;
        const float* pr = MOE ? prow + u.pm * BM : nullptr;
        unsigned pl = (unsigned)(wr * 64 + fr) * 4u; PG8_OPAQUE(pl);
#pragma unroll
        for (int ai = 0; ai < 2; ++ai)
#pragma unroll
            for (int m = 0; m < 4; ++m) {
                float pw = 1.0f; if (MOE) pw = *(const float*)((const char*)pr + pl + (unsigned)(ai * 8 + m) * 64u);
                if (OUT8) pw *= QS_H;
                float hv[8];
#pragma unroll
                for (int n = 0; n < 2; ++n)
#pragma unroll
                    for (int j = 0; j < 4; ++j) { const float g = acc[ai][0][m][n][j], up = acc[ai][1][m][n][j]; hv[n * 4 + j] = g * sigmoidf_(g) * up * pw; }
                if constexpr (OUT8) { u32x2 w; w.x = pk4_fp8(hv[0], hv[1], hv[2], hv[3]); w.y = pk4_fp8(hv[4], hv[5], hv[6], hv[7]);
                    *(u32x2*)(base + lb + (unsigned)(ai * 8 + m) * rstep) = w; }
                else { u32x4 w; w.x = pk2(hv[0], hv[1]); w.y = pk2(hv[2], hv[3]); w.z = pk2(hv[4], hv[5]); w.w = pk2(hv[6], hv[7]);
                    *(u32x4*)(base + lb + (unsigned)(ai * 8 + m) * rstep) = w; } }
    }
};
struct EpiMoeScatter {
    static constexpr bool PERM = false;
    const int* rowmap; float* hlat; const float* gate_lat; int ncol;
    __device__ __forceinline__ void operator()(const f32x4 (&acc)[2][2][4][2], const Unit& u, int wr, int wc, int fr, int fq) const {
        const int pnl = u.pn % ncol;
        const int* rm = rowmap + u.pm * BM;
        char* hb = (char*)hlat + pnl * (BM * 4); const char* gb = (const char*)gate_lat + pnl * (BM * 4);
        unsigned pl = (unsigned)(wr * 64 + fr) * 4u; PG8_OPAQUE(pl);
        unsigned cb = (unsigned)(wc * 32 + 4 * fq) * 4u; PG8_OPAQUE(cb);
#pragma unroll
        for (int ai = 0; ai < 2; ++ai)
#pragma unroll
            for (int m = 0; m < 4; ++m) { const int tok = *(const int*)((const char*)rm + pl + (unsigned)(ai * 8 + m) * 64u);
                if (tok >= 0) { const unsigned ro = (unsigned)tok * (DM * 4u) + cb, go = ((unsigned)tok >> 11) * (6144u * 4u) + cb;
#pragma unroll
                    for (int bj = 0; bj < 2; ++bj)
#pragma unroll
                        for (int n = 0; n < 2; ++n) { const unsigned o = (unsigned)(bj * HALF + n * 16) * 4u; const f32x4 sv = *(const f32x4*)(hb + ro + o); const f32x4 gv = *(const f32x4*)(gb + go + o);
                            *(f32x4*)(hb + ro + o) = sv + gv * acc[ai][bj][m][n]; } }
                asm volatile("" ::: "memory"); }
    }
};
struct MoeOrder {
    int NT, ncol, G, c; const PG8_LAS int* texp;
    __device__ bool next(int i, Unit& u) const {
        const long L = (long)i * G + c; if (L >= (long)NT * ncol) return false;
        const int t = (int)(L / ncol), pnl = (int)(L % ncol);
        const int e = __builtin_amdgcn_readfirstlane(texp[t]);
        u.pm = t; u.pn = e * ncol + pnl; return true;
    }
};
}

#define XB_TMO      128
#define XB_XCNT(j)  (256  + 64 * (j))
#define XB_XSUB(j)  (1280 + 64 * (j))
#define XB_XGEN(j)  (2304 + 64 * (j))
#define XB_TOP      3328
#define XB_TOPGEN   3392
#define XCD_BAR_WORDS 3456
#define XB_SPIN_CAP (1u << 18)
DI unsigned xb_ld(unsigned* p)              { return __hip_atomic_load(p, __ATOMIC_RELAXED, __HIP_MEMORY_SCOPE_AGENT); }
DI unsigned xb_add(unsigned* p, unsigned v) { return __hip_atomic_fetch_add(p, v, __ATOMIC_RELAXED, __HIP_MEMORY_SCOPE_AGENT); }
DI unsigned xb_xcc_id() { return (unsigned)__builtin_amdgcn_s_getreg((3 << 11) | 20) & 0xFu; }
#define XB_SPIN(cond, bar) do { unsigned _sp = 0; while (cond) { __builtin_amdgcn_s_sleep(1); \
    if ((++_sp & 255u) == 0u) { if (xb_ld(&(bar)[XB_TMO])) break; if (_sp > XB_SPIN_CAP) { atomicAdd(&(bar)[XB_TMO], 1u); break; } } } } while (0)
struct XcdBarrier { unsigned* bar; unsigned x; volatile LAS unsigned* st; };
DI XcdBarrier xcd_barrier_post(unsigned* bar, volatile LAS unsigned* st) {
    XcdBarrier b; b.bar = bar; b.x = xb_xcc_id(); b.st = st;
    if (threadIdx.x == 0) (void)xb_add(&bar[XB_XCNT(b.x)], 1u);
    return b;
}
DI void xcd_barrier_complete(unsigned* bar, unsigned x, unsigned& nloc, unsigned& nx) {
    const unsigned G = gridDim.x * gridDim.y * gridDim.z;
    unsigned sum, cnt, mine, sp = 0u;
    for (;;) {
        sum = 0u; cnt = 0u; mine = 0u;
#pragma unroll
        for (unsigned j = 0; j < 16; ++j) { const unsigned c = xb_ld(&bar[XB_XCNT(j)]); sum += c; cnt += (c > 0u) ? 1u : 0u; mine = (j == x) ? c : mine; }
        if (sum == G) break;
        __builtin_amdgcn_s_sleep(1);
        if ((++sp & 255u) == 0u) { if (xb_ld(&bar[XB_TMO])) break; if (sp > XB_SPIN_CAP) { atomicAdd(&bar[XB_TMO], 1u); break; } }
    }
    nloc = mine > 0u ? mine : 1u; nx = cnt > 0u ? cnt : 1u;
}
DI void xcd_barrier(const XcdBarrier& b) {
    asm volatile("s_waitcnt vmcnt(0)" ::: "memory");
    __syncthreads();
    if (threadIdx.x == 0) {
        unsigned* bar = b.bar;
        __builtin_amdgcn_s_waitcnt(0);
        unsigned nloc = b.st[0], nx = b.st[1];
        if (nloc == 0u) { xcd_barrier_complete(bar, b.x, nloc, nx); b.st[0] = nloc; b.st[1] = nx; }
        const unsigned old = xb_add(&bar[XB_XSUB(b.x)], 1u);
        const unsigned gen = old / nloc;
        if (old + 1u == (gen + 1u) * nloc) {
            __builtin_amdgcn_fence(__ATOMIC_RELEASE, "agent");
            asm volatile("s_waitcnt vmcnt(0)" ::: "memory");
            const unsigned og = xb_add(&bar[XB_TOP], 1u);
            const unsigned tg = og / nx;
            if (og + 1u == (tg + 1u) * nx) xb_add(&bar[XB_TOPGEN], 1u);
            else XB_SPIN(xb_ld(&bar[XB_TOPGEN]) == tg, bar);
            __builtin_amdgcn_fence(__ATOMIC_ACQUIRE, "agent");
            xb_add(&bar[XB_XGEN(b.x)], 1u);
            asm volatile("s_waitcnt vmcnt(0)" ::: "memory");
        } else {
            XB_SPIN(xb_ld(&bar[XB_XGEN(b.x)]) == gen, bar);
            __builtin_amdgcn_fence(__ATOMIC_ACQUIRE, "agent");
            asm volatile("s_waitcnt vmcnt(0)" ::: "memory");
        }
    }
    __syncthreads();
}

struct Params { const float* in[26]; float* out; unsigned char* ws; int ph_lo, ph_hi, pad0, pad1; };
enum { I_X = 0, I_C, I_CTX, I_CCTX, I_WMOD, I_BMOD, I_N1W, I_N2W, I_WIN, I_WOUT, I_RPB, I_CONVW, I_CONVB, I_CLNW, I_CLNB, I_RDEC, I_RGNW,
       I_FG, I_FU, I_FD, I_MR, I_MRB, I_MG, I_MU, I_MDN, I_FNW };
constexpr int PH_P0 = 0, PH_FINAL = 20, N_PHASES = 21;

typedef __attribute__((address_space(4))) const unsigned char* karg_t;
struct KIn {
    karg_t ka;
    DI const float* operator[](int k) const { return *(const float* __attribute__((address_space(4))) const*)(ka + 8 * k); }
};
struct Frame {
    LAS unsigned char* lds;
    int tid, lane, wave, G, bid, vb;
    KIn in; float* out; unsigned char* ws;
};
DI Frame phase_frame(const Frame& F0) {
    Frame F; karg_t ka = F0.in.ka; asm volatile("" : "+s"(ka)); F.in.ka = ka;
    F.out = *(float* __attribute__((address_space(4))) const*)(ka + 208);
    F.ws = *(unsigned char* __attribute__((address_space(4))) const*)(ka + 216);
    int tid = F0.tid, G = F0.G, bid = F0.bid; unsigned ldsb = (unsigned)(size_t)F0.lds;
    asm volatile("" : "+v"(tid)); asm volatile("" : "+s"(G)); asm volatile("" : "+s"(bid)); asm volatile("" : "+s"(ldsb));
    F.tid = tid; F.lane = tid & 63; F.wave = __builtin_amdgcn_readfirstlane(tid >> 6); F.G = G; F.bid = bid; F.lds = (LAS unsigned char*)(size_t)ldsb;
    F.vb = (G % 8 == 0) ? (bid % 8) * (G / 8) + bid / 8 : bid;
    return F;
}

DI void p0_transpose_item(const float* W, int K, int N, bf16* WT, int k0, int n0, int dst_row0, LAS float* scr, int lane) {
#pragma unroll 8
    for (int i = 0; i < 32; ++i) { const int kk = 2 * i + (lane >> 5); scr[kk * 33 + (lane & 31)] = W[(size_t)(k0 + kk) * N + n0 + (lane & 31)]; }
    asm volatile("s_waitcnt lgkmcnt(0)" ::: "memory");
    const int c = lane & 7;
#pragma unroll
    for (int j = 0; j < 4; ++j) { const int n = (lane >> 3) + 8 * j; const LAS float* s = scr + (8 * c) * 33 + n;
        u32x4 o; o.x = pk2(s[0 * 33], s[1 * 33]); o.y = pk2(s[2 * 33], s[3 * 33]); o.z = pk2(s[4 * 33], s[5 * 33]); o.w = pk2(s[6 * 33], s[7 * 33]);
        *(u32x4*)(WT + (size_t)(dst_row0 + n) * K + k0 + 8 * c) = o; }
    asm volatile("s_waitcnt lgkmcnt(0)" ::: "memory");
}
DI void p0_convert_plain(Frame& F, const float* W, int K, int N, bf16* WT, int item, LAS float* scr) {
    const int nblk = N / 32, kb = item / nblk, nb = item % nblk;
    p0_transpose_item(W, K, N, WT, 64 * kb, 32 * nb, 32 * nb, scr, F.lane);
}
DI void p0_convert_gu(Frame& F, const float* W, int K, int N, bf16* WT, int item, int up, LAS float* scr) {
    const int nblk = N / 32, kb = item / nblk, nb = item % nblk, n0 = 32 * nb;
    p0_transpose_item(W, K, N, WT, 64 * kb, n0, 256 * (n0 / 128) + (n0 % 128) + (up ? 128 : 0), scr, F.lane);
}
DI void conv_item64(const float* W, int K, int N, bf16* WT, int k0, int n0, int dst_row0, LAS unsigned* scr, int lane) {
    const float* wp = W + (size_t)k0 * N + n0 + lane;
    float v[64];
#pragma unroll
    for (int i = 0; i < 64; ++i) v[i] = wp[(size_t)i * N];
#pragma unroll
    for (int i = 0; i < 32; ++i) scr[i * 65 + lane] = pk2(v[2 * i], v[2 * i + 1]);
    asm volatile("s_waitcnt lgkmcnt(0)" ::: "memory");
    const int c = lane & 7;
#pragma unroll
    for (int j = 0; j < 8; ++j) { const int n = (lane >> 3) + 8 * j; const LAS unsigned* sp = scr + (4 * c) * 65 + n;
        u32x4 o; o.x = sp[0]; o.y = sp[65]; o.z = sp[130]; o.w = sp[195];
        *(u32x4*)(WT + (size_t)(dst_row0 + n) * K + k0 + 8 * c) = o; }
    asm volatile("s_waitcnt lgkmcnt(0)" ::: "memory");
}
DI void conv_item64_fp8(const float* W, int K, int N, unsigned char* WT, int k0, int n0, int dst_row0, float qs, LAS unsigned* scr, int lane) {
    const float* wp = W + (size_t)k0 * N + n0 + lane;
    float v[64];
#pragma unroll
    for (int i = 0; i < 64; ++i) v[i] = wp[(size_t)i * N];
#pragma unroll
    for (int i = 0; i < 16; ++i) scr[i * 65 + lane] = pk4_fp8(v[4 * i] * qs, v[4 * i + 1] * qs, v[4 * i + 2] * qs, v[4 * i + 3] * qs);
    asm volatile("s_waitcnt lgkmcnt(0)" ::: "memory");
    const int c = lane & 3;
#pragma unroll
    for (int j = 0; j < 4; ++j) { const int n = (lane >> 2) + 16 * j; const LAS unsigned* sp = scr + (4 * c) * 65 + n;
        u32x4 o; o.x = sp[0]; o.y = sp[65]; o.z = sp[130]; o.w = sp[195];
        *(u32x4*)(WT + (size_t)(dst_row0 + n) * K + k0 + 16 * c) = o; }
    asm volatile("s_waitcnt lgkmcnt(0)" ::: "memory");
}
constexpr int BG_ITEMS = 21504;
constexpr int BG_B0 = 0, BG_D0 = 1200, BG_E0 = 5200, BG_F0 = 8700, BG_B1 = 19700, BG_CL = 20900;
DI void bg_item(Frame& F, int g, LAS unsigned* scr) {
    if (g < 14336) { const int m = g / 896, e = m >> 1, up = m & 1, r = g % 896, kb = r / 56, nb = r % 56, n0 = 64 * nb; const int drow = 256 * (n0 / 128) + (n0 % 128) + (up ? 128 : 0);
#if MOE_FP8
        conv_item64_fp8(F.in[up ? I_MU : I_MG] + (size_t)e * 1024 * 3584, 1024, 3584, F.ws + WS_MGU + (size_t)e * 7168 * 1024, 64 * kb, n0, drow, QS_WGU, scr, F.lane);
#else
        conv_item64(F.in[up ? I_MU : I_MG] + (size_t)e * 1024 * 3584, 1024, 3584, (bf16*)(F.ws + WS_MGU) + (size_t)e * 7168 * 1024, 64 * kb, n0, drow, scr, F.lane);
#endif
    } else { const int gg = g - 14336, e = gg / 896, r = gg % 896, kb = r / 16, nb = r % 16;
#if MOE_FP8
        conv_item64_fp8(F.in[I_MDN] + (size_t)e * 3584 * 1024, 3584, 1024, F.ws + WS_MD + (size_t)e * 1024 * 3584, 64 * kb, 64 * nb, 64 * nb, QS_WD, scr, F.lane);
#else
        conv_item64(F.in[I_MDN] + (size_t)e * 3584 * 1024, 3584, 1024, (bf16*)(F.ws + WS_MD) + (size_t)e * 1024 * 3584, 64 * kb, 64 * nb, 64 * nb, scr, F.lane);
#endif
    }
}
DI void bg_convert_tail(Frame& F, int nwg, int lo, int hi) {
    const int nmax = (nwg + F.G - 1) / F.G, rem = nwg - (nmax - 1) * F.G;
    if (F.bid < rem || rem >= F.G) return;
    LAS unsigned* scr = (LAS unsigned*)(F.lds + F.wave * 8320);
    const int w = (F.bid - rem) * 8 + F.wave, nw = (F.G - rem) * 8;
    for (int g = lo + w; g < hi; g += nw) bg_item(F, g, scr);
}
DI void bg_convert_all(Frame& F, int lo, int hi) {
    LAS unsigned* scr = (LAS unsigned*)(F.lds + F.wave * 8320);
    for (int g = lo + F.bid * 8 + F.wave; g < hi; g += F.G * 8) bg_item(F, g, scr);
}
DI void p0_prologue(Frame& F) {
    {
        LAS float* Sx = (LAS float*)F.lds;
        LAS float* red = (LAS float*)(F.lds + 81920);
        bool staged = false;
        for (int unit = F.bid; unit < 192; unit += F.G) {
            if (!staged) {
                for (int idx = F.tid; idx < 17 * 1024; idx += 512) { const int r = idx / 1024, k = idx % 1024;
                    const float v = r < 16 ? F.in[I_C][r * 1024 + k] : F.in[I_CCTX][k]; Sx[k * 20 + r] = v * sigmoidf_(v); }
                staged = true; __syncthreads();
            }
            const int l = unit / 96, n0 = (unit % 96) * 64;
            const float* Wm = F.in[I_WMOD] + (size_t)l * 1024 * 6144 + n0 + F.lane;
            float acc[17];
#pragma unroll
            for (int r = 0; r < 17; ++r) acc[r] = 0.f;
            const int kb = F.wave * 128;
#pragma unroll 4
            for (int k = 0; k < 128; ++k) { const float wv = Wm[(size_t)(kb + k) * 6144]; const LAS float* sp = Sx + (kb + k) * 20;
                const f32x4 s0 = *(const LAS f32x4*)(sp), s1 = *(const LAS f32x4*)(sp + 4), s2 = *(const LAS f32x4*)(sp + 8), s3 = *(const LAS f32x4*)(sp + 12); const float s4 = sp[16];
                acc[0] += s0[0] * wv; acc[1] += s0[1] * wv; acc[2] += s0[2] * wv; acc[3] += s0[3] * wv; acc[4] += s1[0] * wv; acc[5] += s1[1] * wv; acc[6] += s1[2] * wv; acc[7] += s1[3] * wv;
                acc[8] += s2[0] * wv; acc[9] += s2[1] * wv; acc[10] += s2[2] * wv; acc[11] += s2[3] * wv; acc[12] += s3[0] * wv; acc[13] += s3[1] * wv; acc[14] += s3[2] * wv; acc[15] += s3[3] * wv;
                acc[16] += s4 * wv; }
#pragma unroll
            for (int r = 0; r < 17; ++r) red[(F.wave * 17 + r) * 64 + F.lane] = acc[r];
            __syncthreads();
            for (int idx = F.tid; idx < 17 * 64; idx += 512) { const int r = idx / 64, ln = idx % 64; float s = F.in[I_BMOD][l * 6144 + n0 + ln];
#pragma unroll
                for (int w = 0; w < 8; ++w) s += red[(w * 17 + r) * 64 + ln];
                if (r < 16) ((float*)(F.ws + WS_MODLAT))[((size_t)l * 16 + r) * 6144 + n0 + ln] = s; else ((float*)(F.ws + WS_MODCTX))[(size_t)l * 6144 + n0 + ln] = s; }
            __syncthreads();
        }
        __syncthreads();
    }
    if (F.bid == 0) { const int pos = F.tid >> 3, j = F.tid & 7; const float inv = exp2f(-(float)j * 0.125f * 13.287712379549449f); const float ang = (float)pos * inv;
        float* tab = (float*)(F.ws + WS_ROPE); tab[(pos * 8 + j) * 2] = cosf(ang); tab[(pos * 8 + j) * 2 + 1] = sinf(ang); }
    {
        LAS float* scr = (LAS float*)(F.lds + F.wave * 16384);
        const int gw = F.bid * 8 + F.wave, NGW = F.G * 8;
        constexpr int I_IN = 16 * 96, I_OUT = 16 * 32, I_G = 16 * 88, I_D = 44 * 32, I_MGI = 16 * 112, I_MDI = 56 * 32;
        constexpr int NITEMS = 2 * I_IN + 2 * I_OUT + (DENSE_FP8 == 1 ? 3 * 704 : (DENSE_FP8 == 2 ? 2 * I_G + 704 : 2 * I_G + I_D));
        for (int it = gw; it < NITEMS; it += NGW) {
            int r = it;
            if (r < 2 * I_IN) { const int l = r / I_IN; p0_convert_plain(F, F.in[I_WIN] + (size_t)l * 1024 * 3072, 1024, 3072, (bf16*)(F.ws + WS_WIN) + (size_t)l * 3072 * 1024, r % I_IN, scr); continue; } r -= 2 * I_IN;
            if (r < 2 * I_OUT) { const int l = r / I_OUT; p0_convert_plain(F, F.in[I_WOUT] + (size_t)l * 1024 * 1024, 1024, 1024, (bf16*)(F.ws + WS_WOUT) + (size_t)l * 1024 * 1024, r % I_OUT, scr); continue; } r -= 2 * I_OUT;
#if DENSE_FP8 == 2
            if (r < I_G) { p0_convert_gu(F, F.in[I_FG], 1024, 2816, (bf16*)(F.ws + WS_WGU), r, 0, scr); continue; } r -= I_G;
            if (r < I_G) { p0_convert_gu(F, F.in[I_FU], 1024, 2816, (bf16*)(F.ws + WS_WGU), r, 1, scr); continue; } r -= I_G;
            { const int kb = r / 16, nb = r % 16; conv_item64_fp8(F.in[I_FD], 2816, 1024, F.ws + WS_WD, 64 * kb, 64 * nb, 64 * nb, QS_WD, (LAS unsigned*)scr, F.lane); }
#elif DENSE_FP8 == 1
            { LAS unsigned* scr8 = (LAS unsigned*)scr;
              if (r < 1408) { const int up = r / 704, q = r % 704, kb = q / 44, nb = q % 44, n0 = 64 * nb;
                  conv_item64_fp8(F.in[up ? I_FU : I_FG], 1024, 2816, F.ws + WS_WGU, 64 * kb, n0, 256 * (n0 / 128) + (n0 % 128) + (up ? 128 : 0), QS_WGU, scr8, F.lane); }
              else { const int q = r - 1408, kb = q / 16, nb = q % 16; conv_item64_fp8(F.in[I_FD], 2816, 1024, F.ws + WS_WD, 64 * kb, 64 * nb, 64 * nb, QS_WD, scr8, F.lane); } }
#else
            if (r < I_G) { p0_convert_gu(F, F.in[I_FG], 1024, 2816, (bf16*)(F.ws + WS_WGU), r, 0, scr); continue; } r -= I_G;
            if (r < I_G) { p0_convert_gu(F, F.in[I_FU], 1024, 2816, (bf16*)(F.ws + WS_WGU), r, 1, scr); continue; } r -= I_G;
            p0_convert_plain(F, F.in[I_FD], 2816, 1024, (bf16*)(F.ws + WS_WD), r, scr);
#endif
        }
    }
}

struct NormVecs { f32x4 gs[4], sh[4]; };
DI void norm_load_vecs(Frame& F, const float* g, const float* mod, int isc, int ish, NormVecs& V) {
#pragma unroll
    for (int j = 0; j < 4; ++j) { const f32x4 gv = ((const f32x4*)g)[F.lane + 64 * j], sv = ((const f32x4*)(mod + isc * DM))[F.lane + 64 * j]; V.gs[j] = gv * (sv + 1.0f); V.sh[j] = ((const f32x4*)(mod + ish * DM))[F.lane + 64 * j]; }
}
DI void norm_load_row(Frame& F, const float* srow, f32x4 (&v)[4]) {
    const f32x4* xr = (const f32x4*)srow + F.lane;
#pragma unroll
    for (int j = 0; j < 4; ++j) v[j] = xr[64 * j];
}
DI float norm_ssq(const f32x4 (&v)[4]) { float s = 0.f;
#pragma unroll
    for (int j = 0; j < 4; ++j) s += (v[j].x * v[j].x + v[j].y * v[j].y) + (v[j].z * v[j].z + v[j].w * v[j].w);
    return s; }
DI void norm_finish(Frame& F, const f32x4 (&v)[4], float ssq_total, const NormVecs& V, bf16* orow, f32x4 (&y)[4]) {
    const float rstd = 1.0f / sqrtf(ssq_total * (1.0f / DM) + EPS);
    u32x2* o8 = (u32x2*)orow + F.lane;
#pragma unroll
    for (int j = 0; j < 4; ++j) { y[j] = (v[j] * rstd) * V.gs[j] + V.sh[j]; u32x2 w; w.x = pk2(y[j].x, y[j].y); w.y = pk2(y[j].z, y[j].w); o8[64 * j] = w; }
}
DI void norm_finish8(Frame& F, const f32x4 (&v)[4], float ssq_total, const NormVecs& V, unsigned char* orow, f32x4 (&y)[4]) {
    const float rstd = 1.0f / sqrtf(ssq_total * (1.0f / DM) + EPS);
    unsigned* o4 = (unsigned*)orow + F.lane;
#pragma unroll
    for (int j = 0; j < 4; ++j) { y[j] = (v[j] * rstd) * V.gs[j] + V.sh[j]; o4[64 * j] = pk4_fp8(y[j].x * QS_U, y[j].y * QS_U, y[j].z * QS_U, y[j].w * QS_U); }
}
DI void norm_phase(Frame& F, int l, int which, bool first, int row_lo, bool out8 = false) {
    const float* g = F.in[which == 1 ? I_N1W : I_N2W] + l * DM;
    const float* modlat = (const float*)(F.ws + WS_MODLAT) + (size_t)l * 16 * 6144;
    const float* modctx = (const float*)(F.ws + WS_MODCTX) + (size_t)l * 6144;
    const int ish = which == 1 ? 0 : 3, isc = which == 1 ? 1 : 4;
    const float* sctx = first ? F.in[I_CTX] : (const float*)(F.ws + WS_HCTX);
    const float* slat = first ? F.in[I_X] : F.out;
    bf16* U = (bf16*)(F.ws + WS_U);
    const int gw = F.bid * 8 + F.wave, NGW = F.G * 8;
    const int rpw = (NTOK - row_lo + NGW - 1) / NGW;
    const int r0 = row_lo + gw * rpw; int r1 = r0 + rpw; if (r1 > NTOK) r1 = NTOK;
    NormVecs V; int curb = -2;
    for (int row = r0; row < r1; row += 2) {
        const bool two = row + 1 < r1;
        const int rowb = two ? row + 1 : row;
        f32x4 va[4], vb[4];
        norm_load_row(F, row < NCTX ? sctx + (size_t)row * DM : slat + (size_t)(row - NCTX) * DM, va);
        norm_load_row(F, rowb < NCTX ? sctx + (size_t)rowb * DM : slat + (size_t)(rowb - NCTX) * DM, vb);
        float sa = norm_ssq(va), sb = norm_ssq(vb);
#pragma unroll
        for (int o = 1; o < 64; o <<= 1) { sa += __shfl_xor(sa, o); sb += __shfl_xor(sb, o); }
        f32x4 y[4];
        { const int bk = row < NCTX ? -1 : (row - NCTX) / SEQ; if (bk != curb) { norm_load_vecs(F, g, bk < 0 ? modctx : modlat + (size_t)bk * 6144, isc, ish, V); curb = bk; } }
        if (out8) norm_finish8(F, va, sa, V, (unsigned char*)U + (size_t)row * DM, y); else norm_finish(F, va, sa, V, U + (size_t)row * DM, y);
        if (two) { const int bk = rowb < NCTX ? -1 : (rowb - NCTX) / SEQ; if (bk != curb) { norm_load_vecs(F, g, bk < 0 ? modctx : modlat + (size_t)bk * 6144, isc, ish, V); curb = bk; }
            if (out8) norm_finish8(F, vb, sb, V, (unsigned char*)U + (size_t)rowb * DM, y); else norm_finish(F, vb, sb, V, U + (size_t)rowb * DM, y); }
    }
}
DI void moe_route_row(Frame& F, const f32x4 (&y)[4], LAS const float* Rw, const float (&rb)[8], LAS int* sel, int tl, int tok) {
    float lg[8];
#pragma unroll
    for (int e = 0; e < 8; ++e) lg[e] = 0.f;
#pragma unroll
    for (int j = 0; j < 4; ++j)
#pragma unroll
        for (int q = 0; q < 4; ++q) { const int k = 256 * j + 4 * F.lane + q; const f32x4 r0 = *(const LAS f32x4*)(Rw + k * 8), r1 = *(const LAS f32x4*)(Rw + k * 8 + 4); const float yv = y[j][q];
            lg[0] += yv * r0[0]; lg[1] += yv * r0[1]; lg[2] += yv * r0[2]; lg[3] += yv * r0[3]; lg[4] += yv * r1[0]; lg[5] += yv * r1[1]; lg[6] += yv * r1[2]; lg[7] += yv * r1[3]; }
#pragma unroll
    for (int o = 1; o < 64; o <<= 1) {
#pragma unroll
        for (int e = 0; e < 8; ++e) lg[e] += __shfl_xor(lg[e], o); }
#pragma unroll
    for (int e = 0; e < 8; ++e) lg[e] += rb[e];
    int e1 = 0; float v1 = lg[0];
#pragma unroll
    for (int e = 1; e < 8; ++e) if (lg[e] > v1) { v1 = lg[e]; e1 = e; }
    int e2 = -1; float v2 = -3.0e38f;
#pragma unroll
    for (int e = 0; e < 8; ++e) if (e != e1 && lg[e] > v2) { v2 = lg[e]; e2 = e; }
    const float ex = __expf(v2 - v1), p1 = 1.0f / (1.0f + ex), p2 = ex / (1.0f + ex);
    if (F.lane == 0) { sel[tl * 2] = e1; sel[tl * 2 + 1] = e2; float* pt = (float*)(F.ws + WS_PTOK) + (size_t)tok * 2; pt[0] = p1; pt[1] = p2; }
}
DI void norm_moe_phase(Frame& F) {
    const int l = 1;
    const float* g = F.in[I_N2W] + l * DM;
    const float* modlat = (const float*)(F.ws + WS_MODLAT) + (size_t)l * 16 * 6144;
    bf16* U = (bf16*)(F.ws + WS_U);
    LAS float* Rw = (LAS float*)F.lds;
    LAS int* sel = (LAS int*)(F.lds + 32768);
    for (int idx = F.tid; idx < 8192; idx += 512) Rw[idx] = F.in[I_MR][idx];
    __syncthreads();
    float rb[8];
#pragma unroll
    for (int e = 0; e < 8; ++e) rb[e] = F.in[I_MRB][e];
    NormVecs V; int curb = -2;
    for (int seg = F.bid; seg < 256; seg += F.G) {
        const int bk = (seg * 128) / SEQ; if (bk != curb) { norm_load_vecs(F, g, modlat + (size_t)bk * 6144, 4, 3, V); curb = bk; }
        for (int i = 0; i < 16; i += 2) {
            const int tl = F.wave * 16 + i, tok = seg * 128 + tl;
            f32x4 va[4], vb[4];
            norm_load_row(F, F.out + (size_t)tok * DM, va); norm_load_row(F, F.out + (size_t)(tok + 1) * DM, vb);
            float sa = norm_ssq(va), sb = norm_ssq(vb);
#pragma unroll
            for (int o = 1; o < 64; o <<= 1) { sa += __shfl_xor(sa, o); sb += __shfl_xor(sb, o); }
            f32x4 y[4];
#if MOE_FP8
            norm_finish8(F, va, sa, V, (unsigned char*)U + (size_t)tok * DM, y); moe_route_row(F, y, Rw, rb, sel, tl, tok);
            norm_finish8(F, vb, sb, V, (unsigned char*)U + (size_t)(tok + 1) * DM, y); moe_route_row(F, y, Rw, rb, sel, tl + 1, tok + 1);
#else
            norm_finish(F, va, sa, V, U + (size_t)(NCTX + tok) * DM, y); moe_route_row(F, y, Rw, rb, sel, tl, tok);
            norm_finish(F, vb, sb, V, U + (size_t)(NCTX + tok + 1) * DM, y); moe_route_row(F, y, Rw, rb, sel, tl + 1, tok + 1);
#endif
        }
        __syncthreads();
        if (F.tid < 16) { const int s = F.tid >> 3, e = F.tid & 7; int cnt = 0; int* lst = (int*)(F.ws + WS_SEGLIST) + ((size_t)(seg * 2 + s) * 8 + e) * 128;
            for (int i = 0; i < 128; ++i) if (sel[i * 2 + s] == e) lst[cnt++] = seg * 128 + i;
            ((int*)(F.ws + WS_SEGCNT))[(seg * 2 + s) * 8 + e] = cnt; }
        __syncthreads();
    }
}
DI void moe_route_phase(Frame& F) {
    LAS int* cn = (LAS int*)F.lds;
    LAS int* offs = cn + 2048;
    LAS int* tb = offs + 256;
    for (int unit = F.bid; unit < 16; unit += F.G) {
        const int s = unit >> 3, e = unit & 7;
        const int* segcnt = (const int*)(F.ws + WS_SEGCNT);
        for (int idx = F.tid; idx < 2048; idx += 512) { const int ee = idx >> 8, gsg = idx & 255; cn[idx] = segcnt[(gsg * 2 + s) * 8 + ee]; }
        __syncthreads();
        if (F.tid < 8) { int tot = 0; for (int gsg = 0; gsg < 256; ++gsg) tot += cn[F.tid * 256 + gsg]; tb[16 + F.tid] = tot; }
        if (F.tid == 64) { int run = 0; for (int gsg = 0; gsg < 256; ++gsg) { offs[gsg] = run; run += cn[e * 256 + gsg]; } }
        __syncthreads();
        if (F.tid == 0) { int run = 0; for (int ee = 0; ee < 8; ++ee) { tb[ee] = run; run += (tb[16 + ee] + 255) / 256; } tb[8] = run; }
        __syncthreads();
        int* rowmap = (int*)(F.ws + WS_ROWMAP) + (size_t)s * MOE_ROWS;
        float* prow = (float*)(F.ws + WS_PROW) + (size_t)s * MOE_ROWS;
        const float* ptok = (const float*)(F.ws + WS_PTOK);
        const int base = tb[e] * 256, tot = tb[16 + e], ntile = (tot + 255) / 256;
        if (F.tid < 256) { const int gsg = F.tid; const int c = cn[e * 256 + gsg]; const int* lst = (const int*)(F.ws + WS_SEGLIST) + ((size_t)(gsg * 2 + s) * 8 + e) * 128;
            for (int i = 0; i < c; ++i) { const int tok = lst[i]; rowmap[base + offs[gsg] + i] = tok; prow[base + offs[gsg] + i] = ptok[(size_t)tok * 2 + s]; } }
        for (int i = tot + F.tid; i < ntile * 256; i += 512) { rowmap[base + i] = -1; prow[base + i] = 0.f; }
        if (e == 0) { int* meta = (int*)(F.ws + WS_META) + s * 256;
            if (F.tid == 0) meta[0] = tb[8];
            if (F.tid < 8) { const int t0 = tb[F.tid], t1 = tb[F.tid + 1]; for (int t = t0; t < t1; ++t) meta[1 + t] = F.tid; } }
        __syncthreads();
    }
}
DI void final_phase(Frame& F) {
    const float* g = F.in[I_FNW];
    f32x4 gv[4];
#pragma unroll
    for (int j = 0; j < 4; ++j) gv[j] = ((const f32x4*)g)[F.lane + 64 * j];
    const int gw = F.bid * 8 + F.wave, NGW = F.G * 8;
    const int rpw = (NLAT + NGW - 1) / NGW; const int r0 = gw * rpw; int r1 = r0 + rpw; if (r1 > NLAT) r1 = NLAT;
    for (int row = r0; row < r1; row += 2) {
        const bool two = row + 1 < r1; const int rowb = two ? row + 1 : row;
        f32x4 va[4], vb[4];
        norm_load_row(F, F.out + (size_t)row * DM, va); norm_load_row(F, F.out + (size_t)rowb * DM, vb);
        float sa = norm_ssq(va), sb = norm_ssq(vb);
#pragma unroll
        for (int o = 1; o < 64; o <<= 1) { sa += __shfl_xor(sa, o); sb += __shfl_xor(sb, o); }
        const float ra = 1.0f / sqrtf(sa * (1.0f / DM) + EPS), rbv = 1.0f / sqrtf(sb * (1.0f / DM) + EPS);
        f32x4* xa = (f32x4*)(F.out + (size_t)row * DM) + F.lane; f32x4* xb = (f32x4*)(F.out + (size_t)rowb * DM) + F.lane;
#pragma unroll
        for (int j = 0; j < 4; ++j) xa[64 * j] = (va[j] * ra) * gv[j];
        if (two) {
#pragma unroll
            for (int j = 0; j < 4; ++j) xb[64 * j] = (vb[j] * rbv) * gv[j]; }
    }
}

DI void conv_unit(Frame& F, int l, int row0, int t0, int slen) {
    const bf16* PX = (const bf16*)(F.ws + WS_P);
    bf16* YC = (bf16*)(F.ws + WS_U);
    LAS float* Y = (LAS float*)F.lds;
    { u32x4 av[6], gv[6];
#pragma unroll
      for (int k = 0; k < 6; ++k) { const int it = F.tid + 512 * k; const int rr = it >> 5, cc = it & 31; const int t = t0 - 15 + rr;
          av[k] = (u32x4){0u, 0u, 0u, 0u}; gv[k] = av[k];
          if (it < 94 * 32 && t >= 0 && t < slen) { const bf16* p = PX + (size_t)(row0 + t) * INW + C_CONV + 8 * cc; av[k] = *(const u32x4*)p; gv[k] = *(const u32x4*)(p + 256); } }
#pragma unroll
      for (int k = 0; k < 6; ++k) { const int it = F.tid + 512 * k; const int rr = it >> 5, cc = it & 31;
          if (it < 94 * 32) { f32x4 o0, o1;
              o0[0] = bflo(av[k].x) * sigmoidf_(bflo(gv[k].x)); o0[1] = bfhi(av[k].x) * sigmoidf_(bfhi(gv[k].x)); o0[2] = bflo(av[k].y) * sigmoidf_(bflo(gv[k].y)); o0[3] = bfhi(av[k].y) * sigmoidf_(bfhi(gv[k].y));
              o1[0] = bflo(av[k].z) * sigmoidf_(bflo(gv[k].z)); o1[1] = bfhi(av[k].z) * sigmoidf_(bfhi(gv[k].z)); o1[2] = bflo(av[k].w) * sigmoidf_(bflo(gv[k].w)); o1[3] = bfhi(av[k].w) * sigmoidf_(bfhi(gv[k].w));
              *(LAS f32x4*)(Y + rr * 256 + 8 * cc) = o0; *(LAS f32x4*)(Y + rr * 256 + 8 * cc + 4) = o1; } } }
    __syncthreads();
    const int c = F.tid & 255, half = F.tid >> 8;
    float w[31];
#pragma unroll
    for (int k = 0; k < 31; ++k) w[k] = F.in[I_CONVW][(size_t)l * 31 * 256 + k * 256 + c];
    float acc[32];
    const float cb = F.in[I_CONVB][l * 256 + c];
#pragma unroll
    for (int o = 0; o < 32; ++o) acc[o] = cb;
#pragma unroll
    for (int kk = 0; kk < 62; ++kk) { const float yv = Y[(32 * half + kk) * 256 + c];
#pragma unroll
        for (int o = 0; o < 32; ++o) { const int tap = kk - o; if (tap >= 0 && tap < 31) acc[o] += yv * w[tap]; } }
    __syncthreads();
#pragma unroll
    for (int o = 0; o < 32; ++o) Y[(32 * half + o) * 256 + c] = acc[o];
    __syncthreads();
    const f32x4 lw = ((const f32x4*)(F.in[I_CLNW] + l * 256))[F.lane], lb = ((const f32x4*)(F.in[I_CLNB] + l * 256))[F.lane];
    for (int i = 0; i < 8; ++i) { const int tl = F.wave * 8 + i; const f32x4 v = *(const LAS f32x4*)(Y + tl * 256 + 4 * F.lane);
        const float mu = wave_sum((v.x + v.y) + (v.z + v.w)) * (1.0f / 256.0f); const f32x4 d = v - mu;
        const float var = wave_sum((d.x * d.x + d.y * d.y) + (d.z * d.z + d.w * d.w)) * (1.0f / 256.0f); const float rstd = 1.0f / sqrtf(var + EPS);
        f32x4 z = d * rstd * lw + lb; z.x *= sigmoidf_(z.x); z.y *= sigmoidf_(z.y); z.z *= sigmoidf_(z.z); z.w *= sigmoidf_(z.w);
        u32x2 o; o.x = pk2(z.x, z.y); o.y = pk2(z.z, z.w);
        *(u32x2*)(YC + (size_t)(row0 + t0 + tl) * DM + 512 + 4 * F.lane) = o; }
    __syncthreads();
}
DI void ret_consts(Frame& F, int l, int hh, float& lg2f, float& lg2b) {
    const float df = F.in[I_RDEC][(l * 2 + 0) * 4 + hh], db = F.in[I_RDEC][(l * 2 + 1) * 4 + hh];
    lg2f = log2f(1.0f - exp2f(-df)); lg2b = log2f(1.0f - exp2f(-db));
}
constexpr int ROPE_LDS = AUX_OFF + 4096;
DI void rope_to_lds(Frame& F) { const float* tab = (const float*)(F.ws + WS_ROPE); LAS float* rt = (LAS float*)(F.lds + ROPE_LDS); for (int i = F.tid; i < 1024; i += 512) rt[i] = tab[i]; __syncthreads(); }
DI void unpack8(const u32x4& a, float (&x)[8]) { x[0] = bflo(a.x); x[1] = bfhi(a.x); x[2] = bflo(a.y); x[3] = bfhi(a.y); x[4] = bflo(a.z); x[5] = bfhi(a.z); x[6] = bflo(a.w); x[7] = bfhi(a.w); }
DI void rope_apply(Frame& F, const u32x4& a, const u32x4& b, int hp, bool lat, int tg, float (&x1)[8], float (&x2)[8]) {
    unpack8(a, x1); unpack8(b, x2);
    if (lat) { const int pos = hp == 0 ? (tg >> 6) : (tg & 63); LAS const f32x4* tab = (LAS const f32x4*)(F.lds + ROPE_LDS) + pos * 4;
#pragma unroll
        for (int jj = 0; jj < 4; ++jj) { const f32x4 cs = tab[jj];
            { const float a1 = x1[2 * jj], a2 = x2[2 * jj]; x1[2 * jj] = a1 * cs[0] - a2 * cs[1]; x2[2 * jj] = a2 * cs[0] + a1 * cs[1]; }
            { const float a1 = x1[2 * jj + 1], a2 = x2[2 * jj + 1]; x1[2 * jj + 1] = a1 * cs[2] - a2 * cs[3]; x2[2 * jj + 1] = a2 * cs[2] + a1 * cs[3]; } } }
}
DI void ret_unit_decode(int su, bool& isctx, int& b, int& hh, int& n) {
    isctx = su >= 1024; if (!isctx) { b = su >> 6; hh = (su >> 4) & 3; n = su & 15; } else { const int v = su - 1024; b = v >> 3; hh = (v >> 1) & 3; n = v & 1; }
}
DI void ret_summary_pair(Frame& F, int l, int it) {
    const bf16* PX = (const bf16*)(F.ws + WS_P);
    const int sub = F.wave >> 2, st = F.tid & 255, su = 2 * it + sub;
    bool isctx; int b, hh, n; ret_unit_decode(su, isctx, b, hh, n);
    const int row0 = isctx ? (b * CTXL + n * 128) : (NCTX + b * SEQ + n * 128);
    float lg2f, lg2b; ret_consts(F, l, hh, lg2f, lg2b);
    LAS unsigned char* base = F.lds + sub * 40960;
    LAS unsigned char* Vimg = base;
    LAS unsigned char* Kf = base + 18432;
    LAS unsigned char* Kb = base + 18432 + 10240;
    { const int tok = st >> 1, hp = st & 1; float x1[8], x2[8];
      const bf16* kp = PX + (size_t)(row0 + tok) * INW + C_RK + 32 * hh; const bf16* vp = PX + (size_t)(row0 + tok) * INW + C_RV + 64 * hh + 32 * hp;
      const u32x4 kra = *(const u32x4*)(kp + 8 * hp), krb = *(const u32x4*)(kp + 16 + 8 * hp);
      u32x4 vr[4];
#pragma unroll
      for (int q = 0; q < 4; ++q) vr[q] = *(const u32x4*)(vp + 8 * q);
      rope_apply(F, kra, krb, hp, !isctx, n * 128 + tok, x1, x2);
      const float ks = 0.17677669529663687f;
      const float wf = fast_exp2(lg2f * (float)(127 - tok)) * ks, wb = fast_exp2(lg2b * (float)tok) * ks;
      u32x4 o;
      o.x = pk2(x1[0] * wf, x1[1] * wf); o.y = pk2(x1[2] * wf, x1[3] * wf); o.z = pk2(x1[4] * wf, x1[5] * wf); o.w = pk2(x1[6] * wf, x1[7] * wf); *(LAS u32x4*)(Kf + tok * 80 + 16 * hp) = o;
      o.x = pk2(x2[0] * wf, x2[1] * wf); o.y = pk2(x2[2] * wf, x2[3] * wf); o.z = pk2(x2[4] * wf, x2[5] * wf); o.w = pk2(x2[6] * wf, x2[7] * wf); *(LAS u32x4*)(Kf + tok * 80 + 32 + 16 * hp) = o;
      o.x = pk2(x1[0] * wb, x1[1] * wb); o.y = pk2(x1[2] * wb, x1[3] * wb); o.z = pk2(x1[4] * wb, x1[5] * wb); o.w = pk2(x1[6] * wb, x1[7] * wb); *(LAS u32x4*)(Kb + tok * 80 + 16 * hp) = o;
      o.x = pk2(x2[0] * wb, x2[1] * wb); o.y = pk2(x2[2] * wb, x2[3] * wb); o.z = pk2(x2[4] * wb, x2[5] * wb); o.w = pk2(x2[6] * wb, x2[7] * wb); *(LAS u32x4*)(Kb + tok * 80 + 32 + 16 * hp) = o;
#pragma unroll
      for (int q = 0; q < 4; ++q) *(LAS u32x4*)(Vimg + tok * 144 + 64 * hp + 16 * q) = vr[q]; }
    __syncthreads();
    { const int role = F.wave & 3, dir = role >> 1, et = role & 1;
      const int l32 = F.lane & 31, h = F.lane >> 5, grp = (F.lane >> 4) & 1, i16 = F.lane & 15, q = i16 >> 2, p = i16 & 3;
      LAS unsigned char* Kimg = dir ? Kb : Kf;
      f32x16 acc;
#pragma unroll
      for (int i = 0; i < 16; ++i) acc[i] = 0.f;
#pragma unroll
      for (int s = 0; s < 8; ++s) { const int r0 = 16 * s + 8 * h + q;
          const s16x4 alo = trread(Vimg + r0 * 144 + (32 * et + 16 * grp + 4 * p) * 2), ahi = trread(Vimg + (r0 + 4) * 144 + (32 * et + 16 * grp + 4 * p) * 2);
          const s16x4 blo = trread(Kimg + r0 * 80 + (16 * grp + 4 * p) * 2), bhi = trread(Kimg + (r0 + 4) * 80 + (16 * grp + 4 * p) * 2);
          const bf16x8 a = __builtin_shufflevector(alo, ahi, 0, 1, 2, 3, 4, 5, 6, 7), bb = __builtin_shufflevector(blo, bhi, 0, 1, 2, 3, 4, 5, 6, 7);
          acc = MFMA32(a, bb, acc); }
      float* S = isctx ? (float*)(F.ws + WS_SUMCTX) + ((size_t)((b * 4 + hh) * 2 + n) * 2 + dir) * 2048 : (float*)(F.ws + WS_SUMLAT) + ((size_t)((b * 4 + hh) * 16 + n) * 2 + dir) * 2048;
#pragma unroll
      for (int i = 0; i < 16; ++i) S[(32 * et + crow(i, h)) * 32 + l32] = acc[i]; }
    __syncthreads();
}
DI void ca_phase(Frame& F, int l) {
    rope_to_lds(F);
    const int nconv = l == 0 ? 576 : 512;
    for (int u = F.vb; u < nconv; u += F.G) {
        int v = u; if (l != 0) v += 64;
        if (v < 64) conv_unit(F, l, (v >> 2) * CTXL, (v & 3) * 64, CTXL);
        else { v -= 64; conv_unit(F, l, NCTX + (v >> 5) * SEQ, (v & 31) * 64, SEQ); }
    }
    for (int it = F.vb; it < 576; it += F.G) ret_summary_pair(F, l, it);
}

constexpr int ATT_KV = 18432, ATT_BUF = 2 * ATT_KV, ATT_BT = 2 * ATT_BUF, ATT_NEG = 640;
struct AttRegs { u32x4 k0, v0, k1, v1; };
DI void attn_fetch(const bf16* PX, int rowA, int rowB, unsigned loff, AttRegs& R) {
    const char* pa = (const char*)(PX + (size_t)rowA * INW) + loff; const char* pb = (const char*)(PX + (size_t)rowB * INW) + loff;
    R.k0 = *(const u32x4*)(pa + C_NAK * 2); R.v0 = *(const u32x4*)(pa + C_NAV * 2); R.k1 = *(const u32x4*)(pb + C_NAK * 2); R.v1 = *(const u32x4*)(pb + C_NAV * 2);
}
DI void attn_put(Frame& F, LAS unsigned char* buf, const AttRegs& R) {
    const int key = F.tid >> 3, ch = F.tid & 7;
    *(LAS u32x4*)(buf + key * 144 + 16 * ch) = R.k0; *(LAS u32x4*)(buf + ATT_KV + key * 144 + 16 * ch) = R.v0;
    *(LAS u32x4*)(buf + (64 + key) * 144 + 16 * ch) = R.k1; *(LAS u32x4*)(buf + ATT_KV + (64 + key) * 144 + 16 * ch) = R.v1;
}
template <bool BIAS, int NT>
DI void attn_tiles(LAS const unsigned char* buf, const int (&koff)[2], const bf16x8 (&qf)[4], f32x16& o0, f32x16& o1, f32x16& o2, float& mrun, int lane,
                   LAS const float* const (&bt)[2]  , const float (&pen)[16]) {
    LAS const unsigned char* Kimg = buf; LAS const unsigned char* Vimg = buf + ATT_KV;
    const int l32 = lane & 31, h = lane >> 5, grp = (lane >> 4) & 1, i16 = lane & 15, q = i16 >> 2, p = i16 & 3;
    f32x16 s[NT];
#pragma unroll
    for (int t = 0; t < NT; ++t)
#pragma unroll
        for (int i = 0; i < 16; ++i) s[t][i] = 0.f;
#pragma unroll
    for (int si = 0; si < 4; ++si)
#pragma unroll
        for (int t = 0; t < NT; ++t) { const bf16x8 a = *(const LAS bf16x8*)(Kimg + (koff[t] + l32) * 144 + (16 * si + 8 * h) * 2); s[t] = MFMA32(a, qf[si], s[t]); }
    const float c = 0.125f * LOG2E;
    float v[NT][16]; float mx = -1.0e30f;
#pragma unroll
    for (int t = 0; t < NT; ++t)
#pragma unroll
        for (int i = 0; i < 16; ++i) { float x;
            if (BIAS) x = __builtin_fmaf(s[t][i], c, bt[t][(i & 3) + 8 * (i >> 2)]) + pen[i]; else x = s[t][i];
            v[t][i] = x; mx = fmaxf(mx, x); }
    if (!BIAS) mx *= c;
    mx = fmaxf(mx, __shfl_xor(mx, 32));
    const float mnew = fmaxf(mrun, mx);
    const float alpha = fast_exp2(mrun - mnew);
    if (__any(alpha != 1.0f)) {
#pragma unroll
        for (int i = 0; i < 16; ++i) { o0[i] *= alpha; o1[i] *= alpha; o2[i] *= alpha; } }
    mrun = mnew;
    bf16x8 pf[NT][2];
#pragma unroll
    for (int t = 0; t < NT; ++t) { float pp[16];
#pragma unroll
        for (int i = 0; i < 16; ++i) pp[i] = BIAS ? fast_exp2(v[t][i] - mnew) : fast_exp2(__builtin_fmaf(v[t][i], c, -mnew));
#pragma unroll
        for (int s2 = 0; s2 < 2; ++s2) { u32x4 w; w.x = pk2(pp[8 * s2], pp[8 * s2 + 1]); w.y = pk2(pp[8 * s2 + 2], pp[8 * s2 + 3]); w.z = pk2(pp[8 * s2 + 4], pp[8 * s2 + 5]); w.w = pk2(pp[8 * s2 + 6], pp[8 * s2 + 7]); pf[t][s2] = __builtin_bit_cast(bf16x8, w); } }
    const u32x4 onesw = (u32x4){0x3f803f80u, 0x3f803f80u, 0x3f803f80u, 0x3f803f80u}; const bf16x8 ones = __builtin_bit_cast(bf16x8, onesw);
#pragma unroll
    for (int t = 0; t < NT; ++t)
#pragma unroll
        for (int s2 = 0; s2 < 2; ++s2) { const int r0 = koff[t] + 16 * s2 + 4 * h + q;
#pragma unroll
            for (int et = 0; et < 2; ++et) { const int cb = (32 * et + 16 * grp + 4 * p) * 2;
                const s16x4 lo = trread(Vimg + r0 * 144 + cb), hi = trread(Vimg + (r0 + 8) * 144 + cb);
                const bf16x8 a = __builtin_shufflevector(lo, hi, 0, 1, 2, 3, 4, 5, 6, 7);
                if (et == 0) o0 = MFMA32(a, pf[t][s2], o0); else o1 = MFMA32(a, pf[t][s2], o1); }
            o2 = MFMA32(ones, pf[t][s2], o2); }
}
DI void attn_unit(Frame& F, int l, bool na, int b, int hh, int rg) {
    const bf16* PX = (const bf16*)(F.ws + WS_P);
    bf16* YC = (bf16*)(F.ws + WS_U);
    LAS float* btab = (LAS float*)(F.lds + ATT_BT);
    const int l32 = F.lane & 31, h = F.lane >> 5;
    int qrow, r = 0, qcol = 0, kc0 = 0, ra = 0;
    float pen[16];
#pragma unroll
    for (int i = 0; i < 16; ++i) pen[i] = 0.f;
    if (na) { const int rp = F.wave >> 2, n = F.wave & 3; ra = 4 * rg + 2 * rp; r = ra + (l32 >> 4); qcol = 16 * n + (l32 & 15); qrow = NCTX + b * SEQ + r * GW + qcol;
        int w0 = qcol - 8; w0 = w0 < 0 ? 0 : (w0 > 48 ? 48 : w0); kc0 = 16 * n - 8; kc0 = kc0 < 0 ? 0 : (kc0 > 32 ? 32 : kc0);
#pragma unroll
        for (int i = 0; i < 16; ++i) pen[i] = ((unsigned)(kc0 + crow(i, h) - w0) < 16u) ? 0.f : -1.0e30f; }
    else qrow = b * CTXL + 32 * F.wave + l32;
    bf16x8 qf[4];
#pragma unroll
    for (int si = 0; si < 4; ++si) qf[si] = *(const bf16x8*)(PX + (size_t)qrow * INW + C_NAQ + 64 * hh + 16 * si + 8 * h);
    if (na) { for (int idx = F.tid; idx < ATT_NEG + 128; idx += 512) { float v = 0.f; if (idx >= 48 && idx < 48 + 465) v = F.in[I_RPB][((size_t)l * 8 + hh) * 465 + (idx - 48)] * LOG2E; if (idx >= ATT_NEG) v = -1.0e30f; btab[idx] = v; } }
    f32x16 o0, o1, o2;
#pragma unroll
    for (int i = 0; i < 16; ++i) { o0[i] = 0.f; o1[i] = 0.f; o2[i] = 0.f; }
    float mrun = -1.0e30f;
    int ylo = 0, yhi = 0, nsteps = 2;
    if (na) { const int rlo = 4 * rg, rhi = 4 * rg + 3;
        ylo = rlo - 4; ylo = ylo < 0 ? 0 : (ylo > 24 ? 24 : ylo);
        yhi = rhi - 4; yhi = yhi < 0 ? 0 : (yhi > 24 ? 24 : yhi); yhi += 8; nsteps = 2 + (yhi - ylo + 1) / 2; }
    int sa = ra - 4; sa = sa < 0 ? 0 : (sa > 24 ? 24 : sa);
    int sb = ra + 1 - 4; sb = sb < 0 ? 0 : (sb > 24 ? 24 : sb);
    const int mylo = (l32 >> 4) ? sb : sa;
    const int cbase = kc0 + 4 * h - qcol + 15;
#define ATT_ROWA(sx) ((sx) < 2 ? b * CTXL + 128 * (sx) : NCTX + b * SEQ + (ylo + 2 * ((sx) - 2)) * GW)
#define ATT_ROWB(sx) ((sx) < 2 ? b * CTXL + 128 * (sx) + 64 : NCTX + b * SEQ + ((ylo + 2 * ((sx) - 2) + 1) < yhi ? (ylo + 2 * ((sx) - 2) + 1) : (yhi - 1)) * GW)
    AttRegs R;
    unsigned loff = (unsigned)(((F.tid >> 3) * INW + 64 * hh + 8 * (F.tid & 7)) * 2); asm volatile("" : "+v"(loff));
    attn_fetch(PX, ATT_ROWA(0), ATT_ROWB(0), loff, R);
    for (int st = 0; st < nsteps; ++st) {
        LAS unsigned char* buf = F.lds + (st & 1) * ATT_BUF;
        attn_put(F, buf, R);
        if (st + 1 < nsteps) attn_fetch(PX, ATT_ROWA(st + 1), ATT_ROWB(st + 1), loff, R);
        __syncthreads();
        if (st < 2) {
            LAS const float* const bt[2] = {btab, btab};
            { const int ko[2] = {0, 32}; attn_tiles<false, 2>(buf, ko, qf, o0, o1, o2, mrun, F.lane, bt, pen); }
            { const int ko[2] = {64, 96}; attn_tiles<false, 2>(buf, ko, qf, o0, o1, o2, mrun, F.lane, bt, pen); }
        } else {
            const int y0 = ylo + 2 * (st - 2), y1 = y0 + 1;
            const bool act0 = (y0 >= sa && y0 < sb + 8), act1 = (y1 < yhi && y1 >= sa && y1 < sb + 8);
            const bool ok0 = (unsigned)(y0 - mylo) < 8u, ok1 = (unsigned)(y1 - mylo) < 8u;
            LAS const float* b0 = btab + (ok0 ? 48 + (y0 - r + 7) * 31 + cbase : ATT_NEG);
            LAS const float* b1 = btab + (ok1 ? 48 + (y1 - r + 7) * 31 + cbase : ATT_NEG);
            if (act0 && act1) { const int ko[2] = {kc0, 64 + kc0}; LAS const float* const bt[2] = {b0, b1}; attn_tiles<true, 2>(buf, ko, qf, o0, o1, o2, mrun, F.lane, bt, pen); }
            else if (act0) { const int ko[2] = {kc0, kc0}; LAS const float* const bt[2] = {b0, b0}; attn_tiles<true, 1>(buf, ko, qf, o0, o1, o2, mrun, F.lane, bt, pen); }
            else if (act1) { const int ko[2] = {64 + kc0, 64 + kc0}; LAS const float* const bt[2] = {b1, b1}; attn_tiles<true, 1>(buf, ko, qf, o0, o1, o2, mrun, F.lane, bt, pen); }
        }
    }
#undef ATT_ROWA
#undef ATT_ROWB
    const float inv = 1.0f / o2[0];
    bf16* orow = YC + (size_t)qrow * DM + 64 * hh;
#pragma unroll
    for (int gq = 0; gq < 4; ++gq) { u32x2 w;
        w.x = pk2(o0[4 * gq] * inv, o0[4 * gq + 1] * inv); w.y = pk2(o0[4 * gq + 2] * inv, o0[4 * gq + 3] * inv); *(u32x2*)(orow + 8 * gq + 4 * h) = w;
        w.x = pk2(o1[4 * gq] * inv, o1[4 * gq + 1] * inv); w.y = pk2(o1[4 * gq + 2] * inv, o1[4 * gq + 3] * inv); *(u32x2*)(orow + 32 + 8 * gq + 4 * h) = w; }
    __syncthreads();
}
DI void ret_out_unit(Frame& F, int l, int su) {
    const bf16* PX = (const bf16*)(F.ws + WS_P);
    bf16* YC = (bf16*)(F.ws + WS_U);
    bool isctx; int b, hh, n; ret_unit_decode(su, isctx, b, hh, n);
    const int row0 = isctx ? (b * CTXL + n * 128) : (NCTX + b * SEQ + n * 128);
    float lg2f, lg2b; ret_consts(F, l, hh, lg2f, lg2b);
    LAS unsigned char* Kimg = F.lds;
    LAS unsigned char* Vimg = F.lds + 10240;
    LAS unsigned char* Stf = F.lds + 28672;
    LAS unsigned char* Stb = F.lds + 33792;
    LAS float* Ob = (LAS float*)(F.lds + 38912);
    const int dir = F.wave >> 2, qb = F.wave & 3, l32 = F.lane & 31, h = F.lane >> 5, grp = (F.lane >> 4) & 1, i16 = F.lane & 15, q = i16 >> 2, p = i16 & 3;
    const int iq = 32 * qb + l32;
    const int ktok = (F.tid & 255) >> 1, khp = F.tid & 1;
    const bf16* kp = PX + (size_t)(row0 + ktok) * INW + C_RK + 32 * hh;
    const u32x4 kra = *(const u32x4*)(kp + 8 * khp), krb = *(const u32x4*)(kp + 16 + 8 * khp);
    const int vtok = F.tid >> 2, vch = F.tid & 3; const bf16* vp = PX + (size_t)(row0 + vtok) * INW + C_RV + 64 * hh + 16 * vch;
    const u32x4 vra = *(const u32x4*)vp, vrb = *(const u32x4*)(vp + 8);
    const bf16* qp = PX + (size_t)(row0 + iq) * INW + C_RQ + 32 * hh;
    const u32x4 qra = *(const u32x4*)(qp + 8 * h), qrb = *(const u32x4*)(qp + 16 + 8 * h);
    const bf16* gp = PX + (size_t)(row0 + iq) * INW + (dir ? C_GB : C_GF) + 64 * hh;
    u32x2 gg[8];
#pragma unroll
    for (int et = 0; et < 2; ++et)
#pragma unroll
        for (int gq = 0; gq < 4; ++gq) gg[et * 4 + gq] = *(const u32x2*)(gp + 32 * et + 8 * gq + 4 * h);
    const float cf = fast_exp2(lg2f * 128.0f), cb = fast_exp2(lg2b * 128.0f);
    const float* SC = (const float*)(F.ws + WS_SUMCTX) + (size_t)((b * 4 + hh) * 2) * 2 * 2048;
    const float* SL = (const float*)(F.ws + WS_SUMLAT) + (size_t)((b * 4 + hh) * 16) * 2 * 2048;
    f32x4 sf = (f32x4){0.f, 0.f, 0.f, 0.f}, sb = sf; const int eo = 4 * F.tid;
    if (!isctx) {
        f32x4 t[16];
#pragma unroll
        for (int m = 0; m < 16; ++m) t[m] = *(const f32x4*)(SL + (size_t)(m * 2 + (m <= n ? 0 : 1)) * 2048 + eo);
        const f32x4 c00 = *(const f32x4*)(SC + (0 * 2 + 0) * 2048 + eo), c10 = *(const f32x4*)(SC + (1 * 2 + 0) * 2048 + eo);
        const f32x4 c11 = *(const f32x4*)(SC + (1 * 2 + 1) * 2048 + eo), c01 = *(const f32x4*)(SC + (0 * 2 + 1) * 2048 + eo);
        sf = c00 * cf + c10;
#pragma unroll
        for (int m = 0; m < 16; ++m) { const f32x4 nv = sf * cf + t[m]; sf = (m < n) ? nv : sf; }
        sb = c11 * cb + c01;
#pragma unroll
        for (int m = 15; m >= 0; --m) { const f32x4 nv = sb * cb + t[m]; sb = (m > n) ? nv : sb; }
    } else {
        if (n == 1) sf = *(const f32x4*)(SC + (0 * 2 + 0) * 2048 + eo);
        if (n == 0) sb = *(const f32x4*)(SC + (1 * 2 + 1) * 2048 + eo);
    }
    if (F.tid < 256) { float x1[8], x2[8]; rope_apply(F, kra, krb, khp, !isctx, n * 128 + ktok, x1, x2);
        const float ks = 0.17677669529663687f; u32x4 o;
        o.x = pk2(x1[0] * ks, x1[1] * ks); o.y = pk2(x1[2] * ks, x1[3] * ks); o.z = pk2(x1[4] * ks, x1[5] * ks); o.w = pk2(x1[6] * ks, x1[7] * ks); *(LAS u32x4*)(Kimg + ktok * 80 + 16 * khp) = o;
        o.x = pk2(x2[0] * ks, x2[1] * ks); o.y = pk2(x2[2] * ks, x2[3] * ks); o.z = pk2(x2[4] * ks, x2[5] * ks); o.w = pk2(x2[6] * ks, x2[7] * ks); *(LAS u32x4*)(Kimg + ktok * 80 + 32 + 16 * khp) = o; }
    *(LAS u32x4*)(Vimg + vtok * 144 + 32 * vch) = vra; *(LAS u32x4*)(Vimg + vtok * 144 + 32 * vch + 16) = vrb;
    { const int e = eo >> 5, d = eo & 31; u32x2 w;
      w.x = pk2(sf[0], sf[1]); w.y = pk2(sf[2], sf[3]); *(LAS u32x2*)(Stf + e * 80 + d * 2) = w;
      w.x = pk2(sb[0], sb[1]); w.y = pk2(sb[2], sb[3]); *(LAS u32x2*)(Stb + e * 80 + d * 2) = w; }
    bf16x8 qf[2], qd[2];
    { float x1[8], x2[8]; rope_apply(F, qra, qrb, h, !isctx, n * 128 + iq, x1, x2);
      const float dec = dir == 0 ? fast_exp2(lg2f * (float)(iq + 1)) : fast_exp2(lg2b * (float)(128 - iq));
      u32x4 w;
      w.x = pk2(x1[0], x1[1]); w.y = pk2(x1[2], x1[3]); w.z = pk2(x1[4], x1[5]); w.w = pk2(x1[6], x1[7]); qf[0] = __builtin_bit_cast(bf16x8, w);
      w.x = pk2(x2[0], x2[1]); w.y = pk2(x2[2], x2[3]); w.z = pk2(x2[4], x2[5]); w.w = pk2(x2[6], x2[7]); qf[1] = __builtin_bit_cast(bf16x8, w);
      w.x = pk2(x1[0] * dec, x1[1] * dec); w.y = pk2(x1[2] * dec, x1[3] * dec); w.z = pk2(x1[4] * dec, x1[5] * dec); w.w = pk2(x1[6] * dec, x1[7] * dec); qd[0] = __builtin_bit_cast(bf16x8, w);
      w.x = pk2(x2[0] * dec, x2[1] * dec); w.y = pk2(x2[2] * dec, x2[3] * dec); w.z = pk2(x2[4] * dec, x2[5] * dec); w.w = pk2(x2[6] * dec, x2[7] * dec); qd[1] = __builtin_bit_cast(bf16x8, w); }
    __syncthreads();
    f32x16 o0, o1;
#pragma unroll
    for (int i = 0; i < 16; ++i) { o0[i] = 0.f; o1[i] = 0.f; }
    { LAS const unsigned char* St = dir ? Stb : Stf;
#pragma unroll
      for (int s = 0; s < 2; ++s) { const bf16x8 a0 = *(const LAS bf16x8*)(St + l32 * 80 + (16 * s + 8 * h) * 2), a1 = *(const LAS bf16x8*)(St + (32 + l32) * 80 + (16 * s + 8 * h) * 2);
          o0 = MFMA32(a0, qd[s], o0); o1 = MFMA32(a1, qd[s], o1); } }
    const float lgd = dir ? lg2b : lg2f;
    const int kt_lo = dir ? qb : 0, kt_hi = dir ? 3 : qb;
    for (int kt = kt_lo; kt <= kt_hi; ++kt) {
        f32x16 s;
#pragma unroll
        for (int i = 0; i < 16; ++i) s[i] = 0.f;
#pragma unroll
        for (int si = 0; si < 2; ++si) { const bf16x8 a = *(const LAS bf16x8*)(Kimg + (32 * kt + l32) * 80 + (16 * si + 8 * h) * 2); s = MFMA32(a, qf[si], s); }
        float pp[16];
#pragma unroll
        for (int i = 0; i < 16; ++i) { const int j = 32 * kt + crow(i, h); const int diff = dir ? (j - iq) : (iq - j); pp[i] = diff >= 0 ? s[i] * fast_exp2(lgd * (float)diff) : 0.f; }
        bf16x8 pf[2];
#pragma unroll
        for (int s2 = 0; s2 < 2; ++s2) { u32x4 w; w.x = pk2(pp[8 * s2], pp[8 * s2 + 1]); w.y = pk2(pp[8 * s2 + 2], pp[8 * s2 + 3]); w.z = pk2(pp[8 * s2 + 4], pp[8 * s2 + 5]); w.w = pk2(pp[8 * s2 + 6], pp[8 * s2 + 7]); pf[s2] = __builtin_bit_cast(bf16x8, w); }
#pragma unroll
        for (int s2 = 0; s2 < 2; ++s2) { const int r0 = 32 * kt + 16 * s2 + 4 * h + q;
#pragma unroll
            for (int et = 0; et < 2; ++et) { const int cb = (32 * et + 16 * grp + 4 * p) * 2;
                const s16x4 lo = trread(Vimg + r0 * 144 + cb), hi = trread(Vimg + (r0 + 8) * 144 + cb);
                const bf16x8 a = __builtin_shufflevector(lo, hi, 0, 1, 2, 3, 4, 5, 6, 7);
                if (et == 0) o0 = MFMA32(a, pf[s2], o0); else o1 = MFMA32(a, pf[s2], o1); } }
    }
    float sm = 0.f;
#pragma unroll
    for (int i = 0; i < 16; ++i) sm += o0[i] + o1[i];
    sm += __shfl_xor(sm, 32);
    const float mu = sm * (1.0f / 64.0f);
    float vs = 0.f;
#pragma unroll
    for (int i = 0; i < 16; ++i) { const float d0 = o0[i] - mu, d1 = o1[i] - mu; vs += d0 * d0 + d1 * d1; }
    vs += __shfl_xor(vs, 32);
    const float rstd = 1.0f / sqrtf(vs * (1.0f / 64.0f) + EPS);
    const float* gn = F.in[I_RGNW] + l * 256 + 64 * hh;
    float val[32];
#pragma unroll
    for (int et = 0; et < 2; ++et)
#pragma unroll
        for (int gq = 0; gq < 4; ++gq) { const int e0 = 32 * et + 8 * gq + 4 * h; const u32x2 ggv = gg[et * 4 + gq]; const f32x4 gw = *(const f32x4*)(gn + e0);
            const float g0 = bflo(ggv.x), g1 = bfhi(ggv.x), g2 = bflo(ggv.y), g3 = bfhi(ggv.y);
            const float a0 = et ? o1[4 * gq] : o0[4 * gq], a1 = et ? o1[4 * gq + 1] : o0[4 * gq + 1], a2 = et ? o1[4 * gq + 2] : o0[4 * gq + 2], a3 = et ? o1[4 * gq + 3] : o0[4 * gq + 3];
            val[et * 16 + 4 * gq] = (a0 - mu) * rstd * gw[0] * g0 * sigmoidf_(g0); val[et * 16 + 4 * gq + 1] = (a1 - mu) * rstd * gw[1] * g1 * sigmoidf_(g1);
            val[et * 16 + 4 * gq + 2] = (a2 - mu) * rstd * gw[2] * g2 * sigmoidf_(g2); val[et * 16 + 4 * gq + 3] = (a3 - mu) * rstd * gw[3] * g3 * sigmoidf_(g3); }
    if (dir == 0) {
#pragma unroll
        for (int et = 0; et < 2; ++et)
#pragma unroll
            for (int gq = 0; gq < 4; ++gq)
#pragma unroll
                for (int j = 0; j < 4; ++j) Ob[iq * 65 + 32 * et + 8 * gq + 4 * h + j] = val[et * 16 + 4 * gq + j];
    }
    __syncthreads();
    if (dir == 1) { bf16* orow = YC + (size_t)(row0 + iq) * DM + 768 + 64 * hh;
#pragma unroll
        for (int et = 0; et < 2; ++et)
#pragma unroll
            for (int gq = 0; gq < 4; ++gq) { const int e0 = 32 * et + 8 * gq + 4 * h; float t[4];
#pragma unroll
                for (int j = 0; j < 4; ++j) t[j] = val[et * 16 + 4 * gq + j] + Ob[iq * 65 + e0 + j];
                u32x2 w; w.x = pk2(t[0], t[1]); w.y = pk2(t[2], t[3]); *(u32x2*)(orow + e0) = w; } }
    __syncthreads();
}
#ifndef PROBE_SUB
#define PROBE_SUB 0
#endif
DI void cb_phase(Frame& F, int l) {
    rope_to_lds(F);
    const int nattn = l == 0 ? 1152 : 1024;
    for (int rep = 0; rep < ((PROBE_SUB & 1) ? 2 : 1); ++rep)
    for (int u = F.vb; u < nattn; u += F.G) {
        if (u < 1024) attn_unit(F, l, true, u >> 6, (u >> 3) & 7, u & 7);
        else { const int v = u - 1024; attn_unit(F, l, false, v >> 3, v & 7, 0); }
    }
    const int nret = l == 0 ? 1152 : 1024;
    for (int rep = 0; rep < ((PROBE_SUB & 2) ? 2 : 1); ++rep)
    for (int u = F.vb; u < nret; u += F.G) ret_out_unit(F, l, u);
}

static_assert(sizeof(Params) == 240, "kernarg layout: in[26] at 0, out at 208, ws at 216, ph_lo at 224, ph_hi at 228");
__global__ void __launch_bounds__(512, 2) fwd_kernel(Params prm) {
    extern __shared__ __attribute__((aligned(16))) unsigned char lds_raw[];
    Frame F;
    F.lds = (LAS unsigned char*)lds_raw;
    F.tid = threadIdx.x; F.lane = F.tid & 63; F.wave = __builtin_amdgcn_readfirstlane(F.tid >> 6);
    F.G = gridDim.x; F.bid = blockIdx.x; F.vb = F.bid;
    F.in.ka = (karg_t)__builtin_amdgcn_kernarg_segment_ptr(); F.out = prm.out; F.ws = prm.ws;
    volatile LAS unsigned* MISC = (volatile LAS unsigned*)(F.lds + AUX_OFF);
    if (F.tid < 64) MISC[F.tid] = 0u;
    __syncthreads();
    XcdBarrier bar; bar.bar = (unsigned*)(prm.ws + WS_CTL) + 1024; bar.x = 0; bar.st = nullptr;
    const int lo = prm.ph_lo, hi = prm.ph_hi;
    if (hi - lo > 1) bar = xcd_barrier_post((unsigned*)(prm.ws + WS_CTL) + 1024, MISC + 8);
#ifdef ONLY_PHASE
#define IN(k) ((k) == ONLY_PHASE && lo <= (k) && (k) < hi)
#else
#define IN(k) (lo <= (k) && (k) < hi)
#endif
#ifndef PROBE_MASK
#define PROBE_MASK 0u
#endif
#define NREP(k) (((PROBE_MASK >> (k)) & 1u) ? 2 : 1)
#define SEAM(k) do { if (IN(k) && IN((k) + 1)) { XcdBarrier bb_ = bar; asm volatile("" : "+s"(bb_.bar)); xcd_barrier(bb_); } } while (0)
#define GLDS(P) ((LAS unsigned char*)(P).lds)
#define WSB(P, off) ((const pg8::bf16_t*)((P).ws + (off)))

    if (IN(0)) for (int rep_ = 0; rep_ < NREP(0); ++rep_) { if (rep_) __syncthreads(); Frame P = phase_frame(F); p0_prologue(P); } SEAM(0);
#pragma unroll 1
    for (int l = 0; l < 2; ++l) {
        const int pb = l == 0 ? 1 : 9;
        if (IN(pb + 0)) for (int rep_ = 0; rep_ < NREP(pb + 0); ++rep_) { if (rep_) __syncthreads(); Frame P = phase_frame(F); norm_phase(P, l, 1, l == 0, 0); } SEAM(pb + 0);
        if (IN(pb + 1)) for (int rep_ = 0; rep_ < NREP(pb + 1); ++rep_) { if (rep_) __syncthreads();
            Frame P = phase_frame(F);
            pg8::StaticOrder S; S.init(NTOK, INW, P.G, P.bid);
            pg8::EpiStoreBf16 E{(pg8::bf16_t*)(P.ws + WS_P), INW};
            pg8::gemm_phase<pg8::EpiStoreBf16, pg8::StaticOrder, pg8::RowsLinear, true>(GLDS(P), P.tid, WSB(P, WS_U), WSB(P, WS_WIN) + (size_t)l * INW * DM, 2 * DM, S, E, pg8::RowsLinear{});
            if (l == 0) bg_convert_tail(P, S.nwg, BG_B0, BG_D0); else bg_convert_tail(P, S.nwg, BG_B1, BG_CL);
        } SEAM(pb + 1);
        if (IN(pb + 2)) for (int rep_ = 0; rep_ < NREP(pb + 2); ++rep_) { if (rep_) __syncthreads(); Frame P = phase_frame(F); if (l == 1) { bg_convert_all(P, BG_CL, BG_ITEMS); __syncthreads(); } ca_phase(P, l); } SEAM(pb + 2);
        if (IN(pb + 3)) for (int rep_ = 0; rep_ < NREP(pb + 3); ++rep_) { if (rep_) __syncthreads(); Frame P = phase_frame(F); cb_phase(P, l); } SEAM(pb + 3);
        if (IN(pb + 4)) {
            Frame P = phase_frame(F);
            const int rb = l == 0 ? 0 : NCTX;
            const float* modlat = (const float*)(P.ws + WS_MODLAT) + (size_t)l * 16 * 6144;
            const float* modctx = (const float*)(P.ws + WS_MODCTX) + (size_t)l * 6144;
            float* hctx = (float*)(P.ws + WS_HCTX);
            pg8::StaticOrder S; S.init(NTOK - rb, DM, P.G, P.bid);
            pg8::EpiResGate E{l == 0 ? P.in[I_CTX] : hctx, l == 0 ? P.in[I_X] : P.out, hctx, P.out, modlat + 2 * DM, modctx + 2 * DM, rb};
            pg8::gemm_phase<pg8::EpiResGate, pg8::StaticOrder, pg8::RowsLinear, true>(GLDS(P), P.tid, WSB(P, WS_U) + (size_t)rb * DM, WSB(P, WS_WOUT) + (size_t)l * DM * DM, 2 * DM, S, E, pg8::RowsLinear{});
            if (l == 0) bg_convert_tail(P, S.nwg, BG_D0, BG_E0);
        } SEAM(pb + 4);
        if (l == 0) {
            if (IN(6)) for (int rep_ = 0; rep_ < NREP(6); ++rep_) { if (rep_) __syncthreads(); Frame P = phase_frame(F); norm_phase(P, 0, 2, false, 0, DENSE_FP8 == 1); } SEAM(6);
            if (IN(7)) for (int rep_ = 0; rep_ < NREP(7); ++rep_) { if (rep_) __syncthreads();
                Frame P = phase_frame(F);
                pg8::StaticOrder S; S.init(NTOK, 2 * DFF, P.G, P.bid);
                pg8::EpiSwiglu<false> E{(pg8::bf16_t*)(P.ws + WS_P), DFF, 0, nullptr};
#if DENSE_FP8 == 1
                pg8::gemm_phase<pg8::EpiSwiglu<false>, pg8::StaticOrder, pg8::RowsLinearOff, true, true>(GLDS(P), P.tid, WSB(P, WS_U), WSB(P, WS_WGU), DM, S, E, pg8::RowsLinearOff{}, SCL_U, SCL_WGU);
#else
                pg8::gemm_phase<pg8::EpiSwiglu<false>, pg8::StaticOrder, pg8::RowsLinear, true>(GLDS(P), P.tid, WSB(P, WS_U), WSB(P, WS_WGU), 2 * DM, S, E, pg8::RowsLinear{});
#endif
                bg_convert_tail(P, S.nwg, BG_E0, BG_F0);
            } SEAM(7);
            if (IN(8)) {
                Frame P = phase_frame(F);
                const float* modlat = (const float*)(P.ws + WS_MODLAT);
                const float* modctx = (const float*)(P.ws + WS_MODCTX);
                float* hctx = (float*)(P.ws + WS_HCTX);
                pg8::StaticOrder S; S.init(NTOK, DM, P.G, P.bid);
                pg8::EpiResGate E{hctx, P.out, hctx, P.out, modlat + 5 * DM, modctx + 5 * DM, 0};
#if DENSE_FP8
                pg8::gemm_phase<pg8::EpiResGate, pg8::StaticOrder, pg8::RowsLinearOff, true, true>(GLDS(P), P.tid, WSB(P, WS_P), WSB(P, WS_WD), DFF, S, E, pg8::RowsLinearOff{}, SCL_H, SCL_WD);
#else
                pg8::gemm_phase<pg8::EpiResGate, pg8::StaticOrder, pg8::RowsLinear, true>(GLDS(P), P.tid, WSB(P, WS_P), WSB(P, WS_WD), 2 * DFF, S, E, pg8::RowsLinear{});
#endif
                bg_convert_tail(P, S.nwg, BG_F0, BG_B1);
            } SEAM(8);
        } else {
            if (IN(14)) for (int rep_ = 0; rep_ < NREP(14); ++rep_) { if (rep_) __syncthreads(); Frame P = phase_frame(F); norm_moe_phase(P); } SEAM(14);
            if (IN(15)) for (int rep_ = 0; rep_ < NREP(15); ++rep_) { if (rep_) __syncthreads(); Frame P = phase_frame(F); moe_route_phase(P); } SEAM(15);
#pragma unroll 1
            for (int s = 0; s < 2; ++s) {
                LAS int* texp = (LAS int*)(F.lds + AUX_TAB);
                if (IN(16 + 2 * s) || IN(17 + 2 * s)) {
                    Frame P = phase_frame(F);
                    const int* meta = (const int*)(P.ws + WS_META) + s * 256;
                    __syncthreads();
                    if (P.tid < 256) texp[P.tid] = ld_i32_coherent(meta + P.tid);
                    __syncthreads();
                }
                if (IN(16 + 2 * s)) for (int rep_ = 0; rep_ < NREP(16 + 2 * s); ++rep_) { if (rep_) __syncthreads();
                    Frame P = phase_frame(F);
                    const int* rowmap = (const int*)(P.ws + WS_ROWMAP) + (size_t)s * MOE_ROWS;
                    const int NT = __builtin_amdgcn_readfirstlane(texp[0]);
                    pg8::MoeOrder S{NT, 28, P.G, P.bid, (const LAS int*)(texp + 1)};
                    pg8::EpiSwiglu<true> E{(pg8::bf16_t*)(P.ws + WS_P), DFE, 28, (const float*)(P.ws + WS_PROW) + (size_t)s * MOE_ROWS};
#if MOE_FP8
                    pg8::gemm_phase<pg8::EpiSwiglu<true>, pg8::MoeOrder, pg8::RowsGather, true, true>(GLDS(P), P.tid, WSB(P, WS_U), WSB(P, WS_MGU), DM, S, E, pg8::RowsGather{rowmap, 0}, SCL_U, SCL_WGU);
#else
                    pg8::gemm_phase<pg8::EpiSwiglu<true>, pg8::MoeOrder, pg8::RowsGather, true>(GLDS(P), P.tid, WSB(P, WS_U), WSB(P, WS_MGU), 2 * DM, S, E, pg8::RowsGather{rowmap, NCTX});
#endif
                } SEAM(16 + 2 * s);
                if (IN(17 + 2 * s)) {
                    Frame P = phase_frame(F);
                    const int* rowmap = (const int*)(P.ws + WS_ROWMAP) + (size_t)s * MOE_ROWS;
                    const float* modlat = (const float*)(P.ws + WS_MODLAT) + (size_t)16 * 6144;
                    const int NT = __builtin_amdgcn_readfirstlane(texp[0]);
                    pg8::MoeOrder S{NT, 4, P.G, P.bid, (const LAS int*)(texp + 1)};
                    pg8::EpiMoeScatter E{rowmap, P.out, modlat + 5 * DM, 4};
#if MOE_FP8
                    pg8::gemm_phase<pg8::EpiMoeScatter, pg8::MoeOrder, pg8::RowsLinearOff, true, true>(GLDS(P), P.tid, WSB(P, WS_P), WSB(P, WS_MD), DFE, S, E, pg8::RowsLinearOff{}, SCL_H, SCL_WD);
#else
                    pg8::gemm_phase<pg8::EpiMoeScatter, pg8::MoeOrder, pg8::RowsLinear, true>(GLDS(P), P.tid, WSB(P, WS_P), WSB(P, WS_MD), 2 * DFE, S, E, pg8::RowsLinear{});
#endif
                } SEAM(17 + 2 * s);
            }
        }
    }
    if (IN(PH_FINAL)) { Frame P = phase_frame(F); final_phase(P); }
#undef IN
#undef SEAM
}

extern "C" void kernel_launch(void* const* d_in, const int* in_sizes, int n_in, void* d_out, int out_size, void* d_ws, size_t ws_size, hipStream_t stream) {
    static int grid = 0;
    if (grid == 0) {
        if (n_in != 26 || in_sizes[0] != NLAT * DM || out_size != NLAT * DM || ws_size < WS_END) {
            fprintf(stderr, "kernel_launch: unexpected shapes (n_in %d, in0 %d, out %d, ws %zu, need %zu); nothing launched\n", n_in, n_in > 0 ? in_sizes[0] : -1, out_size, ws_size, (size_t)WS_END); grid = -1; return; }
        int dev = 0, cus = 0, per_cu = 0;
        if (hipGetDevice(&dev) != hipSuccess || hipDeviceGetAttribute(&cus, hipDeviceAttributeMultiprocessorCount, dev) != hipSuccess) { grid = -1; return; }
        if (hipFuncSetAttribute((const void*)fwd_kernel, hipFuncAttributeMaxDynamicSharedMemorySize, LDS_BYTES) != hipSuccess) { fprintf(stderr, "kernel_launch: hipFuncSetAttribute failed\n"); grid = -1; return; }
        if (hipOccupancyMaxActiveBlocksPerMultiprocessor(&per_cu, (const void*)fwd_kernel, 512, LDS_BYTES) != hipSuccess || per_cu < 1)
            fprintf(stderr, "kernel_launch: note: occupancy query reports %d workgroups per CU\n", per_cu);
        (void)hipGetLastError();
        grid = cus;
    }
    if (grid < 0) return;
    if (hipMemsetAsync((char*)d_ws + WS_CTL, 0, CTL_ZERO_BYTES, stream) != hipSuccess) return;
    Params p{};
    for (int i = 0; i < 26; ++i) p.in[i] = (const float*)d_in[i];
    p.out = (float*)d_out; p.ws = (unsigned char*)d_ws;
#if MK_PER_PHASE
    for (int ph = 0; ph < N_PHASES; ++ph) { p.ph_lo = ph; p.ph_hi = ph + 1; hipLaunchKernelGGL(fwd_kernel, dim3(grid), dim3(512), LDS_BYTES, stream, p); }
#else
    p.ph_lo = 0; p.ph_hi = N_PHASES;
    hipLaunchKernelGGL(fwd_kernel, dim3(grid), dim3(512), LDS_BYTES, stream, p);
#endif
}
```

```cpp
#include <hip/hip_runtime.h>
#include <cstdio>
#include <cstdint>

#ifndef MK_PER_PHASE
#define MK_PER_PHASE 0
#endif

#define LAS __attribute__((address_space(3)))
#define GAS __attribute__((address_space(1)))
#define DI __device__ __forceinline__
typedef unsigned short bf16;
typedef short bf16x8 __attribute__((ext_vector_type(8)));
typedef short s16x4 __attribute__((ext_vector_type(4)));
typedef float f32x4 __attribute__((ext_vector_type(4)));
typedef float f32x16 __attribute__((ext_vector_type(16)));
typedef unsigned u32x4 __attribute__((ext_vector_type(4)));
typedef unsigned u32x2 __attribute__((ext_vector_type(2)));
typedef float f32x2_t __attribute__((ext_vector_type(2)));
typedef __bf16 bf16x2_t __attribute__((ext_vector_type(2)));
typedef short v4i16_t __attribute__((ext_vector_type(4)));

constexpr int DM = 1024, NB = 16, SEQ = 2048, CTXL = 256, GW = 64;
constexpr int NLAT = NB * SEQ, NCTX = NB * CTXL, NTOK = NLAT + NCTX;
constexpr int INW = 3072, DFF = 2816, NE = 8, DFE = 3584;
constexpr int C_NAQ = 0, C_NAK = 512, C_NAV = 1024, C_CONV = 1536, C_RQ = 2048, C_RK = 2176, C_RV = 2304, C_GF = 2560, C_GB = 2816;
constexpr float EPS = 1e-6f;
constexpr float LOG2E = 1.4426950408889634f;

constexpr size_t MiB = 1u << 20;
constexpr size_t WS_CTL = 0, CTL_ZERO_BYTES = 64 * 1024;
constexpr size_t WS_MODLAT = 1 * MiB;
constexpr size_t WS_MODCTX = WS_MODLAT + 2 * 16 * 6144 * 4;
constexpr size_t WS_ROPE = WS_MODCTX + 2 * 6144 * 4;
constexpr size_t WS_PTOK = 2 * MiB;
constexpr size_t WS_SEGCNT = WS_PTOK + 32768 * 2 * 4;
constexpr size_t WS_META = WS_SEGCNT + 256 * 2 * 8 * 4;
constexpr size_t WS_SEGLIST = 3 * MiB;
constexpr size_t WS_ROWMAP = 5 * MiB;
constexpr int MOE_ROWS = 34816;
constexpr int MOE_TILES = MOE_ROWS / 256;
constexpr size_t WS_PROW = WS_ROWMAP + 512 * 1024;
constexpr size_t WS_SUMLAT = 6 * MiB;
constexpr size_t WS_SUMCTX = 22 * MiB;
constexpr size_t WS_WIN = 24 * MiB;
constexpr size_t WS_WOUT = WS_WIN + (size_t)2 * 3072 * 1024 * 2;
constexpr size_t WS_WGU = WS_WOUT + (size_t)2 * 1024 * 1024 * 2;
constexpr size_t WS_WD = WS_WGU + (size_t)5632 * 1024 * 2;
constexpr size_t WS_MGU = WS_WD + (size_t)1024 * 2816 * 2;
constexpr size_t WS_MD = WS_MGU + (size_t)8 * 7168 * 1024 * 2;
constexpr size_t WS_HCTX = WS_MD + (size_t)8 * 1024 * 3584 * 2;
constexpr size_t WS_U = WS_HCTX + (size_t)NCTX * DM * 4;
constexpr size_t WS_P = WS_U + (size_t)NTOK * DM * 2;
constexpr size_t WS_END = WS_P + (size_t)MOE_ROWS * DFE * 2;
static_assert((size_t)NTOK * INW * 2 <= (size_t)MOE_ROWS * DFE * 2, "P region: px | dense hidden | fp8 hidden of both MoE slots (2 x MOE_ROWS x DFE bytes)");
static_assert(WS_WIN % 256 == 0 && WS_WOUT % 256 == 0 && WS_WGU % 256 == 0 && WS_WD % 256 == 0 && WS_MGU % 256 == 0 && WS_MD % 256 == 0 && WS_HCTX % 256 == 0 && WS_U % 256 == 0 && WS_P % 256 == 0, "align");

constexpr int RING_BYTES = 131072;
constexpr int AUX_OFF = RING_BYTES;
constexpr int AUX_TAB = AUX_OFF + 1024;
constexpr int LDS_BYTES = 147456;

#ifndef MOE_FP8
#define MOE_FP8 1
#endif
#ifndef DENSE_FP8
#define DENSE_FP8 2
#endif
constexpr int SCL_U = 0x7c7c7c7c, SCL_WGU = 0x79797979, SCL_H = 0x7c7c7c7c, SCL_WD = 0x78787878;
constexpr float QS_U = 8.0f, QS_WGU = 64.0f, QS_H = 8.0f, QS_WD = 128.0f;
DI unsigned pk2(float lo, float hi) { f32x2_t v = {lo, hi}; bf16x2_t b = __builtin_convertvector(v, bf16x2_t); return __builtin_bit_cast(unsigned, b); }
DI float clamp448(float x) { return __builtin_fminf(__builtin_fmaxf(x, -448.0f), 448.0f); }
DI unsigned pk4_fp8(float a, float b, float c, float d) { int w = 0; w = __builtin_amdgcn_cvt_pk_fp8_f32(clamp448(a), clamp448(b), w, false); w = __builtin_amdgcn_cvt_pk_fp8_f32(clamp448(c), clamp448(d), w, true); return (unsigned)w; }
DI float bflo(unsigned u) { return __uint_as_float(u << 16); }
DI float bfhi(unsigned u) { return __uint_as_float(u & 0xffff0000u); }
DI float wave_sum(float v) {
#pragma unroll
    for (int o = 1; o < 64; o <<= 1) v += __shfl_xor(v, o);
    return v;
}
DI float fast_exp2(float x) { return __builtin_amdgcn_exp2f(x); }
DI float fast_rcp(float x) { return __builtin_amdgcn_rcpf(x); }
DI float sigmoidf_(float x) { return fast_rcp(1.0f + fast_exp2(-x * LOG2E)); }
DI int crow(int reg, int h) { return (reg & 3) + 8 * (reg >> 2) + 4 * h; }
#define MFMA32(a, b, c) __builtin_amdgcn_mfma_f32_32x32x16_bf16((a), (b), (c), 0, 0, 0)
DI s16x4 trread(LAS const unsigned char* p) { return __builtin_bit_cast(s16x4, __builtin_amdgcn_ds_read_tr16_b64_v4i16((LAS v4i16_t*)p)); }
DI int ld_i32_coherent(const int* p) { return (int)__hip_atomic_load((const unsigned*)p, __ATOMIC_RELAXED, __HIP_MEMORY_SCOPE_AGENT); }

namespace pg8 {
#define PG8_LAS __attribute__((address_space(3)))
typedef unsigned short bf16_t;
constexpr int BM = 256, BK = 64, HALF = 128, HTB = HALF * BK * 2, STAGE_BYTES = 8 * HTB, NXCD = 8, WGM = 8;
__host__ __device__ __forceinline__ int lds_byte(int r, int c) { const int st = (r >> 4) * 2 + (c >> 5), rr = r & 15, cc = c & 31, ob = rr * 64 + cc * 2; return st * 1024 + (ob ^ (((ob >> 9) & 1) << 5)); }
__host__ __device__ __forceinline__ void stage_rc(int b, int& R, int& C) { const int st = b / 1024, sb = b % 1024, swz = sb ^ (((sb >> 9) & 1) << 5); R = (st >> 1) * 16 + swz / 64; C = (st & 1) * 32 + (swz % 64) / 2; }
__host__ __device__ __forceinline__ int perm32(int rho) { const int n = rho >> 4, i = rho & 15; return 8 * (i >> 2) + 4 * n + (i & 3); }
struct Unit { int pm, pn; };
struct StaticOrder {
    int nM, nN, nwg, G, c;
    __device__ void init(int M, int N, int G_, int c_) { nM = M / BM; nN = N / BM; nwg = nM * nN; G = G_; c = c_; }
    __device__ bool next(int i, Unit& u) const {
        const long L = (long)i * G + c; if (L >= nwg) return false;
        int wgid = (int)L; { const int q = nwg / NXCD, r = nwg % NXCD, xcd = wgid % NXCD, off = wgid / NXCD; wgid = (xcd < r ? xcd * (q + 1) : r * (q + 1) + (xcd - r) * q) + off; }
        const int nig = WGM * nN, gid = wgid / nig, fm = gid * WGM, gsz = (nM - fm) < WGM ? (nM - fm) : WGM;
        u.pm = fm + ((wgid % nig) % gsz); u.pn = (wgid % nig) / gsz; return true;
    }
};
struct RowsLinear { static constexpr bool GATHER = false; };
struct RowsLinearOff {
    static constexpr bool GATHER = true;
    __device__ __forceinline__ void fetch(const Unit& u, const int (&R)[2], int (&raw)[2][2]) const {
#pragma unroll
        for (int h = 0; h < 2; ++h)
#pragma unroll
            for (int i = 0; i < 2; ++i) raw[h][i] = u.pm * BM + h * HALF + R[i];
    }
    __device__ __forceinline__ void make(const int (&raw)[2][2], const int (&C)[2], int pitch, unsigned (&o)[2][2]) const {
#pragma unroll
        for (int h = 0; h < 2; ++h)
#pragma unroll
            for (int i = 0; i < 2; ++i) { o[h][i] = (unsigned)raw[h][i] * (unsigned)pitch + (unsigned)C[i] * 2u; asm volatile("" : "+v"(o[h][i])); }
    }
};
struct RowsGather {
    static constexpr bool GATHER = true;
    const int* rowmap; int row_add;
    __device__ __forceinline__ void fetch(const Unit& u, const int (&R)[2], int (&raw)[2][2]) const {
#pragma unroll
        for (int h = 0; h < 2; ++h)
#pragma unroll
            for (int i = 0; i < 2; ++i) raw[h][i] = rowmap[u.pm * BM + h * HALF + R[i]];
    }
    __device__ __forceinline__ void make(const int (&raw)[2][2], const int (&C)[2], int pitch, unsigned (&o)[2][2]) const {
#pragma unroll
        for (int h = 0; h < 2; ++h)
#pragma unroll
            for (int i = 0; i < 2; ++i) { int t = raw[h][i]; t = t < 0 ? 0 : t; o[h][i] = (unsigned)((size_t)(t + row_add) * (size_t)pitch + (size_t)C[i] * 2u); }
#pragma unroll
        for (int h = 0; h < 2; ++h)
#pragma unroll
            for (int i = 0; i < 2; ++i) asm volatile("" : "+v"(o[h][i]));
    }
};

typedef int i32x8 __attribute__((ext_vector_type(8)));
typedef int i32x4v __attribute__((ext_vector_type(4)));
template <class Epi, class Sched, class ARows, bool ALIGN_EPI, bool FP8 = false>
__device__ __forceinline__ void gemm_phase(PG8_LAS unsigned char* lds, int tid, const void* A, const void* Bt, int pitch, const Sched& S, const Epi& E, const ARows& AR, int sclA = 0x7f7f7f7f, int sclB = 0x7f7f7f7f) {
    constexpr bool GATHER = ARows::GATHER;
    const int wid = __builtin_amdgcn_readfirstlane(tid >> 6), lane = tid & 63, wr = wid >> 2, wc = wid & 3, fr = lane & 15, fq = lane >> 4;
    const int nt = pitch / (BK * 2);
    int RA[2], CA[2]; unsigned voffA[2], voffB[2];
#pragma unroll
    for (int i = 0; i < 2; ++i) { int R, C; stage_rc(tid * 16 + i * 8192, R, C); const int Rb = Epi::PERM ? ((R & ~31) + perm32(R & 31)) : R;
        RA[i] = R; CA[i] = C; voffA[i] = (unsigned)(R * pitch + C * 2); voffB[i] = (unsigned)(Rb * pitch + C * 2); }
#pragma unroll
    for (int i = 0; i < 2; ++i) { asm volatile("" : "+v"(voffA[i])); asm volatile("" : "+v"(voffB[i])); }
    const size_t kstep = (size_t)(BK * 2);
    const size_t hstep = (size_t)HALF * pitch;
    const size_t tstep = 2 * hstep;
    const unsigned ldsw = (unsigned)wid * 1024u;
    const int aoff = lds_byte(wr * 64 + fr, fq * 8), boff = lds_byte(wc * 32 + fr, fq * 8);
    const char* Ab = (const char*)A;
#define PG8_SA(b, h) (((b) * 2 + (h)) * HTB)
#define PG8_SB(b, h) ((4 + (b) * 2 + (h)) * HTB)
#define PG8_STAGE(bufoff, gbase, voff) do { _Pragma("unroll") for (int _i = 0; _i < 2; ++_i) \
        __builtin_amdgcn_global_load_lds((const unsigned*)((const char*)(gbase) + (voff)[_i]), (PG8_LAS unsigned*)(lds + (bufoff) + ldsw + _i * 8192), 16, 0, 0); } while (0)
#define PG8_STAGEA(bufoff, h, plin, kb) do { if constexpr (GATHER) PG8_STAGE(bufoff, Ab + (kb), curA[h]); else PG8_STAGE(bufoff, (plin) + (h) * hstep, voffA); } while (0)
#define PG8_LDA(dst, b, h) do { _Pragma("unroll") for (int m = 0; m < 4; ++m) _Pragma("unroll") for (int k = 0; k < 2; ++k) dst[m][k] = *(const PG8_LAS bf16x8*)(lds + PG8_SA(b, h) + aoff + m * 2048 + k * 1024); } while (0)
#define PG8_LDB(dst, b, h) do { _Pragma("unroll") for (int n = 0; n < 2; ++n) _Pragma("unroll") for (int k = 0; k < 2; ++k) dst[n][k] = *(const PG8_LAS bf16x8*)(lds + PG8_SB(b, h) + boff + n * 2048 + k * 1024); } while (0)
#define PG8_CAT(x0, x1) __builtin_shufflevector(__builtin_bit_cast(i32x4v, x0), __builtin_bit_cast(i32x4v, x1), 0, 1, 2, 3, 4, 5, 6, 7)
#define PG8_MMA(ai, bj, At, Bt_) do { __builtin_amdgcn_s_setprio(1); \
        if constexpr (FP8) { _Pragma("unroll") for (int m = 0; m < 4; ++m) _Pragma("unroll") for (int n = 0; n < 2; ++n) \
            acc[ai][bj][m][n] = __builtin_amdgcn_mfma_scale_f32_16x16x128_f8f6f4(PG8_CAT(Bt_[n][0], Bt_[n][1]), PG8_CAT(At[m][0], At[m][1]), acc[ai][bj][m][n], 0, 0, 0, sclB, 0, sclA); } \
        else { _Pragma("unroll") for (int m = 0; m < 4; ++m) _Pragma("unroll") for (int n = 0; n < 2; ++n) _Pragma("unroll") for (int k = 0; k < 2; ++k) \
            acc[ai][bj][m][n] = __builtin_amdgcn_mfma_f32_16x16x32_bf16(Bt_[n][k], At[m][k], acc[ai][bj][m][n], 0, 0, 0); } \
        __builtin_amdgcn_s_setprio(0); } while (0)
#define PG8_WAIT_V(n) asm volatile("s_waitcnt vmcnt(" #n ")" ::: "memory")
#define PG8_WAIT_L(n) asm volatile("s_waitcnt lgkmcnt(" #n ")" ::: "memory")
#define PG8_BAR __builtin_amdgcn_s_barrier()
#define PG8_SCHED __builtin_amdgcn_sched_barrier(0)
    Unit cur, nxt; int ui = 0;
    if (!S.next(0, cur)) return;
    f32x4 acc[2][2][4][2];
#pragma unroll
    for (int a = 0; a < 2; ++a)
#pragma unroll
        for (int b = 0; b < 2; ++b)
#pragma unroll
            for (int m = 0; m < 4; ++m)
#pragma unroll
                for (int n = 0; n < 2; ++n) acc[a][b][m][n] = (f32x4){0.f, 0.f, 0.f, 0.f};
    bf16x8 At[4][2], B0[2][2], B1[2][2];
    unsigned curA[2][2] = {{0u, 0u}, {0u, 0u}}, nxtA[2][2] = {{0u, 0u}, {0u, 0u}};
    int rawN[2][2] = {{0, 0}, {0, 0}};
    if constexpr (GATHER) { int rawC[2][2]; AR.fetch(cur, RA, rawC); AR.make(rawC, CA, pitch, curA); Unit n1; if (S.next(1, n1)) AR.fetch(n1, RA, rawN); }
    const char* cA = GATHER ? Ab : Ab + (size_t)cur.pm * tstep;
    const char* cB = (const char*)Bt + (size_t)cur.pn * tstep;
    PG8_STAGE(PG8_SB(0, 0), cB, voffB); PG8_STAGE(PG8_SB(0, 1), cB + hstep, voffB); PG8_STAGEA(PG8_SA(0, 0), 0, cA, 0); PG8_STAGEA(PG8_SA(0, 1), 1, cA, 0);
    if (wr == 1) PG8_BAR;
    PG8_WAIT_V(2); PG8_BAR;
    PG8_STAGE(PG8_SB(1, 0), cB + kstep, voffB); PG8_STAGEA(PG8_SA(1, 0), 0, cA + kstep, kstep); PG8_STAGE(PG8_SB(1, 1), cB + hstep + kstep, voffB);
    PG8_WAIT_V(6); PG8_BAR;
    for (;;) {
        const bool has_next = S.next(ui + 1, nxt);
        if constexpr (GATHER) {
            if (has_next) { AR.make(rawN, CA, pitch, nxtA); Unit n2; if (S.next(ui + 2, n2)) AR.fetch(n2, RA, rawN); }
            else {
#pragma unroll
                for (int h = 0; h < 2; ++h)
#pragma unroll
                    for (int i = 0; i < 2; ++i) nxtA[h][i] = curA[h][i];
            }
        }
        const char* nA = GATHER ? Ab : (has_next ? Ab + (size_t)nxt.pm * tstep : cA);
        const char* nB = has_next ? (const char*)Bt + (size_t)nxt.pn * tstep : cB;
        for (int t = 0; t < nt; t += 2) {
            const bool last = (t == nt - 2);
            const size_t k1 = (size_t)(t + 1) * kstep, k2 = last ? 0 : (size_t)(t + 2) * kstep, k3 = k2 + kstep;
            const char* a1 = cA + k1;
            const char* a2 = last ? nA : cA + k2; const char* b2 = last ? nB : cB + k2;
            const char* a3 = a2 + kstep; const char* b3 = b2 + kstep;
            PG8_LDB(B0, 0, 0); PG8_LDB(B1, 0, 1); PG8_SCHED; PG8_LDA(At, 0, 0); PG8_STAGEA(PG8_SA(1, 1), 1, a1, k1);
            if constexpr (GATHER) { if (last) {
#pragma unroll
                for (int h = 0; h < 2; ++h)
#pragma unroll
                    for (int i = 0; i < 2; ++i) curA[h][i] = nxtA[h][i]; } }
            PG8_WAIT_V(8); PG8_WAIT_L(0); PG8_BAR; PG8_MMA(0, 0, At, B0); PG8_MMA(0, 1, At, B1); PG8_BAR; PG8_SCHED;
            PG8_LDA(At, 0, 1); PG8_STAGE(PG8_SB(0, 0), b2, voffB); PG8_STAGE(PG8_SB(0, 1), b2 + hstep, voffB); PG8_STAGEA(PG8_SA(0, 0), 0, a2, k2);
            PG8_WAIT_V(8); PG8_WAIT_L(0); PG8_BAR; PG8_MMA(1, 0, At, B0); PG8_MMA(1, 1, At, B1); PG8_BAR; PG8_SCHED;
            PG8_LDB(B0, 1, 0); PG8_LDB(B1, 1, 1); PG8_SCHED; PG8_LDA(At, 1, 0); PG8_STAGEA(PG8_SA(0, 1), 1, a2, k2);
            PG8_WAIT_V(8); PG8_WAIT_L(0); PG8_BAR; PG8_MMA(0, 0, At, B0); PG8_MMA(0, 1, At, B1); PG8_BAR; PG8_SCHED;
            PG8_LDA(At, 1, 1); PG8_STAGE(PG8_SB(1, 0), b3, voffB); PG8_STAGE(PG8_SB(1, 1), b3 + hstep, voffB); PG8_STAGEA(PG8_SA(1, 0), 0, a3, k3);
            PG8_WAIT_V(8); PG8_WAIT_L(0); PG8_BAR; PG8_MMA(1, 0, At, B0); PG8_MMA(1, 1, At, B1); PG8_BAR; PG8_SCHED;
        }
        if constexpr (ALIGN_EPI) { if (wr == 0) PG8_BAR; }
        E(acc, cur, wr, wc, fr, fq);
        if (!has_next) break;
#pragma unroll
        for (int a = 0; a < 2; ++a)
#pragma unroll
            for (int b = 0; b < 2; ++b)
#pragma unroll
                for (int m = 0; m < 4; ++m)
#pragma unroll
                    for (int n = 0; n < 2; ++n) acc[a][b][m][n] = (f32x4){0.f, 0.f, 0.f, 0.f};
        cur = nxt; cA = nA; cB = nB; ++ui;
        if constexpr (ALIGN_EPI) { if (wr == 1) PG8_BAR; }
    }
    PG8_WAIT_V(0);
    if constexpr (!ALIGN_EPI) { if (wr == 0) PG8_BAR; }
    PG8_BAR;
#undef PG8_SA
#undef PG8_SB
#undef PG8_STAGE
#undef PG8_STAGEA
#undef PG8_LDA
#undef PG8_LDB
#undef PG8_MMA
#undef PG8_CAT
#undef PG8_WAIT_V
#undef PG8_WAIT_L
#undef PG8_BAR
#undef PG8_SCHED
}

#define PG8_OPAQUE(x) asm volatile("" : "+v"(x))
struct EpiStoreBf16 {
    static constexpr bool PERM = true;
    bf16_t* O; int ldc;
    __device__ __forceinline__ void operator()(const f32x4 (&acc)[2][2][4][2], const Unit& u, int wr, int wc, int fr, int fq) const {
        char* base = (char*)(O + (size_t)(u.pm * BM) * ldc + u.pn * BM);
        unsigned lb = (unsigned)((wr * 64 + fr) * ldc + wc * 32 + 8 * fq) * 2u; PG8_OPAQUE(lb);
        const unsigned rstep = (unsigned)ldc * 32u;
#pragma unroll
        for (int ai = 0; ai < 2; ++ai)
#pragma unroll
            for (int m = 0; m < 4; ++m) { const unsigned ro = lb + (unsigned)(ai * 8 + m) * rstep;
#pragma unroll
                for (int bj = 0; bj < 2; ++bj) { const f32x4 v0 = acc[ai][bj][m][0], v1 = acc[ai][bj][m][1];
                    u32x4 w; w.x = pk2(v0[0], v0[1]); w.y = pk2(v0[2], v0[3]); w.z = pk2(v1[0], v1[1]); w.w = pk2(v1[2], v1[3]);
                    *(u32x4*)(base + ro + bj * (HALF * 2)) = w; } }
    }
};
struct EpiResGate {
    static constexpr bool PERM = false;
    const float* src_ctx; const float* src_lat; float* dst_ctx; float* dst_lat; const float* gate_lat; const float* gate_ctx; int row_base;
    __device__ __forceinline__ void operator()(const f32x4 (&acc)[2][2][4][2], const Unit& u, int wr, int wc, int fr, int fq) const {
        const int rowu = row_base + u.pm * BM; const bool isctx = rowu < NCTX;
        const char* src = (const char*)(isctx ? src_ctx + (size_t)rowu * DM : src_lat + (size_t)(rowu - NCTX) * DM) + u.pn * (BM * 4);
        char* dst = (char*)(isctx ? dst_ctx + (size_t)rowu * DM : dst_lat + (size_t)(rowu - NCTX) * DM) + u.pn * (BM * 4);
        const float* gate = (isctx ? gate_ctx : gate_lat + (size_t)((rowu - NCTX) / SEQ) * 6144) + u.pn * BM;
        const int cl = wc * 32 + 4 * fq;
        f32x4 sc[2][2][4][2];
#pragma unroll
        for (int bj = 0; bj < 2; ++bj)
#pragma unroll
            for (int n = 0; n < 2; ++n) { const f32x4 gv = *(const f32x4*)(gate + cl + bj * HALF + n * 16);
#pragma unroll
                for (int ai = 0; ai < 2; ++ai)
#pragma unroll
                    for (int m = 0; m < 4; ++m) sc[ai][bj][m][n] = acc[ai][bj][m][n] * gv; }
        unsigned lb = (unsigned)((wr * 64 + fr) * DM + cl) * 4u; PG8_OPAQUE(lb);
#pragma unroll
        for (int ai = 0; ai < 2; ++ai)
#pragma unroll
            for (int m = 0; m < 4; ++m) { const unsigned ro = lb + (unsigned)(ai * 8 + m) * (16u * DM * 4u);
#pragma unroll
                for (int bj = 0; bj < 2; ++bj)
#pragma unroll
                    for (int n = 0; n < 2; ++n) { const unsigned o = ro + (unsigned)(bj * HALF + n * 16) * 4u; const f32x4 s = *(const f32x4*)(src + o);
                        *(f32x4*)(dst + o) = s + sc[ai][bj][m][n]; }
                asm volatile("" ::: "memory"); }
    }
};
template <bool MOE> struct EpiSwiglu {
    static constexpr bool PERM = true;
    static constexpr bool OUT8 = MOE ? (MOE_FP8 != 0) : (DENSE_FP8 != 0);
    bf16_t* O; int ldc; int ncol; const float* prow;
    __device__ __forceinline__ void operator()(const f32x4 (&acc)[2][2][4][2], const Unit& u, int wr, int wc, int fr, int fq) const {
        const int pnl = MOE ? (u.pn % ncol) : u.pn;
        constexpr int ES = OUT8 ? 1 : 2;
        char* base = (char*)O + ((size_t)(u.pm * BM) * ldc + pnl * HALF) * ES;
        unsigned lb = (unsigned)((wr * 64 + fr) * ldc + wc * 32 + 8 * fq) * ES; PG8_OPAQUE(lb);
        const unsigned rstep = (unsigned)ldc * 16u * ES;
        const float* pr = MOE ? prow + u.pm * BM : nullptr;
        unsigned pl = (unsigned)(wr * 64 + fr) * 4u; PG8_OPAQUE(pl);
#pragma unroll
        for (int ai = 0; ai < 2; ++ai)
#pragma unroll
            for (int m = 0; m < 4; ++m) {
                float pw = 1.0f; if (MOE) pw = *(const float*)((const char*)pr + pl + (unsigned)(ai * 8 + m) * 64u);
                if (OUT8) pw *= QS_H;
                float hv[8];
#pragma unroll
                for (int n = 0; n < 2; ++n)
#pragma unroll
                    for (int j = 0; j < 4; ++j) { const float g = acc[ai][0][m][n][j], up = acc[ai][1][m][n][j]; hv[n * 4 + j] = g * sigmoidf_(g) * up * pw; }
                if constexpr (OUT8) { u32x2 w; w.x = pk4_fp8(hv[0], hv[1], hv[2], hv[3]); w.y = pk4_fp8(hv[4], hv[5], hv[6], hv[7]);
                    *(u32x2*)(base + lb + (unsigned)(ai * 8 + m) * rstep) = w; }
                else { u32x4 w; w.x = pk2(hv[0], hv[1]); w.y = pk2(hv[2], hv[3]); w.z = pk2(hv[4], hv[5]); w.w = pk2(hv[6], hv[7]);
                    *(u32x4*)(base + lb + (unsigned)(ai * 8 + m) * rstep) = w; } }
    }
};
struct EpiMoeScatter {
    static constexpr bool PERM = false;
    const int* rowmap; float* hlat; const float* gate_lat; int ncol;
    __device__ __forceinline__ void operator()(const f32x4 (&acc)[2][2][4][2], const Unit& u, int wr, int wc, int fr, int fq) const {
        const int pnl = u.pn % ncol;
        const int* rm = rowmap + u.pm * BM;
        char* hb = (char*)hlat + pnl * (BM * 4); const char* gb = (const char*)gate_lat + pnl * (BM * 4);
        unsigned pl = (unsigned)(wr * 64 + fr) * 4u; PG8_OPAQUE(pl);
        unsigned cb = (unsigned)(wc * 32 + 4 * fq) * 4u; PG8_OPAQUE(cb);
#pragma unroll
        for (int ai = 0; ai < 2; ++ai)
#pragma unroll
            for (int m = 0; m < 4; ++m) { const int tok = *(const int*)((const char*)rm + pl + (unsigned)(ai * 8 + m) * 64u);
                if (tok >= 0) { const unsigned ro = (unsigned)tok * (DM * 4u) + cb, go = ((unsigned)tok >> 11) * (6144u * 4u) + cb;
#pragma unroll
                    for (int bj = 0; bj < 2; ++bj)
#pragma unroll
                        for (int n = 0; n < 2; ++n) { const unsigned o = (unsigned)(bj * HALF + n * 16) * 4u; const f32x4 sv = *(const f32x4*)(hb + ro + o); const f32x4 gv = *(const f32x4*)(gb + go + o);
                            *(f32x4*)(hb + ro + o) = sv + gv * acc[ai][bj][m][n]; } }
                asm volatile("" ::: "memory"); }
    }
};
struct MoeOrder {
    int NT0, NT1, ncol, G, c; const PG8_LAS int* texp;
    __device__ bool next(int i, Unit& u) const {
        const long L = (long)i * G + c; if (L >= (long)(NT0 + NT1) * ncol) return false;
        const int tq = (int)(L / ncol), pnl = (int)(L % ncol);
        const int T = tq < NT0 ? tq : MOE_TILES + tq - NT0;
        const int e = __builtin_amdgcn_readfirstlane(texp[T]);
        u.pm = T; u.pn = e * ncol + pnl; return true;
    }
};
}

#define XB_TMO      128
#define XB_XCNT(j)  (256  + 64 * (j))
#define XB_XSUB(j)  (1280 + 64 * (j))
#define XB_XGEN(j)  (2304 + 64 * (j))
#define XB_TOP      3328
#define XB_TOPGEN   3392
#define XCD_BAR_WORDS 3456
#define XB_SPIN_CAP (1u << 18)
DI unsigned xb_ld(unsigned* p)              { return __hip_atomic_load(p, __ATOMIC_RELAXED, __HIP_MEMORY_SCOPE_AGENT); }
DI unsigned xb_add(unsigned* p, unsigned v) { return __hip_atomic_fetch_add(p, v, __ATOMIC_RELAXED, __HIP_MEMORY_SCOPE_AGENT); }
DI unsigned xb_xcc_id() { return (unsigned)__builtin_amdgcn_s_getreg((3 << 11) | 20) & 0xFu; }
#define XB_SPIN(cond, bar) do { unsigned _sp = 0; while (cond) { __builtin_amdgcn_s_sleep(1); \
    if ((++_sp & 255u) == 0u) { if (xb_ld(&(bar)[XB_TMO])) break; if (_sp > XB_SPIN_CAP) { atomicAdd(&(bar)[XB_TMO], 1u); break; } } } } while (0)
struct XcdBarrier { unsigned* bar; unsigned x; volatile LAS unsigned* st; };
DI XcdBarrier xcd_barrier_post(unsigned* bar, volatile LAS unsigned* st) {
    XcdBarrier b; b.bar = bar; b.x = xb_xcc_id(); b.st = st;
    if (threadIdx.x == 0) (void)xb_add(&bar[XB_XCNT(b.x)], 1u);
    return b;
}
DI void xcd_barrier_complete(unsigned* bar, unsigned x, unsigned& nloc, unsigned& nx) {
    const unsigned G = gridDim.x * gridDim.y * gridDim.z;
    unsigned sum, cnt, mine, sp = 0u;
    for (;;) {
        sum = 0u; cnt = 0u; mine = 0u;
#pragma unroll
        for (unsigned j = 0; j < 16; ++j) { const unsigned c = xb_ld(&bar[XB_XCNT(j)]); sum += c; cnt += (c > 0u) ? 1u : 0u; mine = (j == x) ? c : mine; }
        if (sum == G) break;
        __builtin_amdgcn_s_sleep(1);
        if ((++sp & 255u) == 0u) { if (xb_ld(&bar[XB_TMO])) break; if (sp > XB_SPIN_CAP) { atomicAdd(&bar[XB_TMO], 1u); break; } }
    }
    nloc = mine > 0u ? mine : 1u; nx = cnt > 0u ? cnt : 1u;
}
DI void xcd_barrier(const XcdBarrier& b) {
    asm volatile("s_waitcnt vmcnt(0)" ::: "memory");
    __syncthreads();
    if (threadIdx.x == 0) {
        unsigned* bar = b.bar;
        __builtin_amdgcn_s_waitcnt(0);
        unsigned nloc = b.st[0], nx = b.st[1];
        if (nloc == 0u) { xcd_barrier_complete(bar, b.x, nloc, nx); b.st[0] = nloc; b.st[1] = nx; }
        const unsigned old = xb_add(&bar[XB_XSUB(b.x)], 1u);
        const unsigned gen = old / nloc;
        if (old + 1u == (gen + 1u) * nloc) {
            __builtin_amdgcn_fence(__ATOMIC_RELEASE, "agent");
            asm volatile("s_waitcnt vmcnt(0)" ::: "memory");
            const unsigned og = xb_add(&bar[XB_TOP], 1u);
            const unsigned tg = og / nx;
            if (og + 1u == (tg + 1u) * nx) xb_add(&bar[XB_TOPGEN], 1u);
            else XB_SPIN(xb_ld(&bar[XB_TOPGEN]) == tg, bar);
            __builtin_amdgcn_fence(__ATOMIC_ACQUIRE, "agent");
            xb_add(&bar[XB_XGEN(b.x)], 1u);
            asm volatile("s_waitcnt vmcnt(0)" ::: "memory");
        } else {
            XB_SPIN(xb_ld(&bar[XB_XGEN(b.x)]) == gen, bar);
            __builtin_amdgcn_fence(__ATOMIC_ACQUIRE, "agent");
            asm volatile("s_waitcnt vmcnt(0)" ::: "memory");
        }
    }
    __syncthreads();
}

struct Params { const float* in[26]; float* out; unsigned char* ws; int ph_lo, ph_hi, pad0, pad1; };
enum { I_X = 0, I_C, I_CTX, I_CCTX, I_WMOD, I_BMOD, I_N1W, I_N2W, I_WIN, I_WOUT, I_RPB, I_CONVW, I_CONVB, I_CLNW, I_CLNB, I_RDEC, I_RGNW,
       I_FG, I_FU, I_FD, I_MR, I_MRB, I_MG, I_MU, I_MDN, I_FNW };
constexpr int PH_P0 = 0, PH_FINAL = 19, N_PHASES = 20;

typedef __attribute__((address_space(4))) const unsigned char* karg_t;
struct KIn {
    karg_t ka;
    DI const float* operator[](int k) const { return *(const float* __attribute__((address_space(4))) const*)(ka + 8 * k); }
};
struct Frame {
    LAS unsigned char* lds;
    int tid, lane, wave, G, bid, vb;
    KIn in; float* out; unsigned char* ws;
};
DI Frame phase_frame(const Frame& F0) {
    Frame F; karg_t ka = F0.in.ka; asm volatile("" : "+s"(ka)); F.in.ka = ka;
    F.out = *(float* __attribute__((address_space(4))) const*)(ka + 208);
    F.ws = *(unsigned char* __attribute__((address_space(4))) const*)(ka + 216);
    int tid = F0.tid, G = F0.G, bid = F0.bid; unsigned ldsb = (unsigned)(size_t)F0.lds;
    asm volatile("" : "+v"(tid)); asm volatile("" : "+s"(G)); asm volatile("" : "+s"(bid)); asm volatile("" : "+s"(ldsb));
    F.tid = tid; F.lane = tid & 63; F.wave = __builtin_amdgcn_readfirstlane(tid >> 6); F.G = G; F.bid = bid; F.lds = (LAS unsigned char*)(size_t)ldsb;
    F.vb = (G % 8 == 0) ? (bid % 8) * (G / 8) + bid / 8 : bid;
    return F;
}

DI void p0_transpose_item(const float* W, int K, int N, bf16* WT, int k0, int n0, int dst_row0, LAS float* scr, int lane) {
#pragma unroll 8
    for (int i = 0; i < 32; ++i) { const int kk = 2 * i + (lane >> 5); scr[kk * 33 + (lane & 31)] = W[(size_t)(k0 + kk) * N + n0 + (lane & 31)]; }
    asm volatile("s_waitcnt lgkmcnt(0)" ::: "memory");
    const int c = lane & 7;
#pragma unroll
    for (int j = 0; j < 4; ++j) { const int n = (lane >> 3) + 8 * j; const LAS float* s = scr + (8 * c) * 33 + n;
        u32x4 o; o.x = pk2(s[0 * 33], s[1 * 33]); o.y = pk2(s[2 * 33], s[3 * 33]); o.z = pk2(s[4 * 33], s[5 * 33]); o.w = pk2(s[6 * 33], s[7 * 33]);
        *(u32x4*)(WT + (size_t)(dst_row0 + n) * K + k0 + 8 * c) = o; }
    asm volatile("s_waitcnt lgkmcnt(0)" ::: "memory");
}
DI void p0_convert_plain(Frame& F, const float* W, int K, int N, bf16* WT, int item, LAS float* scr) {
    const int nblk = N / 32, kb = item / nblk, nb = item % nblk;
    p0_transpose_item(W, K, N, WT, 64 * kb, 32 * nb, 32 * nb, scr, F.lane);
}
DI void p0_convert_gu(Frame& F, const float* W, int K, int N, bf16* WT, int item, int up, LAS float* scr) {
    const int nblk = N / 32, kb = item / nblk, nb = item % nblk, n0 = 32 * nb;
    p0_transpose_item(W, K, N, WT, 64 * kb, n0, 256 * (n0 / 128) + (n0 % 128) + (up ? 128 : 0), scr, F.lane);
}
DI void conv_item64(const float* W, int K, int N, bf16* WT, int k0, int n0, int dst_row0, LAS unsigned* scr, int lane) {
    const float* wp = W + (size_t)k0 * N + n0 + lane;
    float v[64];
#pragma unroll
    for (int i = 0; i < 64; ++i) v[i] = wp[(size_t)i * N];
#pragma unroll
    for (int i = 0; i < 32; ++i) scr[i * 65 + lane] = pk2(v[2 * i], v[2 * i + 1]);
    asm volatile("s_waitcnt lgkmcnt(0)" ::: "memory");
    const int c = lane & 7;
#pragma unroll
    for (int j = 0; j < 8; ++j) { const int n = (lane >> 3) + 8 * j; const LAS unsigned* sp = scr + (4 * c) * 65 + n;
        u32x4 o; o.x = sp[0]; o.y = sp[65]; o.z = sp[130]; o.w = sp[195];
        *(u32x4*)(WT + (size_t)(dst_row0 + n) * K + k0 + 8 * c) = o; }
    asm volatile("s_waitcnt lgkmcnt(0)" ::: "memory");
}
DI void conv_item64_fp8(const float* W, int K, int N, unsigned char* WT, int k0, int n0, int dst_row0, float qs, LAS unsigned* scr, int lane) {
    const float* wp = W + (size_t)k0 * N + n0 + lane;
    float v[64];
#pragma unroll
    for (int i = 0; i < 64; ++i) v[i] = wp[(size_t)i * N];
#pragma unroll
    for (int i = 0; i < 16; ++i) scr[i * 65 + lane] = pk4_fp8(v[4 * i] * qs, v[4 * i + 1] * qs, v[4 * i + 2] * qs, v[4 * i + 3] * qs);
    asm volatile("s_waitcnt lgkmcnt(0)" ::: "memory");
    const int c = lane & 3;
#pragma unroll
    for (int j = 0; j < 4; ++j) { const int n = (lane >> 2) + 16 * j; const LAS unsigned* sp = scr + (4 * c) * 65 + n;
        u32x4 o; o.x = sp[0]; o.y = sp[65]; o.z = sp[130]; o.w = sp[195];
        *(u32x4*)(WT + (size_t)(dst_row0 + n) * K + k0 + 16 * c) = o; }
    asm volatile("s_waitcnt lgkmcnt(0)" ::: "memory");
}
constexpr int BG_ITEMS = 21504;
constexpr int BG_B0 = 0, BG_D0 = 1200, BG_E0 = 5200, BG_F0 = 8700, BG_B1 = 19700, BG_CL = 20900;
DI void bg_item(Frame& F, int g, LAS unsigned* scr) {
    if (g < 14336) { const int m = g / 896, e = m >> 1, up = m & 1, r = g % 896, kb = r / 56, nb = r % 56, n0 = 64 * nb; const int drow = 256 * (n0 / 128) + (n0 % 128) + (up ? 128 : 0);
#if MOE_FP8
        conv_item64_fp8(F.in[up ? I_MU : I_MG] + (size_t)e * 1024 * 3584, 1024, 3584, F.ws + WS_MGU + (size_t)e * 7168 * 1024, 64 * kb, n0, drow, QS_WGU, scr, F.lane);
#else
        conv_item64(F.in[up ? I_MU : I_MG] + (size_t)e * 1024 * 3584, 1024, 3584, (bf16*)(F.ws + WS_MGU) + (size_t)e * 7168 * 1024, 64 * kb, n0, drow, scr, F.lane);
#endif
    } else { const int gg = g - 14336, e = gg / 896, r = gg % 896, kb = r / 16, nb = r % 16;
#if MOE_FP8
        conv_item64_fp8(F.in[I_MDN] + (size_t)e * 3584 * 1024, 3584, 1024, F.ws + WS_MD + (size_t)e * 1024 * 3584, 64 * kb, 64 * nb, 64 * nb, QS_WD, scr, F.lane);
#else
        conv_item64(F.in[I_MDN] + (size_t)e * 3584 * 1024, 3584, 1024, (bf16*)(F.ws + WS_MD) + (size_t)e * 1024 * 3584, 64 * kb, 64 * nb, 64 * nb, scr, F.lane);
#endif
    }
}
DI void bg_convert_tail(Frame& F, int nwg, int lo, int hi) {
    const int nmax = (nwg + F.G - 1) / F.G, rem = nwg - (nmax - 1) * F.G;
    if (F.bid < rem || rem >= F.G) return;
    LAS unsigned* scr = (LAS unsigned*)(F.lds + F.wave * 8320);
    const int w = (F.bid - rem) * 8 + F.wave, nw = (F.G - rem) * 8;
    for (int g = lo + w; g < hi; g += nw) bg_item(F, g, scr);
}
DI void bg_convert_all(Frame& F, int lo, int hi) {
    LAS unsigned* scr = (LAS unsigned*)(F.lds + F.wave * 8320);
    for (int g = lo + F.bid * 8 + F.wave; g < hi; g += F.G * 8) bg_item(F, g, scr);
}
DI void p0_prologue(Frame& F) {
    {
        LAS float* Sx = (LAS float*)F.lds;
        LAS float* red = (LAS float*)(F.lds + 81920);
        bool staged = false;
        for (int unit = F.bid; unit < 192; unit += F.G) {
            if (!staged) {
                for (int idx = F.tid; idx < 17 * 1024; idx += 512) { const int r = idx / 1024, k = idx % 1024;
                    const float v = r < 16 ? F.in[I_C][r * 1024 + k] : F.in[I_CCTX][k]; Sx[k * 20 + r] = v * sigmoidf_(v); }
                staged = true; __syncthreads();
            }
            const int l = unit / 96, n0 = (unit % 96) * 64;
            const float* Wm = F.in[I_WMOD] + (size_t)l * 1024 * 6144 + n0 + F.lane;
            float acc[17];
#pragma unroll
            for (int r = 0; r < 17; ++r) acc[r] = 0.f;
            const int kb = F.wave * 128;
#pragma unroll 4
            for (int k = 0; k < 128; ++k) { const float wv = Wm[(size_t)(kb + k) * 6144]; const LAS float* sp = Sx + (kb + k) * 20;
                const f32x4 s0 = *(const LAS f32x4*)(sp), s1 = *(const LAS f32x4*)(sp + 4), s2 = *(const LAS f32x4*)(sp + 8), s3 = *(const LAS f32x4*)(sp + 12); const float s4 = sp[16];
                acc[0] += s0[0] * wv; acc[1] += s0[1] * wv; acc[2] += s0[2] * wv; acc[3] += s0[3] * wv; acc[4] += s1[0] * wv; acc[5] += s1[1] * wv; acc[6] += s1[2] * wv; acc[7] += s1[3] * wv;
                acc[8] += s2[0] * wv; acc[9] += s2[1] * wv; acc[10] += s2[2] * wv; acc[11] += s2[3] * wv; acc[12] += s3[0] * wv; acc[13] += s3[1] * wv; acc[14] += s3[2] * wv; acc[15] += s3[3] * wv;
                acc[16] += s4 * wv; }
#pragma unroll
            for (int r = 0; r < 17; ++r) red[(F.wave * 17 + r) * 64 + F.lane] = acc[r];
            __syncthreads();
            for (int idx = F.tid; idx < 17 * 64; idx += 512) { const int r = idx / 64, ln = idx % 64; float s = F.in[I_BMOD][l * 6144 + n0 + ln];
#pragma unroll
                for (int w = 0; w < 8; ++w) s += red[(w * 17 + r) * 64 + ln];
                if (r < 16) ((float*)(F.ws + WS_MODLAT))[((size_t)l * 16 + r) * 6144 + n0 + ln] = s; else ((float*)(F.ws + WS_MODCTX))[(size_t)l * 6144 + n0 + ln] = s; }
            __syncthreads();
        }
        __syncthreads();
    }
    if (F.bid == 0) { const int pos = F.tid >> 3, j = F.tid & 7; const float inv = exp2f(-(float)j * 0.125f * 13.287712379549449f); const float ang = (float)pos * inv;
        float* tab = (float*)(F.ws + WS_ROPE); tab[(pos * 8 + j) * 2] = cosf(ang); tab[(pos * 8 + j) * 2 + 1] = sinf(ang); }
    {
        LAS float* scr = (LAS float*)(F.lds + F.wave * 16384);
        const int gw = F.bid * 8 + F.wave, NGW = F.G * 8;
        constexpr int I_IN = 16 * 96, I_OUT = 16 * 32, I_G = 16 * 88, I_D = 44 * 32, I_MGI = 16 * 112, I_MDI = 56 * 32;
        constexpr int NITEMS = 2 * I_IN + 2 * I_OUT + (DENSE_FP8 == 1 ? 3 * 704 : (DENSE_FP8 == 2 ? 2 * I_G + 704 : 2 * I_G + I_D));
        for (int it = gw; it < NITEMS; it += NGW) {
            int r = it;
            if (r < 2 * I_IN) { const int l = r / I_IN; p0_convert_plain(F, F.in[I_WIN] + (size_t)l * 1024 * 3072, 1024, 3072, (bf16*)(F.ws + WS_WIN) + (size_t)l * 3072 * 1024, r % I_IN, scr); continue; } r -= 2 * I_IN;
            if (r < 2 * I_OUT) { const int l = r / I_OUT; p0_convert_plain(F, F.in[I_WOUT] + (size_t)l * 1024 * 1024, 1024, 1024, (bf16*)(F.ws + WS_WOUT) + (size_t)l * 1024 * 1024, r % I_OUT, scr); continue; } r -= 2 * I_OUT;
#if DENSE_FP8 == 2
            if (r < I_G) { p0_convert_gu(F, F.in[I_FG], 1024, 2816, (bf16*)(F.ws + WS_WGU), r, 0, scr); continue; } r -= I_G;
            if (r < I_G) { p0_convert_gu(F, F.in[I_FU], 1024, 2816, (bf16*)(F.ws + WS_WGU), r, 1, scr); continue; } r -= I_G;
            { const int kb = r / 16, nb = r % 16; conv_item64_fp8(F.in[I_FD], 2816, 1024, F.ws + WS_WD, 64 * kb, 64 * nb, 64 * nb, QS_WD, (LAS unsigned*)scr, F.lane); }
#elif DENSE_FP8 == 1
            { LAS unsigned* scr8 = (LAS unsigned*)scr;
              if (r < 1408) { const int up = r / 704, q = r % 704, kb = q / 44, nb = q % 44, n0 = 64 * nb;
                  conv_item64_fp8(F.in[up ? I_FU : I_FG], 1024, 2816, F.ws + WS_WGU, 64 * kb, n0, 256 * (n0 / 128) + (n0 % 128) + (up ? 128 : 0), QS_WGU, scr8, F.lane); }
              else { const int q = r - 1408, kb = q / 16, nb = q % 16; conv_item64_fp8(F.in[I_FD], 2816, 1024, F.ws + WS_WD, 64 * kb, 64 * nb, 64 * nb, QS_WD, scr8, F.lane); } }
#else
            if (r < I_G) { p0_convert_gu(F, F.in[I_FG], 1024, 2816, (bf16*)(F.ws + WS_WGU), r, 0, scr); continue; } r -= I_G;
            if (r < I_G) { p0_convert_gu(F, F.in[I_FU], 1024, 2816, (bf16*)(F.ws + WS_WGU), r, 1, scr); continue; } r -= I_G;
            p0_convert_plain(F, F.in[I_FD], 2816, 1024, (bf16*)(F.ws + WS_WD), r, scr);
#endif
        }
    }
}

struct NormVecs { f32x4 gs[4], sh[4]; };
DI void norm_load_vecs(Frame& F, const float* g, const float* mod, int isc, int ish, NormVecs& V) {
#pragma unroll
    for (int j = 0; j < 4; ++j) { const f32x4 gv = ((const f32x4*)g)[F.lane + 64 * j], sv = ((const f32x4*)(mod + isc * DM))[F.lane + 64 * j]; V.gs[j] = gv * (sv + 1.0f); V.sh[j] = ((const f32x4*)(mod + ish * DM))[F.lane + 64 * j]; }
}
DI void norm_load_row(Frame& F, const float* srow, f32x4 (&v)[4]) {
    const f32x4* xr = (const f32x4*)srow + F.lane;
#pragma unroll
    for (int j = 0; j < 4; ++j) v[j] = xr[64 * j];
}
DI float norm_ssq(const f32x4 (&v)[4]) { float s = 0.f;
#pragma unroll
    for (int j = 0; j < 4; ++j) s += (v[j].x * v[j].x + v[j].y * v[j].y) + (v[j].z * v[j].z + v[j].w * v[j].w);
    return s; }
DI void norm_finish(Frame& F, const f32x4 (&v)[4], float ssq_total, const NormVecs& V, bf16* orow, f32x4 (&y)[4]) {
    const float rstd = 1.0f / sqrtf(ssq_total * (1.0f / DM) + EPS);
    u32x2* o8 = (u32x2*)orow + F.lane;
#pragma unroll
    for (int j = 0; j < 4; ++j) { y[j] = (v[j] * rstd) * V.gs[j] + V.sh[j]; u32x2 w; w.x = pk2(y[j].x, y[j].y); w.y = pk2(y[j].z, y[j].w); o8[64 * j] = w; }
}
DI void norm_finish8(Frame& F, const f32x4 (&v)[4], float ssq_total, const NormVecs& V, unsigned char* orow, f32x4 (&y)[4]) {
    const float rstd = 1.0f / sqrtf(ssq_total * (1.0f / DM) + EPS);
    unsigned* o4 = (unsigned*)orow + F.lane;
#pragma unroll
    for (int j = 0; j < 4; ++j) { y[j] = (v[j] * rstd) * V.gs[j] + V.sh[j]; o4[64 * j] = pk4_fp8(y[j].x * QS_U, y[j].y * QS_U, y[j].z * QS_U, y[j].w * QS_U); }
}
DI void norm_phase(Frame& F, int l, int which, bool first, int row_lo, bool out8 = false) {
    const float* g = F.in[which == 1 ? I_N1W : I_N2W] + l * DM;
    const float* modlat = (const float*)(F.ws + WS_MODLAT) + (size_t)l * 16 * 6144;
    const float* modctx = (const float*)(F.ws + WS_MODCTX) + (size_t)l * 6144;
    const int ish = which == 1 ? 0 : 3, isc = which == 1 ? 1 : 4;
    const float* sctx = first ? F.in[I_CTX] : (const float*)(F.ws + WS_HCTX);
    const float* slat = first ? F.in[I_X] : F.out;
    bf16* U = (bf16*)(F.ws + WS_U);
    const int gw = F.bid * 8 + F.wave, NGW = F.G * 8;
    const int rpw = (NTOK - row_lo + NGW - 1) / NGW;
    const int r0 = row_lo + gw * rpw; int r1 = r0 + rpw; if (r1 > NTOK) r1 = NTOK;
    NormVecs V; int curb = -2;
    for (int row = r0; row < r1; row += 2) {
        const bool two = row + 1 < r1;
        const int rowb = two ? row + 1 : row;
        f32x4 va[4], vb[4];
        norm_load_row(F, row < NCTX ? sctx + (size_t)row * DM : slat + (size_t)(row - NCTX) * DM, va);
        norm_load_row(F, rowb < NCTX ? sctx + (size_t)rowb * DM : slat + (size_t)(rowb - NCTX) * DM, vb);
        float sa = norm_ssq(va), sb = norm_ssq(vb);
#pragma unroll
        for (int o = 1; o < 64; o <<= 1) { sa += __shfl_xor(sa, o); sb += __shfl_xor(sb, o); }
        f32x4 y[4];
        { const int bk = row < NCTX ? -1 : (row - NCTX) / SEQ; if (bk != curb) { norm_load_vecs(F, g, bk < 0 ? modctx : modlat + (size_t)bk * 6144, isc, ish, V); curb = bk; } }
        if (out8) norm_finish8(F, va, sa, V, (unsigned char*)U + (size_t)row * DM, y); else norm_finish(F, va, sa, V, U + (size_t)row * DM, y);
        if (two) { const int bk = rowb < NCTX ? -1 : (rowb - NCTX) / SEQ; if (bk != curb) { norm_load_vecs(F, g, bk < 0 ? modctx : modlat + (size_t)bk * 6144, isc, ish, V); curb = bk; }
            if (out8) norm_finish8(F, vb, sb, V, (unsigned char*)U + (size_t)rowb * DM, y); else norm_finish(F, vb, sb, V, U + (size_t)rowb * DM, y); }
    }
}
DI void moe_route_row(Frame& F, const f32x4 (&y)[4], LAS const float* Rw, const float (&rb)[8], LAS int* sel, int tl, int tok) {
    float lg[8];
#pragma unroll
    for (int e = 0; e < 8; ++e) lg[e] = 0.f;
#pragma unroll
    for (int j = 0; j < 4; ++j)
#pragma unroll
        for (int q = 0; q < 4; ++q) { const int k = 256 * j + 4 * F.lane + q; const f32x4 r0 = *(const LAS f32x4*)(Rw + k * 8), r1 = *(const LAS f32x4*)(Rw + k * 8 + 4); const float yv = y[j][q];
            lg[0] += yv * r0[0]; lg[1] += yv * r0[1]; lg[2] += yv * r0[2]; lg[3] += yv * r0[3]; lg[4] += yv * r1[0]; lg[5] += yv * r1[1]; lg[6] += yv * r1[2]; lg[7] += yv * r1[3]; }
#pragma unroll
    for (int o = 1; o < 64; o <<= 1) {
#pragma unroll
        for (int e = 0; e < 8; ++e) lg[e] += __shfl_xor(lg[e], o); }
#pragma unroll
    for (int e = 0; e < 8; ++e) lg[e] += rb[e];
    int e1 = 0; float v1 = lg[0];
#pragma unroll
    for (int e = 1; e < 8; ++e) if (lg[e] > v1) { v1 = lg[e]; e1 = e; }
    int e2 = -1; float v2 = -3.0e38f;
#pragma unroll
    for (int e = 0; e < 8; ++e) if (e != e1 && lg[e] > v2) { v2 = lg[e]; e2 = e; }
    const float ex = __expf(v2 - v1), p1 = 1.0f / (1.0f + ex), p2 = ex / (1.0f + ex);
    if (F.lane == 0) { sel[tl * 2] = e1; sel[tl * 2 + 1] = e2; float* pt = (float*)(F.ws + WS_PTOK) + (size_t)tok * 2; pt[0] = p1; pt[1] = p2; }
}
DI void norm_moe_phase(Frame& F) {
    const int l = 1;
    const float* g = F.in[I_N2W] + l * DM;
    const float* modlat = (const float*)(F.ws + WS_MODLAT) + (size_t)l * 16 * 6144;
    bf16* U = (bf16*)(F.ws + WS_U);
    LAS float* Rw = (LAS float*)F.lds;
    LAS int* sel = (LAS int*)(F.lds + 32768);
    for (int idx = F.tid; idx < 8192; idx += 512) Rw[idx] = F.in[I_MR][idx];
    __syncthreads();
    float rb[8];
#pragma unroll
    for (int e = 0; e < 8; ++e) rb[e] = F.in[I_MRB][e];
    NormVecs V; int curb = -2;
    for (int seg = F.bid; seg < 256; seg += F.G) {
        const int bk = (seg * 128) / SEQ; if (bk != curb) { norm_load_vecs(F, g, modlat + (size_t)bk * 6144, 4, 3, V); curb = bk; }
        for (int i = 0; i < 16; i += 2) {
            const int tl = F.wave * 16 + i, tok = seg * 128 + tl;
            f32x4 va[4], vb[4];
            norm_load_row(F, F.out + (size_t)tok * DM, va); norm_load_row(F, F.out + (size_t)(tok + 1) * DM, vb);
            float sa = norm_ssq(va), sb = norm_ssq(vb);
#pragma unroll
            for (int o = 1; o < 64; o <<= 1) { sa += __shfl_xor(sa, o); sb += __shfl_xor(sb, o); }
            f32x4 y[4];
#if MOE_FP8
            norm_finish8(F, va, sa, V, (unsigned char*)U + (size_t)tok * DM, y); moe_route_row(F, y, Rw, rb, sel, tl, tok);
            norm_finish8(F, vb, sb, V, (unsigned char*)U + (size_t)(tok + 1) * DM, y); moe_route_row(F, y, Rw, rb, sel, tl + 1, tok + 1);
#else
            norm_finish(F, va, sa, V, U + (size_t)(NCTX + tok) * DM, y); moe_route_row(F, y, Rw, rb, sel, tl, tok);
            norm_finish(F, vb, sb, V, U + (size_t)(NCTX + tok + 1) * DM, y); moe_route_row(F, y, Rw, rb, sel, tl + 1, tok + 1);
#endif
        }
        __syncthreads();
        if (F.tid < 16) { const int s = F.tid >> 3, e = F.tid & 7; int cnt = 0; int* lst = (int*)(F.ws + WS_SEGLIST) + ((size_t)(seg * 2 + s) * 8 + e) * 128;
            for (int i = 0; i < 128; ++i) if (sel[i * 2 + s] == e) lst[cnt++] = seg * 128 + i;
            ((int*)(F.ws + WS_SEGCNT))[(seg * 2 + s) * 8 + e] = cnt; }
        __syncthreads();
    }
}
DI void moe_route_phase(Frame& F) {
    LAS int* cn = (LAS int*)F.lds;
    LAS int* offs = cn + 2048;
    LAS int* tb = offs + 256;
    for (int unit = F.bid; unit < 16; unit += F.G) {
        const int s = unit >> 3, e = unit & 7;
        const int* segcnt = (const int*)(F.ws + WS_SEGCNT);
        for (int idx = F.tid; idx < 2048; idx += 512) { const int ee = idx >> 8, gsg = idx & 255; cn[idx] = segcnt[(gsg * 2 + s) * 8 + ee]; }
        __syncthreads();
        if (F.tid < 8) { int tot = 0; for (int gsg = 0; gsg < 256; ++gsg) tot += cn[F.tid * 256 + gsg]; tb[16 + F.tid] = tot; }
        if (F.tid == 64) { int run = 0; for (int gsg = 0; gsg < 256; ++gsg) { offs[gsg] = run; run += cn[e * 256 + gsg]; } }
        __syncthreads();
        if (F.tid == 0) { int run = 0; for (int ee = 0; ee < 8; ++ee) { tb[ee] = run; run += (tb[16 + ee] + 255) / 256; } tb[8] = run; }
        __syncthreads();
        int* rowmap = (int*)(F.ws + WS_ROWMAP) + (size_t)s * MOE_ROWS;
        float* prow = (float*)(F.ws + WS_PROW) + (size_t)s * MOE_ROWS;
        const float* ptok = (const float*)(F.ws + WS_PTOK);
        const int base = tb[e] * 256, tot = tb[16 + e], ntile = (tot + 255) / 256;
        if (F.tid < 256) { const int gsg = F.tid; const int c = cn[e * 256 + gsg]; const int* lst = (const int*)(F.ws + WS_SEGLIST) + ((size_t)(gsg * 2 + s) * 8 + e) * 128;
            for (int i = 0; i < c; ++i) { const int tok = lst[i]; rowmap[base + offs[gsg] + i] = tok; prow[base + offs[gsg] + i] = ptok[(size_t)tok * 2 + s]; } }
        for (int i = tot + F.tid; i < ntile * 256; i += 512) { rowmap[base + i] = -1; prow[base + i] = 0.f; }
        if (e == 0) { int* meta = (int*)(F.ws + WS_META) + s * 256;
            if (F.tid == 0) meta[0] = tb[8];
            if (F.tid < 8) { const int t0 = tb[F.tid], t1 = tb[F.tid + 1]; for (int t = t0; t < t1; ++t) meta[1 + t] = F.tid; } }
        __syncthreads();
    }
}
DI void final_phase(Frame& F) {
    const float* g = F.in[I_FNW];
    f32x4 gv[4];
#pragma unroll
    for (int j = 0; j < 4; ++j) gv[j] = ((const f32x4*)g)[F.lane + 64 * j];
    const int gw = F.bid * 8 + F.wave, NGW = F.G * 8;
    const int rpw = (NLAT + NGW - 1) / NGW; const int r0 = gw * rpw; int r1 = r0 + rpw; if (r1 > NLAT) r1 = NLAT;
    for (int row = r0; row < r1; row += 2) {
        const bool two = row + 1 < r1; const int rowb = two ? row + 1 : row;
        f32x4 va[4], vb[4];
        norm_load_row(F, F.out + (size_t)row * DM, va); norm_load_row(F, F.out + (size_t)rowb * DM, vb);
        float sa = norm_ssq(va), sb = norm_ssq(vb);
#pragma unroll
        for (int o = 1; o < 64; o <<= 1) { sa += __shfl_xor(sa, o); sb += __shfl_xor(sb, o); }
        const float ra = 1.0f / sqrtf(sa * (1.0f / DM) + EPS), rbv = 1.0f / sqrtf(sb * (1.0f / DM) + EPS);
        f32x4* xa = (f32x4*)(F.out + (size_t)row * DM) + F.lane; f32x4* xb = (f32x4*)(F.out + (size_t)rowb * DM) + F.lane;
#pragma unroll
        for (int j = 0; j < 4; ++j) xa[64 * j] = (va[j] * ra) * gv[j];
        if (two) {
#pragma unroll
            for (int j = 0; j < 4; ++j) xb[64 * j] = (vb[j] * rbv) * gv[j]; }
    }
}

DI void conv_unit(Frame& F, int l, int row0, int t0, int slen) {
    const bf16* PX = (const bf16*)(F.ws + WS_P);
    bf16* YC = (bf16*)(F.ws + WS_U);
    LAS float* Y = (LAS float*)F.lds;
    { u32x4 av[6], gv[6];
#pragma unroll
      for (int k = 0; k < 6; ++k) { const int it = F.tid + 512 * k; const int rr = it >> 5, cc = it & 31; const int t = t0 - 15 + rr;
          av[k] = (u32x4){0u, 0u, 0u, 0u}; gv[k] = av[k];
          if (it < 94 * 32 && t >= 0 && t < slen) { const bf16* p = PX + (size_t)(row0 + t) * INW + C_CONV + 8 * cc; av[k] = *(const u32x4*)p; gv[k] = *(const u32x4*)(p + 256); } }
#pragma unroll
      for (int k = 0; k < 6; ++k) { const int it = F.tid + 512 * k; const int rr = it >> 5, cc = it & 31;
          if (it < 94 * 32) { f32x4 o0, o1;
              o0[0] = bflo(av[k].x) * sigmoidf_(bflo(gv[k].x)); o0[1] = bfhi(av[k].x) * sigmoidf_(bfhi(gv[k].x)); o0[2] = bflo(av[k].y) * sigmoidf_(bflo(gv[k].y)); o0[3] = bfhi(av[k].y) * sigmoidf_(bfhi(gv[k].y));
              o1[0] = bflo(av[k].z) * sigmoidf_(bflo(gv[k].z)); o1[1] = bfhi(av[k].z) * sigmoidf_(bfhi(gv[k].z)); o1[2] = bflo(av[k].w) * sigmoidf_(bflo(gv[k].w)); o1[3] = bfhi(av[k].w) * sigmoidf_(bfhi(gv[k].w));
              *(LAS f32x4*)(Y + rr * 256 + 8 * cc) = o0; *(LAS f32x4*)(Y + rr * 256 + 8 * cc + 4) = o1; } } }
    __syncthreads();
    const int c = F.tid & 255, half = F.tid >> 8;
    float w[31];
#pragma unroll
    for (int k = 0; k < 31; ++k) w[k] = F.in[I_CONVW][(size_t)l * 31 * 256 + k * 256 + c];
    float acc[32];
    const float cb = F.in[I_CONVB][l * 256 + c];
#pragma unroll
    for (int o = 0; o < 32; ++o) acc[o] = cb;
#pragma unroll
    for (int kk = 0; kk < 62; ++kk) { const float yv = Y[(32 * half + kk) * 256 + c];
#pragma unroll
        for (int o = 0; o < 32; ++o) { const int tap = kk - o; if (tap >= 0 && tap < 31) acc[o] += yv * w[tap]; } }
    __syncthreads();
#pragma unroll
    for (int o = 0; o < 32; ++o) Y[(32 * half + o) * 256 + c] = acc[o];
    __syncthreads();
    const f32x4 lw = ((const f32x4*)(F.in[I_CLNW] + l * 256))[F.lane], lb = ((const f32x4*)(F.in[I_CLNB] + l * 256))[F.lane];
    for (int i = 0; i < 8; ++i) { const int tl = F.wave * 8 + i; const f32x4 v = *(const LAS f32x4*)(Y + tl * 256 + 4 * F.lane);
        const float mu = wave_sum((v.x + v.y) + (v.z + v.w)) * (1.0f / 256.0f); const f32x4 d = v - mu;
        const float var = wave_sum((d.x * d.x + d.y * d.y) + (d.z * d.z + d.w * d.w)) * (1.0f / 256.0f); const float rstd = 1.0f / sqrtf(var + EPS);
        f32x4 z = d * rstd * lw + lb; z.x *= sigmoidf_(z.x); z.y *= sigmoidf_(z.y); z.z *= sigmoidf_(z.z); z.w *= sigmoidf_(z.w);
        u32x2 o; o.x = pk2(z.x, z.y); o.y = pk2(z.z, z.w);
        *(u32x2*)(YC + (size_t)(row0 + t0 + tl) * DM + 512 + 4 * F.lane) = o; }
    __syncthreads();
}
DI void ret_consts(Frame& F, int l, int hh, float& lg2f, float& lg2b) {
    const float df = F.in[I_RDEC][(l * 2 + 0) * 4 + hh], db = F.in[I_RDEC][(l * 2 + 1) * 4 + hh];
    lg2f = log2f(1.0f - exp2f(-df)); lg2b = log2f(1.0f - exp2f(-db));
}
constexpr int ROPE_LDS = AUX_OFF + 4096;
DI void rope_to_lds(Frame& F) { const float* tab = (const float*)(F.ws + WS_ROPE); LAS float* rt = (LAS float*)(F.lds + ROPE_LDS); for (int i = F.tid; i < 1024; i += 512) rt[i] = tab[i]; __syncthreads(); }
DI void unpack8(const u32x4& a, float (&x)[8]) { x[0] = bflo(a.x); x[1] = bfhi(a.x); x[2] = bflo(a.y); x[3] = bfhi(a.y); x[4] = bflo(a.z); x[5] = bfhi(a.z); x[6] = bflo(a.w); x[7] = bfhi(a.w); }
DI void rope_apply(Frame& F, const u32x4& a, const u32x4& b, int hp, bool lat, int tg, float (&x1)[8], float (&x2)[8]) {
    unpack8(a, x1); unpack8(b, x2);
    if (lat) { const int pos = hp == 0 ? (tg >> 6) : (tg & 63); LAS const f32x4* tab = (LAS const f32x4*)(F.lds + ROPE_LDS) + pos * 4;
#pragma unroll
        for (int jj = 0; jj < 4; ++jj) { const f32x4 cs = tab[jj];
            { const float a1 = x1[2 * jj], a2 = x2[2 * jj]; x1[2 * jj] = a1 * cs[0] - a2 * cs[1]; x2[2 * jj] = a2 * cs[0] + a1 * cs[1]; }
            { const float a1 = x1[2 * jj + 1], a2 = x2[2 * jj + 1]; x1[2 * jj + 1] = a1 * cs[2] - a2 * cs[3]; x2[2 * jj + 1] = a2 * cs[2] + a1 * cs[3]; } } }
}
DI void ret_unit_decode(int su, bool& isctx, int& b, int& hh, int& n) {
    isctx = su >= 1024; if (!isctx) { b = su >> 6; hh = (su >> 4) & 3; n = su & 15; } else { const int v = su - 1024; b = v >> 3; hh = (v >> 1) & 3; n = v & 1; }
}
DI void ret_summary_pair(Frame& F, int l, int it) {
    const bf16* PX = (const bf16*)(F.ws + WS_P);
    const int sub = F.wave >> 2, st = F.tid & 255, su = 2 * it + sub;
    bool isctx; int b, hh, n; ret_unit_decode(su, isctx, b, hh, n);
    const int row0 = isctx ? (b * CTXL + n * 128) : (NCTX + b * SEQ + n * 128);
    float lg2f, lg2b; ret_consts(F, l, hh, lg2f, lg2b);
    LAS unsigned char* base = F.lds + sub * 40960;
    LAS unsigned char* Vimg = base;
    LAS unsigned char* Kf = base + 18432;
    LAS unsigned char* Kb = base + 18432 + 10240;
    { const int tok = st >> 1, hp = st & 1; float x1[8], x2[8];
      const bf16* kp = PX + (size_t)(row0 + tok) * INW + C_RK + 32 * hh; const bf16* vp = PX + (size_t)(row0 + tok) * INW + C_RV + 64 * hh + 32 * hp;
      const u32x4 kra = *(const u32x4*)(kp + 8 * hp), krb = *(const u32x4*)(kp + 16 + 8 * hp);
      u32x4 vr[4];
#pragma unroll
      for (int q = 0; q < 4; ++q) vr[q] = *(const u32x4*)(vp + 8 * q);
      rope_apply(F, kra, krb, hp, !isctx, n * 128 + tok, x1, x2);
      const float ks = 0.17677669529663687f;
      const float wf = fast_exp2(lg2f * (float)(127 - tok)) * ks, wb = fast_exp2(lg2b * (float)tok) * ks;
      u32x4 o;
      o.x = pk2(x1[0] * wf, x1[1] * wf); o.y = pk2(x1[2] * wf, x1[3] * wf); o.z = pk2(x1[4] * wf, x1[5] * wf); o.w = pk2(x1[6] * wf, x1[7] * wf); *(LAS u32x4*)(Kf + tok * 80 + 16 * hp) = o;
      o.x = pk2(x2[0] * wf, x2[1] * wf); o.y = pk2(x2[2] * wf, x2[3] * wf); o.z = pk2(x2[4] * wf, x2[5] * wf); o.w = pk2(x2[6] * wf, x2[7] * wf); *(LAS u32x4*)(Kf + tok * 80 + 32 + 16 * hp) = o;
      o.x = pk2(x1[0] * wb, x1[1] * wb); o.y = pk2(x1[2] * wb, x1[3] * wb); o.z = pk2(x1[4] * wb, x1[5] * wb); o.w = pk2(x1[6] * wb, x1[7] * wb); *(LAS u32x4*)(Kb + tok * 80 + 16 * hp) = o;
      o.x = pk2(x2[0] * wb, x2[1] * wb); o.y = pk2(x2[2] * wb, x2[3] * wb); o.z = pk2(x2[4] * wb, x2[5] * wb); o.w = pk2(x2[6] * wb, x2[7] * wb); *(LAS u32x4*)(Kb + tok * 80 + 32 + 16 * hp) = o;
#pragma unroll
      for (int q = 0; q < 4; ++q) *(LAS u32x4*)(Vimg + tok * 144 + 64 * hp + 16 * q) = vr[q]; }
    __syncthreads();
    { const int role = F.wave & 3, dir = role >> 1, et = role & 1;
      const int l32 = F.lane & 31, h = F.lane >> 5, grp = (F.lane >> 4) & 1, i16 = F.lane & 15, q = i16 >> 2, p = i16 & 3;
      LAS unsigned char* Kimg = dir ? Kb : Kf;
      f32x16 acc;
#pragma unroll
      for (int i = 0; i < 16; ++i) acc[i] = 0.f;
#pragma unroll
      for (int s = 0; s < 8; ++s) { const int r0 = 16 * s + 8 * h + q;
          const s16x4 alo = trread(Vimg + r0 * 144 + (32 * et + 16 * grp + 4 * p) * 2), ahi = trread(Vimg + (r0 + 4) * 144 + (32 * et + 16 * grp + 4 * p) * 2);
          const s16x4 blo = trread(Kimg + r0 * 80 + (16 * grp + 4 * p) * 2), bhi = trread(Kimg + (r0 + 4) * 80 + (16 * grp + 4 * p) * 2);
          const bf16x8 a = __builtin_shufflevector(alo, ahi, 0, 1, 2, 3, 4, 5, 6, 7), bb = __builtin_shufflevector(blo, bhi, 0, 1, 2, 3, 4, 5, 6, 7);
          acc = MFMA32(a, bb, acc); }
      float* S = isctx ? (float*)(F.ws + WS_SUMCTX) + ((size_t)((b * 4 + hh) * 2 + n) * 2 + dir) * 2048 : (float*)(F.ws + WS_SUMLAT) + ((size_t)((b * 4 + hh) * 16 + n) * 2 + dir) * 2048;
#pragma unroll
      for (int i = 0; i < 16; ++i) S[(32 * et + crow(i, h)) * 32 + l32] = acc[i]; }
    __syncthreads();
}
DI void ca_phase(Frame& F, int l) {
    rope_to_lds(F);
    const int nconv = l == 0 ? 576 : 512;
    for (int u = F.vb; u < nconv; u += F.G) {
        int v = u; if (l != 0) v += 64;
        if (v < 64) conv_unit(F, l, (v >> 2) * CTXL, (v & 3) * 64, CTXL);
        else { v -= 64; conv_unit(F, l, NCTX + (v >> 5) * SEQ, (v & 31) * 64, SEQ); }
    }
    for (int it = F.vb; it < 576; it += F.G) ret_summary_pair(F, l, it);
}

constexpr int ATT_KV = 18432, ATT_BUF = 2 * ATT_KV, ATT_BT = 2 * ATT_BUF, ATT_NEG = 640;
struct AttRegs { u32x4 k0, v0, k1, v1; };
DI void attn_fetch(const bf16* PX, int rowA, int rowB, unsigned loff, AttRegs& R) {
    const char* pa = (const char*)(PX + (size_t)rowA * INW) + loff; const char* pb = (const char*)(PX + (size_t)rowB * INW) + loff;
    R.k0 = *(const u32x4*)(pa + C_NAK * 2); R.v0 = *(const u32x4*)(pa + C_NAV * 2); R.k1 = *(const u32x4*)(pb + C_NAK * 2); R.v1 = *(const u32x4*)(pb + C_NAV * 2);
}
DI void attn_put(Frame& F, LAS unsigned char* buf, const AttRegs& R) {
    const int key = F.tid >> 3, ch = F.tid & 7;
    *(LAS u32x4*)(buf + key * 144 + 16 * ch) = R.k0; *(LAS u32x4*)(buf + ATT_KV + key * 144 + 16 * ch) = R.v0;
    *(LAS u32x4*)(buf + (64 + key) * 144 + 16 * ch) = R.k1; *(LAS u32x4*)(buf + ATT_KV + (64 + key) * 144 + 16 * ch) = R.v1;
}
template <bool BIAS, int NT>
DI void attn_tiles(LAS const unsigned char* buf, const int (&koff)[2], const bf16x8 (&qf)[4], f32x16& o0, f32x16& o1, f32x16& o2, float& mrun, int lane,
                   LAS const float* const (&bt)[2]  , const float (&pen)[16]) {
    LAS const unsigned char* Kimg = buf; LAS const unsigned char* Vimg = buf + ATT_KV;
    const int l32 = lane & 31, h = lane >> 5, grp = (lane >> 4) & 1, i16 = lane & 15, q = i16 >> 2, p = i16 & 3;
    f32x16 s[NT];
#pragma unroll
    for (int t = 0; t < NT; ++t)
#pragma unroll
        for (int i = 0; i < 16; ++i) s[t][i] = 0.f;
#pragma unroll
    for (int si = 0; si < 4; ++si)
#pragma unroll
        for (int t = 0; t < NT; ++t) { const bf16x8 a = *(const LAS bf16x8*)(Kimg + (koff[t] + l32) * 144 + (16 * si + 8 * h) * 2); s[t] = MFMA32(a, qf[si], s[t]); }
    const float c = 0.125f * LOG2E;
    float v[NT][16]; float mx = -1.0e30f;
#pragma unroll
    for (int t = 0; t < NT; ++t)
#pragma unroll
        for (int i = 0; i < 16; ++i) { float x;
            if (BIAS) x = __builtin_fmaf(s[t][i], c, bt[t][(i & 3) + 8 * (i >> 2)]) + pen[i]; else x = s[t][i];
            v[t][i] = x; mx = fmaxf(mx, x); }
    if (!BIAS) mx *= c;
    mx = fmaxf(mx, __shfl_xor(mx, 32));
    const float mnew = fmaxf(mrun, mx);
    const float alpha = fast_exp2(mrun - mnew);
    if (__any(alpha != 1.0f)) {
#pragma unroll
        for (int i = 0; i < 16; ++i) { o0[i] *= alpha; o1[i] *= alpha; o2[i] *= alpha; } }
    mrun = mnew;
    bf16x8 pf[NT][2];
#pragma unroll
    for (int t = 0; t < NT; ++t) { float pp[16];
#pragma unroll
        for (int i = 0; i < 16; ++i) pp[i] = BIAS ? fast_exp2(v[t][i] - mnew) : fast_exp2(__builtin_fmaf(v[t][i], c, -mnew));
#pragma unroll
        for (int s2 = 0; s2 < 2; ++s2) { u32x4 w; w.x = pk2(pp[8 * s2], pp[8 * s2 + 1]); w.y = pk2(pp[8 * s2 + 2], pp[8 * s2 + 3]); w.z = pk2(pp[8 * s2 + 4], pp[8 * s2 + 5]); w.w = pk2(pp[8 * s2 + 6], pp[8 * s2 + 7]); pf[t][s2] = __builtin_bit_cast(bf16x8, w); } }
    const u32x4 onesw = (u32x4){0x3f803f80u, 0x3f803f80u, 0x3f803f80u, 0x3f803f80u}; const bf16x8 ones = __builtin_bit_cast(bf16x8, onesw);
#pragma unroll
    for (int t = 0; t < NT; ++t)
#pragma unroll
        for (int s2 = 0; s2 < 2; ++s2) { const int r0 = koff[t] + 16 * s2 + 4 * h + q;
#pragma unroll
            for (int et = 0; et < 2; ++et) { const int cb = (32 * et + 16 * grp + 4 * p) * 2;
                const s16x4 lo = trread(Vimg + r0 * 144 + cb), hi = trread(Vimg + (r0 + 8) * 144 + cb);
                const bf16x8 a = __builtin_shufflevector(lo, hi, 0, 1, 2, 3, 4, 5, 6, 7);
                if (et == 0) o0 = MFMA32(a, pf[t][s2], o0); else o1 = MFMA32(a, pf[t][s2], o1); }
            o2 = MFMA32(ones, pf[t][s2], o2); }
}
DI void attn_unit(Frame& F, int l, bool na, int b, int hh, int rg) {
    const bf16* PX = (const bf16*)(F.ws + WS_P);
    bf16* YC = (bf16*)(F.ws + WS_U);
    LAS float* btab = (LAS float*)(F.lds + ATT_BT);
    const int l32 = F.lane & 31, h = F.lane >> 5;
    int qrow, r = 0, qcol = 0, kc0 = 0, ra = 0;
    float pen[16];
#pragma unroll
    for (int i = 0; i < 16; ++i) pen[i] = 0.f;
    if (na) { const int rp = F.wave >> 2, n = F.wave & 3; ra = 4 * rg + 2 * rp; r = ra + (l32 >> 4); qcol = 16 * n + (l32 & 15); qrow = NCTX + b * SEQ + r * GW + qcol;
        int w0 = qcol - 8; w0 = w0 < 0 ? 0 : (w0 > 48 ? 48 : w0); kc0 = 16 * n - 8; kc0 = kc0 < 0 ? 0 : (kc0 > 32 ? 32 : kc0);
#pragma unroll
        for (int i = 0; i < 16; ++i) pen[i] = ((unsigned)(kc0 + crow(i, h) - w0) < 16u) ? 0.f : -1.0e30f; }
    else qrow = b * CTXL + 32 * F.wave + l32;
    bf16x8 qf[4];
#pragma unroll
    for (int si = 0; si < 4; ++si) qf[si] = *(const bf16x8*)(PX + (size_t)qrow * INW + C_NAQ + 64 * hh + 16 * si + 8 * h);
    if (na) { for (int idx = F.tid; idx < ATT_NEG + 128; idx += 512) { float v = 0.f; if (idx >= 48 && idx < 48 + 465) v = F.in[I_RPB][((size_t)l * 8 + hh) * 465 + (idx - 48)] * LOG2E; if (idx >= ATT_NEG) v = -1.0e30f; btab[idx] = v; } }
    f32x16 o0, o1, o2;
#pragma unroll
    for (int i = 0; i < 16; ++i) { o0[i] = 0.f; o1[i] = 0.f; o2[i] = 0.f; }
    float mrun = -1.0e30f;
    int ylo = 0, yhi = 0, nsteps = 2;
    if (na) { const int rlo = 4 * rg, rhi = 4 * rg + 3;
        ylo = rlo - 4; ylo = ylo < 0 ? 0 : (ylo > 24 ? 24 : ylo);
        yhi = rhi - 4; yhi = yhi < 0 ? 0 : (yhi > 24 ? 24 : yhi); yhi += 8; nsteps = 2 + (yhi - ylo + 1) / 2; }
    int sa = ra - 4; sa = sa < 0 ? 0 : (sa > 24 ? 24 : sa);
    int sb = ra + 1 - 4; sb = sb < 0 ? 0 : (sb > 24 ? 24 : sb);
    const int mylo = (l32 >> 4) ? sb : sa;
    const int cbase = kc0 + 4 * h - qcol + 15;
#define ATT_ROWA(sx) ((sx) < 2 ? b * CTXL + 128 * (sx) : NCTX + b * SEQ + (ylo + 2 * ((sx) - 2)) * GW)
#define ATT_ROWB(sx) ((sx) < 2 ? b * CTXL + 128 * (sx) + 64 : NCTX + b * SEQ + ((ylo + 2 * ((sx) - 2) + 1) < yhi ? (ylo + 2 * ((sx) - 2) + 1) : (yhi - 1)) * GW)
    AttRegs R;
    unsigned loff = (unsigned)(((F.tid >> 3) * INW + 64 * hh + 8 * (F.tid & 7)) * 2); asm volatile("" : "+v"(loff));
    attn_fetch(PX, ATT_ROWA(0), ATT_ROWB(0), loff, R);
    for (int st = 0; st < nsteps; ++st) {
        LAS unsigned char* buf = F.lds + (st & 1) * ATT_BUF;
        attn_put(F, buf, R);
        if (st + 1 < nsteps) attn_fetch(PX, ATT_ROWA(st + 1), ATT_ROWB(st + 1), loff, R);
        __syncthreads();
        if (st < 2) {
            LAS const float* const bt[2] = {btab, btab};
            { const int ko[2] = {0, 32}; attn_tiles<false, 2>(buf, ko, qf, o0, o1, o2, mrun, F.lane, bt, pen); }
            { const int ko[2] = {64, 96}; attn_tiles<false, 2>(buf, ko, qf, o0, o1, o2, mrun, F.lane, bt, pen); }
        } else {
            const int y0 = ylo + 2 * (st - 2), y1 = y0 + 1;
            const bool act0 = (y0 >= sa && y0 < sb + 8), act1 = (y1 < yhi && y1 >= sa && y1 < sb + 8);
            const bool ok0 = (unsigned)(y0 - mylo) < 8u, ok1 = (unsigned)(y1 - mylo) < 8u;
            LAS const float* b0 = btab + (ok0 ? 48 + (y0 - r + 7) * 31 + cbase : ATT_NEG);
            LAS const float* b1 = btab + (ok1 ? 48 + (y1 - r + 7) * 31 + cbase : ATT_NEG);
            if (act0 && act1) { const int ko[2] = {kc0, 64 + kc0}; LAS const float* const bt[2] = {b0, b1}; attn_tiles<true, 2>(buf, ko, qf, o0, o1, o2, mrun, F.lane, bt, pen); }
            else if (act0) { const int ko[2] = {kc0, kc0}; LAS const float* const bt[2] = {b0, b0}; attn_tiles<true, 1>(buf, ko, qf, o0, o1, o2, mrun, F.lane, bt, pen); }
            else if (act1) { const int ko[2] = {64 + kc0, 64 + kc0}; LAS const float* const bt[2] = {b1, b1}; attn_tiles<true, 1>(buf, ko, qf, o0, o1, o2, mrun, F.lane, bt, pen); }
        }
    }
#undef ATT_ROWA
#undef ATT_ROWB
    const float inv = 1.0f / o2[0];
    bf16* orow = YC + (size_t)qrow * DM + 64 * hh;
#pragma unroll
    for (int gq = 0; gq < 4; ++gq) { u32x2 w;
        w.x = pk2(o0[4 * gq] * inv, o0[4 * gq + 1] * inv); w.y = pk2(o0[4 * gq + 2] * inv, o0[4 * gq + 3] * inv); *(u32x2*)(orow + 8 * gq + 4 * h) = w;
        w.x = pk2(o1[4 * gq] * inv, o1[4 * gq + 1] * inv); w.y = pk2(o1[4 * gq + 2] * inv, o1[4 * gq + 3] * inv); *(u32x2*)(orow + 32 + 8 * gq + 4 * h) = w; }
    __syncthreads();
}
DI void ret_out_unit(Frame& F, int l, int su) {
    const bf16* PX = (const bf16*)(F.ws + WS_P);
    bf16* YC = (bf16*)(F.ws + WS_U);
    bool isctx; int b, hh, n; ret_unit_decode(su, isctx, b, hh, n);
    const int row0 = isctx ? (b * CTXL + n * 128) : (NCTX + b * SEQ + n * 128);
    float lg2f, lg2b; ret_consts(F, l, hh, lg2f, lg2b);
    LAS unsigned char* Kimg = F.lds;
    LAS unsigned char* Vimg = F.lds + 10240;
    LAS unsigned char* Stf = F.lds + 28672;
    LAS unsigned char* Stb = F.lds + 33792;
    LAS float* Ob = (LAS float*)(F.lds + 38912);
    const int dir = F.wave >> 2, qb = F.wave & 3, l32 = F.lane & 31, h = F.lane >> 5, grp = (F.lane >> 4) & 1, i16 = F.lane & 15, q = i16 >> 2, p = i16 & 3;
    const int iq = 32 * qb + l32;
    const int ktok = (F.tid & 255) >> 1, khp = F.tid & 1;
    const bf16* kp = PX + (size_t)(row0 + ktok) * INW + C_RK + 32 * hh;
    const u32x4 kra = *(const u32x4*)(kp + 8 * khp), krb = *(const u32x4*)(kp + 16 + 8 * khp);
    const int vtok = F.tid >> 2, vch = F.tid & 3; const bf16* vp = PX + (size_t)(row0 + vtok) * INW + C_RV + 64 * hh + 16 * vch;
    const u32x4 vra = *(const u32x4*)vp, vrb = *(const u32x4*)(vp + 8);
    const bf16* qp = PX + (size_t)(row0 + iq) * INW + C_RQ + 32 * hh;
    const u32x4 qra = *(const u32x4*)(qp + 8 * h), qrb = *(const u32x4*)(qp + 16 + 8 * h);
    const bf16* gp = PX + (size_t)(row0 + iq) * INW + (dir ? C_GB : C_GF) + 64 * hh;
    u32x2 gg[8];
#pragma unroll
    for (int et = 0; et < 2; ++et)
#pragma unroll
        for (int gq = 0; gq < 4; ++gq) gg[et * 4 + gq] = *(const u32x2*)(gp + 32 * et + 8 * gq + 4 * h);
    const float cf = fast_exp2(lg2f * 128.0f), cb = fast_exp2(lg2b * 128.0f);
    const float* SC = (const float*)(F.ws + WS_SUMCTX) + (size_t)((b * 4 + hh) * 2) * 2 * 2048;
    const float* SL = (const float*)(F.ws + WS_SUMLAT) + (size_t)((b * 4 + hh) * 16) * 2 * 2048;
    f32x4 sf = (f32x4){0.f, 0.f, 0.f, 0.f}, sb = sf; const int eo = 4 * F.tid;
    if (!isctx) {
        f32x4 t[16];
#pragma unroll
        for (int m = 0; m < 16; ++m) t[m] = *(const f32x4*)(SL + (size_t)(m * 2 + (m <= n ? 0 : 1)) * 2048 + eo);
        const f32x4 c00 = *(const f32x4*)(SC + (0 * 2 + 0) * 2048 + eo), c10 = *(const f32x4*)(SC + (1 * 2 + 0) * 2048 + eo);
        const f32x4 c11 = *(const f32x4*)(SC + (1 * 2 + 1) * 2048 + eo), c01 = *(const f32x4*)(SC + (0 * 2 + 1) * 2048 + eo);
        sf = c00 * cf + c10;
#pragma unroll
        for (int m = 0; m < 16; ++m) { const f32x4 nv = sf * cf + t[m]; sf = (m < n) ? nv : sf; }
        sb = c11 * cb + c01;
#pragma unroll
        for (int m = 15; m >= 0; --m) { const f32x4 nv = sb * cb + t[m]; sb = (m > n) ? nv : sb; }
    } else {
        if (n == 1) sf = *(const f32x4*)(SC + (0 * 2 + 0) * 2048 + eo);
        if (n == 0) sb = *(const f32x4*)(SC + (1 * 2 + 1) * 2048 + eo);
    }
    if (F.tid < 256) { float x1[8], x2[8]; rope_apply(F, kra, krb, khp, !isctx, n * 128 + ktok, x1, x2);
        const float ks = 0.17677669529663687f; u32x4 o;
        o.x = pk2(x1[0] * ks, x1[1] * ks); o.y = pk2(x1[2] * ks, x1[3] * ks); o.z = pk2(x1[4] * ks, x1[5] * ks); o.w = pk2(x1[6] * ks, x1[7] * ks); *(LAS u32x4*)(Kimg + ktok * 80 + 16 * khp) = o;
        o.x = pk2(x2[0] * ks, x2[1] * ks); o.y = pk2(x2[2] * ks, x2[3] * ks); o.z = pk2(x2[4] * ks, x2[5] * ks); o.w = pk2(x2[6] * ks, x2[7] * ks); *(LAS u32x4*)(Kimg + ktok * 80 + 32 + 16 * khp) = o; }
    *(LAS u32x4*)(Vimg + vtok * 144 + 32 * vch) = vra; *(LAS u32x4*)(Vimg + vtok * 144 + 32 * vch + 16) = vrb;
    { const int e = eo >> 5, d = eo & 31; u32x2 w;
      w.x = pk2(sf[0], sf[1]); w.y = pk2(sf[2], sf[3]); *(LAS u32x2*)(Stf + e * 80 + d * 2) = w;
      w.x = pk2(sb[0], sb[1]); w.y = pk2(sb[2], sb[3]); *(LAS u32x2*)(Stb + e * 80 + d * 2) = w; }
    bf16x8 qf[2], qd[2];
    { float x1[8], x2[8]; rope_apply(F, qra, qrb, h, !isctx, n * 128 + iq, x1, x2);
      const float dec = dir == 0 ? fast_exp2(lg2f * (float)(iq + 1)) : fast_exp2(lg2b * (float)(128 - iq));
      u32x4 w;
      w.x = pk2(x1[0], x1[1]); w.y = pk2(x1[2], x1[3]); w.z = pk2(x1[4], x1[5]); w.w = pk2(x1[6], x1[7]); qf[0] = __builtin_bit_cast(bf16x8, w);
      w.x = pk2(x2[0], x2[1]); w.y = pk2(x2[2], x2[3]); w.z = pk2(x2[4], x2[5]); w.w = pk2(x2[6], x2[7]); qf[1] = __builtin_bit_cast(bf16x8, w);
      w.x = pk2(x1[0] * dec, x1[1] * dec); w.y = pk2(x1[2] * dec, x1[3] * dec); w.z = pk2(x1[4] * dec, x1[5] * dec); w.w = pk2(x1[6] * dec, x1[7] * dec); qd[0] = __builtin_bit_cast(bf16x8, w);
      w.x = pk2(x2[0] * dec, x2[1] * dec); w.y = pk2(x2[2] * dec, x2[3] * dec); w.z = pk2(x2[4] * dec, x2[5] * dec); w.w = pk2(x2[6] * dec, x2[7] * dec); qd[1] = __builtin_bit_cast(bf16x8, w); }
    __syncthreads();
    f32x16 o0, o1;
#pragma unroll
    for (int i = 0; i < 16; ++i) { o0[i] = 0.f; o1[i] = 0.f; }
    { LAS const unsigned char* St = dir ? Stb : Stf;
#pragma unroll
      for (int s = 0; s < 2; ++s) { const bf16x8 a0 = *(const LAS bf16x8*)(St + l32 * 80 + (16 * s + 8 * h) * 2), a1 = *(const LAS bf16x8*)(St + (32 + l32) * 80 + (16 * s + 8 * h) * 2);
          o0 = MFMA32(a0, qd[s], o0); o1 = MFMA32(a1, qd[s], o1); } }
    const float lgd = dir ? lg2b : lg2f;
    const int kt_lo = dir ? qb : 0, kt_hi = dir ? 3 : qb;
    for (int kt = kt_lo; kt <= kt_hi; ++kt) {
        f32x16 s;
#pragma unroll
        for (int i = 0; i < 16; ++i) s[i] = 0.f;
#pragma unroll
        for (int si = 0; si < 2; ++si) { const bf16x8 a = *(const LAS bf16x8*)(Kimg + (32 * kt + l32) * 80 + (16 * si + 8 * h) * 2); s = MFMA32(a, qf[si], s); }
        float pp[16];
#pragma unroll
        for (int i = 0; i < 16; ++i) { const int j = 32 * kt + crow(i, h); const int diff = dir ? (j - iq) : (iq - j); pp[i] = diff >= 0 ? s[i] * fast_exp2(lgd * (float)diff) : 0.f; }
        bf16x8 pf[2];
#pragma unroll
        for (int s2 = 0; s2 < 2; ++s2) { u32x4 w; w.x = pk2(pp[8 * s2], pp[8 * s2 + 1]); w.y = pk2(pp[8 * s2 + 2], pp[8 * s2 + 3]); w.z = pk2(pp[8 * s2 + 4], pp[8 * s2 + 5]); w.w = pk2(pp[8 * s2 + 6], pp[8 * s2 + 7]); pf[s2] = __builtin_bit_cast(bf16x8, w); }
#pragma unroll
        for (int s2 = 0; s2 < 2; ++s2) { const int r0 = 32 * kt + 16 * s2 + 4 * h + q;
#pragma unroll
            for (int et = 0; et < 2; ++et) { const int cb = (32 * et + 16 * grp + 4 * p) * 2;
                const s16x4 lo = trread(Vimg + r0 * 144 + cb), hi = trread(Vimg + (r0 + 8) * 144 + cb);
                const bf16x8 a = __builtin_shufflevector(lo, hi, 0, 1, 2, 3, 4, 5, 6, 7);
                if (et == 0) o0 = MFMA32(a, pf[s2], o0); else o1 = MFMA32(a, pf[s2], o1); } }
    }
    float sm = 0.f;
#pragma unroll
    for (int i = 0; i < 16; ++i) sm += o0[i] + o1[i];
    sm += __shfl_xor(sm, 32);
    const float mu = sm * (1.0f / 64.0f);
    float vs = 0.f;
#pragma unroll
    for (int i = 0; i < 16; ++i) { const float d0 = o0[i] - mu, d1 = o1[i] - mu; vs += d0 * d0 + d1 * d1; }
    vs += __shfl_xor(vs, 32);
    const float rstd = 1.0f / sqrtf(vs * (1.0f / 64.0f) + EPS);
    const float* gn = F.in[I_RGNW] + l * 256 + 64 * hh;
    float val[32];
#pragma unroll
    for (int et = 0; et < 2; ++et)
#pragma unroll
        for (int gq = 0; gq < 4; ++gq) { const int e0 = 32 * et + 8 * gq + 4 * h; const u32x2 ggv = gg[et * 4 + gq]; const f32x4 gw = *(const f32x4*)(gn + e0);
            const float g0 = bflo(ggv.x), g1 = bfhi(ggv.x), g2 = bflo(ggv.y), g3 = bfhi(ggv.y);
            const float a0 = et ? o1[4 * gq] : o0[4 * gq], a1 = et ? o1[4 * gq + 1] : o0[4 * gq + 1], a2 = et ? o1[4 * gq + 2] : o0[4 * gq + 2], a3 = et ? o1[4 * gq + 3] : o0[4 * gq + 3];
            val[et * 16 + 4 * gq] = (a0 - mu) * rstd * gw[0] * g0 * sigmoidf_(g0); val[et * 16 + 4 * gq + 1] = (a1 - mu) * rstd * gw[1] * g1 * sigmoidf_(g1);
            val[et * 16 + 4 * gq + 2] = (a2 - mu) * rstd * gw[2] * g2 * sigmoidf_(g2); val[et * 16 + 4 * gq + 3] = (a3 - mu) * rstd * gw[3] * g3 * sigmoidf_(g3); }
    if (dir == 0) {
#pragma unroll
        for (int et = 0; et < 2; ++et)
#pragma unroll
            for (int gq = 0; gq < 4; ++gq)
#pragma unroll
                for (int j = 0; j < 4; ++j) Ob[iq * 65 + 32 * et + 8 * gq + 4 * h + j] = val[et * 16 + 4 * gq + j];
    }
    __syncthreads();
    if (dir == 1) { bf16* orow = YC + (size_t)(row0 + iq) * DM + 768 + 64 * hh;
#pragma unroll
        for (int et = 0; et < 2; ++et)
#pragma unroll
            for (int gq = 0; gq < 4; ++gq) { const int e0 = 32 * et + 8 * gq + 4 * h; float t[4];
#pragma unroll
                for (int j = 0; j < 4; ++j) t[j] = val[et * 16 + 4 * gq + j] + Ob[iq * 65 + e0 + j];
                u32x2 w; w.x = pk2(t[0], t[1]); w.y = pk2(t[2], t[3]); *(u32x2*)(orow + e0) = w; } }
    __syncthreads();
}
#ifndef PROBE_SUB
#define PROBE_SUB 0
#endif
DI void cb_phase(Frame& F, int l) {
    rope_to_lds(F);
    const int nattn = l == 0 ? 1152 : 1024;
    for (int rep = 0; rep < ((PROBE_SUB & 1) ? 2 : 1); ++rep)
    for (int u = F.vb; u < nattn; u += F.G) {
        if (u < 1024) attn_unit(F, l, true, u >> 6, (u >> 3) & 7, u & 7);
        else { const int v = u - 1024; attn_unit(F, l, false, v >> 3, v & 7, 0); }
    }
    const int nret = l == 0 ? 1152 : 1024;
    for (int rep = 0; rep < ((PROBE_SUB & 2) ? 2 : 1); ++rep)
    for (int u = F.vb; u < nret; u += F.G) ret_out_unit(F, l, u);
}

static_assert(sizeof(Params) == 240, "kernarg layout: in[26] at 0, out at 208, ws at 216, ph_lo at 224, ph_hi at 228");
__global__ void __launch_bounds__(512, 2) fwd_kernel(Params prm) {
    extern __shared__ __attribute__((aligned(16))) unsigned char lds_raw[];
    Frame F;
    F.lds = (LAS unsigned char*)lds_raw;
    F.tid = threadIdx.x; F.lane = F.tid & 63; F.wave = __builtin_amdgcn_readfirstlane(F.tid >> 6);
    F.G = gridDim.x; F.bid = blockIdx.x; F.vb = F.bid;
    F.in.ka = (karg_t)__builtin_amdgcn_kernarg_segment_ptr(); F.out = prm.out; F.ws = prm.ws;
    volatile LAS unsigned* MISC = (volatile LAS unsigned*)(F.lds + AUX_OFF);
    if (F.tid < 64) MISC[F.tid] = 0u;
    __syncthreads();
    XcdBarrier bar; bar.bar = (unsigned*)(prm.ws + WS_CTL) + 1024; bar.x = 0; bar.st = nullptr;
    const int lo = prm.ph_lo, hi = prm.ph_hi;
    if (hi - lo > 1) bar = xcd_barrier_post((unsigned*)(prm.ws + WS_CTL) + 1024, MISC + 8);
#ifdef ONLY_PHASE
#define IN(k) ((k) == ONLY_PHASE && lo <= (k) && (k) < hi)
#else
#define IN(k) (lo <= (k) && (k) < hi)
#endif
#ifndef PROBE_MASK
#define PROBE_MASK 0u
#endif
#define NREP(k) (((PROBE_MASK >> (k)) & 1u) ? 2 : 1)
#define SEAM(k) do { if (IN(k) && IN((k) + 1)) { XcdBarrier bb_ = bar; asm volatile("" : "+s"(bb_.bar)); xcd_barrier(bb_); } } while (0)
#define GLDS(P) ((LAS unsigned char*)(P).lds)
#define WSB(P, off) ((const pg8::bf16_t*)((P).ws + (off)))

    if (IN(0)) for (int rep_ = 0; rep_ < NREP(0); ++rep_) { if (rep_) __syncthreads(); Frame P = phase_frame(F); p0_prologue(P); } SEAM(0);
#pragma unroll 1
    for (int l = 0; l < 2; ++l) {
        const int pb = l == 0 ? 1 : 9;
        if (IN(pb + 0)) for (int rep_ = 0; rep_ < NREP(pb + 0); ++rep_) { if (rep_) __syncthreads(); Frame P = phase_frame(F); norm_phase(P, l, 1, l == 0, 0); } SEAM(pb + 0);
        if (IN(pb + 1)) for (int rep_ = 0; rep_ < NREP(pb + 1); ++rep_) { if (rep_) __syncthreads();
            Frame P = phase_frame(F);
            pg8::StaticOrder S; S.init(NTOK, INW, P.G, P.bid);
            pg8::EpiStoreBf16 E{(pg8::bf16_t*)(P.ws + WS_P), INW};
            pg8::gemm_phase<pg8::EpiStoreBf16, pg8::StaticOrder, pg8::RowsLinear, true>(GLDS(P), P.tid, WSB(P, WS_U), WSB(P, WS_WIN) + (size_t)l * INW * DM, 2 * DM, S, E, pg8::RowsLinear{});
            if (l == 0) bg_convert_tail(P, S.nwg, BG_B0, BG_D0); else bg_convert_tail(P, S.nwg, BG_B1, BG_CL);
        } SEAM(pb + 1);
        if (IN(pb + 2)) for (int rep_ = 0; rep_ < NREP(pb + 2); ++rep_) { if (rep_) __syncthreads(); Frame P = phase_frame(F); if (l == 1) { bg_convert_all(P, BG_CL, BG_ITEMS); __syncthreads(); } ca_phase(P, l); } SEAM(pb + 2);
        if (IN(pb + 3)) for (int rep_ = 0; rep_ < NREP(pb + 3); ++rep_) { if (rep_) __syncthreads(); Frame P = phase_frame(F); cb_phase(P, l); } SEAM(pb + 3);
        if (IN(pb + 4)) {
            Frame P = phase_frame(F);
            const int rb = l == 0 ? 0 : NCTX;
            const float* modlat = (const float*)(P.ws + WS_MODLAT) + (size_t)l * 16 * 6144;
            const float* modctx = (const float*)(P.ws + WS_MODCTX) + (size_t)l * 6144;
            float* hctx = (float*)(P.ws + WS_HCTX);
            pg8::StaticOrder S; S.init(NTOK - rb, DM, P.G, P.bid);
            pg8::EpiResGate E{l == 0 ? P.in[I_CTX] : hctx, l == 0 ? P.in[I_X] : P.out, hctx, P.out, modlat + 2 * DM, modctx + 2 * DM, rb};
            pg8::gemm_phase<pg8::EpiResGate, pg8::StaticOrder, pg8::RowsLinear, true>(GLDS(P), P.tid, WSB(P, WS_U) + (size_t)rb * DM, WSB(P, WS_WOUT) + (size_t)l * DM * DM, 2 * DM, S, E, pg8::RowsLinear{});
            if (l == 0) bg_convert_tail(P, S.nwg, BG_D0, BG_E0);
        } SEAM(pb + 4);
        if (l == 0) {
            if (IN(6)) for (int rep_ = 0; rep_ < NREP(6); ++rep_) { if (rep_) __syncthreads(); Frame P = phase_frame(F); norm_phase(P, 0, 2, false, 0, DENSE_FP8 == 1); } SEAM(6);
            if (IN(7)) for (int rep_ = 0; rep_ < NREP(7); ++rep_) { if (rep_) __syncthreads();
                Frame P = phase_frame(F);
                pg8::StaticOrder S; S.init(NTOK, 2 * DFF, P.G, P.bid);
                pg8::EpiSwiglu<false> E{(pg8::bf16_t*)(P.ws + WS_P), DFF, 0, nullptr};
#if DENSE_FP8 == 1
                pg8::gemm_phase<pg8::EpiSwiglu<false>, pg8::StaticOrder, pg8::RowsLinearOff, true, true>(GLDS(P), P.tid, WSB(P, WS_U), WSB(P, WS_WGU), DM, S, E, pg8::RowsLinearOff{}, SCL_U, SCL_WGU);
#else
                pg8::gemm_phase<pg8::EpiSwiglu<false>, pg8::StaticOrder, pg8::RowsLinear, true>(GLDS(P), P.tid, WSB(P, WS_U), WSB(P, WS_WGU), 2 * DM, S, E, pg8::RowsLinear{});
#endif
                bg_convert_tail(P, S.nwg, BG_E0, BG_F0);
            } SEAM(7);
            if (IN(8)) {
                Frame P = phase_frame(F);
                const float* modlat = (const float*)(P.ws + WS_MODLAT);
                const float* modctx = (const float*)(P.ws + WS_MODCTX);
                float* hctx = (float*)(P.ws + WS_HCTX);
                pg8::StaticOrder S; S.init(NTOK, DM, P.G, P.bid);
                pg8::EpiResGate E{hctx, P.out, hctx, P.out, modlat + 5 * DM, modctx + 5 * DM, 0};
#if DENSE_FP8
                pg8::gemm_phase<pg8::EpiResGate, pg8::StaticOrder, pg8::RowsLinearOff, true, true>(GLDS(P), P.tid, WSB(P, WS_P), WSB(P, WS_WD), DFF, S, E, pg8::RowsLinearOff{}, SCL_H, SCL_WD);
#else
                pg8::gemm_phase<pg8::EpiResGate, pg8::StaticOrder, pg8::RowsLinear, true>(GLDS(P), P.tid, WSB(P, WS_P), WSB(P, WS_WD), 2 * DFF, S, E, pg8::RowsLinear{});
#endif
                bg_convert_tail(P, S.nwg, BG_F0, BG_B1);
            } SEAM(8);
        } else {
            if (IN(14)) for (int rep_ = 0; rep_ < NREP(14); ++rep_) { if (rep_) __syncthreads(); Frame P = phase_frame(F); norm_moe_phase(P); } SEAM(14);
            if (IN(15)) for (int rep_ = 0; rep_ < NREP(15); ++rep_) { if (rep_) __syncthreads(); Frame P = phase_frame(F); moe_route_phase(P); } SEAM(15);
            LAS int* texp = (LAS int*)(F.lds + AUX_TAB);
            if (IN(16) || IN(17) || IN(18)) {
                Frame P = phase_frame(F);
                const int* meta = (const int*)(P.ws + WS_META);
                __syncthreads();
                for (int i = P.tid; i < 2 * MOE_TILES; i += 512) texp[i] = ld_i32_coherent(meta + (i / MOE_TILES) * 256 + 1 + (i % MOE_TILES));
                if (P.tid < 2) texp[2 * MOE_TILES + P.tid] = ld_i32_coherent(meta + P.tid * 256);
                __syncthreads();
            }
            if (IN(16)) for (int rep_ = 0; rep_ < NREP(16); ++rep_) { if (rep_) __syncthreads();
                Frame P = phase_frame(F);
                const int NT0 = __builtin_amdgcn_readfirstlane(texp[2 * MOE_TILES]), NT1 = __builtin_amdgcn_readfirstlane(texp[2 * MOE_TILES + 1]);
                pg8::MoeOrder S{NT0, NT1, 28, P.G, P.bid, (const LAS int*)texp};
                pg8::EpiSwiglu<true> E{(pg8::bf16_t*)(P.ws + WS_P), DFE, 28, (const float*)(P.ws + WS_PROW)};
                pg8::gemm_phase<pg8::EpiSwiglu<true>, pg8::MoeOrder, pg8::RowsGather, true, true>(GLDS(P), P.tid, WSB(P, WS_U), WSB(P, WS_MGU), DM, S, E, pg8::RowsGather{(const int*)(P.ws + WS_ROWMAP), 0}, SCL_U, SCL_WGU);
            } SEAM(16);
#pragma unroll 1
            for (int s = 0; s < 2; ++s) {
                if (IN(17 + s)) {
                    Frame P = phase_frame(F);
                    const int* rowmap = (const int*)(P.ws + WS_ROWMAP) + (size_t)s * MOE_ROWS;
                    const float* modlat = (const float*)(P.ws + WS_MODLAT) + (size_t)16 * 6144;
                    const int NT = __builtin_amdgcn_readfirstlane(texp[2 * MOE_TILES + s]);
                    pg8::MoeOrder S{NT, 0, 4, P.G, P.bid, (const LAS int*)(texp + s * MOE_TILES)};
                    pg8::EpiMoeScatter E{rowmap, P.out, modlat + 5 * DM, 4};
                    pg8::gemm_phase<pg8::EpiMoeScatter, pg8::MoeOrder, pg8::RowsLinearOff, true, true>(GLDS(P), P.tid, P.ws + WS_P + (size_t)s * MOE_ROWS * DFE, WSB(P, WS_MD), DFE, S, E, pg8::RowsLinearOff{}, SCL_H, SCL_WD);
                } SEAM(17 + s);
            }
        }
    }
    if (IN(PH_FINAL)) { Frame P = phase_frame(F); final_phase(P); }
#undef IN
#undef SEAM
}

extern "C" void kernel_launch(void* const* d_in, const int* in_sizes, int n_in, void* d_out, int out_size, void* d_ws, size_t ws_size, hipStream_t stream) {
    static int grid = 0;
    if (grid == 0) {
        if (n_in != 26 || in_sizes[0] != NLAT * DM || out_size != NLAT * DM || ws_size < WS_END) {
            fprintf(stderr, "kernel_launch: unexpected shapes (n_in %d, in0 %d, out %d, ws %zu, need %zu); nothing launched\n", n_in, n_in > 0 ? in_sizes[0] : -1, out_size, ws_size, (size_t)WS_END); grid = -1; return; }
        int dev = 0, cus = 0, per_cu = 0;
        if (hipGetDevice(&dev) != hipSuccess || hipDeviceGetAttribute(&cus, hipDeviceAttributeMultiprocessorCount, dev) != hipSuccess) { grid = -1; return; }
        if (hipFuncSetAttribute((const void*)fwd_kernel, hipFuncAttributeMaxDynamicSharedMemorySize, LDS_BYTES) != hipSuccess) { fprintf(stderr, "kernel_launch: hipFuncSetAttribute failed\n"); grid = -1; return; }
        if (hipOccupancyMaxActiveBlocksPerMultiprocessor(&per_cu, (const void*)fwd_kernel, 512, LDS_BYTES) != hipSuccess || per_cu < 1)
            fprintf(stderr, "kernel_launch: note: occupancy query reports %d workgroups per CU\n", per_cu);
        (void)hipGetLastError();
        grid = cus;
    }
    if (grid < 0) return;
    if (hipMemsetAsync((char*)d_ws + WS_CTL, 0, CTL_ZERO_BYTES, stream) != hipSuccess) return;
    Params p{};
    for (int i = 0; i < 26; ++i) p.in[i] = (const float*)d_in[i];
    p.out = (float*)d_out; p.ws = (unsigned char*)d_ws;
#if MK_PER_PHASE
    for (int ph = 0; ph < N_PHASES; ++ph) { p.ph_lo = ph; p.ph_hi = ph + 1; hipLaunchKernelGGL(fwd_kernel, dim3(grid), dim3(512), LDS_BYTES, stream, p); }
#else
    p.ph_lo = 0; p.ph_hi = N_PHASES;
    hipLaunchKernelGGL(fwd_kernel, dim3(grid), dim3(512), LDS_BYTES, stream, p);
#endif
}
```

```cpp
#include <hip/hip_runtime.h>
#include <cstdio>
#include <cstdint>

#ifndef PROBE_SUB
#define PROBE_SUB 0
#endif
#ifndef MK_PER_PHASE
#define MK_PER_PHASE 0
#endif

#define LAS __attribute__((address_space(3)))
#define GAS __attribute__((address_space(1)))
#define DI __device__ __forceinline__
typedef unsigned short bf16;
typedef short bf16x8 __attribute__((ext_vector_type(8)));
typedef short s16x4 __attribute__((ext_vector_type(4)));
typedef float f32x4 __attribute__((ext_vector_type(4)));
typedef float f32x16 __attribute__((ext_vector_type(16)));
typedef unsigned u32x4 __attribute__((ext_vector_type(4)));
typedef unsigned u32x2 __attribute__((ext_vector_type(2)));
typedef float f32x2_t __attribute__((ext_vector_type(2)));
typedef __bf16 bf16x2_t __attribute__((ext_vector_type(2)));
typedef short v4i16_t __attribute__((ext_vector_type(4)));

constexpr int DM = 1024, NB = 16, SEQ = 2048, CTXL = 256, GW = 64;
constexpr int NLAT = NB * SEQ, NCTX = NB * CTXL, NTOK = NLAT + NCTX;
constexpr int INW = 3072, DFF = 2816, NE = 8, DFE = 3584;
constexpr int C_NAQ = 0, C_NAK = 512, C_NAV = 1024, C_CONV = 1536, C_RQ = 2048, C_RK = 2176, C_RV = 2304, C_GF = 2560, C_GB = 2816;
constexpr float EPS = 1e-6f;
constexpr float LOG2E = 1.4426950408889634f;

constexpr size_t MiB = 1u << 20;
constexpr size_t WS_CTL = 0, CTL_ZERO_BYTES = 64 * 1024;
constexpr size_t WS_MODLAT = 1 * MiB;
constexpr size_t WS_MODCTX = WS_MODLAT + 2 * 16 * 6144 * 4;
constexpr size_t WS_ROPE = WS_MODCTX + 2 * 6144 * 4;
constexpr size_t WS_PTOK = 2 * MiB;
constexpr size_t WS_SEGCNT = WS_PTOK + 32768 * 2 * 4;
constexpr size_t WS_META = WS_SEGCNT + 256 * 2 * 8 * 4;
constexpr size_t WS_SEGLIST = 3 * MiB;
constexpr size_t WS_ROWMAP = 5 * MiB;
constexpr int MOE_ROWS = 34816;
constexpr int MOE_TILES = MOE_ROWS / 256;
constexpr size_t WS_PROW = WS_ROWMAP + 512 * 1024;
constexpr size_t WS_SUMLAT = 6 * MiB;
constexpr size_t WS_SUMCTX = 22 * MiB;
constexpr size_t WS_WIN = 24 * MiB;
constexpr size_t WS_WOUT = WS_WIN + (size_t)2 * 3072 * 1024 * 2;
constexpr size_t WS_WGU = WS_WOUT + (size_t)2 * 1024 * 1024 * 2;
constexpr size_t WS_WD = WS_WGU + (size_t)5632 * 1024 * 2;
constexpr size_t WS_MGU = WS_WD + (size_t)1024 * 2816 * 2;
constexpr size_t WS_MD = WS_MGU + (size_t)8 * 7168 * 1024 * 2;
constexpr size_t WS_HCTX = WS_MD + (size_t)8 * 1024 * 3584 * 2;
constexpr size_t WS_U = WS_HCTX + (size_t)NCTX * DM * 4;
constexpr size_t WS_P = WS_U + (size_t)NTOK * DM * 2;
constexpr size_t WS_END = WS_P + (size_t)MOE_ROWS * DFE * 2;
static_assert((size_t)NTOK * INW * 2 <= (size_t)MOE_ROWS * DFE * 2, "P region: px | dense hidden | fp8 hidden of both MoE slots (2 x MOE_ROWS x DFE bytes)");
static_assert(WS_WIN % 256 == 0 && WS_WOUT % 256 == 0 && WS_WGU % 256 == 0 && WS_WD % 256 == 0 && WS_MGU % 256 == 0 && WS_MD % 256 == 0 && WS_HCTX % 256 == 0 && WS_U % 256 == 0 && WS_P % 256 == 0, "align");

constexpr int RING_BYTES = 131072;
constexpr int AUX_OFF = RING_BYTES;
constexpr int AUX_TAB = AUX_OFF + 1024;
constexpr int LDS_BYTES = 147456;

#ifndef MOE_FP8
#define MOE_FP8 1
#endif
#ifndef DENSE_FP8
#define DENSE_FP8 2
#endif
constexpr int SCL_U = 0x7c7c7c7c, SCL_WGU = 0x79797979, SCL_H = 0x7c7c7c7c, SCL_WD = 0x78787878;
constexpr float QS_U = 8.0f, QS_WGU = 64.0f, QS_H = 8.0f, QS_WD = 128.0f;
DI unsigned pk2(float lo, float hi) { f32x2_t v = {lo, hi}; bf16x2_t b = __builtin_convertvector(v, bf16x2_t); return __builtin_bit_cast(unsigned, b); }
DI float clamp448(float x) { return __builtin_fminf(__builtin_fmaxf(x, -448.0f), 448.0f); }
DI unsigned pk4_fp8(float a, float b, float c, float d) { int w = 0; w = __builtin_amdgcn_cvt_pk_fp8_f32(clamp448(a), clamp448(b), w, false); w = __builtin_amdgcn_cvt_pk_fp8_f32(clamp448(c), clamp448(d), w, true); return (unsigned)w; }
DI float bflo(unsigned u) { return __uint_as_float(u << 16); }
DI float bfhi(unsigned u) { return __uint_as_float(u & 0xffff0000u); }
DI float wave_sum(float v) {
#pragma unroll
    for (int o = 1; o < 64; o <<= 1) v += __shfl_xor(v, o);
    return v;
}
DI float fast_exp2(float x) { return __builtin_amdgcn_exp2f(x); }
DI float fast_rcp(float x) { return __builtin_amdgcn_rcpf(x); }
DI float sigmoidf_(float x) { return fast_rcp(1.0f + fast_exp2(-x * LOG2E)); }
DI int crow(int reg, int h) { return (reg & 3) + 8 * (reg >> 2) + 4 * h; }
#define MFMA32(a, b, c) __builtin_amdgcn_mfma_f32_32x32x16_bf16((a), (b), (c), 0, 0, 0)
DI s16x4 trread(LAS const unsigned char* p) { return __builtin_bit_cast(s16x4, __builtin_amdgcn_ds_read_tr16_b64_v4i16((LAS v4i16_t*)p)); }
DI int ld_i32_coherent(const int* p) { return (int)__hip_atomic_load((const unsigned*)p, __ATOMIC_RELAXED, __HIP_MEMORY_SCOPE_AGENT); }

namespace pg8 {
#define PG8_LAS __attribute__((address_space(3)))
typedef unsigned short bf16_t;
constexpr int BM = 256, BK = 64, HALF = 128, HTB = HALF * BK * 2, STAGE_BYTES = 8 * HTB, NXCD = 8, WGM = 8;
__host__ __device__ __forceinline__ int lds_byte(int r, int c) { const int st = (r >> 4) * 2 + (c >> 5), rr = r & 15, cc = c & 31, ob = rr * 64 + cc * 2; return st * 1024 + (ob ^ (((ob >> 9) & 1) << 5)); }
__host__ __device__ __forceinline__ void stage_rc(int b, int& R, int& C) { const int st = b / 1024, sb = b % 1024, swz = sb ^ (((sb >> 9) & 1) << 5); R = (st >> 1) * 16 + swz / 64; C = (st & 1) * 32 + (swz % 64) / 2; }
__host__ __device__ __forceinline__ int perm32(int rho) { const int n = rho >> 4, i = rho & 15; return 8 * (i >> 2) + 4 * n + (i & 3); }
struct Unit { int pm, pn; };
struct StaticOrder {
    int nM, nN, nwg, G, c;
    __device__ void init(int M, int N, int G_, int c_) { nM = M / BM; nN = N / BM; nwg = nM * nN; G = G_; c = c_; }
    __device__ bool next(int i, Unit& u) const {
        const long L = (long)i * G + c; if (L >= nwg) return false;
        int wgid = (int)L; { const int q = nwg / NXCD, r = nwg % NXCD, xcd = wgid % NXCD, off = wgid / NXCD; wgid = (xcd < r ? xcd * (q + 1) : r * (q + 1) + (xcd - r) * q) + off; }
        const int nig = WGM * nN, gid = wgid / nig, fm = gid * WGM, gsz = (nM - fm) < WGM ? (nM - fm) : WGM;
        u.pm = fm + ((wgid % nig) % gsz); u.pn = (wgid % nig) / gsz; return true;
    }
};
struct RowsLinear { static constexpr bool GATHER = false; };
struct RowsLinearOff {
    static constexpr bool GATHER = true;
    __device__ __forceinline__ void fetch(const Unit& u, const int (&R)[2], int (&raw)[2][2]) const {
#pragma unroll
        for (int h = 0; h < 2; ++h)
#pragma unroll
            for (int i = 0; i < 2; ++i) raw[h][i] = u.pm * BM + h * HALF + R[i];
    }
    __device__ __forceinline__ void make(const int (&raw)[2][2], const int (&C)[2], int pitch, unsigned (&o)[2][2]) const {
#pragma unroll
        for (int h = 0; h < 2; ++h)
#pragma unroll
            for (int i = 0; i < 2; ++i) { o[h][i] = (unsigned)raw[h][i] * (unsigned)pitch + (unsigned)C[i] * 2u; asm volatile("" : "+v"(o[h][i])); }
    }
};
struct RowsGather {
    static constexpr bool GATHER = true;
    const int* rowmap; int row_add;
    __device__ __forceinline__ void fetch(const Unit& u, const int (&R)[2], int (&raw)[2][2]) const {
#pragma unroll
        for (int h = 0; h < 2; ++h)
#pragma unroll
            for (int i = 0; i < 2; ++i) raw[h][i] = rowmap[u.pm * BM + h * HALF + R[i]];
    }
    __device__ __forceinline__ void make(const int (&raw)[2][2], const int (&C)[2], int pitch, unsigned (&o)[2][2]) const {
#pragma unroll
        for (int h = 0; h < 2; ++h)
#pragma unroll
            for (int i = 0; i < 2; ++i) { int t = raw[h][i]; t = t < 0 ? 0 : t; o[h][i] = (unsigned)((size_t)(t + row_add) * (size_t)pitch + (size_t)C[i] * 2u); }
#pragma unroll
        for (int h = 0; h < 2; ++h)
#pragma unroll
            for (int i = 0; i < 2; ++i) asm volatile("" : "+v"(o[h][i]));
    }
};

typedef int i32x8 __attribute__((ext_vector_type(8)));
typedef int i32x4v __attribute__((ext_vector_type(4)));
template <class Epi, class Sched, class ARows, bool ALIGN_EPI, bool FP8 = false>
__device__ __forceinline__ void gemm_phase(PG8_LAS unsigned char* lds, int tid, const void* A, const void* Bt, int pitch, const Sched& S, const Epi& E, const ARows& AR, int sclA = 0x7f7f7f7f, int sclB = 0x7f7f7f7f) {
    constexpr bool GATHER = ARows::GATHER;
    const int wid = __builtin_amdgcn_readfirstlane(tid >> 6), lane = tid & 63, wr = wid >> 2, wc = wid & 3, fr = lane & 15, fq = lane >> 4;
    const int nt = pitch / (BK * 2);
    int RA[2], CA[2]; unsigned voffA[2], voffB[2];
#pragma unroll
    for (int i = 0; i < 2; ++i) { int R, C; stage_rc(tid * 16 + i * 8192, R, C); const int Rb = Epi::PERM ? ((R & ~31) + perm32(R & 31)) : R;
        RA[i] = R; CA[i] = C; voffA[i] = (unsigned)(R * pitch + C * 2); voffB[i] = (unsigned)(Rb * pitch + C * 2); }
#pragma unroll
    for (int i = 0; i < 2; ++i) { asm volatile("" : "+v"(voffA[i])); asm volatile("" : "+v"(voffB[i])); }
    const size_t kstep = (size_t)(BK * 2);
    const size_t hstep = (size_t)HALF * pitch;
    const size_t tstep = 2 * hstep;
    const unsigned ldsw = (unsigned)wid * 1024u;
    const int aoff = lds_byte(wr * 64 + fr, fq * 8), boff = lds_byte(wc * 32 + fr, fq * 8);
    const char* Ab = (const char*)A;
#define PG8_SA(b, h) (((b) * 2 + (h)) * HTB)
#define PG8_SB(b, h) ((4 + (b) * 2 + (h)) * HTB)
#define PG8_STAGE(bufoff, gbase, voff) do { _Pragma("unroll") for (int _i = 0; _i < 2; ++_i) \
        __builtin_amdgcn_global_load_lds((const unsigned*)((const char*)(gbase) + (voff)[_i]), (PG8_LAS unsigned*)(lds + (bufoff) + ldsw + _i * 8192), 16, 0, 0); } while (0)
#define PG8_STAGEA(bufoff, h, plin, kb) do { if constexpr (GATHER) PG8_STAGE(bufoff, Ab + (kb), curA[h]); else PG8_STAGE(bufoff, (plin) + (h) * hstep, voffA); } while (0)
#define PG8_LDA(dst, b, h) do { _Pragma("unroll") for (int m = 0; m < 4; ++m) _Pragma("unroll") for (int k = 0; k < 2; ++k) dst[m][k] = *(const PG8_LAS bf16x8*)(lds + PG8_SA(b, h) + aoff + m * 2048 + k * 1024); } while (0)
#define PG8_LDB(dst, b, h) do { _Pragma("unroll") for (int n = 0; n < 2; ++n) _Pragma("unroll") for (int k = 0; k < 2; ++k) dst[n][k] = *(const PG8_LAS bf16x8*)(lds + PG8_SB(b, h) + boff + n * 2048 + k * 1024); } while (0)
#define PG8_CAT(x0, x1) __builtin_shufflevector(__builtin_bit_cast(i32x4v, x0), __builtin_bit_cast(i32x4v, x1), 0, 1, 2, 3, 4, 5, 6, 7)
#define PG8_MMA(ai, bj, At, Bt_) do { __builtin_amdgcn_s_setprio(1); \
        if constexpr (FP8) { _Pragma("unroll") for (int m = 0; m < 4; ++m) _Pragma("unroll") for (int n = 0; n < 2; ++n) \
            acc[ai][bj][m][n] = __builtin_amdgcn_mfma_scale_f32_16x16x128_f8f6f4(PG8_CAT(Bt_[n][0], Bt_[n][1]), PG8_CAT(At[m][0], At[m][1]), acc[ai][bj][m][n], 0, 0, 0, sclB, 0, sclA); } \
        else { _Pragma("unroll") for (int m = 0; m < 4; ++m) _Pragma("unroll") for (int n = 0; n < 2; ++n) _Pragma("unroll") for (int k = 0; k < 2; ++k) \
            acc[ai][bj][m][n] = __builtin_amdgcn_mfma_f32_16x16x32_bf16(Bt_[n][k], At[m][k], acc[ai][bj][m][n], 0, 0, 0); } \
        __builtin_amdgcn_s_setprio(0); } while (0)
#define PG8_WAIT_V(n) asm volatile("s_waitcnt vmcnt(" #n ")" ::: "memory")
#define PG8_WAIT_L(n) asm volatile("s_waitcnt lgkmcnt(" #n ")" ::: "memory")
#define PG8_BAR __builtin_amdgcn_s_barrier()
#define PG8_SCHED __builtin_amdgcn_sched_barrier(0)
    Unit cur, nxt; int ui = 0;
    if (!S.next(0, cur)) return;
    f32x4 acc[2][2][4][2];
#pragma unroll
    for (int a = 0; a < 2; ++a)
#pragma unroll
        for (int b = 0; b < 2; ++b)
#pragma unroll
            for (int m = 0; m < 4; ++m)
#pragma unroll
                for (int n = 0; n < 2; ++n) acc[a][b][m][n] = (f32x4){0.f, 0.f, 0.f, 0.f};
    bf16x8 At[4][2], B0[2][2], B1[2][2];
    unsigned curA[2][2] = {{0u, 0u}, {0u, 0u}}, nxtA[2][2] = {{0u, 0u}, {0u, 0u}};
    int rawN[2][2] = {{0, 0}, {0, 0}};
    if constexpr (GATHER) { int rawC[2][2]; AR.fetch(cur, RA, rawC); AR.make(rawC, CA, pitch, curA); Unit n1; if (S.next(1, n1)) AR.fetch(n1, RA, rawN); }
    const char* cA = GATHER ? Ab : Ab + (size_t)cur.pm * tstep;
    const char* cB = (const char*)Bt + (size_t)cur.pn * tstep;
    PG8_STAGE(PG8_SB(0, 0), cB, voffB); PG8_STAGE(PG8_SB(0, 1), cB + hstep, voffB); PG8_STAGEA(PG8_SA(0, 0), 0, cA, 0); PG8_STAGEA(PG8_SA(0, 1), 1, cA, 0);
    if (wr == 1) PG8_BAR;
    PG8_WAIT_V(2); PG8_BAR;
    PG8_STAGE(PG8_SB(1, 0), cB + kstep, voffB); PG8_STAGEA(PG8_SA(1, 0), 0, cA + kstep, kstep); PG8_STAGE(PG8_SB(1, 1), cB + hstep + kstep, voffB);
    PG8_WAIT_V(6); PG8_BAR;
    for (;;) {
        const bool has_next = S.next(ui + 1, nxt);
        if constexpr (GATHER) {
            if (has_next) { AR.make(rawN, CA, pitch, nxtA); Unit n2; if (S.next(ui + 2, n2)) AR.fetch(n2, RA, rawN); }
            else {
#pragma unroll
                for (int h = 0; h < 2; ++h)
#pragma unroll
                    for (int i = 0; i < 2; ++i) nxtA[h][i] = curA[h][i];
            }
        }
        const char* nA = GATHER ? Ab : (has_next ? Ab + (size_t)nxt.pm * tstep : cA);
        const char* nB = has_next ? (const char*)Bt + (size_t)nxt.pn * tstep : cB;
        for (int t = 0; t < nt; t += 2) {
            const bool last = (t == nt - 2);
            const size_t k1 = (size_t)(t + 1) * kstep, k2 = last ? 0 : (size_t)(t + 2) * kstep, k3 = k2 + kstep;
            const char* a1 = cA + k1;
            const char* a2 = last ? nA : cA + k2; const char* b2 = last ? nB : cB + k2;
            const char* a3 = a2 + kstep; const char* b3 = b2 + kstep;
            PG8_LDB(B0, 0, 0); PG8_LDB(B1, 0, 1); PG8_SCHED; PG8_LDA(At, 0, 0); PG8_STAGEA(PG8_SA(1, 1), 1, a1, k1);
            if constexpr (GATHER) { if (last) {
#pragma unroll
                for (int h = 0; h < 2; ++h)
#pragma unroll
                    for (int i = 0; i < 2; ++i) curA[h][i] = nxtA[h][i]; } }
            PG8_WAIT_V(8); PG8_WAIT_L(0); PG8_BAR; PG8_MMA(0, 0, At, B0); PG8_MMA(0, 1, At, B1); PG8_BAR; PG8_SCHED;
            PG8_LDA(At, 0, 1); PG8_STAGE(PG8_SB(0, 0), b2, voffB); PG8_STAGE(PG8_SB(0, 1), b2 + hstep, voffB); PG8_STAGEA(PG8_SA(0, 0), 0, a2, k2);
            PG8_WAIT_V(8); PG8_WAIT_L(0); PG8_BAR; PG8_MMA(1, 0, At, B0); PG8_MMA(1, 1, At, B1); PG8_BAR; PG8_SCHED;
            PG8_LDB(B0, 1, 0); PG8_LDB(B1, 1, 1); PG8_SCHED; PG8_LDA(At, 1, 0); PG8_STAGEA(PG8_SA(0, 1), 1, a2, k2);
            PG8_WAIT_V(8); PG8_WAIT_L(0); PG8_BAR; PG8_MMA(0, 0, At, B0); PG8_MMA(0, 1, At, B1); PG8_BAR; PG8_SCHED;
            PG8_LDA(At, 1, 1); PG8_STAGE(PG8_SB(1, 0), b3, voffB); PG8_STAGE(PG8_SB(1, 1), b3 + hstep, voffB); PG8_STAGEA(PG8_SA(1, 0), 0, a3, k3);
            PG8_WAIT_V(8); PG8_WAIT_L(0); PG8_BAR; PG8_MMA(1, 0, At, B0); PG8_MMA(1, 1, At, B1); PG8_BAR; PG8_SCHED;
        }
        if constexpr (ALIGN_EPI) { if (wr == 0) PG8_BAR; }
        E(acc, cur, wr, wc, fr, fq);
        if (!has_next) break;
#pragma unroll
        for (int a = 0; a < 2; ++a)
#pragma unroll
            for (int b = 0; b < 2; ++b)
#pragma unroll
                for (int m = 0; m < 4; ++m)
#pragma unroll
                    for (int n = 0; n < 2; ++n) acc[a][b][m][n] = (f32x4){0.f, 0.f, 0.f, 0.f};
        cur = nxt; cA = nA; cB = nB; ++ui;
        if constexpr (ALIGN_EPI) { if (wr == 1) PG8_BAR; }
    }
    PG8_WAIT_V(0);
    if constexpr (!ALIGN_EPI) { if (wr == 0) PG8_BAR; }
    PG8_BAR;
#undef PG8_SA
#undef PG8_SB
#undef PG8_STAGE
#undef PG8_STAGEA
#undef PG8_LDA
#undef PG8_LDB
#undef PG8_MMA
#undef PG8_CAT
#undef PG8_WAIT_V
#undef PG8_WAIT_L
#undef PG8_BAR
#undef PG8_SCHED
}

#define PG8_OPAQUE(x) asm volatile("" : "+v"(x))
struct EpiNull { static constexpr bool PERM = true; __device__ __forceinline__ void operator()(const f32x4 (&acc)[2][2][4][2], const Unit& u, int wr, int wc, int fr, int fq) const { if (u.pm < 0) {
#pragma unroll
        for (int a = 0; a < 2; ++a)
#pragma unroll
            for (int b = 0; b < 2; ++b)
#pragma unroll
                for (int m = 0; m < 4; ++m)
#pragma unroll
                    for (int n = 0; n < 2; ++n) asm volatile("" :: "v"(acc[a][b][m][n])); } } };
struct EpiStoreBf16 {
    static constexpr bool PERM = true;
    bf16_t* O; int ldc;
    __device__ __forceinline__ void operator()(const f32x4 (&acc)[2][2][4][2], const Unit& u, int wr, int wc, int fr, int fq) const {
        char* base = (char*)(O + (size_t)(u.pm * BM) * ldc + u.pn * BM);
        unsigned lb = (unsigned)((wr * 64 + fr) * ldc + wc * 32 + 8 * fq) * 2u; PG8_OPAQUE(lb);
        const unsigned rstep = (unsigned)ldc * 32u;
#pragma unroll
        for (int ai = 0; ai < 2; ++ai)
#pragma unroll
            for (int m = 0; m < 4; ++m) { const unsigned ro = lb + (unsigned)(ai * 8 + m) * rstep;
#pragma unroll
                for (int bj = 0; bj < 2; ++bj) { const f32x4 v0 = acc[ai][bj][m][0], v1 = acc[ai][bj][m][1];
                    u32x4 w; w.x = pk2(v0[0], v0[1]); w.y = pk2(v0[2], v0[3]); w.z = pk2(v1[0], v1[1]); w.w = pk2(v1[2], v1[3]);
                    *(u32x4*)(base + ro + bj * (HALF * 2)) = w; } }
    }
};
struct EpiResGate {
    static constexpr bool PERM = false;
    const float* src_ctx; const float* src_lat; float* dst_ctx; float* dst_lat; const float* gate_lat; const float* gate_ctx; int row_base;
    __device__ __forceinline__ void operator()(const f32x4 (&acc)[2][2][4][2], const Unit& u, int wr, int wc, int fr, int fq) const {
        const int rowu = row_base + u.pm * BM; const bool isctx = rowu < NCTX;
        const char* src = (const char*)(isctx ? src_ctx + (size_t)rowu * DM : src_lat + (size_t)(rowu - NCTX) * DM) + u.pn * (BM * 4);
        char* dst = (char*)(isctx ? dst_ctx + (size_t)rowu * DM : dst_lat + (size_t)(rowu - NCTX) * DM) + u.pn * (BM * 4);
        const float* gate = (isctx ? gate_ctx : gate_lat + (size_t)((rowu - NCTX) / SEQ) * 6144) + u.pn * BM;
        const int cl = wc * 32 + 4 * fq;
        f32x4 sc[2][2][4][2];
#pragma unroll
        for (int bj = 0; bj < 2; ++bj)
#pragma unroll
            for (int n = 0; n < 2; ++n) { const f32x4 gv = *(const f32x4*)(gate + cl + bj * HALF + n * 16);
#pragma unroll
                for (int ai = 0; ai < 2; ++ai)
#pragma unroll
                    for (int m = 0; m < 4; ++m) sc[ai][bj][m][n] = acc[ai][bj][m][n] * gv; }
        unsigned lb = (unsigned)((wr * 64 + fr) * DM + cl) * 4u; PG8_OPAQUE(lb);
#pragma unroll
        for (int ai = 0; ai < 2; ++ai)
#pragma unroll
            for (int m = 0; m < 4; ++m) { const unsigned ro = lb + (unsigned)(ai * 8 + m) * (16u * DM * 4u);
#pragma unroll
                for (int bj = 0; bj < 2; ++bj)
#pragma unroll
                    for (int n = 0; n < 2; ++n) { const unsigned o = ro + (unsigned)(bj * HALF + n * 16) * 4u; const f32x4 s = *(const f32x4*)(src + o);
                        *(f32x4*)(dst + o) = s + sc[ai][bj][m][n]; }
                asm volatile("" ::: "memory"); }
    }
};
template <bool MOE> struct EpiSwiglu {
    static constexpr bool PERM = true;
    static constexpr bool OUT8 = MOE ? (MOE_FP8 != 0) : (DENSE_FP8 != 0);
    bf16_t* O; int ldc; int ncol; const float* prow;
    __device__ __forceinline__ void operator()(const f32x4 (&acc)[2][2][4][2], const Unit& u, int wr, int wc, int fr, int fq) const {
        const int pnl = MOE ? (u.pn % ncol) : u.pn;
        constexpr int ES = OUT8 ? 1 : 2;
        char* base = (char*)O + ((size_t)(u.pm * BM) * ldc + pnl * HALF) * ES;
        unsigned lb = (unsigned)((wr * 64 + fr) * ldc + wc * 32 + 8 * fq) * ES; PG8_OPAQUE(lb);
        const unsigned rstep = (unsigned)ldc * 16u * ES;
#pragma unroll
        for (int ai = 0; ai < 2; ++ai)
#pragma unroll
            for (int m = 0; m < 4; ++m) {
                const float pw = OUT8 ? QS_H : 1.0f;
                float hv[8];
#pragma unroll
                for (int n = 0; n < 2; ++n)
#pragma unroll
                    for (int j = 0; j < 4; ++j) { const float g = acc[ai][0][m][n][j], up = acc[ai][1][m][n][j]; hv[n * 4 + j] = g * sigmoidf_(g) * up * pw; }
                if constexpr (OUT8) { u32x2 w; w.x = pk4_fp8(hv[0], hv[1], hv[2], hv[3]); w.y = pk4_fp8(hv[4], hv[5], hv[6], hv[7]);
                    *(u32x2*)(base + lb + (unsigned)(ai * 8 + m) * rstep) = w; }
                else { u32x4 w; w.x = pk2(hv[0], hv[1]); w.y = pk2(hv[2], hv[3]); w.z = pk2(hv[4], hv[5]); w.w = pk2(hv[6], hv[7]);
                    *(u32x4*)(base + lb + (unsigned)(ai * 8 + m) * rstep) = w; } }
    }
};
struct EpiMoeScatter {
    static constexpr bool PERM = false;
    const int* rowmap; const float* prow; float* hlat; const float* gate_lat; int ncol;
    __device__ __forceinline__ void operator()(const f32x4 (&acc)[2][2][4][2], const Unit& u, int wr, int wc, int fr, int fq) const {
        const int pnl = u.pn % ncol;
        const int* rm = rowmap + u.pm * BM; const float* pr = prow + u.pm * BM;
        char* hb = (char*)hlat + pnl * (BM * 4); const char* gb = (const char*)gate_lat + pnl * (BM * 4);
        unsigned pl = (unsigned)(wr * 64 + fr) * 4u; PG8_OPAQUE(pl);
        unsigned cb = (unsigned)(wc * 32 + 4 * fq) * 4u; PG8_OPAQUE(cb);
#pragma unroll
        for (int ai = 0; ai < 2; ++ai)
#pragma unroll
            for (int m = 0; m < 4; ++m) { const int tok = *(const int*)((const char*)rm + pl + (unsigned)(ai * 8 + m) * 64u);
                if (tok >= 0) { const float pw = *(const float*)((const char*)pr + pl + (unsigned)(ai * 8 + m) * 64u); const unsigned ro = (unsigned)tok * (DM * 4u) + cb, go = ((unsigned)tok >> 11) * (6144u * 4u) + cb;
#pragma unroll
                    for (int bj = 0; bj < 2; ++bj)
#pragma unroll
                        for (int n = 0; n < 2; ++n) { const unsigned o = (unsigned)(bj * HALF + n * 16) * 4u; const f32x4 sv = *(const f32x4*)(hb + ro + o); const f32x4 gv = *(const f32x4*)(gb + go + o);
                            const f32x4 t = acc[ai][bj][m][n] * pw; *(f32x4*)(hb + ro + o) = sv + gv * t; } }
                asm volatile("" ::: "memory"); }
    }
};
struct MoeOrder {
    int NT0, NT1, ncol, G, c; const PG8_LAS int* texp;
    __device__ bool next(int i, Unit& u) const {
        const long L = (long)i * G + c; if (L >= (long)(NT0 + NT1) * ncol) return false;
        const int tq = (int)(L / ncol), pnl = (int)(L % ncol);
        const int T = tq < NT0 ? tq : MOE_TILES + tq - NT0;
        const int e = __builtin_amdgcn_readfirstlane(texp[T]);
        u.pm = T; u.pn = e * ncol + pnl; return true;
    }
};
}

#define XB_TMO      128
#define XB_XCNT(j)  (256  + 64 * (j))
#define XB_XSUB(j)  (1280 + 64 * (j))
#define XB_XGEN(j)  (2304 + 64 * (j))
#define XB_TOP      3328
#define XB_TOPGEN   3392
#define XCD_BAR_WORDS 3456
#define XB_SPIN_CAP (1u << 18)
DI unsigned xb_ld(unsigned* p)              { return __hip_atomic_load(p, __ATOMIC_RELAXED, __HIP_MEMORY_SCOPE_AGENT); }
DI unsigned xb_add(unsigned* p, unsigned v) { return __hip_atomic_fetch_add(p, v, __ATOMIC_RELAXED, __HIP_MEMORY_SCOPE_AGENT); }
DI unsigned xb_xcc_id() { return (unsigned)__builtin_amdgcn_s_getreg((3 << 11) | 20) & 0xFu; }
#define XB_SPIN(cond, bar) do { unsigned _sp = 0; while (cond) { __builtin_amdgcn_s_sleep(1); \
    if ((++_sp & 255u) == 0u) { if (xb_ld(&(bar)[XB_TMO])) break; if (_sp > XB_SPIN_CAP) { atomicAdd(&(bar)[XB_TMO], 1u); break; } } } } while (0)
struct XcdBarrier { unsigned* bar; unsigned x; volatile LAS unsigned* st; };
DI XcdBarrier xcd_barrier_post(unsigned* bar, volatile LAS unsigned* st) {
    XcdBarrier b; b.bar = bar; b.x = xb_xcc_id(); b.st = st;
    if (threadIdx.x == 0) (void)xb_add(&bar[XB_XCNT(b.x)], 1u);
    return b;
}
DI void xcd_barrier_complete(unsigned* bar, unsigned x, unsigned& nloc, unsigned& nx) {
    const unsigned G = gridDim.x * gridDim.y * gridDim.z;
    unsigned sum, cnt, mine, sp = 0u;
    for (;;) {
        sum = 0u; cnt = 0u; mine = 0u;
#pragma unroll
        for (unsigned j = 0; j < 16; ++j) { const unsigned c = xb_ld(&bar[XB_XCNT(j)]); sum += c; cnt += (c > 0u) ? 1u : 0u; mine = (j == x) ? c : mine; }
        if (sum == G) break;
        __builtin_amdgcn_s_sleep(1);
        if ((++sp & 255u) == 0u) { if (xb_ld(&bar[XB_TMO])) break; if (sp > XB_SPIN_CAP) { atomicAdd(&bar[XB_TMO], 1u); break; } }
    }
    nloc = mine > 0u ? mine : 1u; nx = cnt > 0u ? cnt : 1u;
}
DI void xcd_barrier(const XcdBarrier& b, int wave) {
    asm volatile("s_waitcnt vmcnt(0)" ::: "memory");
    __syncthreads();
    if (wave == 0 && __builtin_amdgcn_mbcnt_hi(~0u, __builtin_amdgcn_mbcnt_lo(~0u, 0u)) == 0u) {
        unsigned* bar = b.bar;
        __builtin_amdgcn_s_waitcnt(0);
        unsigned nloc = b.st[0], nx = b.st[1];
        if (nloc == 0u) { xcd_barrier_complete(bar, b.x, nloc, nx); b.st[0] = nloc; b.st[1] = nx; }
        const unsigned old = xb_add(&bar[XB_XSUB(b.x)], 1u);
        const unsigned gen = old / nloc;
        if (old + 1u == (gen + 1u) * nloc) {
            __builtin_amdgcn_fence(__ATOMIC_RELEASE, "agent");
            asm volatile("s_waitcnt vmcnt(0)" ::: "memory");
            const unsigned og = xb_add(&bar[XB_TOP], 1u);
            const unsigned tg = og / nx;
            if (og + 1u == (tg + 1u) * nx) xb_add(&bar[XB_TOPGEN], 1u);
            else XB_SPIN(xb_ld(&bar[XB_TOPGEN]) == tg, bar);
            __builtin_amdgcn_fence(__ATOMIC_ACQUIRE, "agent");
            xb_add(&bar[XB_XGEN(b.x)], 1u);
            asm volatile("s_waitcnt vmcnt(0)" ::: "memory");
        } else {
            XB_SPIN(xb_ld(&bar[XB_XGEN(b.x)]) == gen, bar);
            __builtin_amdgcn_fence(__ATOMIC_ACQUIRE, "agent");
            asm volatile("s_waitcnt vmcnt(0)" ::: "memory");
        }
    }
    __syncthreads();
}

struct Params { const float* in[26]; float* out; unsigned char* ws; int ph_lo, ph_hi, pad0, pad1; };
enum { I_X = 0, I_C, I_CTX, I_CCTX, I_WMOD, I_BMOD, I_N1W, I_N2W, I_WIN, I_WOUT, I_RPB, I_CONVW, I_CONVB, I_CLNW, I_CLNB, I_RDEC, I_RGNW,
       I_FG, I_FU, I_FD, I_MR, I_MRB, I_MG, I_MU, I_MDN, I_FNW };
constexpr int PH_P0 = 0, PH_FINAL = 19, N_PHASES = 20;

typedef __attribute__((address_space(4))) const unsigned char* karg_t;
struct KIn {
    karg_t ka;
    DI const float* operator[](int k) const { return *(const float* __attribute__((address_space(4))) const*)(ka + 8 * k); }
};
struct Frame {
    LAS unsigned char* lds;
    int tid, lane, wave, G, bid, vb;
    KIn in; float* out; unsigned char* ws;
};
DI Frame phase_frame(const Frame& F0) {
    Frame F; karg_t ka = F0.in.ka; asm volatile("" : "+s"(ka)); F.in.ka = ka;
    F.out = *(float* __attribute__((address_space(4))) const*)(ka + 208);
    F.ws = *(unsigned char* __attribute__((address_space(4))) const*)(ka + 216);
    int wv = F0.wave; asm volatile("" : "+s"(wv));
    int tid = (wv << 6) + (int)__builtin_amdgcn_mbcnt_hi(~0u, __builtin_amdgcn_mbcnt_lo(~0u, 0u)), G = F0.G, bid = F0.bid; unsigned ldsb = (unsigned)(size_t)F0.lds;
    asm volatile("" : "+v"(tid)); asm volatile("" : "+s"(G)); asm volatile("" : "+s"(bid)); asm volatile("" : "+s"(ldsb));
    F.tid = tid; F.lane = tid & 63; F.wave = __builtin_amdgcn_readfirstlane(tid >> 6); F.G = G; F.bid = bid; F.lds = (LAS unsigned char*)(size_t)ldsb;
    F.vb = (G % 8 == 0) ? (bid % 8) * (G / 8) + bid / 8 : bid;
    return F;
}

DI void p0_transpose_item(const float* W, int K, int N, bf16* WT, int k0, int n0, int dst_row0, LAS float* scr, int lane) {
#pragma unroll 8
    for (int i = 0; i < 32; ++i) { const int kk = 2 * i + (lane >> 5); scr[kk * 33 + (lane & 31)] = W[(size_t)(k0 + kk) * N + n0 + (lane & 31)]; }
    asm volatile("s_waitcnt lgkmcnt(0)" ::: "memory");
    const int c = lane & 7;
#pragma unroll
    for (int j = 0; j < 4; ++j) { const int n = (lane >> 3) + 8 * j; const LAS float* s = scr + (8 * c) * 33 + n;
        u32x4 o; o.x = pk2(s[0 * 33], s[1 * 33]); o.y = pk2(s[2 * 33], s[3 * 33]); o.z = pk2(s[4 * 33], s[5 * 33]); o.w = pk2(s[6 * 33], s[7 * 33]);
        *(u32x4*)(WT + (size_t)(dst_row0 + n) * K + k0 + 8 * c) = o; }
    asm volatile("s_waitcnt lgkmcnt(0)" ::: "memory");
}
DI void p0_convert_plain(Frame& F, const float* W, int K, int N, bf16* WT, int item, LAS float* scr) {
    const int nblk = N / 32, kb = item / nblk, nb = item % nblk;
    p0_transpose_item(W, K, N, WT, 64 * kb, 32 * nb, 32 * nb, scr, F.lane);
}
DI void p0_convert_gu(Frame& F, const float* W, int K, int N, bf16* WT, int item, int up, LAS float* scr) {
    const int nblk = N / 32, kb = item / nblk, nb = item % nblk, n0 = 32 * nb;
    p0_transpose_item(W, K, N, WT, 64 * kb, n0, 256 * (n0 / 128) + (n0 % 128) + (up ? 128 : 0), scr, F.lane);
}
DI void conv_item64(const float* W, int K, int N, bf16* WT, int k0, int n0, int dst_row0, LAS unsigned* scr, int lane) {
    const float* wp = W + (size_t)k0 * N + n0 + lane;
    float v[64];
#pragma unroll
    for (int i = 0; i < 64; ++i) v[i] = wp[(size_t)i * N];
#pragma unroll
    for (int i = 0; i < 32; ++i) scr[i * 65 + lane] = pk2(v[2 * i], v[2 * i + 1]);
    asm volatile("s_waitcnt lgkmcnt(0)" ::: "memory");
    const int c = lane & 7;
#pragma unroll
    for (int j = 0; j < 8; ++j) { const int n = (lane >> 3) + 8 * j; const LAS unsigned* sp = scr + (4 * c) * 65 + n;
        u32x4 o; o.x = sp[0]; o.y = sp[65]; o.z = sp[130]; o.w = sp[195];
        *(u32x4*)(WT + (size_t)(dst_row0 + n) * K + k0 + 8 * c) = o; }
    asm volatile("s_waitcnt lgkmcnt(0)" ::: "memory");
}
DI void conv_item64_fp8(const float* W, int K, int N, unsigned char* WT, int k0, int n0, int dst_row0, float qs, LAS unsigned* scr, int lane) {
    const float* wp = W + (size_t)k0 * N + n0 + lane;
    float v[64];
#pragma unroll
    for (int i = 0; i < 64; ++i) v[i] = wp[(size_t)i * N];
#pragma unroll
    for (int i = 0; i < 16; ++i) scr[i * 65 + lane] = pk4_fp8(v[4 * i] * qs, v[4 * i + 1] * qs, v[4 * i + 2] * qs, v[4 * i + 3] * qs);
    asm volatile("s_waitcnt lgkmcnt(0)" ::: "memory");
    const int c = lane & 3;
#pragma unroll
    for (int j = 0; j < 4; ++j) { const int n = (lane >> 2) + 16 * j; const LAS unsigned* sp = scr + (4 * c) * 65 + n;
        u32x4 o; o.x = sp[0]; o.y = sp[65]; o.z = sp[130]; o.w = sp[195];
        *(u32x4*)(WT + (size_t)(dst_row0 + n) * K + k0 + 16 * c) = o; }
    asm volatile("s_waitcnt lgkmcnt(0)" ::: "memory");
}
constexpr int BG_ITEMS = 21504;
constexpr int BG_B0 = 0, BG_D0 = 1200, BG_E0 = 5200, BG_F0 = 8700, BG_B1 = 19700, BG_CL = 20900;
DI void bg_item(Frame& F, int g, LAS unsigned* scr) {
    if (g < 14336) { const int m = g / 896, e = m >> 1, up = m & 1, r = g % 896, kb = r / 56, nb = r % 56, n0 = 64 * nb; const int drow = 256 * (n0 / 128) + (n0 % 128) + (up ? 128 : 0);
#if MOE_FP8
        conv_item64_fp8(F.in[up ? I_MU : I_MG] + (size_t)e * 1024 * 3584, 1024, 3584, F.ws + WS_MGU + (size_t)e * 7168 * 1024, 64 * kb, n0, drow, QS_WGU, scr, F.lane);
#else
        conv_item64(F.in[up ? I_MU : I_MG] + (size_t)e * 1024 * 3584, 1024, 3584, (bf16*)(F.ws + WS_MGU) + (size_t)e * 7168 * 1024, 64 * kb, n0, drow, scr, F.lane);
#endif
    } else { const int gg = g - 14336, e = gg / 896, r = gg % 896, kb = r / 16, nb = r % 16;
#if MOE_FP8
        conv_item64_fp8(F.in[I_MDN] + (size_t)e * 3584 * 1024, 3584, 1024, F.ws + WS_MD + (size_t)e * 1024 * 3584, 64 * kb, 64 * nb, 64 * nb, QS_WD, scr, F.lane);
#else
        conv_item64(F.in[I_MDN] + (size_t)e * 3584 * 1024, 3584, 1024, (bf16*)(F.ws + WS_MD) + (size_t)e * 1024 * 3584, 64 * kb, 64 * nb, 64 * nb, scr, F.lane);
#endif
    }
}
DI void bg_convert_tail(Frame& F, int nwg, int lo, int hi) {
    const int nmax = (nwg + F.G - 1) / F.G, rem = nwg - (nmax - 1) * F.G;
    if (F.bid < rem || rem >= F.G) return;
    LAS unsigned* scr = (LAS unsigned*)(F.lds + F.wave * 8320);
    const int w = (F.bid - rem) * 8 + F.wave, nw = (F.G - rem) * 8;
    for (int g = lo + w; g < hi; g += nw) bg_item(F, g, scr);
}
DI void bg_convert_all(Frame& F, int lo, int hi) {
    LAS unsigned* scr = (LAS unsigned*)(F.lds + F.wave * 8320);
    for (int g = lo + F.bid * 8 + F.wave; g < hi; g += F.G * 8) bg_item(F, g, scr);
}
DI void p0_prologue(Frame& F) {
    {
        LAS float* Sx = (LAS float*)F.lds;
        LAS float* red = (LAS float*)(F.lds + 81920);
        bool staged = false;
        for (int unit = F.bid; unit < 192; unit += F.G) {
            if (!staged) {
                for (int idx = F.tid; idx < 17 * 1024; idx += 512) { const int r = idx / 1024, k = idx % 1024;
                    const float v = r < 16 ? F.in[I_C][r * 1024 + k] : F.in[I_CCTX][k]; Sx[k * 20 + r] = v * sigmoidf_(v); }
                staged = true; __syncthreads();
            }
            const int l = unit / 96, n0 = (unit % 96) * 64;
            const float* Wm = F.in[I_WMOD] + (size_t)l * 1024 * 6144 + n0 + F.lane;
            float acc[17];
#pragma unroll
            for (int r = 0; r < 17; ++r) acc[r] = 0.f;
            const int kb = F.wave * 128;
#pragma unroll 4
            for (int k = 0; k < 128; ++k) { const float wv = Wm[(size_t)(kb + k) * 6144]; const LAS float* sp = Sx + (kb + k) * 20;
                const f32x4 s0 = *(const LAS f32x4*)(sp), s1 = *(const LAS f32x4*)(sp + 4), s2 = *(const LAS f32x4*)(sp + 8), s3 = *(const LAS f32x4*)(sp + 12); const float s4 = sp[16];
                acc[0] += s0[0] * wv; acc[1] += s0[1] * wv; acc[2] += s0[2] * wv; acc[3] += s0[3] * wv; acc[4] += s1[0] * wv; acc[5] += s1[1] * wv; acc[6] += s1[2] * wv; acc[7] += s1[3] * wv;
                acc[8] += s2[0] * wv; acc[9] += s2[1] * wv; acc[10] += s2[2] * wv; acc[11] += s2[3] * wv; acc[12] += s3[0] * wv; acc[13] += s3[1] * wv; acc[14] += s3[2] * wv; acc[15] += s3[3] * wv;
                acc[16] += s4 * wv; }
#pragma unroll
            for (int r = 0; r < 17; ++r) red[(F.wave * 17 + r) * 64 + F.lane] = acc[r];
            __syncthreads();
            for (int idx = F.tid; idx < 17 * 64; idx += 512) { const int r = idx / 64, ln = idx % 64; float s = F.in[I_BMOD][l * 6144 + n0 + ln];
#pragma unroll
                for (int w = 0; w < 8; ++w) s += red[(w * 17 + r) * 64 + ln];
                if (r < 16) ((float*)(F.ws + WS_MODLAT))[((size_t)l * 16 + r) * 6144 + n0 + ln] = s; else ((float*)(F.ws + WS_MODCTX))[(size_t)l * 6144 + n0 + ln] = s; }
            __syncthreads();
        }
        __syncthreads();
    }
    if (F.bid == 0) { const int pos = F.tid >> 3, j = F.tid & 7; const float inv = exp2f(-(float)j * 0.125f * 13.287712379549449f); const float ang = (float)pos * inv;
        float* tab = (float*)(F.ws + WS_ROPE); tab[(pos * 8 + j) * 2] = cosf(ang); tab[(pos * 8 + j) * 2 + 1] = sinf(ang); }
    {
        LAS float* scr = (LAS float*)(F.lds + F.wave * 16384);
        const int gw = F.bid * 8 + F.wave, NGW = F.G * 8;
        constexpr int I_IN = 16 * 96, I_OUT = 16 * 32, I_G = 16 * 88, I_D = 44 * 32, I_MGI = 16 * 112, I_MDI = 56 * 32;
        constexpr int NITEMS = 2 * I_IN + 2 * I_OUT + (DENSE_FP8 == 1 ? 3 * 704 : (DENSE_FP8 == 2 ? 2 * I_G + 704 : 2 * I_G + I_D));
        for (int it = gw; it < NITEMS; it += NGW) {
            int r = it;
            if (r < 2 * I_IN) { const int l = r / I_IN; p0_convert_plain(F, F.in[I_WIN] + (size_t)l * 1024 * 3072, 1024, 3072, (bf16*)(F.ws + WS_WIN) + (size_t)l * 3072 * 1024, r % I_IN, scr); continue; } r -= 2 * I_IN;
            if (r < 2 * I_OUT) { const int l = r / I_OUT; p0_convert_plain(F, F.in[I_WOUT] + (size_t)l * 1024 * 1024, 1024, 1024, (bf16*)(F.ws + WS_WOUT) + (size_t)l * 1024 * 1024, r % I_OUT, scr); continue; } r -= 2 * I_OUT;
#if DENSE_FP8 == 2
            if (r < I_G) { p0_convert_gu(F, F.in[I_FG], 1024, 2816, (bf16*)(F.ws + WS_WGU), r, 0, scr); continue; } r -= I_G;
            if (r < I_G) { p0_convert_gu(F, F.in[I_FU], 1024, 2816, (bf16*)(F.ws + WS_WGU), r, 1, scr); continue; } r -= I_G;
            { const int kb = r / 16, nb = r % 16; conv_item64_fp8(F.in[I_FD], 2816, 1024, F.ws + WS_WD, 64 * kb, 64 * nb, 64 * nb, QS_WD, (LAS unsigned*)scr, F.lane); }
#elif DENSE_FP8 == 1
            { LAS unsigned* scr8 = (LAS unsigned*)scr;
              if (r < 1408) { const int up = r / 704, q = r % 704, kb = q / 44, nb = q % 44, n0 = 64 * nb;
                  conv_item64_fp8(F.in[up ? I_FU : I_FG], 1024, 2816, F.ws + WS_WGU, 64 * kb, n0, 256 * (n0 / 128) + (n0 % 128) + (up ? 128 : 0), QS_WGU, scr8, F.lane); }
              else { const int q = r - 1408, kb = q / 16, nb = q % 16; conv_item64_fp8(F.in[I_FD], 2816, 1024, F.ws + WS_WD, 64 * kb, 64 * nb, 64 * nb, QS_WD, scr8, F.lane); } }
#else
            if (r < I_G) { p0_convert_gu(F, F.in[I_FG], 1024, 2816, (bf16*)(F.ws + WS_WGU), r, 0, scr); continue; } r -= I_G;
            if (r < I_G) { p0_convert_gu(F, F.in[I_FU], 1024, 2816, (bf16*)(F.ws + WS_WGU), r, 1, scr); continue; } r -= I_G;
            p0_convert_plain(F, F.in[I_FD], 2816, 1024, (bf16*)(F.ws + WS_WD), r, scr);
#endif
        }
    }
}

struct NormVecs { f32x4 gs[4], sh[4]; };
DI void norm_load_vecs(Frame& F, const float* g, const float* mod, int isc, int ish, NormVecs& V) {
#pragma unroll
    for (int j = 0; j < 4; ++j) { const f32x4 gv = ((const f32x4*)g)[F.lane + 64 * j], sv = ((const f32x4*)(mod + isc * DM))[F.lane + 64 * j]; V.gs[j] = gv * (sv + 1.0f); V.sh[j] = ((const f32x4*)(mod + ish * DM))[F.lane + 64 * j]; }
}
DI void norm_load_row(Frame& F, const float* srow, f32x4 (&v)[4]) {
    const f32x4* xr = (const f32x4*)srow + F.lane;
#pragma unroll
    for (int j = 0; j < 4; ++j) v[j] = xr[64 * j];
}
DI float norm_ssq(const f32x4 (&v)[4]) { float s = 0.f;
#pragma unroll
    for (int j = 0; j < 4; ++j) s += (v[j].x * v[j].x + v[j].y * v[j].y) + (v[j].z * v[j].z + v[j].w * v[j].w);
    return s; }
DI void norm_finish(Frame& F, const f32x4 (&v)[4], float ssq_total, const NormVecs& V, bf16* orow, f32x4 (&y)[4]) {
    const float rstd = 1.0f / sqrtf(ssq_total * (1.0f / DM) + EPS);
    u32x2* o8 = (u32x2*)orow + F.lane;
#pragma unroll
    for (int j = 0; j < 4; ++j) { y[j] = (v[j] * rstd) * V.gs[j] + V.sh[j]; u32x2 w; w.x = pk2(y[j].x, y[j].y); w.y = pk2(y[j].z, y[j].w); o8[64 * j] = w; }
}
DI void norm_finish8(Frame& F, const f32x4 (&v)[4], float ssq_total, const NormVecs& V, unsigned char* orow, f32x4 (&y)[4]) {
    const float rstd = 1.0f / sqrtf(ssq_total * (1.0f / DM) + EPS);
    unsigned* o4 = (unsigned*)orow + F.lane;
#pragma unroll
    for (int j = 0; j < 4; ++j) { y[j] = (v[j] * rstd) * V.gs[j] + V.sh[j]; o4[64 * j] = pk4_fp8(y[j].x * QS_U, y[j].y * QS_U, y[j].z * QS_U, y[j].w * QS_U); }
}
DI void norm_phase(Frame& F, int l, int which, bool first, int row_lo, bool out8 = false) {
    const float* g = F.in[which == 1 ? I_N1W : I_N2W] + l * DM;
    const float* modlat = (const float*)(F.ws + WS_MODLAT) + (size_t)l * 16 * 6144;
    const float* modctx = (const float*)(F.ws + WS_MODCTX) + (size_t)l * 6144;
    const int ish = which == 1 ? 0 : 3, isc = which == 1 ? 1 : 4;
    const float* sctx = first ? F.in[I_CTX] : (const float*)(F.ws + WS_HCTX);
    const float* slat = first ? F.in[I_X] : F.out;
    bf16* U = (bf16*)(F.ws + WS_U);
    const int gw = F.bid * 8 + F.wave, NGW = F.G * 8;
    const int rpw = (NTOK - row_lo + NGW - 1) / NGW;
    const int r0 = row_lo + gw * rpw; int r1 = r0 + rpw; if (r1 > NTOK) r1 = NTOK;
    NormVecs V; int curb = -2;
    for (int row = r0; row < r1; row += 2) {
        const bool two = row + 1 < r1;
        const int rowb = two ? row + 1 : row;
        f32x4 va[4], vb[4];
        norm_load_row(F, row < NCTX ? sctx + (size_t)row * DM : slat + (size_t)(row - NCTX) * DM, va);
        norm_load_row(F, rowb < NCTX ? sctx + (size_t)rowb * DM : slat + (size_t)(rowb - NCTX) * DM, vb);
        float sa = norm_ssq(va), sb = norm_ssq(vb);
#pragma unroll
        for (int o = 1; o < 64; o <<= 1) { sa += __shfl_xor(sa, o); sb += __shfl_xor(sb, o); }
        f32x4 y[4];
        { const int bk = row < NCTX ? -1 : (row - NCTX) / SEQ; if (bk != curb) { norm_load_vecs(F, g, bk < 0 ? modctx : modlat + (size_t)bk * 6144, isc, ish, V); curb = bk; } }
        if (out8) norm_finish8(F, va, sa, V, (unsigned char*)U + (size_t)row * DM, y); else norm_finish(F, va, sa, V, U + (size_t)row * DM, y);
        if (two) { const int bk = rowb < NCTX ? -1 : (rowb - NCTX) / SEQ; if (bk != curb) { norm_load_vecs(F, g, bk < 0 ? modctx : modlat + (size_t)bk * 6144, isc, ish, V); curb = bk; }
            if (out8) norm_finish8(F, vb, sb, V, (unsigned char*)U + (size_t)rowb * DM, y); else norm_finish(F, vb, sb, V, U + (size_t)rowb * DM, y); }
    }
}
DI void moe_route_row(Frame& F, const f32x4 (&y)[4], LAS const float* Rw, const float (&rb)[8], LAS int* sel, int tl, int tok) {
    float lg[8];
#pragma unroll
    for (int e = 0; e < 8; ++e) lg[e] = 0.f;
#pragma unroll
    for (int j = 0; j < 4; ++j)
#pragma unroll
        for (int q = 0; q < 4; ++q) { const int k = 256 * j + 4 * F.lane + q; const f32x4 r0 = *(const LAS f32x4*)(Rw + k * 8), r1 = *(const LAS f32x4*)(Rw + k * 8 + 4); const float yv = y[j][q];
            lg[0] += yv * r0[0]; lg[1] += yv * r0[1]; lg[2] += yv * r0[2]; lg[3] += yv * r0[3]; lg[4] += yv * r1[0]; lg[5] += yv * r1[1]; lg[6] += yv * r1[2]; lg[7] += yv * r1[3]; }
#pragma unroll
    for (int o = 1; o < 64; o <<= 1) {
#pragma unroll
        for (int e = 0; e < 8; ++e) lg[e] += __shfl_xor(lg[e], o); }
#pragma unroll
    for (int e = 0; e < 8; ++e) lg[e] += rb[e];
    int e1 = 0; float v1 = lg[0];
#pragma unroll
    for (int e = 1; e < 8; ++e) if (lg[e] > v1) { v1 = lg[e]; e1 = e; }
    int e2 = -1; float v2 = -3.0e38f;
#pragma unroll
    for (int e = 0; e < 8; ++e) if (e != e1 && lg[e] > v2) { v2 = lg[e]; e2 = e; }
    const float ex = __expf(v2 - v1), p1 = 1.0f / (1.0f + ex), p2 = ex / (1.0f + ex);
    if (F.lane == 0) { sel[tl * 2] = e1; sel[tl * 2 + 1] = e2; float* pt = (float*)(F.ws + WS_PTOK) + (size_t)tok * 2; pt[0] = p1; pt[1] = p2; }
}
DI void norm_moe_phase(Frame& F) {
    const int l = 1;
    const float* g = F.in[I_N2W] + l * DM;
    const float* modlat = (const float*)(F.ws + WS_MODLAT) + (size_t)l * 16 * 6144;
    bf16* U = (bf16*)(F.ws + WS_U);
    LAS float* Rw = (LAS float*)F.lds;
    LAS int* sel = (LAS int*)(F.lds + 32768);
    for (int idx = F.tid; idx < 8192; idx += 512) Rw[idx] = F.in[I_MR][idx];
    __syncthreads();
    float rb[8];
#pragma unroll
    for (int e = 0; e < 8; ++e) rb[e] = F.in[I_MRB][e];
    NormVecs V; int curb = -2;
    for (int seg = F.bid; seg < 256; seg += F.G) {
        const int bk = (seg * 128) / SEQ; if (bk != curb) { norm_load_vecs(F, g, modlat + (size_t)bk * 6144, 4, 3, V); curb = bk; }
        for (int i = 0; i < 16; i += 2) {
            const int tl = F.wave * 16 + i, tok = seg * 128 + tl;
            f32x4 va[4], vb[4];
            norm_load_row(F, F.out + (size_t)tok * DM, va); norm_load_row(F, F.out + (size_t)(tok + 1) * DM, vb);
            float sa = norm_ssq(va), sb = norm_ssq(vb);
#pragma unroll
            for (int o = 1; o < 64; o <<= 1) { sa += __shfl_xor(sa, o); sb += __shfl_xor(sb, o); }
            f32x4 y[4];
#if MOE_FP8
            norm_finish8(F, va, sa, V, (unsigned char*)U + (size_t)tok * DM, y); moe_route_row(F, y, Rw, rb, sel, tl, tok);
            norm_finish8(F, vb, sb, V, (unsigned char*)U + (size_t)(tok + 1) * DM, y); moe_route_row(F, y, Rw, rb, sel, tl + 1, tok + 1);
#else
            norm_finish(F, va, sa, V, U + (size_t)(NCTX + tok) * DM, y); moe_route_row(F, y, Rw, rb, sel, tl, tok);
            norm_finish(F, vb, sb, V, U + (size_t)(NCTX + tok + 1) * DM, y); moe_route_row(F, y, Rw, rb, sel, tl + 1, tok + 1);
#endif
        }
        __syncthreads();
        if (F.tid < 16) { const int s = F.tid >> 3, e = F.tid & 7; int cnt = 0; int* lst = (int*)(F.ws + WS_SEGLIST) + ((size_t)(seg * 2 + s) * 8 + e) * 128;
            for (int i = 0; i < 128; ++i) if (sel[i * 2 + s] == e) lst[cnt++] = seg * 128 + i;
            ((int*)(F.ws + WS_SEGCNT))[(seg * 2 + s) * 8 + e] = cnt; }
        __syncthreads();
    }
}
DI void moe_route_phase(Frame& F) {
    LAS int* cn = (LAS int*)F.lds;
    LAS int* offs = cn + 2048;
    LAS int* tb = offs + 256;
    for (int unit = F.bid; unit < 16; unit += F.G) {
        const int s = unit >> 3, e = unit & 7;
        const int* segcnt = (const int*)(F.ws + WS_SEGCNT);
        for (int idx = F.tid; idx < 2048; idx += 512) { const int ee = idx >> 8, gsg = idx & 255; cn[idx] = segcnt[(gsg * 2 + s) * 8 + ee]; }
        __syncthreads();
        if (F.tid < 8) { int tot = 0; for (int gsg = 0; gsg < 256; ++gsg) tot += cn[F.tid * 256 + gsg]; tb[16 + F.tid] = tot; }
        if (F.tid == 64) { int run = 0; for (int gsg = 0; gsg < 256; ++gsg) { offs[gsg] = run; run += cn[e * 256 + gsg]; } }
        __syncthreads();
        if (F.tid == 0) { int run = 0; for (int ee = 0; ee < 8; ++ee) { tb[ee] = run; run += (tb[16 + ee] + 255) / 256; } tb[8] = run; }
        __syncthreads();
        int* rowmap = (int*)(F.ws + WS_ROWMAP) + (size_t)s * MOE_ROWS;
        float* prow = (float*)(F.ws + WS_PROW) + (size_t)s * MOE_ROWS;
        const float* ptok = (const float*)(F.ws + WS_PTOK);
        const int base = tb[e] * 256, tot = tb[16 + e], ntile = (tot + 255) / 256;
        if (F.tid < 256) { const int gsg = F.tid; const int c = cn[e * 256 + gsg]; const int* lst = (const int*)(F.ws + WS_SEGLIST) + ((size_t)(gsg * 2 + s) * 8 + e) * 128;
            for (int i = 0; i < c; ++i) { const int tok = lst[i]; rowmap[base + offs[gsg] + i] = tok; prow[base + offs[gsg] + i] = ptok[(size_t)tok * 2 + s]; } }
        for (int i = tot + F.tid; i < ntile * 256; i += 512) { rowmap[base + i] = -1; prow[base + i] = 0.f; }
        if (e == 0) { int* meta = (int*)(F.ws + WS_META) + s * 256;
            if (F.tid == 0) meta[0] = tb[8];
            if (F.tid < 8) { const int t0 = tb[F.tid], t1 = tb[F.tid + 1]; for (int t = t0; t < t1; ++t) meta[1 + t] = F.tid; } }
        __syncthreads();
    }
}
DI void final_phase(Frame& F) {
    const float* g = F.in[I_FNW];
    f32x4 gv[4];
#pragma unroll
    for (int j = 0; j < 4; ++j) gv[j] = ((const f32x4*)g)[F.lane + 64 * j];
    const int gw = F.bid * 8 + F.wave, NGW = F.G * 8;
    const int rpw = (NLAT + NGW - 1) / NGW; const int r0 = gw * rpw; int r1 = r0 + rpw; if (r1 > NLAT) r1 = NLAT;
    for (int row = r0; row < r1; row += 2) {
        const bool two = row + 1 < r1; const int rowb = two ? row + 1 : row;
        f32x4 va[4], vb[4];
        norm_load_row(F, F.out + (size_t)row * DM, va); norm_load_row(F, F.out + (size_t)rowb * DM, vb);
        float sa = norm_ssq(va), sb = norm_ssq(vb);
#pragma unroll
        for (int o = 1; o < 64; o <<= 1) { sa += __shfl_xor(sa, o); sb += __shfl_xor(sb, o); }
        const float ra = 1.0f / sqrtf(sa * (1.0f / DM) + EPS), rbv = 1.0f / sqrtf(sb * (1.0f / DM) + EPS);
        f32x4* xa = (f32x4*)(F.out + (size_t)row * DM) + F.lane; f32x4* xb = (f32x4*)(F.out + (size_t)rowb * DM) + F.lane;
#pragma unroll
        for (int j = 0; j < 4; ++j) xa[64 * j] = (va[j] * ra) * gv[j];
        if (two) {
#pragma unroll
            for (int j = 0; j < 4; ++j) xb[64 * j] = (vb[j] * rbv) * gv[j]; }
    }
}

DI void conv_unit(Frame& F, int l, int row0, int t0, int slen) {
    const bf16* PX = (const bf16*)(F.ws + WS_P);
    bf16* YC = (bf16*)(F.ws + WS_U);
    LAS float* Y = (LAS float*)F.lds;
    { u32x4 av[6], gv[6];
#pragma unroll
      for (int k = 0; k < 6; ++k) { const int it = F.tid + 512 * k; const int rr = it >> 5, cc = it & 31; const int t = t0 - 15 + rr;
          av[k] = (u32x4){0u, 0u, 0u, 0u}; gv[k] = av[k];
          if (it < 94 * 32 && t >= 0 && t < slen) { const bf16* p = PX + (size_t)(row0 + t) * INW + C_CONV + 8 * cc; av[k] = *(const u32x4*)p; gv[k] = *(const u32x4*)(p + 256); } }
#pragma unroll
      for (int k = 0; k < 6; ++k) { const int it = F.tid + 512 * k; const int rr = it >> 5, cc = it & 31;
          if (it < 94 * 32) { f32x4 o0, o1;
              o0[0] = bflo(av[k].x) * sigmoidf_(bflo(gv[k].x)); o0[1] = bfhi(av[k].x) * sigmoidf_(bfhi(gv[k].x)); o0[2] = bflo(av[k].y) * sigmoidf_(bflo(gv[k].y)); o0[3] = bfhi(av[k].y) * sigmoidf_(bfhi(gv[k].y));
              o1[0] = bflo(av[k].z) * sigmoidf_(bflo(gv[k].z)); o1[1] = bfhi(av[k].z) * sigmoidf_(bfhi(gv[k].z)); o1[2] = bflo(av[k].w) * sigmoidf_(bflo(gv[k].w)); o1[3] = bfhi(av[k].w) * sigmoidf_(bfhi(gv[k].w));
              *(LAS f32x4*)(Y + rr * 256 + 8 * cc) = o0; *(LAS f32x4*)(Y + rr * 256 + 8 * cc + 4) = o1; } } }
    __syncthreads();
    const int c = F.tid & 255, half = F.tid >> 8;
    float w[31];
#pragma unroll
    for (int k = 0; k < 31; ++k) w[k] = F.in[I_CONVW][(size_t)l * 31 * 256 + k * 256 + c];
    float acc[32];
    const float cb = F.in[I_CONVB][l * 256 + c];
#pragma unroll
    for (int o = 0; o < 32; ++o) acc[o] = cb;
#pragma unroll
    for (int kk = 0; kk < 62; ++kk) { const float yv = Y[(32 * half + kk) * 256 + c];
#pragma unroll
        for (int o = 0; o < 32; ++o) { const int tap = kk - o; if (tap >= 0 && tap < 31) acc[o] += yv * w[tap]; } }
    __syncthreads();
#pragma unroll
    for (int o = 0; o < 32; ++o) Y[(32 * half + o) * 256 + c] = acc[o];
    __syncthreads();
    const f32x4 lw = ((const f32x4*)(F.in[I_CLNW] + l * 256))[F.lane], lb = ((const f32x4*)(F.in[I_CLNB] + l * 256))[F.lane];
    for (int i = 0; i < 8; ++i) { const int tl = F.wave * 8 + i; const f32x4 v = *(const LAS f32x4*)(Y + tl * 256 + 4 * F.lane);
        const float mu = wave_sum((v.x + v.y) + (v.z + v.w)) * (1.0f / 256.0f); const f32x4 d = v - mu;
        const float var = wave_sum((d.x * d.x + d.y * d.y) + (d.z * d.z + d.w * d.w)) * (1.0f / 256.0f); const float rstd = 1.0f / sqrtf(var + EPS);
        f32x4 z = d * rstd * lw + lb; z.x *= sigmoidf_(z.x); z.y *= sigmoidf_(z.y); z.z *= sigmoidf_(z.z); z.w *= sigmoidf_(z.w);
        u32x2 o; o.x = pk2(z.x, z.y); o.y = pk2(z.z, z.w);
        *(u32x2*)(YC + (size_t)(row0 + t0 + tl) * DM + 512 + 4 * F.lane) = o; }
    __syncthreads();
}
DI void ret_consts(Frame& F, int l, int hh, float& lg2f, float& lg2b) {
    const float df = F.in[I_RDEC][(l * 2 + 0) * 4 + hh], db = F.in[I_RDEC][(l * 2 + 1) * 4 + hh];
    lg2f = log2f(1.0f - exp2f(-df)); lg2b = log2f(1.0f - exp2f(-db));
}
constexpr int ROPE_LDS = AUX_OFF + 4096;
DI void rope_to_lds(Frame& F) { const float* tab = (const float*)(F.ws + WS_ROPE); LAS float* rt = (LAS float*)(F.lds + ROPE_LDS); for (int i = F.tid; i < 1024; i += 512) rt[i] = tab[i]; __syncthreads(); }
DI void unpack8(const u32x4& a, float (&x)[8]) { x[0] = bflo(a.x); x[1] = bfhi(a.x); x[2] = bflo(a.y); x[3] = bfhi(a.y); x[4] = bflo(a.z); x[5] = bfhi(a.z); x[6] = bflo(a.w); x[7] = bfhi(a.w); }
DI void rope_apply(Frame& F, const u32x4& a, const u32x4& b, int hp, bool lat, int tg, float (&x1)[8], float (&x2)[8]) {
    unpack8(a, x1); unpack8(b, x2);
    if (lat) { const int pos = hp == 0 ? (tg >> 6) : (tg & 63); LAS const f32x4* tab = (LAS const f32x4*)(F.lds + ROPE_LDS) + pos * 4;
#pragma unroll
        for (int jj = 0; jj < 4; ++jj) { const f32x4 cs = tab[jj];
            { const float a1 = x1[2 * jj], a2 = x2[2 * jj]; x1[2 * jj] = a1 * cs[0] - a2 * cs[1]; x2[2 * jj] = a2 * cs[0] + a1 * cs[1]; }
            { const float a1 = x1[2 * jj + 1], a2 = x2[2 * jj + 1]; x1[2 * jj + 1] = a1 * cs[2] - a2 * cs[3]; x2[2 * jj + 1] = a2 * cs[2] + a1 * cs[3]; } } }
}
DI void ret_unit_decode(int su, bool& isctx, int& b, int& hh, int& n) {
    isctx = su >= 1024; if (!isctx) { b = su >> 6; hh = (su >> 4) & 3; n = su & 15; } else { const int v = su - 1024; b = v >> 3; hh = (v >> 1) & 3; n = v & 1; }
}
DI void ret_summary_pair(Frame& F, int l, int it) {
    const bf16* PX = (const bf16*)(F.ws + WS_P);
    const int sub = F.wave >> 2, st = F.tid & 255, su = 2 * it + sub;
    bool isctx; int b, hh, n; ret_unit_decode(su, isctx, b, hh, n);
    const int row0 = isctx ? (b * CTXL + n * 128) : (NCTX + b * SEQ + n * 128);
    float lg2f, lg2b; ret_consts(F, l, hh, lg2f, lg2b);
    LAS unsigned char* base = F.lds + sub * 40960;
    LAS unsigned char* Vimg = base;
    LAS unsigned char* Kf = base + 18432;
    LAS unsigned char* Kb = base + 18432 + 10240;
    { const int tok = st >> 1, hp = st & 1; float x1[8], x2[8];
      const bf16* kp = PX + (size_t)(row0 + tok) * INW + C_RK + 32 * hh; const bf16* vp = PX + (size_t)(row0 + tok) * INW + C_RV + 64 * hh + 32 * hp;
      const u32x4 kra = *(const u32x4*)(kp + 8 * hp), krb = *(const u32x4*)(kp + 16 + 8 * hp);
      u32x4 vr[4];
#pragma unroll
      for (int q = 0; q < 4; ++q) vr[q] = *(const u32x4*)(vp + 8 * q);
      rope_apply(F, kra, krb, hp, !isctx, n * 128 + tok, x1, x2);
      const float ks = 0.17677669529663687f;
      const float wf = fast_exp2(lg2f * (float)(127 - tok)) * ks, wb = fast_exp2(lg2b * (float)tok) * ks;
      u32x4 o;
      o.x = pk2(x1[0] * wf, x1[1] * wf); o.y = pk2(x1[2] * wf, x1[3] * wf); o.z = pk2(x1[4] * wf, x1[5] * wf); o.w = pk2(x1[6] * wf, x1[7] * wf); *(LAS u32x4*)(Kf + tok * 80 + 16 * hp) = o;
      o.x = pk2(x2[0] * wf, x2[1] * wf); o.y = pk2(x2[2] * wf, x2[3] * wf); o.z = pk2(x2[4] * wf, x2[5] * wf); o.w = pk2(x2[6] * wf, x2[7] * wf); *(LAS u32x4*)(Kf + tok * 80 + 32 + 16 * hp) = o;
      o.x = pk2(x1[0] * wb, x1[1] * wb); o.y = pk2(x1[2] * wb, x1[3] * wb); o.z = pk2(x1[4] * wb, x1[5] * wb); o.w = pk2(x1[6] * wb, x1[7] * wb); *(LAS u32x4*)(Kb + tok * 80 + 16 * hp) = o;
      o.x = pk2(x2[0] * wb, x2[1] * wb); o.y = pk2(x2[2] * wb, x2[3] * wb); o.z = pk2(x2[4] * wb, x2[5] * wb); o.w = pk2(x2[6] * wb, x2[7] * wb); *(LAS u32x4*)(Kb + tok * 80 + 32 + 16 * hp) = o;
#pragma unroll
      for (int q = 0; q < 4; ++q) *(LAS u32x4*)(Vimg + tok * 144 + 64 * hp + 16 * q) = vr[q]; }
    __syncthreads();
    { const int role = F.wave & 3, dir = role >> 1, et = role & 1;
      const int l32 = F.lane & 31, h = F.lane >> 5, grp = (F.lane >> 4) & 1, i16 = F.lane & 15, q = i16 >> 2, p = i16 & 3;
      LAS unsigned char* Kimg = dir ? Kb : Kf;
      f32x16 acc;
#pragma unroll
      for (int i = 0; i < 16; ++i) acc[i] = 0.f;
#pragma unroll
      for (int s = 0; s < 8; ++s) { const int r0 = 16 * s + 8 * h + q;
          const s16x4 alo = trread(Vimg + r0 * 144 + (32 * et + 16 * grp + 4 * p) * 2), ahi = trread(Vimg + (r0 + 4) * 144 + (32 * et + 16 * grp + 4 * p) * 2);
          const s16x4 blo = trread(Kimg + r0 * 80 + (16 * grp + 4 * p) * 2), bhi = trread(Kimg + (r0 + 4) * 80 + (16 * grp + 4 * p) * 2);
          const bf16x8 a = __builtin_shufflevector(alo, ahi, 0, 1, 2, 3, 4, 5, 6, 7), bb = __builtin_shufflevector(blo, bhi, 0, 1, 2, 3, 4, 5, 6, 7);
          acc = MFMA32(a, bb, acc); }
      float* S = isctx ? (float*)(F.ws + WS_SUMCTX) + ((size_t)((b * 4 + hh) * 2 + n) * 2 + dir) * 2048 : (float*)(F.ws + WS_SUMLAT) + ((size_t)((b * 4 + hh) * 16 + n) * 2 + dir) * 2048;
#pragma unroll
      for (int i = 0; i < 16; ++i) S[(32 * et + crow(i, h)) * 32 + l32] = acc[i]; }
    __syncthreads();
}
DI void ca_phase(Frame& F, int l) {
    rope_to_lds(F);
    const int nconv = l == 0 ? 576 : 512;
    for (int u = F.vb; u < nconv; u += F.G) {
        int v = u; if (l != 0) v += 64;
        if (v < 64) conv_unit(F, l, (v >> 2) * CTXL, (v & 3) * 64, CTXL);
        else { v -= 64; conv_unit(F, l, NCTX + (v >> 5) * SEQ, (v & 31) * 64, SEQ); }
    }
    for (int it = F.vb; it < 576; it += F.G) ret_summary_pair(F, l, it);
}

constexpr int ATT_KV = 18432, ATT_BUF = 2 * ATT_KV, ATT_BT = 2 * ATT_BUF, ATT_NEG = 640;
struct AttRegs { u32x4 k0, v0, k1, v1; };
DI void attn_fetch(const bf16* PX, int rowA, int rowB, unsigned loff, AttRegs& R) {
    const char* pa = (const char*)(PX + (size_t)rowA * INW) + loff; const char* pb = (const char*)(PX + (size_t)rowB * INW) + loff;
    R.k0 = *(const u32x4*)(pa + C_NAK * 2); R.v0 = *(const u32x4*)(pa + C_NAV * 2); R.k1 = *(const u32x4*)(pb + C_NAK * 2); R.v1 = *(const u32x4*)(pb + C_NAV * 2);
}
DI void attn_put(Frame& F, LAS unsigned char* buf, const AttRegs& R) {
    const int key = F.tid >> 3, ch = F.tid & 7;
    *(LAS u32x4*)(buf + key * 144 + 16 * ch) = R.k0; *(LAS u32x4*)(buf + ATT_KV + key * 144 + 16 * ch) = R.v0;
    *(LAS u32x4*)(buf + (64 + key) * 144 + 16 * ch) = R.k1; *(LAS u32x4*)(buf + ATT_KV + (64 + key) * 144 + 16 * ch) = R.v1;
}
template <bool BIAS, int NT>
DI void attn_tiles(LAS const unsigned char* buf, const int (&koff)[2], const bf16x8 (&qf)[4], f32x16& o0, f32x16& o1, f32x16& o2, float& mrun, int lane,
                   LAS const float* const (&bt)[2]  , const float (&pen)[16]) {
    LAS const unsigned char* Kimg = buf; LAS const unsigned char* Vimg = buf + ATT_KV;
    const int l32 = lane & 31, h = lane >> 5, grp = (lane >> 4) & 1, i16 = lane & 15, q = i16 >> 2, p = i16 & 3;
    f32x16 s[NT];
#pragma unroll
    for (int t = 0; t < NT; ++t)
#pragma unroll
        for (int i = 0; i < 16; ++i) s[t][i] = 0.f;
#pragma unroll
    for (int si = 0; si < 4; ++si)
#pragma unroll
        for (int t = 0; t < NT; ++t) { const bf16x8 a = *(const LAS bf16x8*)(Kimg + (koff[t] + l32) * 144 + (16 * si + 8 * h) * 2); s[t] = MFMA32(a, qf[si], s[t]); }
    const float c = 0.125f * LOG2E;
    float v[NT][16]; float mx = -1.0e30f;
#pragma unroll
    for (int t = 0; t < NT; ++t)
#pragma unroll
        for (int i = 0; i < 16; ++i) { float x;
            if (BIAS) x = __builtin_fmaf(s[t][i], c, bt[t][(i & 3) + 8 * (i >> 2)]) + pen[i]; else x = s[t][i];
            v[t][i] = x; mx = fmaxf(mx, x); }
    if (!BIAS) mx *= c;
    mx = fmaxf(mx, __shfl_xor(mx, 32));
    const float mnew = fmaxf(mrun, mx);
    const float alpha = fast_exp2(mrun - mnew);
    if (__any(alpha != 1.0f)) {
#pragma unroll
        for (int i = 0; i < 16; ++i) { o0[i] *= alpha; o1[i] *= alpha; o2[i] *= alpha; } }
    mrun = mnew;
    bf16x8 pf[NT][2];
#pragma unroll
    for (int t = 0; t < NT; ++t) { float pp[16];
#pragma unroll
        for (int i = 0; i < 16; ++i) pp[i] = BIAS ? fast_exp2(v[t][i] - mnew) : fast_exp2(__builtin_fmaf(v[t][i], c, -mnew));
#pragma unroll
        for (int s2 = 0; s2 < 2; ++s2) { u32x4 w; w.x = pk2(pp[8 * s2], pp[8 * s2 + 1]); w.y = pk2(pp[8 * s2 + 2], pp[8 * s2 + 3]); w.z = pk2(pp[8 * s2 + 4], pp[8 * s2 + 5]); w.w = pk2(pp[8 * s2 + 6], pp[8 * s2 + 7]); pf[t][s2] = __builtin_bit_cast(bf16x8, w); } }
    const u32x4 onesw = (u32x4){0x3f803f80u, 0x3f803f80u, 0x3f803f80u, 0x3f803f80u}; const bf16x8 ones = __builtin_bit_cast(bf16x8, onesw);
#pragma unroll
    for (int t = 0; t < NT; ++t)
#pragma unroll
        for (int s2 = 0; s2 < 2; ++s2) { const int r0 = koff[t] + 16 * s2 + 4 * h + q;
#pragma unroll
            for (int et = 0; et < 2; ++et) { const int cb = (32 * et + 16 * grp + 4 * p) * 2;
                const s16x4 lo = trread(Vimg + r0 * 144 + cb), hi = trread(Vimg + (r0 + 8) * 144 + cb);
                const bf16x8 a = __builtin_shufflevector(lo, hi, 0, 1, 2, 3, 4, 5, 6, 7);
                if (et == 0) o0 = MFMA32(a, pf[t][s2], o0); else o1 = MFMA32(a, pf[t][s2], o1); }
            o2 = MFMA32(ones, pf[t][s2], o2); }
}
DI void attn_unit(Frame& F, int l, bool na, int b, int hh, int rg) {
    const bf16* PX = (const bf16*)(F.ws + WS_P);
    bf16* YC = (bf16*)(F.ws + WS_U);
    LAS float* btab = (LAS float*)(F.lds + ATT_BT);
    const int l32 = F.lane & 31, h = F.lane >> 5;
    int qrow, r = 0, qcol = 0, kc0 = 0, ra = 0;
    float pen[16];
#pragma unroll
    for (int i = 0; i < 16; ++i) pen[i] = 0.f;
    if (na) { const int rp = F.wave >> 2, n = F.wave & 3; ra = 4 * rg + 2 * rp; r = ra + (l32 >> 4); qcol = 16 * n + (l32 & 15); qrow = NCTX + b * SEQ + r * GW + qcol;
        int w0 = qcol - 8; w0 = w0 < 0 ? 0 : (w0 > 48 ? 48 : w0); kc0 = 16 * n - 8; kc0 = kc0 < 0 ? 0 : (kc0 > 32 ? 32 : kc0);
#pragma unroll
        for (int i = 0; i < 16; ++i) pen[i] = ((unsigned)(kc0 + crow(i, h) - w0) < 16u) ? 0.f : -1.0e30f; }
    else qrow = b * CTXL + 32 * F.wave + l32;
    bf16x8 qf[4];
#pragma unroll
    for (int si = 0; si < 4; ++si) qf[si] = *(const bf16x8*)(PX + (size_t)qrow * INW + C_NAQ + 64 * hh + 16 * si + 8 * h);
    if (na) { for (int idx = F.tid; idx < ATT_NEG + 128; idx += 512) { float v = 0.f; if (idx >= 48 && idx < 48 + 465) v = F.in[I_RPB][((size_t)l * 8 + hh) * 465 + (idx - 48)] * LOG2E; if (idx >= ATT_NEG) v = -1.0e30f; btab[idx] = v; } }
    f32x16 o0, o1, o2;
#pragma unroll
    for (int i = 0; i < 16; ++i) { o0[i] = 0.f; o1[i] = 0.f; o2[i] = 0.f; }
    float mrun = -1.0e30f;
    int ylo = 0, yhi = 0, nsteps = 2;
    if (na) { const int rlo = 4 * rg, rhi = 4 * rg + 3;
        ylo = rlo - 4; ylo = ylo < 0 ? 0 : (ylo > 24 ? 24 : ylo);
        yhi = rhi - 4; yhi = yhi < 0 ? 0 : (yhi > 24 ? 24 : yhi); yhi += 8; nsteps = 2 + (yhi - ylo + 1) / 2; }
    int sa = ra - 4; sa = sa < 0 ? 0 : (sa > 24 ? 24 : sa);
    int sb = ra + 1 - 4; sb = sb < 0 ? 0 : (sb > 24 ? 24 : sb);
    const int mylo = (l32 >> 4) ? sb : sa;
    const int cbase = kc0 + 4 * h - qcol + 15;
#define ATT_ROWA(sx) ((sx) < 2 ? b * CTXL + 128 * (sx) : NCTX + b * SEQ + (ylo + 2 * ((sx) - 2)) * GW)
#define ATT_ROWB(sx) ((sx) < 2 ? b * CTXL + 128 * (sx) + 64 : NCTX + b * SEQ + ((ylo + 2 * ((sx) - 2) + 1) < yhi ? (ylo + 2 * ((sx) - 2) + 1) : (yhi - 1)) * GW)
    AttRegs R;
    unsigned loff = (unsigned)(((F.tid >> 3) * INW + 64 * hh + 8 * (F.tid & 7)) * 2); asm volatile("" : "+v"(loff));
    attn_fetch(PX, ATT_ROWA(0), ATT_ROWB(0), loff, R);
    for (int st = 0; st < nsteps; ++st) {
        LAS unsigned char* buf = F.lds + (st & 1) * ATT_BUF;
        attn_put(F, buf, R);
        if (st + 1 < nsteps) attn_fetch(PX, ATT_ROWA(st + 1), ATT_ROWB(st + 1), loff, R);
        __syncthreads();
        if (st < 2) {
            LAS const float* const bt[2] = {btab, btab};
            { const int ko[2] = {0, 32}; attn_tiles<false, 2>(buf, ko, qf, o0, o1, o2, mrun, F.lane, bt, pen); }
            { const int ko[2] = {64, 96}; attn_tiles<false, 2>(buf, ko, qf, o0, o1, o2, mrun, F.lane, bt, pen); }
        } else {
            const int y0 = ylo + 2 * (st - 2), y1 = y0 + 1;
            const bool act0 = (y0 >= sa && y0 < sb + 8), act1 = (y1 < yhi && y1 >= sa && y1 < sb + 8);
            const bool ok0 = (unsigned)(y0 - mylo) < 8u, ok1 = (unsigned)(y1 - mylo) < 8u;
            LAS const float* b0 = btab + (ok0 ? 48 + (y0 - r + 7) * 31 + cbase : ATT_NEG);
            LAS const float* b1 = btab + (ok1 ? 48 + (y1 - r + 7) * 31 + cbase : ATT_NEG);
            if (act0 && act1) { const int ko[2] = {kc0, 64 + kc0}; LAS const float* const bt[2] = {b0, b1}; attn_tiles<true, 2>(buf, ko, qf, o0, o1, o2, mrun, F.lane, bt, pen); }
            else if (act0) { const int ko[2] = {kc0, kc0}; LAS const float* const bt[2] = {b0, b0}; attn_tiles<true, 1>(buf, ko, qf, o0, o1, o2, mrun, F.lane, bt, pen); }
            else if (act1) { const int ko[2] = {64 + kc0, 64 + kc0}; LAS const float* const bt[2] = {b1, b1}; attn_tiles<true, 1>(buf, ko, qf, o0, o1, o2, mrun, F.lane, bt, pen); }
        }
    }
#undef ATT_ROWA
#undef ATT_ROWB
    const float inv = 1.0f / o2[0];
    bf16* orow = YC + (size_t)qrow * DM + 64 * hh;
#pragma unroll
    for (int gq = 0; gq < 4; ++gq) { u32x2 w;
        w.x = pk2(o0[4 * gq] * inv, o0[4 * gq + 1] * inv); w.y = pk2(o0[4 * gq + 2] * inv, o0[4 * gq + 3] * inv); *(u32x2*)(orow + 8 * gq + 4 * h) = w;
        w.x = pk2(o1[4 * gq] * inv, o1[4 * gq + 1] * inv); w.y = pk2(o1[4 * gq + 2] * inv, o1[4 * gq + 3] * inv); *(u32x2*)(orow + 32 + 8 * gq + 4 * h) = w; }
    __syncthreads();
}
DI void ret_out_unit(Frame& F, int l, int su) {
    const bf16* PX = (const bf16*)(F.ws + WS_P);
    bf16* YC = (bf16*)(F.ws + WS_U);
    bool isctx; int b, hh, n; ret_unit_decode(su, isctx, b, hh, n);
    const int row0 = isctx ? (b * CTXL + n * 128) : (NCTX + b * SEQ + n * 128);
    float lg2f, lg2b; ret_consts(F, l, hh, lg2f, lg2b);
    LAS unsigned char* Kimg = F.lds;
    LAS unsigned char* Vimg = F.lds + 10240;
    LAS unsigned char* Stf = F.lds + 28672;
    LAS unsigned char* Stb = F.lds + 33792;
    LAS float* Ob = (LAS float*)(F.lds + 38912);
    const int dir = F.wave >> 2, qb = F.wave & 3, l32 = F.lane & 31, h = F.lane >> 5, grp = (F.lane >> 4) & 1, i16 = F.lane & 15, q = i16 >> 2, p = i16 & 3;
    const int iq = 32 * qb + l32;
    const int ktok = (F.tid & 255) >> 1, khp = F.tid & 1;
    const bf16* kp = PX + (size_t)(row0 + ktok) * INW + C_RK + 32 * hh;
    const u32x4 kra = *(const u32x4*)(kp + 8 * khp), krb = *(const u32x4*)(kp + 16 + 8 * khp);
    const int vtok = F.tid >> 2, vch = F.tid & 3; const bf16* vp = PX + (size_t)(row0 + vtok) * INW + C_RV + 64 * hh + 16 * vch;
    const u32x4 vra = *(const u32x4*)vp, vrb = *(const u32x4*)(vp + 8);
    const bf16* qp = PX + (size_t)(row0 + iq) * INW + C_RQ + 32 * hh;
    const u32x4 qra = *(const u32x4*)(qp + 8 * h), qrb = *(const u32x4*)(qp + 16 + 8 * h);
    const bf16* gp = PX + (size_t)(row0 + iq) * INW + (dir ? C_GB : C_GF) + 64 * hh;
    u32x2 gg[8];
#pragma unroll
    for (int et = 0; et < 2; ++et)
#pragma unroll
        for (int gq = 0; gq < 4; ++gq) gg[et * 4 + gq] = *(const u32x2*)(gp + 32 * et + 8 * gq + 4 * h);
    const float cf = fast_exp2(lg2f * 128.0f), cb = fast_exp2(lg2b * 128.0f);
    const float* SC = (const float*)(F.ws + WS_SUMCTX) + (size_t)((b * 4 + hh) * 2) * 2 * 2048;
    const float* SL = (const float*)(F.ws + WS_SUMLAT) + (size_t)((b * 4 + hh) * 16) * 2 * 2048;
    f32x4 sf = (f32x4){0.f, 0.f, 0.f, 0.f}, sb = sf; const int eo = 4 * F.tid;
    if (!isctx) {
        f32x4 t[16];
#pragma unroll
        for (int m = 0; m < 16; ++m) t[m] = *(const f32x4*)(SL + (size_t)(m * 2 + (m <= n ? 0 : 1)) * 2048 + eo);
        const f32x4 c00 = *(const f32x4*)(SC + (0 * 2 + 0) * 2048 + eo), c10 = *(const f32x4*)(SC + (1 * 2 + 0) * 2048 + eo);
        const f32x4 c11 = *(const f32x4*)(SC + (1 * 2 + 1) * 2048 + eo), c01 = *(const f32x4*)(SC + (0 * 2 + 1) * 2048 + eo);
        sf = c00 * cf + c10;
#pragma unroll
        for (int m = 0; m < 16; ++m) { const f32x4 nv = sf * cf + t[m]; sf = (m < n) ? nv : sf; }
        sb = c11 * cb + c01;
#pragma unroll
        for (int m = 15; m >= 0; --m) { const f32x4 nv = sb * cb + t[m]; sb = (m > n) ? nv : sb; }
    } else {
        if (n == 1) sf = *(const f32x4*)(SC + (0 * 2 + 0) * 2048 + eo);
        if (n == 0) sb = *(const f32x4*)(SC + (1 * 2 + 1) * 2048 + eo);
    }
    if (F.tid < 256) { float x1[8], x2[8]; rope_apply(F, kra, krb, khp, !isctx, n * 128 + ktok, x1, x2);
        const float ks = 0.17677669529663687f; u32x4 o;
        o.x = pk2(x1[0] * ks, x1[1] * ks); o.y = pk2(x1[2] * ks, x1[3] * ks); o.z = pk2(x1[4] * ks, x1[5] * ks); o.w = pk2(x1[6] * ks, x1[7] * ks); *(LAS u32x4*)(Kimg + ktok * 80 + 16 * khp) = o;
        o.x = pk2(x2[0] * ks, x2[1] * ks); o.y = pk2(x2[2] * ks, x2[3] * ks); o.z = pk2(x2[4] * ks, x2[5] * ks); o.w = pk2(x2[6] * ks, x2[7] * ks); *(LAS u32x4*)(Kimg + ktok * 80 + 32 + 16 * khp) = o; }
    *(LAS u32x4*)(Vimg + vtok * 144 + 32 * vch) = vra; *(LAS u32x4*)(Vimg + vtok * 144 + 32 * vch + 16) = vrb;
    { const int e = eo >> 5, d = eo & 31; u32x2 w;
      w.x = pk2(sf[0], sf[1]); w.y = pk2(sf[2], sf[3]); *(LAS u32x2*)(Stf + e * 80 + d * 2) = w;
      w.x = pk2(sb[0], sb[1]); w.y = pk2(sb[2], sb[3]); *(LAS u32x2*)(Stb + e * 80 + d * 2) = w; }
    bf16x8 qf[2], qd[2];
    { float x1[8], x2[8]; rope_apply(F, qra, qrb, h, !isctx, n * 128 + iq, x1, x2);
      const float dec = dir == 0 ? fast_exp2(lg2f * (float)(iq + 1)) : fast_exp2(lg2b * (float)(128 - iq));
      u32x4 w;
      w.x = pk2(x1[0], x1[1]); w.y = pk2(x1[2], x1[3]); w.z = pk2(x1[4], x1[5]); w.w = pk2(x1[6], x1[7]); qf[0] = __builtin_bit_cast(bf16x8, w);
      w.x = pk2(x2[0], x2[1]); w.y = pk2(x2[2], x2[3]); w.z = pk2(x2[4], x2[5]); w.w = pk2(x2[6], x2[7]); qf[1] = __builtin_bit_cast(bf16x8, w);
      w.x = pk2(x1[0] * dec, x1[1] * dec); w.y = pk2(x1[2] * dec, x1[3] * dec); w.z = pk2(x1[4] * dec, x1[5] * dec); w.w = pk2(x1[6] * dec, x1[7] * dec); qd[0] = __builtin_bit_cast(bf16x8, w);
      w.x = pk2(x2[0] * dec, x2[1] * dec); w.y = pk2(x2[2] * dec, x2[3] * dec); w.z = pk2(x2[4] * dec, x2[5] * dec); w.w = pk2(x2[6] * dec, x2[7] * dec); qd[1] = __builtin_bit_cast(bf16x8, w); }
    __syncthreads();
    f32x16 o0, o1;
#pragma unroll
    for (int i = 0; i < 16; ++i) { o0[i] = 0.f; o1[i] = 0.f; }
    { LAS const unsigned char* St = dir ? Stb : Stf;
#pragma unroll
      for (int s = 0; s < 2; ++s) { const bf16x8 a0 = *(const LAS bf16x8*)(St + l32 * 80 + (16 * s + 8 * h) * 2), a1 = *(const LAS bf16x8*)(St + (32 + l32) * 80 + (16 * s + 8 * h) * 2);
          o0 = MFMA32(a0, qd[s], o0); o1 = MFMA32(a1, qd[s], o1); } }
    const float lgd = dir ? lg2b : lg2f;
    const int kt_lo = dir ? qb : 0, kt_hi = dir ? 3 : qb;
    for (int kt = kt_lo; kt <= kt_hi; ++kt) {
        f32x16 s;
#pragma unroll
        for (int i = 0; i < 16; ++i) s[i] = 0.f;
#pragma unroll
        for (int si = 0; si < 2; ++si) { const bf16x8 a = *(const LAS bf16x8*)(Kimg + (32 * kt + l32) * 80 + (16 * si + 8 * h) * 2); s = MFMA32(a, qf[si], s); }
        float pp[16];
#pragma unroll
        for (int i = 0; i < 16; ++i) { const int j = 32 * kt + crow(i, h); const int diff = dir ? (j - iq) : (iq - j); pp[i] = diff >= 0 ? s[i] * fast_exp2(lgd * (float)diff) : 0.f; }
        bf16x8 pf[2];
#pragma unroll
        for (int s2 = 0; s2 < 2; ++s2) { u32x4 w; w.x = pk2(pp[8 * s2], pp[8 * s2 + 1]); w.y = pk2(pp[8 * s2 + 2], pp[8 * s2 + 3]); w.z = pk2(pp[8 * s2 + 4], pp[8 * s2 + 5]); w.w = pk2(pp[8 * s2 + 6], pp[8 * s2 + 7]); pf[s2] = __builtin_bit_cast(bf16x8, w); }
#pragma unroll
        for (int s2 = 0; s2 < 2; ++s2) { const int r0 = 32 * kt + 16 * s2 + 4 * h + q;
#pragma unroll
            for (int et = 0; et < 2; ++et) { const int cb = (32 * et + 16 * grp + 4 * p) * 2;
                const s16x4 lo = trread(Vimg + r0 * 144 + cb), hi = trread(Vimg + (r0 + 8) * 144 + cb);
                const bf16x8 a = __builtin_shufflevector(lo, hi, 0, 1, 2, 3, 4, 5, 6, 7);
                if (et == 0) o0 = MFMA32(a, pf[s2], o0); else o1 = MFMA32(a, pf[s2], o1); } }
    }
    float sm = 0.f;
#pragma unroll
    for (int i = 0; i < 16; ++i) sm += o0[i] + o1[i];
    sm += __shfl_xor(sm, 32);
    const float mu = sm * (1.0f / 64.0f);
    float vs = 0.f;
#pragma unroll
    for (int i = 0; i < 16; ++i) { const float d0 = o0[i] - mu, d1 = o1[i] - mu; vs += d0 * d0 + d1 * d1; }
    vs += __shfl_xor(vs, 32);
    const float rstd = 1.0f / sqrtf(vs * (1.0f / 64.0f) + EPS);
    const float* gn = F.in[I_RGNW] + l * 256 + 64 * hh;
    float val[32];
#pragma unroll
    for (int et = 0; et < 2; ++et)
#pragma unroll
        for (int gq = 0; gq < 4; ++gq) { const int e0 = 32 * et + 8 * gq + 4 * h; const u32x2 ggv = gg[et * 4 + gq]; const f32x4 gw = *(const f32x4*)(gn + e0);
            const float g0 = bflo(ggv.x), g1 = bfhi(ggv.x), g2 = bflo(ggv.y), g3 = bfhi(ggv.y);
            const float a0 = et ? o1[4 * gq] : o0[4 * gq], a1 = et ? o1[4 * gq + 1] : o0[4 * gq + 1], a2 = et ? o1[4 * gq + 2] : o0[4 * gq + 2], a3 = et ? o1[4 * gq + 3] : o0[4 * gq + 3];
            val[et * 16 + 4 * gq] = (a0 - mu) * rstd * gw[0] * g0 * sigmoidf_(g0); val[et * 16 + 4 * gq + 1] = (a1 - mu) * rstd * gw[1] * g1 * sigmoidf_(g1);
            val[et * 16 + 4 * gq + 2] = (a2 - mu) * rstd * gw[2] * g2 * sigmoidf_(g2); val[et * 16 + 4 * gq + 3] = (a3 - mu) * rstd * gw[3] * g3 * sigmoidf_(g3); }
    if (dir == 0) {
#pragma unroll
        for (int et = 0; et < 2; ++et)
#pragma unroll
            for (int gq = 0; gq < 4; ++gq)
#pragma unroll
                for (int j = 0; j < 4; ++j) Ob[iq * 65 + 32 * et + 8 * gq + 4 * h + j] = val[et * 16 + 4 * gq + j];
    }
    __syncthreads();
    if (dir == 1) { bf16* orow = YC + (size_t)(row0 + iq) * DM + 768 + 64 * hh;
#pragma unroll
        for (int et = 0; et < 2; ++et)
#pragma unroll
            for (int gq = 0; gq < 4; ++gq) { const int e0 = 32 * et + 8 * gq + 4 * h; float t[4];
#pragma unroll
                for (int j = 0; j < 4; ++j) t[j] = val[et * 16 + 4 * gq + j] + Ob[iq * 65 + e0 + j];
                u32x2 w; w.x = pk2(t[0], t[1]); w.y = pk2(t[2], t[3]); *(u32x2*)(orow + e0) = w; } }
    __syncthreads();
}
#ifndef PROBE_SUB
#define PROBE_SUB 0
#endif
DI void cb_phase(Frame& F, int l) {
    rope_to_lds(F);
    const int nattn = l == 0 ? 1152 : 1024;
    for (int rep = 0; rep < ((PROBE_SUB & 1) ? 2 : 1); ++rep)
    for (int u = F.vb; u < nattn; u += F.G) {
        if (u < 1024) attn_unit(F, l, true, u >> 6, (u >> 3) & 7, u & 7);
        else { const int v = u - 1024; attn_unit(F, l, false, v >> 3, v & 7, 0); }
    }
    const int nret = l == 0 ? 1152 : 1024;
    for (int rep = 0; rep < ((PROBE_SUB & 2) ? 2 : 1); ++rep)
    for (int u = F.vb; u < nret; u += F.G) ret_out_unit(F, l, u);
}

static_assert(sizeof(Params) == 240, "kernarg layout: in[26] at 0, out at 208, ws at 216, ph_lo at 224, ph_hi at 228");
#ifdef ONLY_PHASE
#define IN(k) ((k) == ONLY_PHASE && lo <= (k) && (k) < hi)
#else
#define IN(k) (lo <= (k) && (k) < hi)
#endif
#ifndef PROBE_MASK
#define PROBE_MASK 0u
#endif
#define NREP(k) (((PROBE_MASK >> (k)) & 1u) ? 2 : 1)
#define SEAM(k) do { if (IN(k) && IN((k) + 1)) { XcdBarrier bb_ = bar; asm volatile("" : "+s"(bb_.bar)); xcd_barrier(bb_, F.wave); } } while (0)
#define GLDS(P) ((LAS unsigned char*)(P).lds)
#define WSB(P, off) ((const pg8::bf16_t*)((P).ws + (off)))
template <int l> DI void layer_phases(Frame& F, const XcdBarrier& bar) {
    constexpr int lo = 0, hi = N_PHASES;
        const int pb = l == 0 ? 1 : 9;
        if (IN(pb + 0)) for (int rep_ = 0; rep_ < NREP(pb + 0); ++rep_) { if (rep_) __syncthreads(); Frame P = phase_frame(F); norm_phase(P, l, 1, l == 0, 0); } SEAM(pb + 0);
        if (IN(pb + 1)) for (int rep_ = 0; rep_ < NREP(pb + 1); ++rep_) { if (rep_) __syncthreads();
            Frame P = phase_frame(F);
            pg8::StaticOrder S; S.init(NTOK, INW, P.G, P.bid);
            pg8::EpiStoreBf16 E{(pg8::bf16_t*)(P.ws + WS_P), INW};
            pg8::gemm_phase<pg8::EpiStoreBf16, pg8::StaticOrder, pg8::RowsLinear, true>(GLDS(P), P.tid, WSB(P, WS_U), WSB(P, WS_WIN) + (size_t)l * INW * DM, 2 * DM, S, E, pg8::RowsLinear{});
            if (PROBE_SUB & 4) { __syncthreads(); pg8::gemm_phase<pg8::EpiNull, pg8::StaticOrder, pg8::RowsLinear, true>(GLDS(P), P.tid, WSB(P, WS_U), WSB(P, WS_WIN) + (size_t)l * INW * DM, 2 * DM, S, pg8::EpiNull{}, pg8::RowsLinear{}); }
            if (l == 0) bg_convert_tail(P, S.nwg, BG_B0, BG_D0); else bg_convert_tail(P, S.nwg, BG_B1, BG_CL);
        } SEAM(pb + 1);
        if (IN(pb + 2)) for (int rep_ = 0; rep_ < NREP(pb + 2); ++rep_) { if (rep_) __syncthreads(); Frame P = phase_frame(F); if (l == 1) { bg_convert_all(P, BG_CL, BG_ITEMS); __syncthreads(); } ca_phase(P, l); } SEAM(pb + 2);
        if (IN(pb + 3)) for (int rep_ = 0; rep_ < NREP(pb + 3); ++rep_) { if (rep_) __syncthreads(); Frame P = phase_frame(F); cb_phase(P, l); } SEAM(pb + 3);
        if (IN(pb + 4)) {
            Frame P = phase_frame(F);
            const int rb = l == 0 ? 0 : NCTX;
            const float* modlat = (const float*)(P.ws + WS_MODLAT) + (size_t)l * 16 * 6144;
            const float* modctx = (const float*)(P.ws + WS_MODCTX) + (size_t)l * 6144;
            float* hctx = (float*)(P.ws + WS_HCTX);
            pg8::StaticOrder S; S.init(NTOK - rb, DM, P.G, P.bid);
            pg8::EpiResGate E{l == 0 ? P.in[I_CTX] : hctx, l == 0 ? P.in[I_X] : P.out, hctx, P.out, modlat + 2 * DM, modctx + 2 * DM, rb};
            pg8::gemm_phase<pg8::EpiResGate, pg8::StaticOrder, pg8::RowsLinear, true>(GLDS(P), P.tid, WSB(P, WS_U) + (size_t)rb * DM, WSB(P, WS_WOUT) + (size_t)l * DM * DM, 2 * DM, S, E, pg8::RowsLinear{});
            if (l == 0) bg_convert_tail(P, S.nwg, BG_D0, BG_E0);
        } SEAM(pb + 4);
        if (l == 0) {
            if (IN(6)) for (int rep_ = 0; rep_ < NREP(6); ++rep_) { if (rep_) __syncthreads(); Frame P = phase_frame(F); norm_phase(P, 0, 2, false, 0, DENSE_FP8 == 1); } SEAM(6);
            if (IN(7)) for (int rep_ = 0; rep_ < NREP(7); ++rep_) { if (rep_) __syncthreads();
                Frame P = phase_frame(F);
                pg8::StaticOrder S; S.init(NTOK, 2 * DFF, P.G, P.bid);
                pg8::EpiSwiglu<false> E{(pg8::bf16_t*)(P.ws + WS_P), DFF, 0, nullptr};
#if DENSE_FP8 == 1
                pg8::gemm_phase<pg8::EpiSwiglu<false>, pg8::StaticOrder, pg8::RowsLinearOff, true, true>(GLDS(P), P.tid, WSB(P, WS_U), WSB(P, WS_WGU), DM, S, E, pg8::RowsLinearOff{}, SCL_U, SCL_WGU);
#else
                pg8::gemm_phase<pg8::EpiSwiglu<false>, pg8::StaticOrder, pg8::RowsLinear, true>(GLDS(P), P.tid, WSB(P, WS_U), WSB(P, WS_WGU), 2 * DM, S, E, pg8::RowsLinear{});
#endif
                bg_convert_tail(P, S.nwg, BG_E0, BG_F0);
            } SEAM(7);
            if (IN(8)) {
                Frame P = phase_frame(F);
                const float* modlat = (const float*)(P.ws + WS_MODLAT);
                const float* modctx = (const float*)(P.ws + WS_MODCTX);
                float* hctx = (float*)(P.ws + WS_HCTX);
                pg8::StaticOrder S; S.init(NTOK, DM, P.G, P.bid);
                pg8::EpiResGate E{hctx, P.out, hctx, P.out, modlat + 5 * DM, modctx + 5 * DM, 0};
#if DENSE_FP8
                pg8::gemm_phase<pg8::EpiResGate, pg8::StaticOrder, pg8::RowsLinearOff, true, true>(GLDS(P), P.tid, WSB(P, WS_P), WSB(P, WS_WD), DFF, S, E, pg8::RowsLinearOff{}, SCL_H, SCL_WD);
#else
                pg8::gemm_phase<pg8::EpiResGate, pg8::StaticOrder, pg8::RowsLinear, true>(GLDS(P), P.tid, WSB(P, WS_P), WSB(P, WS_WD), 2 * DFF, S, E, pg8::RowsLinear{});
#endif
                bg_convert_tail(P, S.nwg, BG_F0, BG_B1);
            } SEAM(8);
        } else {
            if (IN(14)) for (int rep_ = 0; rep_ < NREP(14); ++rep_) { if (rep_) __syncthreads(); Frame P = phase_frame(F); norm_moe_phase(P); } SEAM(14);
            if (IN(15)) for (int rep_ = 0; rep_ < NREP(15); ++rep_) { if (rep_) __syncthreads(); Frame P = phase_frame(F); moe_route_phase(P); } SEAM(15);
            LAS int* texp = (LAS int*)(F.lds + AUX_TAB);
            if (IN(16) || IN(17) || IN(18)) {
                Frame P = phase_frame(F);
                const int* meta = (const int*)(P.ws + WS_META);
                __syncthreads();
                for (int i = P.tid; i < 2 * MOE_TILES; i += 512) texp[i] = ld_i32_coherent(meta + (i / MOE_TILES) * 256 + 1 + (i % MOE_TILES));
                if (P.tid < 2) texp[2 * MOE_TILES + P.tid] = ld_i32_coherent(meta + P.tid * 256);
                __syncthreads();
            }
            if (IN(16)) for (int rep_ = 0; rep_ < NREP(16); ++rep_) { if (rep_) __syncthreads();
                Frame P = phase_frame(F);
                const int NT0 = __builtin_amdgcn_readfirstlane(texp[2 * MOE_TILES]), NT1 = __builtin_amdgcn_readfirstlane(texp[2 * MOE_TILES + 1]);
                pg8::MoeOrder S{NT0, NT1, 28, P.G, P.bid, (const LAS int*)texp};
                pg8::EpiSwiglu<true> E{(pg8::bf16_t*)(P.ws + WS_P), DFE, 28, (const float*)(P.ws + WS_PROW)};
                pg8::gemm_phase<pg8::EpiSwiglu<true>, pg8::MoeOrder, pg8::RowsGather, true, true>(GLDS(P), P.tid, WSB(P, WS_U), WSB(P, WS_MGU), DM, S, E, pg8::RowsGather{(const int*)(P.ws + WS_ROWMAP), 0}, SCL_U, SCL_WGU);
            } SEAM(16);
#pragma unroll 1
            for (int s = 0; s < 2; ++s) {
                if (IN(17 + s)) {
                    Frame P = phase_frame(F);
                    const int* rowmap = (const int*)(P.ws + WS_ROWMAP) + (size_t)s * MOE_ROWS;
                    const float* modlat = (const float*)(P.ws + WS_MODLAT) + (size_t)16 * 6144;
                    const int NT = __builtin_amdgcn_readfirstlane(texp[2 * MOE_TILES + s]);
                    pg8::MoeOrder S{NT, 0, 4, P.G, P.bid, (const LAS int*)(texp + s * MOE_TILES)};
                    pg8::EpiMoeScatter E{rowmap, (const float*)(P.ws + WS_PROW) + (size_t)s * MOE_ROWS, P.out, modlat + 5 * DM, 4};
                    pg8::gemm_phase<pg8::EpiMoeScatter, pg8::MoeOrder, pg8::RowsLinearOff, true, true>(GLDS(P), P.tid, P.ws + WS_P + (size_t)s * MOE_ROWS * DFE, WSB(P, WS_MD), DFE, S, E, pg8::RowsLinearOff{}, SCL_H, SCL_WD);
                } SEAM(17 + s);
            }
        }
}
__global__ void __launch_bounds__(512, 2) fwd_kernel(Params prm) {
    extern __shared__ __attribute__((aligned(16))) unsigned char lds_raw[];
    Frame F;
    F.lds = (LAS unsigned char*)lds_raw;
    F.tid = threadIdx.x; F.lane = F.tid & 63; F.wave = __builtin_amdgcn_readfirstlane(F.tid >> 6);
    F.G = gridDim.x; F.bid = blockIdx.x; F.vb = F.bid;
    F.in.ka = (karg_t)__builtin_amdgcn_kernarg_segment_ptr(); F.out = prm.out; F.ws = prm.ws;
    volatile LAS unsigned* MISC = (volatile LAS unsigned*)(F.lds + AUX_OFF);
    if (F.tid < 64) MISC[F.tid] = 0u;
    __syncthreads();
    XcdBarrier bar; bar.bar = (unsigned*)(prm.ws + WS_CTL) + 1024; bar.x = 0; bar.st = nullptr;
#if MK_PER_PHASE
    const int lo = prm.ph_lo, hi = prm.ph_hi;
#else
    constexpr int lo = 0, hi = N_PHASES;
#endif
    if (hi - lo > 1) bar = xcd_barrier_post((unsigned*)(prm.ws + WS_CTL) + 1024, MISC + 8);

    if (IN(0)) for (int rep_ = 0; rep_ < NREP(0); ++rep_) { if (rep_) __syncthreads(); Frame P = phase_frame(F); p0_prologue(P); } SEAM(0);
    layer_phases<0>(F, bar);
    layer_phases<1>(F, bar);
    if (IN(PH_FINAL)) { Frame P = phase_frame(F); final_phase(P); }
#undef IN
#undef SEAM
}

extern "C" void kernel_launch(void* const* d_in, const int* in_sizes, int n_in, void* d_out, int out_size, void* d_ws, size_t ws_size, hipStream_t stream) {
    static int grid = 0;
    if (grid == 0) {
        if (n_in != 26 || in_sizes[0] != NLAT * DM || out_size != NLAT * DM || ws_size < WS_END) {
            fprintf(stderr, "kernel_launch: unexpected shapes (n_in %d, in0 %d, out %d, ws %zu, need %zu); nothing launched\n", n_in, n_in > 0 ? in_sizes[0] : -1, out_size, ws_size, (size_t)WS_END); grid = -1; return; }
        int dev = 0, cus = 0, per_cu = 0;
        if (hipGetDevice(&dev) != hipSuccess || hipDeviceGetAttribute(&cus, hipDeviceAttributeMultiprocessorCount, dev) != hipSuccess) { grid = -1; return; }
        if (hipFuncSetAttribute((const void*)fwd_kernel, hipFuncAttributeMaxDynamicSharedMemorySize, LDS_BYTES) != hipSuccess) { fprintf(stderr, "kernel_launch: hipFuncSetAttribute failed\n"); grid = -1; return; }
        if (hipOccupancyMaxActiveBlocksPerMultiprocessor(&per_cu, (const void*)fwd_kernel, 512, LDS_BYTES) != hipSuccess || per_cu < 1)
            fprintf(stderr, "kernel_launch: note: occupancy query reports %d workgroups per CU\n", per_cu);
        (void)hipGetLastError();
        grid = cus;
    }
    if (grid < 0) return;
    if (hipMemsetAsync((char*)d_ws + WS_CTL, 0, CTL_ZERO_BYTES, stream) != hipSuccess) return;
    Params p{};
    for (int i = 0; i < 26; ++i) p.in[i] = (const float*)d_in[i];
    p.out = (float*)d_out; p.ws = (unsigned char*)d_ws;
#if MK_PER_PHASE
    for (int ph = 0; ph < N_PHASES; ++ph) { p.ph_lo = ph; p.ph_hi = ph + 1; hipLaunchKernelGGL(fwd_kernel, dim3(grid), dim3(512), LDS_BYTES, stream, p); }
#else
    p.ph_lo = 0; p.ph_hi = N_PHASES;
    hipLaunchKernelGGL(fwd_kernel, dim3(grid), dim3(512), LDS_BYTES, stream, p);
#endif
}
```

```cpp
#include <hip/hip_runtime.h>
#include <cstdio>
#include <cstdint>

#ifndef PROBE_SUB
#define PROBE_SUB 0
#endif
#ifndef MK_PER_PHASE
#define MK_PER_PHASE 0
#endif

#define LAS __attribute__((address_space(3)))
#define GAS __attribute__((address_space(1)))
#define DI __device__ __forceinline__
typedef unsigned short bf16;
typedef short bf16x8 __attribute__((ext_vector_type(8)));
typedef short s16x4 __attribute__((ext_vector_type(4)));
typedef float f32x4 __attribute__((ext_vector_type(4)));
typedef float f32x16 __attribute__((ext_vector_type(16)));
typedef unsigned u32x4 __attribute__((ext_vector_type(4)));
typedef unsigned u32x2 __attribute__((ext_vector_type(2)));
typedef float f32x2_t __attribute__((ext_vector_type(2)));
typedef __bf16 bf16x2_t __attribute__((ext_vector_type(2)));
typedef short v4i16_t __attribute__((ext_vector_type(4)));

constexpr int DM = 1024, NB = 16, SEQ = 2048, CTXL = 256, GW = 64;
constexpr int NLAT = NB * SEQ, NCTX = NB * CTXL, NTOK = NLAT + NCTX;
constexpr int INW = 3072, DFF = 2816, NE = 8, DFE = 3584;
constexpr int C_NAQ = 0, C_NAK = 512, C_NAV = 1024, C_CONV = 1536, C_RQ = 2048, C_RK = 2176, C_RV = 2304, C_GF = 2560, C_GB = 2816;
constexpr float EPS = 1e-6f;
constexpr float LOG2E = 1.4426950408889634f;

constexpr size_t MiB = 1u << 20;
constexpr size_t WS_CTL = 0, CTL_ZERO_BYTES = 64 * 1024;
constexpr size_t WS_MODLAT = 1 * MiB;
constexpr size_t WS_MODCTX = WS_MODLAT + 2 * 16 * 6144 * 4;
constexpr size_t WS_ROPE = WS_MODCTX + 2 * 6144 * 4;
constexpr size_t WS_PTOK = 2 * MiB;
constexpr size_t WS_SEGCNT = WS_PTOK + 32768 * 2 * 4;
constexpr size_t WS_META = WS_SEGCNT + 256 * 2 * 8 * 4;
constexpr size_t WS_SEGLIST = 3 * MiB;
constexpr size_t WS_ROWMAP = 5 * MiB;
constexpr int MOE_ROWS = 34816;
constexpr int MOE_TILES = MOE_ROWS / 256;
constexpr size_t WS_PROW = WS_ROWMAP + 512 * 1024;
constexpr size_t WS_SUMLAT = 6 * MiB;
constexpr size_t WS_SUMCTX = 22 * MiB;
constexpr size_t WS_WIN = 24 * MiB;
constexpr size_t WS_WOUT = WS_WIN + (size_t)2 * 3072 * 1024 * 2;
constexpr size_t WS_WGU = WS_WOUT + (size_t)2 * 1024 * 1024 * 2;
constexpr size_t WS_WD = WS_WGU + (size_t)5632 * 1024 * 2;
constexpr size_t WS_MGU = WS_WD + (size_t)1024 * 2816 * 2;
constexpr size_t WS_MD = WS_MGU + (size_t)8 * 7168 * 1024 * 2;
constexpr size_t WS_HCTX = WS_MD + (size_t)8 * 1024 * 3584 * 2;
constexpr size_t WS_U = WS_HCTX + (size_t)NCTX * DM * 4;
constexpr size_t WS_P = WS_U + (size_t)NTOK * DM * 2;
constexpr size_t WS_END = WS_P + (size_t)MOE_ROWS * DFE * 2;
static_assert((size_t)NTOK * INW * 2 <= (size_t)MOE_ROWS * DFE * 2, "P region: px | dense hidden | fp8 hidden of both MoE slots (2 x MOE_ROWS x DFE bytes)");
static_assert(WS_WIN % 256 == 0 && WS_WOUT % 256 == 0 && WS_WGU % 256 == 0 && WS_WD % 256 == 0 && WS_MGU % 256 == 0 && WS_MD % 256 == 0 && WS_HCTX % 256 == 0 && WS_U % 256 == 0 && WS_P % 256 == 0, "align");

constexpr int RING_BYTES = 131072;
constexpr int AUX_OFF = RING_BYTES;
constexpr int AUX_TAB = AUX_OFF + 1024;
constexpr int LDS_BYTES = 147456;

#ifndef MOE_FP8
#define MOE_FP8 1
#endif
#ifndef DENSE_FP8
#define DENSE_FP8 2
#endif
constexpr int SCL_U = 0x7c7c7c7c, SCL_WGU = 0x79797979, SCL_H = 0x7c7c7c7c, SCL_WD = 0x78787878;
constexpr float QS_U = 8.0f, QS_WGU = 64.0f, QS_H = 8.0f, QS_WD = 128.0f;
DI unsigned pk2(float lo, float hi) { f32x2_t v = {lo, hi}; bf16x2_t b = __builtin_convertvector(v, bf16x2_t); return __builtin_bit_cast(unsigned, b); }
DI float clamp448(float x) { return __builtin_fminf(__builtin_fmaxf(x, -448.0f), 448.0f); }
DI unsigned pk4_fp8(float a, float b, float c, float d) { int w = 0; w = __builtin_amdgcn_cvt_pk_fp8_f32(clamp448(a), clamp448(b), w, false); w = __builtin_amdgcn_cvt_pk_fp8_f32(clamp448(c), clamp448(d), w, true); return (unsigned)w; }
DI float bflo(unsigned u) { return __uint_as_float(u << 16); }
DI float bfhi(unsigned u) { return __uint_as_float(u & 0xffff0000u); }
DI float wave_sum(float v) {
#pragma unroll
    for (int o = 1; o < 64; o <<= 1) v += __shfl_xor(v, o);
    return v;
}
DI float fast_exp2(float x) { return __builtin_amdgcn_exp2f(x); }
DI float fast_rcp(float x) { return __builtin_amdgcn_rcpf(x); }
DI float sigmoidf_(float x) { return fast_rcp(1.0f + fast_exp2(-x * LOG2E)); }
DI int crow(int reg, int h) { return (reg & 3) + 8 * (reg >> 2) + 4 * h; }
#define MFMA32(a, b, c) __builtin_amdgcn_mfma_f32_32x32x16_bf16((a), (b), (c), 0, 0, 0)
DI s16x4 trread(LAS const unsigned char* p) { return __builtin_bit_cast(s16x4, __builtin_amdgcn_ds_read_tr16_b64_v4i16((LAS v4i16_t*)p)); }
DI int ld_i32_coherent(const int* p) { return (int)__hip_atomic_load((const unsigned*)p, __ATOMIC_RELAXED, __HIP_MEMORY_SCOPE_AGENT); }

namespace pg8 {
#define PG8_LAS __attribute__((address_space(3)))
typedef unsigned short bf16_t;
constexpr int BM = 256, BK = 64, HALF = 128, HTB = HALF * BK * 2, STAGE_BYTES = 8 * HTB, NXCD = 8, WGM = 8;
__host__ __device__ __forceinline__ int lds_byte(int r, int c) { const int st = (r >> 4) * 2 + (c >> 5), rr = r & 15, cc = c & 31, ob = rr * 64 + cc * 2; return st * 1024 + (ob ^ (((ob >> 9) & 1) << 5)); }
__host__ __device__ __forceinline__ void stage_rc(int b, int& R, int& C) { const int st = b / 1024, sb = b % 1024, swz = sb ^ (((sb >> 9) & 1) << 5); R = (st >> 1) * 16 + swz / 64; C = (st & 1) * 32 + (swz % 64) / 2; }
__host__ __device__ __forceinline__ int perm32(int rho) { const int n = rho >> 4, i = rho & 15; return 8 * (i >> 2) + 4 * n + (i & 3); }
struct Unit { int pm, pn; };
struct StaticOrder {
    int nM, nN, nwg, G, c;
    __device__ void init(int M, int N, int G_, int c_) { nM = M / BM; nN = N / BM; nwg = nM * nN; G = G_; c = c_; }
    __device__ bool next(int i, Unit& u) const {
        const long L = (long)i * G + c; if (L >= nwg) return false;
        int wgid = (int)L; { const int q = nwg / NXCD, r = nwg % NXCD, xcd = wgid % NXCD, off = wgid / NXCD; wgid = (xcd < r ? xcd * (q + 1) : r * (q + 1) + (xcd - r) * q) + off; }
        const int nig = WGM * nN, gid = wgid / nig, fm = gid * WGM, gsz = (nM - fm) < WGM ? (nM - fm) : WGM;
        u.pm = fm + ((wgid % nig) % gsz); u.pn = (wgid % nig) / gsz; return true;
    }
};
struct RowsLinear { static constexpr bool GATHER = false; };
struct RowsLinearOff {
    static constexpr bool GATHER = true;
    __device__ __forceinline__ void fetch(const Unit& u, const int (&R)[2], int (&raw)[2][2]) const {
#pragma unroll
        for (int h = 0; h < 2; ++h)
#pragma unroll
            for (int i = 0; i < 2; ++i) raw[h][i] = u.pm * BM + h * HALF + R[i];
    }
    __device__ __forceinline__ void make(const int (&raw)[2][2], const int (&C)[2], int pitch, unsigned (&o)[2][2]) const {
#pragma unroll
        for (int h = 0; h < 2; ++h)
#pragma unroll
            for (int i = 0; i < 2; ++i) { o[h][i] = (unsigned)raw[h][i] * (unsigned)pitch + (unsigned)C[i] * 2u; asm volatile("" : "+v"(o[h][i])); }
    }
};
struct RowsGather {
    static constexpr bool GATHER = true;
    const int* rowmap; int row_add;
    __device__ __forceinline__ void fetch(const Unit& u, const int (&R)[2], int (&raw)[2][2]) const {
#pragma unroll
        for (int h = 0; h < 2; ++h)
#pragma unroll
            for (int i = 0; i < 2; ++i) raw[h][i] = rowmap[u.pm * BM + h * HALF + R[i]];
    }
    __device__ __forceinline__ void make(const int (&raw)[2][2], const int (&C)[2], int pitch, unsigned (&o)[2][2]) const {
#pragma unroll
        for (int h = 0; h < 2; ++h)
#pragma unroll
            for (int i = 0; i < 2; ++i) { int t = raw[h][i]; t = t < 0 ? 0 : t; o[h][i] = (unsigned)((size_t)(t + row_add) * (size_t)pitch + (size_t)C[i] * 2u); }
#pragma unroll
        for (int h = 0; h < 2; ++h)
#pragma unroll
            for (int i = 0; i < 2; ++i) asm volatile("" : "+v"(o[h][i]));
    }
};

typedef int i32x8 __attribute__((ext_vector_type(8)));
typedef int i32x4v __attribute__((ext_vector_type(4)));
template <class Epi, class Sched, class ARows, bool ALIGN_EPI, bool FP8 = false>
__device__ __forceinline__ void gemm_phase(PG8_LAS unsigned char* lds, int tid, const void* A, const void* Bt, int pitch, const Sched& S, const Epi& E, const ARows& AR, int sclA = 0x7f7f7f7f, int sclB = 0x7f7f7f7f) {
    constexpr bool GATHER = ARows::GATHER;
    const int wid = __builtin_amdgcn_readfirstlane(tid >> 6), lane = tid & 63, wr = wid >> 2, wc = wid & 3, fr = lane & 15, fq = lane >> 4;
    const int nt = pitch / (BK * 2);
    int RA[2], CA[2]; unsigned voffA[2], voffB[2];
#pragma unroll
    for (int i = 0; i < 2; ++i) { int R, C; stage_rc(tid * 16 + i * 8192, R, C); const int Rb = Epi::PERM ? ((R & ~31) + perm32(R & 31)) : R;
        RA[i] = R; CA[i] = C; voffA[i] = (unsigned)(R * pitch + C * 2); voffB[i] = (unsigned)(Rb * pitch + C * 2); }
#pragma unroll
    for (int i = 0; i < 2; ++i) { asm volatile("" : "+v"(voffA[i])); asm volatile("" : "+v"(voffB[i])); }
    const size_t kstep = (size_t)(BK * 2);
    const size_t hstep = (size_t)HALF * pitch;
    const size_t tstep = 2 * hstep;
    const unsigned ldsw = (unsigned)wid * 1024u;
    const int aoff = lds_byte(wr * 64 + fr, fq * 8), boff = lds_byte(wc * 32 + fr, fq * 8);
    const char* Ab = (const char*)A;
#define PG8_SA(b, h) (((b) * 2 + (h)) * HTB)
#define PG8_SB(b, h) ((4 + (b) * 2 + (h)) * HTB)
#define PG8_STAGE(bufoff, gbase, voff) do { _Pragma("unroll") for (int _i = 0; _i < 2; ++_i) \
        __builtin_amdgcn_global_load_lds((const unsigned*)((const char*)(gbase) + (voff)[_i]), (PG8_LAS unsigned*)(lds + (bufoff) + ldsw + _i * 8192), 16, 0, 0); } while (0)
#define PG8_STAGEA(bufoff, h, plin, kb) do { if constexpr (GATHER) PG8_STAGE(bufoff, Ab + (kb), curA[h]); else PG8_STAGE(bufoff, (plin) + (h) * hstep, voffA); } while (0)
#define PG8_LDA(dst, b, h) do { _Pragma("unroll") for (int m = 0; m < 4; ++m) _Pragma("unroll") for (int k = 0; k < 2; ++k) dst[m][k] = *(const PG8_LAS bf16x8*)(lds + PG8_SA(b, h) + aoff + m * 2048 + k * 1024); } while (0)
#define PG8_LDB(dst, b, h) do { _Pragma("unroll") for (int n = 0; n < 2; ++n) _Pragma("unroll") for (int k = 0; k < 2; ++k) dst[n][k] = *(const PG8_LAS bf16x8*)(lds + PG8_SB(b, h) + boff + n * 2048 + k * 1024); } while (0)
#define PG8_CAT(x0, x1) __builtin_shufflevector(__builtin_bit_cast(i32x4v, x0), __builtin_bit_cast(i32x4v, x1), 0, 1, 2, 3, 4, 5, 6, 7)
#define PG8_MMA(ai, bj, At, Bt_) do { __builtin_amdgcn_s_setprio(1); \
        if constexpr (FP8) { _Pragma("unroll") for (int m = 0; m < 4; ++m) _Pragma("unroll") for (int n = 0; n < 2; ++n) \
            acc[ai][bj][m][n] = __builtin_amdgcn_mfma_scale_f32_16x16x128_f8f6f4(PG8_CAT(Bt_[n][0], Bt_[n][1]), PG8_CAT(At[m][0], At[m][1]), acc[ai][bj][m][n], 0, 0, 0, sclB, 0, sclA); } \
        else { _Pragma("unroll") for (int m = 0; m < 4; ++m) _Pragma("unroll") for (int n = 0; n < 2; ++n) _Pragma("unroll") for (int k = 0; k < 2; ++k) \
            acc[ai][bj][m][n] = __builtin_amdgcn_mfma_f32_16x16x32_bf16(Bt_[n][k], At[m][k], acc[ai][bj][m][n], 0, 0, 0); } \
        __builtin_amdgcn_s_setprio(0); } while (0)
#define PG8_WAIT_V(n) asm volatile("s_waitcnt vmcnt(" #n ")" ::: "memory")
#define PG8_WAIT_L(n) asm volatile("s_waitcnt lgkmcnt(" #n ")" ::: "memory")
#define PG8_BAR __builtin_amdgcn_s_barrier()
#define PG8_SCHED __builtin_amdgcn_sched_barrier(0)
    Unit cur, nxt; int ui = 0;
    if (!S.next(0, cur)) return;
    f32x4 acc[2][2][4][2];
#pragma unroll
    for (int a = 0; a < 2; ++a)
#pragma unroll
        for (int b = 0; b < 2; ++b)
#pragma unroll
            for (int m = 0; m < 4; ++m)
#pragma unroll
                for (int n = 0; n < 2; ++n) acc[a][b][m][n] = (f32x4){0.f, 0.f, 0.f, 0.f};
    bf16x8 At[4][2], B0[2][2], B1[2][2];
    unsigned curA[2][2] = {{0u, 0u}, {0u, 0u}}, nxtA[2][2] = {{0u, 0u}, {0u, 0u}};
    int rawN[2][2] = {{0, 0}, {0, 0}};
    if constexpr (GATHER) { int rawC[2][2]; AR.fetch(cur, RA, rawC); AR.make(rawC, CA, pitch, curA); Unit n1; if (S.next(1, n1)) AR.fetch(n1, RA, rawN); }
    const char* cA = GATHER ? Ab : Ab + (size_t)cur.pm * tstep;
    const char* cB = (const char*)Bt + (size_t)cur.pn * tstep;
    PG8_STAGE(PG8_SB(0, 0), cB, voffB); PG8_STAGE(PG8_SB(0, 1), cB + hstep, voffB); PG8_STAGEA(PG8_SA(0, 0), 0, cA, 0); PG8_STAGEA(PG8_SA(0, 1), 1, cA, 0);
    if (wr == 1) PG8_BAR;
    PG8_WAIT_V(2); PG8_BAR;
    PG8_STAGE(PG8_SB(1, 0), cB + kstep, voffB); PG8_STAGEA(PG8_SA(1, 0), 0, cA + kstep, kstep); PG8_STAGE(PG8_SB(1, 1), cB + hstep + kstep, voffB);
    PG8_WAIT_V(6); PG8_BAR;
    for (;;) {
        const bool has_next = S.next(ui + 1, nxt);
        if constexpr (GATHER) {
            if (has_next) { AR.make(rawN, CA, pitch, nxtA); Unit n2; if (S.next(ui + 2, n2)) AR.fetch(n2, RA, rawN); }
            else {
#pragma unroll
                for (int h = 0; h < 2; ++h)
#pragma unroll
                    for (int i = 0; i < 2; ++i) nxtA[h][i] = curA[h][i];
            }
        }
        const char* nA = GATHER ? Ab : (has_next ? Ab + (size_t)nxt.pm * tstep : cA);
        const char* nB = has_next ? (const char*)Bt + (size_t)nxt.pn * tstep : cB;
        for (int t = 0; t < nt; t += 2) {
            const bool last = (t == nt - 2);
            const size_t k1 = (size_t)(t + 1) * kstep, k2 = last ? 0 : (size_t)(t + 2) * kstep, k3 = k2 + kstep;
            const char* a1 = cA + k1;
            const char* a2 = last ? nA : cA + k2; const char* b2 = last ? nB : cB + k2;
            const char* a3 = a2 + kstep; const char* b3 = b2 + kstep;
            PG8_LDB(B0, 0, 0); PG8_LDB(B1, 0, 1); PG8_SCHED; PG8_LDA(At, 0, 0); PG8_STAGEA(PG8_SA(1, 1), 1, a1, k1);
            if constexpr (GATHER) { if (last) {
#pragma unroll
                for (int h = 0; h < 2; ++h)
#pragma unroll
                    for (int i = 0; i < 2; ++i) curA[h][i] = nxtA[h][i]; } }
            PG8_WAIT_V(8); PG8_WAIT_L(0); PG8_BAR; PG8_MMA(0, 0, At, B0); PG8_MMA(0, 1, At, B1); PG8_BAR; PG8_SCHED;
            PG8_LDA(At, 0, 1); PG8_STAGE(PG8_SB(0, 0), b2, voffB); PG8_STAGE(PG8_SB(0, 1), b2 + hstep, voffB); PG8_STAGEA(PG8_SA(0, 0), 0, a2, k2);
            PG8_WAIT_V(8); PG8_WAIT_L(0); PG8_BAR; PG8_MMA(1, 0, At, B0); PG8_MMA(1, 1, At, B1); PG8_BAR; PG8_SCHED;
            PG8_LDB(B0, 1, 0); PG8_LDB(B1, 1, 1); PG8_SCHED; PG8_LDA(At, 1, 0); PG8_STAGEA(PG8_SA(0, 1), 1, a2, k2);
            PG8_WAIT_V(8); PG8_WAIT_L(0); PG8_BAR; PG8_MMA(0, 0, At, B0); PG8_MMA(0, 1, At, B1); PG8_BAR; PG8_SCHED;
            PG8_LDA(At, 1, 1); PG8_STAGE(PG8_SB(1, 0), b3, voffB); PG8_STAGE(PG8_SB(1, 1), b3 + hstep, voffB); PG8_STAGEA(PG8_SA(1, 0), 0, a3, k3);
            PG8_WAIT_V(8); PG8_WAIT_L(0); PG8_BAR; PG8_MMA(1, 0, At, B0); PG8_MMA(1, 1, At, B1); PG8_BAR; PG8_SCHED;
        }
        if constexpr (ALIGN_EPI) { if (wr == 0) PG8_BAR; }
        E(acc, cur, wr, wc, fr, fq);
        if (!has_next) break;
#pragma unroll
        for (int a = 0; a < 2; ++a)
#pragma unroll
            for (int b = 0; b < 2; ++b)
#pragma unroll
                for (int m = 0; m < 4; ++m)
#pragma unroll
                    for (int n = 0; n < 2; ++n) acc[a][b][m][n] = (f32x4){0.f, 0.f, 0.f, 0.f};
        cur = nxt; cA = nA; cB = nB; ++ui;
        if constexpr (ALIGN_EPI) { if (wr == 1) PG8_BAR; }
    }
    PG8_WAIT_V(0);
    if constexpr (!ALIGN_EPI) { if (wr == 0) PG8_BAR; }
    PG8_BAR;
#undef PG8_SA
#undef PG8_SB
#undef PG8_STAGE
#undef PG8_STAGEA
#undef PG8_LDA
#undef PG8_LDB
#undef PG8_MMA
#undef PG8_CAT
#undef PG8_WAIT_V
#undef PG8_WAIT_L
#undef PG8_BAR
#undef PG8_SCHED
}

#define PG8_OPAQUE(x) asm volatile("" : "+v"(x))
struct EpiNull { static constexpr bool PERM = true; __device__ __forceinline__ void operator()(const f32x4 (&acc)[2][2][4][2], const Unit& u, int wr, int wc, int fr, int fq) const { if (u.pm < 0) {
#pragma unroll
        for (int a = 0; a < 2; ++a)
#pragma unroll
            for (int b = 0; b < 2; ++b)
#pragma unroll
                for (int m = 0; m < 4; ++m)
#pragma unroll
                    for (int n = 0; n < 2; ++n) asm volatile("" :: "v"(acc[a][b][m][n])); } } };
struct EpiStoreBf16 {
    static constexpr bool PERM = true;
    bf16_t* O; int ldc;
    __device__ __forceinline__ void operator()(const f32x4 (&acc)[2][2][4][2], const Unit& u, int wr, int wc, int fr, int fq) const {
        char* base = (char*)(O + (size_t)(u.pm * BM) * ldc + u.pn * BM);
        unsigned lb = (unsigned)((wr * 64 + fr) * ldc + wc * 32 + 8 * fq) * 2u; PG8_OPAQUE(lb);
        const unsigned rstep = (unsigned)ldc * 32u;
#pragma unroll
        for (int ai = 0; ai < 2; ++ai)
#pragma unroll
            for (int m = 0; m < 4; ++m) { const unsigned ro = lb + (unsigned)(ai * 8 + m) * rstep;
#pragma unroll
                for (int bj = 0; bj < 2; ++bj) { const f32x4 v0 = acc[ai][bj][m][0], v1 = acc[ai][bj][m][1];
                    u32x4 w; w.x = pk2(v0[0], v0[1]); w.y = pk2(v0[2], v0[3]); w.z = pk2(v1[0], v1[1]); w.w = pk2(v1[2], v1[3]);
                    *(u32x4*)(base + ro + bj * (HALF * 2)) = w; } }
    }
};
struct EpiResGate {
    static constexpr bool PERM = false;
    const float* src_ctx; const float* src_lat; float* dst_ctx; float* dst_lat; const float* gate_lat; const float* gate_ctx; int row_base;
    __device__ __forceinline__ void operator()(const f32x4 (&acc)[2][2][4][2], const Unit& u, int wr, int wc, int fr, int fq) const {
        const int rowu = row_base + u.pm * BM; const bool isctx = rowu < NCTX;
        const char* src = (const char*)(isctx ? src_ctx + (size_t)rowu * DM : src_lat + (size_t)(rowu - NCTX) * DM) + u.pn * (BM * 4);
        char* dst = (char*)(isctx ? dst_ctx + (size_t)rowu * DM : dst_lat + (size_t)(rowu - NCTX) * DM) + u.pn * (BM * 4);
        const float* gate = (isctx ? gate_ctx : gate_lat + (size_t)((rowu - NCTX) / SEQ) * 6144) + u.pn * BM;
        const int cl = wc * 32 + 4 * fq;
        f32x4 sc[2][2][4][2];
#pragma unroll
        for (int bj = 0; bj < 2; ++bj)
#pragma unroll
            for (int n = 0; n < 2; ++n) { const f32x4 gv = *(const f32x4*)(gate + cl + bj * HALF + n * 16);
#pragma unroll
                for (int ai = 0; ai < 2; ++ai)
#pragma unroll
                    for (int m = 0; m < 4; ++m) sc[ai][bj][m][n] = acc[ai][bj][m][n] * gv; }
        unsigned lb = (unsigned)((wr * 64 + fr) * DM + cl) * 4u; PG8_OPAQUE(lb);
#pragma unroll
        for (int ai = 0; ai < 2; ++ai)
#pragma unroll
            for (int m = 0; m < 4; ++m) { const unsigned ro = lb + (unsigned)(ai * 8 + m) * (16u * DM * 4u);
#pragma unroll
                for (int bj = 0; bj < 2; ++bj)
#pragma unroll
                    for (int n = 0; n < 2; ++n) { const unsigned o = ro + (unsigned)(bj * HALF + n * 16) * 4u; const f32x4 s = *(const f32x4*)(src + o);
                        *(f32x4*)(dst + o) = s + sc[ai][bj][m][n]; }
                asm volatile("" ::: "memory"); }
    }
};
template <bool MOE> struct EpiSwiglu {
    static constexpr bool PERM = true;
    static constexpr bool OUT8 = MOE ? (MOE_FP8 != 0) : (DENSE_FP8 != 0);
    bf16_t* O; int ldc; int ncol; const float* prow;
    __device__ __forceinline__ void operator()(const f32x4 (&acc)[2][2][4][2], const Unit& u, int wr, int wc, int fr, int fq) const {
        const int pnl = MOE ? (u.pn % ncol) : u.pn;
        constexpr int ES = OUT8 ? 1 : 2;
        char* base = (char*)O + ((size_t)(u.pm * BM) * ldc + pnl * HALF) * ES;
        unsigned lb = (unsigned)((wr * 64 + fr) * ldc + wc * 32 + 8 * fq) * ES; PG8_OPAQUE(lb);
        const unsigned rstep = (unsigned)ldc * 16u * ES;
#pragma unroll
        for (int ai = 0; ai < 2; ++ai)
#pragma unroll
            for (int m = 0; m < 4; ++m) {
                const float pw = OUT8 ? QS_H : 1.0f;
                float hv[8];
#pragma unroll
                for (int n = 0; n < 2; ++n)
#pragma unroll
                    for (int jp = 0; jp < 2; ++jp) { const f32x2_t g = {acc[ai][0][m][n][2 * jp], acc[ai][0][m][n][2 * jp + 1]}, up = {acc[ai][1][m][n][2 * jp], acc[ai][1][m][n][2 * jp + 1]};
                        const f32x2_t a = g * (-LOG2E); f32x2_t d; d.x = fast_exp2(a.x); d.y = fast_exp2(a.y); d = d + 1.0f;
                        f32x2_t r; r.x = fast_rcp(d.x); r.y = fast_rcp(d.y);
                        const f32x2_t hh = (g * up) * (r * pw); hv[n * 4 + 2 * jp] = hh.x; hv[n * 4 + 2 * jp + 1] = hh.y; }
                if constexpr (OUT8) { u32x2 w; w.x = pk4_fp8(hv[0], hv[1], hv[2], hv[3]); w.y = pk4_fp8(hv[4], hv[5], hv[6], hv[7]);
                    *(u32x2*)(base + lb + (unsigned)(ai * 8 + m) * rstep) = w; }
                else { u32x4 w; w.x = pk2(hv[0], hv[1]); w.y = pk2(hv[2], hv[3]); w.z = pk2(hv[4], hv[5]); w.w = pk2(hv[6], hv[7]);
                    *(u32x4*)(base + lb + (unsigned)(ai * 8 + m) * rstep) = w; } }
    }
};
struct EpiMoeScatter {
    static constexpr bool PERM = false;
    const int* rowmap; const float* prow; float* hlat; const float* gate_lat; int ncol;
    __device__ __forceinline__ void operator()(const f32x4 (&acc)[2][2][4][2], const Unit& u, int wr, int wc, int fr, int fq) const {
        const int pnl = u.pn % ncol;
        const int* rm = rowmap + u.pm * BM; const float* pr = prow + u.pm * BM;
        char* hb = (char*)hlat + pnl * (BM * 4); const char* gb = (const char*)gate_lat + pnl * (BM * 4);
        unsigned pl = (unsigned)(wr * 64 + fr) * 4u; PG8_OPAQUE(pl);
        unsigned cb = (unsigned)(wc * 32 + 4 * fq) * 4u; PG8_OPAQUE(cb);
#pragma unroll
        for (int ai = 0; ai < 2; ++ai)
#pragma unroll
            for (int m = 0; m < 4; ++m) { const int tok = *(const int*)((const char*)rm + pl + (unsigned)(ai * 8 + m) * 64u);
                if (tok >= 0) { const float pw = *(const float*)((const char*)pr + pl + (unsigned)(ai * 8 + m) * 64u); const unsigned ro = (unsigned)tok * (DM * 4u) + cb, go = ((unsigned)tok >> 11) * (6144u * 4u) + cb;
#pragma unroll
                    for (int bj = 0; bj < 2; ++bj)
#pragma unroll
                        for (int n = 0; n < 2; ++n) { const unsigned o = (unsigned)(bj * HALF + n * 16) * 4u; const f32x4 sv = *(const f32x4*)(hb + ro + o); const f32x4 gv = *(const f32x4*)(gb + go + o);
                            const f32x4 t = acc[ai][bj][m][n] * pw; *(f32x4*)(hb + ro + o) = sv + gv * t; } }
                asm volatile("" ::: "memory"); }
    }
};
struct MoeOrder {
    int NT0, NT1, ncol, G, c; const PG8_LAS int* texp;
    __device__ bool next(int i, Unit& u) const {
        const long L = (long)i * G + c; if (L >= (long)(NT0 + NT1) * ncol) return false;
        const int tq = (int)(L / ncol), pnl = (int)(L % ncol);
        const int T = tq < NT0 ? tq : MOE_TILES + tq - NT0;
        const int e = __builtin_amdgcn_readfirstlane(texp[T]);
        u.pm = T; u.pn = e * ncol + pnl; return true;
    }
};
}

#define XB_TMO      128
#define XB_XCNT(j)  (256  + 64 * (j))
#define XB_XSUB(j)  (1280 + 64 * (j))
#define XB_XGEN(j)  (2304 + 64 * (j))
#define XB_TOP      3328
#define XB_TOPGEN   3392
#define XCD_BAR_WORDS 3456
#define XB_SPIN_CAP (1u << 18)
DI unsigned xb_ld(unsigned* p)              { return __hip_atomic_load(p, __ATOMIC_RELAXED, __HIP_MEMORY_SCOPE_AGENT); }
DI unsigned xb_add(unsigned* p, unsigned v) { return __hip_atomic_fetch_add(p, v, __ATOMIC_RELAXED, __HIP_MEMORY_SCOPE_AGENT); }
DI unsigned xb_xcc_id() { return (unsigned)__builtin_amdgcn_s_getreg((3 << 11) | 20) & 0xFu; }
#define XB_SPIN(cond, bar) do { unsigned _sp = 0; while (cond) { __builtin_amdgcn_s_sleep(1); \
    if ((++_sp & 255u) == 0u) { if (xb_ld(&(bar)[XB_TMO])) break; if (_sp > XB_SPIN_CAP) { atomicAdd(&(bar)[XB_TMO], 1u); break; } } } } while (0)
struct XcdBarrier { unsigned* bar; unsigned x; volatile LAS unsigned* st; };
DI XcdBarrier xcd_barrier_post(unsigned* bar, volatile LAS unsigned* st) {
    XcdBarrier b; b.bar = bar; b.x = xb_xcc_id(); b.st = st;
    if (threadIdx.x == 0) (void)xb_add(&bar[XB_XCNT(b.x)], 1u);
    return b;
}
DI void xcd_barrier_complete(unsigned* bar, unsigned x, unsigned& nloc, unsigned& nx) {
    const unsigned G = gridDim.x * gridDim.y * gridDim.z;
    unsigned sum, cnt, mine, sp = 0u;
    for (;;) {
        sum = 0u; cnt = 0u; mine = 0u;
#pragma unroll
        for (unsigned j = 0; j < 16; ++j) { const unsigned c = xb_ld(&bar[XB_XCNT(j)]); sum += c; cnt += (c > 0u) ? 1u : 0u; mine = (j == x) ? c : mine; }
        if (sum == G) break;
        __builtin_amdgcn_s_sleep(1);
        if ((++sp & 255u) == 0u) { if (xb_ld(&bar[XB_TMO])) break; if (sp > XB_SPIN_CAP) { atomicAdd(&bar[XB_TMO], 1u); break; } }
    }
    nloc = mine > 0u ? mine : 1u; nx = cnt > 0u ? cnt : 1u;
}
DI void xcd_barrier(const XcdBarrier& b, int wave) {
    asm volatile("s_waitcnt vmcnt(0)" ::: "memory");
    __syncthreads();
    if (wave == 0 && __builtin_amdgcn_mbcnt_hi(~0u, __builtin_amdgcn_mbcnt_lo(~0u, 0u)) == 0u) {
        unsigned* bar = b.bar;
        __builtin_amdgcn_s_waitcnt(0);
        unsigned nloc = b.st[0], nx = b.st[1];
        if (nloc == 0u) { xcd_barrier_complete(bar, b.x, nloc, nx); b.st[0] = nloc; b.st[1] = nx; }
        const unsigned old = xb_add(&bar[XB_XSUB(b.x)], 1u);
        const unsigned gen = old / nloc;
        if (old + 1u == (gen + 1u) * nloc) {
            __builtin_amdgcn_fence(__ATOMIC_RELEASE, "agent");
            asm volatile("s_waitcnt vmcnt(0)" ::: "memory");
            const unsigned og = xb_add(&bar[XB_TOP], 1u);
            const unsigned tg = og / nx;
            if (og + 1u == (tg + 1u) * nx) xb_add(&bar[XB_TOPGEN], 1u);
            else XB_SPIN(xb_ld(&bar[XB_TOPGEN]) == tg, bar);
            __builtin_amdgcn_fence(__ATOMIC_ACQUIRE, "agent");
            xb_add(&bar[XB_XGEN(b.x)], 1u);
            asm volatile("s_waitcnt vmcnt(0)" ::: "memory");
        } else {
            XB_SPIN(xb_ld(&bar[XB_XGEN(b.x)]) == gen, bar);
            __builtin_amdgcn_fence(__ATOMIC_ACQUIRE, "agent");
            asm volatile("s_waitcnt vmcnt(0)" ::: "memory");
        }
    }
    __syncthreads();
}

struct Params { const float* in[26]; float* out; unsigned char* ws; int ph_lo, ph_hi, pad0, pad1; };
enum { I_X = 0, I_C, I_CTX, I_CCTX, I_WMOD, I_BMOD, I_N1W, I_N2W, I_WIN, I_WOUT, I_RPB, I_CONVW, I_CONVB, I_CLNW, I_CLNB, I_RDEC, I_RGNW,
       I_FG, I_FU, I_FD, I_MR, I_MRB, I_MG, I_MU, I_MDN, I_FNW };
constexpr int PH_P0 = 0, PH_FINAL = 19, N_PHASES = 20;

typedef __attribute__((address_space(4))) const unsigned char* karg_t;
struct KIn {
    karg_t ka;
    DI const float* operator[](int k) const { return *(const float* __attribute__((address_space(4))) const*)(ka + 8 * k); }
};
struct Frame {
    LAS unsigned char* lds;
    int tid, lane, wave, G, bid, vb;
    KIn in; float* out; unsigned char* ws;
};
DI Frame phase_frame(const Frame& F0) {
    Frame F; karg_t ka = F0.in.ka; asm volatile("" : "+s"(ka)); F.in.ka = ka;
    F.out = *(float* __attribute__((address_space(4))) const*)(ka + 208);
    F.ws = *(unsigned char* __attribute__((address_space(4))) const*)(ka + 216);
    int wv = F0.wave; asm volatile("" : "+s"(wv));
    int tid = (wv << 6) + (int)__builtin_amdgcn_mbcnt_hi(~0u, __builtin_amdgcn_mbcnt_lo(~0u, 0u)), G = F0.G, bid = F0.bid; unsigned ldsb = (unsigned)(size_t)F0.lds;
    asm volatile("" : "+v"(tid)); asm volatile("" : "+s"(G)); asm volatile("" : "+s"(bid)); asm volatile("" : "+s"(ldsb));
    F.tid = tid; F.lane = tid & 63; F.wave = __builtin_amdgcn_readfirstlane(tid >> 6); F.G = G; F.bid = bid; F.lds = (LAS unsigned char*)(size_t)ldsb;
    F.vb = (G % 8 == 0) ? (bid % 8) * (G / 8) + bid / 8 : bid;
    return F;
}

DI void p0_transpose_item(const float* W, int K, int N, bf16* WT, int k0, int n0, int dst_row0, LAS float* scr, int lane) {
#pragma unroll 8
    for (int i = 0; i < 32; ++i) { const int kk = 2 * i + (lane >> 5); scr[kk * 33 + (lane & 31)] = W[(size_t)(k0 + kk) * N + n0 + (lane & 31)]; }
    asm volatile("s_waitcnt lgkmcnt(0)" ::: "memory");
    const int c = lane & 7;
#pragma unroll
    for (int j = 0; j < 4; ++j) { const int n = (lane >> 3) + 8 * j; const LAS float* s = scr + (8 * c) * 33 + n;
        u32x4 o; o.x = pk2(s[0 * 33], s[1 * 33]); o.y = pk2(s[2 * 33], s[3 * 33]); o.z = pk2(s[4 * 33], s[5 * 33]); o.w = pk2(s[6 * 33], s[7 * 33]);
        *(u32x4*)(WT + (size_t)(dst_row0 + n) * K + k0 + 8 * c) = o; }
    asm volatile("s_waitcnt lgkmcnt(0)" ::: "memory");
}
DI void p0_convert_plain(Frame& F, const float* W, int K, int N, bf16* WT, int item, LAS float* scr) {
    const int nblk = N / 32, kb = item / nblk, nb = item % nblk;
    p0_transpose_item(W, K, N, WT, 64 * kb, 32 * nb, 32 * nb, scr, F.lane);
}
DI void p0_convert_gu(Frame& F, const float* W, int K, int N, bf16* WT, int item, int up, LAS float* scr) {
    const int nblk = N / 32, kb = item / nblk, nb = item % nblk, n0 = 32 * nb;
    p0_transpose_item(W, K, N, WT, 64 * kb, n0, 256 * (n0 / 128) + (n0 % 128) + (up ? 128 : 0), scr, F.lane);
}
DI void conv_item64(const float* W, int K, int N, bf16* WT, int k0, int n0, int dst_row0, LAS unsigned* scr, int lane) {
    const float* wp = W + (size_t)k0 * N + n0 + lane;
    float v[64];
#pragma unroll
    for (int i = 0; i < 64; ++i) v[i] = wp[(size_t)i * N];
#pragma unroll
    for (int i = 0; i < 32; ++i) scr[i * 65 + lane] = pk2(v[2 * i], v[2 * i + 1]);
    asm volatile("s_waitcnt lgkmcnt(0)" ::: "memory");
    const int c = lane & 7;
#pragma unroll
    for (int j = 0; j < 8; ++j) { const int n = (lane >> 3) + 8 * j; const LAS unsigned* sp = scr + (4 * c) * 65 + n;
        u32x4 o; o.x = sp[0]; o.y = sp[65]; o.z = sp[130]; o.w = sp[195];
        *(u32x4*)(WT + (size_t)(dst_row0 + n) * K + k0 + 8 * c) = o; }
    asm volatile("s_waitcnt lgkmcnt(0)" ::: "memory");
}
DI void conv_item64_fp8(const float* W, int K, int N, unsigned char* WT, int k0, int n0, int dst_row0, float qs, LAS unsigned* scr, int lane) {
    const float* wp = W + (size_t)k0 * N + n0 + lane;
    float v[64];
#pragma unroll
    for (int i = 0; i < 64; ++i) v[i] = wp[(size_t)i * N];
#pragma unroll
    for (int i = 0; i < 16; ++i) scr[i * 65 + lane] = pk4_fp8(v[4 * i] * qs, v[4 * i + 1] * qs, v[4 * i + 2] * qs, v[4 * i + 3] * qs);
    asm volatile("s_waitcnt lgkmcnt(0)" ::: "memory");
    const int c = lane & 3;
#pragma unroll
    for (int j = 0; j < 4; ++j) { const int n = (lane >> 2) + 16 * j; const LAS unsigned* sp = scr + (4 * c) * 65 + n;
        u32x4 o; o.x = sp[0]; o.y = sp[65]; o.z = sp[130]; o.w = sp[195];
        *(u32x4*)(WT + (size_t)(dst_row0 + n) * K + k0 + 16 * c) = o; }
    asm volatile("s_waitcnt lgkmcnt(0)" ::: "memory");
}
constexpr int BG_ITEMS = 21504;
constexpr int BG_B0 = 0, BG_D0 = 1200, BG_E0 = 5200, BG_F0 = 8700, BG_B1 = 19700, BG_CL = 20900;
DI void bg_item(Frame& F, int g, LAS unsigned* scr) {
    if (g < 14336) { const int m = g / 896, e = m >> 1, up = m & 1, r = g % 896, kb = r / 56, nb = r % 56, n0 = 64 * nb; const int drow = 256 * (n0 / 128) + (n0 % 128) + (up ? 128 : 0);
#if MOE_FP8
        conv_item64_fp8(F.in[up ? I_MU : I_MG] + (size_t)e * 1024 * 3584, 1024, 3584, F.ws + WS_MGU + (size_t)e * 7168 * 1024, 64 * kb, n0, drow, QS_WGU, scr, F.lane);
#else
        conv_item64(F.in[up ? I_MU : I_MG] + (size_t)e * 1024 * 3584, 1024, 3584, (bf16*)(F.ws + WS_MGU) + (size_t)e * 7168 * 1024, 64 * kb, n0, drow, scr, F.lane);
#endif
    } else { const int gg = g - 14336, e = gg / 896, r = gg % 896, kb = r / 16, nb = r % 16;
#if MOE_FP8
        conv_item64_fp8(F.in[I_MDN] + (size_t)e * 3584 * 1024, 3584, 1024, F.ws + WS_MD + (size_t)e * 1024 * 3584, 64 * kb, 64 * nb, 64 * nb, QS_WD, scr, F.lane);
#else
        conv_item64(F.in[I_MDN] + (size_t)e * 3584 * 1024, 3584, 1024, (bf16*)(F.ws + WS_MD) + (size_t)e * 1024 * 3584, 64 * kb, 64 * nb, 64 * nb, scr, F.lane);
#endif
    }
}
DI void bg_convert_tail(Frame& F, int nwg, int lo, int hi) {
    const int nmax = (nwg + F.G - 1) / F.G, rem = nwg - (nmax - 1) * F.G;
    if (F.bid < rem || rem >= F.G) return;
    LAS unsigned* scr = (LAS unsigned*)(F.lds + F.wave * 8320);
    const int w = (F.bid - rem) * 8 + F.wave, nw = (F.G - rem) * 8;
    for (int g = lo + w; g < hi; g += nw) bg_item(F, g, scr);
}
DI void bg_convert_all(Frame& F, int lo, int hi) {
    LAS unsigned* scr = (LAS unsigned*)(F.lds + F.wave * 8320);
    for (int g = lo + F.bid * 8 + F.wave; g < hi; g += F.G * 8) bg_item(F, g, scr);
}
DI void p0_prologue(Frame& F) {
    {
        LAS float* Sx = (LAS float*)F.lds;
        LAS float* red = (LAS float*)(F.lds + 81920);
        bool staged = false;
        for (int unit = F.bid; unit < 192; unit += F.G) {
            if (!staged) {
                for (int idx = F.tid; idx < 17 * 1024; idx += 512) { const int r = idx / 1024, k = idx % 1024;
                    const float v = r < 16 ? F.in[I_C][r * 1024 + k] : F.in[I_CCTX][k]; Sx[k * 20 + r] = v * sigmoidf_(v); }
                staged = true; __syncthreads();
            }
            const int l = unit / 96, n0 = (unit % 96) * 64;
            const float* Wm = F.in[I_WMOD] + (size_t)l * 1024 * 6144 + n0 + F.lane;
            float acc[17];
#pragma unroll
            for (int r = 0; r < 17; ++r) acc[r] = 0.f;
            const int kb = F.wave * 128;
#pragma unroll 4
            for (int k = 0; k < 128; ++k) { const float wv = Wm[(size_t)(kb + k) * 6144]; const LAS float* sp = Sx + (kb + k) * 20;
                const f32x4 s0 = *(const LAS f32x4*)(sp), s1 = *(const LAS f32x4*)(sp + 4), s2 = *(const LAS f32x4*)(sp + 8), s3 = *(const LAS f32x4*)(sp + 12); const float s4 = sp[16];
                acc[0] += s0[0] * wv; acc[1] += s0[1] * wv; acc[2] += s0[2] * wv; acc[3] += s0[3] * wv; acc[4] += s1[0] * wv; acc[5] += s1[1] * wv; acc[6] += s1[2] * wv; acc[7] += s1[3] * wv;
                acc[8] += s2[0] * wv; acc[9] += s2[1] * wv; acc[10] += s2[2] * wv; acc[11] += s2[3] * wv; acc[12] += s3[0] * wv; acc[13] += s3[1] * wv; acc[14] += s3[2] * wv; acc[15] += s3[3] * wv;
                acc[16] += s4 * wv; }
#pragma unroll
            for (int r = 0; r < 17; ++r) red[(F.wave * 17 + r) * 64 + F.lane] = acc[r];
            __syncthreads();
            for (int idx = F.tid; idx < 17 * 64; idx += 512) { const int r = idx / 64, ln = idx % 64; float s = F.in[I_BMOD][l * 6144 + n0 + ln];
#pragma unroll
                for (int w = 0; w < 8; ++w) s += red[(w * 17 + r) * 64 + ln];
                if (r < 16) ((float*)(F.ws + WS_MODLAT))[((size_t)l * 16 + r) * 6144 + n0 + ln] = s; else ((float*)(F.ws + WS_MODCTX))[(size_t)l * 6144 + n0 + ln] = s; }
            __syncthreads();
        }
        __syncthreads();
    }
    if (F.bid == 0) { const int pos = F.tid >> 3, j = F.tid & 7; const float inv = exp2f(-(float)j * 0.125f * 13.287712379549449f); const float ang = (float)pos * inv;
        float* tab = (float*)(F.ws + WS_ROPE); tab[(pos * 8 + j) * 2] = cosf(ang); tab[(pos * 8 + j) * 2 + 1] = sinf(ang); }
    {
        LAS float* scr = (LAS float*)(F.lds + F.wave * 16384);
        const int gw = F.bid * 8 + F.wave, NGW = F.G * 8;
        constexpr int I_IN = 16 * 96, I_OUT = 16 * 32, I_G = 16 * 88, I_D = 44 * 32, I_MGI = 16 * 112, I_MDI = 56 * 32;
        constexpr int NITEMS = 2 * I_IN + 2 * I_OUT + (DENSE_FP8 == 1 ? 3 * 704 : (DENSE_FP8 == 2 ? 2 * I_G + 704 : 2 * I_G + I_D));
        for (int it = gw; it < NITEMS; it += NGW) {
            int r = it;
            if (r < 2 * I_IN) { const int l = r / I_IN; p0_convert_plain(F, F.in[I_WIN] + (size_t)l * 1024 * 3072, 1024, 3072, (bf16*)(F.ws + WS_WIN) + (size_t)l * 3072 * 1024, r % I_IN, scr); continue; } r -= 2 * I_IN;
            if (r < 2 * I_OUT) { const int l = r / I_OUT; p0_convert_plain(F, F.in[I_WOUT] + (size_t)l * 1024 * 1024, 1024, 1024, (bf16*)(F.ws + WS_WOUT) + (size_t)l * 1024 * 1024, r % I_OUT, scr); continue; } r -= 2 * I_OUT;
#if DENSE_FP8 == 2
            if (r < I_G) { p0_convert_gu(F, F.in[I_FG], 1024, 2816, (bf16*)(F.ws + WS_WGU), r, 0, scr); continue; } r -= I_G;
            if (r < I_G) { p0_convert_gu(F, F.in[I_FU], 1024, 2816, (bf16*)(F.ws + WS_WGU), r, 1, scr); continue; } r -= I_G;
            { const int kb = r / 16, nb = r % 16; conv_item64_fp8(F.in[I_FD], 2816, 1024, F.ws + WS_WD, 64 * kb, 64 * nb, 64 * nb, QS_WD, (LAS unsigned*)scr, F.lane); }
#elif DENSE_FP8 == 1
            { LAS unsigned* scr8 = (LAS unsigned*)scr;
              if (r < 1408) { const int up = r / 704, q = r % 704, kb = q / 44, nb = q % 44, n0 = 64 * nb;
                  conv_item64_fp8(F.in[up ? I_FU : I_FG], 1024, 2816, F.ws + WS_WGU, 64 * kb, n0, 256 * (n0 / 128) + (n0 % 128) + (up ? 128 : 0), QS_WGU, scr8, F.lane); }
              else { const int q = r - 1408, kb = q / 16, nb = q % 16; conv_item64_fp8(F.in[I_FD], 2816, 1024, F.ws + WS_WD, 64 * kb, 64 * nb, 64 * nb, QS_WD, scr8, F.lane); } }
#else
            if (r < I_G) { p0_convert_gu(F, F.in[I_FG], 1024, 2816, (bf16*)(F.ws + WS_WGU), r, 0, scr); continue; } r -= I_G;
            if (r < I_G) { p0_convert_gu(F, F.in[I_FU], 1024, 2816, (bf16*)(F.ws + WS_WGU), r, 1, scr); continue; } r -= I_G;
            p0_convert_plain(F, F.in[I_FD], 2816, 1024, (bf16*)(F.ws + WS_WD), r, scr);
#endif
        }
    }
}

struct NormVecs { f32x4 gs[4], sh[4]; };
DI void norm_load_vecs(Frame& F, const float* g, const float* mod, int isc, int ish, NormVecs& V) {
#pragma unroll
    for (int j = 0; j < 4; ++j) { const f32x4 gv = ((const f32x4*)g)[F.lane + 64 * j], sv = ((const f32x4*)(mod + isc * DM))[F.lane + 64 * j]; V.gs[j] = gv * (sv + 1.0f); V.sh[j] = ((const f32x4*)(mod + ish * DM))[F.lane + 64 * j]; }
}
DI void norm_load_row(Frame& F, const float* srow, f32x4 (&v)[4]) {
    const f32x4* xr = (const f32x4*)srow + F.lane;
#pragma unroll
    for (int j = 0; j < 4; ++j) v[j] = xr[64 * j];
}
DI float norm_ssq(const f32x4 (&v)[4]) { float s = 0.f;
#pragma unroll
    for (int j = 0; j < 4; ++j) s += (v[j].x * v[j].x + v[j].y * v[j].y) + (v[j].z * v[j].z + v[j].w * v[j].w);
    return s; }
DI void norm_finish(Frame& F, const f32x4 (&v)[4], float ssq_total, const NormVecs& V, bf16* orow, f32x4 (&y)[4]) {
    const float rstd = 1.0f / sqrtf(ssq_total * (1.0f / DM) + EPS);
    u32x2* o8 = (u32x2*)orow + F.lane;
#pragma unroll
    for (int j = 0; j < 4; ++j) { y[j] = (v[j] * rstd) * V.gs[j] + V.sh[j]; u32x2 w; w.x = pk2(y[j].x, y[j].y); w.y = pk2(y[j].z, y[j].w); o8[64 * j] = w; }
}
DI void norm_finish8(Frame& F, const f32x4 (&v)[4], float ssq_total, const NormVecs& V, unsigned char* orow, f32x4 (&y)[4]) {
    const float rstd = 1.0f / sqrtf(ssq_total * (1.0f / DM) + EPS);
    unsigned* o4 = (unsigned*)orow + F.lane;
#pragma unroll
    for (int j = 0; j < 4; ++j) { y[j] = (v[j] * rstd) * V.gs[j] + V.sh[j]; o4[64 * j] = pk4_fp8(y[j].x * QS_U, y[j].y * QS_U, y[j].z * QS_U, y[j].w * QS_U); }
}
DI void norm_phase(Frame& F, int l, int which, bool first, int row_lo, bool out8 = false) {
    const float* g = F.in[which == 1 ? I_N1W : I_N2W] + l * DM;
    const float* modlat = (const float*)(F.ws + WS_MODLAT) + (size_t)l * 16 * 6144;
    const float* modctx = (const float*)(F.ws + WS_MODCTX) + (size_t)l * 6144;
    const int ish = which == 1 ? 0 : 3, isc = which == 1 ? 1 : 4;
    const float* sctx = first ? F.in[I_CTX] : (const float*)(F.ws + WS_HCTX);
    const float* slat = first ? F.in[I_X] : F.out;
    bf16* U = (bf16*)(F.ws + WS_U);
    const int gw = F.bid * 8 + F.wave, NGW = F.G * 8;
    const int rpw = (NTOK - row_lo + NGW - 1) / NGW;
    const int r0 = row_lo + gw * rpw; int r1 = r0 + rpw; if (r1 > NTOK) r1 = NTOK;
    NormVecs V; int curb = -2;
    for (int row = r0; row < r1; row += 2) {
        const bool two = row + 1 < r1;
        const int rowb = two ? row + 1 : row;
        f32x4 va[4], vb[4];
        norm_load_row(F, row < NCTX ? sctx + (size_t)row * DM : slat + (size_t)(row - NCTX) * DM, va);
        norm_load_row(F, rowb < NCTX ? sctx + (size_t)rowb * DM : slat + (size_t)(rowb - NCTX) * DM, vb);
        float sa = norm_ssq(va), sb = norm_ssq(vb);
#pragma unroll
        for (int o = 1; o < 64; o <<= 1) { sa += __shfl_xor(sa, o); sb += __shfl_xor(sb, o); }
        f32x4 y[4];
        { const int bk = row < NCTX ? -1 : (row - NCTX) / SEQ; if (bk != curb) { norm_load_vecs(F, g, bk < 0 ? modctx : modlat + (size_t)bk * 6144, isc, ish, V); curb = bk; } }
        if (out8) norm_finish8(F, va, sa, V, (unsigned char*)U + (size_t)row * DM, y); else norm_finish(F, va, sa, V, U + (size_t)row * DM, y);
        if (two) { const int bk = rowb < NCTX ? -1 : (rowb - NCTX) / SEQ; if (bk != curb) { norm_load_vecs(F, g, bk < 0 ? modctx : modlat + (size_t)bk * 6144, isc, ish, V); curb = bk; }
            if (out8) norm_finish8(F, vb, sb, V, (unsigned char*)U + (size_t)rowb * DM, y); else norm_finish(F, vb, sb, V, U + (size_t)rowb * DM, y); }
    }
}
DI void moe_route_row(Frame& F, const f32x4 (&y)[4], LAS const float* Rw, const float (&rb)[8], LAS int* sel, int tl, int tok) {
    float lg[8];
#pragma unroll
    for (int e = 0; e < 8; ++e) lg[e] = 0.f;
#pragma unroll
    for (int j = 0; j < 4; ++j)
#pragma unroll
        for (int q = 0; q < 4; ++q) { const int k = 256 * j + 4 * F.lane + q; const f32x4 r0 = *(const LAS f32x4*)(Rw + k * 8), r1 = *(const LAS f32x4*)(Rw + k * 8 + 4); const float yv = y[j][q];
            lg[0] += yv * r0[0]; lg[1] += yv * r0[1]; lg[2] += yv * r0[2]; lg[3] += yv * r0[3]; lg[4] += yv * r1[0]; lg[5] += yv * r1[1]; lg[6] += yv * r1[2]; lg[7] += yv * r1[3]; }
#pragma unroll
    for (int o = 1; o < 64; o <<= 1) {
#pragma unroll
        for (int e = 0; e < 8; ++e) lg[e] += __shfl_xor(lg[e], o); }
#pragma unroll
    for (int e = 0; e < 8; ++e) lg[e] += rb[e];
    int e1 = 0; float v1 = lg[0];
#pragma unroll
    for (int e = 1; e < 8; ++e) if (lg[e] > v1) { v1 = lg[e]; e1 = e; }
    int e2 = -1; float v2 = -3.0e38f;
#pragma unroll
    for (int e = 0; e < 8; ++e) if (e != e1 && lg[e] > v2) { v2 = lg[e]; e2 = e; }
    const float ex = __expf(v2 - v1), p1 = 1.0f / (1.0f + ex), p2 = ex / (1.0f + ex);
    if (F.lane == 0) { sel[tl * 2] = e1; sel[tl * 2 + 1] = e2; float* pt = (float*)(F.ws + WS_PTOK) + (size_t)tok * 2; pt[0] = p1; pt[1] = p2; }
}
DI void norm_moe_phase(Frame& F) {
    const int l = 1;
    const float* g = F.in[I_N2W] + l * DM;
    const float* modlat = (const float*)(F.ws + WS_MODLAT) + (size_t)l * 16 * 6144;
    bf16* U = (bf16*)(F.ws + WS_U);
    LAS float* Rw = (LAS float*)F.lds;
    LAS int* sel = (LAS int*)(F.lds + 32768);
    for (int idx = F.tid; idx < 8192; idx += 512) Rw[idx] = F.in[I_MR][idx];
    __syncthreads();
    float rb[8];
#pragma unroll
    for (int e = 0; e < 8; ++e) rb[e] = F.in[I_MRB][e];
    NormVecs V; int curb = -2;
    for (int seg = F.bid; seg < 256; seg += F.G) {
        const int bk = (seg * 128) / SEQ; if (bk != curb) { norm_load_vecs(F, g, modlat + (size_t)bk * 6144, 4, 3, V); curb = bk; }
        for (int i = 0; i < 16; i += 2) {
            const int tl = F.wave * 16 + i, tok = seg * 128 + tl;
            f32x4 va[4], vb[4];
            norm_load_row(F, F.out + (size_t)tok * DM, va); norm_load_row(F, F.out + (size_t)(tok + 1) * DM, vb);
            float sa = norm_ssq(va), sb = norm_ssq(vb);
#pragma unroll
            for (int o = 1; o < 64; o <<= 1) { sa += __shfl_xor(sa, o); sb += __shfl_xor(sb, o); }
            f32x4 y[4];
#if MOE_FP8
            norm_finish8(F, va, sa, V, (unsigned char*)U + (size_t)tok * DM, y); moe_route_row(F, y, Rw, rb, sel, tl, tok);
            norm_finish8(F, vb, sb, V, (unsigned char*)U + (size_t)(tok + 1) * DM, y); moe_route_row(F, y, Rw, rb, sel, tl + 1, tok + 1);
#else
            norm_finish(F, va, sa, V, U + (size_t)(NCTX + tok) * DM, y); moe_route_row(F, y, Rw, rb, sel, tl, tok);
            norm_finish(F, vb, sb, V, U + (size_t)(NCTX + tok + 1) * DM, y); moe_route_row(F, y, Rw, rb, sel, tl + 1, tok + 1);
#endif
        }
        __syncthreads();
        if (F.tid < 16) { const int s = F.tid >> 3, e = F.tid & 7; int cnt = 0; int* lst = (int*)(F.ws + WS_SEGLIST) + ((size_t)(seg * 2 + s) * 8 + e) * 128;
            for (int i = 0; i < 128; ++i) if (sel[i * 2 + s] == e) lst[cnt++] = seg * 128 + i;
            ((int*)(F.ws + WS_SEGCNT))[(seg * 2 + s) * 8 + e] = cnt; }
        __syncthreads();
    }
}
DI void moe_route_phase(Frame& F) {
    LAS int* cn = (LAS int*)F.lds;
    LAS int* offs = cn + 2048;
    LAS int* tb = offs + 256;
    for (int unit = F.bid; unit < 16; unit += F.G) {
        const int s = unit >> 3, e = unit & 7;
        const int* segcnt = (const int*)(F.ws + WS_SEGCNT);
        for (int idx = F.tid; idx < 2048; idx += 512) { const int ee = idx >> 8, gsg = idx & 255; cn[idx] = segcnt[(gsg * 2 + s) * 8 + ee]; }
        __syncthreads();
        if (F.tid < 8) { int tot = 0; for (int gsg = 0; gsg < 256; ++gsg) tot += cn[F.tid * 256 + gsg]; tb[16 + F.tid] = tot; }
        if (F.tid == 64) { int run = 0; for (int gsg = 0; gsg < 256; ++gsg) { offs[gsg] = run; run += cn[e * 256 + gsg]; } }
        __syncthreads();
        if (F.tid == 0) { int run = 0; for (int ee = 0; ee < 8; ++ee) { tb[ee] = run; run += (tb[16 + ee] + 255) / 256; } tb[8] = run; }
        __syncthreads();
        int* rowmap = (int*)(F.ws + WS_ROWMAP) + (size_t)s * MOE_ROWS;
        float* prow = (float*)(F.ws + WS_PROW) + (size_t)s * MOE_ROWS;
        const float* ptok = (const float*)(F.ws + WS_PTOK);
        const int base = tb[e] * 256, tot = tb[16 + e], ntile = (tot + 255) / 256;
        if (F.tid < 256) { const int gsg = F.tid; const int c = cn[e * 256 + gsg]; const int* lst = (const int*)(F.ws + WS_SEGLIST) + ((size_t)(gsg * 2 + s) * 8 + e) * 128;
            for (int i = 0; i < c; ++i) { const int tok = lst[i]; rowmap[base + offs[gsg] + i] = tok; prow[base + offs[gsg] + i] = ptok[(size_t)tok * 2 + s]; } }
        for (int i = tot + F.tid; i < ntile * 256; i += 512) { rowmap[base + i] = -1; prow[base + i] = 0.f; }
        if (e == 0) { int* meta = (int*)(F.ws + WS_META) + s * 256;
            if (F.tid == 0) meta[0] = tb[8];
            if (F.tid < 8) { const int t0 = tb[F.tid], t1 = tb[F.tid + 1]; for (int t = t0; t < t1; ++t) meta[1 + t] = F.tid; } }
        __syncthreads();
    }
}
DI void final_phase(Frame& F) {
    const float* g = F.in[I_FNW];
    f32x4 gv[4];
#pragma unroll
    for (int j = 0; j < 4; ++j) gv[j] = ((const f32x4*)g)[F.lane + 64 * j];
    const int gw = F.bid * 8 + F.wave, NGW = F.G * 8;
    const int rpw = (NLAT + NGW - 1) / NGW; const int r0 = gw * rpw; int r1 = r0 + rpw; if (r1 > NLAT) r1 = NLAT;
    for (int row = r0; row < r1; row += 2) {
        const bool two = row + 1 < r1; const int rowb = two ? row + 1 : row;
        f32x4 va[4], vb[4];
        norm_load_row(F, F.out + (size_t)row * DM, va); norm_load_row(F, F.out + (size_t)rowb * DM, vb);
        float sa = norm_ssq(va), sb = norm_ssq(vb);
#pragma unroll
        for (int o = 1; o < 64; o <<= 1) { sa += __shfl_xor(sa, o); sb += __shfl_xor(sb, o); }
        const float ra = 1.0f / sqrtf(sa * (1.0f / DM) + EPS), rbv = 1.0f / sqrtf(sb * (1.0f / DM) + EPS);
        f32x4* xa = (f32x4*)(F.out + (size_t)row * DM) + F.lane; f32x4* xb = (f32x4*)(F.out + (size_t)rowb * DM) + F.lane;
#pragma unroll
        for (int j = 0; j < 4; ++j) xa[64 * j] = (va[j] * ra) * gv[j];
        if (two) {
#pragma unroll
            for (int j = 0; j < 4; ++j) xb[64 * j] = (vb[j] * rbv) * gv[j]; }
    }
}

DI void conv_unit(Frame& F, int l, int row0, int t0, int slen) {
    const bf16* PX = (const bf16*)(F.ws + WS_P);
    bf16* YC = (bf16*)(F.ws + WS_U);
    LAS float* Y = (LAS float*)F.lds;
    { u32x4 av[6], gv[6];
#pragma unroll
      for (int k = 0; k < 6; ++k) { const int it = F.tid + 512 * k; const int rr = it >> 5, cc = it & 31; const int t = t0 - 15 + rr;
          av[k] = (u32x4){0u, 0u, 0u, 0u}; gv[k] = av[k];
          if (it < 94 * 32 && t >= 0 && t < slen) { const bf16* p = PX + (size_t)(row0 + t) * INW + C_CONV + 8 * cc; av[k] = *(const u32x4*)p; gv[k] = *(const u32x4*)(p + 256); } }
#pragma unroll
      for (int k = 0; k < 6; ++k) { const int it = F.tid + 512 * k; const int rr = it >> 5, cc = it & 31;
          if (it < 94 * 32) { f32x4 o0, o1;
              o0[0] = bflo(av[k].x) * sigmoidf_(bflo(gv[k].x)); o0[1] = bfhi(av[k].x) * sigmoidf_(bfhi(gv[k].x)); o0[2] = bflo(av[k].y) * sigmoidf_(bflo(gv[k].y)); o0[3] = bfhi(av[k].y) * sigmoidf_(bfhi(gv[k].y));
              o1[0] = bflo(av[k].z) * sigmoidf_(bflo(gv[k].z)); o1[1] = bfhi(av[k].z) * sigmoidf_(bfhi(gv[k].z)); o1[2] = bflo(av[k].w) * sigmoidf_(bflo(gv[k].w)); o1[3] = bfhi(av[k].w) * sigmoidf_(bfhi(gv[k].w));
              *(LAS f32x4*)(Y + rr * 256 + 8 * cc) = o0; *(LAS f32x4*)(Y + rr * 256 + 8 * cc + 4) = o1; } } }
    __syncthreads();
    const int c = F.tid & 255, half = F.tid >> 8;
    float w[31];
#pragma unroll
    for (int k = 0; k < 31; ++k) w[k] = F.in[I_CONVW][(size_t)l * 31 * 256 + k * 256 + c];
    float acc[32];
    const float cb = F.in[I_CONVB][l * 256 + c];
#pragma unroll
    for (int o = 0; o < 32; ++o) acc[o] = cb;
#pragma unroll
    for (int kk = 0; kk < 62; ++kk) { const float yv = Y[(32 * half + kk) * 256 + c];
#pragma unroll
        for (int o = 0; o < 32; ++o) { const int tap = kk - o; if (tap >= 0 && tap < 31) acc[o] += yv * w[tap]; } }
    __syncthreads();
#pragma unroll
    for (int o = 0; o < 32; ++o) Y[(32 * half + o) * 256 + c] = acc[o];
    __syncthreads();
    const f32x4 lw = ((const f32x4*)(F.in[I_CLNW] + l * 256))[F.lane], lb = ((const f32x4*)(F.in[I_CLNB] + l * 256))[F.lane];
    for (int i = 0; i < 8; ++i) { const int tl = F.wave * 8 + i; const f32x4 v = *(const LAS f32x4*)(Y + tl * 256 + 4 * F.lane);
        const float mu = wave_sum((v.x + v.y) + (v.z + v.w)) * (1.0f / 256.0f); const f32x4 d = v - mu;
        const float var = wave_sum((d.x * d.x + d.y * d.y) + (d.z * d.z + d.w * d.w)) * (1.0f / 256.0f); const float rstd = 1.0f / sqrtf(var + EPS);
        f32x4 z = d * rstd * lw + lb; z.x *= sigmoidf_(z.x); z.y *= sigmoidf_(z.y); z.z *= sigmoidf_(z.z); z.w *= sigmoidf_(z.w);
        u32x2 o; o.x = pk2(z.x, z.y); o.y = pk2(z.z, z.w);
        *(u32x2*)(YC + (size_t)(row0 + t0 + tl) * DM + 512 + 4 * F.lane) = o; }
    __syncthreads();
}
DI void ret_consts(Frame& F, int l, int hh, float& lg2f, float& lg2b) {
    const float df = F.in[I_RDEC][(l * 2 + 0) * 4 + hh], db = F.in[I_RDEC][(l * 2 + 1) * 4 + hh];
    lg2f = log2f(1.0f - exp2f(-df)); lg2b = log2f(1.0f - exp2f(-db));
}
constexpr int ROPE_LDS = AUX_OFF + 4096;
DI void rope_to_lds(Frame& F) { const float* tab = (const float*)(F.ws + WS_ROPE); LAS float* rt = (LAS float*)(F.lds + ROPE_LDS); for (int i = F.tid; i < 1024; i += 512) rt[i] = tab[i]; __syncthreads(); }
DI void unpack8(const u32x4& a, float (&x)[8]) { x[0] = bflo(a.x); x[1] = bfhi(a.x); x[2] = bflo(a.y); x[3] = bfhi(a.y); x[4] = bflo(a.z); x[5] = bfhi(a.z); x[6] = bflo(a.w); x[7] = bfhi(a.w); }
DI void rope_apply(Frame& F, const u32x4& a, const u32x4& b, int hp, bool lat, int tg, float (&x1)[8], float (&x2)[8]) {
    unpack8(a, x1); unpack8(b, x2);
    if (lat) { const int pos = hp == 0 ? (tg >> 6) : (tg & 63); LAS const f32x4* tab = (LAS const f32x4*)(F.lds + ROPE_LDS) + pos * 4;
#pragma unroll
        for (int jj = 0; jj < 4; ++jj) { const f32x4 cs = tab[jj];
            { const float a1 = x1[2 * jj], a2 = x2[2 * jj]; x1[2 * jj] = a1 * cs[0] - a2 * cs[1]; x2[2 * jj] = a2 * cs[0] + a1 * cs[1]; }
            { const float a1 = x1[2 * jj + 1], a2 = x2[2 * jj + 1]; x1[2 * jj + 1] = a1 * cs[2] - a2 * cs[3]; x2[2 * jj + 1] = a2 * cs[2] + a1 * cs[3]; } } }
}
DI void ret_unit_decode(int su, bool& isctx, int& b, int& hh, int& n) {
    isctx = su >= 1024; if (!isctx) { b = su >> 6; hh = (su >> 4) & 3; n = su & 15; } else { const int v = su - 1024; b = v >> 3; hh = (v >> 1) & 3; n = v & 1; }
}
DI void ret_summary_pair(Frame& F, int l, int it) {
    const bf16* PX = (const bf16*)(F.ws + WS_P);
    const int sub = F.wave >> 2, st = F.tid & 255, su = 2 * it + sub;
    bool isctx; int b, hh, n; ret_unit_decode(su, isctx, b, hh, n);
    const int row0 = isctx ? (b * CTXL + n * 128) : (NCTX + b * SEQ + n * 128);
    float lg2f, lg2b; ret_consts(F, l, hh, lg2f, lg2b);
    LAS unsigned char* base = F.lds + sub * 40960;
    LAS unsigned char* Vimg = base;
    LAS unsigned char* Kf = base + 18432;
    LAS unsigned char* Kb = base + 18432 + 10240;
    { const int tok = st >> 1, hp = st & 1; float x1[8], x2[8];
      const bf16* kp = PX + (size_t)(row0 + tok) * INW + C_RK + 32 * hh; const bf16* vp = PX + (size_t)(row0 + tok) * INW + C_RV + 64 * hh + 32 * hp;
      const u32x4 kra = *(const u32x4*)(kp + 8 * hp), krb = *(const u32x4*)(kp + 16 + 8 * hp);
      u32x4 vr[4];
#pragma unroll
      for (int q = 0; q < 4; ++q) vr[q] = *(const u32x4*)(vp + 8 * q);
      rope_apply(F, kra, krb, hp, !isctx, n * 128 + tok, x1, x2);
      const float ks = 0.17677669529663687f;
      const float wf = fast_exp2(lg2f * (float)(127 - tok)) * ks, wb = fast_exp2(lg2b * (float)tok) * ks;
      u32x4 o;
      o.x = pk2(x1[0] * wf, x1[1] * wf); o.y = pk2(x1[2] * wf, x1[3] * wf); o.z = pk2(x1[4] * wf, x1[5] * wf); o.w = pk2(x1[6] * wf, x1[7] * wf); *(LAS u32x4*)(Kf + tok * 80 + 16 * hp) = o;
      o.x = pk2(x2[0] * wf, x2[1] * wf); o.y = pk2(x2[2] * wf, x2[3] * wf); o.z = pk2(x2[4] * wf, x2[5] * wf); o.w = pk2(x2[6] * wf, x2[7] * wf); *(LAS u32x4*)(Kf + tok * 80 + 32 + 16 * hp) = o;
      o.x = pk2(x1[0] * wb, x1[1] * wb); o.y = pk2(x1[2] * wb, x1[3] * wb); o.z = pk2(x1[4] * wb, x1[5] * wb); o.w = pk2(x1[6] * wb, x1[7] * wb); *(LAS u32x4*)(Kb + tok * 80 + 16 * hp) = o;
      o.x = pk2(x2[0] * wb, x2[1] * wb); o.y = pk2(x2[2] * wb, x2[3] * wb); o.z = pk2(x2[4] * wb, x2[5] * wb); o.w = pk2(x2[6] * wb, x2[7] * wb); *(LAS u32x4*)(Kb + tok * 80 + 32 + 16 * hp) = o;
#pragma unroll
      for (int q = 0; q < 4; ++q) *(LAS u32x4*)(Vimg + tok * 144 + 64 * hp + 16 * q) = vr[q]; }
    __syncthreads();
    { const int role = F.wave & 3, dir = role >> 1, et = role & 1;
      const int l32 = F.lane & 31, h = F.lane >> 5, grp = (F.lane >> 4) & 1, i16 = F.lane & 15, q = i16 >> 2, p = i16 & 3;
      LAS unsigned char* Kimg = dir ? Kb : Kf;
      f32x16 acc;
#pragma unroll
      for (int i = 0; i < 16; ++i) acc[i] = 0.f;
#pragma unroll
      for (int s = 0; s < 8; ++s) { const int r0 = 16 * s + 8 * h + q;
          const s16x4 alo = trread(Vimg + r0 * 144 + (32 * et + 16 * grp + 4 * p) * 2), ahi = trread(Vimg + (r0 + 4) * 144 + (32 * et + 16 * grp + 4 * p) * 2);
          const s16x4 blo = trread(Kimg + r0 * 80 + (16 * grp + 4 * p) * 2), bhi = trread(Kimg + (r0 + 4) * 80 + (16 * grp + 4 * p) * 2);
          const bf16x8 a = __builtin_shufflevector(alo, ahi, 0, 1, 2, 3, 4, 5, 6, 7), bb = __builtin_shufflevector(blo, bhi, 0, 1, 2, 3, 4, 5, 6, 7);
          acc = MFMA32(a, bb, acc); }
      float* S = isctx ? (float*)(F.ws + WS_SUMCTX) + ((size_t)((b * 4 + hh) * 2 + n) * 2 + dir) * 2048 : (float*)(F.ws + WS_SUMLAT) + ((size_t)((b * 4 + hh) * 16 + n) * 2 + dir) * 2048;
#pragma unroll
      for (int i = 0; i < 16; ++i) S[(32 * et + crow(i, h)) * 32 + l32] = acc[i]; }
    __syncthreads();
}
DI void ca_phase(Frame& F, int l) {
    rope_to_lds(F);
    const int nconv = l == 0 ? 576 : 512;
    for (int u = F.vb; u < nconv; u += F.G) {
        int v = u; if (l != 0) v += 64;
        if (v < 64) conv_unit(F, l, (v >> 2) * CTXL, (v & 3) * 64, CTXL);
        else { v -= 64; conv_unit(F, l, NCTX + (v >> 5) * SEQ, (v & 31) * 64, SEQ); }
    }
    for (int it = F.vb; it < 576; it += F.G) ret_summary_pair(F, l, it);
}

constexpr int ATT_KV = 18432, ATT_BUF = 2 * ATT_KV, ATT_BT = 2 * ATT_BUF, ATT_NEG = 640;
struct AttRegs { u32x4 k0, v0, k1, v1; };
DI void attn_fetch(const bf16* PX, int rowA, int rowB, unsigned loff, AttRegs& R) {
    const char* pa = (const char*)(PX + (size_t)rowA * INW) + loff; const char* pb = (const char*)(PX + (size_t)rowB * INW) + loff;
    R.k0 = *(const u32x4*)(pa + C_NAK * 2); R.v0 = *(const u32x4*)(pa + C_NAV * 2); R.k1 = *(const u32x4*)(pb + C_NAK * 2); R.v1 = *(const u32x4*)(pb + C_NAV * 2);
}
DI void attn_put(Frame& F, LAS unsigned char* buf, const AttRegs& R) {
    const int key = F.tid >> 3, ch = F.tid & 7;
    *(LAS u32x4*)(buf + key * 144 + 16 * ch) = R.k0; *(LAS u32x4*)(buf + ATT_KV + key * 144 + 16 * ch) = R.v0;
    *(LAS u32x4*)(buf + (64 + key) * 144 + 16 * ch) = R.k1; *(LAS u32x4*)(buf + ATT_KV + (64 + key) * 144 + 16 * ch) = R.v1;
}
template <bool BIAS, int NT>
DI void attn_tiles(LAS const unsigned char* buf, const int (&koff)[2], const bf16x8 (&qf)[4], f32x16& o0, f32x16& o1, f32x16& o2, float& mrun, int lane,
                   LAS const float* const (&bt)[2]  , const float (&pen)[16]) {
    LAS const unsigned char* Kimg = buf; LAS const unsigned char* Vimg = buf + ATT_KV;
    const int l32 = lane & 31, h = lane >> 5, grp = (lane >> 4) & 1, i16 = lane & 15, q = i16 >> 2, p = i16 & 3;
    f32x16 s[NT];
#pragma unroll
    for (int t = 0; t < NT; ++t)
#pragma unroll
        for (int i = 0; i < 16; ++i) s[t][i] = 0.f;
#pragma unroll
    for (int si = 0; si < 4; ++si)
#pragma unroll
        for (int t = 0; t < NT; ++t) { const bf16x8 a = *(const LAS bf16x8*)(Kimg + (koff[t] + l32) * 144 + (16 * si + 8 * h) * 2); s[t] = MFMA32(a, qf[si], s[t]); }
    const float c = 0.125f * LOG2E;
    float v[NT][16]; float mx = -1.0e30f;
#pragma unroll
    for (int t = 0; t < NT; ++t)
#pragma unroll
        for (int i = 0; i < 16; ++i) { float x;
            if (BIAS) x = __builtin_fmaf(s[t][i], c, bt[t][(i & 3) + 8 * (i >> 2)]) + pen[i]; else x = s[t][i];
            v[t][i] = x; mx = fmaxf(mx, x); }
    if (!BIAS) mx *= c;
    mx = fmaxf(mx, __shfl_xor(mx, 32));
    const float mnew = fmaxf(mrun, mx);
    const float alpha = fast_exp2(mrun - mnew);
    if (__any(alpha != 1.0f)) {
#pragma unroll
        for (int i = 0; i < 16; ++i) { o0[i] *= alpha; o1[i] *= alpha; o2[i] *= alpha; } }
    mrun = mnew;
    bf16x8 pf[NT][2];
#pragma unroll
    for (int t = 0; t < NT; ++t) { float pp[16];
#pragma unroll
        for (int i = 0; i < 16; ++i) pp[i] = BIAS ? fast_exp2(v[t][i] - mnew) : fast_exp2(__builtin_fmaf(v[t][i], c, -mnew));
#pragma unroll
        for (int s2 = 0; s2 < 2; ++s2) { u32x4 w; w.x = pk2(pp[8 * s2], pp[8 * s2 + 1]); w.y = pk2(pp[8 * s2 + 2], pp[8 * s2 + 3]); w.z = pk2(pp[8 * s2 + 4], pp[8 * s2 + 5]); w.w = pk2(pp[8 * s2 + 6], pp[8 * s2 + 7]); pf[t][s2] = __builtin_bit_cast(bf16x8, w); } }
    const u32x4 onesw = (u32x4){0x3f803f80u, 0x3f803f80u, 0x3f803f80u, 0x3f803f80u}; const bf16x8 ones = __builtin_bit_cast(bf16x8, onesw);
#pragma unroll
    for (int t = 0; t < NT; ++t)
#pragma unroll
        for (int s2 = 0; s2 < 2; ++s2) { const int r0 = koff[t] + 16 * s2 + 4 * h + q;
#pragma unroll
            for (int et = 0; et < 2; ++et) { const int cb = (32 * et + 16 * grp + 4 * p) * 2;
                const s16x4 lo = trread(Vimg + r0 * 144 + cb), hi = trread(Vimg + (r0 + 8) * 144 + cb);
                const bf16x8 a = __builtin_shufflevector(lo, hi, 0, 1, 2, 3, 4, 5, 6, 7);
                if (et == 0) o0 = MFMA32(a, pf[t][s2], o0); else o1 = MFMA32(a, pf[t][s2], o1); }
            o2 = MFMA32(ones, pf[t][s2], o2); }
}
DI void attn_unit(Frame& F, int l, bool na, int b, int hh, int rg) {
    const bf16* PX = (const bf16*)(F.ws + WS_P);
    bf16* YC = (bf16*)(F.ws + WS_U);
    LAS float* btab = (LAS float*)(F.lds + ATT_BT);
    const int l32 = F.lane & 31, h = F.lane >> 5;
    int qrow, r = 0, qcol = 0, kc0 = 0, ra = 0;
    float pen[16];
#pragma unroll
    for (int i = 0; i < 16; ++i) pen[i] = 0.f;
    if (na) { const int rp = F.wave >> 2, n = F.wave & 3; ra = 4 * rg + 2 * rp; r = ra + (l32 >> 4); qcol = 16 * n + (l32 & 15); qrow = NCTX + b * SEQ + r * GW + qcol;
        int w0 = qcol - 8; w0 = w0 < 0 ? 0 : (w0 > 48 ? 48 : w0); kc0 = 16 * n - 8; kc0 = kc0 < 0 ? 0 : (kc0 > 32 ? 32 : kc0);
#pragma unroll
        for (int i = 0; i < 16; ++i) pen[i] = ((unsigned)(kc0 + crow(i, h) - w0) < 16u) ? 0.f : -1.0e30f; }
    else qrow = b * CTXL + 32 * F.wave + l32;
    bf16x8 qf[4];
#pragma unroll
    for (int si = 0; si < 4; ++si) qf[si] = *(const bf16x8*)(PX + (size_t)qrow * INW + C_NAQ + 64 * hh + 16 * si + 8 * h);
    if (na) { for (int idx = F.tid; idx < ATT_NEG + 128; idx += 512) { float v = 0.f; if (idx >= 48 && idx < 48 + 465) v = F.in[I_RPB][((size_t)l * 8 + hh) * 465 + (idx - 48)] * LOG2E; if (idx >= ATT_NEG) v = -1.0e30f; btab[idx] = v; } }
    f32x16 o0, o1, o2;
#pragma unroll
    for (int i = 0; i < 16; ++i) { o0[i] = 0.f; o1[i] = 0.f; o2[i] = 0.f; }
    float mrun = -1.0e30f;
    int ylo = 0, yhi = 0, nsteps = 2;
    if (na) { const int rlo = 4 * rg, rhi = 4 * rg + 3;
        ylo = rlo - 4; ylo = ylo < 0 ? 0 : (ylo > 24 ? 24 : ylo);
        yhi = rhi - 4; yhi = yhi < 0 ? 0 : (yhi > 24 ? 24 : yhi); yhi += 8; nsteps = 2 + (yhi - ylo + 1) / 2; }
    int sa = ra - 4; sa = sa < 0 ? 0 : (sa > 24 ? 24 : sa);
    int sb = ra + 1 - 4; sb = sb < 0 ? 0 : (sb > 24 ? 24 : sb);
    const int mylo = (l32 >> 4) ? sb : sa;
    const int cbase = kc0 + 4 * h - qcol + 15;
#define ATT_ROWA(sx) ((sx) < 2 ? b * CTXL + 128 * (sx) : NCTX + b * SEQ + (ylo + 2 * ((sx) - 2)) * GW)
#define ATT_ROWB(sx) ((sx) < 2 ? b * CTXL + 128 * (sx) + 64 : NCTX + b * SEQ + ((ylo + 2 * ((sx) - 2) + 1) < yhi ? (ylo + 2 * ((sx) - 2) + 1) : (yhi - 1)) * GW)
    AttRegs R;
    unsigned loff = (unsigned)(((F.tid >> 3) * INW + 64 * hh + 8 * (F.tid & 7)) * 2); asm volatile("" : "+v"(loff));
    attn_fetch(PX, ATT_ROWA(0), ATT_ROWB(0), loff, R);
    for (int st = 0; st < nsteps; ++st) {
        LAS unsigned char* buf = F.lds + (st & 1) * ATT_BUF;
        attn_put(F, buf, R);
        if (st + 1 < nsteps) attn_fetch(PX, ATT_ROWA(st + 1), ATT_ROWB(st + 1), loff, R);
        __syncthreads();
        if (st < 2) {
            LAS const float* const bt[2] = {btab, btab};
            { const int ko[2] = {0, 32}; attn_tiles<false, 2>(buf, ko, qf, o0, o1, o2, mrun, F.lane, bt, pen); }
            { const int ko[2] = {64, 96}; attn_tiles<false, 2>(buf, ko, qf, o0, o1, o2, mrun, F.lane, bt, pen); }
        } else {
            const int y0 = ylo + 2 * (st - 2), y1 = y0 + 1;
            const bool act0 = (y0 >= sa && y0 < sb + 8), act1 = (y1 < yhi && y1 >= sa && y1 < sb + 8);
            const bool ok0 = (unsigned)(y0 - mylo) < 8u, ok1 = (unsigned)(y1 - mylo) < 8u;
            LAS const float* b0 = btab + (ok0 ? 48 + (y0 - r + 7) * 31 + cbase : ATT_NEG);
            LAS const float* b1 = btab + (ok1 ? 48 + (y1 - r + 7) * 31 + cbase : ATT_NEG);
            if (act0 && act1) { const int ko[2] = {kc0, 64 + kc0}; LAS const float* const bt[2] = {b0, b1}; attn_tiles<true, 2>(buf, ko, qf, o0, o1, o2, mrun, F.lane, bt, pen); }
            else if (act0) { const int ko[2] = {kc0, kc0}; LAS const float* const bt[2] = {b0, b0}; attn_tiles<true, 1>(buf, ko, qf, o0, o1, o2, mrun, F.lane, bt, pen); }
            else if (act1) { const int ko[2] = {64 + kc0, 64 + kc0}; LAS const float* const bt[2] = {b1, b1}; attn_tiles<true, 1>(buf, ko, qf, o0, o1, o2, mrun, F.lane, bt, pen); }
        }
    }
#undef ATT_ROWA
#undef ATT_ROWB
    const float inv = 1.0f / o2[0];
    bf16* orow = YC + (size_t)qrow * DM + 64 * hh;
#pragma unroll
    for (int gq = 0; gq < 4; ++gq) { u32x2 w;
        w.x = pk2(o0[4 * gq] * inv, o0[4 * gq + 1] * inv); w.y = pk2(o0[4 * gq + 2] * inv, o0[4 * gq + 3] * inv); *(u32x2*)(orow + 8 * gq + 4 * h) = w;
        w.x = pk2(o1[4 * gq] * inv, o1[4 * gq + 1] * inv); w.y = pk2(o1[4 * gq + 2] * inv, o1[4 * gq + 3] * inv); *(u32x2*)(orow + 32 + 8 * gq + 4 * h) = w; }
    __syncthreads();
}
DI void ret_out_unit(Frame& F, int l, int su) {
    const bf16* PX = (const bf16*)(F.ws + WS_P);
    bf16* YC = (bf16*)(F.ws + WS_U);
    bool isctx; int b, hh, n; ret_unit_decode(su, isctx, b, hh, n);
    const int row0 = isctx ? (b * CTXL + n * 128) : (NCTX + b * SEQ + n * 128);
    float lg2f, lg2b; ret_consts(F, l, hh, lg2f, lg2b);
    LAS unsigned char* Kimg = F.lds;
    LAS unsigned char* Vimg = F.lds + 10240;
    LAS unsigned char* Stf = F.lds + 28672;
    LAS unsigned char* Stb = F.lds + 33792;
    LAS float* Ob = (LAS float*)(F.lds + 38912);
    const int dir = F.wave >> 2, qb = F.wave & 3, l32 = F.lane & 31, h = F.lane >> 5, grp = (F.lane >> 4) & 1, i16 = F.lane & 15, q = i16 >> 2, p = i16 & 3;
    const int iq = 32 * qb + l32;
    const int ktok = (F.tid & 255) >> 1, khp = F.tid & 1;
    const bf16* kp = PX + (size_t)(row0 + ktok) * INW + C_RK + 32 * hh;
    const u32x4 kra = *(const u32x4*)(kp + 8 * khp), krb = *(const u32x4*)(kp + 16 + 8 * khp);
    const int vtok = F.tid >> 2, vch = F.tid & 3; const bf16* vp = PX + (size_t)(row0 + vtok) * INW + C_RV + 64 * hh + 16 * vch;
    const u32x4 vra = *(const u32x4*)vp, vrb = *(const u32x4*)(vp + 8);
    const bf16* qp = PX + (size_t)(row0 + iq) * INW + C_RQ + 32 * hh;
    const u32x4 qra = *(const u32x4*)(qp + 8 * h), qrb = *(const u32x4*)(qp + 16 + 8 * h);
    const bf16* gp = PX + (size_t)(row0 + iq) * INW + (dir ? C_GB : C_GF) + 64 * hh;
    u32x2 gg[8];
#pragma unroll
    for (int et = 0; et < 2; ++et)
#pragma unroll
        for (int gq = 0; gq < 4; ++gq) gg[et * 4 + gq] = *(const u32x2*)(gp + 32 * et + 8 * gq + 4 * h);
    const float cf = fast_exp2(lg2f * 128.0f), cb = fast_exp2(lg2b * 128.0f);
    const float* SC = (const float*)(F.ws + WS_SUMCTX) + (size_t)((b * 4 + hh) * 2) * 2 * 2048;
    const float* SL = (const float*)(F.ws + WS_SUMLAT) + (size_t)((b * 4 + hh) * 16) * 2 * 2048;
    f32x4 sf = (f32x4){0.f, 0.f, 0.f, 0.f}, sb = sf; const int eo = 4 * F.tid;
    if (!isctx) {
        f32x4 t[16];
#pragma unroll
        for (int m = 0; m < 16; ++m) t[m] = *(const f32x4*)(SL + (size_t)(m * 2 + (m <= n ? 0 : 1)) * 2048 + eo);
        const f32x4 c00 = *(const f32x4*)(SC + (0 * 2 + 0) * 2048 + eo), c10 = *(const f32x4*)(SC + (1 * 2 + 0) * 2048 + eo);
        const f32x4 c11 = *(const f32x4*)(SC + (1 * 2 + 1) * 2048 + eo), c01 = *(const f32x4*)(SC + (0 * 2 + 1) * 2048 + eo);
        sf = c00 * cf + c10;
#pragma unroll
        for (int m = 0; m < 16; ++m) { const f32x4 nv = sf * cf + t[m]; sf = (m < n) ? nv : sf; }
        sb = c11 * cb + c01;
#pragma unroll
        for (int m = 15; m >= 0; --m) { const f32x4 nv = sb * cb + t[m]; sb = (m > n) ? nv : sb; }
    } else {
        if (n == 1) sf = *(const f32x4*)(SC + (0 * 2 + 0) * 2048 + eo);
        if (n == 0) sb = *(const f32x4*)(SC + (1 * 2 + 1) * 2048 + eo);
    }
    if (F.tid < 256) { float x1[8], x2[8]; rope_apply(F, kra, krb, khp, !isctx, n * 128 + ktok, x1, x2);
        const float ks = 0.17677669529663687f; u32x4 o;
        o.x = pk2(x1[0] * ks, x1[1] * ks); o.y = pk2(x1[2] * ks, x1[3] * ks); o.z = pk2(x1[4] * ks, x1[5] * ks); o.w = pk2(x1[6] * ks, x1[7] * ks); *(LAS u32x4*)(Kimg + ktok * 80 + 16 * khp) = o;
        o.x = pk2(x2[0] * ks, x2[1] * ks); o.y = pk2(x2[2] * ks, x2[3] * ks); o.z = pk2(x2[4] * ks, x2[5] * ks); o.w = pk2(x2[6] * ks, x2[7] * ks); *(LAS u32x4*)(Kimg + ktok * 80 + 32 + 16 * khp) = o; }
    *(LAS u32x4*)(Vimg + vtok * 144 + 32 * vch) = vra; *(LAS u32x4*)(Vimg + vtok * 144 + 32 * vch + 16) = vrb;
    { const int e = eo >> 5, d = eo & 31; u32x2 w;
      w.x = pk2(sf[0], sf[1]); w.y = pk2(sf[2], sf[3]); *(LAS u32x2*)(Stf + e * 80 + d * 2) = w;
      w.x = pk2(sb[0], sb[1]); w.y = pk2(sb[2], sb[3]); *(LAS u32x2*)(Stb + e * 80 + d * 2) = w; }
    bf16x8 qf[2], qd[2];
    { float x1[8], x2[8]; rope_apply(F, qra, qrb, h, !isctx, n * 128 + iq, x1, x2);
      const float dec = dir == 0 ? fast_exp2(lg2f * (float)(iq + 1)) : fast_exp2(lg2b * (float)(128 - iq));
      u32x4 w;
      w.x = pk2(x1[0], x1[1]); w.y = pk2(x1[2], x1[3]); w.z = pk2(x1[4], x1[5]); w.w = pk2(x1[6], x1[7]); qf[0] = __builtin_bit_cast(bf16x8, w);
      w.x = pk2(x2[0], x2[1]); w.y = pk2(x2[2], x2[3]); w.z = pk2(x2[4], x2[5]); w.w = pk2(x2[6], x2[7]); qf[1] = __builtin_bit_cast(bf16x8, w);
      w.x = pk2(x1[0] * dec, x1[1] * dec); w.y = pk2(x1[2] * dec, x1[3] * dec); w.z = pk2(x1[4] * dec, x1[5] * dec); w.w = pk2(x1[6] * dec, x1[7] * dec); qd[0] = __builtin_bit_cast(bf16x8, w);
      w.x = pk2(x2[0] * dec, x2[1] * dec); w.y = pk2(x2[2] * dec, x2[3] * dec); w.z = pk2(x2[4] * dec, x2[5] * dec); w.w = pk2(x2[6] * dec, x2[7] * dec); qd[1] = __builtin_bit_cast(bf16x8, w); }
    __syncthreads();
    f32x16 o0, o1;
#pragma unroll
    for (int i = 0; i < 16; ++i) { o0[i] = 0.f; o1[i] = 0.f; }
    { LAS const unsigned char* St = dir ? Stb : Stf;
#pragma unroll
      for (int s = 0; s < 2; ++s) { const bf16x8 a0 = *(const LAS bf16x8*)(St + l32 * 80 + (16 * s + 8 * h) * 2), a1 = *(const LAS bf16x8*)(St + (32 + l32) * 80 + (16 * s + 8 * h) * 2);
          o0 = MFMA32(a0, qd[s], o0); o1 = MFMA32(a1, qd[s], o1); } }
    const float lgd = dir ? lg2b : lg2f;
    const int kt_lo = dir ? qb : 0, kt_hi = dir ? 3 : qb;
    for (int kt = kt_lo; kt <= kt_hi; ++kt) {
        f32x16 s;
#pragma unroll
        for (int i = 0; i < 16; ++i) s[i] = 0.f;
#pragma unroll
        for (int si = 0; si < 2; ++si) { const bf16x8 a = *(const LAS bf16x8*)(Kimg + (32 * kt + l32) * 80 + (16 * si + 8 * h) * 2); s = MFMA32(a, qf[si], s); }
        float pp[16];
#pragma unroll
        for (int i = 0; i < 16; ++i) { const int j = 32 * kt + crow(i, h); const int diff = dir ? (j - iq) : (iq - j); pp[i] = diff >= 0 ? s[i] * fast_exp2(lgd * (float)diff) : 0.f; }
        bf16x8 pf[2];
#pragma unroll
        for (int s2 = 0; s2 < 2; ++s2) { u32x4 w; w.x = pk2(pp[8 * s2], pp[8 * s2 + 1]); w.y = pk2(pp[8 * s2 + 2], pp[8 * s2 + 3]); w.z = pk2(pp[8 * s2 + 4], pp[8 * s2 + 5]); w.w = pk2(pp[8 * s2 + 6], pp[8 * s2 + 7]); pf[s2] = __builtin_bit_cast(bf16x8, w); }
#pragma unroll
        for (int s2 = 0; s2 < 2; ++s2) { const int r0 = 32 * kt + 16 * s2 + 4 * h + q;
#pragma unroll
            for (int et = 0; et < 2; ++et) { const int cb = (32 * et + 16 * grp + 4 * p) * 2;
                const s16x4 lo = trread(Vimg + r0 * 144 + cb), hi = trread(Vimg + (r0 + 8) * 144 + cb);
                const bf16x8 a = __builtin_shufflevector(lo, hi, 0, 1, 2, 3, 4, 5, 6, 7);
                if (et == 0) o0 = MFMA32(a, pf[s2], o0); else o1 = MFMA32(a, pf[s2], o1); } }
    }
    float sm = 0.f;
#pragma unroll
    for (int i = 0; i < 16; ++i) sm += o0[i] + o1[i];
    sm += __shfl_xor(sm, 32);
    const float mu = sm * (1.0f / 64.0f);
    float vs = 0.f;
#pragma unroll
    for (int i = 0; i < 16; ++i) { const float d0 = o0[i] - mu, d1 = o1[i] - mu; vs += d0 * d0 + d1 * d1; }
    vs += __shfl_xor(vs, 32);
    const float rstd = 1.0f / sqrtf(vs * (1.0f / 64.0f) + EPS);
    const float* gn = F.in[I_RGNW] + l * 256 + 64 * hh;
    float val[32];
#pragma unroll
    for (int et = 0; et < 2; ++et)
#pragma unroll
        for (int gq = 0; gq < 4; ++gq) { const int e0 = 32 * et + 8 * gq + 4 * h; const u32x2 ggv = gg[et * 4 + gq]; const f32x4 gw = *(const f32x4*)(gn + e0);
            const float g0 = bflo(ggv.x), g1 = bfhi(ggv.x), g2 = bflo(ggv.y), g3 = bfhi(ggv.y);
            const float a0 = et ? o1[4 * gq] : o0[4 * gq], a1 = et ? o1[4 * gq + 1] : o0[4 * gq + 1], a2 = et ? o1[4 * gq + 2] : o0[4 * gq + 2], a3 = et ? o1[4 * gq + 3] : o0[4 * gq + 3];
            val[et * 16 + 4 * gq] = (a0 - mu) * rstd * gw[0] * g0 * sigmoidf_(g0); val[et * 16 + 4 * gq + 1] = (a1 - mu) * rstd * gw[1] * g1 * sigmoidf_(g1);
            val[et * 16 + 4 * gq + 2] = (a2 - mu) * rstd * gw[2] * g2 * sigmoidf_(g2); val[et * 16 + 4 * gq + 3] = (a3 - mu) * rstd * gw[3] * g3 * sigmoidf_(g3); }
    if (dir == 0) {
#pragma unroll
        for (int et = 0; et < 2; ++et)
#pragma unroll
            for (int gq = 0; gq < 4; ++gq)
#pragma unroll
                for (int j = 0; j < 4; ++j) Ob[iq * 65 + 32 * et + 8 * gq + 4 * h + j] = val[et * 16 + 4 * gq + j];
    }
    __syncthreads();
    if (dir == 1) { bf16* orow = YC + (size_t)(row0 + iq) * DM + 768 + 64 * hh;
#pragma unroll
        for (int et = 0; et < 2; ++et)
#pragma unroll
            for (int gq = 0; gq < 4; ++gq) { const int e0 = 32 * et + 8 * gq + 4 * h; float t[4];
#pragma unroll
                for (int j = 0; j < 4; ++j) t[j] = val[et * 16 + 4 * gq + j] + Ob[iq * 65 + e0 + j];
                u32x2 w; w.x = pk2(t[0], t[1]); w.y = pk2(t[2], t[3]); *(u32x2*)(orow + e0) = w; } }
    __syncthreads();
}
#ifndef PROBE_SUB
#define PROBE_SUB 0
#endif
DI void cb_phase(Frame& F, int l) {
    rope_to_lds(F);
    const int nattn = l == 0 ? 1152 : 1024;
    for (int rep = 0; rep < ((PROBE_SUB & 1) ? 2 : 1); ++rep)
    for (int u = F.vb; u < nattn; u += F.G) {
        if (u < 1024) attn_unit(F, l, true, u >> 6, (u >> 3) & 7, u & 7);
        else { const int v = u - 1024; attn_unit(F, l, false, v >> 3, v & 7, 0); }
    }
    const int nret = l == 0 ? 1152 : 1024;
    for (int rep = 0; rep < ((PROBE_SUB & 2) ? 2 : 1); ++rep)
    for (int u = F.vb; u < nret; u += F.G) ret_out_unit(F, l, u);
}

static_assert(sizeof(Params) == 240, "kernarg layout: in[26] at 0, out at 208, ws at 216, ph_lo at 224, ph_hi at 228");
#ifdef ONLY_PHASE
#define IN(k) ((k) == ONLY_PHASE && lo <= (k) && (k) < hi)
#else
#define IN(k) (lo <= (k) && (k) < hi)
#endif
#ifndef PROBE_MASK
#define PROBE_MASK 0u
#endif
#define NREP(k) (((PROBE_MASK >> (k)) & 1u) ? 2 : 1)
#define SEAM(k) do { if (IN(k) && IN((k) + 1)) { XcdBarrier bb_ = bar; asm volatile("" : "+s"(bb_.bar)); xcd_barrier(bb_, F.wave); } } while (0)
#define GLDS(P) ((LAS unsigned char*)(P).lds)
#define WSB(P, off) ((const pg8::bf16_t*)((P).ws + (off)))
template <int l> DI void layer_phases(Frame& F, const XcdBarrier& bar) {
    constexpr int lo = 0, hi = N_PHASES;
        const int pb = l == 0 ? 1 : 9;
        if (IN(pb + 0)) for (int rep_ = 0; rep_ < NREP(pb + 0); ++rep_) { if (rep_) __syncthreads(); Frame P = phase_frame(F); norm_phase(P, l, 1, l == 0, 0); } SEAM(pb + 0);
        if (IN(pb + 1)) for (int rep_ = 0; rep_ < NREP(pb + 1); ++rep_) { if (rep_) __syncthreads();
            Frame P = phase_frame(F);
            pg8::StaticOrder S; S.init(NTOK, INW, P.G, P.bid);
            pg8::EpiStoreBf16 E{(pg8::bf16_t*)(P.ws + WS_P), INW};
            pg8::gemm_phase<pg8::EpiStoreBf16, pg8::StaticOrder, pg8::RowsLinear, true>(GLDS(P), P.tid, WSB(P, WS_U), WSB(P, WS_WIN) + (size_t)l * INW * DM, 2 * DM, S, E, pg8::RowsLinear{});
            if (PROBE_SUB & 4) { __syncthreads(); pg8::gemm_phase<pg8::EpiNull, pg8::StaticOrder, pg8::RowsLinear, true>(GLDS(P), P.tid, WSB(P, WS_U), WSB(P, WS_WIN) + (size_t)l * INW * DM, 2 * DM, S, pg8::EpiNull{}, pg8::RowsLinear{}); }
            if (l == 0) bg_convert_tail(P, S.nwg, BG_B0, BG_D0); else bg_convert_tail(P, S.nwg, BG_B1, BG_CL);
        } SEAM(pb + 1);
        if (IN(pb + 2)) for (int rep_ = 0; rep_ < NREP(pb + 2); ++rep_) { if (rep_) __syncthreads(); Frame P = phase_frame(F); if (l == 1) { bg_convert_all(P, BG_CL, BG_ITEMS); __syncthreads(); } ca_phase(P, l); } SEAM(pb + 2);
        if (IN(pb + 3)) for (int rep_ = 0; rep_ < NREP(pb + 3); ++rep_) { if (rep_) __syncthreads(); Frame P = phase_frame(F); cb_phase(P, l); } SEAM(pb + 3);
        if (IN(pb + 4)) {
            Frame P = phase_frame(F);
            const int rb = l == 0 ? 0 : NCTX;
            const float* modlat = (const float*)(P.ws + WS_MODLAT) + (size_t)l * 16 * 6144;
            const float* modctx = (const float*)(P.ws + WS_MODCTX) + (size_t)l * 6144;
            float* hctx = (float*)(P.ws + WS_HCTX);
            pg8::StaticOrder S; S.init(NTOK - rb, DM, P.G, P.bid);
            pg8::EpiResGate E{l == 0 ? P.in[I_CTX] : hctx, l == 0 ? P.in[I_X] : P.out, hctx, P.out, modlat + 2 * DM, modctx + 2 * DM, rb};
            pg8::gemm_phase<pg8::EpiResGate, pg8::StaticOrder, pg8::RowsLinear, true>(GLDS(P), P.tid, WSB(P, WS_U) + (size_t)rb * DM, WSB(P, WS_WOUT) + (size_t)l * DM * DM, 2 * DM, S, E, pg8::RowsLinear{});
            if (l == 0) bg_convert_tail(P, S.nwg, BG_D0, BG_E0);
        } SEAM(pb + 4);
        if (l == 0) {
            if (IN(6)) for (int rep_ = 0; rep_ < NREP(6); ++rep_) { if (rep_) __syncthreads(); Frame P = phase_frame(F); norm_phase(P, 0, 2, false, 0, DENSE_FP8 == 1); } SEAM(6);
            if (IN(7)) for (int rep_ = 0; rep_ < NREP(7); ++rep_) { if (rep_) __syncthreads();
                Frame P = phase_frame(F);
                pg8::StaticOrder S; S.init(NTOK, 2 * DFF, P.G, P.bid);
                pg8::EpiSwiglu<false> E{(pg8::bf16_t*)(P.ws + WS_P), DFF, 0, nullptr};
#if DENSE_FP8 == 1
                pg8::gemm_phase<pg8::EpiSwiglu<false>, pg8::StaticOrder, pg8::RowsLinearOff, true, true>(GLDS(P), P.tid, WSB(P, WS_U), WSB(P, WS_WGU), DM, S, E, pg8::RowsLinearOff{}, SCL_U, SCL_WGU);
#else
                pg8::gemm_phase<pg8::EpiSwiglu<false>, pg8::StaticOrder, pg8::RowsLinear, true>(GLDS(P), P.tid, WSB(P, WS_U), WSB(P, WS_WGU), 2 * DM, S, E, pg8::RowsLinear{});
#endif
                bg_convert_tail(P, S.nwg, BG_E0, BG_F0);
            } SEAM(7);
            if (IN(8)) {
                Frame P = phase_frame(F);
                const float* modlat = (const float*)(P.ws + WS_MODLAT);
                const float* modctx = (const float*)(P.ws + WS_MODCTX);
                float* hctx = (float*)(P.ws + WS_HCTX);
                pg8::StaticOrder S; S.init(NTOK, DM, P.G, P.bid);
                pg8::EpiResGate E{hctx, P.out, hctx, P.out, modlat + 5 * DM, modctx + 5 * DM, 0};
#if DENSE_FP8
                pg8::gemm_phase<pg8::EpiResGate, pg8::StaticOrder, pg8::RowsLinearOff, true, true>(GLDS(P), P.tid, WSB(P, WS_P), WSB(P, WS_WD), DFF, S, E, pg8::RowsLinearOff{}, SCL_H, SCL_WD);
#else
                pg8::gemm_phase<pg8::EpiResGate, pg8::StaticOrder, pg8::RowsLinear, true>(GLDS(P), P.tid, WSB(P, WS_P), WSB(P, WS_WD), 2 * DFF, S, E, pg8::RowsLinear{});
#endif
                bg_convert_tail(P, S.nwg, BG_F0, BG_B1);
            } SEAM(8);
        } else {
            if (IN(14)) for (int rep_ = 0; rep_ < NREP(14); ++rep_) { if (rep_) __syncthreads(); Frame P = phase_frame(F); norm_moe_phase(P); } SEAM(14);
            if (IN(15)) for (int rep_ = 0; rep_ < NREP(15); ++rep_) { if (rep_) __syncthreads(); Frame P = phase_frame(F); moe_route_phase(P); } SEAM(15);
            LAS int* texp = (LAS int*)(F.lds + AUX_TAB);
            if (IN(16) || IN(17) || IN(18)) {
                Frame P = phase_frame(F);
                const int* meta = (const int*)(P.ws + WS_META);
                __syncthreads();
                for (int i = P.tid; i < 2 * MOE_TILES; i += 512) texp[i] = ld_i32_coherent(meta + (i / MOE_TILES) * 256 + 1 + (i % MOE_TILES));
                if (P.tid < 2) texp[2 * MOE_TILES + P.tid] = ld_i32_coherent(meta + P.tid * 256);
                __syncthreads();
            }
            if (IN(16)) for (int rep_ = 0; rep_ < NREP(16); ++rep_) { if (rep_) __syncthreads();
                Frame P = phase_frame(F);
                const int NT0 = __builtin_amdgcn_readfirstlane(texp[2 * MOE_TILES]), NT1 = __builtin_amdgcn_readfirstlane(texp[2 * MOE_TILES + 1]);
                pg8::MoeOrder S{NT0, NT1, 28, P.G, P.bid, (const LAS int*)texp};
                pg8::EpiSwiglu<true> E{(pg8::bf16_t*)(P.ws + WS_P), DFE, 28, (const float*)(P.ws + WS_PROW)};
                pg8::gemm_phase<pg8::EpiSwiglu<true>, pg8::MoeOrder, pg8::RowsGather, true, true>(GLDS(P), P.tid, WSB(P, WS_U), WSB(P, WS_MGU), DM, S, E, pg8::RowsGather{(const int*)(P.ws + WS_ROWMAP), 0}, SCL_U, SCL_WGU);
            } SEAM(16);
#pragma unroll 1
            for (int s = 0; s < 2; ++s) {
                if (IN(17 + s)) {
                    Frame P = phase_frame(F);
                    const int* rowmap = (const int*)(P.ws + WS_ROWMAP) + (size_t)s * MOE_ROWS;
                    const float* modlat = (const float*)(P.ws + WS_MODLAT) + (size_t)16 * 6144;
                    const int NT = __builtin_amdgcn_readfirstlane(texp[2 * MOE_TILES + s]);
                    pg8::MoeOrder S{NT, 0, 4, P.G, P.bid, (const LAS int*)(texp + s * MOE_TILES)};
                    pg8::EpiMoeScatter E{rowmap, (const float*)(P.ws + WS_PROW) + (size_t)s * MOE_ROWS, P.out, modlat + 5 * DM, 4};
                    pg8::gemm_phase<pg8::EpiMoeScatter, pg8::MoeOrder, pg8::RowsLinearOff, true, true>(GLDS(P), P.tid, P.ws + WS_P + (size_t)s * MOE_ROWS * DFE, WSB(P, WS_MD), DFE, S, E, pg8::RowsLinearOff{}, SCL_H, SCL_WD);
                } SEAM(17 + s);
            }
        }
}
__global__ void __launch_bounds__(512, 2) fwd_kernel(Params prm) {
    extern __shared__ __attribute__((aligned(16))) unsigned char lds_raw[];
    Frame F;
    F.lds = (LAS unsigned char*)lds_raw;
    F.tid = threadIdx.x; F.lane = F.tid & 63; F.wave = __builtin_amdgcn_readfirstlane(F.tid >> 6);
    F.G = gridDim.x; F.bid = blockIdx.x; F.vb = F.bid;
    F.in.ka = (karg_t)__builtin_amdgcn_kernarg_segment_ptr(); F.out = prm.out; F.ws = prm.ws;
    volatile LAS unsigned* MISC = (volatile LAS unsigned*)(F.lds + AUX_OFF);
    if (F.tid < 64) MISC[F.tid] = 0u;
    __syncthreads();
    XcdBarrier bar; bar.bar = (unsigned*)(prm.ws + WS_CTL) + 1024; bar.x = 0; bar.st = nullptr;
#if MK_PER_PHASE
    const int lo = prm.ph_lo, hi = prm.ph_hi;
#else
    constexpr int lo = 0, hi = N_PHASES;
#endif
    if (hi - lo > 1) bar = xcd_barrier_post((unsigned*)(prm.ws + WS_CTL) + 1024, MISC + 8);

    if (IN(0)) for (int rep_ = 0; rep_ < NREP(0); ++rep_) { if (rep_) __syncthreads(); Frame P = phase_frame(F); p0_prologue(P); } SEAM(0);
    layer_phases<0>(F, bar);
    layer_phases<1>(F, bar);
    if (IN(PH_FINAL)) { Frame P = phase_frame(F); final_phase(P); }
#undef IN
#undef SEAM
}

extern "C" void kernel_launch(void* const* d_in, const int* in_sizes, int n_in, void* d_out, int out_size, void* d_ws, size_t ws_size, hipStream_t stream) {
    static int grid = 0;
    if (grid == 0) {
        if (n_in != 26 || in_sizes[0] != NLAT * DM || out_size != NLAT * DM || ws_size < WS_END) {
            fprintf(stderr, "kernel_launch: unexpected shapes (n_in %d, in0 %d, out %d, ws %zu, need %zu); nothing launched\n", n_in, n_in > 0 ? in_sizes[0] : -1, out_size, ws_size, (size_t)WS_END); grid = -1; return; }
        int dev = 0, cus = 0, per_cu = 0;
        if (hipGetDevice(&dev) != hipSuccess || hipDeviceGetAttribute(&cus, hipDeviceAttributeMultiprocessorCount, dev) != hipSuccess) { grid = -1; return; }
        if (hipFuncSetAttribute((const void*)fwd_kernel, hipFuncAttributeMaxDynamicSharedMemorySize, LDS_BYTES) != hipSuccess) { fprintf(stderr, "kernel_launch: hipFuncSetAttribute failed\n"); grid = -1; return; }
        if (hipOccupancyMaxActiveBlocksPerMultiprocessor(&per_cu, (const void*)fwd_kernel, 512, LDS_BYTES) != hipSuccess || per_cu < 1)
            fprintf(stderr, "kernel_launch: note: occupancy query reports %d workgroups per CU\n", per_cu);
        (void)hipGetLastError();
        grid = cus;
    }
    if (grid < 0) return;
    if (hipMemsetAsync((char*)d_ws + WS_CTL, 0, CTL_ZERO_BYTES, stream) != hipSuccess) return;
    Params p{};
    for (int i = 0; i < 26; ++i) p.in[i] = (const float*)d_in[i];
    p.out = (float*)d_out; p.ws = (unsigned char*)d_ws;
#if MK_PER_PHASE
    for (int ph = 0; ph < N_PHASES; ++ph) { p.ph_lo = ph; p.ph_hi = ph + 1; hipLaunchKernelGGL(fwd_kernel, dim3(grid), dim3(512), LDS_BYTES, stream, p); }
#else
    p.ph_lo = 0; p.ph_hi = N_PHASES;
    hipLaunchKernelGGL(fwd_kernel, dim3(grid), dim3(512), LDS_BYTES, stream, p);
#endif
}
```

```cpp
#include <hip/hip_runtime.h>
#include <cstdio>
#include <cstdint>

#ifndef PROBE_SUB
#define PROBE_SUB 0
#endif
#ifndef MK_PER_PHASE
#define MK_PER_PHASE 0
#endif

#define LAS __attribute__((address_space(3)))
#define GAS __attribute__((address_space(1)))
#define DI __device__ __forceinline__
typedef unsigned short bf16;
typedef short bf16x8 __attribute__((ext_vector_type(8)));
typedef short s16x4 __attribute__((ext_vector_type(4)));
typedef float f32x4 __attribute__((ext_vector_type(4)));
typedef float f32x16 __attribute__((ext_vector_type(16)));
typedef unsigned u32x4 __attribute__((ext_vector_type(4)));
typedef unsigned u32x2 __attribute__((ext_vector_type(2)));
typedef float f32x2_t __attribute__((ext_vector_type(2)));
typedef __bf16 bf16x2_t __attribute__((ext_vector_type(2)));
typedef short v4i16_t __attribute__((ext_vector_type(4)));

constexpr int DM = 1024, NB = 16, SEQ = 2048, CTXL = 256, GW = 64;
constexpr int NLAT = NB * SEQ, NCTX = NB * CTXL, NTOK = NLAT + NCTX;
constexpr int INW = 3072, DFF = 2816, NE = 8, DFE = 3584;
constexpr int C_NAQ = 0, C_NAK = 512, C_NAV = 1024, C_CONV = 1536, C_RQ = 2048, C_RK = 2176, C_RV = 2304, C_GF = 2560, C_GB = 2816;
constexpr float EPS = 1e-6f;
constexpr float LOG2E = 1.4426950408889634f;

constexpr size_t MiB = 1u << 20;
constexpr size_t WS_CTL = 0, CTL_ZERO_BYTES = 64 * 1024;
constexpr size_t WS_MODLAT = 1 * MiB;
constexpr size_t WS_MODCTX = WS_MODLAT + 2 * 16 * 6144 * 4;
constexpr size_t WS_ROPE = WS_MODCTX + 2 * 6144 * 4;
constexpr size_t WS_PTOK = 2 * MiB;
constexpr size_t WS_SEGCNT = WS_PTOK + 32768 * 2 * 4;
constexpr size_t WS_META = WS_SEGCNT + 256 * 2 * 8 * 4;
constexpr size_t WS_SEGLIST = 3 * MiB;
constexpr size_t WS_ROWMAP = 5 * MiB;
constexpr int MOE_ROWS = 34816;
constexpr int MOE_TILES = MOE_ROWS / 256;
constexpr size_t WS_PROW = WS_ROWMAP + 512 * 1024;
constexpr size_t WS_SUMLAT = 6 * MiB;
constexpr size_t WS_SUMCTX = 22 * MiB;
constexpr size_t WS_WIN = 24 * MiB;
constexpr size_t WS_WOUT = WS_WIN + (size_t)2 * 3072 * 1024 * 2;
constexpr size_t WS_WGU = WS_WOUT + (size_t)2 * 1024 * 1024 * 2;
constexpr size_t WS_WD = WS_WGU + (size_t)5632 * 1024 * 2;
constexpr size_t WS_MGU = WS_WD + (size_t)1024 * 2816 * 2;
constexpr size_t WS_MD = WS_MGU + (size_t)8 * 7168 * 1024 * 2;
constexpr size_t WS_HCTX = WS_MD + (size_t)8 * 1024 * 3584 * 2;
constexpr size_t WS_U = WS_HCTX + (size_t)NCTX * DM * 4;
constexpr size_t WS_P = WS_U + (size_t)NTOK * DM * 2;
constexpr size_t WS_END = WS_P + (size_t)MOE_ROWS * DFE * 2;
static_assert((size_t)NTOK * INW * 2 <= (size_t)MOE_ROWS * DFE * 2, "P region: px | dense hidden | fp8 hidden of both MoE slots (2 x MOE_ROWS x DFE bytes)");
static_assert(WS_WIN % 256 == 0 && WS_WOUT % 256 == 0 && WS_WGU % 256 == 0 && WS_WD % 256 == 0 && WS_MGU % 256 == 0 && WS_MD % 256 == 0 && WS_HCTX % 256 == 0 && WS_U % 256 == 0 && WS_P % 256 == 0, "align");

constexpr int RING_BYTES = 131072;
constexpr int AUX_OFF = RING_BYTES;
constexpr int AUX_TAB = AUX_OFF + 1024;
constexpr int LDS_BYTES = 147456;

#ifndef MOE_FP8
#define MOE_FP8 1
#endif
#ifndef DENSE_FP8
#define DENSE_FP8 2
#endif
constexpr int SCL_U = 0x7c7c7c7c, SCL_WGU = 0x79797979, SCL_H = 0x7c7c7c7c, SCL_WD = 0x78787878;
constexpr float QS_U = 8.0f, QS_WGU = 64.0f, QS_H = 8.0f, QS_WD = 128.0f;
DI unsigned pk2(float lo, float hi) { f32x2_t v = {lo, hi}; bf16x2_t b = __builtin_convertvector(v, bf16x2_t); return __builtin_bit_cast(unsigned, b); }
DI float clamp448(float x) { return __builtin_fminf(__builtin_fmaxf(x, -448.0f), 448.0f); }
DI unsigned pk4_fp8(float a, float b, float c, float d) { int w = 0; w = __builtin_amdgcn_cvt_pk_fp8_f32(clamp448(a), clamp448(b), w, false); w = __builtin_amdgcn_cvt_pk_fp8_f32(clamp448(c), clamp448(d), w, true); return (unsigned)w; }
DI float bflo(unsigned u) { return __uint_as_float(u << 16); }
DI float bfhi(unsigned u) { return __uint_as_float(u & 0xffff0000u); }
DI float wave_sum(float v) {
#pragma unroll
    for (int o = 1; o < 64; o <<= 1) v += __shfl_xor(v, o);
    return v;
}
DI float fast_exp2(float x) { return __builtin_amdgcn_exp2f(x); }
DI float fast_rcp(float x) { return __builtin_amdgcn_rcpf(x); }
DI float sigmoidf_(float x) { return fast_rcp(1.0f + fast_exp2(-x * LOG2E)); }
DI int crow(int reg, int h) { return (reg & 3) + 8 * (reg >> 2) + 4 * h; }
#define MFMA32(a, b, c) __builtin_amdgcn_mfma_f32_32x32x16_bf16((a), (b), (c), 0, 0, 0)
DI s16x4 trread(LAS const unsigned char* p) { return __builtin_bit_cast(s16x4, __builtin_amdgcn_ds_read_tr16_b64_v4i16((LAS v4i16_t*)p)); }
DI int ld_i32_coherent(const int* p) { return (int)__hip_atomic_load((const unsigned*)p, __ATOMIC_RELAXED, __HIP_MEMORY_SCOPE_AGENT); }

namespace pg8 {
#define PG8_LAS __attribute__((address_space(3)))
typedef unsigned short bf16_t;
constexpr int BM = 256, BK = 64, HALF = 128, HTB = HALF * BK * 2, STAGE_BYTES = 8 * HTB, NXCD = 8, WGM = 8;
__host__ __device__ __forceinline__ int lds_byte(int r, int c) { const int st = (r >> 4) * 2 + (c >> 5), rr = r & 15, cc = c & 31, ob = rr * 64 + cc * 2; return st * 1024 + (ob ^ (((ob >> 9) & 1) << 5)); }
__host__ __device__ __forceinline__ void stage_rc(int b, int& R, int& C) { const int st = b / 1024, sb = b % 1024, swz = sb ^ (((sb >> 9) & 1) << 5); R = (st >> 1) * 16 + swz / 64; C = (st & 1) * 32 + (swz % 64) / 2; }
__host__ __device__ __forceinline__ int perm32(int rho) { const int n = rho >> 4, i = rho & 15; return 8 * (i >> 2) + 4 * n + (i & 3); }
struct Unit { int pm, pn; };
struct StaticOrder {
    int nM, nN, nwg, G, c;
    __device__ void init(int M, int N, int G_, int c_) { nM = M / BM; nN = N / BM; nwg = nM * nN; G = G_; c = c_; }
    __device__ bool next(int i, Unit& u) const {
        const long L = (long)i * G + c; if (L >= nwg) return false;
        int wgid = (int)L; { const int q = nwg / NXCD, r = nwg % NXCD, xcd = wgid % NXCD, off = wgid / NXCD; wgid = (xcd < r ? xcd * (q + 1) : r * (q + 1) + (xcd - r) * q) + off; }
        const int nig = WGM * nN, gid = wgid / nig, fm = gid * WGM, gsz = (nM - fm) < WGM ? (nM - fm) : WGM;
        u.pm = fm + ((wgid % nig) % gsz); u.pn = (wgid % nig) / gsz; return true;
    }
};
struct RowsLinear { static constexpr bool GATHER = false; };
struct RowsLinearOff {
    static constexpr bool GATHER = true;
    __device__ __forceinline__ void fetch(const Unit& u, const int (&R)[2], int (&raw)[2][2]) const {
#pragma unroll
        for (int h = 0; h < 2; ++h)
#pragma unroll
            for (int i = 0; i < 2; ++i) raw[h][i] = u.pm * BM + h * HALF + R[i];
    }
    __device__ __forceinline__ void make(const int (&raw)[2][2], const int (&C)[2], int pitch, unsigned (&o)[2][2]) const {
#pragma unroll
        for (int h = 0; h < 2; ++h)
#pragma unroll
            for (int i = 0; i < 2; ++i) { o[h][i] = (unsigned)raw[h][i] * (unsigned)pitch + (unsigned)C[i] * 2u; asm volatile("" : "+v"(o[h][i])); }
    }
};
struct RowsGather {
    static constexpr bool GATHER = true;
    const int* rowmap; int row_add;
    __device__ __forceinline__ void fetch(const Unit& u, const int (&R)[2], int (&raw)[2][2]) const {
#pragma unroll
        for (int h = 0; h < 2; ++h)
#pragma unroll
            for (int i = 0; i < 2; ++i) raw[h][i] = rowmap[u.pm * BM + h * HALF + R[i]];
    }
    __device__ __forceinline__ void make(const int (&raw)[2][2], const int (&C)[2], int pitch, unsigned (&o)[2][2]) const {
#pragma unroll
        for (int h = 0; h < 2; ++h)
#pragma unroll
            for (int i = 0; i < 2; ++i) { int t = raw[h][i]; t = t < 0 ? 0 : t; o[h][i] = (unsigned)((size_t)(t + row_add) * (size_t)pitch + (size_t)C[i] * 2u); }
#pragma unroll
        for (int h = 0; h < 2; ++h)
#pragma unroll
            for (int i = 0; i < 2; ++i) asm volatile("" : "+v"(o[h][i]));
    }
};

typedef int i32x8 __attribute__((ext_vector_type(8)));
typedef int i32x4v __attribute__((ext_vector_type(4)));
template <class Epi, class Sched, class ARows, bool ALIGN_EPI, bool FP8 = false>
__device__ __forceinline__ void gemm_phase(PG8_LAS unsigned char* lds, int tid, const void* A, const void* Bt, int pitch, const Sched& S, const Epi& E, const ARows& AR, int sclA = 0x7f7f7f7f, int sclB = 0x7f7f7f7f) {
    constexpr bool GATHER = ARows::GATHER;
    const int wid = __builtin_amdgcn_readfirstlane(tid >> 6), lane = tid & 63, wr = wid >> 2, wc = wid & 3, fr = lane & 15, fq = lane >> 4;
    const int nt = pitch / (BK * 2);
    int RA[2], CA[2]; unsigned voffA[2], voffB[2];
#pragma unroll
    for (int i = 0; i < 2; ++i) { int R, C; stage_rc(tid * 16 + i * 8192, R, C); const int Rb = Epi::PERM ? ((R & ~31) + perm32(R & 31)) : R;
        RA[i] = R; CA[i] = C; voffA[i] = (unsigned)(R * pitch + C * 2); voffB[i] = (unsigned)(Rb * pitch + C * 2); }
#pragma unroll
    for (int i = 0; i < 2; ++i) { asm volatile("" : "+v"(voffA[i])); asm volatile("" : "+v"(voffB[i])); }
    const size_t kstep = (size_t)(BK * 2);
    const size_t hstep = (size_t)HALF * pitch;
    const size_t tstep = 2 * hstep;
    const unsigned ldsw = (unsigned)wid * 1024u;
    const int aoff = lds_byte(wr * 64 + fr, fq * 8), boff = lds_byte(wc * 32 + fr, fq * 8);
    const char* Ab = (const char*)A;
#define PG8_SA(b, h) (((b) * 2 + (h)) * HTB)
#define PG8_SB(b, h) ((4 + (b) * 2 + (h)) * HTB)
#define PG8_STAGE(bufoff, gbase, voff) do { _Pragma("unroll") for (int _i = 0; _i < 2; ++_i) \
        __builtin_amdgcn_global_load_lds((const unsigned*)((const char*)(gbase) + (voff)[_i]), (PG8_LAS unsigned*)(lds + (bufoff) + ldsw + _i * 8192), 16, 0, 0); } while (0)
#define PG8_STAGEA(bufoff, h, plin, kb) do { if constexpr (GATHER) PG8_STAGE(bufoff, Ab + (kb), curA[h]); else PG8_STAGE(bufoff, (plin) + (h) * hstep, voffA); } while (0)
#define PG8_LDA(dst, b, h) do { _Pragma("unroll") for (int m = 0; m < 4; ++m) _Pragma("unroll") for (int k = 0; k < 2; ++k) dst[m][k] = *(const PG8_LAS bf16x8*)(lds + PG8_SA(b, h) + aoff + m * 2048 + k * 1024); } while (0)
#define PG8_LDB(dst, b, h) do { _Pragma("unroll") for (int n = 0; n < 2; ++n) _Pragma("unroll") for (int k = 0; k < 2; ++k) dst[n][k] = *(const PG8_LAS bf16x8*)(lds + PG8_SB(b, h) + boff + n * 2048 + k * 1024); } while (0)
#define PG8_CAT(x0, x1) __builtin_shufflevector(__builtin_bit_cast(i32x4v, x0), __builtin_bit_cast(i32x4v, x1), 0, 1, 2, 3, 4, 5, 6, 7)
#define PG8_MMA(ai, bj, At, Bt_) do { __builtin_amdgcn_s_setprio(1); \
        if constexpr (FP8) { _Pragma("unroll") for (int m = 0; m < 4; ++m) _Pragma("unroll") for (int n = 0; n < 2; ++n) \
            acc[ai][bj][m][n] = __builtin_amdgcn_mfma_scale_f32_16x16x128_f8f6f4(PG8_CAT(Bt_[n][0], Bt_[n][1]), PG8_CAT(At[m][0], At[m][1]), acc[ai][bj][m][n], 0, 0, 0, sclB, 0, sclA); } \
        else { _Pragma("unroll") for (int m = 0; m < 4; ++m) _Pragma("unroll") for (int n = 0; n < 2; ++n) _Pragma("unroll") for (int k = 0; k < 2; ++k) \
            acc[ai][bj][m][n] = __builtin_amdgcn_mfma_f32_16x16x32_bf16(Bt_[n][k], At[m][k], acc[ai][bj][m][n], 0, 0, 0); } \
        __builtin_amdgcn_s_setprio(0); } while (0)
#define PG8_WAIT_V(n) asm volatile("s_waitcnt vmcnt(" #n ")" ::: "memory")
#define PG8_WAIT_L(n) asm volatile("s_waitcnt lgkmcnt(" #n ")" ::: "memory")
#define PG8_BAR __builtin_amdgcn_s_barrier()
#define PG8_SCHED __builtin_amdgcn_sched_barrier(0)
    Unit cur, nxt; int ui = 0;
    if (!S.next(0, cur)) return;
    f32x4 acc[2][2][4][2];
#pragma unroll
    for (int a = 0; a < 2; ++a)
#pragma unroll
        for (int b = 0; b < 2; ++b)
#pragma unroll
            for (int m = 0; m < 4; ++m)
#pragma unroll
                for (int n = 0; n < 2; ++n) acc[a][b][m][n] = (f32x4){0.f, 0.f, 0.f, 0.f};
    bf16x8 At[4][2], B0[2][2], B1[2][2];
    unsigned curA[2][2] = {{0u, 0u}, {0u, 0u}}, nxtA[2][2] = {{0u, 0u}, {0u, 0u}};
    int rawN[2][2] = {{0, 0}, {0, 0}};
    if constexpr (GATHER) { int rawC[2][2]; AR.fetch(cur, RA, rawC); AR.make(rawC, CA, pitch, curA); Unit n1; if (S.next(1, n1)) AR.fetch(n1, RA, rawN); }
    const char* cA = GATHER ? Ab : Ab + (size_t)cur.pm * tstep;
    const char* cB = (const char*)Bt + (size_t)cur.pn * tstep;
    PG8_STAGE(PG8_SB(0, 0), cB, voffB); PG8_STAGE(PG8_SB(0, 1), cB + hstep, voffB); PG8_STAGEA(PG8_SA(0, 0), 0, cA, 0); PG8_STAGEA(PG8_SA(0, 1), 1, cA, 0);
    if (wr == 1) PG8_BAR;
    PG8_WAIT_V(2); PG8_BAR;
    PG8_STAGE(PG8_SB(1, 0), cB + kstep, voffB); PG8_STAGEA(PG8_SA(1, 0), 0, cA + kstep, kstep); PG8_STAGE(PG8_SB(1, 1), cB + hstep + kstep, voffB);
    PG8_WAIT_V(6); PG8_BAR;
    for (;;) {
        const bool has_next = S.next(ui + 1, nxt);
        if constexpr (GATHER) {
            if (has_next) { AR.make(rawN, CA, pitch, nxtA); Unit n2; if (S.next(ui + 2, n2)) AR.fetch(n2, RA, rawN); }
            else {
#pragma unroll
                for (int h = 0; h < 2; ++h)
#pragma unroll
                    for (int i = 0; i < 2; ++i) nxtA[h][i] = curA[h][i];
            }
        }
        const char* nA = GATHER ? Ab : (has_next ? Ab + (size_t)nxt.pm * tstep : cA);
        const char* nB = has_next ? (const char*)Bt + (size_t)nxt.pn * tstep : cB;
        for (int t = 0; t < nt; t += 2) {
            const bool last = (t == nt - 2);
            const size_t k1 = (size_t)(t + 1) * kstep, k2 = last ? 0 : (size_t)(t + 2) * kstep, k3 = k2 + kstep;
            const char* a1 = cA + k1;
            const char* a2 = last ? nA : cA + k2; const char* b2 = last ? nB : cB + k2;
            const char* a3 = a2 + kstep; const char* b3 = b2 + kstep;
            PG8_LDB(B0, 0, 0); PG8_LDB(B1, 0, 1); PG8_SCHED; PG8_LDA(At, 0, 0); PG8_STAGEA(PG8_SA(1, 1), 1, a1, k1);
            if constexpr (GATHER) { if (last) {
#pragma unroll
                for (int h = 0; h < 2; ++h)
#pragma unroll
                    for (int i = 0; i < 2; ++i) curA[h][i] = nxtA[h][i]; } }
            PG8_WAIT_V(8); PG8_WAIT_L(0); PG8_BAR; PG8_MMA(0, 0, At, B0); PG8_MMA(0, 1, At, B1); PG8_BAR; PG8_SCHED;
            PG8_LDA(At, 0, 1); PG8_STAGE(PG8_SB(0, 0), b2, voffB); PG8_STAGE(PG8_SB(0, 1), b2 + hstep, voffB); PG8_STAGEA(PG8_SA(0, 0), 0, a2, k2);
            PG8_WAIT_V(8); PG8_WAIT_L(0); PG8_BAR; PG8_MMA(1, 0, At, B0); PG8_MMA(1, 1, At, B1); PG8_BAR; PG8_SCHED;
            PG8_LDB(B0, 1, 0); PG8_LDB(B1, 1, 1); PG8_SCHED; PG8_LDA(At, 1, 0); PG8_STAGEA(PG8_SA(0, 1), 1, a2, k2);
            PG8_WAIT_V(8); PG8_WAIT_L(0); PG8_BAR; PG8_MMA(0, 0, At, B0); PG8_MMA(0, 1, At, B1); PG8_BAR; PG8_SCHED;
            PG8_LDA(At, 1, 1); PG8_STAGE(PG8_SB(1, 0), b3, voffB); PG8_STAGE(PG8_SB(1, 1), b3 + hstep, voffB); PG8_STAGEA(PG8_SA(1, 0), 0, a3, k3);
            PG8_WAIT_V(8); PG8_WAIT_L(0); PG8_BAR; PG8_MMA(1, 0, At, B0); PG8_MMA(1, 1, At, B1); PG8_BAR; PG8_SCHED;
        }
        if constexpr (ALIGN_EPI) { if (wr == 0) PG8_BAR; }
        E(acc, cur, wr, wc, fr, fq);
        if (!has_next) break;
#pragma unroll
        for (int a = 0; a < 2; ++a)
#pragma unroll
            for (int b = 0; b < 2; ++b)
#pragma unroll
                for (int m = 0; m < 4; ++m)
#pragma unroll
                    for (int n = 0; n < 2; ++n) acc[a][b][m][n] = (f32x4){0.f, 0.f, 0.f, 0.f};
        cur = nxt; cA = nA; cB = nB; ++ui;
        if constexpr (ALIGN_EPI) { if (wr == 1) PG8_BAR; }
    }
    PG8_WAIT_V(0);
    if constexpr (!ALIGN_EPI) { if (wr == 0) PG8_BAR; }
    PG8_BAR;
#undef PG8_SA
#undef PG8_SB
#undef PG8_STAGE
#undef PG8_STAGEA
#undef PG8_LDA
#undef PG8_LDB
#undef PG8_MMA
#undef PG8_CAT
#undef PG8_WAIT_V
#undef PG8_WAIT_L
#undef PG8_BAR
#undef PG8_SCHED
}

#define PG8_OPAQUE(x) asm volatile("" : "+v"(x))
struct EpiNull { static constexpr bool PERM = true; __device__ __forceinline__ void operator()(const f32x4 (&acc)[2][2][4][2], const Unit& u, int wr, int wc, int fr, int fq) const { if (u.pm < 0) {
#pragma unroll
        for (int a = 0; a < 2; ++a)
#pragma unroll
            for (int b = 0; b < 2; ++b)
#pragma unroll
                for (int m = 0; m < 4; ++m)
#pragma unroll
                    for (int n = 0; n < 2; ++n) asm volatile("" :: "v"(acc[a][b][m][n])); } } };
struct EpiStoreBf16 {
    static constexpr bool PERM = true;
    bf16_t* O; int ldc;
    __device__ __forceinline__ void operator()(const f32x4 (&acc)[2][2][4][2], const Unit& u, int wr, int wc, int fr, int fq) const {
        char* base = (char*)(O + (size_t)(u.pm * BM) * ldc + u.pn * BM);
        unsigned lb = (unsigned)((wr * 64 + fr) * ldc + wc * 32 + 8 * fq) * 2u; PG8_OPAQUE(lb);
        const unsigned rstep = (unsigned)ldc * 32u;
#pragma unroll
        for (int ai = 0; ai < 2; ++ai)
#pragma unroll
            for (int m = 0; m < 4; ++m) { const unsigned ro = lb + (unsigned)(ai * 8 + m) * rstep;
#pragma unroll
                for (int bj = 0; bj < 2; ++bj) { const f32x4 v0 = acc[ai][bj][m][0], v1 = acc[ai][bj][m][1];
                    u32x4 w; w.x = pk2(v0[0], v0[1]); w.y = pk2(v0[2], v0[3]); w.z = pk2(v1[0], v1[1]); w.w = pk2(v1[2], v1[3]);
                    *(u32x4*)(base + ro + bj * (HALF * 2)) = w; } }
    }
};
struct EpiResGate {
    static constexpr bool PERM = false;
    const float* src_ctx; const float* src_lat; float* dst_ctx; float* dst_lat; const float* gate_lat; const float* gate_ctx; int row_base;
    __device__ __forceinline__ void operator()(const f32x4 (&acc)[2][2][4][2], const Unit& u, int wr, int wc, int fr, int fq) const {
        const int rowu = row_base + u.pm * BM; const bool isctx = rowu < NCTX;
        const char* src = (const char*)(isctx ? src_ctx + (size_t)rowu * DM : src_lat + (size_t)(rowu - NCTX) * DM) + u.pn * (BM * 4);
        char* dst = (char*)(isctx ? dst_ctx + (size_t)rowu * DM : dst_lat + (size_t)(rowu - NCTX) * DM) + u.pn * (BM * 4);
        const float* gate = (isctx ? gate_ctx : gate_lat + (size_t)((rowu - NCTX) / SEQ) * 6144) + u.pn * BM;
        const int cl = wc * 32 + 4 * fq;
        f32x4 sc[2][2][4][2];
#pragma unroll
        for (int bj = 0; bj < 2; ++bj)
#pragma unroll
            for (int n = 0; n < 2; ++n) { const f32x4 gv = *(const f32x4*)(gate + cl + bj * HALF + n * 16);
#pragma unroll
                for (int ai = 0; ai < 2; ++ai)
#pragma unroll
                    for (int m = 0; m < 4; ++m) sc[ai][bj][m][n] = acc[ai][bj][m][n] * gv; }
        unsigned lb = (unsigned)((wr * 64 + fr) * DM + cl) * 4u; PG8_OPAQUE(lb);
#pragma unroll
        for (int ai = 0; ai < 2; ++ai)
#pragma unroll
            for (int m = 0; m < 4; ++m) { const unsigned ro = lb + (unsigned)(ai * 8 + m) * (16u * DM * 4u);
#pragma unroll
                for (int bj = 0; bj < 2; ++bj)
#pragma unroll
                    for (int n = 0; n < 2; ++n) { const unsigned o = ro + (unsigned)(bj * HALF + n * 16) * 4u; const f32x4 s = *(const f32x4*)(src + o);
                        *(f32x4*)(dst + o) = s + sc[ai][bj][m][n]; }
                asm volatile("" ::: "memory"); }
    }
};
template <bool MOE> struct EpiSwiglu {
    static constexpr bool PERM = true;
    static constexpr bool OUT8 = MOE ? (MOE_FP8 != 0) : (DENSE_FP8 != 0);
    bf16_t* O; int ldc; int ncol; const float* prow;
    __device__ __forceinline__ void operator()(const f32x4 (&acc)[2][2][4][2], const Unit& u, int wr, int wc, int fr, int fq) const {
        const int pnl = MOE ? (u.pn % ncol) : u.pn;
        constexpr int ES = OUT8 ? 1 : 2;
        char* base = (char*)O + ((size_t)(u.pm * BM) * ldc + pnl * HALF) * ES;
        unsigned lb = (unsigned)((wr * 64 + fr) * ldc + wc * 32 + 8 * fq) * ES; PG8_OPAQUE(lb);
        const unsigned rstep = (unsigned)ldc * 16u * ES;
#pragma unroll
        for (int ai = 0; ai < 2; ++ai)
#pragma unroll
            for (int m = 0; m < 4; ++m) {
                const float pw = OUT8 ? QS_H : 1.0f;
                float hv[8];
#pragma unroll
                for (int n = 0; n < 2; ++n)
#pragma unroll
                    for (int jp = 0; jp < 2; ++jp) { const f32x2_t g = {acc[ai][0][m][n][2 * jp], acc[ai][0][m][n][2 * jp + 1]}, up = {acc[ai][1][m][n][2 * jp], acc[ai][1][m][n][2 * jp + 1]};
                        const f32x2_t a = g * (-LOG2E); f32x2_t d; d.x = fast_exp2(a.x); d.y = fast_exp2(a.y); d = d + 1.0f;
                        f32x2_t r; r.x = fast_rcp(d.x); r.y = fast_rcp(d.y);
                        const f32x2_t hh = (g * up) * (r * pw); hv[n * 4 + 2 * jp] = hh.x; hv[n * 4 + 2 * jp + 1] = hh.y; }
                if constexpr (OUT8) { u32x2 w; w.x = pk4_fp8(hv[0], hv[1], hv[2], hv[3]); w.y = pk4_fp8(hv[4], hv[5], hv[6], hv[7]);
                    *(u32x2*)(base + lb + (unsigned)(ai * 8 + m) * rstep) = w; }
                else { u32x4 w; w.x = pk2(hv[0], hv[1]); w.y = pk2(hv[2], hv[3]); w.z = pk2(hv[4], hv[5]); w.w = pk2(hv[6], hv[7]);
                    *(u32x4*)(base + lb + (unsigned)(ai * 8 + m) * rstep) = w; } }
    }
};
struct EpiMoeScatter {
    static constexpr bool PERM = false;
    const int* rowmap; const float* prow; float* hlat; const float* gate_lat; int ncol;
    __device__ __forceinline__ void operator()(const f32x4 (&acc)[2][2][4][2], const Unit& u, int wr, int wc, int fr, int fq) const {
        const int pnl = u.pn % ncol;
        const int* rm = rowmap + u.pm * BM; const float* pr = prow + u.pm * BM;
        char* hb = (char*)hlat + pnl * (BM * 4); const char* gb = (const char*)gate_lat + pnl * (BM * 4);
        unsigned pl = (unsigned)(wr * 64 + fr) * 4u; PG8_OPAQUE(pl);
        unsigned cb = (unsigned)(wc * 32 + 4 * fq) * 4u; PG8_OPAQUE(cb);
#pragma unroll
        for (int ai = 0; ai < 2; ++ai)
#pragma unroll
            for (int m = 0; m < 4; ++m) { const int tok = *(const int*)((const char*)rm + pl + (unsigned)(ai * 8 + m) * 64u);
                if (tok >= 0) { const float pw = *(const float*)((const char*)pr + pl + (unsigned)(ai * 8 + m) * 64u); const unsigned ro = (unsigned)tok * (DM * 4u) + cb, go = ((unsigned)tok >> 11) * (6144u * 4u) + cb;
#pragma unroll
                    for (int bj = 0; bj < 2; ++bj)
#pragma unroll
                        for (int n = 0; n < 2; ++n) { const unsigned o = (unsigned)(bj * HALF + n * 16) * 4u; const f32x4 sv = *(const f32x4*)(hb + ro + o); const f32x4 gv = *(const f32x4*)(gb + go + o);
                            const f32x4 t = acc[ai][bj][m][n] * pw; *(f32x4*)(hb + ro + o) = sv + gv * t; } }
                asm volatile("" ::: "memory"); }
    }
};
struct MoeOrder {
    int NT0, NT1, ncol, G, c; const PG8_LAS int* texp;
    __device__ bool next(int i, Unit& u) const {
        const long L = (long)i * G + c; if (L >= (long)(NT0 + NT1) * ncol) return false;
        const int tq = (int)(L / ncol), pnl = (int)(L % ncol);
        const int T = tq < NT0 ? tq : MOE_TILES + tq - NT0;
        const int e = __builtin_amdgcn_readfirstlane(texp[T]);
        u.pm = T; u.pn = e * ncol + pnl; return true;
    }
};
}

#define XB_TMO      128
#define XB_XCNT(j)  (256  + 64 * (j))
#define XB_XSUB(j)  (1280 + 64 * (j))
#define XB_XGEN(j)  (2304 + 64 * (j))
#define XB_TOP      3328
#define XB_TOPGEN   3392
#define XCD_BAR_WORDS 3456
#define XB_SPIN_CAP (1u << 18)
DI unsigned xb_ld(unsigned* p)              { return __hip_atomic_load(p, __ATOMIC_RELAXED, __HIP_MEMORY_SCOPE_AGENT); }
DI unsigned xb_add(unsigned* p, unsigned v) { return __hip_atomic_fetch_add(p, v, __ATOMIC_RELAXED, __HIP_MEMORY_SCOPE_AGENT); }
DI unsigned xb_xcc_id() { return (unsigned)__builtin_amdgcn_s_getreg((3 << 11) | 20) & 0xFu; }
#define XB_SPIN(cond, bar) do { unsigned _sp = 0; while (cond) { __builtin_amdgcn_s_sleep(1); \
    if ((++_sp & 255u) == 0u) { if (xb_ld(&(bar)[XB_TMO])) break; if (_sp > XB_SPIN_CAP) { atomicAdd(&(bar)[XB_TMO], 1u); break; } } } } while (0)
struct XcdBarrier { unsigned* bar; unsigned x; volatile LAS unsigned* st; };
DI XcdBarrier xcd_barrier_post(unsigned* bar, volatile LAS unsigned* st) {
    XcdBarrier b; b.bar = bar; b.x = xb_xcc_id(); b.st = st;
    if (threadIdx.x == 0) (void)xb_add(&bar[XB_XCNT(b.x)], 1u);
    return b;
}
DI void xcd_barrier_complete(unsigned* bar, unsigned x, unsigned& nloc, unsigned& nx) {
    const unsigned G = gridDim.x * gridDim.y * gridDim.z;
    unsigned sum, cnt, mine, sp = 0u;
    for (;;) {
        sum = 0u; cnt = 0u; mine = 0u;
#pragma unroll
        for (unsigned j = 0; j < 16; ++j) { const unsigned c = xb_ld(&bar[XB_XCNT(j)]); sum += c; cnt += (c > 0u) ? 1u : 0u; mine = (j == x) ? c : mine; }
        if (sum == G) break;
        __builtin_amdgcn_s_sleep(1);
        if ((++sp & 255u) == 0u) { if (xb_ld(&bar[XB_TMO])) break; if (sp > XB_SPIN_CAP) { atomicAdd(&bar[XB_TMO], 1u); break; } }
    }
    nloc = mine > 0u ? mine : 1u; nx = cnt > 0u ? cnt : 1u;
}
DI void xcd_barrier(const XcdBarrier& b, int wave) {
    asm volatile("s_waitcnt vmcnt(0)" ::: "memory");
    __syncthreads();
    if (wave == 0 && __builtin_amdgcn_mbcnt_hi(~0u, __builtin_amdgcn_mbcnt_lo(~0u, 0u)) == 0u) {
        unsigned* bar = b.bar;
        __builtin_amdgcn_s_waitcnt(0);
        unsigned nloc = b.st[0], nx = b.st[1];
        if (nloc == 0u) { xcd_barrier_complete(bar, b.x, nloc, nx); b.st[0] = nloc; b.st[1] = nx; }
        const unsigned old = xb_add(&bar[XB_XSUB(b.x)], 1u);
        const unsigned gen = old / nloc;
        if (old + 1u == (gen + 1u) * nloc) {
            __builtin_amdgcn_fence(__ATOMIC_RELEASE, "agent");
            asm volatile("s_waitcnt vmcnt(0)" ::: "memory");
            const unsigned og = xb_add(&bar[XB_TOP], 1u);
            const unsigned tg = og / nx;
            if (og + 1u == (tg + 1u) * nx) xb_add(&bar[XB_TOPGEN], 1u);
            else XB_SPIN(xb_ld(&bar[XB_TOPGEN]) == tg, bar);
            __builtin_amdgcn_fence(__ATOMIC_ACQUIRE, "agent");
            xb_add(&bar[XB_XGEN(b.x)], 1u);
            asm volatile("s_waitcnt vmcnt(0)" ::: "memory");
        } else {
            XB_SPIN(xb_ld(&bar[XB_XGEN(b.x)]) == gen, bar);
            __builtin_amdgcn_fence(__ATOMIC_ACQUIRE, "agent");
            asm volatile("s_waitcnt vmcnt(0)" ::: "memory");
        }
    }
    __syncthreads();
}

struct Params { const float* in[26]; float* out; unsigned char* ws; int ph_lo, ph_hi, pad0, pad1; };
enum { I_X = 0, I_C, I_CTX, I_CCTX, I_WMOD, I_BMOD, I_N1W, I_N2W, I_WIN, I_WOUT, I_RPB, I_CONVW, I_CONVB, I_CLNW, I_CLNB, I_RDEC, I_RGNW,
       I_FG, I_FU, I_FD, I_MR, I_MRB, I_MG, I_MU, I_MDN, I_FNW };
constexpr int PH_P0 = 0, PH_FINAL = 19, N_PHASES = 20;

typedef __attribute__((address_space(4))) const unsigned char* karg_t;
struct KIn {
    karg_t ka;
    DI const float* operator[](int k) const { return *(const float* __attribute__((address_space(4))) const*)(ka + 8 * k); }
};
struct Frame {
    LAS unsigned char* lds;
    int tid, lane, wave, G, bid, vb;
    KIn in; float* out; unsigned char* ws;
};
DI Frame phase_frame(const Frame& F0) {
    Frame F; karg_t ka = F0.in.ka; asm volatile("" : "+s"(ka)); F.in.ka = ka;
    F.out = *(float* __attribute__((address_space(4))) const*)(ka + 208);
    F.ws = *(unsigned char* __attribute__((address_space(4))) const*)(ka + 216);
    int wv = F0.wave; asm volatile("" : "+s"(wv));
    int tid = (wv << 6) + (int)__builtin_amdgcn_mbcnt_hi(~0u, __builtin_amdgcn_mbcnt_lo(~0u, 0u)), G = F0.G, bid = F0.bid; unsigned ldsb = (unsigned)(size_t)F0.lds;
    asm volatile("" : "+v"(tid)); asm volatile("" : "+s"(G)); asm volatile("" : "+s"(bid)); asm volatile("" : "+s"(ldsb));
    F.tid = tid; F.lane = tid & 63; F.wave = __builtin_amdgcn_readfirstlane(tid >> 6); F.G = G; F.bid = bid; F.lds = (LAS unsigned char*)(size_t)ldsb;
    F.vb = (G % 8 == 0) ? (bid % 8) * (G / 8) + bid / 8 : bid;
    return F;
}

DI void p0_transpose_item(const float* W, int K, int N, bf16* WT, int k0, int n0, int dst_row0, LAS float* scr, int lane) {
#pragma unroll 8
    for (int i = 0; i < 32; ++i) { const int kk = 2 * i + (lane >> 5); scr[kk * 33 + (lane & 31)] = W[(size_t)(k0 + kk) * N + n0 + (lane & 31)]; }
    asm volatile("s_waitcnt lgkmcnt(0)" ::: "memory");
    const int c = lane & 7;
#pragma unroll
    for (int j = 0; j < 4; ++j) { const int n = (lane >> 3) + 8 * j; const LAS float* s = scr + (8 * c) * 33 + n;
        u32x4 o; o.x = pk2(s[0 * 33], s[1 * 33]); o.y = pk2(s[2 * 33], s[3 * 33]); o.z = pk2(s[4 * 33], s[5 * 33]); o.w = pk2(s[6 * 33], s[7 * 33]);
        *(u32x4*)(WT + (size_t)(dst_row0 + n) * K + k0 + 8 * c) = o; }
    asm volatile("s_waitcnt lgkmcnt(0)" ::: "memory");
}
DI void p0_convert_plain(Frame& F, const float* W, int K, int N, bf16* WT, int item, LAS float* scr) {
    const int nblk = N / 32, kb = item / nblk, nb = item % nblk;
    p0_transpose_item(W, K, N, WT, 64 * kb, 32 * nb, 32 * nb, scr, F.lane);
}
DI void p0_convert_gu(Frame& F, const float* W, int K, int N, bf16* WT, int item, int up, LAS float* scr) {
    const int nblk = N / 32, kb = item / nblk, nb = item % nblk, n0 = 32 * nb;
    p0_transpose_item(W, K, N, WT, 64 * kb, n0, 256 * (n0 / 128) + (n0 % 128) + (up ? 128 : 0), scr, F.lane);
}
DI void conv_item64(const float* W, int K, int N, bf16* WT, int k0, int n0, int dst_row0, LAS unsigned* scr, int lane) {
    const float* wp = W + (size_t)k0 * N + n0 + lane;
    float v[64];
#pragma unroll
    for (int i = 0; i < 64; ++i) v[i] = wp[(size_t)i * N];
#pragma unroll
    for (int i = 0; i < 32; ++i) scr[i * 65 + lane] = pk2(v[2 * i], v[2 * i + 1]);
    asm volatile("s_waitcnt lgkmcnt(0)" ::: "memory");
    const int c = lane & 7;
#pragma unroll
    for (int j = 0; j < 8; ++j) { const int n = (lane >> 3) + 8 * j; const LAS unsigned* sp = scr + (4 * c) * 65 + n;
        u32x4 o; o.x = sp[0]; o.y = sp[65]; o.z = sp[130]; o.w = sp[195];
        *(u32x4*)(WT + (size_t)(dst_row0 + n) * K + k0 + 8 * c) = o; }
    asm volatile("s_waitcnt lgkmcnt(0)" ::: "memory");
}
DI void conv_item64_fp8(const float* W, int K, int N, unsigned char* WT, int k0, int n0, int dst_row0, float qs, LAS unsigned* scr, int lane) {
    const float* wp = W + (size_t)k0 * N + n0 + lane;
    float v[64];
#pragma unroll
    for (int i = 0; i < 64; ++i) v[i] = wp[(size_t)i * N];
#pragma unroll
    for (int i = 0; i < 16; ++i) scr[i * 65 + lane] = pk4_fp8(v[4 * i] * qs, v[4 * i + 1] * qs, v[4 * i + 2] * qs, v[4 * i + 3] * qs);
    asm volatile("s_waitcnt lgkmcnt(0)" ::: "memory");
    const int c = lane & 3;
#pragma unroll
    for (int j = 0; j < 4; ++j) { const int n = (lane >> 2) + 16 * j; const LAS unsigned* sp = scr + (4 * c) * 65 + n;
        u32x4 o; o.x = sp[0]; o.y = sp[65]; o.z = sp[130]; o.w = sp[195];
        *(u32x4*)(WT + (size_t)(dst_row0 + n) * K + k0 + 16 * c) = o; }
    asm volatile("s_waitcnt lgkmcnt(0)" ::: "memory");
}
constexpr int BG_ITEMS = 21504;
constexpr int BG_B0 = 0, BG_D0 = 1200, BG_E0 = 5200, BG_F0 = 8700, BG_B1 = 19700, BG_CL = 20900;
DI void bg_item(Frame& F, int g, LAS unsigned* scr) {
    if (g < 14336) { const int m = g / 896, e = m >> 1, up = m & 1, r = g % 896, kb = r / 56, nb = r % 56, n0 = 64 * nb; const int drow = 256 * (n0 / 128) + (n0 % 128) + (up ? 128 : 0);
#if MOE_FP8
        conv_item64_fp8(F.in[up ? I_MU : I_MG] + (size_t)e * 1024 * 3584, 1024, 3584, F.ws + WS_MGU + (size_t)e * 7168 * 1024, 64 * kb, n0, drow, QS_WGU, scr, F.lane);
#else
        conv_item64(F.in[up ? I_MU : I_MG] + (size_t)e * 1024 * 3584, 1024, 3584, (bf16*)(F.ws + WS_MGU) + (size_t)e * 7168 * 1024, 64 * kb, n0, drow, scr, F.lane);
#endif
    } else { const int gg = g - 14336, e = gg / 896, r = gg % 896, kb = r / 16, nb = r % 16;
#if MOE_FP8
        conv_item64_fp8(F.in[I_MDN] + (size_t)e * 3584 * 1024, 3584, 1024, F.ws + WS_MD + (size_t)e * 1024 * 3584, 64 * kb, 64 * nb, 64 * nb, QS_WD, scr, F.lane);
#else
        conv_item64(F.in[I_MDN] + (size_t)e * 3584 * 1024, 3584, 1024, (bf16*)(F.ws + WS_MD) + (size_t)e * 1024 * 3584, 64 * kb, 64 * nb, 64 * nb, scr, F.lane);
#endif
    }
}
DI void bg_convert_tail(Frame& F, int nwg, int lo, int hi) {
    const int nmax = (nwg + F.G - 1) / F.G, rem = nwg - (nmax - 1) * F.G;
    if (F.bid < rem || rem >= F.G) return;
    LAS unsigned* scr = (LAS unsigned*)(F.lds + F.wave * 8320);
    const int w = (F.bid - rem) * 8 + F.wave, nw = (F.G - rem) * 8;
    for (int g = lo + w; g < hi; g += nw) bg_item(F, g, scr);
}
DI void bg_convert_all(Frame& F, int lo, int hi) {
    LAS unsigned* scr = (LAS unsigned*)(F.lds + F.wave * 8320);
    for (int g = lo + F.bid * 8 + F.wave; g < hi; g += F.G * 8) bg_item(F, g, scr);
}
DI void p0_prologue(Frame& F) {
    {
        LAS float* Sx = (LAS float*)F.lds;
        LAS float* red = (LAS float*)(F.lds + 81920);
        bool staged = false;
        for (int unit = F.bid; unit < 192; unit += F.G) {
            if (!staged) {
                for (int idx = F.tid; idx < 17 * 1024; idx += 512) { const int r = idx / 1024, k = idx % 1024;
                    const float v = r < 16 ? F.in[I_C][r * 1024 + k] : F.in[I_CCTX][k]; Sx[k * 20 + r] = v * sigmoidf_(v); }
                staged = true; __syncthreads();
            }
            const int l = unit / 96, n0 = (unit % 96) * 64;
            const float* Wm = F.in[I_WMOD] + (size_t)l * 1024 * 6144 + n0 + F.lane;
            float acc[17];
#pragma unroll
            for (int r = 0; r < 17; ++r) acc[r] = 0.f;
            const int kb = F.wave * 128;
#pragma unroll 4
            for (int k = 0; k < 128; ++k) { const float wv = Wm[(size_t)(kb + k) * 6144]; const LAS float* sp = Sx + (kb + k) * 20;
                const f32x4 s0 = *(const LAS f32x4*)(sp), s1 = *(const LAS f32x4*)(sp + 4), s2 = *(const LAS f32x4*)(sp + 8), s3 = *(const LAS f32x4*)(sp + 12); const float s4 = sp[16];
                acc[0] += s0[0] * wv; acc[1] += s0[1] * wv; acc[2] += s0[2] * wv; acc[3] += s0[3] * wv; acc[4] += s1[0] * wv; acc[5] += s1[1] * wv; acc[6] += s1[2] * wv; acc[7] += s1[3] * wv;
                acc[8] += s2[0] * wv; acc[9] += s2[1] * wv; acc[10] += s2[2] * wv; acc[11] += s2[3] * wv; acc[12] += s3[0] * wv; acc[13] += s3[1] * wv; acc[14] += s3[2] * wv; acc[15] += s3[3] * wv;
                acc[16] += s4 * wv; }
#pragma unroll
            for (int r = 0; r < 17; ++r) red[(F.wave * 17 + r) * 64 + F.lane] = acc[r];
            __syncthreads();
            for (int idx = F.tid; idx < 17 * 64; idx += 512) { const int r = idx / 64, ln = idx % 64; float s = F.in[I_BMOD][l * 6144 + n0 + ln];
#pragma unroll
                for (int w = 0; w < 8; ++w) s += red[(w * 17 + r) * 64 + ln];
                if (r < 16) ((float*)(F.ws + WS_MODLAT))[((size_t)l * 16 + r) * 6144 + n0 + ln] = s; else ((float*)(F.ws + WS_MODCTX))[(size_t)l * 6144 + n0 + ln] = s; }
            __syncthreads();
        }
        __syncthreads();
    }
    if (F.bid == 0) { const int pos = F.tid >> 3, j = F.tid & 7; const float inv = exp2f(-(float)j * 0.125f * 13.287712379549449f); const float ang = (float)pos * inv;
        float* tab = (float*)(F.ws + WS_ROPE); tab[(pos * 8 + j) * 2] = cosf(ang); tab[(pos * 8 + j) * 2 + 1] = sinf(ang); }
    {
        LAS float* scr = (LAS float*)(F.lds + F.wave * 16384);
        const int gw = F.bid * 8 + F.wave, NGW = F.G * 8;
        constexpr int I_IN = 16 * 96, I_OUT = 16 * 32, I_G = 16 * 88, I_D = 44 * 32, I_MGI = 16 * 112, I_MDI = 56 * 32;
        constexpr int NITEMS = 2 * I_IN + 2 * I_OUT + (DENSE_FP8 == 1 ? 3 * 704 : (DENSE_FP8 == 2 ? 2 * I_G + 704 : 2 * I_G + I_D));
        for (int it = gw; it < NITEMS; it += NGW) {
            int r = it;
            if (r < 2 * I_IN) { const int l = r / I_IN; p0_convert_plain(F, F.in[I_WIN] + (size_t)l * 1024 * 3072, 1024, 3072, (bf16*)(F.ws + WS_WIN) + (size_t)l * 3072 * 1024, r % I_IN, scr); continue; } r -= 2 * I_IN;
            if (r < 2 * I_OUT) { const int l = r / I_OUT; p0_convert_plain(F, F.in[I_WOUT] + (size_t)l * 1024 * 1024, 1024, 1024, (bf16*)(F.ws + WS_WOUT) + (size_t)l * 1024 * 1024, r % I_OUT, scr); continue; } r -= 2 * I_OUT;
#if DENSE_FP8 == 2
            if (r < I_G) { p0_convert_gu(F, F.in[I_FG], 1024, 2816, (bf16*)(F.ws + WS_WGU), r, 0, scr); continue; } r -= I_G;
            if (r < I_G) { p0_convert_gu(F, F.in[I_FU], 1024, 2816, (bf16*)(F.ws + WS_WGU), r, 1, scr); continue; } r -= I_G;
            { const int kb = r / 16, nb = r % 16; conv_item64_fp8(F.in[I_FD], 2816, 1024, F.ws + WS_WD, 64 * kb, 64 * nb, 64 * nb, QS_WD, (LAS unsigned*)scr, F.lane); }
#elif DENSE_FP8 == 1
            { LAS unsigned* scr8 = (LAS unsigned*)scr;
              if (r < 1408) { const int up = r / 704, q = r % 704, kb = q / 44, nb = q % 44, n0 = 64 * nb;
                  conv_item64_fp8(F.in[up ? I_FU : I_FG], 1024, 2816, F.ws + WS_WGU, 64 * kb, n0, 256 * (n0 / 128) + (n0 % 128) + (up ? 128 : 0), QS_WGU, scr8, F.lane); }
              else { const int q = r - 1408, kb = q / 16, nb = q % 16; conv_item64_fp8(F.in[I_FD], 2816, 1024, F.ws + WS_WD, 64 * kb, 64 * nb, 64 * nb, QS_WD, scr8, F.lane); } }
#else
            if (r < I_G) { p0_convert_gu(F, F.in[I_FG], 1024, 2816, (bf16*)(F.ws + WS_WGU), r, 0, scr); continue; } r -= I_G;
            if (r < I_G) { p0_convert_gu(F, F.in[I_FU], 1024, 2816, (bf16*)(F.ws + WS_WGU), r, 1, scr); continue; } r -= I_G;
            p0_convert_plain(F, F.in[I_FD], 2816, 1024, (bf16*)(F.ws + WS_WD), r, scr);
#endif
        }
    }
}

struct NormVecs { f32x4 gs[4], sh[4]; };
DI void norm_load_vecs(Frame& F, const float* g, const float* mod, int isc, int ish, NormVecs& V) {
#pragma unroll
    for (int j = 0; j < 4; ++j) { const f32x4 gv = ((const f32x4*)g)[F.lane + 64 * j], sv = ((const f32x4*)(mod + isc * DM))[F.lane + 64 * j]; V.gs[j] = gv * (sv + 1.0f); V.sh[j] = ((const f32x4*)(mod + ish * DM))[F.lane + 64 * j]; }
}
DI void norm_load_row(Frame& F, const float* srow, f32x4 (&v)[4]) {
    const f32x4* xr = (const f32x4*)srow + F.lane;
#pragma unroll
    for (int j = 0; j < 4; ++j) v[j] = xr[64 * j];
}
DI float norm_ssq(const f32x4 (&v)[4]) { float s = 0.f;
#pragma unroll
    for (int j = 0; j < 4; ++j) s += (v[j].x * v[j].x + v[j].y * v[j].y) + (v[j].z * v[j].z + v[j].w * v[j].w);
    return s; }
DI void norm_finish(Frame& F, const f32x4 (&v)[4], float ssq_total, const NormVecs& V, bf16* orow, f32x4 (&y)[4]) {
    const float rstd = 1.0f / sqrtf(ssq_total * (1.0f / DM) + EPS);
    u32x2* o8 = (u32x2*)orow + F.lane;
#pragma unroll
    for (int j = 0; j < 4; ++j) { y[j] = (v[j] * rstd) * V.gs[j] + V.sh[j]; u32x2 w; w.x = pk2(y[j].x, y[j].y); w.y = pk2(y[j].z, y[j].w); o8[64 * j] = w; }
}
DI void norm_finish8(Frame& F, const f32x4 (&v)[4], float ssq_total, const NormVecs& V, unsigned char* orow, f32x4 (&y)[4]) {
    const float rstd = 1.0f / sqrtf(ssq_total * (1.0f / DM) + EPS);
    unsigned* o4 = (unsigned*)orow + F.lane;
#pragma unroll
    for (int j = 0; j < 4; ++j) { y[j] = (v[j] * rstd) * V.gs[j] + V.sh[j]; o4[64 * j] = pk4_fp8(y[j].x * QS_U, y[j].y * QS_U, y[j].z * QS_U, y[j].w * QS_U); }
}
DI void norm_phase(Frame& F, int l, int which, bool first, int row_lo, bool out8 = false) {
    const float* g = F.in[which == 1 ? I_N1W : I_N2W] + l * DM;
    const float* modlat = (const float*)(F.ws + WS_MODLAT) + (size_t)l * 16 * 6144;
    const float* modctx = (const float*)(F.ws + WS_MODCTX) + (size_t)l * 6144;
    const int ish = which == 1 ? 0 : 3, isc = which == 1 ? 1 : 4;
    const float* sctx = first ? F.in[I_CTX] : (const float*)(F.ws + WS_HCTX);
    const float* slat = first ? F.in[I_X] : F.out;
    bf16* U = (bf16*)(F.ws + WS_U);
    const int gw = F.bid * 8 + F.wave, NGW = F.G * 8;
    const int rpw = (NTOK - row_lo + NGW - 1) / NGW;
    const int r0 = row_lo + gw * rpw; int r1 = r0 + rpw; if (r1 > NTOK) r1 = NTOK;
    NormVecs V; int curb = -2;
    for (int row = r0; row < r1; row += 2) {
        const bool two = row + 1 < r1;
        const int rowb = two ? row + 1 : row;
        f32x4 va[4], vb[4];
        norm_load_row(F, row < NCTX ? sctx + (size_t)row * DM : slat + (size_t)(row - NCTX) * DM, va);
        norm_load_row(F, rowb < NCTX ? sctx + (size_t)rowb * DM : slat + (size_t)(rowb - NCTX) * DM, vb);
        float sa = norm_ssq(va), sb = norm_ssq(vb);
#pragma unroll
        for (int o = 1; o < 64; o <<= 1) { sa += __shfl_xor(sa, o); sb += __shfl_xor(sb, o); }
        f32x4 y[4];
        { const int bk = row < NCTX ? -1 : (row - NCTX) / SEQ; if (bk != curb) { norm_load_vecs(F, g, bk < 0 ? modctx : modlat + (size_t)bk * 6144, isc, ish, V); curb = bk; } }
        if (out8) norm_finish8(F, va, sa, V, (unsigned char*)U + (size_t)row * DM, y); else norm_finish(F, va, sa, V, U + (size_t)row * DM, y);
        if (two) { const int bk = rowb < NCTX ? -1 : (rowb - NCTX) / SEQ; if (bk != curb) { norm_load_vecs(F, g, bk < 0 ? modctx : modlat + (size_t)bk * 6144, isc, ish, V); curb = bk; }
            if (out8) norm_finish8(F, vb, sb, V, (unsigned char*)U + (size_t)rowb * DM, y); else norm_finish(F, vb, sb, V, U + (size_t)rowb * DM, y); }
    }
}
DI void moe_route_row(Frame& F, const f32x4 (&y)[4], LAS const float* Rw, const float (&rb)[8], LAS int* sel, int tl, int tok) {
    float lg[8];
#pragma unroll
    for (int e = 0; e < 8; ++e) lg[e] = 0.f;
#pragma unroll
    for (int j = 0; j < 4; ++j)
#pragma unroll
        for (int q = 0; q < 4; ++q) { const int k = 256 * j + 4 * F.lane + q; const f32x4 r0 = *(const LAS f32x4*)(Rw + k * 8), r1 = *(const LAS f32x4*)(Rw + k * 8 + 4); const float yv = y[j][q];
            lg[0] += yv * r0[0]; lg[1] += yv * r0[1]; lg[2] += yv * r0[2]; lg[3] += yv * r0[3]; lg[4] += yv * r1[0]; lg[5] += yv * r1[1]; lg[6] += yv * r1[2]; lg[7] += yv * r1[3]; }
#pragma unroll
    for (int o = 1; o < 64; o <<= 1) {
#pragma unroll
        for (int e = 0; e < 8; ++e) lg[e] += __shfl_xor(lg[e], o); }
#pragma unroll
    for (int e = 0; e < 8; ++e) lg[e] += rb[e];
    int e1 = 0; float v1 = lg[0];
#pragma unroll
    for (int e = 1; e < 8; ++e) if (lg[e] > v1) { v1 = lg[e]; e1 = e; }
    int e2 = -1; float v2 = -3.0e38f;
#pragma unroll
    for (int e = 0; e < 8; ++e) if (e != e1 && lg[e] > v2) { v2 = lg[e]; e2 = e; }
    const float ex = __expf(v2 - v1), p1 = 1.0f / (1.0f + ex), p2 = ex / (1.0f + ex);
    if (F.lane == 0) { sel[tl * 2] = e1; sel[tl * 2 + 1] = e2; float* pt = (float*)(F.ws + WS_PTOK) + (size_t)tok * 2; pt[0] = p1; pt[1] = p2; }
}
DI void norm_moe_phase(Frame& F) {
    const int l = 1;
    const float* g = F.in[I_N2W] + l * DM;
    const float* modlat = (const float*)(F.ws + WS_MODLAT) + (size_t)l * 16 * 6144;
    bf16* U = (bf16*)(F.ws + WS_U);
    LAS float* Rw = (LAS float*)F.lds;
    LAS int* sel = (LAS int*)(F.lds + 32768);
    for (int idx = F.tid; idx < 8192; idx += 512) Rw[idx] = F.in[I_MR][idx];
    __syncthreads();
    float rb[8];
#pragma unroll
    for (int e = 0; e < 8; ++e) rb[e] = F.in[I_MRB][e];
    NormVecs V; int curb = -2;
    for (int seg = F.bid; seg < 256; seg += F.G) {
        const int bk = (seg * 128) / SEQ; if (bk != curb) { norm_load_vecs(F, g, modlat + (size_t)bk * 6144, 4, 3, V); curb = bk; }
        for (int i = 0; i < 16; i += 2) {
            const int tl = F.wave * 16 + i, tok = seg * 128 + tl;
            f32x4 va[4], vb[4];
            norm_load_row(F, F.out + (size_t)tok * DM, va); norm_load_row(F, F.out + (size_t)(tok + 1) * DM, vb);
            float sa = norm_ssq(va), sb = norm_ssq(vb);
#pragma unroll
            for (int o = 1; o < 64; o <<= 1) { sa += __shfl_xor(sa, o); sb += __shfl_xor(sb, o); }
            f32x4 y[4];
#if MOE_FP8
            norm_finish8(F, va, sa, V, (unsigned char*)U + (size_t)tok * DM, y); moe_route_row(F, y, Rw, rb, sel, tl, tok);
            norm_finish8(F, vb, sb, V, (unsigned char*)U + (size_t)(tok + 1) * DM, y); moe_route_row(F, y, Rw, rb, sel, tl + 1, tok + 1);
#else
            norm_finish(F, va, sa, V, U + (size_t)(NCTX + tok) * DM, y); moe_route_row(F, y, Rw, rb, sel, tl, tok);
            norm_finish(F, vb, sb, V, U + (size_t)(NCTX + tok + 1) * DM, y); moe_route_row(F, y, Rw, rb, sel, tl + 1, tok + 1);
#endif
        }
        __syncthreads();
        if (F.tid < 16) { const int s = F.tid >> 3, e = F.tid & 7; int cnt = 0; int* lst = (int*)(F.ws + WS_SEGLIST) + ((size_t)(seg * 2 + s) * 8 + e) * 128;
            for (int i = 0; i < 128; ++i) if (sel[i * 2 + s] == e) lst[cnt++] = seg * 128 + i;
            ((int*)(F.ws + WS_SEGCNT))[(seg * 2 + s) * 8 + e] = cnt; }
        __syncthreads();
    }
}
DI void moe_route_phase(Frame& F) {
    LAS int* cn = (LAS int*)F.lds;
    LAS int* offs = cn + 2048;
    LAS int* tb = offs + 256;
    for (int unit = F.bid; unit < 16; unit += F.G) {
        const int s = unit >> 3, e = unit & 7;
        const int* segcnt = (const int*)(F.ws + WS_SEGCNT);
        for (int idx = F.tid; idx < 2048; idx += 512) { const int ee = idx >> 8, gsg = idx & 255; cn[idx] = segcnt[(gsg * 2 + s) * 8 + ee]; }
        __syncthreads();
        if (F.tid < 8) { int tot = 0; for (int gsg = 0; gsg < 256; ++gsg) tot += cn[F.tid * 256 + gsg]; tb[16 + F.tid] = tot; }
        if (F.tid == 64) { int run = 0; for (int gsg = 0; gsg < 256; ++gsg) { offs[gsg] = run; run += cn[e * 256 + gsg]; } }
        __syncthreads();
        if (F.tid == 0) { int run = 0; for (int ee = 0; ee < 8; ++ee) { tb[ee] = run; run += (tb[16 + ee] + 255) / 256; } tb[8] = run; }
        __syncthreads();
        int* rowmap = (int*)(F.ws + WS_ROWMAP) + (size_t)s * MOE_ROWS;
        float* prow = (float*)(F.ws + WS_PROW) + (size_t)s * MOE_ROWS;
        const float* ptok = (const float*)(F.ws + WS_PTOK);
        const int base = tb[e] * 256, tot = tb[16 + e], ntile = (tot + 255) / 256;
        if (F.tid < 256) { const int gsg = F.tid; const int c = cn[e * 256 + gsg]; const int* lst = (const int*)(F.ws + WS_SEGLIST) + ((size_t)(gsg * 2 + s) * 8 + e) * 128;
            for (int i = 0; i < c; ++i) { const int tok = lst[i]; rowmap[base + offs[gsg] + i] = tok; prow[base + offs[gsg] + i] = ptok[(size_t)tok * 2 + s]; } }
        for (int i = tot + F.tid; i < ntile * 256; i += 512) { rowmap[base + i] = -1; prow[base + i] = 0.f; }
        if (e == 0) { int* meta = (int*)(F.ws + WS_META) + s * 256;
            if (F.tid == 0) meta[0] = tb[8];
            if (F.tid < 8) { const int t0 = tb[F.tid], t1 = tb[F.tid + 1]; for (int t = t0; t < t1; ++t) meta[1 + t] = F.tid; } }
        __syncthreads();
    }
}
DI void final_phase(Frame& F) {
    const float* g = F.in[I_FNW];
    f32x4 gv[4];
#pragma unroll
    for (int j = 0; j < 4; ++j) gv[j] = ((const f32x4*)g)[F.lane + 64 * j];
    const int gw = F.bid * 8 + F.wave, NGW = F.G * 8;
    const int rpw = (NLAT + NGW - 1) / NGW; const int r0 = gw * rpw; int r1 = r0 + rpw; if (r1 > NLAT) r1 = NLAT;
    for (int row = r0; row < r1; row += 2) {
        const bool two = row + 1 < r1; const int rowb = two ? row + 1 : row;
        f32x4 va[4], vb[4];
        norm_load_row(F, F.out + (size_t)row * DM, va); norm_load_row(F, F.out + (size_t)rowb * DM, vb);
        float sa = norm_ssq(va), sb = norm_ssq(vb);
#pragma unroll
        for (int o = 1; o < 64; o <<= 1) { sa += __shfl_xor(sa, o); sb += __shfl_xor(sb, o); }
        const float ra = 1.0f / sqrtf(sa * (1.0f / DM) + EPS), rbv = 1.0f / sqrtf(sb * (1.0f / DM) + EPS);
        f32x4* xa = (f32x4*)(F.out + (size_t)row * DM) + F.lane; f32x4* xb = (f32x4*)(F.out + (size_t)rowb * DM) + F.lane;
#pragma unroll
        for (int j = 0; j < 4; ++j) xa[64 * j] = (va[j] * ra) * gv[j];
        if (two) {
#pragma unroll
            for (int j = 0; j < 4; ++j) xb[64 * j] = (vb[j] * rbv) * gv[j]; }
    }
}

DI void conv_unit(Frame& F, int l, int row0, int t0, int slen) {
    const bf16* PX = (const bf16*)(F.ws + WS_P);
    bf16* YC = (bf16*)(F.ws + WS_U);
    LAS float* Y = (LAS float*)F.lds;
    { u32x4 av[6], gv[6];
#pragma unroll
      for (int k = 0; k < 6; ++k) { const int it = F.tid + 512 * k; const int rr = it >> 5, cc = it & 31; const int t = t0 - 15 + rr;
          av[k] = (u32x4){0u, 0u, 0u, 0u}; gv[k] = av[k];
          if (it < 94 * 32 && t >= 0 && t < slen) { const bf16* p = PX + (size_t)(row0 + t) * INW + C_CONV + 8 * cc; av[k] = *(const u32x4*)p; gv[k] = *(const u32x4*)(p + 256); } }
#pragma unroll
      for (int k = 0; k < 6; ++k) { const int it = F.tid + 512 * k; const int rr = it >> 5, cc = it & 31;
          if (it < 94 * 32) { f32x4 o0, o1;
              o0[0] = bflo(av[k].x) * sigmoidf_(bflo(gv[k].x)); o0[1] = bfhi(av[k].x) * sigmoidf_(bfhi(gv[k].x)); o0[2] = bflo(av[k].y) * sigmoidf_(bflo(gv[k].y)); o0[3] = bfhi(av[k].y) * sigmoidf_(bfhi(gv[k].y));
              o1[0] = bflo(av[k].z) * sigmoidf_(bflo(gv[k].z)); o1[1] = bfhi(av[k].z) * sigmoidf_(bfhi(gv[k].z)); o1[2] = bflo(av[k].w) * sigmoidf_(bflo(gv[k].w)); o1[3] = bfhi(av[k].w) * sigmoidf_(bfhi(gv[k].w));
              *(LAS f32x4*)(Y + rr * 256 + 8 * cc) = o0; *(LAS f32x4*)(Y + rr * 256 + 8 * cc + 4) = o1; } } }
    __syncthreads();
    const int c = F.tid & 255, half = F.tid >> 8;
    float w[31];
#pragma unroll
    for (int k = 0; k < 31; ++k) w[k] = F.in[I_CONVW][(size_t)l * 31 * 256 + k * 256 + c];
    float acc[32];
    const float cb = F.in[I_CONVB][l * 256 + c];
#pragma unroll
    for (int o = 0; o < 32; ++o) acc[o] = cb;
#pragma unroll
    for (int kk = 0; kk < 62; ++kk) { const float yv = Y[(32 * half + kk) * 256 + c];
#pragma unroll
        for (int o = 0; o < 32; ++o) { const int tap = kk - o; if (tap >= 0 && tap < 31) acc[o] += yv * w[tap]; } }
    __syncthreads();
#pragma unroll
    for (int o = 0; o < 32; ++o) Y[(32 * half + o) * 256 + c] = acc[o];
    __syncthreads();
    const f32x4 lw = ((const f32x4*)(F.in[I_CLNW] + l * 256))[F.lane], lb = ((const f32x4*)(F.in[I_CLNB] + l * 256))[F.lane];
    for (int i = 0; i < 8; ++i) { const int tl = F.wave * 8 + i; const f32x4 v = *(const LAS f32x4*)(Y + tl * 256 + 4 * F.lane);
        const float mu = wave_sum((v.x + v.y) + (v.z + v.w)) * (1.0f / 256.0f); const f32x4 d = v - mu;
        const float var = wave_sum((d.x * d.x + d.y * d.y) + (d.z * d.z + d.w * d.w)) * (1.0f / 256.0f); const float rstd = 1.0f / sqrtf(var + EPS);
        f32x4 z = d * rstd * lw + lb; z.x *= sigmoidf_(z.x); z.y *= sigmoidf_(z.y); z.z *= sigmoidf_(z.z); z.w *= sigmoidf_(z.w);
        u32x2 o; o.x = pk2(z.x, z.y); o.y = pk2(z.z, z.w);
        *(u32x2*)(YC + (size_t)(row0 + t0 + tl) * DM + 512 + 4 * F.lane) = o; }
    __syncthreads();
}
DI void ret_consts(Frame& F, int l, int hh, float& lg2f, float& lg2b) {
    const float df = F.in[I_RDEC][(l * 2 + 0) * 4 + hh], db = F.in[I_RDEC][(l * 2 + 1) * 4 + hh];
    lg2f = log2f(1.0f - exp2f(-df)); lg2b = log2f(1.0f - exp2f(-db));
}
constexpr int ROPE_LDS = AUX_OFF + 4096;
DI void rope_to_lds(Frame& F) { const float* tab = (const float*)(F.ws + WS_ROPE); LAS float* rt = (LAS float*)(F.lds + ROPE_LDS); for (int i = F.tid; i < 1024; i += 512) rt[i] = tab[i]; __syncthreads(); }
DI void unpack8(const u32x4& a, float (&x)[8]) { x[0] = bflo(a.x); x[1] = bfhi(a.x); x[2] = bflo(a.y); x[3] = bfhi(a.y); x[4] = bflo(a.z); x[5] = bfhi(a.z); x[6] = bflo(a.w); x[7] = bfhi(a.w); }
DI void rope_apply(Frame& F, const u32x4& a, const u32x4& b, int hp, bool lat, int tg, float (&x1)[8], float (&x2)[8]) {
    unpack8(a, x1); unpack8(b, x2);
    if (lat) { const int pos = hp == 0 ? (tg >> 6) : (tg & 63); LAS const f32x4* tab = (LAS const f32x4*)(F.lds + ROPE_LDS) + pos * 4;
#pragma unroll
        for (int jj = 0; jj < 4; ++jj) { const f32x4 cs = tab[jj];
            { const float a1 = x1[2 * jj], a2 = x2[2 * jj]; x1[2 * jj] = a1 * cs[0] - a2 * cs[1]; x2[2 * jj] = a2 * cs[0] + a1 * cs[1]; }
            { const float a1 = x1[2 * jj + 1], a2 = x2[2 * jj + 1]; x1[2 * jj + 1] = a1 * cs[2] - a2 * cs[3]; x2[2 * jj + 1] = a2 * cs[2] + a1 * cs[3]; } } }
}
DI void ret_unit_decode(int su, bool& isctx, int& b, int& hh, int& n) {
    isctx = su >= 1024; if (!isctx) { b = su >> 6; hh = (su >> 4) & 3; n = su & 15; } else { const int v = su - 1024; b = v >> 3; hh = (v >> 1) & 3; n = v & 1; }
}
DI void ret_summary_pair(Frame& F, int l, int it) {
    const bf16* PX = (const bf16*)(F.ws + WS_P);
    const int sub = F.wave >> 2, st = F.tid & 255, su = 2 * it + sub;
    bool isctx; int b, hh, n; ret_unit_decode(su, isctx, b, hh, n);
    const int row0 = isctx ? (b * CTXL + n * 128) : (NCTX + b * SEQ + n * 128);
    float lg2f, lg2b; ret_consts(F, l, hh, lg2f, lg2b);
    LAS unsigned char* base = F.lds + sub * 40960;
    LAS unsigned char* Vimg = base;
    LAS unsigned char* Kf = base + 18432;
    LAS unsigned char* Kb = base + 18432 + 10240;
    { const int tok = st >> 1, hp = st & 1; float x1[8], x2[8];
      const bf16* kp = PX + (size_t)(row0 + tok) * INW + C_RK + 32 * hh; const bf16* vp = PX + (size_t)(row0 + tok) * INW + C_RV + 64 * hh + 32 * hp;
      const u32x4 kra = *(const u32x4*)(kp + 8 * hp), krb = *(const u32x4*)(kp + 16 + 8 * hp);
      u32x4 vr[4];
#pragma unroll
      for (int q = 0; q < 4; ++q) vr[q] = *(const u32x4*)(vp + 8 * q);
      rope_apply(F, kra, krb, hp, !isctx, n * 128 + tok, x1, x2);
      const float ks = 0.17677669529663687f;
      const float wf = fast_exp2(lg2f * (float)(127 - tok)) * ks, wb = fast_exp2(lg2b * (float)tok) * ks;
      u32x4 o;
      o.x = pk2(x1[0] * wf, x1[1] * wf); o.y = pk2(x1[2] * wf, x1[3] * wf); o.z = pk2(x1[4] * wf, x1[5] * wf); o.w = pk2(x1[6] * wf, x1[7] * wf); *(LAS u32x4*)(Kf + tok * 80 + 16 * hp) = o;
      o.x = pk2(x2[0] * wf, x2[1] * wf); o.y = pk2(x2[2] * wf, x2[3] * wf); o.z = pk2(x2[4] * wf, x2[5] * wf); o.w = pk2(x2[6] * wf, x2[7] * wf); *(LAS u32x4*)(Kf + tok * 80 + 32 + 16 * hp) = o;
      o.x = pk2(x1[0] * wb, x1[1] * wb); o.y = pk2(x1[2] * wb, x1[3] * wb); o.z = pk2(x1[4] * wb, x1[5] * wb); o.w = pk2(x1[6] * wb, x1[7] * wb); *(LAS u32x4*)(Kb + tok * 80 + 16 * hp) = o;
      o.x = pk2(x2[0] * wb, x2[1] * wb); o.y = pk2(x2[2] * wb, x2[3] * wb); o.z = pk2(x2[4] * wb, x2[5] * wb); o.w = pk2(x2[6] * wb, x2[7] * wb); *(LAS u32x4*)(Kb + tok * 80 + 32 + 16 * hp) = o;
#pragma unroll
      for (int q = 0; q < 4; ++q) *(LAS u32x4*)(Vimg + tok * 144 + 64 * hp + 16 * q) = vr[q]; }
    __syncthreads();
    { const int role = F.wave & 3, dir = role >> 1, et = role & 1;
      const int l32 = F.lane & 31, h = F.lane >> 5, grp = (F.lane >> 4) & 1, i16 = F.lane & 15, q = i16 >> 2, p = i16 & 3;
      LAS unsigned char* Kimg = dir ? Kb : Kf;
      f32x16 acc;
#pragma unroll
      for (int i = 0; i < 16; ++i) acc[i] = 0.f;
#pragma unroll
      for (int s = 0; s < 8; ++s) { const int r0 = 16 * s + 8 * h + q;
          const s16x4 alo = trread(Vimg + r0 * 144 + (32 * et + 16 * grp + 4 * p) * 2), ahi = trread(Vimg + (r0 + 4) * 144 + (32 * et + 16 * grp + 4 * p) * 2);
          const s16x4 blo = trread(Kimg + r0 * 80 + (16 * grp + 4 * p) * 2), bhi = trread(Kimg + (r0 + 4) * 80 + (16 * grp + 4 * p) * 2);
          const bf16x8 a = __builtin_shufflevector(alo, ahi, 0, 1, 2, 3, 4, 5, 6, 7), bb = __builtin_shufflevector(blo, bhi, 0, 1, 2, 3, 4, 5, 6, 7);
          acc = MFMA32(a, bb, acc); }
      float* S = isctx ? (float*)(F.ws + WS_SUMCTX) + ((size_t)((b * 4 + hh) * 2 + n) * 2 + dir) * 2048 : (float*)(F.ws + WS_SUMLAT) + ((size_t)((b * 4 + hh) * 16 + n) * 2 + dir) * 2048;
#pragma unroll
      for (int i = 0; i < 16; ++i) S[(32 * et + crow(i, h)) * 32 + l32] = acc[i]; }
    __syncthreads();
}
DI void ca_phase(Frame& F, int l) {
    rope_to_lds(F);
    const int nconv = l == 0 ? 576 : 512;
    for (int u = F.vb; u < nconv; u += F.G) {
        int v = u; if (l != 0) v += 64;
        if (v < 64) conv_unit(F, l, (v >> 2) * CTXL, (v & 3) * 64, CTXL);
        else { v -= 64; conv_unit(F, l, NCTX + (v >> 5) * SEQ, (v & 31) * 64, SEQ); }
    }
    for (int it = F.vb; it < 576; it += F.G) ret_summary_pair(F, l, it);
}

constexpr int ATT_KV = 18432, ATT_BUF = 2 * ATT_KV, ATT_BT = 2 * ATT_BUF, ATT_NEG = 640;
struct AttRegs { u32x4 k0, v0, k1, v1; };
DI void attn_fetch(const bf16* PX, int rowA, int rowB, unsigned loff, AttRegs& R) {
    const char* pa = (const char*)(PX + (size_t)rowA * INW) + loff; const char* pb = (const char*)(PX + (size_t)rowB * INW) + loff;
    R.k0 = *(const u32x4*)(pa + C_NAK * 2); R.v0 = *(const u32x4*)(pa + C_NAV * 2); R.k1 = *(const u32x4*)(pb + C_NAK * 2); R.v1 = *(const u32x4*)(pb + C_NAV * 2);
}
DI void attn_put(Frame& F, LAS unsigned char* buf, const AttRegs& R) {
    const int key = F.tid >> 3, ch = F.tid & 7;
    *(LAS u32x4*)(buf + key * 144 + 16 * ch) = R.k0; *(LAS u32x4*)(buf + ATT_KV + key * 144 + 16 * ch) = R.v0;
    *(LAS u32x4*)(buf + (64 + key) * 144 + 16 * ch) = R.k1; *(LAS u32x4*)(buf + ATT_KV + (64 + key) * 144 + 16 * ch) = R.v1;
}
template <bool BIAS, int NT>
DI void attn_tiles(LAS const unsigned char* buf, const int (&koff)[2], const bf16x8 (&qf)[4], f32x16& o0, f32x16& o1, f32x16& o2, float& mrun, int lane,
                   LAS const float* const (&bt)[2]  , const float (&pen)[16]) {
    LAS const unsigned char* Kimg = buf; LAS const unsigned char* Vimg = buf + ATT_KV;
    const int l32 = lane & 31, h = lane >> 5, grp = (lane >> 4) & 1, i16 = lane & 15, q = i16 >> 2, p = i16 & 3;
    f32x16 s[NT];
#pragma unroll
    for (int t = 0; t < NT; ++t)
#pragma unroll
        for (int i = 0; i < 16; ++i) s[t][i] = 0.f;
#pragma unroll
    for (int si = 0; si < 4; ++si)
#pragma unroll
        for (int t = 0; t < NT; ++t) { const bf16x8 a = *(const LAS bf16x8*)(Kimg + (koff[t] + l32) * 144 + (16 * si + 8 * h) * 2); s[t] = MFMA32(a, qf[si], s[t]); }
    const float c = 0.125f * LOG2E;
    float v[NT][16]; float mx = -1.0e30f;
#pragma unroll
    for (int t = 0; t < NT; ++t)
#pragma unroll
        for (int i = 0; i < 16; ++i) { float x;
            if (BIAS) x = __builtin_fmaf(s[t][i], c, bt[t][(i & 3) + 8 * (i >> 2)]) + pen[i]; else x = s[t][i];
            v[t][i] = x; mx = fmaxf(mx, x); }
    if (!BIAS) mx *= c;
    mx = fmaxf(mx, __shfl_xor(mx, 32));
    const float mnew = fmaxf(mrun, mx);
    const float alpha = fast_exp2(mrun - mnew);
    if (__any(alpha != 1.0f)) {
#pragma unroll
        for (int i = 0; i < 16; ++i) { o0[i] *= alpha; o1[i] *= alpha; o2[i] *= alpha; } }
    mrun = mnew;
    bf16x8 pf[NT][2];
#pragma unroll
    for (int t = 0; t < NT; ++t) { float pp[16];
#pragma unroll
        for (int i = 0; i < 16; ++i) pp[i] = BIAS ? fast_exp2(v[t][i] - mnew) : fast_exp2(__builtin_fmaf(v[t][i], c, -mnew));
#pragma unroll
        for (int s2 = 0; s2 < 2; ++s2) { u32x4 w; w.x = pk2(pp[8 * s2], pp[8 * s2 + 1]); w.y = pk2(pp[8 * s2 + 2], pp[8 * s2 + 3]); w.z = pk2(pp[8 * s2 + 4], pp[8 * s2 + 5]); w.w = pk2(pp[8 * s2 + 6], pp[8 * s2 + 7]); pf[t][s2] = __builtin_bit_cast(bf16x8, w); } }
    const u32x4 onesw = (u32x4){0x3f803f80u, 0x3f803f80u, 0x3f803f80u, 0x3f803f80u}; const bf16x8 ones = __builtin_bit_cast(bf16x8, onesw);
#pragma unroll
    for (int t = 0; t < NT; ++t)
#pragma unroll
        for (int s2 = 0; s2 < 2; ++s2) { const int r0 = koff[t] + 16 * s2 + 4 * h + q;
#pragma unroll
            for (int et = 0; et < 2; ++et) { const int cb = (32 * et + 16 * grp + 4 * p) * 2;
                const s16x4 lo = trread(Vimg + r0 * 144 + cb), hi = trread(Vimg + (r0 + 8) * 144 + cb);
                const bf16x8 a = __builtin_shufflevector(lo, hi, 0, 1, 2, 3, 4, 5, 6, 7);
                if (et == 0) o0 = MFMA32(a, pf[t][s2], o0); else o1 = MFMA32(a, pf[t][s2], o1); }
            o2 = MFMA32(ones, pf[t][s2], o2); }
}
DI void attn_unit(Frame& F, int l, bool na, int b, int hh, int rg) {
    const bf16* PX = (const bf16*)(F.ws + WS_P);
    bf16* YC = (bf16*)(F.ws + WS_U);
    LAS float* btab = (LAS float*)(F.lds + ATT_BT);
    const int l32 = F.lane & 31, h = F.lane >> 5;
    int qrow, r = 0, qcol = 0, kc0 = 0, ra = 0;
    float pen[16];
#pragma unroll
    for (int i = 0; i < 16; ++i) pen[i] = 0.f;
    if (na) { const int rp = F.wave >> 2, n = F.wave & 3; ra = 4 * rg + 2 * rp; r = ra + (l32 >> 4); qcol = 16 * n + (l32 & 15); qrow = NCTX + b * SEQ + r * GW + qcol;
        int w0 = qcol - 8; w0 = w0 < 0 ? 0 : (w0 > 48 ? 48 : w0); kc0 = 16 * n - 8; kc0 = kc0 < 0 ? 0 : (kc0 > 32 ? 32 : kc0);
#pragma unroll
        for (int i = 0; i < 16; ++i) pen[i] = ((unsigned)(kc0 + crow(i, h) - w0) < 16u) ? 0.f : -1.0e30f; }
    else qrow = b * CTXL + 32 * F.wave + l32;
    bf16x8 qf[4];
#pragma unroll
    for (int si = 0; si < 4; ++si) qf[si] = *(const bf16x8*)(PX + (size_t)qrow * INW + C_NAQ + 64 * hh + 16 * si + 8 * h);
    if (na) { for (int idx = F.tid; idx < ATT_NEG + 128; idx += 512) { float v = 0.f; if (idx >= 48 && idx < 48 + 465) v = F.in[I_RPB][((size_t)l * 8 + hh) * 465 + (idx - 48)] * LOG2E; if (idx >= ATT_NEG) v = -1.0e30f; btab[idx] = v; } }
    f32x16 o0, o1, o2;
#pragma unroll
    for (int i = 0; i < 16; ++i) { o0[i] = 0.f; o1[i] = 0.f; o2[i] = 0.f; }
    float mrun = -1.0e30f;
    int ylo = 0, yhi = 0, nsteps = 2;
    if (na) { const int rlo = 4 * rg, rhi = 4 * rg + 3;
        ylo = rlo - 4; ylo = ylo < 0 ? 0 : (ylo > 24 ? 24 : ylo);
        yhi = rhi - 4; yhi = yhi < 0 ? 0 : (yhi > 24 ? 24 : yhi); yhi += 8; nsteps = 2 + (yhi - ylo + 1) / 2; }
    int sa = ra - 4; sa = sa < 0 ? 0 : (sa > 24 ? 24 : sa);
    int sb = ra + 1 - 4; sb = sb < 0 ? 0 : (sb > 24 ? 24 : sb);
    const int mylo = (l32 >> 4) ? sb : sa;
    const int cbase = kc0 + 4 * h - qcol + 15;
#define ATT_ROWA(sx) ((sx) < 2 ? b * CTXL + 128 * (sx) : NCTX + b * SEQ + (ylo + 2 * ((sx) - 2)) * GW)
#define ATT_ROWB(sx) ((sx) < 2 ? b * CTXL + 128 * (sx) + 64 : NCTX + b * SEQ + ((ylo + 2 * ((sx) - 2) + 1) < yhi ? (ylo + 2 * ((sx) - 2) + 1) : (yhi - 1)) * GW)
    AttRegs R;
    unsigned loff = (unsigned)(((F.tid >> 3) * INW + 64 * hh + 8 * (F.tid & 7)) * 2); asm volatile("" : "+v"(loff));
    attn_fetch(PX, ATT_ROWA(0), ATT_ROWB(0), loff, R);
    for (int st = 0; st < nsteps; ++st) {
        LAS unsigned char* buf = F.lds + (st & 1) * ATT_BUF;
        attn_put(F, buf, R);
        if (st + 1 < nsteps) attn_fetch(PX, ATT_ROWA(st + 1), ATT_ROWB(st + 1), loff, R);
        __syncthreads();
        if (st < 2) {
            LAS const float* const bt[2] = {btab, btab};
            { const int ko[2] = {0, 32}; attn_tiles<false, 2>(buf, ko, qf, o0, o1, o2, mrun, F.lane, bt, pen); }
            { const int ko[2] = {64, 96}; attn_tiles<false, 2>(buf, ko, qf, o0, o1, o2, mrun, F.lane, bt, pen); }
        } else {
            const int y0 = ylo + 2 * (st - 2), y1 = y0 + 1;
            const bool act0 = (y0 >= sa && y0 < sb + 8), act1 = (y1 < yhi && y1 >= sa && y1 < sb + 8);
            const bool ok0 = (unsigned)(y0 - mylo) < 8u, ok1 = (unsigned)(y1 - mylo) < 8u;
            LAS const float* b0 = btab + (ok0 ? 48 + (y0 - r + 7) * 31 + cbase : ATT_NEG);
            LAS const float* b1 = btab + (ok1 ? 48 + (y1 - r + 7) * 31 + cbase : ATT_NEG);
            if (act0 && act1) { const int ko[2] = {kc0, 64 + kc0}; LAS const float* const bt[2] = {b0, b1}; attn_tiles<true, 2>(buf, ko, qf, o0, o1, o2, mrun, F.lane, bt, pen); }
            else if (act0) { const int ko[2] = {kc0, kc0}; LAS const float* const bt[2] = {b0, b0}; attn_tiles<true, 1>(buf, ko, qf, o0, o1, o2, mrun, F.lane, bt, pen); }
            else if (act1) { const int ko[2] = {64 + kc0, 64 + kc0}; LAS const float* const bt[2] = {b1, b1}; attn_tiles<true, 1>(buf, ko, qf, o0, o1, o2, mrun, F.lane, bt, pen); }
        }
    }
#undef ATT_ROWA
#undef ATT_ROWB
    const float inv = 1.0f / o2[0];
    bf16* orow = YC + (size_t)qrow * DM + 64 * hh;
#pragma unroll
    for (int gq = 0; gq < 4; ++gq) { u32x2 w;
        w.x = pk2(o0[4 * gq] * inv, o0[4 * gq + 1] * inv); w.y = pk2(o0[4 * gq + 2] * inv, o0[4 * gq + 3] * inv); *(u32x2*)(orow + 8 * gq + 4 * h) = w;
        w.x = pk2(o1[4 * gq] * inv, o1[4 * gq + 1] * inv); w.y = pk2(o1[4 * gq + 2] * inv, o1[4 * gq + 3] * inv); *(u32x2*)(orow + 32 + 8 * gq + 4 * h) = w; }
    __syncthreads();
}
struct RetRaw { u32x4 kra, krb, vra, vrb, qra, qrb; u32x2 gg[8]; };
DI void ret_fetch(Frame& F, int su, RetRaw& R) {
    const bf16* PX = (const bf16*)(F.ws + WS_P);
    bool isctx; int b, hh, n; ret_unit_decode(su, isctx, b, hh, n);
    const int row0 = isctx ? (b * CTXL + n * 128) : (NCTX + b * SEQ + n * 128);
    const int dir = F.wave >> 2, qb = F.wave & 3, l32 = F.lane & 31, h = F.lane >> 5; const int iq = 32 * qb + l32;
    const int ktok = (F.tid & 255) >> 1, khp = F.tid & 1;
    const bf16* kp = PX + (size_t)(row0 + ktok) * INW + C_RK + 32 * hh;
    R.kra = *(const u32x4*)(kp + 8 * khp); R.krb = *(const u32x4*)(kp + 16 + 8 * khp);
    const int vtok = F.tid >> 2, vch = F.tid & 3; const bf16* vp = PX + (size_t)(row0 + vtok) * INW + C_RV + 64 * hh + 16 * vch;
    R.vra = *(const u32x4*)vp; R.vrb = *(const u32x4*)(vp + 8);
    const bf16* qp = PX + (size_t)(row0 + iq) * INW + C_RQ + 32 * hh;
    R.qra = *(const u32x4*)(qp + 8 * h); R.qrb = *(const u32x4*)(qp + 16 + 8 * h);
    const bf16* gp = PX + (size_t)(row0 + iq) * INW + (dir ? C_GB : C_GF) + 64 * hh;
#pragma unroll
    for (int et = 0; et < 2; ++et)
#pragma unroll
        for (int gq = 0; gq < 4; ++gq) R.gg[et * 4 + gq] = *(const u32x2*)(gp + 32 * et + 8 * gq + 4 * h);
}
DI void ret_out_units(Frame& F, int l, int nret) {
    bf16* YC = (bf16*)(F.ws + WS_U);
    LAS unsigned char* Kimg = F.lds;
    LAS unsigned char* Vimg = F.lds + 10240;
    LAS unsigned char* Stf = F.lds + 28672;
    LAS unsigned char* Stb = F.lds + 33792;
    LAS float* Ob = (LAS float*)(F.lds + 38912);
    const int dir = F.wave >> 2, qb = F.wave & 3, l32 = F.lane & 31, h = F.lane >> 5, grp = (F.lane >> 4) & 1, i16 = F.lane & 15, q = i16 >> 2, p = i16 & 3;
    const int iq = 32 * qb + l32;
    const int ktok = (F.tid & 255) >> 1, khp = F.tid & 1, vtok = F.tid >> 2, vch = F.tid & 3;
    int su = F.vb;
    if (su >= nret) return;
    RetRaw R; ret_fetch(F, su, R);
    for (; su < nret; su += F.G) {
        bool isctx; int b, hh, n; ret_unit_decode(su, isctx, b, hh, n);
        const int row0 = isctx ? (b * CTXL + n * 128) : (NCTX + b * SEQ + n * 128);
        float lg2f, lg2b; ret_consts(F, l, hh, lg2f, lg2b);
        if (F.tid < 256) { float x1[8], x2[8]; rope_apply(F, R.kra, R.krb, khp, !isctx, n * 128 + ktok, x1, x2);
            const float ks = 0.17677669529663687f; u32x4 o;
            o.x = pk2(x1[0] * ks, x1[1] * ks); o.y = pk2(x1[2] * ks, x1[3] * ks); o.z = pk2(x1[4] * ks, x1[5] * ks); o.w = pk2(x1[6] * ks, x1[7] * ks); *(LAS u32x4*)(Kimg + ktok * 80 + 16 * khp) = o;
            o.x = pk2(x2[0] * ks, x2[1] * ks); o.y = pk2(x2[2] * ks, x2[3] * ks); o.z = pk2(x2[4] * ks, x2[5] * ks); o.w = pk2(x2[6] * ks, x2[7] * ks); *(LAS u32x4*)(Kimg + ktok * 80 + 32 + 16 * khp) = o; }
        *(LAS u32x4*)(Vimg + vtok * 144 + 32 * vch) = R.vra; *(LAS u32x4*)(Vimg + vtok * 144 + 32 * vch + 16) = R.vrb;
        bf16x8 qf[2], qd[2];
        { float x1[8], x2[8]; rope_apply(F, R.qra, R.qrb, h, !isctx, n * 128 + iq, x1, x2);
          const float dec = dir == 0 ? fast_exp2(lg2f * (float)(iq + 1)) : fast_exp2(lg2b * (float)(128 - iq));
          u32x4 w;
          w.x = pk2(x1[0], x1[1]); w.y = pk2(x1[2], x1[3]); w.z = pk2(x1[4], x1[5]); w.w = pk2(x1[6], x1[7]); qf[0] = __builtin_bit_cast(bf16x8, w);
          w.x = pk2(x2[0], x2[1]); w.y = pk2(x2[2], x2[3]); w.z = pk2(x2[4], x2[5]); w.w = pk2(x2[6], x2[7]); qf[1] = __builtin_bit_cast(bf16x8, w);
          w.x = pk2(x1[0] * dec, x1[1] * dec); w.y = pk2(x1[2] * dec, x1[3] * dec); w.z = pk2(x1[4] * dec, x1[5] * dec); w.w = pk2(x1[6] * dec, x1[7] * dec); qd[0] = __builtin_bit_cast(bf16x8, w);
          w.x = pk2(x2[0] * dec, x2[1] * dec); w.y = pk2(x2[2] * dec, x2[3] * dec); w.z = pk2(x2[4] * dec, x2[5] * dec); w.w = pk2(x2[6] * dec, x2[7] * dec); qd[1] = __builtin_bit_cast(bf16x8, w); }
        u32x2 gcur[8];
#pragma unroll
        for (int i = 0; i < 8; ++i) gcur[i] = R.gg[i];
        const float cf = fast_exp2(lg2f * 128.0f), cb = fast_exp2(lg2b * 128.0f);
        const float* SC = (const float*)(F.ws + WS_SUMCTX) + (size_t)((b * 4 + hh) * 2) * 2 * 2048;
        const float* SL = (const float*)(F.ws + WS_SUMLAT) + (size_t)((b * 4 + hh) * 16) * 2 * 2048;
        const int eo = 4 * F.tid;
        f32x4 t[16], c00, c10, c11, c01;
        if (!isctx) {
#pragma unroll
            for (int m = 0; m < 16; ++m) t[m] = *(const f32x4*)(SL + (size_t)(m * 2 + (m <= n ? 0 : 1)) * 2048 + eo);
            c00 = *(const f32x4*)(SC + (0 * 2 + 0) * 2048 + eo); c10 = *(const f32x4*)(SC + (1 * 2 + 0) * 2048 + eo);
            c11 = *(const f32x4*)(SC + (1 * 2 + 1) * 2048 + eo); c01 = *(const f32x4*)(SC + (0 * 2 + 1) * 2048 + eo);
        } else {
#pragma unroll
            for (int m = 0; m < 16; ++m) t[m] = (f32x4){0.f, 0.f, 0.f, 0.f};
            c00 = *(const f32x4*)(SC + (0 * 2 + 0) * 2048 + eo); c11 = *(const f32x4*)(SC + (1 * 2 + 1) * 2048 + eo); c10 = c00; c01 = c11;
        }
        __syncthreads();
        f32x16 o0, o1;
#pragma unroll
        for (int i = 0; i < 16; ++i) { o0[i] = 0.f; o1[i] = 0.f; }
        const float lgd = dir ? lg2b : lg2f;
        const int kt_lo = dir ? qb : 0, kt_hi = dir ? 3 : qb;
        for (int kt = kt_lo; kt <= kt_hi; ++kt) {
            f32x16 sc;
#pragma unroll
            for (int i = 0; i < 16; ++i) sc[i] = 0.f;
#pragma unroll
            for (int si = 0; si < 2; ++si) { const bf16x8 a = *(const LAS bf16x8*)(Kimg + (32 * kt + l32) * 80 + (16 * si + 8 * h) * 2); sc = MFMA32(a, qf[si], sc); }
            float pp[16];
#pragma unroll
            for (int i = 0; i < 16; ++i) { const int j = 32 * kt + crow(i, h); const int diff = dir ? (j - iq) : (iq - j); pp[i] = diff >= 0 ? sc[i] * fast_exp2(lgd * (float)diff) : 0.f; }
            bf16x8 pf[2];
#pragma unroll
            for (int s2 = 0; s2 < 2; ++s2) { u32x4 w; w.x = pk2(pp[8 * s2], pp[8 * s2 + 1]); w.y = pk2(pp[8 * s2 + 2], pp[8 * s2 + 3]); w.z = pk2(pp[8 * s2 + 4], pp[8 * s2 + 5]); w.w = pk2(pp[8 * s2 + 6], pp[8 * s2 + 7]); pf[s2] = __builtin_bit_cast(bf16x8, w); }
#pragma unroll
            for (int s2 = 0; s2 < 2; ++s2) { const int r0 = 32 * kt + 16 * s2 + 4 * h + q;
#pragma unroll
                for (int et = 0; et < 2; ++et) { const int cbo = (32 * et + 16 * grp + 4 * p) * 2;
                    const s16x4 lo = trread(Vimg + r0 * 144 + cbo), hi = trread(Vimg + (r0 + 8) * 144 + cbo);
                    const bf16x8 a = __builtin_shufflevector(lo, hi, 0, 1, 2, 3, 4, 5, 6, 7);
                    if (et == 0) o0 = MFMA32(a, pf[s2], o0); else o1 = MFMA32(a, pf[s2], o1); } }
        }
        { f32x4 sf = (f32x4){0.f, 0.f, 0.f, 0.f}, sb = sf;
          if (!isctx) {
              sf = c00 * cf + c10;
#pragma unroll
              for (int m = 0; m < 16; ++m) { const f32x4 nv = sf * cf + t[m]; sf = (m < n) ? nv : sf; }
              sb = c11 * cb + c01;
#pragma unroll
              for (int m = 15; m >= 0; --m) { const f32x4 nv = sb * cb + t[m]; sb = (m > n) ? nv : sb; }
          } else { if (n == 1) sf = c00; if (n == 0) sb = c11; }
          const int e = eo >> 5, d = eo & 31; u32x2 w;
          w.x = pk2(sf[0], sf[1]); w.y = pk2(sf[2], sf[3]); *(LAS u32x2*)(Stf + e * 80 + d * 2) = w;
          w.x = pk2(sb[0], sb[1]); w.y = pk2(sb[2], sb[3]); *(LAS u32x2*)(Stb + e * 80 + d * 2) = w; }
        __syncthreads();
        { LAS const unsigned char* St = dir ? Stb : Stf;
#pragma unroll
          for (int s2 = 0; s2 < 2; ++s2) { const bf16x8 a0 = *(const LAS bf16x8*)(St + l32 * 80 + (16 * s2 + 8 * h) * 2), a1 = *(const LAS bf16x8*)(St + (32 + l32) * 80 + (16 * s2 + 8 * h) * 2);
              o0 = MFMA32(a0, qd[s2], o0); o1 = MFMA32(a1, qd[s2], o1); } }
        if (su + F.G < nret) ret_fetch(F, su + F.G, R);
        float sm = 0.f;
#pragma unroll
        for (int i = 0; i < 16; ++i) sm += o0[i] + o1[i];
        sm += __shfl_xor(sm, 32);
        const float mu = sm * (1.0f / 64.0f);
        float vs = 0.f;
#pragma unroll
        for (int i = 0; i < 16; ++i) { const float d0 = o0[i] - mu, d1 = o1[i] - mu; vs += d0 * d0 + d1 * d1; }
        vs += __shfl_xor(vs, 32);
        const float rstd = 1.0f / sqrtf(vs * (1.0f / 64.0f) + EPS);
        const float* gn = F.in[I_RGNW] + l * 256 + 64 * hh;
        float val[32];
#pragma unroll
        for (int et = 0; et < 2; ++et)
#pragma unroll
            for (int gq = 0; gq < 4; ++gq) { const int e0 = 32 * et + 8 * gq + 4 * h; const u32x2 ggv = gcur[et * 4 + gq]; const f32x4 gw = *(const f32x4*)(gn + e0);
                const float g0 = bflo(ggv.x), g1 = bfhi(ggv.x), g2 = bflo(ggv.y), g3 = bfhi(ggv.y);
                const float a0 = et ? o1[4 * gq] : o0[4 * gq], a1 = et ? o1[4 * gq + 1] : o0[4 * gq + 1], a2 = et ? o1[4 * gq + 2] : o0[4 * gq + 2], a3 = et ? o1[4 * gq + 3] : o0[4 * gq + 3];
                val[et * 16 + 4 * gq] = (a0 - mu) * rstd * gw[0] * g0 * sigmoidf_(g0); val[et * 16 + 4 * gq + 1] = (a1 - mu) * rstd * gw[1] * g1 * sigmoidf_(g1);
                val[et * 16 + 4 * gq + 2] = (a2 - mu) * rstd * gw[2] * g2 * sigmoidf_(g2); val[et * 16 + 4 * gq + 3] = (a3 - mu) * rstd * gw[3] * g3 * sigmoidf_(g3); }
        if (dir == 0) {
#pragma unroll
            for (int et = 0; et < 2; ++et)
#pragma unroll
                for (int gq = 0; gq < 4; ++gq)
#pragma unroll
                    for (int j = 0; j < 4; ++j) Ob[iq * 65 + 32 * et + 8 * gq + 4 * h + j] = val[et * 16 + 4 * gq + j];
        }
        __syncthreads();
        if (dir == 1) { bf16* orow = YC + (size_t)(row0 + iq) * DM + 768 + 64 * hh;
#pragma unroll
            for (int et = 0; et < 2; ++et)
#pragma unroll
                for (int gq = 0; gq < 4; ++gq) { const int e0 = 32 * et + 8 * gq + 4 * h; float tt[4];
#pragma unroll
                    for (int j = 0; j < 4; ++j) tt[j] = val[et * 16 + 4 * gq + j] + Ob[iq * 65 + e0 + j];
                    u32x2 w; w.x = pk2(tt[0], tt[1]); w.y = pk2(tt[2], tt[3]); *(u32x2*)(orow + e0) = w; } }
        __syncthreads();
    }
}
#ifndef PROBE_SUB
#define PROBE_SUB 0
#endif
DI void cb_phase(Frame& F, int l) {
    rope_to_lds(F);
    const int nattn = l == 0 ? 1152 : 1024;
    for (int rep = 0; rep < ((PROBE_SUB & 1) ? 2 : 1); ++rep)
    for (int u = F.vb; u < nattn; u += F.G) {
        if (u < 1024) attn_unit(F, l, true, u >> 6, (u >> 3) & 7, u & 7);
        else { const int v = u - 1024; attn_unit(F, l, false, v >> 3, v & 7, 0); }
    }
    const int nret = l == 0 ? 1152 : 1024;
    for (int rep = 0; rep < ((PROBE_SUB & 2) ? 2 : 1); ++rep) ret_out_units(F, l, nret);
}

static_assert(sizeof(Params) == 240, "kernarg layout: in[26] at 0, out at 208, ws at 216, ph_lo at 224, ph_hi at 228");
#ifdef ONLY_PHASE
#define IN(k) ((k) == ONLY_PHASE && lo <= (k) && (k) < hi)
#else
#define IN(k) (lo <= (k) && (k) < hi)
#endif
#ifndef PROBE_MASK
#define PROBE_MASK 0u
#endif
#define NREP(k) (((PROBE_MASK >> (k)) & 1u) ? 2 : 1)
#define SEAM(k) do { if (IN(k) && IN((k) + 1)) { XcdBarrier bb_ = bar; asm volatile("" : "+s"(bb_.bar)); xcd_barrier(bb_, F.wave); } } while (0)
#define GLDS(P) ((LAS unsigned char*)(P).lds)
#define WSB(P, off) ((const pg8::bf16_t*)((P).ws + (off)))
template <int l> DI void layer_phases(Frame& F, const XcdBarrier& bar) {
    constexpr int lo = 0, hi = N_PHASES;
        const int pb = l == 0 ? 1 : 9;
        if (IN(pb + 0)) for (int rep_ = 0; rep_ < NREP(pb + 0); ++rep_) { if (rep_) __syncthreads(); Frame P = phase_frame(F); norm_phase(P, l, 1, l == 0, 0); } SEAM(pb + 0);
        if (IN(pb + 1)) for (int rep_ = 0; rep_ < NREP(pb + 1); ++rep_) { if (rep_) __syncthreads();
            Frame P = phase_frame(F);
            pg8::StaticOrder S; S.init(NTOK, INW, P.G, P.bid);
            pg8::EpiStoreBf16 E{(pg8::bf16_t*)(P.ws + WS_P), INW};
            pg8::gemm_phase<pg8::EpiStoreBf16, pg8::StaticOrder, pg8::RowsLinear, true>(GLDS(P), P.tid, WSB(P, WS_U), WSB(P, WS_WIN) + (size_t)l * INW * DM, 2 * DM, S, E, pg8::RowsLinear{});
            if (PROBE_SUB & 4) { __syncthreads(); pg8::gemm_phase<pg8::EpiNull, pg8::StaticOrder, pg8::RowsLinear, true>(GLDS(P), P.tid, WSB(P, WS_U), WSB(P, WS_WIN) + (size_t)l * INW * DM, 2 * DM, S, pg8::EpiNull{}, pg8::RowsLinear{}); }
            if (l == 0) bg_convert_tail(P, S.nwg, BG_B0, BG_D0); else bg_convert_tail(P, S.nwg, BG_B1, BG_CL);
        } SEAM(pb + 1);
        if (IN(pb + 2)) for (int rep_ = 0; rep_ < NREP(pb + 2); ++rep_) { if (rep_) __syncthreads(); Frame P = phase_frame(F); if (l == 1) { bg_convert_all(P, BG_CL, BG_ITEMS); __syncthreads(); } ca_phase(P, l); } SEAM(pb + 2);
        if (IN(pb + 3)) for (int rep_ = 0; rep_ < NREP(pb + 3); ++rep_) { if (rep_) __syncthreads(); Frame P = phase_frame(F); cb_phase(P, l); } SEAM(pb + 3);
        if (IN(pb + 4)) {
            Frame P = phase_frame(F);
            const int rb = l == 0 ? 0 : NCTX;
            const float* modlat = (const float*)(P.ws + WS_MODLAT) + (size_t)l * 16 * 6144;
            const float* modctx = (const float*)(P.ws + WS_MODCTX) + (size_t)l * 6144;
            float* hctx = (float*)(P.ws + WS_HCTX);
            pg8::StaticOrder S; S.init(NTOK - rb, DM, P.G, P.bid);
            pg8::EpiResGate E{l == 0 ? P.in[I_CTX] : hctx, l == 0 ? P.in[I_X] : P.out, hctx, P.out, modlat + 2 * DM, modctx + 2 * DM, rb};
            pg8::gemm_phase<pg8::EpiResGate, pg8::StaticOrder, pg8::RowsLinear, true>(GLDS(P), P.tid, WSB(P, WS_U) + (size_t)rb * DM, WSB(P, WS_WOUT) + (size_t)l * DM * DM, 2 * DM, S, E, pg8::RowsLinear{});
            if (l == 0) bg_convert_tail(P, S.nwg, BG_D0, BG_E0);
        } SEAM(pb + 4);
        if (l == 0) {
            if (IN(6)) for (int rep_ = 0; rep_ < NREP(6); ++rep_) { if (rep_) __syncthreads(); Frame P = phase_frame(F); norm_phase(P, 0, 2, false, 0, DENSE_FP8 == 1); } SEAM(6);
            if (IN(7)) for (int rep_ = 0; rep_ < NREP(7); ++rep_) { if (rep_) __syncthreads();
                Frame P = phase_frame(F);
                pg8::StaticOrder S; S.init(NTOK, 2 * DFF, P.G, P.bid);
                pg8::EpiSwiglu<false> E{(pg8::bf16_t*)(P.ws + WS_P), DFF, 0, nullptr};
#if DENSE_FP8 == 1
                pg8::gemm_phase<pg8::EpiSwiglu<false>, pg8::StaticOrder, pg8::RowsLinearOff, true, true>(GLDS(P), P.tid, WSB(P, WS_U), WSB(P, WS_WGU), DM, S, E, pg8::RowsLinearOff{}, SCL_U, SCL_WGU);
#else
                pg8::gemm_phase<pg8::EpiSwiglu<false>, pg8::StaticOrder, pg8::RowsLinear, true>(GLDS(P), P.tid, WSB(P, WS_U), WSB(P, WS_WGU), 2 * DM, S, E, pg8::RowsLinear{});
#endif
                bg_convert_tail(P, S.nwg, BG_E0, BG_F0);
            } SEAM(7);
            if (IN(8)) {
                Frame P = phase_frame(F);
                const float* modlat = (const float*)(P.ws + WS_MODLAT);
                const float* modctx = (const float*)(P.ws + WS_MODCTX);
                float* hctx = (float*)(P.ws + WS_HCTX);
                pg8::StaticOrder S; S.init(NTOK, DM, P.G, P.bid);
                pg8::EpiResGate E{hctx, P.out, hctx, P.out, modlat + 5 * DM, modctx + 5 * DM, 0};
#if DENSE_FP8
                pg8::gemm_phase<pg8::EpiResGate, pg8::StaticOrder, pg8::RowsLinearOff, true, true>(GLDS(P), P.tid, WSB(P, WS_P), WSB(P, WS_WD), DFF, S, E, pg8::RowsLinearOff{}, SCL_H, SCL_WD);
#else
                pg8::gemm_phase<pg8::EpiResGate, pg8::StaticOrder, pg8::RowsLinear, true>(GLDS(P), P.tid, WSB(P, WS_P), WSB(P, WS_WD), 2 * DFF, S, E, pg8::RowsLinear{});
#endif
                bg_convert_tail(P, S.nwg, BG_F0, BG_B1);
            } SEAM(8);
        } else {
            if (IN(14)) for (int rep_ = 0; rep_ < NREP(14); ++rep_) { if (rep_) __syncthreads(); Frame P = phase_frame(F); norm_moe_phase(P); } SEAM(14);
            if (IN(15)) for (int rep_ = 0; rep_ < NREP(15); ++rep_) { if (rep_) __syncthreads(); Frame P = phase_frame(F); moe_route_phase(P); } SEAM(15);
            LAS int* texp = (LAS int*)(F.lds + AUX_TAB);
            if (IN(16) || IN(17) || IN(18)) {
                Frame P = phase_frame(F);
                const int* meta = (const int*)(P.ws + WS_META);
                __syncthreads();
                for (int i = P.tid; i < 2 * MOE_TILES; i += 512) texp[i] = ld_i32_coherent(meta + (i / MOE_TILES) * 256 + 1 + (i % MOE_TILES));
                if (P.tid < 2) texp[2 * MOE_TILES + P.tid] = ld_i32_coherent(meta + P.tid * 256);
                __syncthreads();
            }
            if (IN(16)) for (int rep_ = 0; rep_ < NREP(16); ++rep_) { if (rep_) __syncthreads();
                Frame P = phase_frame(F);
                const int NT0 = __builtin_amdgcn_readfirstlane(texp[2 * MOE_TILES]), NT1 = __builtin_amdgcn_readfirstlane(texp[2 * MOE_TILES + 1]);
                pg8::MoeOrder S{NT0, NT1, 28, P.G, P.bid, (const LAS int*)texp};
                pg8::EpiSwiglu<true> E{(pg8::bf16_t*)(P.ws + WS_P), DFE, 28, (const float*)(P.ws + WS_PROW)};
                pg8::gemm_phase<pg8::EpiSwiglu<true>, pg8::MoeOrder, pg8::RowsGather, true, true>(GLDS(P), P.tid, WSB(P, WS_U), WSB(P, WS_MGU), DM, S, E, pg8::RowsGather{(const int*)(P.ws + WS_ROWMAP), 0}, SCL_U, SCL_WGU);
            } SEAM(16);
#pragma unroll 1
            for (int s = 0; s < 2; ++s) {
                if (IN(17 + s)) {
                    Frame P = phase_frame(F);
                    const int* rowmap = (const int*)(P.ws + WS_ROWMAP) + (size_t)s * MOE_ROWS;
                    const float* modlat = (const float*)(P.ws + WS_MODLAT) + (size_t)16 * 6144;
                    const int NT = __builtin_amdgcn_readfirstlane(texp[2 * MOE_TILES + s]);
                    pg8::MoeOrder S{NT, 0, 4, P.G, P.bid, (const LAS int*)(texp + s * MOE_TILES)};
                    pg8::EpiMoeScatter E{rowmap, (const float*)(P.ws + WS_PROW) + (size_t)s * MOE_ROWS, P.out, modlat + 5 * DM, 4};
                    pg8::gemm_phase<pg8::EpiMoeScatter, pg8::MoeOrder, pg8::RowsLinearOff, true, true>(GLDS(P), P.tid, P.ws + WS_P + (size_t)s * MOE_ROWS * DFE, WSB(P, WS_MD), DFE, S, E, pg8::RowsLinearOff{}, SCL_H, SCL_WD);
                } SEAM(17 + s);
            }
        }
}
__global__ void __launch_bounds__(512, 2) fwd_kernel(Params prm) {
    extern __shared__ __attribute__((aligned(16))) unsigned char lds_raw[];
    Frame F;
    F.lds = (LAS unsigned char*)lds_raw;
    F.tid = threadIdx.x; F.lane = F.tid & 63; F.wave = __builtin_amdgcn_readfirstlane(F.tid >> 6);
    F.G = gridDim.x; F.bid = blockIdx.x; F.vb = F.bid;
    F.in.ka = (karg_t)__builtin_amdgcn_kernarg_segment_ptr(); F.out = prm.out; F.ws = prm.ws;
    volatile LAS unsigned* MISC = (volatile LAS unsigned*)(F.lds + AUX_OFF);
    if (F.tid < 64) MISC[F.tid] = 0u;
    __syncthreads();
    XcdBarrier bar; bar.bar = (unsigned*)(prm.ws + WS_CTL) + 1024; bar.x = 0; bar.st = nullptr;
#if MK_PER_PHASE
    const int lo = prm.ph_lo, hi = prm.ph_hi;
#else
    constexpr int lo = 0, hi = N_PHASES;
#endif
    if (hi - lo > 1) bar = xcd_barrier_post((unsigned*)(prm.ws + WS_CTL) + 1024, MISC + 8);

    if (IN(0)) for (int rep_ = 0; rep_ < NREP(0); ++rep_) { if (rep_) __syncthreads(); Frame P = phase_frame(F); p0_prologue(P); } SEAM(0);
    layer_phases<0>(F, bar);
    layer_phases<1>(F, bar);
    if (IN(PH_FINAL)) { Frame P = phase_frame(F); final_phase(P); }
#undef IN
#undef SEAM
}

extern "C" void kernel_launch(void* const* d_in, const int* in_sizes, int n_in, void* d_out, int out_size, void* d_ws, size_t ws_size, hipStream_t stream) {
    static int grid = 0;
    if (grid == 0) {
        if (n_in != 26 || in_sizes[0] != NLAT * DM || out_size != NLAT * DM || ws_size < WS_END) {
            fprintf(stderr, "kernel_launch: unexpected shapes (n_in %d, in0 %d, out %d, ws %zu, need %zu); nothing launched\n", n_in, n_in > 0 ? in_sizes[0] : -1, out_size, ws_size, (size_t)WS_END); grid = -1; return; }
        int dev = 0, cus = 0, per_cu = 0;
        if (hipGetDevice(&dev) != hipSuccess || hipDeviceGetAttribute(&cus, hipDeviceAttributeMultiprocessorCount, dev) != hipSuccess) { grid = -1; return; }
        if (hipFuncSetAttribute((const void*)fwd_kernel, hipFuncAttributeMaxDynamicSharedMemorySize, LDS_BYTES) != hipSuccess) { fprintf(stderr, "kernel_launch: hipFuncSetAttribute failed\n"); grid = -1; return; }
        if (hipOccupancyMaxActiveBlocksPerMultiprocessor(&per_cu, (const void*)fwd_kernel, 512, LDS_BYTES) != hipSuccess || per_cu < 1)
            fprintf(stderr, "kernel_launch: note: occupancy query reports %d workgroups per CU\n", per_cu);
        (void)hipGetLastError();
        grid = cus;
    }
    if (grid < 0) return;
    if (hipMemsetAsync((char*)d_ws + WS_CTL, 0, CTL_ZERO_BYTES, stream) != hipSuccess) return;
    Params p{};
    for (int i = 0; i < 26; ++i) p.in[i] = (const float*)d_in[i];
    p.out = (float*)d_out; p.ws = (unsigned char*)d_ws;
#if MK_PER_PHASE
    for (int ph = 0; ph < N_PHASES; ++ph) { p.ph_lo = ph; p.ph_hi = ph + 1; hipLaunchKernelGGL(fwd_kernel, dim3(grid), dim3(512), LDS_BYTES, stream, p); }
#else
    p.ph_lo = 0; p.ph_hi = N_PHASES;
    hipLaunchKernelGGL(fwd_kernel, dim3(grid), dim3(512), LDS_BYTES, stream, p);
#endif
}
```

```cpp
#include <hip/hip_runtime.h>
#include <cstdio>
#include <cstdint>

#ifndef PROBE_SUB
#define PROBE_SUB 0
#endif
#ifndef MK_PER_PHASE
#define MK_PER_PHASE 0
#endif

#define LAS __attribute__((address_space(3)))
#define GAS __attribute__((address_space(1)))
#define DI __device__ __forceinline__
typedef unsigned short bf16;
typedef short bf16x8 __attribute__((ext_vector_type(8)));
typedef short s16x4 __attribute__((ext_vector_type(4)));
typedef float f32x4 __attribute__((ext_vector_type(4)));
typedef float f32x16 __attribute__((ext_vector_type(16)));
typedef unsigned u32x4 __attribute__((ext_vector_type(4)));
typedef unsigned u32x2 __attribute__((ext_vector_type(2)));
typedef float f32x2_t __attribute__((ext_vector_type(2)));
typedef __bf16 bf16x2_t __attribute__((ext_vector_type(2)));
typedef short v4i16_t __attribute__((ext_vector_type(4)));

constexpr int DM = 1024, NB = 16, SEQ = 2048, CTXL = 256, GW = 64;
constexpr int NLAT = NB * SEQ, NCTX = NB * CTXL, NTOK = NLAT + NCTX;
constexpr int INW = 3072, DFF = 2816, NE = 8, DFE = 3584;
constexpr int C_NAQ = 0, C_NAK = 512, C_NAV = 1024, C_CONV = 1536, C_RQ = 2048, C_RK = 2176, C_RV = 2304, C_GF = 2560, C_GB = 2816;
constexpr float EPS = 1e-6f;
constexpr float LOG2E = 1.4426950408889634f;

constexpr size_t MiB = 1u << 20;
constexpr size_t WS_CTL = 0, CTL_ZERO_BYTES = 64 * 1024;
constexpr size_t WS_MODLAT = 1 * MiB;
constexpr size_t WS_MODCTX = WS_MODLAT + 2 * 16 * 6144 * 4;
constexpr size_t WS_ROPE = WS_MODCTX + 2 * 6144 * 4;
constexpr size_t WS_PTOK = 2 * MiB;
constexpr size_t WS_SEGCNT = WS_PTOK + 32768 * 2 * 4;
constexpr size_t WS_META = WS_SEGCNT + 256 * 2 * 8 * 4;
constexpr size_t WS_SEGLIST = 3 * MiB;
constexpr size_t WS_ROWMAP = 5 * MiB;
constexpr int MOE_ROWS = 34816;
constexpr int MOE_TILES = MOE_ROWS / 256;
constexpr size_t WS_PROW = WS_ROWMAP + 512 * 1024;
constexpr size_t WS_SUMLAT = 6 * MiB;
constexpr size_t WS_SUMCTX = 22 * MiB;
constexpr size_t WS_WIN = 24 * MiB;
constexpr size_t WS_WOUT = WS_WIN + (size_t)2 * 3072 * 1024 * 2;
constexpr size_t WS_WGU = WS_WOUT + (size_t)2 * 1024 * 1024 * 2;
constexpr size_t WS_WD = WS_WGU + (size_t)5632 * 1024 * 2;
constexpr size_t WS_MGU = WS_WD + (size_t)1024 * 2816 * 2;
constexpr size_t WS_MD = WS_MGU + (size_t)8 * 7168 * 1024 * 2;
constexpr size_t WS_HCTX = WS_MD + (size_t)8 * 1024 * 3584 * 2;
constexpr size_t WS_U = WS_HCTX + (size_t)NCTX * DM * 4;
constexpr size_t WS_P = WS_U + (size_t)NTOK * DM * 2;
constexpr size_t WS_END = WS_P + (size_t)MOE_ROWS * DFE * 2;
static_assert((size_t)NTOK * INW * 2 <= (size_t)MOE_ROWS * DFE * 2, "P region: px | dense hidden | fp8 hidden of both MoE slots (2 x MOE_ROWS x DFE bytes)");
static_assert(WS_WIN % 256 == 0 && WS_WOUT % 256 == 0 && WS_WGU % 256 == 0 && WS_WD % 256 == 0 && WS_MGU % 256 == 0 && WS_MD % 256 == 0 && WS_HCTX % 256 == 0 && WS_U % 256 == 0 && WS_P % 256 == 0, "align");

constexpr int RING_BYTES = 131072;
constexpr int AUX_OFF = RING_BYTES;
constexpr int AUX_TAB = AUX_OFF + 1024;
constexpr int LDS_BYTES = 147456;

#ifndef MOE_FP8
#define MOE_FP8 1
#endif
#ifndef DENSE_FP8
#define DENSE_FP8 2
#endif
constexpr int SCL_U = 0x7c7c7c7c, SCL_WGU = 0x79797979, SCL_H = 0x7c7c7c7c, SCL_WD = 0x78787878;
constexpr float QS_U = 8.0f, QS_WGU = 64.0f, QS_H = 8.0f, QS_WD = 128.0f;
DI unsigned pk2(float lo, float hi) { f32x2_t v = {lo, hi}; bf16x2_t b = __builtin_convertvector(v, bf16x2_t); return __builtin_bit_cast(unsigned, b); }
DI float clamp448(float x) { return __builtin_fminf(__builtin_fmaxf(x, -448.0f), 448.0f); }
DI unsigned pk4_fp8(float a, float b, float c, float d) { int w = 0; w = __builtin_amdgcn_cvt_pk_fp8_f32(clamp448(a), clamp448(b), w, false); w = __builtin_amdgcn_cvt_pk_fp8_f32(clamp448(c), clamp448(d), w, true); return (unsigned)w; }
DI float bflo(unsigned u) { return __uint_as_float(u << 16); }
DI float bfhi(unsigned u) { return __uint_as_float(u & 0xffff0000u); }
DI float wave_sum(float v) {
#pragma unroll
    for (int o = 1; o < 64; o <<= 1) v += __shfl_xor(v, o);
    return v;
}
DI float fast_exp2(float x) { return __builtin_amdgcn_exp2f(x); }
DI float fast_rcp(float x) { return __builtin_amdgcn_rcpf(x); }
DI float sigmoidf_(float x) { return fast_rcp(1.0f + fast_exp2(-x * LOG2E)); }
DI int crow(int reg, int h) { return (reg & 3) + 8 * (reg >> 2) + 4 * h; }
#define MFMA32(a, b, c) __builtin_amdgcn_mfma_f32_32x32x16_bf16((a), (b), (c), 0, 0, 0)
DI s16x4 trread(LAS const unsigned char* p) { return __builtin_bit_cast(s16x4, __builtin_amdgcn_ds_read_tr16_b64_v4i16((LAS v4i16_t*)p)); }
DI int ld_i32_coherent(const int* p) { return (int)__hip_atomic_load((const unsigned*)p, __ATOMIC_RELAXED, __HIP_MEMORY_SCOPE_AGENT); }

namespace pg8 {
#define PG8_LAS __attribute__((address_space(3)))
typedef unsigned short bf16_t;
constexpr int BM = 256, BK = 64, HALF = 128, HTB = HALF * BK * 2, STAGE_BYTES = 8 * HTB, NXCD = 8, WGM = 8;
__host__ __device__ __forceinline__ int lds_byte(int r, int c) { const int st = (r >> 4) * 2 + (c >> 5), rr = r & 15, cc = c & 31, ob = rr * 64 + cc * 2; return st * 1024 + (ob ^ (((ob >> 9) & 1) << 5)); }
__host__ __device__ __forceinline__ void stage_rc(int b, int& R, int& C) { const int st = b / 1024, sb = b % 1024, swz = sb ^ (((sb >> 9) & 1) << 5); R = (st >> 1) * 16 + swz / 64; C = (st & 1) * 32 + (swz % 64) / 2; }
__host__ __device__ __forceinline__ int perm32(int rho) { const int n = rho >> 4, i = rho & 15; return 8 * (i >> 2) + 4 * n + (i & 3); }
struct Unit { int pm, pn; };
struct StaticOrder {
    int nM, nN, nwg, G, c;
    __device__ void init(int M, int N, int G_, int c_) { nM = M / BM; nN = N / BM; nwg = nM * nN; G = G_; c = c_; }
    __device__ bool next(int i, Unit& u) const {
        const long L = (long)i * G + c; if (L >= nwg) return false;
        int wgid = (int)L; { const int q = nwg / NXCD, r = nwg % NXCD, xcd = wgid % NXCD, off = wgid / NXCD; wgid = (xcd < r ? xcd * (q + 1) : r * (q + 1) + (xcd - r) * q) + off; }
        const int nig = WGM * nN, gid = wgid / nig, fm = gid * WGM, gsz = (nM - fm) < WGM ? (nM - fm) : WGM;
        u.pm = fm + ((wgid % nig) % gsz); u.pn = (wgid % nig) / gsz; return true;
    }
};
struct RowsLinear { static constexpr bool GATHER = false; };
struct RowsLinearOff {
    static constexpr bool GATHER = true;
    __device__ __forceinline__ void fetch(const Unit& u, const int (&R)[2], int (&raw)[2][2]) const {
#pragma unroll
        for (int h = 0; h < 2; ++h)
#pragma unroll
            for (int i = 0; i < 2; ++i) raw[h][i] = u.pm * BM + h * HALF + R[i];
    }
    __device__ __forceinline__ void make(const int (&raw)[2][2], const int (&C)[2], int pitch, unsigned (&o)[2][2]) const {
#pragma unroll
        for (int h = 0; h < 2; ++h)
#pragma unroll
            for (int i = 0; i < 2; ++i) { o[h][i] = (unsigned)raw[h][i] * (unsigned)pitch + (unsigned)C[i] * 2u; asm volatile("" : "+v"(o[h][i])); }
    }
};
struct RowsGather {
    static constexpr bool GATHER = true;
    const int* rowmap; int row_add;
    __device__ __forceinline__ void fetch(const Unit& u, const int (&R)[2], int (&raw)[2][2]) const {
#pragma unroll
        for (int h = 0; h < 2; ++h)
#pragma unroll
            for (int i = 0; i < 2; ++i) raw[h][i] = rowmap[u.pm * BM + h * HALF + R[i]];
    }
    __device__ __forceinline__ void make(const int (&raw)[2][2], const int (&C)[2], int pitch, unsigned (&o)[2][2]) const {
#pragma unroll
        for (int h = 0; h < 2; ++h)
#pragma unroll
            for (int i = 0; i < 2; ++i) { int t = raw[h][i]; t = t < 0 ? 0 : t; o[h][i] = (unsigned)((size_t)(t + row_add) * (size_t)pitch + (size_t)C[i] * 2u); }
#pragma unroll
        for (int h = 0; h < 2; ++h)
#pragma unroll
            for (int i = 0; i < 2; ++i) asm volatile("" : "+v"(o[h][i]));
    }
};

typedef int i32x8 __attribute__((ext_vector_type(8)));
typedef int i32x4v __attribute__((ext_vector_type(4)));
template <class Epi, class Sched, class ARows, bool ALIGN_EPI, bool FP8 = false>
__device__ __forceinline__ void gemm_phase(PG8_LAS unsigned char* lds, int tid, const void* A, const void* Bt, int pitch, const Sched& S, const Epi& E, const ARows& AR, int sclA = 0x7f7f7f7f, int sclB = 0x7f7f7f7f) {
    constexpr bool GATHER = ARows::GATHER;
    const int wid = __builtin_amdgcn_readfirstlane(tid >> 6), lane = tid & 63, wr = wid >> 2, wc = wid & 3, fr = lane & 15, fq = lane >> 4;
    const int nt = pitch / (BK * 2);
    int RA[2], CA[2]; unsigned voffA[2], voffB[2];
#pragma unroll
    for (int i = 0; i < 2; ++i) { int R, C; stage_rc(tid * 16 + i * 8192, R, C); const int Rb = Epi::PERM ? ((R & ~31) + perm32(R & 31)) : R;
        RA[i] = R; CA[i] = C; voffA[i] = (unsigned)(R * pitch + C * 2); voffB[i] = (unsigned)(Rb * pitch + C * 2); }
#pragma unroll
    for (int i = 0; i < 2; ++i) { asm volatile("" : "+v"(voffA[i])); asm volatile("" : "+v"(voffB[i])); }
    const size_t kstep = (size_t)(BK * 2);
    const size_t hstep = (size_t)HALF * pitch;
    const size_t tstep = 2 * hstep;
    const unsigned ldsw = (unsigned)wid * 1024u;
    const int aoff = lds_byte(wr * 64 + fr, fq * 8), boff = lds_byte(wc * 32 + fr, fq * 8);
    const char* Ab = (const char*)A;
#define PG8_SA(b, h) (((b) * 2 + (h)) * HTB)
#define PG8_SB(b, h) ((4 + (b) * 2 + (h)) * HTB)
#define PG8_STAGE(bufoff, gbase, voff) do { _Pragma("unroll") for (int _i = 0; _i < 2; ++_i) \
        __builtin_amdgcn_global_load_lds((const unsigned*)((const char*)(gbase) + (voff)[_i]), (PG8_LAS unsigned*)(lds + (bufoff) + ldsw + _i * 8192), 16, 0, 0); } while (0)
#define PG8_STAGEA(bufoff, h, plin, kb) do { if constexpr (GATHER) PG8_STAGE(bufoff, Ab + (kb), curA[h]); else PG8_STAGE(bufoff, (plin) + (h) * hstep, voffA); } while (0)
#define PG8_LDA(dst, b, h) do { _Pragma("unroll") for (int m = 0; m < 4; ++m) _Pragma("unroll") for (int k = 0; k < 2; ++k) dst[m][k] = *(const PG8_LAS bf16x8*)(lds + PG8_SA(b, h) + aoff + m * 2048 + k * 1024); } while (0)
#define PG8_LDB(dst, b, h) do { _Pragma("unroll") for (int n = 0; n < 2; ++n) _Pragma("unroll") for (int k = 0; k < 2; ++k) dst[n][k] = *(const PG8_LAS bf16x8*)(lds + PG8_SB(b, h) + boff + n * 2048 + k * 1024); } while (0)
#define PG8_CAT(x0, x1) __builtin_shufflevector(__builtin_bit_cast(i32x4v, x0), __builtin_bit_cast(i32x4v, x1), 0, 1, 2, 3, 4, 5, 6, 7)
#define PG8_MMA(ai, bj, At, Bt_) do { __builtin_amdgcn_s_setprio(1); \
        if constexpr (FP8) { _Pragma("unroll") for (int m = 0; m < 4; ++m) _Pragma("unroll") for (int n = 0; n < 2; ++n) \
            acc[ai][bj][m][n] = __builtin_amdgcn_mfma_scale_f32_16x16x128_f8f6f4(PG8_CAT(Bt_[n][0], Bt_[n][1]), PG8_CAT(At[m][0], At[m][1]), acc[ai][bj][m][n], 0, 0, 0, sclB, 0, sclA); } \
        else { _Pragma("unroll") for (int m = 0; m < 4; ++m) _Pragma("unroll") for (int n = 0; n < 2; ++n) _Pragma("unroll") for (int k = 0; k < 2; ++k) \
            acc[ai][bj][m][n] = __builtin_amdgcn_mfma_f32_16x16x32_bf16(Bt_[n][k], At[m][k], acc[ai][bj][m][n], 0, 0, 0); } \
        __builtin_amdgcn_s_setprio(0); } while (0)
#define PG8_WAIT_V(n) asm volatile("s_waitcnt vmcnt(" #n ")" ::: "memory")
#define PG8_WAIT_L(n) asm volatile("s_waitcnt lgkmcnt(" #n ")" ::: "memory")
#define PG8_BAR __builtin_amdgcn_s_barrier()
#define PG8_SCHED __builtin_amdgcn_sched_barrier(0)
    Unit cur, nxt; int ui = 0;
    if (!S.next(0, cur)) return;
    f32x4 acc[2][2][4][2];
#pragma unroll
    for (int a = 0; a < 2; ++a)
#pragma unroll
        for (int b = 0; b < 2; ++b)
#pragma unroll
            for (int m = 0; m < 4; ++m)
#pragma unroll
                for (int n = 0; n < 2; ++n) acc[a][b][m][n] = (f32x4){0.f, 0.f, 0.f, 0.f};
    bf16x8 At[4][2], B0[2][2], B1[2][2];
    unsigned curA[2][2] = {{0u, 0u}, {0u, 0u}}, nxtA[2][2] = {{0u, 0u}, {0u, 0u}};
    int rawN[2][2] = {{0, 0}, {0, 0}};
    if constexpr (GATHER) { int rawC[2][2]; AR.fetch(cur, RA, rawC); AR.make(rawC, CA, pitch, curA); Unit n1; if (S.next(1, n1)) AR.fetch(n1, RA, rawN); }
    const char* cA = GATHER ? Ab : Ab + (size_t)cur.pm * tstep;
    const char* cB = (const char*)Bt + (size_t)cur.pn * tstep;
    PG8_STAGE(PG8_SB(0, 0), cB, voffB); PG8_STAGE(PG8_SB(0, 1), cB + hstep, voffB); PG8_STAGEA(PG8_SA(0, 0), 0, cA, 0); PG8_STAGEA(PG8_SA(0, 1), 1, cA, 0);
    if (wr == 1) PG8_BAR;
    PG8_WAIT_V(2); PG8_BAR;
    PG8_STAGE(PG8_SB(1, 0), cB + kstep, voffB); PG8_STAGEA(PG8_SA(1, 0), 0, cA + kstep, kstep); PG8_STAGE(PG8_SB(1, 1), cB + hstep + kstep, voffB);
    PG8_WAIT_V(6); PG8_BAR;
    for (;;) {
        const bool has_next = S.next(ui + 1, nxt);
        if constexpr (GATHER) {
            if (has_next) { AR.make(rawN, CA, pitch, nxtA); Unit n2; if (S.next(ui + 2, n2)) AR.fetch(n2, RA, rawN); }
            else {
#pragma unroll
                for (int h = 0; h < 2; ++h)
#pragma unroll
                    for (int i = 0; i < 2; ++i) nxtA[h][i] = curA[h][i];
            }
        }
        const char* nA = GATHER ? Ab : (has_next ? Ab + (size_t)nxt.pm * tstep : cA);
        const char* nB = has_next ? (const char*)Bt + (size_t)nxt.pn * tstep : cB;
        for (int t = 0; t < nt; t += 2) {
            const bool last = (t == nt - 2);
            const size_t k1 = (size_t)(t + 1) * kstep, k2 = last ? 0 : (size_t)(t + 2) * kstep, k3 = k2 + kstep;
            const char* a1 = cA + k1;
            const char* a2 = last ? nA : cA + k2; const char* b2 = last ? nB : cB + k2;
            const char* a3 = a2 + kstep; const char* b3 = b2 + kstep;
            PG8_LDB(B0, 0, 0); PG8_LDB(B1, 0, 1); PG8_SCHED; PG8_LDA(At, 0, 0); PG8_STAGEA(PG8_SA(1, 1), 1, a1, k1);
            if constexpr (GATHER) { if (last) {
#pragma unroll
                for (int h = 0; h < 2; ++h)
#pragma unroll
                    for (int i = 0; i < 2; ++i) curA[h][i] = nxtA[h][i]; } }
            PG8_WAIT_V(8); PG8_WAIT_L(0); PG8_BAR; PG8_MMA(0, 0, At, B0); PG8_MMA(0, 1, At, B1); PG8_BAR; PG8_SCHED;
            PG8_LDA(At, 0, 1); PG8_STAGE(PG8_SB(0, 0), b2, voffB); PG8_STAGE(PG8_SB(0, 1), b2 + hstep, voffB); PG8_STAGEA(PG8_SA(0, 0), 0, a2, k2);
            PG8_WAIT_V(8); PG8_WAIT_L(0); PG8_BAR; PG8_MMA(1, 0, At, B0); PG8_MMA(1, 1, At, B1); PG8_BAR; PG8_SCHED;
            PG8_LDB(B0, 1, 0); PG8_LDB(B1, 1, 1); PG8_SCHED; PG8_LDA(At, 1, 0); PG8_STAGEA(PG8_SA(0, 1), 1, a2, k2);
            PG8_WAIT_V(8); PG8_WAIT_L(0); PG8_BAR; PG8_MMA(0, 0, At, B0); PG8_MMA(0, 1, At, B1); PG8_BAR; PG8_SCHED;
            PG8_LDA(At, 1, 1); PG8_STAGE(PG8_SB(1, 0), b3, voffB); PG8_STAGE(PG8_SB(1, 1), b3 + hstep, voffB); PG8_STAGEA(PG8_SA(1, 0), 0, a3, k3);
            PG8_WAIT_V(8); PG8_WAIT_L(0); PG8_BAR; PG8_MMA(1, 0, At, B0); PG8_MMA(1, 1, At, B1); PG8_BAR; PG8_SCHED;
        }
        if constexpr (ALIGN_EPI) { if (wr == 0) PG8_BAR; }
        E(acc, cur, wr, wc, fr, fq);
        if (!has_next) break;
#pragma unroll
        for (int a = 0; a < 2; ++a)
#pragma unroll
            for (int b = 0; b < 2; ++b)
#pragma unroll
                for (int m = 0; m < 4; ++m)
#pragma unroll
                    for (int n = 0; n < 2; ++n) acc[a][b][m][n] = (f32x4){0.f, 0.f, 0.f, 0.f};
        cur = nxt; cA = nA; cB = nB; ++ui;
        if constexpr (ALIGN_EPI) { if (wr == 1) PG8_BAR; }
    }
    PG8_WAIT_V(0);
    if constexpr (!ALIGN_EPI) { if (wr == 0) PG8_BAR; }
    PG8_BAR;
#undef PG8_SA
#undef PG8_SB
#undef PG8_STAGE
#undef PG8_STAGEA
#undef PG8_LDA
#undef PG8_LDB
#undef PG8_MMA
#undef PG8_CAT
#undef PG8_WAIT_V
#undef PG8_WAIT_L
#undef PG8_BAR
#undef PG8_SCHED
}

#define PG8_OPAQUE(x) asm volatile("" : "+v"(x))
struct EpiNull { static constexpr bool PERM = true; __device__ __forceinline__ void operator()(const f32x4 (&acc)[2][2][4][2], const Unit& u, int wr, int wc, int fr, int fq) const { if (u.pm < 0) {
#pragma unroll
        for (int a = 0; a < 2; ++a)
#pragma unroll
            for (int b = 0; b < 2; ++b)
#pragma unroll
                for (int m = 0; m < 4; ++m)
#pragma unroll
                    for (int n = 0; n < 2; ++n) asm volatile("" :: "v"(acc[a][b][m][n])); } } };
struct EpiStoreBf16 {
    static constexpr bool PERM = true;
    bf16_t* O; int ldc;
    __device__ __forceinline__ void operator()(const f32x4 (&acc)[2][2][4][2], const Unit& u, int wr, int wc, int fr, int fq) const {
        char* base = (char*)(O + (size_t)(u.pm * BM) * ldc + u.pn * BM);
        unsigned lb = (unsigned)((wr * 64 + fr) * ldc + wc * 32 + 8 * fq) * 2u; PG8_OPAQUE(lb);
        const unsigned rstep = (unsigned)ldc * 32u;
#pragma unroll
        for (int ai = 0; ai < 2; ++ai)
#pragma unroll
            for (int m = 0; m < 4; ++m) { const unsigned ro = lb + (unsigned)(ai * 8 + m) * rstep;
#pragma unroll
                for (int bj = 0; bj < 2; ++bj) { const f32x4 v0 = acc[ai][bj][m][0], v1 = acc[ai][bj][m][1];
                    u32x4 w; w.x = pk2(v0[0], v0[1]); w.y = pk2(v0[2], v0[3]); w.z = pk2(v1[0], v1[1]); w.w = pk2(v1[2], v1[3]);
                    *(u32x4*)(base + ro + bj * (HALF * 2)) = w; } }
    }
};
struct EpiResGate {
    static constexpr bool PERM = false;
    const float* src_ctx; const float* src_lat; float* dst_ctx; float* dst_lat; const float* gate_lat; const float* gate_ctx; int row_base;
    __device__ __forceinline__ void operator()(const f32x4 (&acc)[2][2][4][2], const Unit& u, int wr, int wc, int fr, int fq) const {
        const int rowu = row_base + u.pm * BM; const bool isctx = rowu < NCTX;
        const char* src = (const char*)(isctx ? src_ctx + (size_t)rowu * DM : src_lat + (size_t)(rowu - NCTX) * DM) + u.pn * (BM * 4);
        char* dst = (char*)(isctx ? dst_ctx + (size_t)rowu * DM : dst_lat + (size_t)(rowu - NCTX) * DM) + u.pn * (BM * 4);
        const float* gate = (isctx ? gate_ctx : gate_lat + (size_t)((rowu - NCTX) / SEQ) * 6144) + u.pn * BM;
        const int cl = wc * 32 + 4 * fq;
        f32x4 sc[2][2][4][2];
#pragma unroll
        for (int bj = 0; bj < 2; ++bj)
#pragma unroll
            for (int n = 0; n < 2; ++n) { const f32x4 gv = *(const f32x4*)(gate + cl + bj * HALF + n * 16);
#pragma unroll
                for (int ai = 0; ai < 2; ++ai)
#pragma unroll
                    for (int m = 0; m < 4; ++m) sc[ai][bj][m][n] = acc[ai][bj][m][n] * gv; }
        unsigned lb = (unsigned)((wr * 64 + fr) * DM + cl) * 4u; PG8_OPAQUE(lb);
#pragma unroll
        for (int ai = 0; ai < 2; ++ai)
#pragma unroll
            for (int m = 0; m < 4; ++m) { const unsigned ro = lb + (unsigned)(ai * 8 + m) * (16u * DM * 4u);
#pragma unroll
                for (int bj = 0; bj < 2; ++bj)
#pragma unroll
                    for (int n = 0; n < 2; ++n) { const unsigned o = ro + (unsigned)(bj * HALF + n * 16) * 4u; const f32x4 s = *(const f32x4*)(src + o);
                        *(f32x4*)(dst + o) = s + sc[ai][bj][m][n]; }
                asm volatile("" ::: "memory"); }
    }
};
template <bool MOE> struct EpiSwiglu {
    static constexpr bool PERM = true;
    static constexpr bool OUT8 = MOE ? (MOE_FP8 != 0) : (DENSE_FP8 != 0);
    bf16_t* O; int ldc; int ncol; const float* prow;
    __device__ __forceinline__ void operator()(const f32x4 (&acc)[2][2][4][2], const Unit& u, int wr, int wc, int fr, int fq) const {
        const int pnl = MOE ? (u.pn % ncol) : u.pn;
        constexpr int ES = OUT8 ? 1 : 2;
        char* base = (char*)O + ((size_t)(u.pm * BM) * ldc + pnl * HALF) * ES;
        unsigned lb = (unsigned)((wr * 64 + fr) * ldc + wc * 32 + 8 * fq) * ES; PG8_OPAQUE(lb);
        const unsigned rstep = (unsigned)ldc * 16u * ES;
#pragma unroll
        for (int ai = 0; ai < 2; ++ai)
#pragma unroll
            for (int m = 0; m < 4; ++m) {
                const float pw = OUT8 ? QS_H : 1.0f;
                float hv[8];
#pragma unroll
                for (int n = 0; n < 2; ++n)
#pragma unroll
                    for (int jp = 0; jp < 2; ++jp) { const f32x2_t g = {acc[ai][0][m][n][2 * jp], acc[ai][0][m][n][2 * jp + 1]}, up = {acc[ai][1][m][n][2 * jp], acc[ai][1][m][n][2 * jp + 1]};
                        const f32x2_t a = g * (-LOG2E); f32x2_t d; d.x = fast_exp2(a.x); d.y = fast_exp2(a.y); d = d + 1.0f;
                        f32x2_t r; r.x = fast_rcp(d.x); r.y = fast_rcp(d.y);
                        const f32x2_t hh = (g * up) * (r * pw); hv[n * 4 + 2 * jp] = hh.x; hv[n * 4 + 2 * jp + 1] = hh.y; }
                if constexpr (OUT8) { u32x2 w; w.x = pk4_fp8(hv[0], hv[1], hv[2], hv[3]); w.y = pk4_fp8(hv[4], hv[5], hv[6], hv[7]);
                    *(u32x2*)(base + lb + (unsigned)(ai * 8 + m) * rstep) = w; }
                else { u32x4 w; w.x = pk2(hv[0], hv[1]); w.y = pk2(hv[2], hv[3]); w.z = pk2(hv[4], hv[5]); w.w = pk2(hv[6], hv[7]);
                    *(u32x4*)(base + lb + (unsigned)(ai * 8 + m) * rstep) = w; } }
    }
};
struct EpiMoeScatter {
    static constexpr bool PERM = false;
    const int* rowmap; const float* prow; float* hlat; bf16_t* y1; const float* gate_lat; int ncol;
    __device__ __forceinline__ void operator()(const f32x4 (&acc)[2][2][4][2], const Unit& u, int wr, int wc, int fr, int fq) const {
        const int pnl = u.pn % ncol; const bool slot1 = u.pm >= MOE_TILES;
        const int* rm = rowmap + u.pm * BM; const float* pr = prow + u.pm * BM;
        char* hb = (char*)hlat + pnl * (BM * 4); const char* gb = (const char*)gate_lat + pnl * (BM * 4); char* yb = (char*)y1 + pnl * (BM * 2);
        unsigned pl = (unsigned)(wr * 64 + fr) * 4u; PG8_OPAQUE(pl);
        unsigned cb = (unsigned)(wc * 32 + 4 * fq) * 4u; PG8_OPAQUE(cb);
#pragma unroll
        for (int ai = 0; ai < 2; ++ai)
#pragma unroll
            for (int m = 0; m < 4; ++m) { const int tok = *(const int*)((const char*)rm + pl + (unsigned)(ai * 8 + m) * 64u);
                if (tok >= 0) { const float pw = *(const float*)((const char*)pr + pl + (unsigned)(ai * 8 + m) * 64u); const unsigned ro = (unsigned)tok * (DM * 4u) + cb, go = ((unsigned)tok >> 11) * (6144u * 4u) + cb;
#pragma unroll
                    for (int bj = 0; bj < 2; ++bj)
#pragma unroll
                        for (int n = 0; n < 2; ++n) { const unsigned o = (unsigned)(bj * HALF + n * 16) * 4u; const f32x4 gv = *(const f32x4*)(gb + go + o); const f32x4 t = (acc[ai][bj][m][n] * pw) * gv;
                            if (slot1) { u32x2 w; w.x = pk2(t[0], t[1]); w.y = pk2(t[2], t[3]); *(u32x2*)(yb + (ro >> 1) + (o >> 1)) = w; }
                            else { const f32x4 sv = *(const f32x4*)(hb + ro + o); *(f32x4*)(hb + ro + o) = sv + t; } } }
                asm volatile("" ::: "memory"); }
    }
};
struct MoeOrder {
    int NT0, NT1, ncol, G, c; const PG8_LAS int* texp;
    __device__ bool next(int i, Unit& u) const {
        const long L = (long)i * G + c; if (L >= (long)(NT0 + NT1) * ncol) return false;
        const int tq = (int)(L / ncol), pnl = (int)(L % ncol);
        const int T = tq < NT0 ? tq : MOE_TILES + tq - NT0;
        const int e = __builtin_amdgcn_readfirstlane(texp[T]);
        u.pm = T; u.pn = e * ncol + pnl; return true;
    }
};
}

#define XB_TMO      128
#define XB_XCNT(j)  (256  + 64 * (j))
#define XB_XSUB(j)  (1280 + 64 * (j))
#define XB_XGEN(j)  (2304 + 64 * (j))
#define XB_TOP      3328
#define XB_TOPGEN   3392
#define XCD_BAR_WORDS 3456
#define XB_SPIN_CAP (1u << 18)
DI unsigned xb_ld(unsigned* p)              { return __hip_atomic_load(p, __ATOMIC_RELAXED, __HIP_MEMORY_SCOPE_AGENT); }
DI unsigned xb_add(unsigned* p, unsigned v) { return __hip_atomic_fetch_add(p, v, __ATOMIC_RELAXED, __HIP_MEMORY_SCOPE_AGENT); }
DI unsigned xb_xcc_id() { return (unsigned)__builtin_amdgcn_s_getreg((3 << 11) | 20) & 0xFu; }
#define XB_SPIN(cond, bar) do { unsigned _sp = 0; while (cond) { __builtin_amdgcn_s_sleep(1); \
    if ((++_sp & 255u) == 0u) { if (xb_ld(&(bar)[XB_TMO])) break; if (_sp > XB_SPIN_CAP) { atomicAdd(&(bar)[XB_TMO], 1u); break; } } } } while (0)
struct XcdBarrier { unsigned* bar; unsigned x; volatile LAS unsigned* st; };
DI XcdBarrier xcd_barrier_post(unsigned* bar, volatile LAS unsigned* st) {
    XcdBarrier b; b.bar = bar; b.x = xb_xcc_id(); b.st = st;
    if (threadIdx.x == 0) (void)xb_add(&bar[XB_XCNT(b.x)], 1u);
    return b;
}
DI void xcd_barrier_complete(unsigned* bar, unsigned x, unsigned& nloc, unsigned& nx) {
    const unsigned G = gridDim.x * gridDim.y * gridDim.z;
    unsigned sum, cnt, mine, sp = 0u;
    for (;;) {
        sum = 0u; cnt = 0u; mine = 0u;
#pragma unroll
        for (unsigned j = 0; j < 16; ++j) { const unsigned c = xb_ld(&bar[XB_XCNT(j)]); sum += c; cnt += (c > 0u) ? 1u : 0u; mine = (j == x) ? c : mine; }
        if (sum == G) break;
        __builtin_amdgcn_s_sleep(1);
        if ((++sp & 255u) == 0u) { if (xb_ld(&bar[XB_TMO])) break; if (sp > XB_SPIN_CAP) { atomicAdd(&bar[XB_TMO], 1u); break; } }
    }
    nloc = mine > 0u ? mine : 1u; nx = cnt > 0u ? cnt : 1u;
}
DI void xcd_barrier(const XcdBarrier& b, int wave) {
    asm volatile("s_waitcnt vmcnt(0)" ::: "memory");
    __syncthreads();
    if (wave == 0 && __builtin_amdgcn_mbcnt_hi(~0u, __builtin_amdgcn_mbcnt_lo(~0u, 0u)) == 0u) {
        unsigned* bar = b.bar;
        __builtin_amdgcn_s_waitcnt(0);
        unsigned nloc = b.st[0], nx = b.st[1];
        if (nloc == 0u) { xcd_barrier_complete(bar, b.x, nloc, nx); b.st[0] = nloc; b.st[1] = nx; }
        const unsigned old = xb_add(&bar[XB_XSUB(b.x)], 1u);
        const unsigned gen = old / nloc;
        if (old + 1u == (gen + 1u) * nloc) {
            __builtin_amdgcn_fence(__ATOMIC_RELEASE, "agent");
            asm volatile("s_waitcnt vmcnt(0)" ::: "memory");
            const unsigned og = xb_add(&bar[XB_TOP], 1u);
            const unsigned tg = og / nx;
            if (og + 1u == (tg + 1u) * nx) xb_add(&bar[XB_TOPGEN], 1u);
            else XB_SPIN(xb_ld(&bar[XB_TOPGEN]) == tg, bar);
            __builtin_amdgcn_fence(__ATOMIC_ACQUIRE, "agent");
            xb_add(&bar[XB_XGEN(b.x)], 1u);
            asm volatile("s_waitcnt vmcnt(0)" ::: "memory");
        } else {
            XB_SPIN(xb_ld(&bar[XB_XGEN(b.x)]) == gen, bar);
            __builtin_amdgcn_fence(__ATOMIC_ACQUIRE, "agent");
            asm volatile("s_waitcnt vmcnt(0)" ::: "memory");
        }
    }
    __syncthreads();
}

struct Params { const float* in[26]; float* out; unsigned char* ws; int ph_lo, ph_hi, pad0, pad1; };
enum { I_X = 0, I_C, I_CTX, I_CCTX, I_WMOD, I_BMOD, I_N1W, I_N2W, I_WIN, I_WOUT, I_RPB, I_CONVW, I_CONVB, I_CLNW, I_CLNB, I_RDEC, I_RGNW,
       I_FG, I_FU, I_FD, I_MR, I_MRB, I_MG, I_MU, I_MDN, I_FNW };
constexpr int PH_P0 = 0, PH_FINAL = 18, N_PHASES = 19;

typedef __attribute__((address_space(4))) const unsigned char* karg_t;
struct KIn {
    karg_t ka;
    DI const float* operator[](int k) const { return *(const float* __attribute__((address_space(4))) const*)(ka + 8 * k); }
};
struct Frame {
    LAS unsigned char* lds;
    int tid, lane, wave, G, bid, vb;
    KIn in; float* out; unsigned char* ws;
};
DI Frame phase_frame(const Frame& F0) {
    Frame F; karg_t ka = F0.in.ka; asm volatile("" : "+s"(ka)); F.in.ka = ka;
    F.out = *(float* __attribute__((address_space(4))) const*)(ka + 208);
    F.ws = *(unsigned char* __attribute__((address_space(4))) const*)(ka + 216);
    int wv = F0.wave; asm volatile("" : "+s"(wv));
    int tid = (wv << 6) + (int)__builtin_amdgcn_mbcnt_hi(~0u, __builtin_amdgcn_mbcnt_lo(~0u, 0u)), G = F0.G, bid = F0.bid; unsigned ldsb = (unsigned)(size_t)F0.lds;
    asm volatile("" : "+v"(tid)); asm volatile("" : "+s"(G)); asm volatile("" : "+s"(bid)); asm volatile("" : "+s"(ldsb));
    F.tid = tid; F.lane = tid & 63; F.wave = __builtin_amdgcn_readfirstlane(tid >> 6); F.G = G; F.bid = bid; F.lds = (LAS unsigned char*)(size_t)ldsb;
    F.vb = (G % 8 == 0) ? (bid % 8) * (G / 8) + bid / 8 : bid;
    return F;
}

DI void p0_transpose_item(const float* W, int K, int N, bf16* WT, int k0, int n0, int dst_row0, LAS float* scr, int lane) {
#pragma unroll 8
    for (int i = 0; i < 32; ++i) { const int kk = 2 * i + (lane >> 5); scr[kk * 33 + (lane & 31)] = W[(size_t)(k0 + kk) * N + n0 + (lane & 31)]; }
    asm volatile("s_waitcnt lgkmcnt(0)" ::: "memory");
    const int c = lane & 7;
#pragma unroll
    for (int j = 0; j < 4; ++j) { const int n = (lane >> 3) + 8 * j; const LAS float* s = scr + (8 * c) * 33 + n;
        u32x4 o; o.x = pk2(s[0 * 33], s[1 * 33]); o.y = pk2(s[2 * 33], s[3 * 33]); o.z = pk2(s[4 * 33], s[5 * 33]); o.w = pk2(s[6 * 33], s[7 * 33]);
        *(u32x4*)(WT + (size_t)(dst_row0 + n) * K + k0 + 8 * c) = o; }
    asm volatile("s_waitcnt lgkmcnt(0)" ::: "memory");
}
DI void p0_convert_plain(Frame& F, const float* W, int K, int N, bf16* WT, int item, LAS float* scr) {
    const int nblk = N / 32, kb = item / nblk, nb = item % nblk;
    p0_transpose_item(W, K, N, WT, 64 * kb, 32 * nb, 32 * nb, scr, F.lane);
}
DI void p0_convert_gu(Frame& F, const float* W, int K, int N, bf16* WT, int item, int up, LAS float* scr) {
    const int nblk = N / 32, kb = item / nblk, nb = item % nblk, n0 = 32 * nb;
    p0_transpose_item(W, K, N, WT, 64 * kb, n0, 256 * (n0 / 128) + (n0 % 128) + (up ? 128 : 0), scr, F.lane);
}
DI void conv_item64(const float* W, int K, int N, bf16* WT, int k0, int n0, int dst_row0, LAS unsigned* scr, int lane) {
    const float* wp = W + (size_t)k0 * N + n0 + lane;
    float v[64];
#pragma unroll
    for (int i = 0; i < 64; ++i) v[i] = wp[(size_t)i * N];
#pragma unroll
    for (int i = 0; i < 32; ++i) scr[i * 65 + lane] = pk2(v[2 * i], v[2 * i + 1]);
    asm volatile("s_waitcnt lgkmcnt(0)" ::: "memory");
    const int c = lane & 7;
#pragma unroll
    for (int j = 0; j < 8; ++j) { const int n = (lane >> 3) + 8 * j; const LAS unsigned* sp = scr + (4 * c) * 65 + n;
        u32x4 o; o.x = sp[0]; o.y = sp[65]; o.z = sp[130]; o.w = sp[195];
        *(u32x4*)(WT + (size_t)(dst_row0 + n) * K + k0 + 8 * c) = o; }
    asm volatile("s_waitcnt lgkmcnt(0)" ::: "memory");
}
DI void conv_item64_fp8(const float* W, int K, int N, unsigned char* WT, int k0, int n0, int dst_row0, float qs, LAS unsigned* scr, int lane) {
    const float* wp = W + (size_t)k0 * N + n0 + lane;
    float v[64];
#pragma unroll
    for (int i = 0; i < 64; ++i) v[i] = wp[(size_t)i * N];
#pragma unroll
    for (int i = 0; i < 16; ++i) scr[i * 65 + lane] = pk4_fp8(v[4 * i] * qs, v[4 * i + 1] * qs, v[4 * i + 2] * qs, v[4 * i + 3] * qs);
    asm volatile("s_waitcnt lgkmcnt(0)" ::: "memory");
    const int c = lane & 3;
#pragma unroll
    for (int j = 0; j < 4; ++j) { const int n = (lane >> 2) + 16 * j; const LAS unsigned* sp = scr + (4 * c) * 65 + n;
        u32x4 o; o.x = sp[0]; o.y = sp[65]; o.z = sp[130]; o.w = sp[195];
        *(u32x4*)(WT + (size_t)(dst_row0 + n) * K + k0 + 16 * c) = o; }
    asm volatile("s_waitcnt lgkmcnt(0)" ::: "memory");
}
constexpr int BG_ITEMS = 21504;
constexpr int BG_B0 = 0, BG_D0 = 1200, BG_E0 = 5200, BG_F0 = 8700, BG_B1 = 19700, BG_CL = 20900;
DI void bg_item(Frame& F, int g, LAS unsigned* scr) {
    if (g < 14336) { const int m = g / 896, e = m >> 1, up = m & 1, r = g % 896, kb = r / 56, nb = r % 56, n0 = 64 * nb; const int drow = 256 * (n0 / 128) + (n0 % 128) + (up ? 128 : 0);
#if MOE_FP8
        conv_item64_fp8(F.in[up ? I_MU : I_MG] + (size_t)e * 1024 * 3584, 1024, 3584, F.ws + WS_MGU + (size_t)e * 7168 * 1024, 64 * kb, n0, drow, QS_WGU, scr, F.lane);
#else
        conv_item64(F.in[up ? I_MU : I_MG] + (size_t)e * 1024 * 3584, 1024, 3584, (bf16*)(F.ws + WS_MGU) + (size_t)e * 7168 * 1024, 64 * kb, n0, drow, scr, F.lane);
#endif
    } else { const int gg = g - 14336, e = gg / 896, r = gg % 896, kb = r / 16, nb = r % 16;
#if MOE_FP8
        conv_item64_fp8(F.in[I_MDN] + (size_t)e * 3584 * 1024, 3584, 1024, F.ws + WS_MD + (size_t)e * 1024 * 3584, 64 * kb, 64 * nb, 64 * nb, QS_WD, scr, F.lane);
#else
        conv_item64(F.in[I_MDN] + (size_t)e * 3584 * 1024, 3584, 1024, (bf16*)(F.ws + WS_MD) + (size_t)e * 1024 * 3584, 64 * kb, 64 * nb, 64 * nb, scr, F.lane);
#endif
    }
}
DI void bg_convert_tail(Frame& F, int nwg, int lo, int hi) {
    const int nmax = (nwg + F.G - 1) / F.G, rem = nwg - (nmax - 1) * F.G;
    if (F.bid < rem || rem >= F.G) return;
    LAS unsigned* scr = (LAS unsigned*)(F.lds + F.wave * 8320);
    const int w = (F.bid - rem) * 8 + F.wave, nw = (F.G - rem) * 8;
    for (int g = lo + w; g < hi; g += nw) bg_item(F, g, scr);
}
DI void bg_convert_all(Frame& F, int lo, int hi) {
    LAS unsigned* scr = (LAS unsigned*)(F.lds + F.wave * 8320);
    for (int g = lo + F.bid * 8 + F.wave; g < hi; g += F.G * 8) bg_item(F, g, scr);
}
DI void p0_prologue(Frame& F) {
    {
        LAS float* Sx = (LAS float*)F.lds;
        LAS float* red = (LAS float*)(F.lds + 81920);
        bool staged = false;
        for (int unit = F.bid; unit < 192; unit += F.G) {
            if (!staged) {
                for (int idx = F.tid; idx < 17 * 1024; idx += 512) { const int r = idx / 1024, k = idx % 1024;
                    const float v = r < 16 ? F.in[I_C][r * 1024 + k] : F.in[I_CCTX][k]; Sx[k * 20 + r] = v * sigmoidf_(v); }
                staged = true; __syncthreads();
            }
            const int l = unit / 96, n0 = (unit % 96) * 64;
            const float* Wm = F.in[I_WMOD] + (size_t)l * 1024 * 6144 + n0 + F.lane;
            float acc[17];
#pragma unroll
            for (int r = 0; r < 17; ++r) acc[r] = 0.f;
            const int kb = F.wave * 128;
#pragma unroll 4
            for (int k = 0; k < 128; ++k) { const float wv = Wm[(size_t)(kb + k) * 6144]; const LAS float* sp = Sx + (kb + k) * 20;
                const f32x4 s0 = *(const LAS f32x4*)(sp), s1 = *(const LAS f32x4*)(sp + 4), s2 = *(const LAS f32x4*)(sp + 8), s3 = *(const LAS f32x4*)(sp + 12); const float s4 = sp[16];
                acc[0] += s0[0] * wv; acc[1] += s0[1] * wv; acc[2] += s0[2] * wv; acc[3] += s0[3] * wv; acc[4] += s1[0] * wv; acc[5] += s1[1] * wv; acc[6] += s1[2] * wv; acc[7] += s1[3] * wv;
                acc[8] += s2[0] * wv; acc[9] += s2[1] * wv; acc[10] += s2[2] * wv; acc[11] += s2[3] * wv; acc[12] += s3[0] * wv; acc[13] += s3[1] * wv; acc[14] += s3[2] * wv; acc[15] += s3[3] * wv;
                acc[16] += s4 * wv; }
#pragma unroll
            for (int r = 0; r < 17; ++r) red[(F.wave * 17 + r) * 64 + F.lane] = acc[r];
            __syncthreads();
            for (int idx = F.tid; idx < 17 * 64; idx += 512) { const int r = idx / 64, ln = idx % 64; float s = F.in[I_BMOD][l * 6144 + n0 + ln];
#pragma unroll
                for (int w = 0; w < 8; ++w) s += red[(w * 17 + r) * 64 + ln];
                if (r < 16) ((float*)(F.ws + WS_MODLAT))[((size_t)l * 16 + r) * 6144 + n0 + ln] = s; else ((float*)(F.ws + WS_MODCTX))[(size_t)l * 6144 + n0 + ln] = s; }
            __syncthreads();
        }
        __syncthreads();
    }
    if (F.bid == 0) { const int pos = F.tid >> 3, j = F.tid & 7; const float inv = exp2f(-(float)j * 0.125f * 13.287712379549449f); const float ang = (float)pos * inv;
        float* tab = (float*)(F.ws + WS_ROPE); tab[(pos * 8 + j) * 2] = cosf(ang); tab[(pos * 8 + j) * 2 + 1] = sinf(ang); }
    {
        LAS float* scr = (LAS float*)(F.lds + F.wave * 16384);
        const int gw = F.bid * 8 + F.wave, NGW = F.G * 8;
        constexpr int I_IN = 16 * 96, I_OUT = 16 * 32, I_G = 16 * 88, I_D = 44 * 32, I_MGI = 16 * 112, I_MDI = 56 * 32;
        constexpr int NITEMS = 2 * I_IN + 2 * I_OUT + (DENSE_FP8 == 1 ? 3 * 704 : (DENSE_FP8 == 2 ? 2 * I_G + 704 : 2 * I_G + I_D));
        for (int it = gw; it < NITEMS; it += NGW) {
            int r = it;
            if (r < 2 * I_IN) { const int l = r / I_IN; p0_convert_plain(F, F.in[I_WIN] + (size_t)l * 1024 * 3072, 1024, 3072, (bf16*)(F.ws + WS_WIN) + (size_t)l * 3072 * 1024, r % I_IN, scr); continue; } r -= 2 * I_IN;
            if (r < 2 * I_OUT) { const int l = r / I_OUT; p0_convert_plain(F, F.in[I_WOUT] + (size_t)l * 1024 * 1024, 1024, 1024, (bf16*)(F.ws + WS_WOUT) + (size_t)l * 1024 * 1024, r % I_OUT, scr); continue; } r -= 2 * I_OUT;
#if DENSE_FP8 == 2
            if (r < I_G) { p0_convert_gu(F, F.in[I_FG], 1024, 2816, (bf16*)(F.ws + WS_WGU), r, 0, scr); continue; } r -= I_G;
            if (r < I_G) { p0_convert_gu(F, F.in[I_FU], 1024, 2816, (bf16*)(F.ws + WS_WGU), r, 1, scr); continue; } r -= I_G;
            { const int kb = r / 16, nb = r % 16; conv_item64_fp8(F.in[I_FD], 2816, 1024, F.ws + WS_WD, 64 * kb, 64 * nb, 64 * nb, QS_WD, (LAS unsigned*)scr, F.lane); }
#elif DENSE_FP8 == 1
            { LAS unsigned* scr8 = (LAS unsigned*)scr;
              if (r < 1408) { const int up = r / 704, q = r % 704, kb = q / 44, nb = q % 44, n0 = 64 * nb;
                  conv_item64_fp8(F.in[up ? I_FU : I_FG], 1024, 2816, F.ws + WS_WGU, 64 * kb, n0, 256 * (n0 / 128) + (n0 % 128) + (up ? 128 : 0), QS_WGU, scr8, F.lane); }
              else { const int q = r - 1408, kb = q / 16, nb = q % 16; conv_item64_fp8(F.in[I_FD], 2816, 1024, F.ws + WS_WD, 64 * kb, 64 * nb, 64 * nb, QS_WD, scr8, F.lane); } }
#else
            if (r < I_G) { p0_convert_gu(F, F.in[I_FG], 1024, 2816, (bf16*)(F.ws + WS_WGU), r, 0, scr); continue; } r -= I_G;
            if (r < I_G) { p0_convert_gu(F, F.in[I_FU], 1024, 2816, (bf16*)(F.ws + WS_WGU), r, 1, scr); continue; } r -= I_G;
            p0_convert_plain(F, F.in[I_FD], 2816, 1024, (bf16*)(F.ws + WS_WD), r, scr);
#endif
        }
    }
}

struct NormVecs { f32x4 gs[4], sh[4]; };
DI void norm_load_vecs(Frame& F, const float* g, const float* mod, int isc, int ish, NormVecs& V) {
#pragma unroll
    for (int j = 0; j < 4; ++j) { const f32x4 gv = ((const f32x4*)g)[F.lane + 64 * j], sv = ((const f32x4*)(mod + isc * DM))[F.lane + 64 * j]; V.gs[j] = gv * (sv + 1.0f); V.sh[j] = ((const f32x4*)(mod + ish * DM))[F.lane + 64 * j]; }
}
DI void norm_load_row(Frame& F, const float* srow, f32x4 (&v)[4]) {
    const f32x4* xr = (const f32x4*)srow + F.lane;
#pragma unroll
    for (int j = 0; j < 4; ++j) v[j] = xr[64 * j];
}
DI float norm_ssq(const f32x4 (&v)[4]) { float s = 0.f;
#pragma unroll
    for (int j = 0; j < 4; ++j) s += (v[j].x * v[j].x + v[j].y * v[j].y) + (v[j].z * v[j].z + v[j].w * v[j].w);
    return s; }
DI void norm_finish(Frame& F, const f32x4 (&v)[4], float ssq_total, const NormVecs& V, bf16* orow, f32x4 (&y)[4]) {
    const float rstd = 1.0f / sqrtf(ssq_total * (1.0f / DM) + EPS);
    u32x2* o8 = (u32x2*)orow + F.lane;
#pragma unroll
    for (int j = 0; j < 4; ++j) { y[j] = (v[j] * rstd) * V.gs[j] + V.sh[j]; u32x2 w; w.x = pk2(y[j].x, y[j].y); w.y = pk2(y[j].z, y[j].w); o8[64 * j] = w; }
}
DI void norm_finish8(Frame& F, const f32x4 (&v)[4], float ssq_total, const NormVecs& V, unsigned char* orow, f32x4 (&y)[4]) {
    const float rstd = 1.0f / sqrtf(ssq_total * (1.0f / DM) + EPS);
    unsigned* o4 = (unsigned*)orow + F.lane;
#pragma unroll
    for (int j = 0; j < 4; ++j) { y[j] = (v[j] * rstd) * V.gs[j] + V.sh[j]; o4[64 * j] = pk4_fp8(y[j].x * QS_U, y[j].y * QS_U, y[j].z * QS_U, y[j].w * QS_U); }
}
DI void norm_phase(Frame& F, int l, int which, bool first, int row_lo, bool out8 = false) {
    const float* g = F.in[which == 1 ? I_N1W : I_N2W] + l * DM;
    const float* modlat = (const float*)(F.ws + WS_MODLAT) + (size_t)l * 16 * 6144;
    const float* modctx = (const float*)(F.ws + WS_MODCTX) + (size_t)l * 6144;
    const int ish = which == 1 ? 0 : 3, isc = which == 1 ? 1 : 4;
    const float* sctx = first ? F.in[I_CTX] : (const float*)(F.ws + WS_HCTX);
    const float* slat = first ? F.in[I_X] : F.out;
    bf16* U = (bf16*)(F.ws + WS_U);
    const int gw = F.bid * 8 + F.wave, NGW = F.G * 8;
    const int rpw = (NTOK - row_lo + NGW - 1) / NGW;
    const int r0 = row_lo + gw * rpw; int r1 = r0 + rpw; if (r1 > NTOK) r1 = NTOK;
    NormVecs V; int curb = -2;
    for (int row = r0; row < r1; row += 2) {
        const bool two = row + 1 < r1;
        const int rowb = two ? row + 1 : row;
        f32x4 va[4], vb[4];
        norm_load_row(F, row < NCTX ? sctx + (size_t)row * DM : slat + (size_t)(row - NCTX) * DM, va);
        norm_load_row(F, rowb < NCTX ? sctx + (size_t)rowb * DM : slat + (size_t)(rowb - NCTX) * DM, vb);
        float sa = norm_ssq(va), sb = norm_ssq(vb);
#pragma unroll
        for (int o = 1; o < 64; o <<= 1) { sa += __shfl_xor(sa, o); sb += __shfl_xor(sb, o); }
        f32x4 y[4];
        { const int bk = row < NCTX ? -1 : (row - NCTX) / SEQ; if (bk != curb) { norm_load_vecs(F, g, bk < 0 ? modctx : modlat + (size_t)bk * 6144, isc, ish, V); curb = bk; } }
        if (out8) norm_finish8(F, va, sa, V, (unsigned char*)U + (size_t)row * DM, y); else norm_finish(F, va, sa, V, U + (size_t)row * DM, y);
        if (two) { const int bk = rowb < NCTX ? -1 : (rowb - NCTX) / SEQ; if (bk != curb) { norm_load_vecs(F, g, bk < 0 ? modctx : modlat + (size_t)bk * 6144, isc, ish, V); curb = bk; }
            if (out8) norm_finish8(F, vb, sb, V, (unsigned char*)U + (size_t)rowb * DM, y); else norm_finish(F, vb, sb, V, U + (size_t)rowb * DM, y); }
    }
}
DI void moe_route_row(Frame& F, const f32x4 (&y)[4], LAS const float* Rw, const float (&rb)[8], LAS int* sel, int tl, int tok) {
    float lg[8];
#pragma unroll
    for (int e = 0; e < 8; ++e) lg[e] = 0.f;
#pragma unroll
    for (int j = 0; j < 4; ++j)
#pragma unroll
        for (int q = 0; q < 4; ++q) { const int k = 256 * j + 4 * F.lane + q; const f32x4 r0 = *(const LAS f32x4*)(Rw + k * 8), r1 = *(const LAS f32x4*)(Rw + k * 8 + 4); const float yv = y[j][q];
            lg[0] += yv * r0[0]; lg[1] += yv * r0[1]; lg[2] += yv * r0[2]; lg[3] += yv * r0[3]; lg[4] += yv * r1[0]; lg[5] += yv * r1[1]; lg[6] += yv * r1[2]; lg[7] += yv * r1[3]; }
#pragma unroll
    for (int o = 1; o < 64; o <<= 1) {
#pragma unroll
        for (int e = 0; e < 8; ++e) lg[e] += __shfl_xor(lg[e], o); }
#pragma unroll
    for (int e = 0; e < 8; ++e) lg[e] += rb[e];
    int e1 = 0; float v1 = lg[0];
#pragma unroll
    for (int e = 1; e < 8; ++e) if (lg[e] > v1) { v1 = lg[e]; e1 = e; }
    int e2 = -1; float v2 = -3.0e38f;
#pragma unroll
    for (int e = 0; e < 8; ++e) if (e != e1 && lg[e] > v2) { v2 = lg[e]; e2 = e; }
    const float ex = __expf(v2 - v1), p1 = 1.0f / (1.0f + ex), p2 = ex / (1.0f + ex);
    if (F.lane == 0) { sel[tl * 2] = e1; sel[tl * 2 + 1] = e2; float* pt = (float*)(F.ws + WS_PTOK) + (size_t)tok * 2; pt[0] = p1; pt[1] = p2; }
}
DI void norm_moe_phase(Frame& F) {
    const int l = 1;
    const float* g = F.in[I_N2W] + l * DM;
    const float* modlat = (const float*)(F.ws + WS_MODLAT) + (size_t)l * 16 * 6144;
    bf16* U = (bf16*)(F.ws + WS_U);
    LAS float* Rw = (LAS float*)F.lds;
    LAS int* sel = (LAS int*)(F.lds + 32768);
    for (int idx = F.tid; idx < 8192; idx += 512) Rw[idx] = F.in[I_MR][idx];
    __syncthreads();
    float rb[8];
#pragma unroll
    for (int e = 0; e < 8; ++e) rb[e] = F.in[I_MRB][e];
    NormVecs V; int curb = -2;
    for (int seg = F.bid; seg < 256; seg += F.G) {
        const int bk = (seg * 128) / SEQ; if (bk != curb) { norm_load_vecs(F, g, modlat + (size_t)bk * 6144, 4, 3, V); curb = bk; }
        for (int i = 0; i < 16; i += 2) {
            const int tl = F.wave * 16 + i, tok = seg * 128 + tl;
            f32x4 va[4], vb[4];
            norm_load_row(F, F.out + (size_t)tok * DM, va); norm_load_row(F, F.out + (size_t)(tok + 1) * DM, vb);
            float sa = norm_ssq(va), sb = norm_ssq(vb);
#pragma unroll
            for (int o = 1; o < 64; o <<= 1) { sa += __shfl_xor(sa, o); sb += __shfl_xor(sb, o); }
            f32x4 y[4];
#if MOE_FP8
            norm_finish8(F, va, sa, V, (unsigned char*)U + (size_t)tok * DM, y); moe_route_row(F, y, Rw, rb, sel, tl, tok);
            norm_finish8(F, vb, sb, V, (unsigned char*)U + (size_t)(tok + 1) * DM, y); moe_route_row(F, y, Rw, rb, sel, tl + 1, tok + 1);
#else
            norm_finish(F, va, sa, V, U + (size_t)(NCTX + tok) * DM, y); moe_route_row(F, y, Rw, rb, sel, tl, tok);
            norm_finish(F, vb, sb, V, U + (size_t)(NCTX + tok + 1) * DM, y); moe_route_row(F, y, Rw, rb, sel, tl + 1, tok + 1);
#endif
        }
        __syncthreads();
        if (F.tid < 16) { const int s = F.tid >> 3, e = F.tid & 7; int cnt = 0; int* lst = (int*)(F.ws + WS_SEGLIST) + ((size_t)(seg * 2 + s) * 8 + e) * 128;
            for (int i = 0; i < 128; ++i) if (sel[i * 2 + s] == e) lst[cnt++] = seg * 128 + i;
            ((int*)(F.ws + WS_SEGCNT))[(seg * 2 + s) * 8 + e] = cnt; }
        __syncthreads();
    }
}
DI void moe_route_phase(Frame& F) {
    LAS int* cn = (LAS int*)F.lds;
    LAS int* offs = cn + 2048;
    LAS int* tb = offs + 256;
    for (int unit = F.bid; unit < 16; unit += F.G) {
        const int s = unit >> 3, e = unit & 7;
        const int* segcnt = (const int*)(F.ws + WS_SEGCNT);
        for (int idx = F.tid; idx < 2048; idx += 512) { const int ee = idx >> 8, gsg = idx & 255; cn[idx] = segcnt[(gsg * 2 + s) * 8 + ee]; }
        __syncthreads();
        if (F.tid < 8) { int tot = 0; for (int gsg = 0; gsg < 256; ++gsg) tot += cn[F.tid * 256 + gsg]; tb[16 + F.tid] = tot; }
        if (F.tid == 64) { int run = 0; for (int gsg = 0; gsg < 256; ++gsg) { offs[gsg] = run; run += cn[e * 256 + gsg]; } }
        __syncthreads();
        if (F.tid == 0) { int run = 0; for (int ee = 0; ee < 8; ++ee) { tb[ee] = run; run += (tb[16 + ee] + 255) / 256; } tb[8] = run; }
        __syncthreads();
        int* rowmap = (int*)(F.ws + WS_ROWMAP) + (size_t)s * MOE_ROWS;
        float* prow = (float*)(F.ws + WS_PROW) + (size_t)s * MOE_ROWS;
        const float* ptok = (const float*)(F.ws + WS_PTOK);
        const int base = tb[e] * 256, tot = tb[16 + e], ntile = (tot + 255) / 256;
        if (F.tid < 256) { const int gsg = F.tid; const int c = cn[e * 256 + gsg]; const int* lst = (const int*)(F.ws + WS_SEGLIST) + ((size_t)(gsg * 2 + s) * 8 + e) * 128;
            for (int i = 0; i < c; ++i) { const int tok = lst[i]; rowmap[base + offs[gsg] + i] = tok; prow[base + offs[gsg] + i] = ptok[(size_t)tok * 2 + s]; } }
        for (int i = tot + F.tid; i < ntile * 256; i += 512) { rowmap[base + i] = -1; prow[base + i] = 0.f; }
        if (e == 0) { int* meta = (int*)(F.ws + WS_META) + s * 256;
            if (F.tid == 0) meta[0] = tb[8];
            if (F.tid < 8) { const int t0 = tb[F.tid], t1 = tb[F.tid + 1]; for (int t = t0; t < t1; ++t) meta[1 + t] = F.tid; } }
        __syncthreads();
    }
}
DI void final_phase(Frame& F) {
    const float* g = F.in[I_FNW];
    f32x4 gv[4];
#pragma unroll
    for (int j = 0; j < 4; ++j) gv[j] = ((const f32x4*)g)[F.lane + 64 * j];
    const int gw = F.bid * 8 + F.wave, NGW = F.G * 8;
    const int rpw = (NLAT + NGW - 1) / NGW; const int r0 = gw * rpw; int r1 = r0 + rpw; if (r1 > NLAT) r1 = NLAT;
    for (int row = r0; row < r1; row += 2) {
        const bool two = row + 1 < r1; const int rowb = two ? row + 1 : row;
        f32x4 va[4], vb[4];
        norm_load_row(F, F.out + (size_t)row * DM, va); norm_load_row(F, F.out + (size_t)rowb * DM, vb);
        { const bf16* y1 = (const bf16*)(F.ws + WS_U);
#pragma unroll
          for (int j = 0; j < 4; ++j) { const u32x2 ya = ((const u32x2*)(y1 + (size_t)row * DM))[F.lane + 64 * j], yb = ((const u32x2*)(y1 + (size_t)rowb * DM))[F.lane + 64 * j];
              va[j].x += bflo(ya.x); va[j].y += bfhi(ya.x); va[j].z += bflo(ya.y); va[j].w += bfhi(ya.y); vb[j].x += bflo(yb.x); vb[j].y += bfhi(yb.x); vb[j].z += bflo(yb.y); vb[j].w += bfhi(yb.y); } }
        float sa = norm_ssq(va), sb = norm_ssq(vb);
#pragma unroll
        for (int o = 1; o < 64; o <<= 1) { sa += __shfl_xor(sa, o); sb += __shfl_xor(sb, o); }
        const float ra = 1.0f / sqrtf(sa * (1.0f / DM) + EPS), rbv = 1.0f / sqrtf(sb * (1.0f / DM) + EPS);
        f32x4* xa = (f32x4*)(F.out + (size_t)row * DM) + F.lane; f32x4* xb = (f32x4*)(F.out + (size_t)rowb * DM) + F.lane;
#pragma unroll
        for (int j = 0; j < 4; ++j) xa[64 * j] = (va[j] * ra) * gv[j];
        if (two) {
#pragma unroll
            for (int j = 0; j < 4; ++j) xb[64 * j] = (vb[j] * rbv) * gv[j]; }
    }
}

DI void conv_unit(Frame& F, int l, int row0, int t0, int slen) {
    const bf16* PX = (const bf16*)(F.ws + WS_P);
    bf16* YC = (bf16*)(F.ws + WS_U);
    LAS float* Y = (LAS float*)F.lds;
    { u32x4 av[6], gv[6];
#pragma unroll
      for (int k = 0; k < 6; ++k) { const int it = F.tid + 512 * k; const int rr = it >> 5, cc = it & 31; const int t = t0 - 15 + rr;
          av[k] = (u32x4){0u, 0u, 0u, 0u}; gv[k] = av[k];
          if (it < 94 * 32 && t >= 0 && t < slen) { const bf16* p = PX + (size_t)(row0 + t) * INW + C_CONV + 8 * cc; av[k] = *(const u32x4*)p; gv[k] = *(const u32x4*)(p + 256); } }
#pragma unroll
      for (int k = 0; k < 6; ++k) { const int it = F.tid + 512 * k; const int rr = it >> 5, cc = it & 31;
          if (it < 94 * 32) { f32x4 o0, o1;
              o0[0] = bflo(av[k].x) * sigmoidf_(bflo(gv[k].x)); o0[1] = bfhi(av[k].x) * sigmoidf_(bfhi(gv[k].x)); o0[2] = bflo(av[k].y) * sigmoidf_(bflo(gv[k].y)); o0[3] = bfhi(av[k].y) * sigmoidf_(bfhi(gv[k].y));
              o1[0] = bflo(av[k].z) * sigmoidf_(bflo(gv[k].z)); o1[1] = bfhi(av[k].z) * sigmoidf_(bfhi(gv[k].z)); o1[2] = bflo(av[k].w) * sigmoidf_(bflo(gv[k].w)); o1[3] = bfhi(av[k].w) * sigmoidf_(bfhi(gv[k].w));
              *(LAS f32x4*)(Y + rr * 256 + 8 * cc) = o0; *(LAS f32x4*)(Y + rr * 256 + 8 * cc + 4) = o1; } } }
    __syncthreads();
    const int c = F.tid & 255, half = F.tid >> 8;
    float w[31];
#pragma unroll
    for (int k = 0; k < 31; ++k) w[k] = F.in[I_CONVW][(size_t)l * 31 * 256 + k * 256 + c];
    float acc[32];
    const float cb = F.in[I_CONVB][l * 256 + c];
#pragma unroll
    for (int o = 0; o < 32; ++o) acc[o] = cb;
#pragma unroll
    for (int kk = 0; kk < 62; ++kk) { const float yv = Y[(32 * half + kk) * 256 + c];
#pragma unroll
        for (int o = 0; o < 32; ++o) { const int tap = kk - o; if (tap >= 0 && tap < 31) acc[o] += yv * w[tap]; } }
    __syncthreads();
#pragma unroll
    for (int o = 0; o < 32; ++o) Y[(32 * half + o) * 256 + c] = acc[o];
    __syncthreads();
    const f32x4 lw = ((const f32x4*)(F.in[I_CLNW] + l * 256))[F.lane], lb = ((const f32x4*)(F.in[I_CLNB] + l * 256))[F.lane];
    for (int i = 0; i < 8; ++i) { const int tl = F.wave * 8 + i; const f32x4 v = *(const LAS f32x4*)(Y + tl * 256 + 4 * F.lane);
        const float mu = wave_sum((v.x + v.y) + (v.z + v.w)) * (1.0f / 256.0f); const f32x4 d = v - mu;
        const float var = wave_sum((d.x * d.x + d.y * d.y) + (d.z * d.z + d.w * d.w)) * (1.0f / 256.0f); const float rstd = 1.0f / sqrtf(var + EPS);
        f32x4 z = d * rstd * lw + lb; z.x *= sigmoidf_(z.x); z.y *= sigmoidf_(z.y); z.z *= sigmoidf_(z.z); z.w *= sigmoidf_(z.w);
        u32x2 o; o.x = pk2(z.x, z.y); o.y = pk2(z.z, z.w);
        *(u32x2*)(YC + (size_t)(row0 + t0 + tl) * DM + 512 + 4 * F.lane) = o; }
    __syncthreads();
}
DI void ret_consts(Frame& F, int l, int hh, float& lg2f, float& lg2b) {
    const float df = F.in[I_RDEC][(l * 2 + 0) * 4 + hh], db = F.in[I_RDEC][(l * 2 + 1) * 4 + hh];
    lg2f = log2f(1.0f - exp2f(-df)); lg2b = log2f(1.0f - exp2f(-db));
}
constexpr int ROPE_LDS = AUX_OFF + 4096;
DI void rope_to_lds(Frame& F) { const float* tab = (const float*)(F.ws + WS_ROPE); LAS float* rt = (LAS float*)(F.lds + ROPE_LDS); for (int i = F.tid; i < 1024; i += 512) rt[i] = tab[i]; __syncthreads(); }
DI void unpack8(const u32x4& a, float (&x)[8]) { x[0] = bflo(a.x); x[1] = bfhi(a.x); x[2] = bflo(a.y); x[3] = bfhi(a.y); x[4] = bflo(a.z); x[5] = bfhi(a.z); x[6] = bflo(a.w); x[7] = bfhi(a.w); }
DI void rope_apply(Frame& F, const u32x4& a, const u32x4& b, int hp, bool lat, int tg, float (&x1)[8], float (&x2)[8]) {
    unpack8(a, x1); unpack8(b, x2);
    if (lat) { const int pos = hp == 0 ? (tg >> 6) : (tg & 63); LAS const f32x4* tab = (LAS const f32x4*)(F.lds + ROPE_LDS) + pos * 4;
#pragma unroll
        for (int jj = 0; jj < 4; ++jj) { const f32x4 cs = tab[jj];
            { const float a1 = x1[2 * jj], a2 = x2[2 * jj]; x1[2 * jj] = a1 * cs[0] - a2 * cs[1]; x2[2 * jj] = a2 * cs[0] + a1 * cs[1]; }
            { const float a1 = x1[2 * jj + 1], a2 = x2[2 * jj + 1]; x1[2 * jj + 1] = a1 * cs[2] - a2 * cs[3]; x2[2 * jj + 1] = a2 * cs[2] + a1 * cs[3]; } } }
}
DI void ret_unit_decode(int su, bool& isctx, int& b, int& hh, int& n) {
    isctx = su >= 1024; if (!isctx) { b = su >> 6; hh = (su >> 4) & 3; n = su & 15; } else { const int v = su - 1024; b = v >> 3; hh = (v >> 1) & 3; n = v & 1; }
}
DI void ret_summary_pair(Frame& F, int l, int it) {
    const bf16* PX = (const bf16*)(F.ws + WS_P);
    const int sub = F.wave >> 2, st = F.tid & 255, su = 2 * it + sub;
    bool isctx; int b, hh, n; ret_unit_decode(su, isctx, b, hh, n);
    const int row0 = isctx ? (b * CTXL + n * 128) : (NCTX + b * SEQ + n * 128);
    float lg2f, lg2b; ret_consts(F, l, hh, lg2f, lg2b);
    LAS unsigned char* base = F.lds + sub * 40960;
    LAS unsigned char* Vimg = base;
    LAS unsigned char* Kf = base + 18432;
    LAS unsigned char* Kb = base + 18432 + 10240;
    { const int tok = st >> 1, hp = st & 1; float x1[8], x2[8];
      const bf16* kp = PX + (size_t)(row0 + tok) * INW + C_RK + 32 * hh; const bf16* vp = PX + (size_t)(row0 + tok) * INW + C_RV + 64 * hh + 32 * hp;
      const u32x4 kra = *(const u32x4*)(kp + 8 * hp), krb = *(const u32x4*)(kp + 16 + 8 * hp);
      u32x4 vr[4];
#pragma unroll
      for (int q = 0; q < 4; ++q) vr[q] = *(const u32x4*)(vp + 8 * q);
      rope_apply(F, kra, krb, hp, !isctx, n * 128 + tok, x1, x2);
      const float ks = 0.17677669529663687f;
      const float wf = fast_exp2(lg2f * (float)(127 - tok)) * ks, wb = fast_exp2(lg2b * (float)tok) * ks;
      u32x4 o;
      o.x = pk2(x1[0] * wf, x1[1] * wf); o.y = pk2(x1[2] * wf, x1[3] * wf); o.z = pk2(x1[4] * wf, x1[5] * wf); o.w = pk2(x1[6] * wf, x1[7] * wf); *(LAS u32x4*)(Kf + tok * 80 + 16 * hp) = o;
      o.x = pk2(x2[0] * wf, x2[1] * wf); o.y = pk2(x2[2] * wf, x2[3] * wf); o.z = pk2(x2[4] * wf, x2[5] * wf); o.w = pk2(x2[6] * wf, x2[7] * wf); *(LAS u32x4*)(Kf + tok * 80 + 32 + 16 * hp) = o;
      o.x = pk2(x1[0] * wb, x1[1] * wb); o.y = pk2(x1[2] * wb, x1[3] * wb); o.z = pk2(x1[4] * wb, x1[5] * wb); o.w = pk2(x1[6] * wb, x1[7] * wb); *(LAS u32x4*)(Kb + tok * 80 + 16 * hp) = o;
      o.x = pk2(x2[0] * wb, x2[1] * wb); o.y = pk2(x2[2] * wb, x2[3] * wb); o.z = pk2(x2[4] * wb, x2[5] * wb); o.w = pk2(x2[6] * wb, x2[7] * wb); *(LAS u32x4*)(Kb + tok * 80 + 32 + 16 * hp) = o;
#pragma unroll
      for (int q = 0; q < 4; ++q) *(LAS u32x4*)(Vimg + tok * 144 + 64 * hp + 16 * q) = vr[q]; }
    __syncthreads();
    { const int role = F.wave & 3, dir = role >> 1, et = role & 1;
      const int l32 = F.lane & 31, h = F.lane >> 5, grp = (F.lane >> 4) & 1, i16 = F.lane & 15, q = i16 >> 2, p = i16 & 3;
      LAS unsigned char* Kimg = dir ? Kb : Kf;
      f32x16 acc;
#pragma unroll
      for (int i = 0; i < 16; ++i) acc[i] = 0.f;
#pragma unroll
      for (int s = 0; s < 8; ++s) { const int r0 = 16 * s + 8 * h + q;
          const s16x4 alo = trread(Vimg + r0 * 144 + (32 * et + 16 * grp + 4 * p) * 2), ahi = trread(Vimg + (r0 + 4) * 144 + (32 * et + 16 * grp + 4 * p) * 2);
          const s16x4 blo = trread(Kimg + r0 * 80 + (16 * grp + 4 * p) * 2), bhi = trread(Kimg + (r0 + 4) * 80 + (16 * grp + 4 * p) * 2);
          const bf16x8 a = __builtin_shufflevector(alo, ahi, 0, 1, 2, 3, 4, 5, 6, 7), bb = __builtin_shufflevector(blo, bhi, 0, 1, 2, 3, 4, 5, 6, 7);
          acc = MFMA32(a, bb, acc); }
      float* S = isctx ? (float*)(F.ws + WS_SUMCTX) + ((size_t)((b * 4 + hh) * 2 + n) * 2 + dir) * 2048 : (float*)(F.ws + WS_SUMLAT) + ((size_t)((b * 4 + hh) * 16 + n) * 2 + dir) * 2048;
#pragma unroll
      for (int i = 0; i < 16; ++i) S[(32 * et + crow(i, h)) * 32 + l32] = acc[i]; }
    __syncthreads();
}
DI void ca_phase(Frame& F, int l) {
    rope_to_lds(F);
    const int nconv = l == 0 ? 576 : 512;
    for (int u = F.vb; u < nconv; u += F.G) {
        int v = u; if (l != 0) v += 64;
        if (v < 64) conv_unit(F, l, (v >> 2) * CTXL, (v & 3) * 64, CTXL);
        else { v -= 64; conv_unit(F, l, NCTX + (v >> 5) * SEQ, (v & 31) * 64, SEQ); }
    }
    for (int it = F.vb; it < 576; it += F.G) ret_summary_pair(F, l, it);
}

constexpr int ATT_KV = 18432, ATT_BUF = 2 * ATT_KV, ATT_BT = 2 * ATT_BUF, ATT_NEG = 640;
struct AttRegs { u32x4 k0, v0, k1, v1; };
DI void attn_fetch(const bf16* PX, int rowA, int rowB, unsigned loff, AttRegs& R) {
    const char* pa = (const char*)(PX + (size_t)rowA * INW) + loff; const char* pb = (const char*)(PX + (size_t)rowB * INW) + loff;
    R.k0 = *(const u32x4*)(pa + C_NAK * 2); R.v0 = *(const u32x4*)(pa + C_NAV * 2); R.k1 = *(const u32x4*)(pb + C_NAK * 2); R.v1 = *(const u32x4*)(pb + C_NAV * 2);
}
DI void attn_put(Frame& F, LAS unsigned char* buf, const AttRegs& R) {
    const int key = F.tid >> 3, ch = F.tid & 7;
    *(LAS u32x4*)(buf + key * 144 + 16 * ch) = R.k0; *(LAS u32x4*)(buf + ATT_KV + key * 144 + 16 * ch) = R.v0;
    *(LAS u32x4*)(buf + (64 + key) * 144 + 16 * ch) = R.k1; *(LAS u32x4*)(buf + ATT_KV + (64 + key) * 144 + 16 * ch) = R.v1;
}
template <bool BIAS, int NT>
DI void attn_tiles(LAS const unsigned char* buf, const int (&koff)[2], const bf16x8 (&qf)[4], f32x16& o0, f32x16& o1, f32x16& o2, float& mrun, int lane,
                   LAS const float* const (&bt)[2]  , const float (&pen)[16]) {
    LAS const unsigned char* Kimg = buf; LAS const unsigned char* Vimg = buf + ATT_KV;
    const int l32 = lane & 31, h = lane >> 5, grp = (lane >> 4) & 1, i16 = lane & 15, q = i16 >> 2, p = i16 & 3;
    f32x16 s[NT];
#pragma unroll
    for (int t = 0; t < NT; ++t)
#pragma unroll
        for (int i = 0; i < 16; ++i) s[t][i] = 0.f;
#pragma unroll
    for (int si = 0; si < 4; ++si)
#pragma unroll
        for (int t = 0; t < NT; ++t) { const bf16x8 a = *(const LAS bf16x8*)(Kimg + (koff[t] + l32) * 144 + (16 * si + 8 * h) * 2); s[t] = MFMA32(a, qf[si], s[t]); }
    const float c = 0.125f * LOG2E;
    float v[NT][16]; float mx = -1.0e30f;
#pragma unroll
    for (int t = 0; t < NT; ++t)
#pragma unroll
        for (int i = 0; i < 16; ++i) { float x;
            if (BIAS) x = __builtin_fmaf(s[t][i], c, bt[t][(i & 3) + 8 * (i >> 2)]) + pen[i]; else x = s[t][i];
            v[t][i] = x; mx = fmaxf(mx, x); }
    if (!BIAS) mx *= c;
    mx = fmaxf(mx, __shfl_xor(mx, 32));
    const float mnew = fmaxf(mrun, mx);
    const float alpha = fast_exp2(mrun - mnew);
    if (__any(alpha != 1.0f)) {
#pragma unroll
        for (int i = 0; i < 16; ++i) { o0[i] *= alpha; o1[i] *= alpha; o2[i] *= alpha; } }
    mrun = mnew;
    bf16x8 pf[NT][2];
#pragma unroll
    for (int t = 0; t < NT; ++t) { float pp[16];
#pragma unroll
        for (int i = 0; i < 16; ++i) pp[i] = BIAS ? fast_exp2(v[t][i] - mnew) : fast_exp2(__builtin_fmaf(v[t][i], c, -mnew));
#pragma unroll
        for (int s2 = 0; s2 < 2; ++s2) { u32x4 w; w.x = pk2(pp[8 * s2], pp[8 * s2 + 1]); w.y = pk2(pp[8 * s2 + 2], pp[8 * s2 + 3]); w.z = pk2(pp[8 * s2 + 4], pp[8 * s2 + 5]); w.w = pk2(pp[8 * s2 + 6], pp[8 * s2 + 7]); pf[t][s2] = __builtin_bit_cast(bf16x8, w); } }
    const u32x4 onesw = (u32x4){0x3f803f80u, 0x3f803f80u, 0x3f803f80u, 0x3f803f80u}; const bf16x8 ones = __builtin_bit_cast(bf16x8, onesw);
#pragma unroll
    for (int t = 0; t < NT; ++t)
#pragma unroll
        for (int s2 = 0; s2 < 2; ++s2) { const int r0 = koff[t] + 16 * s2 + 4 * h + q;
#pragma unroll
            for (int et = 0; et < 2; ++et) { const int cb = (32 * et + 16 * grp + 4 * p) * 2;
                const s16x4 lo = trread(Vimg + r0 * 144 + cb), hi = trread(Vimg + (r0 + 8) * 144 + cb);
                const bf16x8 a = __builtin_shufflevector(lo, hi, 0, 1, 2, 3, 4, 5, 6, 7);
                if (et == 0) o0 = MFMA32(a, pf[t][s2], o0); else o1 = MFMA32(a, pf[t][s2], o1); }
            o2 = MFMA32(ones, pf[t][s2], o2); }
}
DI void attn_unit(Frame& F, int l, bool na, int b, int hh, int rg) {
    const bf16* PX = (const bf16*)(F.ws + WS_P);
    bf16* YC = (bf16*)(F.ws + WS_U);
    LAS float* btab = (LAS float*)(F.lds + ATT_BT);
    const int l32 = F.lane & 31, h = F.lane >> 5;
    int qrow, r = 0, qcol = 0, kc0 = 0, ra = 0;
    float pen[16];
#pragma unroll
    for (int i = 0; i < 16; ++i) pen[i] = 0.f;
    if (na) { const int rp = F.wave >> 2, n = F.wave & 3; ra = 4 * rg + 2 * rp; r = ra + (l32 >> 4); qcol = 16 * n + (l32 & 15); qrow = NCTX + b * SEQ + r * GW + qcol;
        int w0 = qcol - 8; w0 = w0 < 0 ? 0 : (w0 > 48 ? 48 : w0); kc0 = 16 * n - 8; kc0 = kc0 < 0 ? 0 : (kc0 > 32 ? 32 : kc0);
#pragma unroll
        for (int i = 0; i < 16; ++i) pen[i] = ((unsigned)(kc0 + crow(i, h) - w0) < 16u) ? 0.f : -1.0e30f; }
    else qrow = b * CTXL + 32 * F.wave + l32;
    bf16x8 qf[4];
#pragma unroll
    for (int si = 0; si < 4; ++si) qf[si] = *(const bf16x8*)(PX + (size_t)qrow * INW + C_NAQ + 64 * hh + 16 * si + 8 * h);
    if (na) { for (int idx = F.tid; idx < ATT_NEG + 128; idx += 512) { float v = 0.f; if (idx >= 48 && idx < 48 + 465) v = F.in[I_RPB][((size_t)l * 8 + hh) * 465 + (idx - 48)] * LOG2E; if (idx >= ATT_NEG) v = -1.0e30f; btab[idx] = v; } }
    f32x16 o0, o1, o2;
#pragma unroll
    for (int i = 0; i < 16; ++i) { o0[i] = 0.f; o1[i] = 0.f; o2[i] = 0.f; }
    float mrun = -1.0e30f;
    int ylo = 0, yhi = 0, nsteps = 2;
    if (na) { const int rlo = 4 * rg, rhi = 4 * rg + 3;
        ylo = rlo - 4; ylo = ylo < 0 ? 0 : (ylo > 24 ? 24 : ylo);
        yhi = rhi - 4; yhi = yhi < 0 ? 0 : (yhi > 24 ? 24 : yhi); yhi += 8; nsteps = 2 + (yhi - ylo + 1) / 2; }
    int sa = ra - 4; sa = sa < 0 ? 0 : (sa > 24 ? 24 : sa);
    int sb = ra + 1 - 4; sb = sb < 0 ? 0 : (sb > 24 ? 24 : sb);
    const int mylo = (l32 >> 4) ? sb : sa;
    const int cbase = kc0 + 4 * h - qcol + 15;
#define ATT_ROWA(sx) ((sx) < 2 ? b * CTXL + 128 * (sx) : NCTX + b * SEQ + (ylo + 2 * ((sx) - 2)) * GW)
#define ATT_ROWB(sx) ((sx) < 2 ? b * CTXL + 128 * (sx) + 64 : NCTX + b * SEQ + ((ylo + 2 * ((sx) - 2) + 1) < yhi ? (ylo + 2 * ((sx) - 2) + 1) : (yhi - 1)) * GW)
    AttRegs R;
    unsigned loff = (unsigned)(((F.tid >> 3) * INW + 64 * hh + 8 * (F.tid & 7)) * 2); asm volatile("" : "+v"(loff));
    attn_fetch(PX, ATT_ROWA(0), ATT_ROWB(0), loff, R);
    for (int st = 0; st < nsteps; ++st) {
        LAS unsigned char* buf = F.lds + (st & 1) * ATT_BUF;
        attn_put(F, buf, R);
        if (st + 1 < nsteps) attn_fetch(PX, ATT_ROWA(st + 1), ATT_ROWB(st + 1), loff, R);
        __syncthreads();
        if (st < 2) {
            LAS const float* const bt[2] = {btab, btab};
            { const int ko[2] = {0, 32}; attn_tiles<false, 2>(buf, ko, qf, o0, o1, o2, mrun, F.lane, bt, pen); }
            { const int ko[2] = {64, 96}; attn_tiles<false, 2>(buf, ko, qf, o0, o1, o2, mrun, F.lane, bt, pen); }
        } else {
            const int y0 = ylo + 2 * (st - 2), y1 = y0 + 1;
            const bool act0 = (y0 >= sa && y0 < sb + 8), act1 = (y1 < yhi && y1 >= sa && y1 < sb + 8);
            const bool ok0 = (unsigned)(y0 - mylo) < 8u, ok1 = (unsigned)(y1 - mylo) < 8u;
            LAS const float* b0 = btab + (ok0 ? 48 + (y0 - r + 7) * 31 + cbase : ATT_NEG);
            LAS const float* b1 = btab + (ok1 ? 48 + (y1 - r + 7) * 31 + cbase : ATT_NEG);
            if (act0 && act1) { const int ko[2] = {kc0, 64 + kc0}; LAS const float* const bt[2] = {b0, b1}; attn_tiles<true, 2>(buf, ko, qf, o0, o1, o2, mrun, F.lane, bt, pen); }
            else if (act0) { const int ko[2] = {kc0, kc0}; LAS const float* const bt[2] = {b0, b0}; attn_tiles<true, 1>(buf, ko, qf, o0, o1, o2, mrun, F.lane, bt, pen); }
            else if (act1) { const int ko[2] = {64 + kc0, 64 + kc0}; LAS const float* const bt[2] = {b1, b1}; attn_tiles<true, 1>(buf, ko, qf, o0, o1, o2, mrun, F.lane, bt, pen); }
        }
    }
#undef ATT_ROWA
#undef ATT_ROWB
    const float inv = 1.0f / o2[0];
    bf16* orow = YC + (size_t)qrow * DM + 64 * hh;
#pragma unroll
    for (int gq = 0; gq < 4; ++gq) { u32x2 w;
        w.x = pk2(o0[4 * gq] * inv, o0[4 * gq + 1] * inv); w.y = pk2(o0[4 * gq + 2] * inv, o0[4 * gq + 3] * inv); *(u32x2*)(orow + 8 * gq + 4 * h) = w;
        w.x = pk2(o1[4 * gq] * inv, o1[4 * gq + 1] * inv); w.y = pk2(o1[4 * gq + 2] * inv, o1[4 * gq + 3] * inv); *(u32x2*)(orow + 32 + 8 * gq + 4 * h) = w; }
    __syncthreads();
}
struct RetRaw { u32x4 kra, krb, vra, vrb, qra, qrb; u32x2 gg[8]; };
DI void ret_fetch(Frame& F, int su, RetRaw& R) {
    const bf16* PX = (const bf16*)(F.ws + WS_P);
    bool isctx; int b, hh, n; ret_unit_decode(su, isctx, b, hh, n);
    const int row0 = isctx ? (b * CTXL + n * 128) : (NCTX + b * SEQ + n * 128);
    const int dir = F.wave >> 2, qb = F.wave & 3, l32 = F.lane & 31, h = F.lane >> 5; const int iq = 32 * qb + l32;
    const int ktok = (F.tid & 255) >> 1, khp = F.tid & 1;
    const bf16* kp = PX + (size_t)(row0 + ktok) * INW + C_RK + 32 * hh;
    R.kra = *(const u32x4*)(kp + 8 * khp); R.krb = *(const u32x4*)(kp + 16 + 8 * khp);
    const int vtok = F.tid >> 2, vch = F.tid & 3; const bf16* vp = PX + (size_t)(row0 + vtok) * INW + C_RV + 64 * hh + 16 * vch;
    R.vra = *(const u32x4*)vp; R.vrb = *(const u32x4*)(vp + 8);
    const bf16* qp = PX + (size_t)(row0 + iq) * INW + C_RQ + 32 * hh;
    R.qra = *(const u32x4*)(qp + 8 * h); R.qrb = *(const u32x4*)(qp + 16 + 8 * h);
    const bf16* gp = PX + (size_t)(row0 + iq) * INW + (dir ? C_GB : C_GF) + 64 * hh;
#pragma unroll
    for (int et = 0; et < 2; ++et)
#pragma unroll
        for (int gq = 0; gq < 4; ++gq) R.gg[et * 4 + gq] = *(const u32x2*)(gp + 32 * et + 8 * gq + 4 * h);
}
DI void ret_out_units(Frame& F, int l, int nret) {
    bf16* YC = (bf16*)(F.ws + WS_U);
    LAS unsigned char* Kimg = F.lds;
    LAS unsigned char* Vimg = F.lds + 10240;
    LAS unsigned char* Stf = F.lds + 28672;
    LAS unsigned char* Stb = F.lds + 33792;
    LAS float* Ob = (LAS float*)(F.lds + 38912);
    const int dir = F.wave >> 2, qb = F.wave & 3, l32 = F.lane & 31, h = F.lane >> 5, grp = (F.lane >> 4) & 1, i16 = F.lane & 15, q = i16 >> 2, p = i16 & 3;
    const int iq = 32 * qb + l32;
    const int ktok = (F.tid & 255) >> 1, khp = F.tid & 1, vtok = F.tid >> 2, vch = F.tid & 3;
    int su = F.vb;
    if (su >= nret) return;
    RetRaw R; ret_fetch(F, su, R);
    for (; su < nret; su += F.G) {
        bool isctx; int b, hh, n; ret_unit_decode(su, isctx, b, hh, n);
        const int row0 = isctx ? (b * CTXL + n * 128) : (NCTX + b * SEQ + n * 128);
        float lg2f, lg2b; ret_consts(F, l, hh, lg2f, lg2b);
        if (F.tid < 256) { float x1[8], x2[8]; rope_apply(F, R.kra, R.krb, khp, !isctx, n * 128 + ktok, x1, x2);
            const float ks = 0.17677669529663687f; u32x4 o;
            o.x = pk2(x1[0] * ks, x1[1] * ks); o.y = pk2(x1[2] * ks, x1[3] * ks); o.z = pk2(x1[4] * ks, x1[5] * ks); o.w = pk2(x1[6] * ks, x1[7] * ks); *(LAS u32x4*)(Kimg + ktok * 80 + 16 * khp) = o;
            o.x = pk2(x2[0] * ks, x2[1] * ks); o.y = pk2(x2[2] * ks, x2[3] * ks); o.z = pk2(x2[4] * ks, x2[5] * ks); o.w = pk2(x2[6] * ks, x2[7] * ks); *(LAS u32x4*)(Kimg + ktok * 80 + 32 + 16 * khp) = o; }
        *(LAS u32x4*)(Vimg + vtok * 144 + 32 * vch) = R.vra; *(LAS u32x4*)(Vimg + vtok * 144 + 32 * vch + 16) = R.vrb;
        bf16x8 qf[2], qd[2];
        { float x1[8], x2[8]; rope_apply(F, R.qra, R.qrb, h, !isctx, n * 128 + iq, x1, x2);
          const float dec = dir == 0 ? fast_exp2(lg2f * (float)(iq + 1)) : fast_exp2(lg2b * (float)(128 - iq));
          u32x4 w;
          w.x = pk2(x1[0], x1[1]); w.y = pk2(x1[2], x1[3]); w.z = pk2(x1[4], x1[5]); w.w = pk2(x1[6], x1[7]); qf[0] = __builtin_bit_cast(bf16x8, w);
          w.x = pk2(x2[0], x2[1]); w.y = pk2(x2[2], x2[3]); w.z = pk2(x2[4], x2[5]); w.w = pk2(x2[6], x2[7]); qf[1] = __builtin_bit_cast(bf16x8, w);
          w.x = pk2(x1[0] * dec, x1[1] * dec); w.y = pk2(x1[2] * dec, x1[3] * dec); w.z = pk2(x1[4] * dec, x1[5] * dec); w.w = pk2(x1[6] * dec, x1[7] * dec); qd[0] = __builtin_bit_cast(bf16x8, w);
          w.x = pk2(x2[0] * dec, x2[1] * dec); w.y = pk2(x2[2] * dec, x2[3] * dec); w.z = pk2(x2[4] * dec, x2[5] * dec); w.w = pk2(x2[6] * dec, x2[7] * dec); qd[1] = __builtin_bit_cast(bf16x8, w); }
        u32x2 gcur[8];
#pragma unroll
        for (int i = 0; i < 8; ++i) gcur[i] = R.gg[i];
        const float cf = fast_exp2(lg2f * 128.0f), cb = fast_exp2(lg2b * 128.0f);
        const float* SC = (const float*)(F.ws + WS_SUMCTX) + (size_t)((b * 4 + hh) * 2) * 2 * 2048;
        const float* SL = (const float*)(F.ws + WS_SUMLAT) + (size_t)((b * 4 + hh) * 16) * 2 * 2048;
        const int eo = 4 * F.tid;
        f32x4 t[16], c00, c10, c11, c01;
        if (!isctx) {
#pragma unroll
            for (int m = 0; m < 16; ++m) t[m] = *(const f32x4*)(SL + (size_t)(m * 2 + (m <= n ? 0 : 1)) * 2048 + eo);
            c00 = *(const f32x4*)(SC + (0 * 2 + 0) * 2048 + eo); c10 = *(const f32x4*)(SC + (1 * 2 + 0) * 2048 + eo);
            c11 = *(const f32x4*)(SC + (1 * 2 + 1) * 2048 + eo); c01 = *(const f32x4*)(SC + (0 * 2 + 1) * 2048 + eo);
        } else {
#pragma unroll
            for (int m = 0; m < 16; ++m) t[m] = (f32x4){0.f, 0.f, 0.f, 0.f};
            c00 = *(const f32x4*)(SC + (0 * 2 + 0) * 2048 + eo); c11 = *(const f32x4*)(SC + (1 * 2 + 1) * 2048 + eo); c10 = c00; c01 = c11;
        }
        __syncthreads();
        f32x16 o0, o1;
#pragma unroll
        for (int i = 0; i < 16; ++i) { o0[i] = 0.f; o1[i] = 0.f; }
        const float lgd = dir ? lg2b : lg2f;
        const int kt_lo = dir ? qb : 0, kt_hi = dir ? 3 : qb;
        for (int kt = kt_lo; kt <= kt_hi; ++kt) {
            f32x16 sc;
#pragma unroll
            for (int i = 0; i < 16; ++i) sc[i] = 0.f;
#pragma unroll
            for (int si = 0; si < 2; ++si) { const bf16x8 a = *(const LAS bf16x8*)(Kimg + (32 * kt + l32) * 80 + (16 * si + 8 * h) * 2); sc = MFMA32(a, qf[si], sc); }
            float pp[16];
#pragma unroll
            for (int i = 0; i < 16; ++i) { const int j = 32 * kt + crow(i, h); const int diff = dir ? (j - iq) : (iq - j); pp[i] = diff >= 0 ? sc[i] * fast_exp2(lgd * (float)diff) : 0.f; }
            bf16x8 pf[2];
#pragma unroll
            for (int s2 = 0; s2 < 2; ++s2) { u32x4 w; w.x = pk2(pp[8 * s2], pp[8 * s2 + 1]); w.y = pk2(pp[8 * s2 + 2], pp[8 * s2 + 3]); w.z = pk2(pp[8 * s2 + 4], pp[8 * s2 + 5]); w.w = pk2(pp[8 * s2 + 6], pp[8 * s2 + 7]); pf[s2] = __builtin_bit_cast(bf16x8, w); }
#pragma unroll
            for (int s2 = 0; s2 < 2; ++s2) { const int r0 = 32 * kt + 16 * s2 + 4 * h + q;
#pragma unroll
                for (int et = 0; et < 2; ++et) { const int cbo = (32 * et + 16 * grp + 4 * p) * 2;
                    const s16x4 lo = trread(Vimg + r0 * 144 + cbo), hi = trread(Vimg + (r0 + 8) * 144 + cbo);
                    const bf16x8 a = __builtin_shufflevector(lo, hi, 0, 1, 2, 3, 4, 5, 6, 7);
                    if (et == 0) o0 = MFMA32(a, pf[s2], o0); else o1 = MFMA32(a, pf[s2], o1); } }
        }
        { f32x4 sf = (f32x4){0.f, 0.f, 0.f, 0.f}, sb = sf;
          if (!isctx) {
              sf = c00 * cf + c10;
#pragma unroll
              for (int m = 0; m < 16; ++m) { const f32x4 nv = sf * cf + t[m]; sf = (m < n) ? nv : sf; }
              sb = c11 * cb + c01;
#pragma unroll
              for (int m = 15; m >= 0; --m) { const f32x4 nv = sb * cb + t[m]; sb = (m > n) ? nv : sb; }
          } else { if (n == 1) sf = c00; if (n == 0) sb = c11; }
          const int e = eo >> 5, d = eo & 31; u32x2 w;
          w.x = pk2(sf[0], sf[1]); w.y = pk2(sf[2], sf[3]); *(LAS u32x2*)(Stf + e * 80 + d * 2) = w;
          w.x = pk2(sb[0], sb[1]); w.y = pk2(sb[2], sb[3]); *(LAS u32x2*)(Stb + e * 80 + d * 2) = w; }
        __syncthreads();
        { LAS const unsigned char* St = dir ? Stb : Stf;
#pragma unroll
          for (int s2 = 0; s2 < 2; ++s2) { const bf16x8 a0 = *(const LAS bf16x8*)(St + l32 * 80 + (16 * s2 + 8 * h) * 2), a1 = *(const LAS bf16x8*)(St + (32 + l32) * 80 + (16 * s2 + 8 * h) * 2);
              o0 = MFMA32(a0, qd[s2], o0); o1 = MFMA32(a1, qd[s2], o1); } }
        if (su + F.G < nret) ret_fetch(F, su + F.G, R);
        float sm = 0.f;
#pragma unroll
        for (int i = 0; i < 16; ++i) sm += o0[i] + o1[i];
        sm += __shfl_xor(sm, 32);
        const float mu = sm * (1.0f / 64.0f);
        float vs = 0.f;
#pragma unroll
        for (int i = 0; i < 16; ++i) { const float d0 = o0[i] - mu, d1 = o1[i] - mu; vs += d0 * d0 + d1 * d1; }
        vs += __shfl_xor(vs, 32);
        const float rstd = 1.0f / sqrtf(vs * (1.0f / 64.0f) + EPS);
        const float* gn = F.in[I_RGNW] + l * 256 + 64 * hh;
        float val[32];
#pragma unroll
        for (int et = 0; et < 2; ++et)
#pragma unroll
            for (int gq = 0; gq < 4; ++gq) { const int e0 = 32 * et + 8 * gq + 4 * h; const u32x2 ggv = gcur[et * 4 + gq]; const f32x4 gw = *(const f32x4*)(gn + e0);
                const float g0 = bflo(ggv.x), g1 = bfhi(ggv.x), g2 = bflo(ggv.y), g3 = bfhi(ggv.y);
                const float a0 = et ? o1[4 * gq] : o0[4 * gq], a1 = et ? o1[4 * gq + 1] : o0[4 * gq + 1], a2 = et ? o1[4 * gq + 2] : o0[4 * gq + 2], a3 = et ? o1[4 * gq + 3] : o0[4 * gq + 3];
                val[et * 16 + 4 * gq] = (a0 - mu) * rstd * gw[0] * g0 * sigmoidf_(g0); val[et * 16 + 4 * gq + 1] = (a1 - mu) * rstd * gw[1] * g1 * sigmoidf_(g1);
                val[et * 16 + 4 * gq + 2] = (a2 - mu) * rstd * gw[2] * g2 * sigmoidf_(g2); val[et * 16 + 4 * gq + 3] = (a3 - mu) * rstd * gw[3] * g3 * sigmoidf_(g3); }
        if (dir == 0) {
#pragma unroll
            for (int et = 0; et < 2; ++et)
#pragma unroll
                for (int gq = 0; gq < 4; ++gq)
#pragma unroll
                    for (int j = 0; j < 4; ++j) Ob[iq * 65 + 32 * et + 8 * gq + 4 * h + j] = val[et * 16 + 4 * gq + j];
        }
        __syncthreads();
        if (dir == 1) { bf16* orow = YC + (size_t)(row0 + iq) * DM + 768 + 64 * hh;
#pragma unroll
            for (int et = 0; et < 2; ++et)
#pragma unroll
                for (int gq = 0; gq < 4; ++gq) { const int e0 = 32 * et + 8 * gq + 4 * h; float tt[4];
#pragma unroll
                    for (int j = 0; j < 4; ++j) tt[j] = val[et * 16 + 4 * gq + j] + Ob[iq * 65 + e0 + j];
                    u32x2 w; w.x = pk2(tt[0], tt[1]); w.y = pk2(tt[2], tt[3]); *(u32x2*)(orow + e0) = w; } }
        __syncthreads();
    }
}
#ifndef PROBE_SUB
#define PROBE_SUB 0
#endif
DI void cb_phase(Frame& F, int l) {
    rope_to_lds(F);
    const int nattn = l == 0 ? 1152 : 1024;
    for (int rep = 0; rep < ((PROBE_SUB & 1) ? 2 : 1); ++rep)
    for (int u = F.vb; u < nattn; u += F.G) {
        if (u < 1024) attn_unit(F, l, true, u >> 6, (u >> 3) & 7, u & 7);
        else { const int v = u - 1024; attn_unit(F, l, false, v >> 3, v & 7, 0); }
    }
    const int nret = l == 0 ? 1152 : 1024;
    for (int rep = 0; rep < ((PROBE_SUB & 2) ? 2 : 1); ++rep) ret_out_units(F, l, nret);
}

static_assert(sizeof(Params) == 240, "kernarg layout: in[26] at 0, out at 208, ws at 216, ph_lo at 224, ph_hi at 228");
#ifdef ONLY_PHASE
#define IN(k) ((k) == ONLY_PHASE && lo <= (k) && (k) < hi)
#else
#define IN(k) (lo <= (k) && (k) < hi)
#endif
#ifndef PROBE_MASK
#define PROBE_MASK 0u
#endif
#define NREP(k) (((PROBE_MASK >> (k)) & 1u) ? 2 : 1)
#define SEAM(k) do { if (IN(k) && IN((k) + 1)) { XcdBarrier bb_ = bar; asm volatile("" : "+s"(bb_.bar)); xcd_barrier(bb_, F.wave); } } while (0)
#define GLDS(P) ((LAS unsigned char*)(P).lds)
#define WSB(P, off) ((const pg8::bf16_t*)((P).ws + (off)))
template <int l> DI void layer_phases(Frame& F, const XcdBarrier& bar) {
    constexpr int lo = 0, hi = N_PHASES;
        const int pb = l == 0 ? 1 : 9;
        if (IN(pb + 0)) for (int rep_ = 0; rep_ < NREP(pb + 0); ++rep_) { if (rep_) __syncthreads(); Frame P = phase_frame(F); norm_phase(P, l, 1, l == 0, 0); } SEAM(pb + 0);
        if (IN(pb + 1)) for (int rep_ = 0; rep_ < NREP(pb + 1); ++rep_) { if (rep_) __syncthreads();
            Frame P = phase_frame(F);
            pg8::StaticOrder S; S.init(NTOK, INW, P.G, P.bid);
            pg8::EpiStoreBf16 E{(pg8::bf16_t*)(P.ws + WS_P), INW};
            pg8::gemm_phase<pg8::EpiStoreBf16, pg8::StaticOrder, pg8::RowsLinear, true>(GLDS(P), P.tid, WSB(P, WS_U), WSB(P, WS_WIN) + (size_t)l * INW * DM, 2 * DM, S, E, pg8::RowsLinear{});
            if (PROBE_SUB & 4) { __syncthreads(); pg8::gemm_phase<pg8::EpiNull, pg8::StaticOrder, pg8::RowsLinear, true>(GLDS(P), P.tid, WSB(P, WS_U), WSB(P, WS_WIN) + (size_t)l * INW * DM, 2 * DM, S, pg8::EpiNull{}, pg8::RowsLinear{}); }
            if (l == 0) bg_convert_tail(P, S.nwg, BG_B0, BG_D0); else bg_convert_tail(P, S.nwg, BG_B1, BG_CL);
        } SEAM(pb + 1);
        if (IN(pb + 2)) for (int rep_ = 0; rep_ < NREP(pb + 2); ++rep_) { if (rep_) __syncthreads(); Frame P = phase_frame(F); if (l == 1) { bg_convert_all(P, BG_CL, BG_ITEMS); __syncthreads(); } ca_phase(P, l); } SEAM(pb + 2);
        if (IN(pb + 3)) for (int rep_ = 0; rep_ < NREP(pb + 3); ++rep_) { if (rep_) __syncthreads(); Frame P = phase_frame(F); cb_phase(P, l); } SEAM(pb + 3);
        if (IN(pb + 4)) {
            Frame P = phase_frame(F);
            const int rb = l == 0 ? 0 : NCTX;
            const float* modlat = (const float*)(P.ws + WS_MODLAT) + (size_t)l * 16 * 6144;
            const float* modctx = (const float*)(P.ws + WS_MODCTX) + (size_t)l * 6144;
            float* hctx = (float*)(P.ws + WS_HCTX);
            pg8::StaticOrder S; S.init(NTOK - rb, DM, P.G, P.bid);
            pg8::EpiResGate E{l == 0 ? P.in[I_CTX] : hctx, l == 0 ? P.in[I_X] : P.out, hctx, P.out, modlat + 2 * DM, modctx + 2 * DM, rb};
            pg8::gemm_phase<pg8::EpiResGate, pg8::StaticOrder, pg8::RowsLinear, true>(GLDS(P), P.tid, WSB(P, WS_U) + (size_t)rb * DM, WSB(P, WS_WOUT) + (size_t)l * DM * DM, 2 * DM, S, E, pg8::RowsLinear{});
            if (l == 0) bg_convert_tail(P, S.nwg, BG_D0, BG_E0);
        } SEAM(pb + 4);
        if (l == 0) {
            if (IN(6)) for (int rep_ = 0; rep_ < NREP(6); ++rep_) { if (rep_) __syncthreads(); Frame P = phase_frame(F); norm_phase(P, 0, 2, false, 0, DENSE_FP8 == 1); } SEAM(6);
            if (IN(7)) for (int rep_ = 0; rep_ < NREP(7); ++rep_) { if (rep_) __syncthreads();
                Frame P = phase_frame(F);
                pg8::StaticOrder S; S.init(NTOK, 2 * DFF, P.G, P.bid);
                pg8::EpiSwiglu<false> E{(pg8::bf16_t*)(P.ws + WS_P), DFF, 0, nullptr};
#if DENSE_FP8 == 1
                pg8::gemm_phase<pg8::EpiSwiglu<false>, pg8::StaticOrder, pg8::RowsLinearOff, true, true>(GLDS(P), P.tid, WSB(P, WS_U), WSB(P, WS_WGU), DM, S, E, pg8::RowsLinearOff{}, SCL_U, SCL_WGU);
#else
                pg8::gemm_phase<pg8::EpiSwiglu<false>, pg8::StaticOrder, pg8::RowsLinear, true>(GLDS(P), P.tid, WSB(P, WS_U), WSB(P, WS_WGU), 2 * DM, S, E, pg8::RowsLinear{});
#endif
                bg_convert_tail(P, S.nwg, BG_E0, BG_F0);
            } SEAM(7);
            if (IN(8)) {
                Frame P = phase_frame(F);
                const float* modlat = (const float*)(P.ws + WS_MODLAT);
                const float* modctx = (const float*)(P.ws + WS_MODCTX);
                float* hctx = (float*)(P.ws + WS_HCTX);
                pg8::StaticOrder S; S.init(NTOK, DM, P.G, P.bid);
                pg8::EpiResGate E{hctx, P.out, hctx, P.out, modlat + 5 * DM, modctx + 5 * DM, 0};
#if DENSE_FP8
                pg8::gemm_phase<pg8::EpiResGate, pg8::StaticOrder, pg8::RowsLinearOff, true, true>(GLDS(P), P.tid, WSB(P, WS_P), WSB(P, WS_WD), DFF, S, E, pg8::RowsLinearOff{}, SCL_H, SCL_WD);
#else
                pg8::gemm_phase<pg8::EpiResGate, pg8::StaticOrder, pg8::RowsLinear, true>(GLDS(P), P.tid, WSB(P, WS_P), WSB(P, WS_WD), 2 * DFF, S, E, pg8::RowsLinear{});
#endif
                bg_convert_tail(P, S.nwg, BG_F0, BG_B1);
            } SEAM(8);
        } else {
            if (IN(14)) for (int rep_ = 0; rep_ < NREP(14); ++rep_) { if (rep_) __syncthreads(); Frame P = phase_frame(F); norm_moe_phase(P); } SEAM(14);
            if (IN(15)) for (int rep_ = 0; rep_ < NREP(15); ++rep_) { if (rep_) __syncthreads(); Frame P = phase_frame(F); moe_route_phase(P); } SEAM(15);
            LAS int* texp = (LAS int*)(F.lds + AUX_TAB);
            if (IN(16) || IN(17)) {
                Frame P = phase_frame(F);
                const int* meta = (const int*)(P.ws + WS_META);
                __syncthreads();
                for (int i = P.tid; i < 2 * MOE_TILES; i += 512) texp[i] = ld_i32_coherent(meta + (i / MOE_TILES) * 256 + 1 + (i % MOE_TILES));
                if (P.tid < 2) texp[2 * MOE_TILES + P.tid] = ld_i32_coherent(meta + P.tid * 256);
                __syncthreads();
            }
            if (IN(16)) for (int rep_ = 0; rep_ < NREP(16); ++rep_) { if (rep_) __syncthreads();
                Frame P = phase_frame(F);
                const int NT0 = __builtin_amdgcn_readfirstlane(texp[2 * MOE_TILES]), NT1 = __builtin_amdgcn_readfirstlane(texp[2 * MOE_TILES + 1]);
                pg8::MoeOrder S{NT0, NT1, 28, P.G, P.bid, (const LAS int*)texp};
                pg8::EpiSwiglu<true> E{(pg8::bf16_t*)(P.ws + WS_P), DFE, 28, (const float*)(P.ws + WS_PROW)};
                pg8::gemm_phase<pg8::EpiSwiglu<true>, pg8::MoeOrder, pg8::RowsGather, true, true>(GLDS(P), P.tid, WSB(P, WS_U), WSB(P, WS_MGU), DM, S, E, pg8::RowsGather{(const int*)(P.ws + WS_ROWMAP), 0}, SCL_U, SCL_WGU);
            } SEAM(16);
            if (IN(17)) {
                Frame P = phase_frame(F);
                const float* modlat = (const float*)(P.ws + WS_MODLAT) + (size_t)16 * 6144;
                const int NT0 = __builtin_amdgcn_readfirstlane(texp[2 * MOE_TILES]), NT1 = __builtin_amdgcn_readfirstlane(texp[2 * MOE_TILES + 1]);
                pg8::MoeOrder S{NT0, NT1, 4, P.G, P.bid, (const LAS int*)texp};
                pg8::EpiMoeScatter E{(const int*)(P.ws + WS_ROWMAP), (const float*)(P.ws + WS_PROW), P.out, (pg8::bf16_t*)(P.ws + WS_U), modlat + 5 * DM, 4};
                pg8::gemm_phase<pg8::EpiMoeScatter, pg8::MoeOrder, pg8::RowsLinearOff, true, true>(GLDS(P), P.tid, P.ws + WS_P, WSB(P, WS_MD), DFE, S, E, pg8::RowsLinearOff{}, SCL_H, SCL_WD);
            } SEAM(17);
        }
}
__global__ void __launch_bounds__(512, 2) fwd_kernel(Params prm) {
    extern __shared__ __attribute__((aligned(16))) unsigned char lds_raw[];
    Frame F;
    F.lds = (LAS unsigned char*)lds_raw;
    F.tid = threadIdx.x; F.lane = F.tid & 63; F.wave = __builtin_amdgcn_readfirstlane(F.tid >> 6);
    F.G = gridDim.x; F.bid = blockIdx.x; F.vb = F.bid;
    F.in.ka = (karg_t)__builtin_amdgcn_kernarg_segment_ptr(); F.out = prm.out; F.ws = prm.ws;
    volatile LAS unsigned* MISC = (volatile LAS unsigned*)(F.lds + AUX_OFF);
    if (F.tid < 64) MISC[F.tid] = 0u;
    __syncthreads();
    XcdBarrier bar; bar.bar = (unsigned*)(prm.ws + WS_CTL) + 1024; bar.x = 0; bar.st = nullptr;
#if MK_PER_PHASE
    const int lo = prm.ph_lo, hi = prm.ph_hi;
#else
    constexpr int lo = 0, hi = N_PHASES;
#endif
    if (hi - lo > 1) bar = xcd_barrier_post((unsigned*)(prm.ws + WS_CTL) + 1024, MISC + 8);

    if (IN(0)) for (int rep_ = 0; rep_ < NREP(0); ++rep_) { if (rep_) __syncthreads(); Frame P = phase_frame(F); p0_prologue(P); } SEAM(0);
    layer_phases<0>(F, bar);
    layer_phases<1>(F, bar);
    if (IN(PH_FINAL)) { Frame P = phase_frame(F); final_phase(P); }
#undef IN
#undef SEAM
}

extern "C" void kernel_launch(void* const* d_in, const int* in_sizes, int n_in, void* d_out, int out_size, void* d_ws, size_t ws_size, hipStream_t stream) {
    static int grid = 0;
    if (grid == 0) {
        if (n_in != 26 || in_sizes[0] != NLAT * DM || out_size != NLAT * DM || ws_size < WS_END) {
            fprintf(stderr, "kernel_launch: unexpected shapes (n_in %d, in0 %d, out %d, ws %zu, need %zu); nothing launched\n", n_in, n_in > 0 ? in_sizes[0] : -1, out_size, ws_size, (size_t)WS_END); grid = -1; return; }
        int dev = 0, cus = 0, per_cu = 0;
        if (hipGetDevice(&dev) != hipSuccess || hipDeviceGetAttribute(&cus, hipDeviceAttributeMultiprocessorCount, dev) != hipSuccess) { grid = -1; return; }
        if (hipFuncSetAttribute((const void*)fwd_kernel, hipFuncAttributeMaxDynamicSharedMemorySize, LDS_BYTES) != hipSuccess) { fprintf(stderr, "kernel_launch: hipFuncSetAttribute failed\n"); grid = -1; return; }
        if (hipOccupancyMaxActiveBlocksPerMultiprocessor(&per_cu, (const void*)fwd_kernel, 512, LDS_BYTES) != hipSuccess || per_cu < 1)
            fprintf(stderr, "kernel_launch: note: occupancy query reports %d workgroups per CU\n", per_cu);
        (void)hipGetLastError();
        grid = cus;
    }
    if (grid < 0) return;
    if (hipMemsetAsync((char*)d_ws + WS_CTL, 0, CTL_ZERO_BYTES, stream) != hipSuccess) return;
    Params p{};
    for (int i = 0; i < 26; ++i) p.in[i] = (const float*)d_in[i];
    p.out = (float*)d_out; p.ws = (unsigned char*)d_ws;
#if MK_PER_PHASE
    for (int ph = 0; ph < N_PHASES; ++ph) { p.ph_lo = ph; p.ph_hi = ph + 1; hipLaunchKernelGGL(fwd_kernel, dim3(grid), dim3(512), LDS_BYTES, stream, p); }
#else
    p.ph_lo = 0; p.ph_hi = N_PHASES;
    hipLaunchKernelGGL(fwd_kernel, dim3(grid), dim3(512), LDS_BYTES, stream, p);
#endif
}
```

```cpp
#include <hip/hip_runtime.h>
#include <cstdio>
#include <cstdint>

#ifndef PROBE_SUB
#define PROBE_SUB 0
#endif
#ifndef MK_PER_PHASE
#define MK_PER_PHASE 0
#endif

#define LAS __attribute__((address_space(3)))
#define GAS __attribute__((address_space(1)))
#define DI __device__ __forceinline__
typedef unsigned short bf16;
typedef short bf16x8 __attribute__((ext_vector_type(8)));
typedef short s16x4 __attribute__((ext_vector_type(4)));
typedef float f32x4 __attribute__((ext_vector_type(4)));
typedef float f32x16 __attribute__((ext_vector_type(16)));
typedef unsigned u32x4 __attribute__((ext_vector_type(4)));
typedef unsigned u32x2 __attribute__((ext_vector_type(2)));
typedef float f32x2_t __attribute__((ext_vector_type(2)));
typedef __bf16 bf16x2_t __attribute__((ext_vector_type(2)));
typedef short v4i16_t __attribute__((ext_vector_type(4)));

constexpr int DM = 1024, NB = 16, SEQ = 2048, CTXL = 256, GW = 64;
constexpr int NLAT = NB * SEQ, NCTX = NB * CTXL, NTOK = NLAT + NCTX;
constexpr int INW = 3072, DFF = 2816, NE = 8, DFE = 3584;
constexpr int C_NAQ = 0, C_NAK = 512, C_NAV = 1024, C_CONV = 1536, C_RQ = 2048, C_RK = 2176, C_RV = 2304, C_GF = 2560, C_GB = 2816;
constexpr float EPS = 1e-6f;
constexpr float LOG2E = 1.4426950408889634f;

constexpr size_t MiB = 1u << 20;
constexpr size_t WS_CTL = 0, CTL_ZERO_BYTES = 64 * 1024;
constexpr size_t WS_MODLAT = 1 * MiB;
constexpr size_t WS_MODCTX = WS_MODLAT + 2 * 16 * 6144 * 4;
constexpr size_t WS_ROPE = WS_MODCTX + 2 * 6144 * 4;
constexpr size_t WS_PTOK = 2 * MiB;
constexpr size_t WS_SEGCNT = WS_PTOK + 32768 * 2 * 4;
constexpr size_t WS_META = WS_SEGCNT + 256 * 2 * 8 * 4;
constexpr size_t WS_SEGLIST = 3 * MiB;
constexpr size_t WS_ROWMAP = 5 * MiB;
constexpr int MOE_ROWS = 34816;
constexpr int MOE_TILES = MOE_ROWS / 256;
constexpr size_t WS_PROW = WS_ROWMAP + 512 * 1024;
constexpr size_t WS_SUMLAT = 6 * MiB;
constexpr size_t WS_SUMCTX = 22 * MiB;
constexpr size_t WS_WIN = 24 * MiB;
constexpr size_t WS_WOUT = WS_WIN + (size_t)2 * 3072 * 1024 * 2;
constexpr size_t WS_WGU = WS_WOUT + (size_t)2 * 1024 * 1024 * 2;
constexpr size_t WS_WD = WS_WGU + (size_t)5632 * 1024 * 2;
constexpr size_t WS_MGU = WS_WD + (size_t)1024 * 2816 * 2;
constexpr size_t WS_MD = WS_MGU + (size_t)8 * 7168 * 1024 * 2;
constexpr size_t WS_HCTX = WS_MD + (size_t)8 * 1024 * 3584 * 2;
constexpr size_t WS_U = WS_HCTX + (size_t)NCTX * DM * 4;
constexpr size_t WS_P = WS_U + (size_t)NTOK * DM * 2;
constexpr size_t WS_END = WS_P + (size_t)MOE_ROWS * DFE * 2;
static_assert((size_t)NTOK * INW * 2 <= (size_t)MOE_ROWS * DFE * 2, "P region: px | dense hidden | fp8 hidden of both MoE slots (2 x MOE_ROWS x DFE bytes)");
static_assert(WS_WIN % 256 == 0 && WS_WOUT % 256 == 0 && WS_WGU % 256 == 0 && WS_WD % 256 == 0 && WS_MGU % 256 == 0 && WS_MD % 256 == 0 && WS_HCTX % 256 == 0 && WS_U % 256 == 0 && WS_P % 256 == 0, "align");

constexpr int RING_BYTES = 131072;
constexpr int AUX_OFF = RING_BYTES;
constexpr int AUX_TAB = AUX_OFF + 1024;
constexpr int LDS_BYTES = 147456;

#ifndef MOE_FP8
#define MOE_FP8 1
#endif
#ifndef DENSE_FP8
#define DENSE_FP8 2
#endif
constexpr int SCL_U = 0x7c7c7c7c, SCL_WGU = 0x79797979, SCL_H = 0x7c7c7c7c, SCL_WD = 0x78787878;
constexpr float QS_U = 8.0f, QS_WGU = 64.0f, QS_H = 8.0f, QS_WD = 128.0f;
DI unsigned pk2(float lo, float hi) { f32x2_t v = {lo, hi}; bf16x2_t b = __builtin_convertvector(v, bf16x2_t); return __builtin_bit_cast(unsigned, b); }
DI float clamp448(float x) { return __builtin_fminf(__builtin_fmaxf(x, -448.0f), 448.0f); }
DI unsigned pk4_fp8(float a, float b, float c, float d) { int w = 0; w = __builtin_amdgcn_cvt_pk_fp8_f32(clamp448(a), clamp448(b), w, false); w = __builtin_amdgcn_cvt_pk_fp8_f32(clamp448(c), clamp448(d), w, true); return (unsigned)w; }
DI float bflo(unsigned u) { return __uint_as_float(u << 16); }
DI float bfhi(unsigned u) { return __uint_as_float(u & 0xffff0000u); }
DI float wave_sum(float v) {
#pragma unroll
    for (int o = 1; o < 64; o <<= 1) v += __shfl_xor(v, o);
    return v;
}
DI float fast_exp2(float x) { return __builtin_amdgcn_exp2f(x); }
DI float fast_rcp(float x) { return __builtin_amdgcn_rcpf(x); }
DI float sigmoidf_(float x) { return fast_rcp(1.0f + fast_exp2(-x * LOG2E)); }
DI int crow(int reg, int h) { return (reg & 3) + 8 * (reg >> 2) + 4 * h; }
#define MFMA32(a, b, c) __builtin_amdgcn_mfma_f32_32x32x16_bf16((a), (b), (c), 0, 0, 0)
DI s16x4 trread(LAS const unsigned char* p) { return __builtin_bit_cast(s16x4, __builtin_amdgcn_ds_read_tr16_b64_v4i16((LAS v4i16_t*)p)); }
DI int ld_i32_coherent(const int* p) { return (int)__hip_atomic_load((const unsigned*)p, __ATOMIC_RELAXED, __HIP_MEMORY_SCOPE_AGENT); }

namespace pg8 {
#define PG8_LAS __attribute__((address_space(3)))
typedef unsigned short bf16_t;
constexpr int BM = 256, BK = 64, HALF = 128, HTB = HALF * BK * 2, STAGE_BYTES = 8 * HTB, NXCD = 8, WGM = 8;
__host__ __device__ __forceinline__ int lds_byte(int r, int c) { const int st = (r >> 4) * 2 + (c >> 5), rr = r & 15, cc = c & 31, ob = rr * 64 + cc * 2; return st * 1024 + (ob ^ (((ob >> 9) & 1) << 5)); }
__host__ __device__ __forceinline__ void stage_rc(int b, int& R, int& C) { const int st = b / 1024, sb = b % 1024, swz = sb ^ (((sb >> 9) & 1) << 5); R = (st >> 1) * 16 + swz / 64; C = (st & 1) * 32 + (swz % 64) / 2; }
__host__ __device__ __forceinline__ int perm32(int rho) { const int n = rho >> 4, i = rho & 15; return 8 * (i >> 2) + 4 * n + (i & 3); }
struct Unit { int pm, pn; };
struct StaticOrder {
    int nM, nN, nwg, G, c;
    __device__ void init(int M, int N, int G_, int c_) { nM = M / BM; nN = N / BM; nwg = nM * nN; G = G_; c = c_; }
    __device__ bool next(int i, Unit& u) const {
        const long L = (long)i * G + c; if (L >= nwg) return false;
        int wgid = (int)L; { const int q = nwg / NXCD, r = nwg % NXCD, xcd = wgid % NXCD, off = wgid / NXCD; wgid = (xcd < r ? xcd * (q + 1) : r * (q + 1) + (xcd - r) * q) + off; }
        const int nig = WGM * nN, gid = wgid / nig, fm = gid * WGM, gsz = (nM - fm) < WGM ? (nM - fm) : WGM;
        u.pm = fm + ((wgid % nig) % gsz); u.pn = (wgid % nig) / gsz; return true;
    }
};
struct RowsLinear { static constexpr bool GATHER = false; };
struct RowsLinearOff {
    static constexpr bool GATHER = true;
    __device__ __forceinline__ void fetch(const Unit& u, const int (&R)[2], int (&raw)[2][2]) const {
#pragma unroll
        for (int h = 0; h < 2; ++h)
#pragma unroll
            for (int i = 0; i < 2; ++i) raw[h][i] = u.pm * BM + h * HALF + R[i];
    }
    __device__ __forceinline__ void make(const int (&raw)[2][2], const int (&C)[2], int pitch, unsigned (&o)[2][2]) const {
#pragma unroll
        for (int h = 0; h < 2; ++h)
#pragma unroll
            for (int i = 0; i < 2; ++i) { o[h][i] = (unsigned)raw[h][i] * (unsigned)pitch + (unsigned)C[i] * 2u; asm volatile("" : "+v"(o[h][i])); }
    }
};
struct RowsGather {
    static constexpr bool GATHER = true;
    const int* rowmap; int row_add;
    __device__ __forceinline__ void fetch(const Unit& u, const int (&R)[2], int (&raw)[2][2]) const {
#pragma unroll
        for (int h = 0; h < 2; ++h)
#pragma unroll
            for (int i = 0; i < 2; ++i) raw[h][i] = rowmap[u.pm * BM + h * HALF + R[i]];
    }
    __device__ __forceinline__ void make(const int (&raw)[2][2], const int (&C)[2], int pitch, unsigned (&o)[2][2]) const {
#pragma unroll
        for (int h = 0; h < 2; ++h)
#pragma unroll
            for (int i = 0; i < 2; ++i) { int t = raw[h][i]; t = t < 0 ? 0 : t; o[h][i] = (unsigned)((size_t)(t + row_add) * (size_t)pitch + (size_t)C[i] * 2u); }
#pragma unroll
        for (int h = 0; h < 2; ++h)
#pragma unroll
            for (int i = 0; i < 2; ++i) asm volatile("" : "+v"(o[h][i]));
    }
};

typedef int i32x8 __attribute__((ext_vector_type(8)));
typedef int i32x4v __attribute__((ext_vector_type(4)));
template <class Epi, class Sched, class ARows, bool ALIGN_EPI, bool FP8 = false>
__device__ __forceinline__ void gemm_phase(PG8_LAS unsigned char* lds, int tid, const void* A, const void* Bt, int pitch, const Sched& S, const Epi& E, const ARows& AR, int sclA = 0x7f7f7f7f, int sclB = 0x7f7f7f7f) {
    constexpr bool GATHER = ARows::GATHER;
    const int wid = __builtin_amdgcn_readfirstlane(tid >> 6), lane = tid & 63, wr = wid >> 2, wc = wid & 3, fr = lane & 15, fq = lane >> 4;
    const int nt = pitch / (BK * 2);
    int RA[2], CA[2]; unsigned voffA[2], voffB[2];
#pragma unroll
    for (int i = 0; i < 2; ++i) { int R, C; stage_rc(tid * 16 + i * 8192, R, C); const int Rb = Epi::PERM ? ((R & ~31) + perm32(R & 31)) : R;
        RA[i] = R; CA[i] = C; voffA[i] = (unsigned)(R * pitch + C * 2); voffB[i] = (unsigned)(Rb * pitch + C * 2); }
#pragma unroll
    for (int i = 0; i < 2; ++i) { asm volatile("" : "+v"(voffA[i])); asm volatile("" : "+v"(voffB[i])); }
    const size_t kstep = (size_t)(BK * 2);
    const size_t hstep = (size_t)HALF * pitch;
    const size_t tstep = 2 * hstep;
    const unsigned ldsw = (unsigned)wid * 1024u;
    const int aoff = lds_byte(wr * 64 + fr, fq * 8), boff = lds_byte(wc * 32 + fr, fq * 8);
    const char* Ab = (const char*)A;
#define PG8_SA(b, h) (((b) * 2 + (h)) * HTB)
#define PG8_SB(b, h) ((4 + (b) * 2 + (h)) * HTB)
#define PG8_STAGE(bufoff, gbase, voff) do { _Pragma("unroll") for (int _i = 0; _i < 2; ++_i) \
        __builtin_amdgcn_global_load_lds((const unsigned*)((const char*)(gbase) + (voff)[_i]), (PG8_LAS unsigned*)(lds + (bufoff) + ldsw + _i * 8192), 16, 0, 0); } while (0)
#define PG8_STAGEA(bufoff, h, plin, kb) do { if constexpr (GATHER) PG8_STAGE(bufoff, Ab + (kb), curA[h]); else PG8_STAGE(bufoff, (plin) + (h) * hstep, voffA); } while (0)
#define PG8_LDA(dst, b, h) do { _Pragma("unroll") for (int m = 0; m < 4; ++m) _Pragma("unroll") for (int k = 0; k < 2; ++k) dst[m][k] = *(const PG8_LAS bf16x8*)(lds + PG8_SA(b, h) + aoff + m * 2048 + k * 1024); } while (0)
#define PG8_LDB(dst, b, h) do { _Pragma("unroll") for (int n = 0; n < 2; ++n) _Pragma("unroll") for (int k = 0; k < 2; ++k) dst[n][k] = *(const PG8_LAS bf16x8*)(lds + PG8_SB(b, h) + boff + n * 2048 + k * 1024); } while (0)
#define PG8_CAT(x0, x1) __builtin_shufflevector(__builtin_bit_cast(i32x4v, x0), __builtin_bit_cast(i32x4v, x1), 0, 1, 2, 3, 4, 5, 6, 7)
#define PG8_MMA(ai, bj, At, Bt_) do { __builtin_amdgcn_s_setprio(1); \
        if constexpr (FP8) { _Pragma("unroll") for (int m = 0; m < 4; ++m) _Pragma("unroll") for (int n = 0; n < 2; ++n) \
            acc[ai][bj][m][n] = __builtin_amdgcn_mfma_scale_f32_16x16x128_f8f6f4(PG8_CAT(Bt_[n][0], Bt_[n][1]), PG8_CAT(At[m][0], At[m][1]), acc[ai][bj][m][n], 0, 0, 0, sclB, 0, sclA); } \
        else { _Pragma("unroll") for (int m = 0; m < 4; ++m) _Pragma("unroll") for (int n = 0; n < 2; ++n) _Pragma("unroll") for (int k = 0; k < 2; ++k) \
            acc[ai][bj][m][n] = __builtin_amdgcn_mfma_f32_16x16x32_bf16(Bt_[n][k], At[m][k], acc[ai][bj][m][n], 0, 0, 0); } \
        __builtin_amdgcn_s_setprio(0); } while (0)
#define PG8_WAIT_V(n) asm volatile("s_waitcnt vmcnt(" #n ")" ::: "memory")
#define PG8_WAIT_L(n) asm volatile("s_waitcnt lgkmcnt(" #n ")" ::: "memory")
#define PG8_BAR __builtin_amdgcn_s_barrier()
#define PG8_SCHED __builtin_amdgcn_sched_barrier(0)
    Unit cur, nxt; int ui = 0;
    if (!S.next(0, cur)) return;
    f32x4 acc[2][2][4][2];
#pragma unroll
    for (int a = 0; a < 2; ++a)
#pragma unroll
        for (int b = 0; b < 2; ++b)
#pragma unroll
            for (int m = 0; m < 4; ++m)
#pragma unroll
                for (int n = 0; n < 2; ++n) acc[a][b][m][n] = (f32x4){0.f, 0.f, 0.f, 0.f};
    bf16x8 At[4][2], B0[2][2], B1[2][2];
    unsigned curA[2][2] = {{0u, 0u}, {0u, 0u}}, nxtA[2][2] = {{0u, 0u}, {0u, 0u}};
    int rawN[2][2] = {{0, 0}, {0, 0}};
    if constexpr (GATHER) { int rawC[2][2]; AR.fetch(cur, RA, rawC); AR.make(rawC, CA, pitch, curA); Unit n1; if (S.next(1, n1)) AR.fetch(n1, RA, rawN); }
    const char* cA = GATHER ? Ab : Ab + (size_t)cur.pm * tstep;
    const char* cB = (const char*)Bt + (size_t)cur.pn * tstep;
    PG8_STAGE(PG8_SB(0, 0), cB, voffB); PG8_STAGE(PG8_SB(0, 1), cB + hstep, voffB); PG8_STAGEA(PG8_SA(0, 0), 0, cA, 0); PG8_STAGEA(PG8_SA(0, 1), 1, cA, 0);
    if (wr == 1) PG8_BAR;
    PG8_WAIT_V(2); PG8_BAR;
    PG8_STAGE(PG8_SB(1, 0), cB + kstep, voffB); PG8_STAGEA(PG8_SA(1, 0), 0, cA + kstep, kstep); PG8_STAGE(PG8_SB(1, 1), cB + hstep + kstep, voffB);
    PG8_WAIT_V(6); PG8_BAR;
    for (;;) {
        const bool has_next = S.next(ui + 1, nxt);
        if constexpr (GATHER) {
            if (has_next) { AR.make(rawN, CA, pitch, nxtA); Unit n2; if (S.next(ui + 2, n2)) AR.fetch(n2, RA, rawN); }
            else {
#pragma unroll
                for (int h = 0; h < 2; ++h)
#pragma unroll
                    for (int i = 0; i < 2; ++i) nxtA[h][i] = curA[h][i];
            }
        }
        const char* nA = GATHER ? Ab : (has_next ? Ab + (size_t)nxt.pm * tstep : cA);
        const char* nB = has_next ? (const char*)Bt + (size_t)nxt.pn * tstep : cB;
        for (int t = 0; t < nt; t += 2) {
            const bool last = (t == nt - 2);
            const size_t k1 = (size_t)(t + 1) * kstep, k2 = last ? 0 : (size_t)(t + 2) * kstep, k3 = k2 + kstep;
            const char* a1 = cA + k1;
            const char* a2 = last ? nA : cA + k2; const char* b2 = last ? nB : cB + k2;
            const char* a3 = a2 + kstep; const char* b3 = b2 + kstep;
            PG8_LDB(B0, 0, 0); PG8_LDB(B1, 0, 1); PG8_SCHED; PG8_LDA(At, 0, 0); PG8_STAGEA(PG8_SA(1, 1), 1, a1, k1);
            if constexpr (GATHER) { if (last) {
#pragma unroll
                for (int h = 0; h < 2; ++h)
#pragma unroll
                    for (int i = 0; i < 2; ++i) curA[h][i] = nxtA[h][i]; } }
            PG8_WAIT_V(8); PG8_WAIT_L(0); PG8_BAR; PG8_MMA(0, 0, At, B0); PG8_MMA(0, 1, At, B1); PG8_BAR; PG8_SCHED;
            PG8_LDA(At, 0, 1); PG8_STAGE(PG8_SB(0, 0), b2, voffB); PG8_STAGE(PG8_SB(0, 1), b2 + hstep, voffB); PG8_STAGEA(PG8_SA(0, 0), 0, a2, k2);
            PG8_WAIT_V(8); PG8_WAIT_L(0); PG8_BAR; PG8_MMA(1, 0, At, B0); PG8_MMA(1, 1, At, B1); PG8_BAR; PG8_SCHED;
            PG8_LDB(B0, 1, 0); PG8_LDB(B1, 1, 1); PG8_SCHED; PG8_LDA(At, 1, 0); PG8_STAGEA(PG8_SA(0, 1), 1, a2, k2);
            PG8_WAIT_V(8); PG8_WAIT_L(0); PG8_BAR; PG8_MMA(0, 0, At, B0); PG8_MMA(0, 1, At, B1); PG8_BAR; PG8_SCHED;
            PG8_LDA(At, 1, 1); PG8_STAGE(PG8_SB(1, 0), b3, voffB); PG8_STAGE(PG8_SB(1, 1), b3 + hstep, voffB); PG8_STAGEA(PG8_SA(1, 0), 0, a3, k3);
            PG8_WAIT_V(8); PG8_WAIT_L(0); PG8_BAR; PG8_MMA(1, 0, At, B0); PG8_MMA(1, 1, At, B1); PG8_BAR; PG8_SCHED;
        }
        if constexpr (ALIGN_EPI) { if (wr == 0) PG8_BAR; }
        E(acc, cur, wr, wc, fr, fq);
        if (!has_next) break;
#pragma unroll
        for (int a = 0; a < 2; ++a)
#pragma unroll
            for (int b = 0; b < 2; ++b)
#pragma unroll
                for (int m = 0; m < 4; ++m)
#pragma unroll
                    for (int n = 0; n < 2; ++n) acc[a][b][m][n] = (f32x4){0.f, 0.f, 0.f, 0.f};
        cur = nxt; cA = nA; cB = nB; ++ui;
        if constexpr (ALIGN_EPI) { if (wr == 1) PG8_BAR; }
    }
    PG8_WAIT_V(0);
    if constexpr (!ALIGN_EPI) { if (wr == 0) PG8_BAR; }
    PG8_BAR;
#undef PG8_SA
#undef PG8_SB
#undef PG8_STAGE
#undef PG8_STAGEA
#undef PG8_LDA
#undef PG8_LDB
#undef PG8_MMA
#undef PG8_CAT
#undef PG8_WAIT_V
#undef PG8_WAIT_L
#undef PG8_BAR
#undef PG8_SCHED
}

#define PG8_OPAQUE(x) asm volatile("" : "+v"(x))
struct EpiNull { static constexpr bool PERM = true; __device__ __forceinline__ void operator()(const f32x4 (&acc)[2][2][4][2], const Unit& u, int wr, int wc, int fr, int fq) const { if (u.pm < 0) {
#pragma unroll
        for (int a = 0; a < 2; ++a)
#pragma unroll
            for (int b = 0; b < 2; ++b)
#pragma unroll
                for (int m = 0; m < 4; ++m)
#pragma unroll
                    for (int n = 0; n < 2; ++n) asm volatile("" :: "v"(acc[a][b][m][n])); } } };
struct EpiStoreBf16 {
    static constexpr bool PERM = true;
    bf16_t* O; int ldc;
    __device__ __forceinline__ void operator()(const f32x4 (&acc)[2][2][4][2], const Unit& u, int wr, int wc, int fr, int fq) const {
        char* base = (char*)(O + (size_t)(u.pm * BM) * ldc + u.pn * BM);
        unsigned lb = (unsigned)((wr * 64 + fr) * ldc + wc * 32 + 8 * fq) * 2u; PG8_OPAQUE(lb);
        const unsigned rstep = (unsigned)ldc * 32u;
#pragma unroll
        for (int ai = 0; ai < 2; ++ai)
#pragma unroll
            for (int m = 0; m < 4; ++m) { const unsigned ro = lb + (unsigned)(ai * 8 + m) * rstep;
#pragma unroll
                for (int bj = 0; bj < 2; ++bj) { const f32x4 v0 = acc[ai][bj][m][0], v1 = acc[ai][bj][m][1];
                    u32x4 w; w.x = pk2(v0[0], v0[1]); w.y = pk2(v0[2], v0[3]); w.z = pk2(v1[0], v1[1]); w.w = pk2(v1[2], v1[3]);
                    *(u32x4*)(base + ro + bj * (HALF * 2)) = w; } }
    }
};
#ifndef RG_MB
#define RG_MB 2
#endif
struct EpiResGate {
    static constexpr bool PERM = false;
    const float* src_ctx; const float* src_lat; float* dst_ctx; float* dst_lat; const float* gate_lat; const float* gate_ctx; int row_base;
    __device__ __forceinline__ void operator()(const f32x4 (&acc)[2][2][4][2], const Unit& u, int wr, int wc, int fr, int fq) const {
        const int rowu = row_base + u.pm * BM; const bool isctx = rowu < NCTX;
        const char* src = (const char*)(isctx ? src_ctx + (size_t)rowu * DM : src_lat + (size_t)(rowu - NCTX) * DM) + u.pn * (BM * 4);
        char* dst = (char*)(isctx ? dst_ctx + (size_t)rowu * DM : dst_lat + (size_t)(rowu - NCTX) * DM) + u.pn * (BM * 4);
        const float* gate = (isctx ? gate_ctx : gate_lat + (size_t)((rowu - NCTX) / SEQ) * 6144) + u.pn * BM;
        const int cl = wc * 32 + 4 * fq;
        f32x4 sc[2][2][4][2];
#pragma unroll
        for (int bj = 0; bj < 2; ++bj)
#pragma unroll
            for (int n = 0; n < 2; ++n) { const f32x4 gv = *(const f32x4*)(gate + cl + bj * HALF + n * 16);
#pragma unroll
                for (int ai = 0; ai < 2; ++ai)
#pragma unroll
                    for (int m = 0; m < 4; ++m) sc[ai][bj][m][n] = acc[ai][bj][m][n] * gv; }
        unsigned lb = (unsigned)((wr * 64 + fr) * DM + cl) * 4u; PG8_OPAQUE(lb);
#pragma unroll
        for (int gp = 0; gp < 8 / RG_MB; ++gp) {
            f32x4 s[RG_MB][2][2];
#pragma unroll
            for (int q = 0; q < RG_MB; ++q)
#pragma unroll
                for (int bj = 0; bj < 2; ++bj)
#pragma unroll
                    for (int n = 0; n < 2; ++n) s[q][bj][n] = *(const f32x4*)(src + lb + (unsigned)(((gp * RG_MB + q) >> 2) * 8 + ((gp * RG_MB + q) & 3)) * (16u * DM * 4u) + (unsigned)(bj * HALF + n * 16) * 4u);
#pragma unroll
            for (int q = 0; q < RG_MB; ++q)
#pragma unroll
                for (int bj = 0; bj < 2; ++bj)
#pragma unroll
                    for (int n = 0; n < 2; ++n) *(f32x4*)(dst + lb + (unsigned)(((gp * RG_MB + q) >> 2) * 8 + ((gp * RG_MB + q) & 3)) * (16u * DM * 4u) + (unsigned)(bj * HALF + n * 16) * 4u) = s[q][bj][n] + sc[(gp * RG_MB + q) >> 2][bj][(gp * RG_MB + q) & 3][n];
            asm volatile("" ::: "memory"); }
    }
};
template <bool MOE> struct EpiSwiglu {
    static constexpr bool PERM = true;
    static constexpr bool OUT8 = MOE ? (MOE_FP8 != 0) : (DENSE_FP8 != 0);
    bf16_t* O; int ldc; int ncol; const float* prow;
    __device__ __forceinline__ void operator()(const f32x4 (&acc)[2][2][4][2], const Unit& u, int wr, int wc, int fr, int fq) const {
        const int pnl = MOE ? (u.pn % ncol) : u.pn;
        constexpr int ES = OUT8 ? 1 : 2;
        char* base = (char*)O + ((size_t)(u.pm * BM) * ldc + pnl * HALF) * ES;
        unsigned lb = (unsigned)((wr * 64 + fr) * ldc + wc * 32 + 8 * fq) * ES; PG8_OPAQUE(lb);
        const unsigned rstep = (unsigned)ldc * 16u * ES;
#pragma unroll
        for (int ai = 0; ai < 2; ++ai)
#pragma unroll
            for (int m = 0; m < 4; ++m) {
                const float pw = OUT8 ? QS_H : 1.0f;
                float hv[8];
#pragma unroll
                for (int n = 0; n < 2; ++n)
#pragma unroll
                    for (int jp = 0; jp < 2; ++jp) { const f32x2_t g = {acc[ai][0][m][n][2 * jp], acc[ai][0][m][n][2 * jp + 1]}, up = {acc[ai][1][m][n][2 * jp], acc[ai][1][m][n][2 * jp + 1]};
                        const f32x2_t a = g * (-LOG2E); f32x2_t d; d.x = fast_exp2(a.x); d.y = fast_exp2(a.y); d = d + 1.0f;
                        f32x2_t r; r.x = fast_rcp(d.x); r.y = fast_rcp(d.y);
                        const f32x2_t hh = (g * up) * (r * pw); hv[n * 4 + 2 * jp] = hh.x; hv[n * 4 + 2 * jp + 1] = hh.y; }
                if constexpr (OUT8) { u32x2 w; w.x = pk4_fp8(hv[0], hv[1], hv[2], hv[3]); w.y = pk4_fp8(hv[4], hv[5], hv[6], hv[7]);
                    *(u32x2*)(base + lb + (unsigned)(ai * 8 + m) * rstep) = w; }
                else { u32x4 w; w.x = pk2(hv[0], hv[1]); w.y = pk2(hv[2], hv[3]); w.z = pk2(hv[4], hv[5]); w.w = pk2(hv[6], hv[7]);
                    *(u32x4*)(base + lb + (unsigned)(ai * 8 + m) * rstep) = w; } }
    }
};
struct EpiMoeScatter {
    static constexpr bool PERM = false;
    const int* rowmap; const float* prow; float* hlat; bf16_t* y1; const float* gate_lat; int ncol;
    template <bool SLOT1> __device__ __forceinline__ void run(const f32x4 (&acc)[2][2][4][2], const Unit& u, int wr, int wc, int fr, int fq) const {
        const int pnl = u.pn % ncol;
        const int* rm = rowmap + u.pm * BM; const float* pr = prow + u.pm * BM;
        char* hb = (char*)hlat + pnl * (BM * 4); const char* gb = (const char*)gate_lat + pnl * (BM * 4); char* yb = (char*)y1 + pnl * (BM * 2);
        unsigned pl = (unsigned)(wr * 64 + fr) * 4u; PG8_OPAQUE(pl);
        unsigned cb = (unsigned)(wc * 32 + 4 * fq) * 4u; PG8_OPAQUE(cb);
        int tok[8]; float pw[8];
#pragma unroll
        for (int g = 0; g < 8; ++g) { tok[g] = *(const int*)((const char*)rm + pl + (unsigned)((g >> 2) * 8 + (g & 3)) * 64u); pw[g] = *(const float*)((const char*)pr + pl + (unsigned)((g >> 2) * 8 + (g & 3)) * 64u); }
#pragma unroll
        for (int gp = 0; gp < 4; ++gp) {
            f32x4 gv[2][4], sv[2][4]; unsigned ro[2];
#pragma unroll
            for (int q = 0; q < 2; ++q) { const int g = gp * 2 + q; const unsigned tc = (unsigned)(tok[g] < 0 ? 0 : tok[g]); ro[q] = tc * (DM * 4u) + cb; const unsigned go = (tc >> 11) * (6144u * 4u) + cb;
#pragma unroll
                for (int k = 0; k < 4; ++k) { const unsigned o = (unsigned)((k >> 1) * HALF + (k & 1) * 16) * 4u; gv[q][k] = *(const f32x4*)(gb + go + o); if constexpr (!SLOT1) sv[q][k] = *(const f32x4*)(hb + ro[q] + o); } }
#pragma unroll
            for (int q = 0; q < 2; ++q) { const int g = gp * 2 + q, ai = g >> 2, m = g & 3;
                if (tok[g] >= 0) {
#pragma unroll
                    for (int k = 0; k < 4; ++k) { const unsigned o = (unsigned)((k >> 1) * HALF + (k & 1) * 16) * 4u; const f32x4 t = (acc[ai][k >> 1][m][k & 1] * pw[g]) * gv[q][k];
                        if constexpr (SLOT1) { u32x2 w; w.x = pk2(t[0], t[1]); w.y = pk2(t[2], t[3]); *(u32x2*)(yb + (ro[q] >> 1) + (o >> 1)) = w; }
                        else *(f32x4*)(hb + ro[q] + o) = sv[q][k] + t; } } }
            asm volatile("" ::: "memory"); }
    }
    __device__ __forceinline__ void operator()(const f32x4 (&acc)[2][2][4][2], const Unit& u, int wr, int wc, int fr, int fq) const {
        if (u.pm >= MOE_TILES) run<true>(acc, u, wr, wc, fr, fq); else run<false>(acc, u, wr, wc, fr, fq);
    }
};
struct MoeOrder {
    int NT0, NT1, ncol, G, c; const PG8_LAS int* texp;
    __device__ bool next(int i, Unit& u) const {
        const long L = (long)i * G + c; if (L >= (long)(NT0 + NT1) * ncol) return false;
        const int tq = (int)(L / ncol), pnl = (int)(L % ncol);
        const int T = tq < NT0 ? tq : MOE_TILES + tq - NT0;
        const int e = __builtin_amdgcn_readfirstlane(texp[T]);
        u.pm = T; u.pn = e * ncol + pnl; return true;
    }
};
}

#define XB_TMO      128
#define XB_XCNT(j)  (256  + 64 * (j))
#define XB_XSUB(j)  (1280 + 64 * (j))
#define XB_XGEN(j)  (2304 + 64 * (j))
#define XB_TOP      3328
#define XB_TOPGEN   3392
#define XCD_BAR_WORDS 3456
#define XB_SPIN_CAP (1u << 18)
DI unsigned xb_ld(unsigned* p)              { return __hip_atomic_load(p, __ATOMIC_RELAXED, __HIP_MEMORY_SCOPE_AGENT); }
DI unsigned xb_add(unsigned* p, unsigned v) { return __hip_atomic_fetch_add(p, v, __ATOMIC_RELAXED, __HIP_MEMORY_SCOPE_AGENT); }
DI unsigned xb_xcc_id() { return (unsigned)__builtin_amdgcn_s_getreg((3 << 11) | 20) & 0xFu; }
#define XB_SPIN(cond, bar) do { unsigned _sp = 0; while (cond) { __builtin_amdgcn_s_sleep(1); \
    if ((++_sp & 255u) == 0u) { if (xb_ld(&(bar)[XB_TMO])) break; if (_sp > XB_SPIN_CAP) { atomicAdd(&(bar)[XB_TMO], 1u); break; } } } } while (0)
struct XcdBarrier { unsigned* bar; unsigned x; volatile LAS unsigned* st; };
DI XcdBarrier xcd_barrier_post(unsigned* bar, volatile LAS unsigned* st) {
    XcdBarrier b; b.bar = bar; b.x = xb_xcc_id(); b.st = st;
    if (threadIdx.x == 0) (void)xb_add(&bar[XB_XCNT(b.x)], 1u);
    return b;
}
DI void xcd_barrier_complete(unsigned* bar, unsigned x, unsigned& nloc, unsigned& nx) {
    const unsigned G = gridDim.x * gridDim.y * gridDim.z;
    unsigned sum, cnt, mine, sp = 0u;
    for (;;) {
        sum = 0u; cnt = 0u; mine = 0u;
#pragma unroll
        for (unsigned j = 0; j < 16; ++j) { const unsigned c = xb_ld(&bar[XB_XCNT(j)]); sum += c; cnt += (c > 0u) ? 1u : 0u; mine = (j == x) ? c : mine; }
        if (sum == G) break;
        __builtin_amdgcn_s_sleep(1);
        if ((++sp & 255u) == 0u) { if (xb_ld(&bar[XB_TMO])) break; if (sp > XB_SPIN_CAP) { atomicAdd(&bar[XB_TMO], 1u); break; } }
    }
    nloc = mine > 0u ? mine : 1u; nx = cnt > 0u ? cnt : 1u;
}
DI void xcd_barrier(const XcdBarrier& b, int wave) {
    asm volatile("s_waitcnt vmcnt(0)" ::: "memory");
    __syncthreads();
    if (wave == 0 && __builtin_amdgcn_mbcnt_hi(~0u, __builtin_amdgcn_mbcnt_lo(~0u, 0u)) == 0u) {
        unsigned* bar = b.bar;
        __builtin_amdgcn_s_waitcnt(0);
        unsigned nloc = b.st[0], nx = b.st[1];
        if (nloc == 0u) { xcd_barrier_complete(bar, b.x, nloc, nx); b.st[0] = nloc; b.st[1] = nx; }
        const unsigned old = xb_add(&bar[XB_XSUB(b.x)], 1u);
        const unsigned gen = old / nloc;
        if (old + 1u == (gen + 1u) * nloc) {
            __builtin_amdgcn_fence(__ATOMIC_RELEASE, "agent");
            asm volatile("s_waitcnt vmcnt(0)" ::: "memory");
            const unsigned og = xb_add(&bar[XB_TOP], 1u);
            const unsigned tg = og / nx;
            if (og + 1u == (tg + 1u) * nx) xb_add(&bar[XB_TOPGEN], 1u);
            else XB_SPIN(xb_ld(&bar[XB_TOPGEN]) == tg, bar);
            __builtin_amdgcn_fence(__ATOMIC_ACQUIRE, "agent");
            xb_add(&bar[XB_XGEN(b.x)], 1u);
            asm volatile("s_waitcnt vmcnt(0)" ::: "memory");
        } else {
            XB_SPIN(xb_ld(&bar[XB_XGEN(b.x)]) == gen, bar);
            __builtin_amdgcn_fence(__ATOMIC_ACQUIRE, "agent");
            asm volatile("s_waitcnt vmcnt(0)" ::: "memory");
        }
    }
    __syncthreads();
}

struct Params { const float* in[26]; float* out; unsigned char* ws; int ph_lo, ph_hi, pad0, pad1; };
enum { I_X = 0, I_C, I_CTX, I_CCTX, I_WMOD, I_BMOD, I_N1W, I_N2W, I_WIN, I_WOUT, I_RPB, I_CONVW, I_CONVB, I_CLNW, I_CLNB, I_RDEC, I_RGNW,
       I_FG, I_FU, I_FD, I_MR, I_MRB, I_MG, I_MU, I_MDN, I_FNW };
constexpr int PH_P0 = 0, PH_FINAL = 18, N_PHASES = 19;

typedef __attribute__((address_space(4))) const unsigned char* karg_t;
struct KIn {
    karg_t ka;
    DI const float* operator[](int k) const { return *(const float* __attribute__((address_space(4))) const*)(ka + 8 * k); }
};
struct Frame {
    LAS unsigned char* lds;
    int tid, lane, wave, G, bid, vb;
    KIn in; float* out; unsigned char* ws;
};
DI Frame phase_frame(const Frame& F0) {
    Frame F; karg_t ka = F0.in.ka; asm volatile("" : "+s"(ka)); F.in.ka = ka;
    F.out = *(float* __attribute__((address_space(4))) const*)(ka + 208);
    F.ws = *(unsigned char* __attribute__((address_space(4))) const*)(ka + 216);
    int wv = F0.wave; asm volatile("" : "+s"(wv));
    int tid = (wv << 6) + (int)__builtin_amdgcn_mbcnt_hi(~0u, __builtin_amdgcn_mbcnt_lo(~0u, 0u)), G = F0.G, bid = F0.bid; unsigned ldsb = (unsigned)(size_t)F0.lds;
    asm volatile("" : "+v"(tid)); asm volatile("" : "+s"(G)); asm volatile("" : "+s"(bid)); asm volatile("" : "+s"(ldsb));
    F.tid = tid; F.lane = tid & 63; F.wave = __builtin_amdgcn_readfirstlane(tid >> 6); F.G = G; F.bid = bid; F.lds = (LAS unsigned char*)(size_t)ldsb;
    F.vb = (G % 8 == 0) ? (bid % 8) * (G / 8) + bid / 8 : bid;
    return F;
}

DI void p0_transpose_item(const float* W, int K, int N, bf16* WT, int k0, int n0, int dst_row0, LAS float* scr, int lane) {
#pragma unroll 8
    for (int i = 0; i < 32; ++i) { const int kk = 2 * i + (lane >> 5); scr[kk * 33 + (lane & 31)] = W[(size_t)(k0 + kk) * N + n0 + (lane & 31)]; }
    asm volatile("s_waitcnt lgkmcnt(0)" ::: "memory");
    const int c = lane & 7;
#pragma unroll
    for (int j = 0; j < 4; ++j) { const int n = (lane >> 3) + 8 * j; const LAS float* s = scr + (8 * c) * 33 + n;
        u32x4 o; o.x = pk2(s[0 * 33], s[1 * 33]); o.y = pk2(s[2 * 33], s[3 * 33]); o.z = pk2(s[4 * 33], s[5 * 33]); o.w = pk2(s[6 * 33], s[7 * 33]);
        *(u32x4*)(WT + (size_t)(dst_row0 + n) * K + k0 + 8 * c) = o; }
    asm volatile("s_waitcnt lgkmcnt(0)" ::: "memory");
}
DI void p0_convert_plain(Frame& F, const float* W, int K, int N, bf16* WT, int item, LAS float* scr) {
    const int nblk = N / 32, kb = item / nblk, nb = item % nblk;
    p0_transpose_item(W, K, N, WT, 64 * kb, 32 * nb, 32 * nb, scr, F.lane);
}
DI void p0_convert_gu(Frame& F, const float* W, int K, int N, bf16* WT, int item, int up, LAS float* scr) {
    const int nblk = N / 32, kb = item / nblk, nb = item % nblk, n0 = 32 * nb;
    p0_transpose_item(W, K, N, WT, 64 * kb, n0, 256 * (n0 / 128) + (n0 % 128) + (up ? 128 : 0), scr, F.lane);
}
DI void conv_item64(const float* W, int K, int N, bf16* WT, int k0, int n0, int dst_row0, LAS unsigned* scr, int lane) {
    const float* wp = W + (size_t)k0 * N + n0 + lane;
    float v[64];
#pragma unroll
    for (int i = 0; i < 64; ++i) v[i] = wp[(size_t)i * N];
#pragma unroll
    for (int i = 0; i < 32; ++i) scr[i * 65 + lane] = pk2(v[2 * i], v[2 * i + 1]);
    asm volatile("s_waitcnt lgkmcnt(0)" ::: "memory");
    const int c = lane & 7;
#pragma unroll
    for (int j = 0; j < 8; ++j) { const int n = (lane >> 3) + 8 * j; const LAS unsigned* sp = scr + (4 * c) * 65 + n;
        u32x4 o; o.x = sp[0]; o.y = sp[65]; o.z = sp[130]; o.w = sp[195];
        *(u32x4*)(WT + (size_t)(dst_row0 + n) * K + k0 + 8 * c) = o; }
    asm volatile("s_waitcnt lgkmcnt(0)" ::: "memory");
}
DI void conv_item64_fp8(const float* W, int K, int N, unsigned char* WT, int k0, int n0, int dst_row0, float qs, LAS unsigned* scr, int lane) {
    const float* wp = W + (size_t)k0 * N + n0 + lane;
    float v[64];
#pragma unroll
    for (int i = 0; i < 64; ++i) v[i] = wp[(size_t)i * N];
#pragma unroll
    for (int i = 0; i < 16; ++i) scr[i * 65 + lane] = pk4_fp8(v[4 * i] * qs, v[4 * i + 1] * qs, v[4 * i + 2] * qs, v[4 * i + 3] * qs);
    asm volatile("s_waitcnt lgkmcnt(0)" ::: "memory");
    const int c = lane & 3;
#pragma unroll
    for (int j = 0; j < 4; ++j) { const int n = (lane >> 2) + 16 * j; const LAS unsigned* sp = scr + (4 * c) * 65 + n;
        u32x4 o; o.x = sp[0]; o.y = sp[65]; o.z = sp[130]; o.w = sp[195];
        *(u32x4*)(WT + (size_t)(dst_row0 + n) * K + k0 + 16 * c) = o; }
    asm volatile("s_waitcnt lgkmcnt(0)" ::: "memory");
}
constexpr int BG_ITEMS = 21504;
constexpr int BG_B0 = 0, BG_D0 = 1200, BG_E0 = 5200, BG_F0 = 8700, BG_B1 = 19700, BG_CL = 20900;
DI void bg_item(Frame& F, int g, LAS unsigned* scr) {
    if (g < 14336) { const int m = g / 896, e = m >> 1, up = m & 1, r = g % 896, kb = r / 56, nb = r % 56, n0 = 64 * nb; const int drow = 256 * (n0 / 128) + (n0 % 128) + (up ? 128 : 0);
#if MOE_FP8
        conv_item64_fp8(F.in[up ? I_MU : I_MG] + (size_t)e * 1024 * 3584, 1024, 3584, F.ws + WS_MGU + (size_t)e * 7168 * 1024, 64 * kb, n0, drow, QS_WGU, scr, F.lane);
#else
        conv_item64(F.in[up ? I_MU : I_MG] + (size_t)e * 1024 * 3584, 1024, 3584, (bf16*)(F.ws + WS_MGU) + (size_t)e * 7168 * 1024, 64 * kb, n0, drow, scr, F.lane);
#endif
    } else { const int gg = g - 14336, e = gg / 896, r = gg % 896, kb = r / 16, nb = r % 16;
#if MOE_FP8
        conv_item64_fp8(F.in[I_MDN] + (size_t)e * 3584 * 1024, 3584, 1024, F.ws + WS_MD + (size_t)e * 1024 * 3584, 64 * kb, 64 * nb, 64 * nb, QS_WD, scr, F.lane);
#else
        conv_item64(F.in[I_MDN] + (size_t)e * 3584 * 1024, 3584, 1024, (bf16*)(F.ws + WS_MD) + (size_t)e * 1024 * 3584, 64 * kb, 64 * nb, 64 * nb, scr, F.lane);
#endif
    }
}
DI void bg_convert_tail(Frame& F, int nwg, int lo, int hi) {
    const int nmax = (nwg + F.G - 1) / F.G, rem = nwg - (nmax - 1) * F.G;
    if (F.bid < rem || rem >= F.G) return;
    LAS unsigned* scr = (LAS unsigned*)(F.lds + F.wave * 8320);
    const int w = (F.bid - rem) * 8 + F.wave, nw = (F.G - rem) * 8;
    for (int g = lo + w; g < hi; g += nw) bg_item(F, g, scr);
}
DI void bg_convert_all(Frame& F, int lo, int hi) {
    LAS unsigned* scr = (LAS unsigned*)(F.lds + F.wave * 8320);
    for (int g = lo + F.bid * 8 + F.wave; g < hi; g += F.G * 8) bg_item(F, g, scr);
}
DI void p0_prologue(Frame& F) {
    {
        LAS float* Sx = (LAS float*)F.lds;
        LAS float* red = (LAS float*)(F.lds + 81920);
        bool staged = false;
        for (int unit = F.bid; unit < 192; unit += F.G) {
            if (!staged) {
                for (int idx = F.tid; idx < 17 * 1024; idx += 512) { const int r = idx / 1024, k = idx % 1024;
                    const float v = r < 16 ? F.in[I_C][r * 1024 + k] : F.in[I_CCTX][k]; Sx[k * 20 + r] = v * sigmoidf_(v); }
                staged = true; __syncthreads();
            }
            const int l = unit / 96, n0 = (unit % 96) * 64;
            const float* Wm = F.in[I_WMOD] + (size_t)l * 1024 * 6144 + n0 + F.lane;
            float acc[17];
#pragma unroll
            for (int r = 0; r < 17; ++r) acc[r] = 0.f;
            const int kb = F.wave * 128;
#pragma unroll 4
            for (int k = 0; k < 128; ++k) { const float wv = Wm[(size_t)(kb + k) * 6144]; const LAS float* sp = Sx + (kb + k) * 20;
                const f32x4 s0 = *(const LAS f32x4*)(sp), s1 = *(const LAS f32x4*)(sp + 4), s2 = *(const LAS f32x4*)(sp + 8), s3 = *(const LAS f32x4*)(sp + 12); const float s4 = sp[16];
                acc[0] += s0[0] * wv; acc[1] += s0[1] * wv; acc[2] += s0[2] * wv; acc[3] += s0[3] * wv; acc[4] += s1[0] * wv; acc[5] += s1[1] * wv; acc[6] += s1[2] * wv; acc[7] += s1[3] * wv;
                acc[8] += s2[0] * wv; acc[9] += s2[1] * wv; acc[10] += s2[2] * wv; acc[11] += s2[3] * wv; acc[12] += s3[0] * wv; acc[13] += s3[1] * wv; acc[14] += s3[2] * wv; acc[15] += s3[3] * wv;
                acc[16] += s4 * wv; }
#pragma unroll
            for (int r = 0; r < 17; ++r) red[(F.wave * 17 + r) * 64 + F.lane] = acc[r];
            __syncthreads();
            for (int idx = F.tid; idx < 17 * 64; idx += 512) { const int r = idx / 64, ln = idx % 64; float s = F.in[I_BMOD][l * 6144 + n0 + ln];
#pragma unroll
                for (int w = 0; w < 8; ++w) s += red[(w * 17 + r) * 64 + ln];
                if (r < 16) ((float*)(F.ws + WS_MODLAT))[((size_t)l * 16 + r) * 6144 + n0 + ln] = s; else ((float*)(F.ws + WS_MODCTX))[(size_t)l * 6144 + n0 + ln] = s; }
            __syncthreads();
        }
        __syncthreads();
    }
    if (F.bid == 0) { const int pos = F.tid >> 3, j = F.tid & 7; const float inv = exp2f(-(float)j * 0.125f * 13.287712379549449f); const float ang = (float)pos * inv;
        float* tab = (float*)(F.ws + WS_ROPE); tab[(pos * 8 + j) * 2] = cosf(ang); tab[(pos * 8 + j) * 2 + 1] = sinf(ang); }
    {
        LAS float* scr = (LAS float*)(F.lds + F.wave * 16384);
        const int gw = F.bid * 8 + F.wave, NGW = F.G * 8;
        constexpr int I_IN = 16 * 96, I_OUT = 16 * 32, I_G = 16 * 88, I_D = 44 * 32, I_MGI = 16 * 112, I_MDI = 56 * 32;
        constexpr int NITEMS = 2 * I_IN + 2 * I_OUT + (DENSE_FP8 == 1 ? 3 * 704 : (DENSE_FP8 == 2 ? 2 * I_G + 704 : 2 * I_G + I_D));
        for (int it = gw; it < NITEMS; it += NGW) {
            int r = it;
            if (r < 2 * I_IN) { const int l = r / I_IN; p0_convert_plain(F, F.in[I_WIN] + (size_t)l * 1024 * 3072, 1024, 3072, (bf16*)(F.ws + WS_WIN) + (size_t)l * 3072 * 1024, r % I_IN, scr); continue; } r -= 2 * I_IN;
            if (r < 2 * I_OUT) { const int l = r / I_OUT; p0_convert_plain(F, F.in[I_WOUT] + (size_t)l * 1024 * 1024, 1024, 1024, (bf16*)(F.ws + WS_WOUT) + (size_t)l * 1024 * 1024, r % I_OUT, scr); continue; } r -= 2 * I_OUT;
#if DENSE_FP8 == 2
            if (r < I_G) { p0_convert_gu(F, F.in[I_FG], 1024, 2816, (bf16*)(F.ws + WS_WGU), r, 0, scr); continue; } r -= I_G;
            if (r < I_G) { p0_convert_gu(F, F.in[I_FU], 1024, 2816, (bf16*)(F.ws + WS_WGU), r, 1, scr); continue; } r -= I_G;
            { const int kb = r / 16, nb = r % 16; conv_item64_fp8(F.in[I_FD], 2816, 1024, F.ws + WS_WD, 64 * kb, 64 * nb, 64 * nb, QS_WD, (LAS unsigned*)scr, F.lane); }
#elif DENSE_FP8 == 1
            { LAS unsigned* scr8 = (LAS unsigned*)scr;
              if (r < 1408) { const int up = r / 704, q = r % 704, kb = q / 44, nb = q % 44, n0 = 64 * nb;
                  conv_item64_fp8(F.in[up ? I_FU : I_FG], 1024, 2816, F.ws + WS_WGU, 64 * kb, n0, 256 * (n0 / 128) + (n0 % 128) + (up ? 128 : 0), QS_WGU, scr8, F.lane); }
              else { const int q = r - 1408, kb = q / 16, nb = q % 16; conv_item64_fp8(F.in[I_FD], 2816, 1024, F.ws + WS_WD, 64 * kb, 64 * nb, 64 * nb, QS_WD, scr8, F.lane); } }
#else
            if (r < I_G) { p0_convert_gu(F, F.in[I_FG], 1024, 2816, (bf16*)(F.ws + WS_WGU), r, 0, scr); continue; } r -= I_G;
            if (r < I_G) { p0_convert_gu(F, F.in[I_FU], 1024, 2816, (bf16*)(F.ws + WS_WGU), r, 1, scr); continue; } r -= I_G;
            p0_convert_plain(F, F.in[I_FD], 2816, 1024, (bf16*)(F.ws + WS_WD), r, scr);
#endif
        }
    }
}

struct NormVecs { f32x4 gs[4], sh[4]; };
DI void norm_load_vecs(Frame& F, const float* g, const float* mod, int isc, int ish, NormVecs& V) {
#pragma unroll
    for (int j = 0; j < 4; ++j) { const f32x4 gv = ((const f32x4*)g)[F.lane + 64 * j], sv = ((const f32x4*)(mod + isc * DM))[F.lane + 64 * j]; V.gs[j] = gv * (sv + 1.0f); V.sh[j] = ((const f32x4*)(mod + ish * DM))[F.lane + 64 * j]; }
}
DI void norm_load_row(Frame& F, const float* srow, f32x4 (&v)[4]) {
    const f32x4* xr = (const f32x4*)srow + F.lane;
#pragma unroll
    for (int j = 0; j < 4; ++j) v[j] = xr[64 * j];
}
DI float norm_ssq(const f32x4 (&v)[4]) { float s = 0.f;
#pragma unroll
    for (int j = 0; j < 4; ++j) s += (v[j].x * v[j].x + v[j].y * v[j].y) + (v[j].z * v[j].z + v[j].w * v[j].w);
    return s; }
DI void norm_finish(Frame& F, const f32x4 (&v)[4], float ssq_total, const NormVecs& V, bf16* orow, f32x4 (&y)[4]) {
    const float rstd = 1.0f / sqrtf(ssq_total * (1.0f / DM) + EPS);
    u32x2* o8 = (u32x2*)orow + F.lane;
#pragma unroll
    for (int j = 0; j < 4; ++j) { y[j] = (v[j] * rstd) * V.gs[j] + V.sh[j]; u32x2 w; w.x = pk2(y[j].x, y[j].y); w.y = pk2(y[j].z, y[j].w); o8[64 * j] = w; }
}
DI void norm_finish8(Frame& F, const f32x4 (&v)[4], float ssq_total, const NormVecs& V, unsigned char* orow, f32x4 (&y)[4]) {
    const float rstd = 1.0f / sqrtf(ssq_total * (1.0f / DM) + EPS);
    unsigned* o4 = (unsigned*)orow + F.lane;
#pragma unroll
    for (int j = 0; j < 4; ++j) { y[j] = (v[j] * rstd) * V.gs[j] + V.sh[j]; o4[64 * j] = pk4_fp8(y[j].x * QS_U, y[j].y * QS_U, y[j].z * QS_U, y[j].w * QS_U); }
}
DI void norm_phase(Frame& F, int l, int which, bool first, int row_lo, bool out8 = false) {
    const float* g = F.in[which == 1 ? I_N1W : I_N2W] + l * DM;
    const float* modlat = (const float*)(F.ws + WS_MODLAT) + (size_t)l * 16 * 6144;
    const float* modctx = (const float*)(F.ws + WS_MODCTX) + (size_t)l * 6144;
    const int ish = which == 1 ? 0 : 3, isc = which == 1 ? 1 : 4;
    const float* sctx = first ? F.in[I_CTX] : (const float*)(F.ws + WS_HCTX);
    const float* slat = first ? F.in[I_X] : F.out;
    bf16* U = (bf16*)(F.ws + WS_U);
    const int gw = F.bid * 8 + F.wave, NGW = F.G * 8;
    const int rpw = (NTOK - row_lo + NGW - 1) / NGW;
    const int r0 = row_lo + gw * rpw; int r1 = r0 + rpw; if (r1 > NTOK) r1 = NTOK;
    NormVecs V; int curb = -2;
    for (int row = r0; row < r1; row += 2) {
        const bool two = row + 1 < r1;
        const int rowb = two ? row + 1 : row;
        f32x4 va[4], vb[4];
        norm_load_row(F, row < NCTX ? sctx + (size_t)row * DM : slat + (size_t)(row - NCTX) * DM, va);
        norm_load_row(F, rowb < NCTX ? sctx + (size_t)rowb * DM : slat + (size_t)(rowb - NCTX) * DM, vb);
        float sa = norm_ssq(va), sb = norm_ssq(vb);
#pragma unroll
        for (int o = 1; o < 64; o <<= 1) { sa += __shfl_xor(sa, o); sb += __shfl_xor(sb, o); }
        f32x4 y[4];
        { const int bk = row < NCTX ? -1 : (row - NCTX) / SEQ; if (bk != curb) { norm_load_vecs(F, g, bk < 0 ? modctx : modlat + (size_t)bk * 6144, isc, ish, V); curb = bk; } }
        if (out8) norm_finish8(F, va, sa, V, (unsigned char*)U + (size_t)row * DM, y); else norm_finish(F, va, sa, V, U + (size_t)row * DM, y);
        if (two) { const int bk = rowb < NCTX ? -1 : (rowb - NCTX) / SEQ; if (bk != curb) { norm_load_vecs(F, g, bk < 0 ? modctx : modlat + (size_t)bk * 6144, isc, ish, V); curb = bk; }
            if (out8) norm_finish8(F, vb, sb, V, (unsigned char*)U + (size_t)rowb * DM, y); else norm_finish(F, vb, sb, V, U + (size_t)rowb * DM, y); }
    }
}
DI void moe_route_row(Frame& F, const f32x4 (&y)[4], LAS const float* Rw, const float (&rb)[8], LAS int* sel, int tl, int tok) {
    float lg[8];
#pragma unroll
    for (int e = 0; e < 8; ++e) lg[e] = 0.f;
#pragma unroll
    for (int j = 0; j < 4; ++j)
#pragma unroll
        for (int q = 0; q < 4; ++q) { const int k = 256 * j + 4 * F.lane + q; const f32x4 r0 = *(const LAS f32x4*)(Rw + k * 8), r1 = *(const LAS f32x4*)(Rw + k * 8 + 4); const float yv = y[j][q];
            lg[0] += yv * r0[0]; lg[1] += yv * r0[1]; lg[2] += yv * r0[2]; lg[3] += yv * r0[3]; lg[4] += yv * r1[0]; lg[5] += yv * r1[1]; lg[6] += yv * r1[2]; lg[7] += yv * r1[3]; }
#pragma unroll
    for (int o = 1; o < 64; o <<= 1) {
#pragma unroll
        for (int e = 0; e < 8; ++e) lg[e] += __shfl_xor(lg[e], o); }
#pragma unroll
    for (int e = 0; e < 8; ++e) lg[e] += rb[e];
    int e1 = 0; float v1 = lg[0];
#pragma unroll
    for (int e = 1; e < 8; ++e) if (lg[e] > v1) { v1 = lg[e]; e1 = e; }
    int e2 = -1; float v2 = -3.0e38f;
#pragma unroll
    for (int e = 0; e < 8; ++e) if (e != e1 && lg[e] > v2) { v2 = lg[e]; e2 = e; }
    const float ex = __expf(v2 - v1), p1 = 1.0f / (1.0f + ex), p2 = ex / (1.0f + ex);
    if (F.lane == 0) { sel[tl * 2] = e1; sel[tl * 2 + 1] = e2; float* pt = (float*)(F.ws + WS_PTOK) + (size_t)tok * 2; pt[0] = p1; pt[1] = p2; }
}
DI void norm_moe_phase(Frame& F) {
    const int l = 1;
    const float* g = F.in[I_N2W] + l * DM;
    const float* modlat = (const float*)(F.ws + WS_MODLAT) + (size_t)l * 16 * 6144;
    bf16* U = (bf16*)(F.ws + WS_U);
    LAS float* Rw = (LAS float*)F.lds;
    LAS int* sel = (LAS int*)(F.lds + 32768);
    for (int idx = F.tid; idx < 8192; idx += 512) Rw[idx] = F.in[I_MR][idx];
    __syncthreads();
    float rb[8];
#pragma unroll
    for (int e = 0; e < 8; ++e) rb[e] = F.in[I_MRB][e];
    NormVecs V; int curb = -2;
    for (int seg = F.bid; seg < 256; seg += F.G) {
        const int bk = (seg * 128) / SEQ; if (bk != curb) { norm_load_vecs(F, g, modlat + (size_t)bk * 6144, 4, 3, V); curb = bk; }
        for (int i = 0; i < 16; i += 2) {
            const int tl = F.wave * 16 + i, tok = seg * 128 + tl;
            f32x4 va[4], vb[4];
            norm_load_row(F, F.out + (size_t)tok * DM, va); norm_load_row(F, F.out + (size_t)(tok + 1) * DM, vb);
            float sa = norm_ssq(va), sb = norm_ssq(vb);
#pragma unroll
            for (int o = 1; o < 64; o <<= 1) { sa += __shfl_xor(sa, o); sb += __shfl_xor(sb, o); }
            f32x4 y[4];
#if MOE_FP8
            norm_finish8(F, va, sa, V, (unsigned char*)U + (size_t)tok * DM, y); moe_route_row(F, y, Rw, rb, sel, tl, tok);
            norm_finish8(F, vb, sb, V, (unsigned char*)U + (size_t)(tok + 1) * DM, y); moe_route_row(F, y, Rw, rb, sel, tl + 1, tok + 1);
#else
            norm_finish(F, va, sa, V, U + (size_t)(NCTX + tok) * DM, y); moe_route_row(F, y, Rw, rb, sel, tl, tok);
            norm_finish(F, vb, sb, V, U + (size_t)(NCTX + tok + 1) * DM, y); moe_route_row(F, y, Rw, rb, sel, tl + 1, tok + 1);
#endif
        }
        __syncthreads();
        if (F.tid < 16) { const int s = F.tid >> 3, e = F.tid & 7; int cnt = 0; int* lst = (int*)(F.ws + WS_SEGLIST) + ((size_t)(seg * 2 + s) * 8 + e) * 128;
            for (int i = 0; i < 128; ++i) if (sel[i * 2 + s] == e) lst[cnt++] = seg * 128 + i;
            ((int*)(F.ws + WS_SEGCNT))[(seg * 2 + s) * 8 + e] = cnt; }
        __syncthreads();
    }
}
DI void moe_route_phase(Frame& F) {
    LAS int* cn = (LAS int*)F.lds;
    LAS int* offs = cn + 2048;
    LAS int* tb = offs + 256;
    for (int unit = F.bid; unit < 16; unit += F.G) {
        const int s = unit >> 3, e = unit & 7;
        const int* segcnt = (const int*)(F.ws + WS_SEGCNT);
        for (int idx = F.tid; idx < 2048; idx += 512) { const int ee = idx >> 8, gsg = idx & 255; cn[idx] = segcnt[(gsg * 2 + s) * 8 + ee]; }
        __syncthreads();
        if (F.tid < 8) { int tot = 0; for (int gsg = 0; gsg < 256; ++gsg) tot += cn[F.tid * 256 + gsg]; tb[16 + F.tid] = tot; }
        if (F.tid == 64) { int run = 0; for (int gsg = 0; gsg < 256; ++gsg) { offs[gsg] = run; run += cn[e * 256 + gsg]; } }
        __syncthreads();
        if (F.tid == 0) { int run = 0; for (int ee = 0; ee < 8; ++ee) { tb[ee] = run; run += (tb[16 + ee] + 255) / 256; } tb[8] = run; }
        __syncthreads();
        int* rowmap = (int*)(F.ws + WS_ROWMAP) + (size_t)s * MOE_ROWS;
        float* prow = (float*)(F.ws + WS_PROW) + (size_t)s * MOE_ROWS;
        const float* ptok = (const float*)(F.ws + WS_PTOK);
        const int base = tb[e] * 256, tot = tb[16 + e], ntile = (tot + 255) / 256;
        if (F.tid < 256) { const int gsg = F.tid; const int c = cn[e * 256 + gsg]; const int* lst = (const int*)(F.ws + WS_SEGLIST) + ((size_t)(gsg * 2 + s) * 8 + e) * 128;
            for (int i = 0; i < c; ++i) { const int tok = lst[i]; rowmap[base + offs[gsg] + i] = tok; prow[base + offs[gsg] + i] = ptok[(size_t)tok * 2 + s]; } }
        for (int i = tot + F.tid; i < ntile * 256; i += 512) { rowmap[base + i] = -1; prow[base + i] = 0.f; }
        if (e == 0) { int* meta = (int*)(F.ws + WS_META) + s * 256;
            if (F.tid == 0) meta[0] = tb[8];
            if (F.tid < 8) { const int t0 = tb[F.tid], t1 = tb[F.tid + 1]; for (int t = t0; t < t1; ++t) meta[1 + t] = F.tid; } }
        __syncthreads();
    }
}
DI void final_phase(Frame& F) {
    const float* g = F.in[I_FNW];
    f32x4 gv[4];
#pragma unroll
    for (int j = 0; j < 4; ++j) gv[j] = ((const f32x4*)g)[F.lane + 64 * j];
    const int gw = F.bid * 8 + F.wave, NGW = F.G * 8;
    const int rpw = (NLAT + NGW - 1) / NGW; const int r0 = gw * rpw; int r1 = r0 + rpw; if (r1 > NLAT) r1 = NLAT;
    for (int row = r0; row < r1; row += 2) {
        const bool two = row + 1 < r1; const int rowb = two ? row + 1 : row;
        f32x4 va[4], vb[4];
        norm_load_row(F, F.out + (size_t)row * DM, va); norm_load_row(F, F.out + (size_t)rowb * DM, vb);
        { const bf16* y1 = (const bf16*)(F.ws + WS_U);
#pragma unroll
          for (int j = 0; j < 4; ++j) { const u32x2 ya = ((const u32x2*)(y1 + (size_t)row * DM))[F.lane + 64 * j], yb = ((const u32x2*)(y1 + (size_t)rowb * DM))[F.lane + 64 * j];
              va[j].x += bflo(ya.x); va[j].y += bfhi(ya.x); va[j].z += bflo(ya.y); va[j].w += bfhi(ya.y); vb[j].x += bflo(yb.x); vb[j].y += bfhi(yb.x); vb[j].z += bflo(yb.y); vb[j].w += bfhi(yb.y); } }
        float sa = norm_ssq(va), sb = norm_ssq(vb);
#pragma unroll
        for (int o = 1; o < 64; o <<= 1) { sa += __shfl_xor(sa, o); sb += __shfl_xor(sb, o); }
        const float ra = 1.0f / sqrtf(sa * (1.0f / DM) + EPS), rbv = 1.0f / sqrtf(sb * (1.0f / DM) + EPS);
        f32x4* xa = (f32x4*)(F.out + (size_t)row * DM) + F.lane; f32x4* xb = (f32x4*)(F.out + (size_t)rowb * DM) + F.lane;
#pragma unroll
        for (int j = 0; j < 4; ++j) xa[64 * j] = (va[j] * ra) * gv[j];
        if (two) {
#pragma unroll
            for (int j = 0; j < 4; ++j) xb[64 * j] = (vb[j] * rbv) * gv[j]; }
    }
}

DI void conv_unit(Frame& F, int l, int row0, int t0, int slen) {
    const bf16* PX = (const bf16*)(F.ws + WS_P);
    bf16* YC = (bf16*)(F.ws + WS_U);
    LAS float* Y = (LAS float*)F.lds;
    { u32x4 av[6], gv[6];
#pragma unroll
      for (int k = 0; k < 6; ++k) { const int it = F.tid + 512 * k; const int rr = it >> 5, cc = it & 31; const int t = t0 - 15 + rr;
          av[k] = (u32x4){0u, 0u, 0u, 0u}; gv[k] = av[k];
          if (it < 94 * 32 && t >= 0 && t < slen) { const bf16* p = PX + (size_t)(row0 + t) * INW + C_CONV + 8 * cc; av[k] = *(const u32x4*)p; gv[k] = *(const u32x4*)(p + 256); } }
#pragma unroll
      for (int k = 0; k < 6; ++k) { const int it = F.tid + 512 * k; const int rr = it >> 5, cc = it & 31;
          if (it < 94 * 32) { f32x4 o0, o1;
              o0[0] = bflo(av[k].x) * sigmoidf_(bflo(gv[k].x)); o0[1] = bfhi(av[k].x) * sigmoidf_(bfhi(gv[k].x)); o0[2] = bflo(av[k].y) * sigmoidf_(bflo(gv[k].y)); o0[3] = bfhi(av[k].y) * sigmoidf_(bfhi(gv[k].y));
              o1[0] = bflo(av[k].z) * sigmoidf_(bflo(gv[k].z)); o1[1] = bfhi(av[k].z) * sigmoidf_(bfhi(gv[k].z)); o1[2] = bflo(av[k].w) * sigmoidf_(bflo(gv[k].w)); o1[3] = bfhi(av[k].w) * sigmoidf_(bfhi(gv[k].w));
              *(LAS f32x4*)(Y + rr * 256 + 8 * cc) = o0; *(LAS f32x4*)(Y + rr * 256 + 8 * cc + 4) = o1; } } }
    __syncthreads();
    const int c = F.tid & 255, half = F.tid >> 8;
    float w[31];
#pragma unroll
    for (int k = 0; k < 31; ++k) w[k] = F.in[I_CONVW][(size_t)l * 31 * 256 + k * 256 + c];
    float acc[32];
    const float cb = F.in[I_CONVB][l * 256 + c];
#pragma unroll
    for (int o = 0; o < 32; ++o) acc[o] = cb;
#pragma unroll
    for (int kk = 0; kk < 62; ++kk) { const float yv = Y[(32 * half + kk) * 256 + c];
#pragma unroll
        for (int o = 0; o < 32; ++o) { const int tap = kk - o; if (tap >= 0 && tap < 31) acc[o] += yv * w[tap]; } }
    __syncthreads();
#pragma unroll
    for (int o = 0; o < 32; ++o) Y[(32 * half + o) * 256 + c] = acc[o];
    __syncthreads();
    const f32x4 lw = ((const f32x4*)(F.in[I_CLNW] + l * 256))[F.lane], lb = ((const f32x4*)(F.in[I_CLNB] + l * 256))[F.lane];
    for (int i = 0; i < 8; ++i) { const int tl = F.wave * 8 + i; const f32x4 v = *(const LAS f32x4*)(Y + tl * 256 + 4 * F.lane);
        const float mu = wave_sum((v.x + v.y) + (v.z + v.w)) * (1.0f / 256.0f); const f32x4 d = v - mu;
        const float var = wave_sum((d.x * d.x + d.y * d.y) + (d.z * d.z + d.w * d.w)) * (1.0f / 256.0f); const float rstd = 1.0f / sqrtf(var + EPS);
        f32x4 z = d * rstd * lw + lb; z.x *= sigmoidf_(z.x); z.y *= sigmoidf_(z.y); z.z *= sigmoidf_(z.z); z.w *= sigmoidf_(z.w);
        u32x2 o; o.x = pk2(z.x, z.y); o.y = pk2(z.z, z.w);
        *(u32x2*)(YC + (size_t)(row0 + t0 + tl) * DM + 512 + 4 * F.lane) = o; }
    __syncthreads();
}
DI void ret_consts(Frame& F, int l, int hh, float& lg2f, float& lg2b) {
    const float df = F.in[I_RDEC][(l * 2 + 0) * 4 + hh], db = F.in[I_RDEC][(l * 2 + 1) * 4 + hh];
    lg2f = log2f(1.0f - exp2f(-df)); lg2b = log2f(1.0f - exp2f(-db));
}
constexpr int ROPE_LDS = AUX_OFF + 4096;
DI void rope_to_lds(Frame& F) { const float* tab = (const float*)(F.ws + WS_ROPE); LAS float* rt = (LAS float*)(F.lds + ROPE_LDS); for (int i = F.tid; i < 1024; i += 512) rt[i] = tab[i]; __syncthreads(); }
DI void unpack8(const u32x4& a, float (&x)[8]) { x[0] = bflo(a.x); x[1] = bfhi(a.x); x[2] = bflo(a.y); x[3] = bfhi(a.y); x[4] = bflo(a.z); x[5] = bfhi(a.z); x[6] = bflo(a.w); x[7] = bfhi(a.w); }
DI void rope_apply(Frame& F, const u32x4& a, const u32x4& b, int hp, bool lat, int tg, float (&x1)[8], float (&x2)[8]) {
    unpack8(a, x1); unpack8(b, x2);
    if (lat) { const int pos = hp == 0 ? (tg >> 6) : (tg & 63); LAS const f32x4* tab = (LAS const f32x4*)(F.lds + ROPE_LDS) + pos * 4;
#pragma unroll
        for (int jj = 0; jj < 4; ++jj) { const f32x4 cs = tab[jj];
            { const float a1 = x1[2 * jj], a2 = x2[2 * jj]; x1[2 * jj] = a1 * cs[0] - a2 * cs[1]; x2[2 * jj] = a2 * cs[0] + a1 * cs[1]; }
            { const float a1 = x1[2 * jj + 1], a2 = x2[2 * jj + 1]; x1[2 * jj + 1] = a1 * cs[2] - a2 * cs[3]; x2[2 * jj + 1] = a2 * cs[2] + a1 * cs[3]; } } }
}
DI void ret_unit_decode(int su, bool& isctx, int& b, int& hh, int& n) {
    isctx = su >= 1024; if (!isctx) { b = su >> 6; hh = (su >> 4) & 3; n = su & 15; } else { const int v = su - 1024; b = v >> 3; hh = (v >> 1) & 3; n = v & 1; }
}
DI void ret_summary_pair(Frame& F, int l, int it) {
    const bf16* PX = (const bf16*)(F.ws + WS_P);
    const int sub = F.wave >> 2, st = F.tid & 255, su = 2 * it + sub;
    bool isctx; int b, hh, n; ret_unit_decode(su, isctx, b, hh, n);
    const int row0 = isctx ? (b * CTXL + n * 128) : (NCTX + b * SEQ + n * 128);
    float lg2f, lg2b; ret_consts(F, l, hh, lg2f, lg2b);
    LAS unsigned char* base = F.lds + sub * 40960;
    LAS unsigned char* Vimg = base;
    LAS unsigned char* Kf = base + 18432;
    LAS unsigned char* Kb = base + 18432 + 10240;
    { const int tok = st >> 1, hp = st & 1; float x1[8], x2[8];
      const bf16* kp = PX + (size_t)(row0 + tok) * INW + C_RK + 32 * hh; const bf16* vp = PX + (size_t)(row0 + tok) * INW + C_RV + 64 * hh + 32 * hp;
      const u32x4 kra = *(const u32x4*)(kp + 8 * hp), krb = *(const u32x4*)(kp + 16 + 8 * hp);
      u32x4 vr[4];
#pragma unroll
      for (int q = 0; q < 4; ++q) vr[q] = *(const u32x4*)(vp + 8 * q);
      rope_apply(F, kra, krb, hp, !isctx, n * 128 + tok, x1, x2);
      const float ks = 0.17677669529663687f;
      const float wf = fast_exp2(lg2f * (float)(127 - tok)) * ks, wb = fast_exp2(lg2b * (float)tok) * ks;
      u32x4 o;
      o.x = pk2(x1[0] * wf, x1[1] * wf); o.y = pk2(x1[2] * wf, x1[3] * wf); o.z = pk2(x1[4] * wf, x1[5] * wf); o.w = pk2(x1[6] * wf, x1[7] * wf); *(LAS u32x4*)(Kf + tok * 80 + 16 * hp) = o;
      o.x = pk2(x2[0] * wf, x2[1] * wf); o.y = pk2(x2[2] * wf, x2[3] * wf); o.z = pk2(x2[4] * wf, x2[5] * wf); o.w = pk2(x2[6] * wf, x2[7] * wf); *(LAS u32x4*)(Kf + tok * 80 + 32 + 16 * hp) = o;
      o.x = pk2(x1[0] * wb, x1[1] * wb); o.y = pk2(x1[2] * wb, x1[3] * wb); o.z = pk2(x1[4] * wb, x1[5] * wb); o.w = pk2(x1[6] * wb, x1[7] * wb); *(LAS u32x4*)(Kb + tok * 80 + 16 * hp) = o;
      o.x = pk2(x2[0] * wb, x2[1] * wb); o.y = pk2(x2[2] * wb, x2[3] * wb); o.z = pk2(x2[4] * wb, x2[5] * wb); o.w = pk2(x2[6] * wb, x2[7] * wb); *(LAS u32x4*)(Kb + tok * 80 + 32 + 16 * hp) = o;
#pragma unroll
      for (int q = 0; q < 4; ++q) *(LAS u32x4*)(Vimg + tok * 144 + 64 * hp + 16 * q) = vr[q]; }
    __syncthreads();
    { const int role = F.wave & 3, dir = role >> 1, et = role & 1;
      const int l32 = F.lane & 31, h = F.lane >> 5, grp = (F.lane >> 4) & 1, i16 = F.lane & 15, q = i16 >> 2, p = i16 & 3;
      LAS unsigned char* Kimg = dir ? Kb : Kf;
      f32x16 acc;
#pragma unroll
      for (int i = 0; i < 16; ++i) acc[i] = 0.f;
#pragma unroll
      for (int s = 0; s < 8; ++s) { const int r0 = 16 * s + 8 * h + q;
          const s16x4 alo = trread(Vimg + r0 * 144 + (32 * et + 16 * grp + 4 * p) * 2), ahi = trread(Vimg + (r0 + 4) * 144 + (32 * et + 16 * grp + 4 * p) * 2);
          const s16x4 blo = trread(Kimg + r0 * 80 + (16 * grp + 4 * p) * 2), bhi = trread(Kimg + (r0 + 4) * 80 + (16 * grp + 4 * p) * 2);
          const bf16x8 a = __builtin_shufflevector(alo, ahi, 0, 1, 2, 3, 4, 5, 6, 7), bb = __builtin_shufflevector(blo, bhi, 0, 1, 2, 3, 4, 5, 6, 7);
          acc = MFMA32(a, bb, acc); }
      float* S = isctx ? (float*)(F.ws + WS_SUMCTX) + ((size_t)((b * 4 + hh) * 2 + n) * 2 + dir) * 2048 : (float*)(F.ws + WS_SUMLAT) + ((size_t)((b * 4 + hh) * 16 + n) * 2 + dir) * 2048;
#pragma unroll
      for (int i = 0; i < 16; ++i) S[(32 * et + crow(i, h)) * 32 + l32] = acc[i]; }
    __syncthreads();
}
DI void ca_phase(Frame& F, int l) {
    rope_to_lds(F);
    const int nconv = l == 0 ? 576 : 512;
    for (int u = F.vb; u < nconv; u += F.G) {
        int v = u; if (l != 0) v += 64;
        if (v < 64) conv_unit(F, l, (v >> 2) * CTXL, (v & 3) * 64, CTXL);
        else { v -= 64; conv_unit(F, l, NCTX + (v >> 5) * SEQ, (v & 31) * 64, SEQ); }
    }
    for (int it = F.vb; it < 576; it += F.G) ret_summary_pair(F, l, it);
}

constexpr int ATT_KV = 18432, ATT_BUF = 2 * ATT_KV, ATT_BT = 2 * ATT_BUF, ATT_NEG = 640;
struct AttRegs { u32x4 k0, v0, k1, v1; };
DI void attn_fetch(const bf16* PX, int rowA, int rowB, unsigned loff, AttRegs& R) {
    const char* pa = (const char*)(PX + (size_t)rowA * INW) + loff; const char* pb = (const char*)(PX + (size_t)rowB * INW) + loff;
    R.k0 = *(const u32x4*)(pa + C_NAK * 2); R.v0 = *(const u32x4*)(pa + C_NAV * 2); R.k1 = *(const u32x4*)(pb + C_NAK * 2); R.v1 = *(const u32x4*)(pb + C_NAV * 2);
}
DI void attn_put(Frame& F, LAS unsigned char* buf, const AttRegs& R) {
    const int key = F.tid >> 3, ch = F.tid & 7;
    *(LAS u32x4*)(buf + key * 144 + 16 * ch) = R.k0; *(LAS u32x4*)(buf + ATT_KV + key * 144 + 16 * ch) = R.v0;
    *(LAS u32x4*)(buf + (64 + key) * 144 + 16 * ch) = R.k1; *(LAS u32x4*)(buf + ATT_KV + (64 + key) * 144 + 16 * ch) = R.v1;
}
template <bool BIAS, int NT>
DI void attn_tiles(LAS const unsigned char* buf, const int (&koff)[2], const bf16x8 (&qf)[4], f32x16& o0, f32x16& o1, f32x16& o2, float& mrun, int lane,
                   LAS const float* const (&bt)[2]  , const float (&pen)[16]) {
    LAS const unsigned char* Kimg = buf; LAS const unsigned char* Vimg = buf + ATT_KV;
    const int l32 = lane & 31, h = lane >> 5, grp = (lane >> 4) & 1, i16 = lane & 15, q = i16 >> 2, p = i16 & 3;
    f32x16 s[NT];
#pragma unroll
    for (int t = 0; t < NT; ++t)
#pragma unroll
        for (int i = 0; i < 16; ++i) s[t][i] = 0.f;
#pragma unroll
    for (int si = 0; si < 4; ++si)
#pragma unroll
        for (int t = 0; t < NT; ++t) { const bf16x8 a = *(const LAS bf16x8*)(Kimg + (koff[t] + l32) * 144 + (16 * si + 8 * h) * 2); s[t] = MFMA32(a, qf[si], s[t]); }
    const float c = 0.125f * LOG2E;
    float v[NT][16]; float mx = -1.0e30f;
#pragma unroll
    for (int t = 0; t < NT; ++t)
#pragma unroll
        for (int i = 0; i < 16; ++i) { float x;
            if (BIAS) x = __builtin_fmaf(s[t][i], c, bt[t][(i & 3) + 8 * (i >> 2)]) + pen[i]; else x = s[t][i];
            v[t][i] = x; mx = fmaxf(mx, x); }
    if (!BIAS) mx *= c;
    mx = fmaxf(mx, __shfl_xor(mx, 32));
    const float mnew = fmaxf(mrun, mx);
    const float alpha = fast_exp2(mrun - mnew);
    if (__any(alpha != 1.0f)) {
#pragma unroll
        for (int i = 0; i < 16; ++i) { o0[i] *= alpha; o1[i] *= alpha; o2[i] *= alpha; } }
    mrun = mnew;
    bf16x8 pf[NT][2];
#pragma unroll
    for (int t = 0; t < NT; ++t) { float pp[16];
#pragma unroll
        for (int i = 0; i < 16; ++i) pp[i] = BIAS ? fast_exp2(v[t][i] - mnew) : fast_exp2(__builtin_fmaf(v[t][i], c, -mnew));
#pragma unroll
        for (int s2 = 0; s2 < 2; ++s2) { u32x4 w; w.x = pk2(pp[8 * s2], pp[8 * s2 + 1]); w.y = pk2(pp[8 * s2 + 2], pp[8 * s2 + 3]); w.z = pk2(pp[8 * s2 + 4], pp[8 * s2 + 5]); w.w = pk2(pp[8 * s2 + 6], pp[8 * s2 + 7]); pf[t][s2] = __builtin_bit_cast(bf16x8, w); } }
    const u32x4 onesw = (u32x4){0x3f803f80u, 0x3f803f80u, 0x3f803f80u, 0x3f803f80u}; const bf16x8 ones = __builtin_bit_cast(bf16x8, onesw);
#pragma unroll
    for (int t = 0; t < NT; ++t)
#pragma unroll
        for (int s2 = 0; s2 < 2; ++s2) { const int r0 = koff[t] + 16 * s2 + 4 * h + q;
#pragma unroll
            for (int et = 0; et < 2; ++et) { const int cb = (32 * et + 16 * grp + 4 * p) * 2;
                const s16x4 lo = trread(Vimg + r0 * 144 + cb), hi = trread(Vimg + (r0 + 8) * 144 + cb);
                const bf16x8 a = __builtin_shufflevector(lo, hi, 0, 1, 2, 3, 4, 5, 6, 7);
                if (et == 0) o0 = MFMA32(a, pf[t][s2], o0); else o1 = MFMA32(a, pf[t][s2], o1); }
            o2 = MFMA32(ones, pf[t][s2], o2); }
}
DI void attn_unit(Frame& F, int l, bool na, int b, int hh, int rg) {
    const bf16* PX = (const bf16*)(F.ws + WS_P);
    bf16* YC = (bf16*)(F.ws + WS_U);
    LAS float* btab = (LAS float*)(F.lds + ATT_BT);
    const int l32 = F.lane & 31, h = F.lane >> 5;
    int qrow, r = 0, qcol = 0, kc0 = 0, ra = 0;
    float pen[16];
#pragma unroll
    for (int i = 0; i < 16; ++i) pen[i] = 0.f;
    if (na) { const int rp = F.wave >> 2, n = F.wave & 3; ra = 4 * rg + 2 * rp; r = ra + (l32 >> 4); qcol = 16 * n + (l32 & 15); qrow = NCTX + b * SEQ + r * GW + qcol;
        int w0 = qcol - 8; w0 = w0 < 0 ? 0 : (w0 > 48 ? 48 : w0); kc0 = 16 * n - 8; kc0 = kc0 < 0 ? 0 : (kc0 > 32 ? 32 : kc0);
#pragma unroll
        for (int i = 0; i < 16; ++i) pen[i] = ((unsigned)(kc0 + crow(i, h) - w0) < 16u) ? 0.f : -1.0e30f; }
    else qrow = b * CTXL + 32 * F.wave + l32;
    bf16x8 qf[4];
#pragma unroll
    for (int si = 0; si < 4; ++si) qf[si] = *(const bf16x8*)(PX + (size_t)qrow * INW + C_NAQ + 64 * hh + 16 * si + 8 * h);
    if (na) { for (int idx = F.tid; idx < ATT_NEG + 128; idx += 512) { float v = 0.f; if (idx >= 48 && idx < 48 + 465) v = F.in[I_RPB][((size_t)l * 8 + hh) * 465 + (idx - 48)] * LOG2E; if (idx >= ATT_NEG) v = -1.0e30f; btab[idx] = v; } }
    f32x16 o0, o1, o2;
#pragma unroll
    for (int i = 0; i < 16; ++i) { o0[i] = 0.f; o1[i] = 0.f; o2[i] = 0.f; }
    float mrun = -1.0e30f;
    int ylo = 0, yhi = 0, nsteps = 2;
    if (na) { const int rlo = 4 * rg, rhi = 4 * rg + 3;
        ylo = rlo - 4; ylo = ylo < 0 ? 0 : (ylo > 24 ? 24 : ylo);
        yhi = rhi - 4; yhi = yhi < 0 ? 0 : (yhi > 24 ? 24 : yhi); yhi += 8; nsteps = 2 + (yhi - ylo + 1) / 2; }
    int sa = ra - 4; sa = sa < 0 ? 0 : (sa > 24 ? 24 : sa);
    int sb = ra + 1 - 4; sb = sb < 0 ? 0 : (sb > 24 ? 24 : sb);
    const int mylo = (l32 >> 4) ? sb : sa;
    const int cbase = kc0 + 4 * h - qcol + 15;
#define ATT_ROWA(sx) ((sx) < 2 ? b * CTXL + 128 * (sx) : NCTX + b * SEQ + (ylo + 2 * ((sx) - 2)) * GW)
#define ATT_ROWB(sx) ((sx) < 2 ? b * CTXL + 128 * (sx) + 64 : NCTX + b * SEQ + ((ylo + 2 * ((sx) - 2) + 1) < yhi ? (ylo + 2 * ((sx) - 2) + 1) : (yhi - 1)) * GW)
    AttRegs R;
    unsigned loff = (unsigned)(((F.tid >> 3) * INW + 64 * hh + 8 * (F.tid & 7)) * 2); asm volatile("" : "+v"(loff));
    attn_fetch(PX, ATT_ROWA(0), ATT_ROWB(0), loff, R);
    for (int st = 0; st < nsteps; ++st) {
        LAS unsigned char* buf = F.lds + (st & 1) * ATT_BUF;
        attn_put(F, buf, R);
        if (st + 1 < nsteps) attn_fetch(PX, ATT_ROWA(st + 1), ATT_ROWB(st + 1), loff, R);
        __syncthreads();
        if (st < 2) {
            LAS const float* const bt[2] = {btab, btab};
            { const int ko[2] = {0, 32}; attn_tiles<false, 2>(buf, ko, qf, o0, o1, o2, mrun, F.lane, bt, pen); }
            { const int ko[2] = {64, 96}; attn_tiles<false, 2>(buf, ko, qf, o0, o1, o2, mrun, F.lane, bt, pen); }
        } else {
            const int y0 = ylo + 2 * (st - 2), y1 = y0 + 1;
            const bool act0 = (y0 >= sa && y0 < sb + 8), act1 = (y1 < yhi && y1 >= sa && y1 < sb + 8);
            const bool ok0 = (unsigned)(y0 - mylo) < 8u, ok1 = (unsigned)(y1 - mylo) < 8u;
            LAS const float* b0 = btab + (ok0 ? 48 + (y0 - r + 7) * 31 + cbase : ATT_NEG);
            LAS const float* b1 = btab + (ok1 ? 48 + (y1 - r + 7) * 31 + cbase : ATT_NEG);
            if (act0 && act1) { const int ko[2] = {kc0, 64 + kc0}; LAS const float* const bt[2] = {b0, b1}; attn_tiles<true, 2>(buf, ko, qf, o0, o1, o2, mrun, F.lane, bt, pen); }
            else if (act0) { const int ko[2] = {kc0, kc0}; LAS const float* const bt[2] = {b0, b0}; attn_tiles<true, 1>(buf, ko, qf, o0, o1, o2, mrun, F.lane, bt, pen); }
            else if (act1) { const int ko[2] = {64 + kc0, 64 + kc0}; LAS const float* const bt[2] = {b1, b1}; attn_tiles<true, 1>(buf, ko, qf, o0, o1, o2, mrun, F.lane, bt, pen); }
        }
    }
#undef ATT_ROWA
#undef ATT_ROWB
    const float inv = 1.0f / o2[0];
    bf16* orow = YC + (size_t)qrow * DM + 64 * hh;
#pragma unroll
    for (int gq = 0; gq < 4; ++gq) { u32x2 w;
        w.x = pk2(o0[4 * gq] * inv, o0[4 * gq + 1] * inv); w.y = pk2(o0[4 * gq + 2] * inv, o0[4 * gq + 3] * inv); *(u32x2*)(orow + 8 * gq + 4 * h) = w;
        w.x = pk2(o1[4 * gq] * inv, o1[4 * gq + 1] * inv); w.y = pk2(o1[4 * gq + 2] * inv, o1[4 * gq + 3] * inv); *(u32x2*)(orow + 32 + 8 * gq + 4 * h) = w; }
    __syncthreads();
}
struct RetRaw { u32x4 kra, krb, vra, vrb, qra, qrb; u32x2 gg[8]; };
DI void ret_fetch(Frame& F, int su, RetRaw& R) {
    const bf16* PX = (const bf16*)(F.ws + WS_P);
    bool isctx; int b, hh, n; ret_unit_decode(su, isctx, b, hh, n);
    const int row0 = isctx ? (b * CTXL + n * 128) : (NCTX + b * SEQ + n * 128);
    const int dir = F.wave >> 2, qb = F.wave & 3, l32 = F.lane & 31, h = F.lane >> 5; const int iq = 32 * qb + l32;
    const int ktok = (F.tid & 255) >> 1, khp = F.tid & 1;
    const bf16* kp = PX + (size_t)(row0 + ktok) * INW + C_RK + 32 * hh;
    R.kra = *(const u32x4*)(kp + 8 * khp); R.krb = *(const u32x4*)(kp + 16 + 8 * khp);
    const int vtok = F.tid >> 2, vch = F.tid & 3; const bf16* vp = PX + (size_t)(row0 + vtok) * INW + C_RV + 64 * hh + 16 * vch;
    R.vra = *(const u32x4*)vp; R.vrb = *(const u32x4*)(vp + 8);
    const bf16* qp = PX + (size_t)(row0 + iq) * INW + C_RQ + 32 * hh;
    R.qra = *(const u32x4*)(qp + 8 * h); R.qrb = *(const u32x4*)(qp + 16 + 8 * h);
    const bf16* gp = PX + (size_t)(row0 + iq) * INW + (dir ? C_GB : C_GF) + 64 * hh;
#pragma unroll
    for (int et = 0; et < 2; ++et)
#pragma unroll
        for (int gq = 0; gq < 4; ++gq) R.gg[et * 4 + gq] = *(const u32x2*)(gp + 32 * et + 8 * gq + 4 * h);
}
DI void ret_out_units(Frame& F, int l, int nret) {
    bf16* YC = (bf16*)(F.ws + WS_U);
    LAS unsigned char* Kimg = F.lds;
    LAS unsigned char* Vimg = F.lds + 10240;
    LAS unsigned char* Stf = F.lds + 28672;
    LAS unsigned char* Stb = F.lds + 33792;
    LAS float* Ob = (LAS float*)(F.lds + 38912);
    const int dir = F.wave >> 2, qb = F.wave & 3, l32 = F.lane & 31, h = F.lane >> 5, grp = (F.lane >> 4) & 1, i16 = F.lane & 15, q = i16 >> 2, p = i16 & 3;
    const int iq = 32 * qb + l32;
    const int ktok = (F.tid & 255) >> 1, khp = F.tid & 1, vtok = F.tid >> 2, vch = F.tid & 3;
    int su = F.vb;
    if (su >= nret) return;
    RetRaw R; ret_fetch(F, su, R);
    for (; su < nret; su += F.G) {
        bool isctx; int b, hh, n; ret_unit_decode(su, isctx, b, hh, n);
        const int row0 = isctx ? (b * CTXL + n * 128) : (NCTX + b * SEQ + n * 128);
        float lg2f, lg2b; ret_consts(F, l, hh, lg2f, lg2b);
        if (F.tid < 256) { float x1[8], x2[8]; rope_apply(F, R.kra, R.krb, khp, !isctx, n * 128 + ktok, x1, x2);
            const float ks = 0.17677669529663687f; u32x4 o;
            o.x = pk2(x1[0] * ks, x1[1] * ks); o.y = pk2(x1[2] * ks, x1[3] * ks); o.z = pk2(x1[4] * ks, x1[5] * ks); o.w = pk2(x1[6] * ks, x1[7] * ks); *(LAS u32x4*)(Kimg + ktok * 80 + 16 * khp) = o;
            o.x = pk2(x2[0] * ks, x2[1] * ks); o.y = pk2(x2[2] * ks, x2[3] * ks); o.z = pk2(x2[4] * ks, x2[5] * ks); o.w = pk2(x2[6] * ks, x2[7] * ks); *(LAS u32x4*)(Kimg + ktok * 80 + 32 + 16 * khp) = o; }
        *(LAS u32x4*)(Vimg + vtok * 144 + 32 * vch) = R.vra; *(LAS u32x4*)(Vimg + vtok * 144 + 32 * vch + 16) = R.vrb;
        bf16x8 qf[2], qd[2];
        { float x1[8], x2[8]; rope_apply(F, R.qra, R.qrb, h, !isctx, n * 128 + iq, x1, x2);
          const float dec = dir == 0 ? fast_exp2(lg2f * (float)(iq + 1)) : fast_exp2(lg2b * (float)(128 - iq));
          u32x4 w;
          w.x = pk2(x1[0], x1[1]); w.y = pk2(x1[2], x1[3]); w.z = pk2(x1[4], x1[5]); w.w = pk2(x1[6], x1[7]); qf[0] = __builtin_bit_cast(bf16x8, w);
          w.x = pk2(x2[0], x2[1]); w.y = pk2(x2[2], x2[3]); w.z = pk2(x2[4], x2[5]); w.w = pk2(x2[6], x2[7]); qf[1] = __builtin_bit_cast(bf16x8, w);
          w.x = pk2(x1[0] * dec, x1[1] * dec); w.y = pk2(x1[2] * dec, x1[3] * dec); w.z = pk2(x1[4] * dec, x1[5] * dec); w.w = pk2(x1[6] * dec, x1[7] * dec); qd[0] = __builtin_bit_cast(bf16x8, w);
          w.x = pk2(x2[0] * dec, x2[1] * dec); w.y = pk2(x2[2] * dec, x2[3] * dec); w.z = pk2(x2[4] * dec, x2[5] * dec); w.w = pk2(x2[6] * dec, x2[7] * dec); qd[1] = __builtin_bit_cast(bf16x8, w); }
        u32x2 gcur[8];
#pragma unroll
        for (int i = 0; i < 8; ++i) gcur[i] = R.gg[i];
        const float cf = fast_exp2(lg2f * 128.0f), cb = fast_exp2(lg2b * 128.0f);
        const float* SC = (const float*)(F.ws + WS_SUMCTX) + (size_t)((b * 4 + hh) * 2) * 2 * 2048;
        const float* SL = (const float*)(F.ws + WS_SUMLAT) + (size_t)((b * 4 + hh) * 16) * 2 * 2048;
        const int eo = 4 * F.tid;
        f32x4 t[16], c00, c10, c11, c01;
        if (!isctx) {
#pragma unroll
            for (int m = 0; m < 16; ++m) t[m] = *(const f32x4*)(SL + (size_t)(m * 2 + (m <= n ? 0 : 1)) * 2048 + eo);
            c00 = *(const f32x4*)(SC + (0 * 2 + 0) * 2048 + eo); c10 = *(const f32x4*)(SC + (1 * 2 + 0) * 2048 + eo);
            c11 = *(const f32x4*)(SC + (1 * 2 + 1) * 2048 + eo); c01 = *(const f32x4*)(SC + (0 * 2 + 1) * 2048 + eo);
        } else {
#pragma unroll
            for (int m = 0; m < 16; ++m) t[m] = (f32x4){0.f, 0.f, 0.f, 0.f};
            c00 = *(const f32x4*)(SC + (0 * 2 + 0) * 2048 + eo); c11 = *(const f32x4*)(SC + (1 * 2 + 1) * 2048 + eo); c10 = c00; c01 = c11;
        }
        __syncthreads();
        f32x16 o0, o1;
#pragma unroll
        for (int i = 0; i < 16; ++i) { o0[i] = 0.f; o1[i] = 0.f; }
        const float lgd = dir ? lg2b : lg2f;
        const int kt_lo = dir ? qb : 0, kt_hi = dir ? 3 : qb;
        for (int kt = kt_lo; kt <= kt_hi; ++kt) {
            f32x16 sc;
#pragma unroll
            for (int i = 0; i < 16; ++i) sc[i] = 0.f;
#pragma unroll
            for (int si = 0; si < 2; ++si) { const bf16x8 a = *(const LAS bf16x8*)(Kimg + (32 * kt + l32) * 80 + (16 * si + 8 * h) * 2); sc = MFMA32(a, qf[si], sc); }
            float pp[16];
#pragma unroll
            for (int i = 0; i < 16; ++i) { const int j = 32 * kt + crow(i, h); const int diff = dir ? (j - iq) : (iq - j); pp[i] = diff >= 0 ? sc[i] * fast_exp2(lgd * (float)diff) : 0.f; }
            bf16x8 pf[2];
#pragma unroll
            for (int s2 = 0; s2 < 2; ++s2) { u32x4 w; w.x = pk2(pp[8 * s2], pp[8 * s2 + 1]); w.y = pk2(pp[8 * s2 + 2], pp[8 * s2 + 3]); w.z = pk2(pp[8 * s2 + 4], pp[8 * s2 + 5]); w.w = pk2(pp[8 * s2 + 6], pp[8 * s2 + 7]); pf[s2] = __builtin_bit_cast(bf16x8, w); }
#pragma unroll
            for (int s2 = 0; s2 < 2; ++s2) { const int r0 = 32 * kt + 16 * s2 + 4 * h + q;
#pragma unroll
                for (int et = 0; et < 2; ++et) { const int cbo = (32 * et + 16 * grp + 4 * p) * 2;
                    const s16x4 lo = trread(Vimg + r0 * 144 + cbo), hi = trread(Vimg + (r0 + 8) * 144 + cbo);
                    const bf16x8 a = __builtin_shufflevector(lo, hi, 0, 1, 2, 3, 4, 5, 6, 7);
                    if (et == 0) o0 = MFMA32(a, pf[s2], o0); else o1 = MFMA32(a, pf[s2], o1); } }
        }
        { f32x4 sf = (f32x4){0.f, 0.f, 0.f, 0.f}, sb = sf;
          if (!isctx) {
              sf = c00 * cf + c10;
#pragma unroll
              for (int m = 0; m < 16; ++m) { const f32x4 nv = sf * cf + t[m]; sf = (m < n) ? nv : sf; }
              sb = c11 * cb + c01;
#pragma unroll
              for (int m = 15; m >= 0; --m) { const f32x4 nv = sb * cb + t[m]; sb = (m > n) ? nv : sb; }
          } else { if (n == 1) sf = c00; if (n == 0) sb = c11; }
          const int e = eo >> 5, d = eo & 31; u32x2 w;
          w.x = pk2(sf[0], sf[1]); w.y = pk2(sf[2], sf[3]); *(LAS u32x2*)(Stf + e * 80 + d * 2) = w;
          w.x = pk2(sb[0], sb[1]); w.y = pk2(sb[2], sb[3]); *(LAS u32x2*)(Stb + e * 80 + d * 2) = w; }
        __syncthreads();
        { LAS const unsigned char* St = dir ? Stb : Stf;
#pragma unroll
          for (int s2 = 0; s2 < 2; ++s2) { const bf16x8 a0 = *(const LAS bf16x8*)(St + l32 * 80 + (16 * s2 + 8 * h) * 2), a1 = *(const LAS bf16x8*)(St + (32 + l32) * 80 + (16 * s2 + 8 * h) * 2);
              o0 = MFMA32(a0, qd[s2], o0); o1 = MFMA32(a1, qd[s2], o1); } }
        if (su + F.G < nret) ret_fetch(F, su + F.G, R);
        float sm = 0.f;
#pragma unroll
        for (int i = 0; i < 16; ++i) sm += o0[i] + o1[i];
        sm += __shfl_xor(sm, 32);
        const float mu = sm * (1.0f / 64.0f);
        float vs = 0.f;
#pragma unroll
        for (int i = 0; i < 16; ++i) { const float d0 = o0[i] - mu, d1 = o1[i] - mu; vs += d0 * d0 + d1 * d1; }
        vs += __shfl_xor(vs, 32);
        const float rstd = 1.0f / sqrtf(vs * (1.0f / 64.0f) + EPS);
        const float* gn = F.in[I_RGNW] + l * 256 + 64 * hh;
        float val[32];
#pragma unroll
        for (int et = 0; et < 2; ++et)
#pragma unroll
            for (int gq = 0; gq < 4; ++gq) { const int e0 = 32 * et + 8 * gq + 4 * h; const u32x2 ggv = gcur[et * 4 + gq]; const f32x4 gw = *(const f32x4*)(gn + e0);
                const float g0 = bflo(ggv.x), g1 = bfhi(ggv.x), g2 = bflo(ggv.y), g3 = bfhi(ggv.y);
                const float a0 = et ? o1[4 * gq] : o0[4 * gq], a1 = et ? o1[4 * gq + 1] : o0[4 * gq + 1], a2 = et ? o1[4 * gq + 2] : o0[4 * gq + 2], a3 = et ? o1[4 * gq + 3] : o0[4 * gq + 3];
                val[et * 16 + 4 * gq] = (a0 - mu) * rstd * gw[0] * g0 * sigmoidf_(g0); val[et * 16 + 4 * gq + 1] = (a1 - mu) * rstd * gw[1] * g1 * sigmoidf_(g1);
                val[et * 16 + 4 * gq + 2] = (a2 - mu) * rstd * gw[2] * g2 * sigmoidf_(g2); val[et * 16 + 4 * gq + 3] = (a3 - mu) * rstd * gw[3] * g3 * sigmoidf_(g3); }
        if (dir == 0) {
#pragma unroll
            for (int et = 0; et < 2; ++et)
#pragma unroll
                for (int gq = 0; gq < 4; ++gq)
#pragma unroll
                    for (int j = 0; j < 4; ++j) Ob[iq * 65 + 32 * et + 8 * gq + 4 * h + j] = val[et * 16 + 4 * gq + j];
        }
        __syncthreads();
        if (dir == 1) { bf16* orow = YC + (size_t)(row0 + iq) * DM + 768 + 64 * hh;
#pragma unroll
            for (int et = 0; et < 2; ++et)
#pragma unroll
                for (int gq = 0; gq < 4; ++gq) { const int e0 = 32 * et + 8 * gq + 4 * h; float tt[4];
#pragma unroll
                    for (int j = 0; j < 4; ++j) tt[j] = val[et * 16 + 4 * gq + j] + Ob[iq * 65 + e0 + j];
                    u32x2 w; w.x = pk2(tt[0], tt[1]); w.y = pk2(tt[2], tt[3]); *(u32x2*)(orow + e0) = w; } }
        __syncthreads();
    }
}
#ifndef PROBE_SUB
#define PROBE_SUB 0
#endif
DI void cb_phase(Frame& F, int l) {
    rope_to_lds(F);
    const int nattn = l == 0 ? 1152 : 1024;
    for (int rep = 0; rep < ((PROBE_SUB & 1) ? 2 : 1); ++rep)
    for (int u = F.vb; u < nattn; u += F.G) {
        if (u < 1024) attn_unit(F, l, true, u >> 6, (u >> 3) & 7, u & 7);
        else { const int v = u - 1024; attn_unit(F, l, false, v >> 3, v & 7, 0); }
    }
    const int nret = l == 0 ? 1152 : 1024;
    for (int rep = 0; rep < ((PROBE_SUB & 2) ? 2 : 1); ++rep) ret_out_units(F, l, nret);
}

static_assert(sizeof(Params) == 240, "kernarg layout: in[26] at 0, out at 208, ws at 216, ph_lo at 224, ph_hi at 228");
#ifdef ONLY_PHASE
#define IN(k) ((k) == ONLY_PHASE && lo <= (k) && (k) < hi)
#else
#define IN(k) (lo <= (k) && (k) < hi)
#endif
#ifndef PROBE_MASK
#define PROBE_MASK 0u
#endif
#define NREP(k) (((PROBE_MASK >> (k)) & 1u) ? 2 : 1)
#define SEAM(k) do { if (IN(k) && IN((k) + 1)) { XcdBarrier bb_ = bar; asm volatile("" : "+s"(bb_.bar)); xcd_barrier(bb_, F.wave); } } while (0)
#define GLDS(P) ((LAS unsigned char*)(P).lds)
#define WSB(P, off) ((const pg8::bf16_t*)((P).ws + (off)))
template <int l> DI void layer_phases(Frame& F, const XcdBarrier& bar) {
    constexpr int lo = 0, hi = N_PHASES;
        const int pb = l == 0 ? 1 : 9;
        if (IN(pb + 0)) for (int rep_ = 0; rep_ < NREP(pb + 0); ++rep_) { if (rep_) __syncthreads(); Frame P = phase_frame(F); norm_phase(P, l, 1, l == 0, 0); } SEAM(pb + 0);
        if (IN(pb + 1)) for (int rep_ = 0; rep_ < NREP(pb + 1); ++rep_) { if (rep_) __syncthreads();
            Frame P = phase_frame(F);
            pg8::StaticOrder S; S.init(NTOK, INW, P.G, P.bid);
            pg8::EpiStoreBf16 E{(pg8::bf16_t*)(P.ws + WS_P), INW};
            pg8::gemm_phase<pg8::EpiStoreBf16, pg8::StaticOrder, pg8::RowsLinear, true>(GLDS(P), P.tid, WSB(P, WS_U), WSB(P, WS_WIN) + (size_t)l * INW * DM, 2 * DM, S, E, pg8::RowsLinear{});
            if (PROBE_SUB & 4) { __syncthreads(); pg8::gemm_phase<pg8::EpiNull, pg8::StaticOrder, pg8::RowsLinear, true>(GLDS(P), P.tid, WSB(P, WS_U), WSB(P, WS_WIN) + (size_t)l * INW * DM, 2 * DM, S, pg8::EpiNull{}, pg8::RowsLinear{}); }
            if (l == 0) bg_convert_tail(P, S.nwg, BG_B0, BG_D0); else bg_convert_tail(P, S.nwg, BG_B1, BG_CL);
        } SEAM(pb + 1);
        if (IN(pb + 2)) for (int rep_ = 0; rep_ < NREP(pb + 2); ++rep_) { if (rep_) __syncthreads(); Frame P = phase_frame(F); if (l == 1) { bg_convert_all(P, BG_CL, BG_ITEMS); __syncthreads(); } ca_phase(P, l); } SEAM(pb + 2);
        if (IN(pb + 3)) for (int rep_ = 0; rep_ < NREP(pb + 3); ++rep_) { if (rep_) __syncthreads(); Frame P = phase_frame(F); cb_phase(P, l); } SEAM(pb + 3);
        if (IN(pb + 4)) {
            Frame P = phase_frame(F);
            const int rb = l == 0 ? 0 : NCTX;
            const float* modlat = (const float*)(P.ws + WS_MODLAT) + (size_t)l * 16 * 6144;
            const float* modctx = (const float*)(P.ws + WS_MODCTX) + (size_t)l * 6144;
            float* hctx = (float*)(P.ws + WS_HCTX);
            pg8::StaticOrder S; S.init(NTOK - rb, DM, P.G, P.bid);
            pg8::EpiResGate E{l == 0 ? P.in[I_CTX] : hctx, l == 0 ? P.in[I_X] : P.out, hctx, P.out, modlat + 2 * DM, modctx + 2 * DM, rb};
            pg8::gemm_phase<pg8::EpiResGate, pg8::StaticOrder, pg8::RowsLinear, true>(GLDS(P), P.tid, WSB(P, WS_U) + (size_t)rb * DM, WSB(P, WS_WOUT) + (size_t)l * DM * DM, 2 * DM, S, E, pg8::RowsLinear{});
            if (l == 0) bg_convert_tail(P, S.nwg, BG_D0, BG_E0);
        } SEAM(pb + 4);
        if (l == 0) {
            if (IN(6)) for (int rep_ = 0; rep_ < NREP(6); ++rep_) { if (rep_) __syncthreads(); Frame P = phase_frame(F); norm_phase(P, 0, 2, false, 0, DENSE_FP8 == 1); } SEAM(6);
            if (IN(7)) for (int rep_ = 0; rep_ < NREP(7); ++rep_) { if (rep_) __syncthreads();
                Frame P = phase_frame(F);
                pg8::StaticOrder S; S.init(NTOK, 2 * DFF, P.G, P.bid);
                pg8::EpiSwiglu<false> E{(pg8::bf16_t*)(P.ws + WS_P), DFF, 0, nullptr};
#if DENSE_FP8 == 1
                pg8::gemm_phase<pg8::EpiSwiglu<false>, pg8::StaticOrder, pg8::RowsLinearOff, true, true>(GLDS(P), P.tid, WSB(P, WS_U), WSB(P, WS_WGU), DM, S, E, pg8::RowsLinearOff{}, SCL_U, SCL_WGU);
#else
                pg8::gemm_phase<pg8::EpiSwiglu<false>, pg8::StaticOrder, pg8::RowsLinear, true>(GLDS(P), P.tid, WSB(P, WS_U), WSB(P, WS_WGU), 2 * DM, S, E, pg8::RowsLinear{});
#endif
                bg_convert_tail(P, S.nwg, BG_E0, BG_F0);
            } SEAM(7);
            if (IN(8)) {
                Frame P = phase_frame(F);
                const float* modlat = (const float*)(P.ws + WS_MODLAT);
                const float* modctx = (const float*)(P.ws + WS_MODCTX);
                float* hctx = (float*)(P.ws + WS_HCTX);
                pg8::StaticOrder S; S.init(NTOK, DM, P.G, P.bid);
                pg8::EpiResGate E{hctx, P.out, hctx, P.out, modlat + 5 * DM, modctx + 5 * DM, 0};
#if DENSE_FP8
                pg8::gemm_phase<pg8::EpiResGate, pg8::StaticOrder, pg8::RowsLinearOff, true, true>(GLDS(P), P.tid, WSB(P, WS_P), WSB(P, WS_WD), DFF, S, E, pg8::RowsLinearOff{}, SCL_H, SCL_WD);
#else
                pg8::gemm_phase<pg8::EpiResGate, pg8::StaticOrder, pg8::RowsLinear, true>(GLDS(P), P.tid, WSB(P, WS_P), WSB(P, WS_WD), 2 * DFF, S, E, pg8::RowsLinear{});
#endif
                bg_convert_tail(P, S.nwg, BG_F0, BG_B1);
            } SEAM(8);
        } else {
            if (IN(14)) for (int rep_ = 0; rep_ < NREP(14); ++rep_) { if (rep_) __syncthreads(); Frame P = phase_frame(F); norm_moe_phase(P); } SEAM(14);
            if (IN(15)) for (int rep_ = 0; rep_ < NREP(15); ++rep_) { if (rep_) __syncthreads(); Frame P = phase_frame(F); moe_route_phase(P); } SEAM(15);
            LAS int* texp = (LAS int*)(F.lds + AUX_TAB);
            if (IN(16) || IN(17)) {
                Frame P = phase_frame(F);
                const int* meta = (const int*)(P.ws + WS_META);
                __syncthreads();
                for (int i = P.tid; i < 2 * MOE_TILES; i += 512) texp[i] = ld_i32_coherent(meta + (i / MOE_TILES) * 256 + 1 + (i % MOE_TILES));
                if (P.tid < 2) texp[2 * MOE_TILES + P.tid] = ld_i32_coherent(meta + P.tid * 256);
                __syncthreads();
            }
            if (IN(16)) for (int rep_ = 0; rep_ < NREP(16); ++rep_) { if (rep_) __syncthreads();
                Frame P = phase_frame(F);
                const int NT0 = __builtin_amdgcn_readfirstlane(texp[2 * MOE_TILES]), NT1 = __builtin_amdgcn_readfirstlane(texp[2 * MOE_TILES + 1]);
                pg8::MoeOrder S{NT0, NT1, 28, P.G, P.bid, (const LAS int*)texp};
                pg8::EpiSwiglu<true> E{(pg8::bf16_t*)(P.ws + WS_P), DFE, 28, (const float*)(P.ws + WS_PROW)};
                pg8::gemm_phase<pg8::EpiSwiglu<true>, pg8::MoeOrder, pg8::RowsGather, true, true>(GLDS(P), P.tid, WSB(P, WS_U), WSB(P, WS_MGU), DM, S, E, pg8::RowsGather{(const int*)(P.ws + WS_ROWMAP), 0}, SCL_U, SCL_WGU);
            } SEAM(16);
            if (IN(17)) {
                Frame P = phase_frame(F);
                const float* modlat = (const float*)(P.ws + WS_MODLAT) + (size_t)16 * 6144;
                const int NT0 = __builtin_amdgcn_readfirstlane(texp[2 * MOE_TILES]), NT1 = __builtin_amdgcn_readfirstlane(texp[2 * MOE_TILES + 1]);
                pg8::MoeOrder S{NT0, NT1, 4, P.G, P.bid, (const LAS int*)texp};
                pg8::EpiMoeScatter E{(const int*)(P.ws + WS_ROWMAP), (const float*)(P.ws + WS_PROW), P.out, (pg8::bf16_t*)(P.ws + WS_U), modlat + 5 * DM, 4};
                pg8::gemm_phase<pg8::EpiMoeScatter, pg8::MoeOrder, pg8::RowsLinearOff, true, true>(GLDS(P), P.tid, P.ws + WS_P, WSB(P, WS_MD), DFE, S, E, pg8::RowsLinearOff{}, SCL_H, SCL_WD);
            } SEAM(17);
        }
}
__global__ void __launch_bounds__(512, 2) fwd_kernel(Params prm) {
    extern __shared__ __attribute__((aligned(16))) unsigned char lds_raw[];
    Frame F;
    F.lds = (LAS unsigned char*)lds_raw;
    F.tid = threadIdx.x; F.lane = F.tid & 63; F.wave = __builtin_amdgcn_readfirstlane(F.tid >> 6);
    F.G = gridDim.x; F.bid = blockIdx.x; F.vb = F.bid;
    F.in.ka = (karg_t)__builtin_amdgcn_kernarg_segment_ptr(); F.out = prm.out; F.ws = prm.ws;
    volatile LAS unsigned* MISC = (volatile LAS unsigned*)(F.lds + AUX_OFF);
    if (F.tid < 64) MISC[F.tid] = 0u;
    __syncthreads();
    XcdBarrier bar; bar.bar = (unsigned*)(prm.ws + WS_CTL) + 1024; bar.x = 0; bar.st = nullptr;
#if MK_PER_PHASE
    const int lo = prm.ph_lo, hi = prm.ph_hi;
#else
    constexpr int lo = 0, hi = N_PHASES;
#endif
    if (hi - lo > 1) bar = xcd_barrier_post((unsigned*)(prm.ws + WS_CTL) + 1024, MISC + 8);

    if (IN(0)) for (int rep_ = 0; rep_ < NREP(0); ++rep_) { if (rep_) __syncthreads(); Frame P = phase_frame(F); p0_prologue(P); } SEAM(0);
    layer_phases<0>(F, bar);
    layer_phases<1>(F, bar);
    if (IN(PH_FINAL)) { Frame P = phase_frame(F); final_phase(P); }
#undef IN
#undef SEAM
}

extern "C" void kernel_launch(void* const* d_in, const int* in_sizes, int n_in, void* d_out, int out_size, void* d_ws, size_t ws_size, hipStream_t stream) {
    static int grid = 0;
    if (grid == 0) {
        if (n_in != 26 || in_sizes[0] != NLAT * DM || out_size != NLAT * DM || ws_size < WS_END) {
            fprintf(stderr, "kernel_launch: unexpected shapes (n_in %d, in0 %d, out %d, ws %zu, need %zu); nothing launched\n", n_in, n_in > 0 ? in_sizes[0] : -1, out_size, ws_size, (size_t)WS_END); grid = -1; return; }
        int dev = 0, cus = 0, per_cu = 0;
        if (hipGetDevice(&dev) != hipSuccess || hipDeviceGetAttribute(&cus, hipDeviceAttributeMultiprocessorCount, dev) != hipSuccess) { grid = -1; return; }
        if (hipFuncSetAttribute((const void*)fwd_kernel, hipFuncAttributeMaxDynamicSharedMemorySize, LDS_BYTES) != hipSuccess) { fprintf(stderr, "kernel_launch: hipFuncSetAttribute failed\n"); grid = -1; return; }
        if (hipOccupancyMaxActiveBlocksPerMultiprocessor(&per_cu, (const void*)fwd_kernel, 512, LDS_BYTES) != hipSuccess || per_cu < 1)
            fprintf(stderr, "kernel_launch: note: occupancy query reports %d workgroups per CU\n", per_cu);
        (void)hipGetLastError();
        grid = cus;
    }
    if (grid < 0) return;
    if (hipMemsetAsync((char*)d_ws + WS_CTL, 0, CTL_ZERO_BYTES, stream) != hipSuccess) return;
    Params p{};
    for (int i = 0; i < 26; ++i) p.in[i] = (const float*)d_in[i];
    p.out = (float*)d_out; p.ws = (unsigned char*)d_ws;
#if MK_PER_PHASE
    for (int ph = 0; ph < N_PHASES; ++ph) { p.ph_lo = ph; p.ph_hi = ph + 1; hipLaunchKernelGGL(fwd_kernel, dim3(grid), dim3(512), LDS_BYTES, stream, p); }
#else
    p.ph_lo = 0; p.ph_hi = N_PHASES;
    hipLaunchKernelGGL(fwd_kernel, dim3(grid), dim3(512), LDS_BYTES, stream, p);
#endif
}
```

```cpp
#include <hip/hip_runtime.h>
#include <cstdio>
#include <cstdint>

#ifndef PROBE_SUB
#define PROBE_SUB 0
#endif
#ifndef MK_PER_PHASE
#define MK_PER_PHASE 0
#endif

#define LAS __attribute__((address_space(3)))
#define GAS __attribute__((address_space(1)))
#define DI __device__ __forceinline__
typedef unsigned short bf16;
typedef short bf16x8 __attribute__((ext_vector_type(8)));
typedef short s16x4 __attribute__((ext_vector_type(4)));
typedef float f32x4 __attribute__((ext_vector_type(4)));
typedef float f32x16 __attribute__((ext_vector_type(16)));
typedef unsigned u32x4 __attribute__((ext_vector_type(4)));
typedef unsigned u32x2 __attribute__((ext_vector_type(2)));
typedef float f32x2_t __attribute__((ext_vector_type(2)));
typedef __bf16 bf16x2_t __attribute__((ext_vector_type(2)));
typedef short v4i16_t __attribute__((ext_vector_type(4)));

constexpr int DM = 1024, NB = 16, SEQ = 2048, CTXL = 256, GW = 64;
constexpr int NLAT = NB * SEQ, NCTX = NB * CTXL, NTOK = NLAT + NCTX;
constexpr int INW = 3072, DFF = 2816, NE = 8, DFE = 3584;
constexpr int C_NAQ = 0, C_NAK = 512, C_NAV = 1024, C_CONV = 1536, C_RQ = 2048, C_RK = 2176, C_RV = 2304, C_GF = 2560, C_GB = 2816;
constexpr float EPS = 1e-6f;
constexpr float LOG2E = 1.4426950408889634f;

constexpr size_t MiB = 1u << 20;
constexpr size_t WS_CTL = 0, CTL_ZERO_BYTES = 64 * 1024;
constexpr size_t WS_MODLAT = 1 * MiB;
constexpr size_t WS_MODCTX = WS_MODLAT + 2 * 16 * 6144 * 4;
constexpr size_t WS_ROPE = WS_MODCTX + 2 * 6144 * 4;
constexpr size_t WS_PTOK = 2 * MiB;
constexpr size_t WS_SEGCNT = WS_PTOK + 32768 * 2 * 4;
constexpr size_t WS_META = WS_SEGCNT + 256 * 2 * 8 * 4;
constexpr size_t WS_SEGLIST = 3 * MiB;
constexpr size_t WS_ROWMAP = 5 * MiB;
constexpr int MOE_ROWS = 34816;
constexpr int MOE_TILES = MOE_ROWS / 256;
constexpr size_t WS_PROW = WS_ROWMAP + 512 * 1024;
constexpr size_t WS_SUMLAT = 6 * MiB;
constexpr size_t WS_SUMCTX = 22 * MiB;
constexpr size_t WS_WIN = 24 * MiB;
constexpr size_t WS_WOUT = WS_WIN + (size_t)2 * 3072 * 1024 * 2;
constexpr size_t WS_WGU = WS_WOUT + (size_t)2 * 1024 * 1024 * 2;
constexpr size_t WS_WD = WS_WGU + (size_t)5632 * 1024 * 2;
constexpr size_t WS_MGU = WS_WD + (size_t)1024 * 2816 * 2;
constexpr size_t WS_MD = WS_MGU + (size_t)8 * 7168 * 1024;
constexpr size_t WS_Y0 = WS_MD + (size_t)8 * 1024 * 3584;
constexpr size_t WS_HCTX = WS_Y0 + (size_t)NLAT * DM * 2;
constexpr size_t WS_U = WS_HCTX + (size_t)NCTX * DM * 4;
constexpr size_t WS_P = WS_U + (size_t)NTOK * DM * 2;
constexpr size_t WS_END = WS_P + (size_t)MOE_ROWS * DFE * 2;
static_assert((size_t)NTOK * INW * 2 <= (size_t)MOE_ROWS * DFE * 2, "P region: px | dense hidden | fp8 hidden of both MoE slots (2 x MOE_ROWS x DFE bytes)");
static_assert(WS_WIN % 256 == 0 && WS_WOUT % 256 == 0 && WS_WGU % 256 == 0 && WS_WD % 256 == 0 && WS_MGU % 256 == 0 && WS_MD % 256 == 0 && WS_Y0 % 256 == 0 && WS_HCTX % 256 == 0 && WS_U % 256 == 0 && WS_P % 256 == 0, "align");

constexpr int RING_BYTES = 131072;
constexpr int AUX_OFF = RING_BYTES;
constexpr int AUX_TAB = AUX_OFF + 1024;
constexpr int LDS_BYTES = 147456;

#ifndef MOE_FP8
#define MOE_FP8 1
#endif
static_assert(MOE_FP8 == 1, "the workspace map holds the MoE weights as fp8");
#ifndef DENSE_FP8
#define DENSE_FP8 2
#endif
constexpr int SCL_U = 0x7c7c7c7c, SCL_WGU = 0x79797979, SCL_H = 0x7c7c7c7c, SCL_WD = 0x78787878;
constexpr float QS_U = 8.0f, QS_WGU = 64.0f, QS_H = 8.0f, QS_WD = 128.0f;
DI unsigned pk2(float lo, float hi) { f32x2_t v = {lo, hi}; bf16x2_t b = __builtin_convertvector(v, bf16x2_t); return __builtin_bit_cast(unsigned, b); }
DI float clamp448(float x) { return __builtin_fminf(__builtin_fmaxf(x, -448.0f), 448.0f); }
DI unsigned pk4_fp8(float a, float b, float c, float d) { int w = 0; w = __builtin_amdgcn_cvt_pk_fp8_f32(clamp448(a), clamp448(b), w, false); w = __builtin_amdgcn_cvt_pk_fp8_f32(clamp448(c), clamp448(d), w, true); return (unsigned)w; }
DI float bflo(unsigned u) { return __uint_as_float(u << 16); }
DI float bfhi(unsigned u) { return __uint_as_float(u & 0xffff0000u); }
DI float wave_sum(float v) {
#pragma unroll
    for (int o = 1; o < 64; o <<= 1) v += __shfl_xor(v, o);
    return v;
}
DI float fast_exp2(float x) { return __builtin_amdgcn_exp2f(x); }
DI float fast_rcp(float x) { return __builtin_amdgcn_rcpf(x); }
DI float sigmoidf_(float x) { return fast_rcp(1.0f + fast_exp2(-x * LOG2E)); }
DI int crow(int reg, int h) { return (reg & 3) + 8 * (reg >> 2) + 4 * h; }
#define MFMA32(a, b, c) __builtin_amdgcn_mfma_f32_32x32x16_bf16((a), (b), (c), 0, 0, 0)
DI s16x4 trread(LAS const unsigned char* p) { return __builtin_bit_cast(s16x4, __builtin_amdgcn_ds_read_tr16_b64_v4i16((LAS v4i16_t*)p)); }
DI int ld_i32_coherent(const int* p) { return (int)__hip_atomic_load((const unsigned*)p, __ATOMIC_RELAXED, __HIP_MEMORY_SCOPE_AGENT); }

namespace pg8 {
#define PG8_LAS __attribute__((address_space(3)))
typedef unsigned short bf16_t;
constexpr int BM = 256, BK = 64, HALF = 128, HTB = HALF * BK * 2, STAGE_BYTES = 8 * HTB, NXCD = 8, WGM = 8;
__host__ __device__ __forceinline__ int lds_byte(int r, int c) { const int st = (r >> 4) * 2 + (c >> 5), rr = r & 15, cc = c & 31, ob = rr * 64 + cc * 2; return st * 1024 + (ob ^ (((ob >> 9) & 1) << 5)); }
__host__ __device__ __forceinline__ void stage_rc(int b, int& R, int& C) { const int st = b / 1024, sb = b % 1024, swz = sb ^ (((sb >> 9) & 1) << 5); R = (st >> 1) * 16 + swz / 64; C = (st & 1) * 32 + (swz % 64) / 2; }
__host__ __device__ __forceinline__ int perm32(int rho) { const int n = rho >> 4, i = rho & 15; return 8 * (i >> 2) + 4 * n + (i & 3); }
struct Unit { int pm, pn; };
struct StaticOrder {
    int nM, nN, nwg, G, c;
    __device__ void init(int M, int N, int G_, int c_) { nM = M / BM; nN = N / BM; nwg = nM * nN; G = G_; c = c_; }
    __device__ bool next(int i, Unit& u) const {
        const long L = (long)i * G + c; if (L >= nwg) return false;
        int wgid = (int)L; { const int q = nwg / NXCD, r = nwg % NXCD, xcd = wgid % NXCD, off = wgid / NXCD; wgid = (xcd < r ? xcd * (q + 1) : r * (q + 1) + (xcd - r) * q) + off; }
        const int nig = WGM * nN, gid = wgid / nig, fm = gid * WGM, gsz = (nM - fm) < WGM ? (nM - fm) : WGM;
        u.pm = fm + ((wgid % nig) % gsz); u.pn = (wgid % nig) / gsz; return true;
    }
};
struct RowsLinear { static constexpr bool GATHER = false; };
struct RowsLinearOff {
    static constexpr bool GATHER = true;
    __device__ __forceinline__ void fetch(const Unit& u, const int (&R)[2], int (&raw)[2][2]) const {
#pragma unroll
        for (int h = 0; h < 2; ++h)
#pragma unroll
            for (int i = 0; i < 2; ++i) raw[h][i] = u.pm * BM + h * HALF + R[i];
    }
    __device__ __forceinline__ void make(const int (&raw)[2][2], const int (&C)[2], int pitch, unsigned (&o)[2][2]) const {
#pragma unroll
        for (int h = 0; h < 2; ++h)
#pragma unroll
            for (int i = 0; i < 2; ++i) { o[h][i] = (unsigned)raw[h][i] * (unsigned)pitch + (unsigned)C[i] * 2u; asm volatile("" : "+v"(o[h][i])); }
    }
};
struct RowsGather {
    static constexpr bool GATHER = true;
    const int* rowmap; int row_add;
    __device__ __forceinline__ void fetch(const Unit& u, const int (&R)[2], int (&raw)[2][2]) const {
#pragma unroll
        for (int h = 0; h < 2; ++h)
#pragma unroll
            for (int i = 0; i < 2; ++i) raw[h][i] = rowmap[u.pm * BM + h * HALF + R[i]];
    }
    __device__ __forceinline__ void make(const int (&raw)[2][2], const int (&C)[2], int pitch, unsigned (&o)[2][2]) const {
#pragma unroll
        for (int h = 0; h < 2; ++h)
#pragma unroll
            for (int i = 0; i < 2; ++i) { int t = raw[h][i]; t = t < 0 ? 0 : t; o[h][i] = (unsigned)((size_t)(t + row_add) * (size_t)pitch + (size_t)C[i] * 2u); }
#pragma unroll
        for (int h = 0; h < 2; ++h)
#pragma unroll
            for (int i = 0; i < 2; ++i) asm volatile("" : "+v"(o[h][i]));
    }
};

typedef int i32x8 __attribute__((ext_vector_type(8)));
typedef int i32x4v __attribute__((ext_vector_type(4)));
template <class Epi, class Sched, class ARows, bool ALIGN_EPI, bool FP8 = false>
__device__ __forceinline__ void gemm_phase(PG8_LAS unsigned char* lds, int tid, const void* A, const void* Bt, int pitch, const Sched& S, const Epi& E, const ARows& AR, int sclA = 0x7f7f7f7f, int sclB = 0x7f7f7f7f) {
    constexpr bool GATHER = ARows::GATHER;
    const int wid = __builtin_amdgcn_readfirstlane(tid >> 6), lane = tid & 63, wr = wid >> 2, wc = wid & 3, fr = lane & 15, fq = lane >> 4;
    const int nt = pitch / (BK * 2);
    int RA[2], CA[2]; unsigned voffA[2], voffB[2];
#pragma unroll
    for (int i = 0; i < 2; ++i) { int R, C; stage_rc(tid * 16 + i * 8192, R, C); const int Rb = Epi::PERM ? ((R & ~31) + perm32(R & 31)) : R;
        RA[i] = R; CA[i] = C; voffA[i] = (unsigned)(R * pitch + C * 2); voffB[i] = (unsigned)(Rb * pitch + C * 2); }
#pragma unroll
    for (int i = 0; i < 2; ++i) { asm volatile("" : "+v"(voffA[i])); asm volatile("" : "+v"(voffB[i])); }
    const size_t kstep = (size_t)(BK * 2);
    const size_t hstep = (size_t)HALF * pitch;
    const size_t tstep = 2 * hstep;
    const unsigned ldsw = (unsigned)wid * 1024u;
    const int aoff = lds_byte(wr * 64 + fr, fq * 8), boff = lds_byte(wc * 32 + fr, fq * 8);
    const char* Ab = (const char*)A;
#define PG8_SA(b, h) (((b) * 2 + (h)) * HTB)
#define PG8_SB(b, h) ((4 + (b) * 2 + (h)) * HTB)
#define PG8_STAGE(bufoff, gbase, voff) do { _Pragma("unroll") for (int _i = 0; _i < 2; ++_i) \
        __builtin_amdgcn_global_load_lds((const unsigned*)((const char*)(gbase) + (voff)[_i]), (PG8_LAS unsigned*)(lds + (bufoff) + ldsw + _i * 8192), 16, 0, 0); } while (0)
#define PG8_STAGEA(bufoff, h, plin, kb) do { if constexpr (GATHER) PG8_STAGE(bufoff, Ab + (kb), curA[h]); else PG8_STAGE(bufoff, (plin) + (h) * hstep, voffA); } while (0)
#define PG8_LDA(dst, b, h) do { _Pragma("unroll") for (int m = 0; m < 4; ++m) _Pragma("unroll") for (int k = 0; k < 2; ++k) dst[m][k] = *(const PG8_LAS bf16x8*)(lds + PG8_SA(b, h) + aoff + m * 2048 + k * 1024); } while (0)
#define PG8_LDB(dst, b, h) do { _Pragma("unroll") for (int n = 0; n < 2; ++n) _Pragma("unroll") for (int k = 0; k < 2; ++k) dst[n][k] = *(const PG8_LAS bf16x8*)(lds + PG8_SB(b, h) + boff + n * 2048 + k * 1024); } while (0)
#define PG8_CAT(x0, x1) __builtin_shufflevector(__builtin_bit_cast(i32x4v, x0), __builtin_bit_cast(i32x4v, x1), 0, 1, 2, 3, 4, 5, 6, 7)
#define PG8_MMA(ai, bj, At, Bt_) do { __builtin_amdgcn_s_setprio(1); \
        if constexpr (FP8) { _Pragma("unroll") for (int m = 0; m < 4; ++m) _Pragma("unroll") for (int n = 0; n < 2; ++n) \
            acc[ai][bj][m][n] = __builtin_amdgcn_mfma_scale_f32_16x16x128_f8f6f4(PG8_CAT(Bt_[n][0], Bt_[n][1]), PG8_CAT(At[m][0], At[m][1]), acc[ai][bj][m][n], 0, 0, 0, sclB, 0, sclA); } \
        else { _Pragma("unroll") for (int m = 0; m < 4; ++m) _Pragma("unroll") for (int n = 0; n < 2; ++n) _Pragma("unroll") for (int k = 0; k < 2; ++k) \
            acc[ai][bj][m][n] = __builtin_amdgcn_mfma_f32_16x16x32_bf16(Bt_[n][k], At[m][k], acc[ai][bj][m][n], 0, 0, 0); } \
        __builtin_amdgcn_s_setprio(0); } while (0)
#define PG8_WAIT_V(n) asm volatile("s_waitcnt vmcnt(" #n ")" ::: "memory")
#define PG8_WAIT_L(n) asm volatile("s_waitcnt lgkmcnt(" #n ")" ::: "memory")
#define PG8_BAR __builtin_amdgcn_s_barrier()
#define PG8_SCHED __builtin_amdgcn_sched_barrier(0)
    Unit cur, nxt; int ui = 0;
    if (!S.next(0, cur)) return;
    f32x4 acc[2][2][4][2];
#pragma unroll
    for (int a = 0; a < 2; ++a)
#pragma unroll
        for (int b = 0; b < 2; ++b)
#pragma unroll
            for (int m = 0; m < 4; ++m)
#pragma unroll
                for (int n = 0; n < 2; ++n) acc[a][b][m][n] = (f32x4){0.f, 0.f, 0.f, 0.f};
    bf16x8 At[4][2], B0[2][2], B1[2][2];
    unsigned curA[2][2] = {{0u, 0u}, {0u, 0u}}, nxtA[2][2] = {{0u, 0u}, {0u, 0u}};
    int rawN[2][2] = {{0, 0}, {0, 0}};
    if constexpr (GATHER) { int rawC[2][2]; AR.fetch(cur, RA, rawC); AR.make(rawC, CA, pitch, curA); Unit n1; if (S.next(1, n1)) AR.fetch(n1, RA, rawN); }
    const char* cA = GATHER ? Ab : Ab + (size_t)cur.pm * tstep;
    const char* cB = (const char*)Bt + (size_t)cur.pn * tstep;
    PG8_STAGE(PG8_SB(0, 0), cB, voffB); PG8_STAGE(PG8_SB(0, 1), cB + hstep, voffB); PG8_STAGEA(PG8_SA(0, 0), 0, cA, 0); PG8_STAGEA(PG8_SA(0, 1), 1, cA, 0);
    if (wr == 1) PG8_BAR;
    PG8_WAIT_V(2); PG8_BAR;
    PG8_STAGE(PG8_SB(1, 0), cB + kstep, voffB); PG8_STAGEA(PG8_SA(1, 0), 0, cA + kstep, kstep); PG8_STAGE(PG8_SB(1, 1), cB + hstep + kstep, voffB);
    PG8_WAIT_V(6); PG8_BAR;
    for (;;) {
        const bool has_next = S.next(ui + 1, nxt);
        if constexpr (GATHER) {
            if (has_next) { AR.make(rawN, CA, pitch, nxtA); Unit n2; if (S.next(ui + 2, n2)) AR.fetch(n2, RA, rawN); }
            else {
#pragma unroll
                for (int h = 0; h < 2; ++h)
#pragma unroll
                    for (int i = 0; i < 2; ++i) nxtA[h][i] = curA[h][i];
            }
        }
        const char* nA = GATHER ? Ab : (has_next ? Ab + (size_t)nxt.pm * tstep : cA);
        const char* nB = has_next ? (const char*)Bt + (size_t)nxt.pn * tstep : cB;
        for (int t = 0; t < nt; t += 2) {
            const bool last = (t == nt - 2);
            const size_t k1 = (size_t)(t + 1) * kstep, k2 = last ? 0 : (size_t)(t + 2) * kstep, k3 = k2 + kstep;
            const char* a1 = cA + k1;
            const char* a2 = last ? nA : cA + k2; const char* b2 = last ? nB : cB + k2;
            const char* a3 = a2 + kstep; const char* b3 = b2 + kstep;
            PG8_LDB(B0, 0, 0); PG8_LDB(B1, 0, 1); PG8_SCHED; PG8_LDA(At, 0, 0); PG8_STAGEA(PG8_SA(1, 1), 1, a1, k1);
            if constexpr (GATHER) { if (last) {
#pragma unroll
                for (int h = 0; h < 2; ++h)
#pragma unroll
                    for (int i = 0; i < 2; ++i) curA[h][i] = nxtA[h][i]; } }
            PG8_WAIT_V(8); PG8_WAIT_L(0); PG8_BAR; PG8_MMA(0, 0, At, B0); PG8_MMA(0, 1, At, B1); PG8_BAR; PG8_SCHED;
            PG8_LDA(At, 0, 1); PG8_STAGE(PG8_SB(0, 0), b2, voffB); PG8_STAGE(PG8_SB(0, 1), b2 + hstep, voffB); PG8_STAGEA(PG8_SA(0, 0), 0, a2, k2);
            PG8_WAIT_V(8); PG8_WAIT_L(0); PG8_BAR; PG8_MMA(1, 0, At, B0); PG8_MMA(1, 1, At, B1); PG8_BAR; PG8_SCHED;
            PG8_LDB(B0, 1, 0); PG8_LDB(B1, 1, 1); PG8_SCHED; PG8_LDA(At, 1, 0); PG8_STAGEA(PG8_SA(0, 1), 1, a2, k2);
            PG8_WAIT_V(8); PG8_WAIT_L(0); PG8_BAR; PG8_MMA(0, 0, At, B0); PG8_MMA(0, 1, At, B1); PG8_BAR; PG8_SCHED;
            PG8_LDA(At, 1, 1); PG8_STAGE(PG8_SB(1, 0), b3, voffB); PG8_STAGE(PG8_SB(1, 1), b3 + hstep, voffB); PG8_STAGEA(PG8_SA(1, 0), 0, a3, k3);
            PG8_WAIT_V(8); PG8_WAIT_L(0); PG8_BAR; PG8_MMA(1, 0, At, B0); PG8_MMA(1, 1, At, B1); PG8_BAR; PG8_SCHED;
        }
        if constexpr (ALIGN_EPI) { if (wr == 0) PG8_BAR; }
        E(acc, cur, wr, wc, fr, fq);
        if (!has_next) break;
#pragma unroll
        for (int a = 0; a < 2; ++a)
#pragma unroll
            for (int b = 0; b < 2; ++b)
#pragma unroll
                for (int m = 0; m < 4; ++m)
#pragma unroll
                    for (int n = 0; n < 2; ++n) acc[a][b][m][n] = (f32x4){0.f, 0.f, 0.f, 0.f};
        cur = nxt; cA = nA; cB = nB; ++ui;
        if constexpr (ALIGN_EPI) { if (wr == 1) PG8_BAR; }
    }
    PG8_WAIT_V(0);
    if constexpr (!ALIGN_EPI) { if (wr == 0) PG8_BAR; }
    PG8_BAR;
#undef PG8_SA
#undef PG8_SB
#undef PG8_STAGE
#undef PG8_STAGEA
#undef PG8_LDA
#undef PG8_LDB
#undef PG8_MMA
#undef PG8_CAT
#undef PG8_WAIT_V
#undef PG8_WAIT_L
#undef PG8_BAR
#undef PG8_SCHED
}

#define PG8_OPAQUE(x) asm volatile("" : "+v"(x))
struct EpiNull { static constexpr bool PERM = true; __device__ __forceinline__ void operator()(const f32x4 (&acc)[2][2][4][2], const Unit& u, int wr, int wc, int fr, int fq) const { if (u.pm < 0) {
#pragma unroll
        for (int a = 0; a < 2; ++a)
#pragma unroll
            for (int b = 0; b < 2; ++b)
#pragma unroll
                for (int m = 0; m < 4; ++m)
#pragma unroll
                    for (int n = 0; n < 2; ++n) asm volatile("" :: "v"(acc[a][b][m][n])); } } };
struct EpiStoreBf16 {
    static constexpr bool PERM = true;
    bf16_t* O; int ldc;
    __device__ __forceinline__ void operator()(const f32x4 (&acc)[2][2][4][2], const Unit& u, int wr, int wc, int fr, int fq) const {
        char* base = (char*)(O + (size_t)(u.pm * BM) * ldc + u.pn * BM);
        unsigned lb = (unsigned)((wr * 64 + fr) * ldc + wc * 32 + 8 * fq) * 2u; PG8_OPAQUE(lb);
        const unsigned rstep = (unsigned)ldc * 32u;
#pragma unroll
        for (int ai = 0; ai < 2; ++ai)
#pragma unroll
            for (int m = 0; m < 4; ++m) { const unsigned ro = lb + (unsigned)(ai * 8 + m) * rstep;
#pragma unroll
                for (int bj = 0; bj < 2; ++bj) { const f32x4 v0 = acc[ai][bj][m][0], v1 = acc[ai][bj][m][1];
                    u32x4 w; w.x = pk2(v0[0], v0[1]); w.y = pk2(v0[2], v0[3]); w.z = pk2(v1[0], v1[1]); w.w = pk2(v1[2], v1[3]);
                    *(u32x4*)(base + ro + bj * (HALF * 2)) = w; } }
    }
};
#ifndef RG_W
#define RG_W 3
#endif
struct EpiResGate {
    static constexpr bool PERM = false;
    const float* src_ctx; const float* src_lat; float* dst_ctx; float* dst_lat; const float* gate_lat; const float* gate_ctx; int row_base;
    __device__ __forceinline__ void operator()(const f32x4 (&acc)[2][2][4][2], const Unit& u, int wr, int wc, int fr, int fq) const {
        const int rowu = row_base + u.pm * BM; const bool isctx = rowu < NCTX;
        const char* src = (const char*)(isctx ? src_ctx + (size_t)rowu * DM : src_lat + (size_t)(rowu - NCTX) * DM) + u.pn * (BM * 4);
        char* dst = (char*)(isctx ? dst_ctx + (size_t)rowu * DM : dst_lat + (size_t)(rowu - NCTX) * DM) + u.pn * (BM * 4);
        const float* gate = (isctx ? gate_ctx : gate_lat + (size_t)((rowu - NCTX) / SEQ) * 6144) + u.pn * BM;
        const int cl = wc * 32 + 4 * fq;
        unsigned lb = (unsigned)((wr * 64 + fr) * DM + cl) * 4u; PG8_OPAQUE(lb);
        f32x4 s[8][2][2];
#pragma unroll
        for (int g = 0; g < RG_W; ++g)
#pragma unroll
            for (int bj = 0; bj < 2; ++bj)
#pragma unroll
                for (int n = 0; n < 2; ++n) s[g][bj][n] = *(const f32x4*)(src + lb + (unsigned)((g >> 2) * 8 + (g & 3)) * (16u * DM * 4u) + (unsigned)(bj * HALF + n * 16) * 4u);
        f32x4 gvv[2][2];
#pragma unroll
        for (int bj = 0; bj < 2; ++bj)
#pragma unroll
            for (int n = 0; n < 2; ++n) gvv[bj][n] = *(const f32x4*)(gate + cl + bj * HALF + n * 16);
        asm volatile("" : "+v"(gvv[0][0]), "+v"(gvv[0][1]), "+v"(gvv[1][0]), "+v"(gvv[1][1]), "+v"(s[0][0][0]));
        f32x4 sc[2][2][4][2];
#pragma unroll
        for (int bj = 0; bj < 2; ++bj)
#pragma unroll
            for (int n = 0; n < 2; ++n)
#pragma unroll
                for (int ai = 0; ai < 2; ++ai)
#pragma unroll
                    for (int m = 0; m < 4; ++m) sc[ai][bj][m][n] = acc[ai][bj][m][n] * gvv[bj][n];
#pragma unroll
        for (int g = 0; g < 8; ++g) {
#pragma unroll
            for (int bj = 0; bj < 2; ++bj)
#pragma unroll
                for (int n = 0; n < 2; ++n) *(f32x4*)(dst + lb + (unsigned)((g >> 2) * 8 + (g & 3)) * (16u * DM * 4u) + (unsigned)(bj * HALF + n * 16) * 4u) = s[g][bj][n] + sc[g >> 2][bj][g & 3][n];
            if (g + RG_W < 8) {
#pragma unroll
                for (int bj = 0; bj < 2; ++bj)
#pragma unroll
                    for (int n = 0; n < 2; ++n) s[g + RG_W][bj][n] = *(const f32x4*)(src + lb + (unsigned)(((g + RG_W) >> 2) * 8 + ((g + RG_W) & 3)) * (16u * DM * 4u) + (unsigned)(bj * HALF + n * 16) * 4u);
            }
        }
    }
};
template <bool MOE> struct EpiSwiglu {
    static constexpr bool PERM = true;
    static constexpr bool OUT8 = MOE ? (MOE_FP8 != 0) : (DENSE_FP8 != 0);
    bf16_t* O; int ldc; int ncol; const float* prow;
    __device__ __forceinline__ void operator()(const f32x4 (&acc)[2][2][4][2], const Unit& u, int wr, int wc, int fr, int fq) const {
        const int pnl = MOE ? (u.pn % ncol) : u.pn;
        constexpr int ES = OUT8 ? 1 : 2;
        char* base = (char*)O + ((size_t)(u.pm * BM) * ldc + pnl * HALF) * ES;
        unsigned lb = (unsigned)((wr * 64 + fr) * ldc + wc * 32 + 8 * fq) * ES; PG8_OPAQUE(lb);
        const unsigned rstep = (unsigned)ldc * 16u * ES;
#pragma unroll
        for (int ai = 0; ai < 2; ++ai)
#pragma unroll
            for (int m = 0; m < 4; ++m) {
                const float pw = OUT8 ? QS_H : 1.0f;
                float hv[8];
#pragma unroll
                for (int n = 0; n < 2; ++n)
#pragma unroll
                    for (int jp = 0; jp < 2; ++jp) { const f32x2_t g = {acc[ai][0][m][n][2 * jp], acc[ai][0][m][n][2 * jp + 1]}, up = {acc[ai][1][m][n][2 * jp], acc[ai][1][m][n][2 * jp + 1]};
                        const f32x2_t a = g * (-LOG2E); f32x2_t d; d.x = fast_exp2(a.x); d.y = fast_exp2(a.y); d = d + 1.0f;
                        f32x2_t r; r.x = fast_rcp(d.x); r.y = fast_rcp(d.y);
                        const f32x2_t hh = (g * up) * (r * pw); hv[n * 4 + 2 * jp] = hh.x; hv[n * 4 + 2 * jp + 1] = hh.y; }
                if constexpr (OUT8) { u32x2 w; w.x = pk4_fp8(hv[0], hv[1], hv[2], hv[3]); w.y = pk4_fp8(hv[4], hv[5], hv[6], hv[7]);
                    *(u32x2*)(base + lb + (unsigned)(ai * 8 + m) * rstep) = w; }
                else { u32x4 w; w.x = pk2(hv[0], hv[1]); w.y = pk2(hv[2], hv[3]); w.z = pk2(hv[4], hv[5]); w.w = pk2(hv[6], hv[7]);
                    *(u32x4*)(base + lb + (unsigned)(ai * 8 + m) * rstep) = w; } }
    }
};
struct EpiMoeScatter {
    static constexpr bool PERM = false;
    const int* rowmap; const float* prow; bf16_t* y0; bf16_t* y1; int ncol;
    __device__ __forceinline__ void operator()(const f32x4 (&acc)[2][2][4][2], const Unit& u, int wr, int wc, int fr, int fq) const {
        const int pnl = u.pn % ncol;
        const int* rm = rowmap + u.pm * BM; const float* pr = prow + u.pm * BM;
        char* yb = (char*)(u.pm >= MOE_TILES ? y1 : y0) + pnl * (BM * 2);
        unsigned pl = (unsigned)(wr * 64 + fr) * 4u; PG8_OPAQUE(pl);
        unsigned cb = (unsigned)(wc * 32 + 4 * fq) * 2u; PG8_OPAQUE(cb);
        int tok[8]; float pw[8];
#pragma unroll
        for (int g = 0; g < 8; ++g) { tok[g] = *(const int*)((const char*)rm + pl + (unsigned)((g >> 2) * 8 + (g & 3)) * 64u); pw[g] = *(const float*)((const char*)pr + pl + (unsigned)((g >> 2) * 8 + (g & 3)) * 64u); }
#pragma unroll
        for (int g = 0; g < 8; ++g) { const int ai = g >> 2, m = g & 3;
            if (tok[g] >= 0) { const unsigned ro = (unsigned)tok[g] * (DM * 2u) + cb;
#pragma unroll
                for (int k = 0; k < 4; ++k) { const f32x4 t = acc[ai][k >> 1][m][k & 1] * pw[g]; u32x2 w; w.x = pk2(t[0], t[1]); w.y = pk2(t[2], t[3]);
                    *(u32x2*)(yb + ro + (unsigned)((k >> 1) * HALF + (k & 1) * 16) * 2u) = w; } } }
    }
};
struct MoeOrder {
    int NT0, NT1, ncol, G, c; const PG8_LAS int* texp;
    __device__ bool next(int i, Unit& u) const {
        const long L = (long)i * G + c; if (L >= (long)(NT0 + NT1) * ncol) return false;
        const int tq = (int)(L / ncol), pnl = (int)(L % ncol);
        const int T = tq < NT0 ? tq : MOE_TILES + tq - NT0;
        const int e = __builtin_amdgcn_readfirstlane(texp[T]);
        u.pm = T; u.pn = e * ncol + pnl; return true;
    }
};
}

#define XB_TMO      128
#define XB_XCNT(j)  (256  + 64 * (j))
#define XB_XSUB(j)  (1280 + 64 * (j))
#define XB_XGEN(j)  (2304 + 64 * (j))
#define XB_TOP      3328
#define XB_TOPGEN   3392
#define XCD_BAR_WORDS 3456
#define XB_SPIN_CAP (1u << 18)
DI unsigned xb_ld(unsigned* p)              { return __hip_atomic_load(p, __ATOMIC_RELAXED, __HIP_MEMORY_SCOPE_AGENT); }
DI unsigned xb_add(unsigned* p, unsigned v) { return __hip_atomic_fetch_add(p, v, __ATOMIC_RELAXED, __HIP_MEMORY_SCOPE_AGENT); }
DI unsigned xb_xcc_id() { return (unsigned)__builtin_amdgcn_s_getreg((3 << 11) | 20) & 0xFu; }
#define XB_SPIN(cond, bar) do { unsigned _sp = 0; while (cond) { __builtin_amdgcn_s_sleep(1); \
    if ((++_sp & 255u) == 0u) { if (xb_ld(&(bar)[XB_TMO])) break; if (_sp > XB_SPIN_CAP) { atomicAdd(&(bar)[XB_TMO], 1u); break; } } } } while (0)
struct XcdBarrier { unsigned* bar; unsigned x; volatile LAS unsigned* st; };
DI XcdBarrier xcd_barrier_post(unsigned* bar, volatile LAS unsigned* st) {
    XcdBarrier b; b.bar = bar; b.x = xb_xcc_id(); b.st = st;
    if (threadIdx.x == 0) (void)xb_add(&bar[XB_XCNT(b.x)], 1u);
    return b;
}
DI void xcd_barrier_complete(unsigned* bar, unsigned x, unsigned& nloc, unsigned& nx) {
    const unsigned G = gridDim.x * gridDim.y * gridDim.z;
    unsigned sum, cnt, mine, sp = 0u;
    for (;;) {
        sum = 0u; cnt = 0u; mine = 0u;
#pragma unroll
        for (unsigned j = 0; j < 16; ++j) { const unsigned c = xb_ld(&bar[XB_XCNT(j)]); sum += c; cnt += (c > 0u) ? 1u : 0u; mine = (j == x) ? c : mine; }
        if (sum == G) break;
        __builtin_amdgcn_s_sleep(1);
        if ((++sp & 255u) == 0u) { if (xb_ld(&bar[XB_TMO])) break; if (sp > XB_SPIN_CAP) { atomicAdd(&bar[XB_TMO], 1u); break; } }
    }
    nloc = mine > 0u ? mine : 1u; nx = cnt > 0u ? cnt : 1u;
}
DI void xcd_barrier(const XcdBarrier& b, int wave) {
    asm volatile("s_waitcnt vmcnt(0)" ::: "memory");
    __syncthreads();
    if (wave == 0 && __builtin_amdgcn_mbcnt_hi(~0u, __builtin_amdgcn_mbcnt_lo(~0u, 0u)) == 0u) {
        unsigned* bar = b.bar;
        __builtin_amdgcn_s_waitcnt(0);
        unsigned nloc = b.st[0], nx = b.st[1];
        if (nloc == 0u) { xcd_barrier_complete(bar, b.x, nloc, nx); b.st[0] = nloc; b.st[1] = nx; }
        const unsigned old = xb_add(&bar[XB_XSUB(b.x)], 1u);
        const unsigned gen = old / nloc;
        if (old + 1u == (gen + 1u) * nloc) {
            __builtin_amdgcn_fence(__ATOMIC_RELEASE, "agent");
            asm volatile("s_waitcnt vmcnt(0)" ::: "memory");
            const unsigned og = xb_add(&bar[XB_TOP], 1u);
            const unsigned tg = og / nx;
            if (og + 1u == (tg + 1u) * nx) xb_add(&bar[XB_TOPGEN], 1u);
            else XB_SPIN(xb_ld(&bar[XB_TOPGEN]) == tg, bar);
            __builtin_amdgcn_fence(__ATOMIC_ACQUIRE, "agent");
            xb_add(&bar[XB_XGEN(b.x)], 1u);
            asm volatile("s_waitcnt vmcnt(0)" ::: "memory");
        } else {
            XB_SPIN(xb_ld(&bar[XB_XGEN(b.x)]) == gen, bar);
            __builtin_amdgcn_fence(__ATOMIC_ACQUIRE, "agent");
            asm volatile("s_waitcnt vmcnt(0)" ::: "memory");
        }
    }
    __syncthreads();
}

struct Params { const float* in[26]; float* out; unsigned char* ws; int ph_lo, ph_hi, pad0, pad1; };
enum { I_X = 0, I_C, I_CTX, I_CCTX, I_WMOD, I_BMOD, I_N1W, I_N2W, I_WIN, I_WOUT, I_RPB, I_CONVW, I_CONVB, I_CLNW, I_CLNB, I_RDEC, I_RGNW,
       I_FG, I_FU, I_FD, I_MR, I_MRB, I_MG, I_MU, I_MDN, I_FNW };
constexpr int PH_P0 = 0, PH_FINAL = 18, N_PHASES = 19;

typedef __attribute__((address_space(4))) const unsigned char* karg_t;
struct KIn {
    karg_t ka;
    DI const float* operator[](int k) const { return *(const float* __attribute__((address_space(4))) const*)(ka + 8 * k); }
};
struct Frame {
    LAS unsigned char* lds;
    int tid, lane, wave, G, bid, vb;
    KIn in; float* out; unsigned char* ws;
};
DI Frame phase_frame(const Frame& F0) {
    Frame F; karg_t ka = F0.in.ka; asm volatile("" : "+s"(ka)); F.in.ka = ka;
    F.out = *(float* __attribute__((address_space(4))) const*)(ka + 208);
    F.ws = *(unsigned char* __attribute__((address_space(4))) const*)(ka + 216);
    int wv = F0.wave; asm volatile("" : "+s"(wv));
    int tid = (wv << 6) + (int)__builtin_amdgcn_mbcnt_hi(~0u, __builtin_amdgcn_mbcnt_lo(~0u, 0u)), G = F0.G, bid = F0.bid; unsigned ldsb = (unsigned)(size_t)F0.lds;
    asm volatile("" : "+v"(tid)); asm volatile("" : "+s"(G)); asm volatile("" : "+s"(bid)); asm volatile("" : "+s"(ldsb));
    F.tid = tid; F.lane = tid & 63; F.wave = __builtin_amdgcn_readfirstlane(tid >> 6); F.G = G; F.bid = bid; F.lds = (LAS unsigned char*)(size_t)ldsb;
    F.vb = (G % 8 == 0) ? (bid % 8) * (G / 8) + bid / 8 : bid;
    return F;
}

DI void p0_transpose_item(const float* W, int K, int N, bf16* WT, int k0, int n0, int dst_row0, LAS float* scr, int lane) {
#pragma unroll 8
    for (int i = 0; i < 32; ++i) { const int kk = 2 * i + (lane >> 5); scr[kk * 33 + (lane & 31)] = W[(size_t)(k0 + kk) * N + n0 + (lane & 31)]; }
    asm volatile("s_waitcnt lgkmcnt(0)" ::: "memory");
    const int c = lane & 7;
#pragma unroll
    for (int j = 0; j < 4; ++j) { const int n = (lane >> 3) + 8 * j; const LAS float* s = scr + (8 * c) * 33 + n;
        u32x4 o; o.x = pk2(s[0 * 33], s[1 * 33]); o.y = pk2(s[2 * 33], s[3 * 33]); o.z = pk2(s[4 * 33], s[5 * 33]); o.w = pk2(s[6 * 33], s[7 * 33]);
        *(u32x4*)(WT + (size_t)(dst_row0 + n) * K + k0 + 8 * c) = o; }
    asm volatile("s_waitcnt lgkmcnt(0)" ::: "memory");
}
DI void p0_convert_plain(Frame& F, const float* W, int K, int N, bf16* WT, int item, LAS float* scr) {
    const int nblk = N / 32, kb = item / nblk, nb = item % nblk;
    p0_transpose_item(W, K, N, WT, 64 * kb, 32 * nb, 32 * nb, scr, F.lane);
}
DI void p0_convert_gu(Frame& F, const float* W, int K, int N, bf16* WT, int item, int up, LAS float* scr) {
    const int nblk = N / 32, kb = item / nblk, nb = item % nblk, n0 = 32 * nb;
    p0_transpose_item(W, K, N, WT, 64 * kb, n0, 256 * (n0 / 128) + (n0 % 128) + (up ? 128 : 0), scr, F.lane);
}
DI void conv_item64(const float* W, int K, int N, bf16* WT, int k0, int n0, int dst_row0, LAS unsigned* scr, int lane) {
    const float* wp = W + (size_t)k0 * N + n0 + lane;
    float v[64];
#pragma unroll
    for (int i = 0; i < 64; ++i) v[i] = wp[(size_t)i * N];
#pragma unroll
    for (int i = 0; i < 32; ++i) scr[i * 65 + lane] = pk2(v[2 * i], v[2 * i + 1]);
    asm volatile("s_waitcnt lgkmcnt(0)" ::: "memory");
    const int c = lane & 7;
#pragma unroll
    for (int j = 0; j < 8; ++j) { const int n = (lane >> 3) + 8 * j; const LAS unsigned* sp = scr + (4 * c) * 65 + n;
        u32x4 o; o.x = sp[0]; o.y = sp[65]; o.z = sp[130]; o.w = sp[195];
        *(u32x4*)(WT + (size_t)(dst_row0 + n) * K + k0 + 8 * c) = o; }
    asm volatile("s_waitcnt lgkmcnt(0)" ::: "memory");
}
DI void conv_item64_fp8(const float* W, int K, int N, unsigned char* WT, int k0, int n0, int dst_row0, float qs, LAS unsigned* scr, int lane) {
    const float* wp = W + (size_t)k0 * N + n0 + lane;
    float v[64];
#pragma unroll
    for (int i = 0; i < 64; ++i) v[i] = wp[(size_t)i * N];
#pragma unroll
    for (int i = 0; i < 16; ++i) scr[i * 65 + lane] = pk4_fp8(v[4 * i] * qs, v[4 * i + 1] * qs, v[4 * i + 2] * qs, v[4 * i + 3] * qs);
    asm volatile("s_waitcnt lgkmcnt(0)" ::: "memory");
    const int c = lane & 3;
#pragma unroll
    for (int j = 0; j < 4; ++j) { const int n = (lane >> 2) + 16 * j; const LAS unsigned* sp = scr + (4 * c) * 65 + n;
        u32x4 o; o.x = sp[0]; o.y = sp[65]; o.z = sp[130]; o.w = sp[195];
        *(u32x4*)(WT + (size_t)(dst_row0 + n) * K + k0 + 16 * c) = o; }
    asm volatile("s_waitcnt lgkmcnt(0)" ::: "memory");
}
constexpr int BG_ITEMS = 21504;
constexpr int BG_B0 = 0, BG_D0 = 1200, BG_E0 = 5200, BG_F0 = 8700, BG_B1 = 19700, BG_CL = 20900;
DI void bg_item(Frame& F, int g, LAS unsigned* scr) {
    if (g < 14336) { const int m = g / 896, e = m >> 1, up = m & 1, r = g % 896, kb = r / 56, nb = r % 56, n0 = 64 * nb; const int drow = 256 * (n0 / 128) + (n0 % 128) + (up ? 128 : 0);
#if MOE_FP8
        conv_item64_fp8(F.in[up ? I_MU : I_MG] + (size_t)e * 1024 * 3584, 1024, 3584, F.ws + WS_MGU + (size_t)e * 7168 * 1024, 64 * kb, n0, drow, QS_WGU, scr, F.lane);
#else
        conv_item64(F.in[up ? I_MU : I_MG] + (size_t)e * 1024 * 3584, 1024, 3584, (bf16*)(F.ws + WS_MGU) + (size_t)e * 7168 * 1024, 64 * kb, n0, drow, scr, F.lane);
#endif
    } else { const int gg = g - 14336, e = gg / 896, r = gg % 896, kb = r / 16, nb = r % 16;
#if MOE_FP8
        conv_item64_fp8(F.in[I_MDN] + (size_t)e * 3584 * 1024, 3584, 1024, F.ws + WS_MD + (size_t)e * 1024 * 3584, 64 * kb, 64 * nb, 64 * nb, QS_WD, scr, F.lane);
#else
        conv_item64(F.in[I_MDN] + (size_t)e * 3584 * 1024, 3584, 1024, (bf16*)(F.ws + WS_MD) + (size_t)e * 1024 * 3584, 64 * kb, 64 * nb, 64 * nb, scr, F.lane);
#endif
    }
}
DI void bg_convert_tail(Frame& F, int nwg, int lo, int hi) {
    const int nmax = (nwg + F.G - 1) / F.G, rem = nwg - (nmax - 1) * F.G;
    if (F.bid < rem || rem >= F.G) return;
    LAS unsigned* scr = (LAS unsigned*)(F.lds + F.wave * 8320);
    const int w = (F.bid - rem) * 8 + F.wave, nw = (F.G - rem) * 8;
    for (int g = lo + w; g < hi; g += nw) bg_item(F, g, scr);
}
DI void bg_convert_all(Frame& F, int lo, int hi) {
    LAS unsigned* scr = (LAS unsigned*)(F.lds + F.wave * 8320);
    for (int g = lo + F.bid * 8 + F.wave; g < hi; g += F.G * 8) bg_item(F, g, scr);
}
DI void p0_prologue(Frame& F) {
    {
        LAS float* Sx = (LAS float*)F.lds;
        LAS float* red = (LAS float*)(F.lds + 81920);
        bool staged = false;
        for (int unit = F.bid; unit < 192; unit += F.G) {
            if (!staged) {
                for (int idx = F.tid; idx < 17 * 1024; idx += 512) { const int r = idx / 1024, k = idx % 1024;
                    const float v = r < 16 ? F.in[I_C][r * 1024 + k] : F.in[I_CCTX][k]; Sx[k * 20 + r] = v * sigmoidf_(v); }
                staged = true; __syncthreads();
            }
            const int l = unit / 96, n0 = (unit % 96) * 64;
            const float* Wm = F.in[I_WMOD] + (size_t)l * 1024 * 6144 + n0 + F.lane;
            float acc[17];
#pragma unroll
            for (int r = 0; r < 17; ++r) acc[r] = 0.f;
            const int kb = F.wave * 128;
#pragma unroll 4
            for (int k = 0; k < 128; ++k) { const float wv = Wm[(size_t)(kb + k) * 6144]; const LAS float* sp = Sx + (kb + k) * 20;
                const f32x4 s0 = *(const LAS f32x4*)(sp), s1 = *(const LAS f32x4*)(sp + 4), s2 = *(const LAS f32x4*)(sp + 8), s3 = *(const LAS f32x4*)(sp + 12); const float s4 = sp[16];
                acc[0] += s0[0] * wv; acc[1] += s0[1] * wv; acc[2] += s0[2] * wv; acc[3] += s0[3] * wv; acc[4] += s1[0] * wv; acc[5] += s1[1] * wv; acc[6] += s1[2] * wv; acc[7] += s1[3] * wv;
                acc[8] += s2[0] * wv; acc[9] += s2[1] * wv; acc[10] += s2[2] * wv; acc[11] += s2[3] * wv; acc[12] += s3[0] * wv; acc[13] += s3[1] * wv; acc[14] += s3[2] * wv; acc[15] += s3[3] * wv;
                acc[16] += s4 * wv; }
#pragma unroll
            for (int r = 0; r < 17; ++r) red[(F.wave * 17 + r) * 64 + F.lane] = acc[r];
            __syncthreads();
            for (int idx = F.tid; idx < 17 * 64; idx += 512) { const int r = idx / 64, ln = idx % 64; float s = F.in[I_BMOD][l * 6144 + n0 + ln];
#pragma unroll
                for (int w = 0; w < 8; ++w) s += red[(w * 17 + r) * 64 + ln];
                if (r < 16) ((float*)(F.ws + WS_MODLAT))[((size_t)l * 16 + r) * 6144 + n0 + ln] = s; else ((float*)(F.ws + WS_MODCTX))[(size_t)l * 6144 + n0 + ln] = s; }
            __syncthreads();
        }
        __syncthreads();
    }
    if (F.bid == 0) { const int pos = F.tid >> 3, j = F.tid & 7; const float inv = exp2f(-(float)j * 0.125f * 13.287712379549449f); const float ang = (float)pos * inv;
        float* tab = (float*)(F.ws + WS_ROPE); tab[(pos * 8 + j) * 2] = cosf(ang); tab[(pos * 8 + j) * 2 + 1] = sinf(ang); }
    {
        LAS float* scr = (LAS float*)(F.lds + F.wave * 16384);
        const int gw = F.bid * 8 + F.wave, NGW = F.G * 8;
        constexpr int I_IN = 16 * 96, I_OUT = 16 * 32, I_G = 16 * 88, I_D = 44 * 32, I_MGI = 16 * 112, I_MDI = 56 * 32;
        constexpr int NITEMS = 2 * I_IN + 2 * I_OUT + (DENSE_FP8 == 1 ? 3 * 704 : (DENSE_FP8 == 2 ? 2 * I_G + 704 : 2 * I_G + I_D));
        for (int it = gw; it < NITEMS; it += NGW) {
            int r = it;
            if (r < 2 * I_IN) { const int l = r / I_IN; p0_convert_plain(F, F.in[I_WIN] + (size_t)l * 1024 * 3072, 1024, 3072, (bf16*)(F.ws + WS_WIN) + (size_t)l * 3072 * 1024, r % I_IN, scr); continue; } r -= 2 * I_IN;
            if (r < 2 * I_OUT) { const int l = r / I_OUT; p0_convert_plain(F, F.in[I_WOUT] + (size_t)l * 1024 * 1024, 1024, 1024, (bf16*)(F.ws + WS_WOUT) + (size_t)l * 1024 * 1024, r % I_OUT, scr); continue; } r -= 2 * I_OUT;
#if DENSE_FP8 == 2
            if (r < I_G) { p0_convert_gu(F, F.in[I_FG], 1024, 2816, (bf16*)(F.ws + WS_WGU), r, 0, scr); continue; } r -= I_G;
            if (r < I_G) { p0_convert_gu(F, F.in[I_FU], 1024, 2816, (bf16*)(F.ws + WS_WGU), r, 1, scr); continue; } r -= I_G;
            { const int kb = r / 16, nb = r % 16; conv_item64_fp8(F.in[I_FD], 2816, 1024, F.ws + WS_WD, 64 * kb, 64 * nb, 64 * nb, QS_WD, (LAS unsigned*)scr, F.lane); }
#elif DENSE_FP8 == 1
            { LAS unsigned* scr8 = (LAS unsigned*)scr;
              if (r < 1408) { const int up = r / 704, q = r % 704, kb = q / 44, nb = q % 44, n0 = 64 * nb;
                  conv_item64_fp8(F.in[up ? I_FU : I_FG], 1024, 2816, F.ws + WS_WGU, 64 * kb, n0, 256 * (n0 / 128) + (n0 % 128) + (up ? 128 : 0), QS_WGU, scr8, F.lane); }
              else { const int q = r - 1408, kb = q / 16, nb = q % 16; conv_item64_fp8(F.in[I_FD], 2816, 1024, F.ws + WS_WD, 64 * kb, 64 * nb, 64 * nb, QS_WD, scr8, F.lane); } }
#else
            if (r < I_G) { p0_convert_gu(F, F.in[I_FG], 1024, 2816, (bf16*)(F.ws + WS_WGU), r, 0, scr); continue; } r -= I_G;
            if (r < I_G) { p0_convert_gu(F, F.in[I_FU], 1024, 2816, (bf16*)(F.ws + WS_WGU), r, 1, scr); continue; } r -= I_G;
            p0_convert_plain(F, F.in[I_FD], 2816, 1024, (bf16*)(F.ws + WS_WD), r, scr);
#endif
        }
    }
}

struct NormVecs { f32x4 gs[4], sh[4]; };
DI void norm_load_vecs(Frame& F, const float* g, const float* mod, int isc, int ish, NormVecs& V) {
#pragma unroll
    for (int j = 0; j < 4; ++j) { const f32x4 gv = ((const f32x4*)g)[F.lane + 64 * j], sv = ((const f32x4*)(mod + isc * DM))[F.lane + 64 * j]; V.gs[j] = gv * (sv + 1.0f); V.sh[j] = ((const f32x4*)(mod + ish * DM))[F.lane + 64 * j]; }
}
DI void norm_load_row(Frame& F, const float* srow, f32x4 (&v)[4]) {
    const f32x4* xr = (const f32x4*)srow + F.lane;
#pragma unroll
    for (int j = 0; j < 4; ++j) v[j] = xr[64 * j];
}
DI float norm_ssq(const f32x4 (&v)[4]) { float s = 0.f;
#pragma unroll
    for (int j = 0; j < 4; ++j) s += (v[j].x * v[j].x + v[j].y * v[j].y) + (v[j].z * v[j].z + v[j].w * v[j].w);
    return s; }
DI void norm_finish(Frame& F, const f32x4 (&v)[4], float ssq_total, const NormVecs& V, bf16* orow, f32x4 (&y)[4]) {
    const float rstd = 1.0f / sqrtf(ssq_total * (1.0f / DM) + EPS);
    u32x2* o8 = (u32x2*)orow + F.lane;
#pragma unroll
    for (int j = 0; j < 4; ++j) { y[j] = (v[j] * rstd) * V.gs[j] + V.sh[j]; u32x2 w; w.x = pk2(y[j].x, y[j].y); w.y = pk2(y[j].z, y[j].w); o8[64 * j] = w; }
}
DI void norm_finish8(Frame& F, const f32x4 (&v)[4], float ssq_total, const NormVecs& V, unsigned char* orow, f32x4 (&y)[4]) {
    const float rstd = 1.0f / sqrtf(ssq_total * (1.0f / DM) + EPS);
    unsigned* o4 = (unsigned*)orow + F.lane;
#pragma unroll
    for (int j = 0; j < 4; ++j) { y[j] = (v[j] * rstd) * V.gs[j] + V.sh[j]; o4[64 * j] = pk4_fp8(y[j].x * QS_U, y[j].y * QS_U, y[j].z * QS_U, y[j].w * QS_U); }
}
DI void norm_pair(Frame& F, const float* sbase, int row, int send, const NormVecs& V, bf16* U, bool out8, f32x4 (&ca)[4], f32x4 (&cb)[4], f32x4 (&na)[4], f32x4 (&nb)[4]) {
    const bool two = row + 1 < send;
    { const int nr = row + 2 < send ? row + 2 : row, nrb = row + 3 < send ? row + 3 : nr;
      norm_load_row(F, sbase + (size_t)nr * DM, na); norm_load_row(F, sbase + (size_t)nrb * DM, nb); }
    float sa = norm_ssq(ca), sb = norm_ssq(cb);
#pragma unroll
    for (int o = 1; o < 64; o <<= 1) { sa += __shfl_xor(sa, o); sb += __shfl_xor(sb, o); }
    f32x4 y[4];
    if (out8) norm_finish8(F, ca, sa, V, (unsigned char*)U + (size_t)row * DM, y); else norm_finish(F, ca, sa, V, U + (size_t)row * DM, y);
    if (two) { if (out8) norm_finish8(F, cb, sb, V, (unsigned char*)U + (size_t)(row + 1) * DM, y); else norm_finish(F, cb, sb, V, U + (size_t)(row + 1) * DM, y); }
}
DI void norm_phase(Frame& F, int l, int which, bool first, int row_lo, bool out8 = false) {
    const float* g = F.in[which == 1 ? I_N1W : I_N2W] + l * DM;
    const float* modlat = (const float*)(F.ws + WS_MODLAT) + (size_t)l * 16 * 6144;
    const float* modctx = (const float*)(F.ws + WS_MODCTX) + (size_t)l * 6144;
    const int ish = which == 1 ? 0 : 3, isc = which == 1 ? 1 : 4;
    const float* sctx = first ? F.in[I_CTX] : (const float*)(F.ws + WS_HCTX);
    const float* slat = first ? F.in[I_X] : F.out;
    bf16* U = (bf16*)(F.ws + WS_U);
    const int gw = F.bid * 8 + F.wave, NGW = F.G * 8;
    const int rpw = (NTOK - row_lo + NGW - 1) / NGW;
    const int r0 = row_lo + gw * rpw; int r1 = r0 + rpw; if (r1 > NTOK) r1 = NTOK;
    NormVecs V;
    for (int seg = r0; seg < r1;) {
        const int bk = seg < NCTX ? -1 : (seg - NCTX) / SEQ;
        int send = bk < 0 ? NCTX : NCTX + (bk + 1) * SEQ; if (send > r1) send = r1;
        norm_load_vecs(F, g, bk < 0 ? modctx : modlat + (size_t)bk * 6144, isc, ish, V);
        const float* sbase = bk < 0 ? sctx : slat - (size_t)NCTX * DM;
        f32x4 va[4], vb[4], wa[4], wb[4];
        norm_load_row(F, sbase + (size_t)seg * DM, va);
        norm_load_row(F, sbase + (size_t)(seg + 1 < send ? seg + 1 : seg) * DM, vb);
        for (int row = seg; row < send; row += 4) {
            norm_pair(F, sbase, row, send, V, U, out8, va, vb, wa, wb);
            if (row + 2 < send) norm_pair(F, sbase, row + 2, send, V, U, out8, wa, wb, va, vb);
        }
        seg = send;
    }
}
DI void moe_route_row(Frame& F, const f32x4 (&y)[4], LAS const float* Rw, const float (&rb)[8], LAS int* sel, int tl, int tok) {
    float lg[8];
#pragma unroll
    for (int e = 0; e < 8; ++e) lg[e] = 0.f;
#pragma unroll
    for (int j = 0; j < 4; ++j)
#pragma unroll
        for (int q = 0; q < 4; ++q) { const int k = 256 * j + 4 * F.lane + q; const f32x4 r0 = *(const LAS f32x4*)(Rw + k * 8), r1 = *(const LAS f32x4*)(Rw + k * 8 + 4); const float yv = y[j][q];
            lg[0] += yv * r0[0]; lg[1] += yv * r0[1]; lg[2] += yv * r0[2]; lg[3] += yv * r0[3]; lg[4] += yv * r1[0]; lg[5] += yv * r1[1]; lg[6] += yv * r1[2]; lg[7] += yv * r1[3]; }
#pragma unroll
    for (int o = 1; o < 64; o <<= 1) {
#pragma unroll
        for (int e = 0; e < 8; ++e) lg[e] += __shfl_xor(lg[e], o); }
#pragma unroll
    for (int e = 0; e < 8; ++e) lg[e] += rb[e];
    int e1 = 0; float v1 = lg[0];
#pragma unroll
    for (int e = 1; e < 8; ++e) if (lg[e] > v1) { v1 = lg[e]; e1 = e; }
    int e2 = -1; float v2 = -3.0e38f;
#pragma unroll
    for (int e = 0; e < 8; ++e) if (e != e1 && lg[e] > v2) { v2 = lg[e]; e2 = e; }
    const float ex = __expf(v2 - v1), p1 = 1.0f / (1.0f + ex), p2 = ex / (1.0f + ex);
    if (F.lane == 0) { sel[tl * 2] = e1; sel[tl * 2 + 1] = e2; float* pt = (float*)(F.ws + WS_PTOK) + (size_t)tok * 2; pt[0] = p1; pt[1] = p2; }
}
DI void norm_moe_phase(Frame& F) {
    const int l = 1;
    const float* g = F.in[I_N2W] + l * DM;
    const float* modlat = (const float*)(F.ws + WS_MODLAT) + (size_t)l * 16 * 6144;
    bf16* U = (bf16*)(F.ws + WS_U);
    LAS float* Rw = (LAS float*)F.lds;
    LAS int* sel = (LAS int*)(F.lds + 32768);
    for (int idx = F.tid; idx < 8192; idx += 512) Rw[idx] = F.in[I_MR][idx];
    __syncthreads();
    float rb[8];
#pragma unroll
    for (int e = 0; e < 8; ++e) rb[e] = F.in[I_MRB][e];
    NormVecs V; int curb = -2;
    for (int seg = F.bid; seg < 256; seg += F.G) {
        const int bk = (seg * 128) / SEQ; if (bk != curb) { norm_load_vecs(F, g, modlat + (size_t)bk * 6144, 4, 3, V); curb = bk; }
        for (int i = 0; i < 16; i += 2) {
            const int tl = F.wave * 16 + i, tok = seg * 128 + tl;
            f32x4 va[4], vb[4];
            norm_load_row(F, F.out + (size_t)tok * DM, va); norm_load_row(F, F.out + (size_t)(tok + 1) * DM, vb);
            float sa = norm_ssq(va), sb = norm_ssq(vb);
#pragma unroll
            for (int o = 1; o < 64; o <<= 1) { sa += __shfl_xor(sa, o); sb += __shfl_xor(sb, o); }
            f32x4 y[4];
#if MOE_FP8
            norm_finish8(F, va, sa, V, (unsigned char*)U + (size_t)tok * DM, y); moe_route_row(F, y, Rw, rb, sel, tl, tok);
            norm_finish8(F, vb, sb, V, (unsigned char*)U + (size_t)(tok + 1) * DM, y); moe_route_row(F, y, Rw, rb, sel, tl + 1, tok + 1);
#else
            norm_finish(F, va, sa, V, U + (size_t)(NCTX + tok) * DM, y); moe_route_row(F, y, Rw, rb, sel, tl, tok);
            norm_finish(F, vb, sb, V, U + (size_t)(NCTX + tok + 1) * DM, y); moe_route_row(F, y, Rw, rb, sel, tl + 1, tok + 1);
#endif
        }
        __syncthreads();
        if (F.tid < 16) { const int s = F.tid >> 3, e = F.tid & 7; int cnt = 0; int* lst = (int*)(F.ws + WS_SEGLIST) + ((size_t)(seg * 2 + s) * 8 + e) * 128;
            for (int i = 0; i < 128; ++i) if (sel[i * 2 + s] == e) lst[cnt++] = seg * 128 + i;
            ((int*)(F.ws + WS_SEGCNT))[(seg * 2 + s) * 8 + e] = cnt; }
        __syncthreads();
    }
}
DI void moe_route_phase(Frame& F) {
    LAS int* cn = (LAS int*)F.lds;
    LAS int* offs = cn + 2048;
    LAS int* tb = offs + 256;
    for (int unit = F.bid; unit < 16; unit += F.G) {
        const int s = unit >> 3, e = unit & 7;
        const int* segcnt = (const int*)(F.ws + WS_SEGCNT);
        for (int idx = F.tid; idx < 2048; idx += 512) { const int ee = idx >> 8, gsg = idx & 255; cn[idx] = segcnt[(gsg * 2 + s) * 8 + ee]; }
        __syncthreads();
        if (F.tid < 8) { int tot = 0; for (int gsg = 0; gsg < 256; ++gsg) tot += cn[F.tid * 256 + gsg]; tb[16 + F.tid] = tot; }
        if (F.tid == 64) { int run = 0; for (int gsg = 0; gsg < 256; ++gsg) { offs[gsg] = run; run += cn[e * 256 + gsg]; } }
        __syncthreads();
        if (F.tid == 0) { int run = 0; for (int ee = 0; ee < 8; ++ee) { tb[ee] = run; run += (tb[16 + ee] + 255) / 256; } tb[8] = run; }
        __syncthreads();
        int* rowmap = (int*)(F.ws + WS_ROWMAP) + (size_t)s * MOE_ROWS;
        float* prow = (float*)(F.ws + WS_PROW) + (size_t)s * MOE_ROWS;
        const float* ptok = (const float*)(F.ws + WS_PTOK);
        const int base = tb[e] * 256, tot = tb[16 + e], ntile = (tot + 255) / 256;
        if (F.tid < 256) { const int gsg = F.tid; const int c = cn[e * 256 + gsg]; const int* lst = (const int*)(F.ws + WS_SEGLIST) + ((size_t)(gsg * 2 + s) * 8 + e) * 128;
            for (int i = 0; i < c; ++i) { const int tok = lst[i]; rowmap[base + offs[gsg] + i] = tok; prow[base + offs[gsg] + i] = ptok[(size_t)tok * 2 + s]; } }
        for (int i = tot + F.tid; i < ntile * 256; i += 512) { rowmap[base + i] = -1; prow[base + i] = 0.f; }
        if (e == 0) { int* meta = (int*)(F.ws + WS_META) + s * 256;
            if (F.tid == 0) meta[0] = tb[8];
            if (F.tid < 8) { const int t0 = tb[F.tid], t1 = tb[F.tid + 1]; for (int t = t0; t < t1; ++t) meta[1 + t] = F.tid; } }
        __syncthreads();
    }
}
DI void final_phase(Frame& F) {
    const float* g = F.in[I_FNW];
    const float* gate = (const float*)(F.ws + WS_MODLAT) + (size_t)16 * 6144 + 5 * DM;
    const bf16* y0 = (const bf16*)(F.ws + WS_Y0); const bf16* y1 = (const bf16*)(F.ws + WS_U);
    f32x4 gv[4], gt[4];
#pragma unroll
    for (int j = 0; j < 4; ++j) gv[j] = ((const f32x4*)g)[F.lane + 64 * j];
    const int gw = F.bid * 8 + F.wave, NGW = F.G * 8;
    const int rpw = (NLAT + NGW - 1) / NGW; const int r0 = gw * rpw; int r1 = r0 + rpw; if (r1 > NLAT) r1 = NLAT;
    for (int seg = r0; seg < r1;) {
        const int bk = seg / SEQ; int send = (bk + 1) * SEQ; if (send > r1) send = r1;
#pragma unroll
        for (int j = 0; j < 4; ++j) gt[j] = ((const f32x4*)(gate + (size_t)bk * 6144))[F.lane + 64 * j];
        for (int row = seg; row < send; row += 2) {
            const bool two = row + 1 < send; const int rowb = two ? row + 1 : row;
            f32x4 va[4], vb[4]; u32x2 pa[4], pb[4], qa[4], qb[4];
            norm_load_row(F, F.out + (size_t)row * DM, va); norm_load_row(F, F.out + (size_t)rowb * DM, vb);
#pragma unroll
            for (int j = 0; j < 4; ++j) { pa[j] = ((const u32x2*)(y0 + (size_t)row * DM))[F.lane + 64 * j]; qa[j] = ((const u32x2*)(y1 + (size_t)row * DM))[F.lane + 64 * j];
                pb[j] = ((const u32x2*)(y0 + (size_t)rowb * DM))[F.lane + 64 * j]; qb[j] = ((const u32x2*)(y1 + (size_t)rowb * DM))[F.lane + 64 * j]; }
#pragma unroll
            for (int j = 0; j < 4; ++j) { f32x4 fa, fb;
                fa.x = bflo(pa[j].x) + bflo(qa[j].x); fa.y = bfhi(pa[j].x) + bfhi(qa[j].x); fa.z = bflo(pa[j].y) + bflo(qa[j].y); fa.w = bfhi(pa[j].y) + bfhi(qa[j].y);
                fb.x = bflo(pb[j].x) + bflo(qb[j].x); fb.y = bfhi(pb[j].x) + bfhi(qb[j].x); fb.z = bflo(pb[j].y) + bflo(qb[j].y); fb.w = bfhi(pb[j].y) + bfhi(qb[j].y);
                va[j] = va[j] + gt[j] * fa; vb[j] = vb[j] + gt[j] * fb; }
            float sa = norm_ssq(va), sb = norm_ssq(vb);
#pragma unroll
            for (int o = 1; o < 64; o <<= 1) { sa += __shfl_xor(sa, o); sb += __shfl_xor(sb, o); }
            const float ra = 1.0f / sqrtf(sa * (1.0f / DM) + EPS), rbv = 1.0f / sqrtf(sb * (1.0f / DM) + EPS);
            f32x4* xa = (f32x4*)(F.out + (size_t)row * DM) + F.lane; f32x4* xb = (f32x4*)(F.out + (size_t)rowb * DM) + F.lane;
#pragma unroll
            for (int j = 0; j < 4; ++j) xa[64 * j] = (va[j] * ra) * gv[j];
            if (two) {
#pragma unroll
                for (int j = 0; j < 4; ++j) xb[64 * j] = (vb[j] * rbv) * gv[j]; }
        }
        seg = send;
    }
}

DI void conv_unit(Frame& F, int l, int row0, int t0, int slen) {
    const bf16* PX = (const bf16*)(F.ws + WS_P);
    bf16* YC = (bf16*)(F.ws + WS_U);
    LAS float* Y = (LAS float*)F.lds;
    { u32x4 av[6], gv[6];
#pragma unroll
      for (int k = 0; k < 6; ++k) { const int it = F.tid + 512 * k; const int rr = it >> 5, cc = it & 31; int t = t0 - 15 + rr; t = t < 0 ? 0 : (t >= slen ? slen - 1 : t);
          const bf16* p = PX + (size_t)(row0 + t) * INW + C_CONV + 8 * cc; av[k] = *(const u32x4*)p; gv[k] = *(const u32x4*)(p + 256); }
      asm volatile("" : "+v"(av[0]), "+v"(av[1]), "+v"(av[2]), "+v"(av[3]), "+v"(av[4]), "+v"(av[5]), "+v"(gv[0]), "+v"(gv[1]), "+v"(gv[2]), "+v"(gv[3]), "+v"(gv[4]), "+v"(gv[5]));
#pragma unroll
      for (int k = 0; k < 6; ++k) { const int it = F.tid + 512 * k; const int rr = it >> 5, cc = it & 31; const int t = t0 - 15 + rr;
          if (it < 94 * 32) { f32x4 o0, o1;
              o0[0] = bflo(av[k].x) * sigmoidf_(bflo(gv[k].x)); o0[1] = bfhi(av[k].x) * sigmoidf_(bfhi(gv[k].x)); o0[2] = bflo(av[k].y) * sigmoidf_(bflo(gv[k].y)); o0[3] = bfhi(av[k].y) * sigmoidf_(bfhi(gv[k].y));
              o1[0] = bflo(av[k].z) * sigmoidf_(bflo(gv[k].z)); o1[1] = bfhi(av[k].z) * sigmoidf_(bfhi(gv[k].z)); o1[2] = bflo(av[k].w) * sigmoidf_(bflo(gv[k].w)); o1[3] = bfhi(av[k].w) * sigmoidf_(bfhi(gv[k].w));
              if (t < 0 || t >= slen) { o0 = (f32x4){0.f, 0.f, 0.f, 0.f}; o1 = o0; }
              *(LAS f32x4*)(Y + rr * 256 + 8 * cc) = o0; *(LAS f32x4*)(Y + rr * 256 + 8 * cc + 4) = o1; } } }
    __syncthreads();
    const int c = F.tid & 255, half = F.tid >> 8;
    float w[31];
#pragma unroll
    for (int k = 0; k < 31; ++k) w[k] = F.in[I_CONVW][(size_t)l * 31 * 256 + k * 256 + c];
    float acc[32];
    const float cb = F.in[I_CONVB][l * 256 + c];
#pragma unroll
    for (int o = 0; o < 32; ++o) acc[o] = cb;
#pragma unroll
    for (int kk = 0; kk < 62; ++kk) { const float yv = Y[(32 * half + kk) * 256 + c];
#pragma unroll
        for (int o = 0; o < 32; ++o) { const int tap = kk - o; if (tap >= 0 && tap < 31) acc[o] += yv * w[tap]; } }
    __syncthreads();
#pragma unroll
    for (int o = 0; o < 32; ++o) Y[(32 * half + o) * 256 + c] = acc[o];
    __syncthreads();
    const f32x4 lw = ((const f32x4*)(F.in[I_CLNW] + l * 256))[F.lane], lb = ((const f32x4*)(F.in[I_CLNB] + l * 256))[F.lane];
    for (int i = 0; i < 8; ++i) { const int tl = F.wave * 8 + i; const f32x4 v = *(const LAS f32x4*)(Y + tl * 256 + 4 * F.lane);
        const float mu = wave_sum((v.x + v.y) + (v.z + v.w)) * (1.0f / 256.0f); const f32x4 d = v - mu;
        const float var = wave_sum((d.x * d.x + d.y * d.y) + (d.z * d.z + d.w * d.w)) * (1.0f / 256.0f); const float rstd = 1.0f / sqrtf(var + EPS);
        f32x4 z = d * rstd * lw + lb; z.x *= sigmoidf_(z.x); z.y *= sigmoidf_(z.y); z.z *= sigmoidf_(z.z); z.w *= sigmoidf_(z.w);
        u32x2 o; o.x = pk2(z.x, z.y); o.y = pk2(z.z, z.w);
        *(u32x2*)(YC + (size_t)(row0 + t0 + tl) * DM + 512 + 4 * F.lane) = o; }
    __syncthreads();
}
DI void ret_consts(Frame& F, int l, int hh, float& lg2f, float& lg2b) {
    const float df = F.in[I_RDEC][(l * 2 + 0) * 4 + hh], db = F.in[I_RDEC][(l * 2 + 1) * 4 + hh];
    lg2f = log2f(1.0f - exp2f(-df)); lg2b = log2f(1.0f - exp2f(-db));
}
constexpr int ROPE_LDS = AUX_OFF + 4096;
DI void rope_to_lds(Frame& F) { const float* tab = (const float*)(F.ws + WS_ROPE); LAS float* rt = (LAS float*)(F.lds + ROPE_LDS); for (int i = F.tid; i < 1024; i += 512) rt[i] = tab[i]; __syncthreads(); }
DI void unpack8(const u32x4& a, float (&x)[8]) { x[0] = bflo(a.x); x[1] = bfhi(a.x); x[2] = bflo(a.y); x[3] = bfhi(a.y); x[4] = bflo(a.z); x[5] = bfhi(a.z); x[6] = bflo(a.w); x[7] = bfhi(a.w); }
DI void rope_apply(Frame& F, const u32x4& a, const u32x4& b, int hp, bool lat, int tg, float (&x1)[8], float (&x2)[8]) {
    unpack8(a, x1); unpack8(b, x2);
    if (lat) { const int pos = hp == 0 ? (tg >> 6) : (tg & 63); LAS const f32x4* tab = (LAS const f32x4*)(F.lds + ROPE_LDS) + pos * 4;
#pragma unroll
        for (int jj = 0; jj < 4; ++jj) { const f32x4 cs = tab[jj];
            { const float a1 = x1[2 * jj], a2 = x2[2 * jj]; x1[2 * jj] = a1 * cs[0] - a2 * cs[1]; x2[2 * jj] = a2 * cs[0] + a1 * cs[1]; }
            { const float a1 = x1[2 * jj + 1], a2 = x2[2 * jj + 1]; x1[2 * jj + 1] = a1 * cs[2] - a2 * cs[3]; x2[2 * jj + 1] = a2 * cs[2] + a1 * cs[3]; } } }
}
DI void ret_unit_decode(int su, bool& isctx, int& b, int& hh, int& n) {
    isctx = su >= 1024; if (!isctx) { b = su >> 6; hh = (su >> 4) & 3; n = su & 15; } else { const int v = su - 1024; b = v >> 3; hh = (v >> 1) & 3; n = v & 1; }
}
DI void ret_summary_pair(Frame& F, int l, int it) {
    const bf16* PX = (const bf16*)(F.ws + WS_P);
    const int sub = F.wave >> 2, st = F.tid & 255, su = 2 * it + sub;
    bool isctx; int b, hh, n; ret_unit_decode(su, isctx, b, hh, n);
    const int row0 = isctx ? (b * CTXL + n * 128) : (NCTX + b * SEQ + n * 128);
    float lg2f, lg2b; ret_consts(F, l, hh, lg2f, lg2b);
    LAS unsigned char* base = F.lds + sub * 40960;
    LAS unsigned char* Vimg = base;
    LAS unsigned char* Kf = base + 18432;
    LAS unsigned char* Kb = base + 18432 + 10240;
    { const int tok = st >> 1, hp = st & 1; float x1[8], x2[8];
      const bf16* kp = PX + (size_t)(row0 + tok) * INW + C_RK + 32 * hh; const bf16* vp = PX + (size_t)(row0 + tok) * INW + C_RV + 64 * hh + 32 * hp;
      const u32x4 kra = *(const u32x4*)(kp + 8 * hp), krb = *(const u32x4*)(kp + 16 + 8 * hp);
      u32x4 vr[4];
#pragma unroll
      for (int q = 0; q < 4; ++q) vr[q] = *(const u32x4*)(vp + 8 * q);
      rope_apply(F, kra, krb, hp, !isctx, n * 128 + tok, x1, x2);
      const float ks = 0.17677669529663687f;
      const float wf = fast_exp2(lg2f * (float)(127 - tok)) * ks, wb = fast_exp2(lg2b * (float)tok) * ks;
      u32x4 o;
      o.x = pk2(x1[0] * wf, x1[1] * wf); o.y = pk2(x1[2] * wf, x1[3] * wf); o.z = pk2(x1[4] * wf, x1[5] * wf); o.w = pk2(x1[6] * wf, x1[7] * wf); *(LAS u32x4*)(Kf + tok * 80 + 16 * hp) = o;
      o.x = pk2(x2[0] * wf, x2[1] * wf); o.y = pk2(x2[2] * wf, x2[3] * wf); o.z = pk2(x2[4] * wf, x2[5] * wf); o.w = pk2(x2[6] * wf, x2[7] * wf); *(LAS u32x4*)(Kf + tok * 80 + 32 + 16 * hp) = o;
      o.x = pk2(x1[0] * wb, x1[1] * wb); o.y = pk2(x1[2] * wb, x1[3] * wb); o.z = pk2(x1[4] * wb, x1[5] * wb); o.w = pk2(x1[6] * wb, x1[7] * wb); *(LAS u32x4*)(Kb + tok * 80 + 16 * hp) = o;
      o.x = pk2(x2[0] * wb, x2[1] * wb); o.y = pk2(x2[2] * wb, x2[3] * wb); o.z = pk2(x2[4] * wb, x2[5] * wb); o.w = pk2(x2[6] * wb, x2[7] * wb); *(LAS u32x4*)(Kb + tok * 80 + 32 + 16 * hp) = o;
#pragma unroll
      for (int q = 0; q < 4; ++q) *(LAS u32x4*)(Vimg + tok * 144 + 64 * hp + 16 * q) = vr[q]; }
    __syncthreads();
    { const int role = F.wave & 3, dir = role >> 1, et = role & 1;
      const int l32 = F.lane & 31, h = F.lane >> 5, grp = (F.lane >> 4) & 1, i16 = F.lane & 15, q = i16 >> 2, p = i16 & 3;
      LAS unsigned char* Kimg = dir ? Kb : Kf;
      f32x16 acc;
#pragma unroll
      for (int i = 0; i < 16; ++i) acc[i] = 0.f;
#pragma unroll
      for (int s = 0; s < 8; ++s) { const int r0 = 16 * s + 8 * h + q;
          const s16x4 alo = trread(Vimg + r0 * 144 + (32 * et + 16 * grp + 4 * p) * 2), ahi = trread(Vimg + (r0 + 4) * 144 + (32 * et + 16 * grp + 4 * p) * 2);
          const s16x4 blo = trread(Kimg + r0 * 80 + (16 * grp + 4 * p) * 2), bhi = trread(Kimg + (r0 + 4) * 80 + (16 * grp + 4 * p) * 2);
          const bf16x8 a = __builtin_shufflevector(alo, ahi, 0, 1, 2, 3, 4, 5, 6, 7), bb = __builtin_shufflevector(blo, bhi, 0, 1, 2, 3, 4, 5, 6, 7);
          acc = MFMA32(a, bb, acc); }
      float* S = isctx ? (float*)(F.ws + WS_SUMCTX) + ((size_t)((b * 4 + hh) * 2 + n) * 2 + dir) * 2048 : (float*)(F.ws + WS_SUMLAT) + ((size_t)((b * 4 + hh) * 16 + n) * 2 + dir) * 2048;
#pragma unroll
      for (int i = 0; i < 16; ++i) S[(32 * et + crow(i, h)) * 32 + l32] = acc[i]; }
    __syncthreads();
}
DI void ca_phase(Frame& F, int l) {
    rope_to_lds(F);
    const int nconv = l == 0 ? 576 : 512;
    for (int u = F.vb; u < nconv; u += F.G) {
        int v = u; if (l != 0) v += 64;
        if (v < 64) conv_unit(F, l, (v >> 2) * CTXL, (v & 3) * 64, CTXL);
        else { v -= 64; conv_unit(F, l, NCTX + (v >> 5) * SEQ, (v & 31) * 64, SEQ); }
    }
    for (int it = F.vb; it < 576; it += F.G) ret_summary_pair(F, l, it);
}

constexpr int ATT_KV = 18432, ATT_BUF = 2 * ATT_KV, ATT_BT = 2 * ATT_BUF, ATT_NEG = 640;
struct AttRegs { u32x4 k0, v0, k1, v1; };
DI void attn_fetch(const bf16* PX, int rowA, int rowB, unsigned loff, AttRegs& R) {
    const char* pa = (const char*)(PX + (size_t)rowA * INW) + loff; const char* pb = (const char*)(PX + (size_t)rowB * INW) + loff;
    R.k0 = *(const u32x4*)(pa + C_NAK * 2); R.v0 = *(const u32x4*)(pa + C_NAV * 2); R.k1 = *(const u32x4*)(pb + C_NAK * 2); R.v1 = *(const u32x4*)(pb + C_NAV * 2);
}
DI void attn_put(Frame& F, LAS unsigned char* buf, const AttRegs& R) {
    const int key = F.tid >> 3, ch = F.tid & 7;
    *(LAS u32x4*)(buf + key * 144 + 16 * ch) = R.k0; *(LAS u32x4*)(buf + ATT_KV + key * 144 + 16 * ch) = R.v0;
    *(LAS u32x4*)(buf + (64 + key) * 144 + 16 * ch) = R.k1; *(LAS u32x4*)(buf + ATT_KV + (64 + key) * 144 + 16 * ch) = R.v1;
}
template <bool BIAS, int NT>
DI void attn_tiles(LAS const unsigned char* buf, const int (&koff)[2], const bf16x8 (&qf)[4], f32x16& o0, f32x16& o1, f32x16& o2, float& mrun, int lane,
                   LAS const float* const (&bt)[2]  , const float (&pen)[16]) {
    LAS const unsigned char* Kimg = buf; LAS const unsigned char* Vimg = buf + ATT_KV;
    const int l32 = lane & 31, h = lane >> 5, grp = (lane >> 4) & 1, i16 = lane & 15, q = i16 >> 2, p = i16 & 3;
    f32x16 s[NT];
#pragma unroll
    for (int t = 0; t < NT; ++t)
#pragma unroll
        for (int i = 0; i < 16; ++i) s[t][i] = 0.f;
#pragma unroll
    for (int si = 0; si < 4; ++si)
#pragma unroll
        for (int t = 0; t < NT; ++t) { const bf16x8 a = *(const LAS bf16x8*)(Kimg + (koff[t] + l32) * 144 + (16 * si + 8 * h) * 2); s[t] = MFMA32(a, qf[si], s[t]); }
    const float c = 0.125f * LOG2E;
    float v[NT][16]; float mx = -1.0e30f;
#pragma unroll
    for (int t = 0; t < NT; ++t)
#pragma unroll
        for (int i = 0; i < 16; ++i) { float x;
            if (BIAS) x = __builtin_fmaf(s[t][i], c, bt[t][(i & 3) + 8 * (i >> 2)]) + pen[i]; else x = s[t][i];
            v[t][i] = x; mx = fmaxf(mx, x); }
    if (!BIAS) mx *= c;
    mx = fmaxf(mx, __shfl_xor(mx, 32));
    const float mnew = fmaxf(mrun, mx);
    const float alpha = fast_exp2(mrun - mnew);
    if (__any(alpha != 1.0f)) {
#pragma unroll
        for (int i = 0; i < 16; ++i) { o0[i] *= alpha; o1[i] *= alpha; o2[i] *= alpha; } }
    mrun = mnew;
    bf16x8 pf[NT][2];
#pragma unroll
    for (int t = 0; t < NT; ++t) { float pp[16];
#pragma unroll
        for (int i = 0; i < 16; ++i) pp[i] = BIAS ? fast_exp2(v[t][i] - mnew) : fast_exp2(__builtin_fmaf(v[t][i], c, -mnew));
#pragma unroll
        for (int s2 = 0; s2 < 2; ++s2) { u32x4 w; w.x = pk2(pp[8 * s2], pp[8 * s2 + 1]); w.y = pk2(pp[8 * s2 + 2], pp[8 * s2 + 3]); w.z = pk2(pp[8 * s2 + 4], pp[8 * s2 + 5]); w.w = pk2(pp[8 * s2 + 6], pp[8 * s2 + 7]); pf[t][s2] = __builtin_bit_cast(bf16x8, w); } }
    const u32x4 onesw = (u32x4){0x3f803f80u, 0x3f803f80u, 0x3f803f80u, 0x3f803f80u}; const bf16x8 ones = __builtin_bit_cast(bf16x8, onesw);
#pragma unroll
    for (int t = 0; t < NT; ++t)
#pragma unroll
        for (int s2 = 0; s2 < 2; ++s2) { const int r0 = koff[t] + 16 * s2 + 4 * h + q;
#pragma unroll
            for (int et = 0; et < 2; ++et) { const int cb = (32 * et + 16 * grp + 4 * p) * 2;
                const s16x4 lo = trread(Vimg + r0 * 144 + cb), hi = trread(Vimg + (r0 + 8) * 144 + cb);
                const bf16x8 a = __builtin_shufflevector(lo, hi, 0, 1, 2, 3, 4, 5, 6, 7);
                if (et == 0) o0 = MFMA32(a, pf[t][s2], o0); else o1 = MFMA32(a, pf[t][s2], o1); }
            o2 = MFMA32(ones, pf[t][s2], o2); }
}
DI void attn_unit(Frame& F, int l, bool na, int b, int hh, int rg) {
    const bf16* PX = (const bf16*)(F.ws + WS_P);
    bf16* YC = (bf16*)(F.ws + WS_U);
    LAS float* btab = (LAS float*)(F.lds + ATT_BT);
    const int l32 = F.lane & 31, h = F.lane >> 5;
    int qrow, r = 0, qcol = 0, kc0 = 0, ra = 0;
    float pen[16];
#pragma unroll
    for (int i = 0; i < 16; ++i) pen[i] = 0.f;
    if (na) { const int rp = F.wave >> 2, n = F.wave & 3; ra = 4 * rg + 2 * rp; r = ra + (l32 >> 4); qcol = 16 * n + (l32 & 15); qrow = NCTX + b * SEQ + r * GW + qcol;
        int w0 = qcol - 8; w0 = w0 < 0 ? 0 : (w0 > 48 ? 48 : w0); kc0 = 16 * n - 8; kc0 = kc0 < 0 ? 0 : (kc0 > 32 ? 32 : kc0);
#pragma unroll
        for (int i = 0; i < 16; ++i) pen[i] = ((unsigned)(kc0 + crow(i, h) - w0) < 16u) ? 0.f : -1.0e30f; }
    else qrow = b * CTXL + 32 * F.wave + l32;
    bf16x8 qf[4];
#pragma unroll
    for (int si = 0; si < 4; ++si) qf[si] = *(const bf16x8*)(PX + (size_t)qrow * INW + C_NAQ + 64 * hh + 16 * si + 8 * h);
    if (na) { for (int idx = F.tid; idx < ATT_NEG + 128; idx += 512) { float v = 0.f; if (idx >= 48 && idx < 48 + 465) v = F.in[I_RPB][((size_t)l * 8 + hh) * 465 + (idx - 48)] * LOG2E; if (idx >= ATT_NEG) v = -1.0e30f; btab[idx] = v; } }
    f32x16 o0, o1, o2;
#pragma unroll
    for (int i = 0; i < 16; ++i) { o0[i] = 0.f; o1[i] = 0.f; o2[i] = 0.f; }
    float mrun = -1.0e30f;
    int ylo = 0, yhi = 0, nsteps = 2;
    if (na) { const int rlo = 4 * rg, rhi = 4 * rg + 3;
        ylo = rlo - 4; ylo = ylo < 0 ? 0 : (ylo > 24 ? 24 : ylo);
        yhi = rhi - 4; yhi = yhi < 0 ? 0 : (yhi > 24 ? 24 : yhi); yhi += 8; nsteps = 2 + (yhi - ylo + 1) / 2; }
    int sa = ra - 4; sa = sa < 0 ? 0 : (sa > 24 ? 24 : sa);
    int sb = ra + 1 - 4; sb = sb < 0 ? 0 : (sb > 24 ? 24 : sb);
    const int mylo = (l32 >> 4) ? sb : sa;
    const int cbase = kc0 + 4 * h - qcol + 15;
#define ATT_ROWA(sx) ((sx) < 2 ? b * CTXL + 128 * (sx) : NCTX + b * SEQ + (ylo + 2 * ((sx) - 2)) * GW)
#define ATT_ROWB(sx) ((sx) < 2 ? b * CTXL + 128 * (sx) + 64 : NCTX + b * SEQ + ((ylo + 2 * ((sx) - 2) + 1) < yhi ? (ylo + 2 * ((sx) - 2) + 1) : (yhi - 1)) * GW)
    AttRegs R;
    unsigned loff = (unsigned)(((F.tid >> 3) * INW + 64 * hh + 8 * (F.tid & 7)) * 2); asm volatile("" : "+v"(loff));
    attn_fetch(PX, ATT_ROWA(0), ATT_ROWB(0), loff, R);
    for (int st = 0; st < nsteps; ++st) {
        LAS unsigned char* buf = F.lds + (st & 1) * ATT_BUF;
        attn_put(F, buf, R);
        if (st + 1 < nsteps) attn_fetch(PX, ATT_ROWA(st + 1), ATT_ROWB(st + 1), loff, R);
        __syncthreads();
        if (st < 2) {
            LAS const float* const bt[2] = {btab, btab};
            { const int ko[2] = {0, 32}; attn_tiles<false, 2>(buf, ko, qf, o0, o1, o2, mrun, F.lane, bt, pen); }
            { const int ko[2] = {64, 96}; attn_tiles<false, 2>(buf, ko, qf, o0, o1, o2, mrun, F.lane, bt, pen); }
        } else {
            const int y0 = ylo + 2 * (st - 2), y1 = y0 + 1;
            const bool act0 = (y0 >= sa && y0 < sb + 8), act1 = (y1 < yhi && y1 >= sa && y1 < sb + 8);
            const bool ok0 = (unsigned)(y0 - mylo) < 8u, ok1 = (unsigned)(y1 - mylo) < 8u;
            LAS const float* b0 = btab + (ok0 ? 48 + (y0 - r + 7) * 31 + cbase : ATT_NEG);
            LAS const float* b1 = btab + (ok1 ? 48 + (y1 - r + 7) * 31 + cbase : ATT_NEG);
            if (act0 && act1) { const int ko[2] = {kc0, 64 + kc0}; LAS const float* const bt[2] = {b0, b1}; attn_tiles<true, 2>(buf, ko, qf, o0, o1, o2, mrun, F.lane, bt, pen); }
            else if (act0) { const int ko[2] = {kc0, kc0}; LAS const float* const bt[2] = {b0, b0}; attn_tiles<true, 1>(buf, ko, qf, o0, o1, o2, mrun, F.lane, bt, pen); }
            else if (act1) { const int ko[2] = {64 + kc0, 64 + kc0}; LAS const float* const bt[2] = {b1, b1}; attn_tiles<true, 1>(buf, ko, qf, o0, o1, o2, mrun, F.lane, bt, pen); }
        }
    }
#undef ATT_ROWA
#undef ATT_ROWB
    const float inv = 1.0f / o2[0];
    bf16* orow = YC + (size_t)qrow * DM + 64 * hh;
#pragma unroll
    for (int gq = 0; gq < 4; ++gq) { u32x2 w;
        w.x = pk2(o0[4 * gq] * inv, o0[4 * gq + 1] * inv); w.y = pk2(o0[4 * gq + 2] * inv, o0[4 * gq + 3] * inv); *(u32x2*)(orow + 8 * gq + 4 * h) = w;
        w.x = pk2(o1[4 * gq] * inv, o1[4 * gq + 1] * inv); w.y = pk2(o1[4 * gq + 2] * inv, o1[4 * gq + 3] * inv); *(u32x2*)(orow + 32 + 8 * gq + 4 * h) = w; }
    __syncthreads();
}
struct RetRaw { u32x4 kra, krb, vra, vrb, qra, qrb; u32x2 gg[8]; };
DI void ret_fetch(Frame& F, int su, RetRaw& R) {
    const bf16* PX = (const bf16*)(F.ws + WS_P);
    bool isctx; int b, hh, n; ret_unit_decode(su, isctx, b, hh, n);
    const int row0 = isctx ? (b * CTXL + n * 128) : (NCTX + b * SEQ + n * 128);
    const int dir = F.wave >> 2, qb = F.wave & 3, l32 = F.lane & 31, h = F.lane >> 5; const int iq = 32 * qb + l32;
    const int ktok = (F.tid & 255) >> 1, khp = F.tid & 1;
    const bf16* kp = PX + (size_t)(row0 + ktok) * INW + C_RK + 32 * hh;
    R.kra = *(const u32x4*)(kp + 8 * khp); R.krb = *(const u32x4*)(kp + 16 + 8 * khp);
    const int vtok = F.tid >> 2, vch = F.tid & 3; const bf16* vp = PX + (size_t)(row0 + vtok) * INW + C_RV + 64 * hh + 16 * vch;
    R.vra = *(const u32x4*)vp; R.vrb = *(const u32x4*)(vp + 8);
    const bf16* qp = PX + (size_t)(row0 + iq) * INW + C_RQ + 32 * hh;
    R.qra = *(const u32x4*)(qp + 8 * h); R.qrb = *(const u32x4*)(qp + 16 + 8 * h);
    const bf16* gp = PX + (size_t)(row0 + iq) * INW + (dir ? C_GB : C_GF) + 64 * hh;
#pragma unroll
    for (int et = 0; et < 2; ++et)
#pragma unroll
        for (int gq = 0; gq < 4; ++gq) R.gg[et * 4 + gq] = *(const u32x2*)(gp + 32 * et + 8 * gq + 4 * h);
}
DI void ret_out_units(Frame& F, int l, int nret) {
    bf16* YC = (bf16*)(F.ws + WS_U);
    LAS unsigned char* Kimg = F.lds;
    LAS unsigned char* Vimg = F.lds + 10240;
    LAS unsigned char* Stf = F.lds + 28672;
    LAS unsigned char* Stb = F.lds + 33792;
    LAS float* Ob = (LAS float*)(F.lds + 38912);
    const int dir = F.wave >> 2, qb = F.wave & 3, l32 = F.lane & 31, h = F.lane >> 5, grp = (F.lane >> 4) & 1, i16 = F.lane & 15, q = i16 >> 2, p = i16 & 3;
    const int iq = 32 * qb + l32;
    const int ktok = (F.tid & 255) >> 1, khp = F.tid & 1, vtok = F.tid >> 2, vch = F.tid & 3;
    int su = F.vb;
    if (su >= nret) return;
    RetRaw R; ret_fetch(F, su, R);
    for (; su < nret; su += F.G) {
        bool isctx; int b, hh, n; ret_unit_decode(su, isctx, b, hh, n);
        const int row0 = isctx ? (b * CTXL + n * 128) : (NCTX + b * SEQ + n * 128);
        float lg2f, lg2b; ret_consts(F, l, hh, lg2f, lg2b);
        if (F.tid < 256) { float x1[8], x2[8]; rope_apply(F, R.kra, R.krb, khp, !isctx, n * 128 + ktok, x1, x2);
            const float ks = 0.17677669529663687f; u32x4 o;
            o.x = pk2(x1[0] * ks, x1[1] * ks); o.y = pk2(x1[2] * ks, x1[3] * ks); o.z = pk2(x1[4] * ks, x1[5] * ks); o.w = pk2(x1[6] * ks, x1[7] * ks); *(LAS u32x4*)(Kimg + ktok * 80 + 16 * khp) = o;
            o.x = pk2(x2[0] * ks, x2[1] * ks); o.y = pk2(x2[2] * ks, x2[3] * ks); o.z = pk2(x2[4] * ks, x2[5] * ks); o.w = pk2(x2[6] * ks, x2[7] * ks); *(LAS u32x4*)(Kimg + ktok * 80 + 32 + 16 * khp) = o; }
        *(LAS u32x4*)(Vimg + vtok * 144 + 32 * vch) = R.vra; *(LAS u32x4*)(Vimg + vtok * 144 + 32 * vch + 16) = R.vrb;
        bf16x8 qf[2], qd[2];
        { float x1[8], x2[8]; rope_apply(F, R.qra, R.qrb, h, !isctx, n * 128 + iq, x1, x2);
          const float dec = dir == 0 ? fast_exp2(lg2f * (float)(iq + 1)) : fast_exp2(lg2b * (float)(128 - iq));
          u32x4 w;
          w.x = pk2(x1[0], x1[1]); w.y = pk2(x1[2], x1[3]); w.z = pk2(x1[4], x1[5]); w.w = pk2(x1[6], x1[7]); qf[0] = __builtin_bit_cast(bf16x8, w);
          w.x = pk2(x2[0], x2[1]); w.y = pk2(x2[2], x2[3]); w.z = pk2(x2[4], x2[5]); w.w = pk2(x2[6], x2[7]); qf[1] = __builtin_bit_cast(bf16x8, w);
          w.x = pk2(x1[0] * dec, x1[1] * dec); w.y = pk2(x1[2] * dec, x1[3] * dec); w.z = pk2(x1[4] * dec, x1[5] * dec); w.w = pk2(x1[6] * dec, x1[7] * dec); qd[0] = __builtin_bit_cast(bf16x8, w);
          w.x = pk2(x2[0] * dec, x2[1] * dec); w.y = pk2(x2[2] * dec, x2[3] * dec); w.z = pk2(x2[4] * dec, x2[5] * dec); w.w = pk2(x2[6] * dec, x2[7] * dec); qd[1] = __builtin_bit_cast(bf16x8, w); }
        u32x2 gcur[8];
#pragma unroll
        for (int i = 0; i < 8; ++i) gcur[i] = R.gg[i];
        const float cf = fast_exp2(lg2f * 128.0f), cb = fast_exp2(lg2b * 128.0f);
        const float* SC = (const float*)(F.ws + WS_SUMCTX) + (size_t)((b * 4 + hh) * 2) * 2 * 2048;
        const float* SL = (const float*)(F.ws + WS_SUMLAT) + (size_t)((b * 4 + hh) * 16) * 2 * 2048;
        const int eo = 4 * F.tid;
        f32x4 t[16], c00, c10, c11, c01;
        if (!isctx) {
#pragma unroll
            for (int m = 0; m < 16; ++m) t[m] = *(const f32x4*)(SL + (size_t)(m * 2 + (m <= n ? 0 : 1)) * 2048 + eo);
            c00 = *(const f32x4*)(SC + (0 * 2 + 0) * 2048 + eo); c10 = *(const f32x4*)(SC + (1 * 2 + 0) * 2048 + eo);
            c11 = *(const f32x4*)(SC + (1 * 2 + 1) * 2048 + eo); c01 = *(const f32x4*)(SC + (0 * 2 + 1) * 2048 + eo);
        } else {
#pragma unroll
            for (int m = 0; m < 16; ++m) t[m] = (f32x4){0.f, 0.f, 0.f, 0.f};
            c00 = *(const f32x4*)(SC + (0 * 2 + 0) * 2048 + eo); c11 = *(const f32x4*)(SC + (1 * 2 + 1) * 2048 + eo); c10 = c00; c01 = c11;
        }
        __syncthreads();
        f32x16 o0, o1;
#pragma unroll
        for (int i = 0; i < 16; ++i) { o0[i] = 0.f; o1[i] = 0.f; }
        const float lgd = dir ? lg2b : lg2f;
        const int kt_lo = dir ? qb : 0, kt_hi = dir ? 3 : qb;
        for (int kt = kt_lo; kt <= kt_hi; ++kt) {
            f32x16 sc;
#pragma unroll
            for (int i = 0; i < 16; ++i) sc[i] = 0.f;
#pragma unroll
            for (int si = 0; si < 2; ++si) { const bf16x8 a = *(const LAS bf16x8*)(Kimg + (32 * kt + l32) * 80 + (16 * si + 8 * h) * 2); sc = MFMA32(a, qf[si], sc); }
            float pp[16];
#pragma unroll
            for (int i = 0; i < 16; ++i) { const int j = 32 * kt + crow(i, h); const int diff = dir ? (j - iq) : (iq - j); pp[i] = diff >= 0 ? sc[i] * fast_exp2(lgd * (float)diff) : 0.f; }
            bf16x8 pf[2];
#pragma unroll
            for (int s2 = 0; s2 < 2; ++s2) { u32x4 w; w.x = pk2(pp[8 * s2], pp[8 * s2 + 1]); w.y = pk2(pp[8 * s2 + 2], pp[8 * s2 + 3]); w.z = pk2(pp[8 * s2 + 4], pp[8 * s2 + 5]); w.w = pk2(pp[8 * s2 + 6], pp[8 * s2 + 7]); pf[s2] = __builtin_bit_cast(bf16x8, w); }
#pragma unroll
            for (int s2 = 0; s2 < 2; ++s2) { const int r0 = 32 * kt + 16 * s2 + 4 * h + q;
#pragma unroll
                for (int et = 0; et < 2; ++et) { const int cbo = (32 * et + 16 * grp + 4 * p) * 2;
                    const s16x4 lo = trread(Vimg + r0 * 144 + cbo), hi = trread(Vimg + (r0 + 8) * 144 + cbo);
                    const bf16x8 a = __builtin_shufflevector(lo, hi, 0, 1, 2, 3, 4, 5, 6, 7);
                    if (et == 0) o0 = MFMA32(a, pf[s2], o0); else o1 = MFMA32(a, pf[s2], o1); } }
        }
        { f32x4 sf = (f32x4){0.f, 0.f, 0.f, 0.f}, sb = sf;
          if (!isctx) {
              sf = c00 * cf + c10;
#pragma unroll
              for (int m = 0; m < 16; ++m) { const f32x4 nv = sf * cf + t[m]; sf = (m < n) ? nv : sf; }
              sb = c11 * cb + c01;
#pragma unroll
              for (int m = 15; m >= 0; --m) { const f32x4 nv = sb * cb + t[m]; sb = (m > n) ? nv : sb; }
          } else { if (n == 1) sf = c00; if (n == 0) sb = c11; }
          const int e = eo >> 5, d = eo & 31; u32x2 w;
          w.x = pk2(sf[0], sf[1]); w.y = pk2(sf[2], sf[3]); *(LAS u32x2*)(Stf + e * 80 + d * 2) = w;
          w.x = pk2(sb[0], sb[1]); w.y = pk2(sb[2], sb[3]); *(LAS u32x2*)(Stb + e * 80 + d * 2) = w; }
        __syncthreads();
        { LAS const unsigned char* St = dir ? Stb : Stf;
#pragma unroll
          for (int s2 = 0; s2 < 2; ++s2) { const bf16x8 a0 = *(const LAS bf16x8*)(St + l32 * 80 + (16 * s2 + 8 * h) * 2), a1 = *(const LAS bf16x8*)(St + (32 + l32) * 80 + (16 * s2 + 8 * h) * 2);
              o0 = MFMA32(a0, qd[s2], o0); o1 = MFMA32(a1, qd[s2], o1); } }
        if (su + F.G < nret) ret_fetch(F, su + F.G, R);
        float sm = 0.f;
#pragma unroll
        for (int i = 0; i < 16; ++i) sm += o0[i] + o1[i];
        sm += __shfl_xor(sm, 32);
        const float mu = sm * (1.0f / 64.0f);
        float vs = 0.f;
#pragma unroll
        for (int i = 0; i < 16; ++i) { const float d0 = o0[i] - mu, d1 = o1[i] - mu; vs += d0 * d0 + d1 * d1; }
        vs += __shfl_xor(vs, 32);
        const float rstd = 1.0f / sqrtf(vs * (1.0f / 64.0f) + EPS);
        const float* gn = F.in[I_RGNW] + l * 256 + 64 * hh;
        float val[32];
#pragma unroll
        for (int et = 0; et < 2; ++et)
#pragma unroll
            for (int gq = 0; gq < 4; ++gq) { const int e0 = 32 * et + 8 * gq + 4 * h; const u32x2 ggv = gcur[et * 4 + gq]; const f32x4 gw = *(const f32x4*)(gn + e0);
                const float g0 = bflo(ggv.x), g1 = bfhi(ggv.x), g2 = bflo(ggv.y), g3 = bfhi(ggv.y);
                const float a0 = et ? o1[4 * gq] : o0[4 * gq], a1 = et ? o1[4 * gq + 1] : o0[4 * gq + 1], a2 = et ? o1[4 * gq + 2] : o0[4 * gq + 2], a3 = et ? o1[4 * gq + 3] : o0[4 * gq + 3];
                val[et * 16 + 4 * gq] = (a0 - mu) * rstd * gw[0] * g0 * sigmoidf_(g0); val[et * 16 + 4 * gq + 1] = (a1 - mu) * rstd * gw[1] * g1 * sigmoidf_(g1);
                val[et * 16 + 4 * gq + 2] = (a2 - mu) * rstd * gw[2] * g2 * sigmoidf_(g2); val[et * 16 + 4 * gq + 3] = (a3 - mu) * rstd * gw[3] * g3 * sigmoidf_(g3); }
        if (dir == 0) {
#pragma unroll
            for (int et = 0; et < 2; ++et)
#pragma unroll
                for (int gq = 0; gq < 4; ++gq)
#pragma unroll
                    for (int j = 0; j < 4; ++j) Ob[iq * 65 + 32 * et + 8 * gq + 4 * h + j] = val[et * 16 + 4 * gq + j];
        }
        __syncthreads();
        if (dir == 1) { bf16* orow = YC + (size_t)(row0 + iq) * DM + 768 + 64 * hh;
#pragma unroll
            for (int et = 0; et < 2; ++et)
#pragma unroll
                for (int gq = 0; gq < 4; ++gq) { const int e0 = 32 * et + 8 * gq + 4 * h; float tt[4];
#pragma unroll
                    for (int j = 0; j < 4; ++j) tt[j] = val[et * 16 + 4 * gq + j] + Ob[iq * 65 + e0 + j];
                    u32x2 w; w.x = pk2(tt[0], tt[1]); w.y = pk2(tt[2], tt[3]); *(u32x2*)(orow + e0) = w; } }
        __syncthreads();
    }
}
#ifndef PROBE_SUB
#define PROBE_SUB 0
#endif
DI void cb_phase(Frame& F, int l) {
    rope_to_lds(F);
    const int nattn = l == 0 ? 1152 : 1024;
    for (int rep = 0; rep < ((PROBE_SUB & 1) ? 2 : 1); ++rep)
    for (int u = F.vb; u < nattn; u += F.G) {
        if (u < 1024) attn_unit(F, l, true, u >> 6, (u >> 3) & 7, u & 7);
        else { const int v = u - 1024; attn_unit(F, l, false, v >> 3, v & 7, 0); }
    }
    const int nret = l == 0 ? 1152 : 1024;
    for (int rep = 0; rep < ((PROBE_SUB & 2) ? 2 : 1); ++rep) ret_out_units(F, l, nret);
}

static_assert(sizeof(Params) == 240, "kernarg layout: in[26] at 0, out at 208, ws at 216, ph_lo at 224, ph_hi at 228");
#ifdef ONLY_PHASE
#define IN(k) ((k) == ONLY_PHASE && lo <= (k) && (k) < hi)
#else
#define IN(k) (lo <= (k) && (k) < hi)
#endif
#ifndef PROBE_MASK
#define PROBE_MASK 0u
#endif
#define NREP(k) (((PROBE_MASK >> (k)) & 1u) ? 2 : 1)
#define SEAM(k) do { if (IN(k) && IN((k) + 1)) { XcdBarrier bb_ = bar; asm volatile("" : "+s"(bb_.bar)); xcd_barrier(bb_, F.wave); } } while (0)
#define GLDS(P) ((LAS unsigned char*)(P).lds)
#define WSB(P, off) ((const pg8::bf16_t*)((P).ws + (off)))
template <int l> DI void layer_phases(Frame& F, const XcdBarrier& bar) {
    constexpr int lo = 0, hi = N_PHASES;
        const int pb = l == 0 ? 1 : 9;
        if (IN(pb + 0)) for (int rep_ = 0; rep_ < NREP(pb + 0); ++rep_) { if (rep_) __syncthreads(); Frame P = phase_frame(F); norm_phase(P, l, 1, l == 0, 0); } SEAM(pb + 0);
        if (IN(pb + 1)) for (int rep_ = 0; rep_ < NREP(pb + 1); ++rep_) { if (rep_) __syncthreads();
            Frame P = phase_frame(F);
            pg8::StaticOrder S; S.init(NTOK, INW, P.G, P.bid);
            pg8::EpiStoreBf16 E{(pg8::bf16_t*)(P.ws + WS_P), INW};
            pg8::gemm_phase<pg8::EpiStoreBf16, pg8::StaticOrder, pg8::RowsLinear, true>(GLDS(P), P.tid, WSB(P, WS_U), WSB(P, WS_WIN) + (size_t)l * INW * DM, 2 * DM, S, E, pg8::RowsLinear{});
            if (PROBE_SUB & 4) { __syncthreads(); pg8::gemm_phase<pg8::EpiNull, pg8::StaticOrder, pg8::RowsLinear, true>(GLDS(P), P.tid, WSB(P, WS_U), WSB(P, WS_WIN) + (size_t)l * INW * DM, 2 * DM, S, pg8::EpiNull{}, pg8::RowsLinear{}); }
            if (l == 0) bg_convert_tail(P, S.nwg, BG_B0, BG_D0); else bg_convert_tail(P, S.nwg, BG_B1, BG_CL);
        } SEAM(pb + 1);
        if (IN(pb + 2)) for (int rep_ = 0; rep_ < NREP(pb + 2); ++rep_) { if (rep_) __syncthreads(); Frame P = phase_frame(F); if (l == 1) { bg_convert_all(P, BG_CL, BG_ITEMS); __syncthreads(); } ca_phase(P, l); } SEAM(pb + 2);
        if (IN(pb + 3)) for (int rep_ = 0; rep_ < NREP(pb + 3); ++rep_) { if (rep_) __syncthreads(); Frame P = phase_frame(F); cb_phase(P, l); } SEAM(pb + 3);
        if (IN(pb + 4)) {
            Frame P = phase_frame(F);
            const int rb = l == 0 ? 0 : NCTX;
            const float* modlat = (const float*)(P.ws + WS_MODLAT) + (size_t)l * 16 * 6144;
            const float* modctx = (const float*)(P.ws + WS_MODCTX) + (size_t)l * 6144;
            float* hctx = (float*)(P.ws + WS_HCTX);
            pg8::StaticOrder S; S.init(NTOK - rb, DM, P.G, P.bid);
            pg8::EpiResGate E{l == 0 ? P.in[I_CTX] : hctx, l == 0 ? P.in[I_X] : P.out, hctx, P.out, modlat + 2 * DM, modctx + 2 * DM, rb};
            pg8::gemm_phase<pg8::EpiResGate, pg8::StaticOrder, pg8::RowsLinear, true>(GLDS(P), P.tid, WSB(P, WS_U) + (size_t)rb * DM, WSB(P, WS_WOUT) + (size_t)l * DM * DM, 2 * DM, S, E, pg8::RowsLinear{});
            if (l == 0) bg_convert_tail(P, S.nwg, BG_D0, BG_E0);
        } SEAM(pb + 4);
        if (l == 0) {
            if (IN(6)) for (int rep_ = 0; rep_ < NREP(6); ++rep_) { if (rep_) __syncthreads(); Frame P = phase_frame(F); norm_phase(P, 0, 2, false, 0, DENSE_FP8 == 1); } SEAM(6);
            if (IN(7)) for (int rep_ = 0; rep_ < NREP(7); ++rep_) { if (rep_) __syncthreads();
                Frame P = phase_frame(F);
                pg8::StaticOrder S; S.init(NTOK, 2 * DFF, P.G, P.bid);
                pg8::EpiSwiglu<false> E{(pg8::bf16_t*)(P.ws + WS_P), DFF, 0, nullptr};
#if DENSE_FP8 == 1
                pg8::gemm_phase<pg8::EpiSwiglu<false>, pg8::StaticOrder, pg8::RowsLinearOff, true, true>(GLDS(P), P.tid, WSB(P, WS_U), WSB(P, WS_WGU), DM, S, E, pg8::RowsLinearOff{}, SCL_U, SCL_WGU);
#else
                pg8::gemm_phase<pg8::EpiSwiglu<false>, pg8::StaticOrder, pg8::RowsLinear, true>(GLDS(P), P.tid, WSB(P, WS_U), WSB(P, WS_WGU), 2 * DM, S, E, pg8::RowsLinear{});
#endif
                bg_convert_tail(P, S.nwg, BG_E0, BG_F0);
            } SEAM(7);
            if (IN(8)) {
                Frame P = phase_frame(F);
                const float* modlat = (const float*)(P.ws + WS_MODLAT);
                const float* modctx = (const float*)(P.ws + WS_MODCTX);
                float* hctx = (float*)(P.ws + WS_HCTX);
                pg8::StaticOrder S; S.init(NTOK, DM, P.G, P.bid);
                pg8::EpiResGate E{hctx, P.out, hctx, P.out, modlat + 5 * DM, modctx + 5 * DM, 0};
#if DENSE_FP8
                pg8::gemm_phase<pg8::EpiResGate, pg8::StaticOrder, pg8::RowsLinearOff, true, true>(GLDS(P), P.tid, WSB(P, WS_P), WSB(P, WS_WD), DFF, S, E, pg8::RowsLinearOff{}, SCL_H, SCL_WD);
#else
                pg8::gemm_phase<pg8::EpiResGate, pg8::StaticOrder, pg8::RowsLinear, true>(GLDS(P), P.tid, WSB(P, WS_P), WSB(P, WS_WD), 2 * DFF, S, E, pg8::RowsLinear{});
#endif
                bg_convert_tail(P, S.nwg, BG_F0, BG_B1);
            } SEAM(8);
        } else {
            if (IN(14)) for (int rep_ = 0; rep_ < NREP(14); ++rep_) { if (rep_) __syncthreads(); Frame P = phase_frame(F); norm_moe_phase(P); } SEAM(14);
            if (IN(15)) for (int rep_ = 0; rep_ < NREP(15); ++rep_) { if (rep_) __syncthreads(); Frame P = phase_frame(F); moe_route_phase(P); } SEAM(15);
            LAS int* texp = (LAS int*)(F.lds + AUX_TAB);
            if (IN(16) || IN(17)) {
                Frame P = phase_frame(F);
                const int* meta = (const int*)(P.ws + WS_META);
                __syncthreads();
                for (int i = P.tid; i < 2 * MOE_TILES; i += 512) texp[i] = ld_i32_coherent(meta + (i / MOE_TILES) * 256 + 1 + (i % MOE_TILES));
                if (P.tid < 2) texp[2 * MOE_TILES + P.tid] = ld_i32_coherent(meta + P.tid * 256);
                __syncthreads();
            }
            if (IN(16)) for (int rep_ = 0; rep_ < NREP(16); ++rep_) { if (rep_) __syncthreads();
                Frame P = phase_frame(F);
                const int NT0 = __builtin_amdgcn_readfirstlane(texp[2 * MOE_TILES]), NT1 = __builtin_amdgcn_readfirstlane(texp[2 * MOE_TILES + 1]);
                pg8::MoeOrder S{NT0, NT1, 28, P.G, P.bid, (const LAS int*)texp};
                pg8::EpiSwiglu<true> E{(pg8::bf16_t*)(P.ws + WS_P), DFE, 28, (const float*)(P.ws + WS_PROW)};
                pg8::gemm_phase<pg8::EpiSwiglu<true>, pg8::MoeOrder, pg8::RowsGather, true, true>(GLDS(P), P.tid, WSB(P, WS_U), WSB(P, WS_MGU), DM, S, E, pg8::RowsGather{(const int*)(P.ws + WS_ROWMAP), 0}, SCL_U, SCL_WGU);
            } SEAM(16);
            if (IN(17)) {
                Frame P = phase_frame(F);
                const int NT0 = __builtin_amdgcn_readfirstlane(texp[2 * MOE_TILES]), NT1 = __builtin_amdgcn_readfirstlane(texp[2 * MOE_TILES + 1]);
                pg8::MoeOrder S{NT0, NT1, 4, P.G, P.bid, (const LAS int*)texp};
                pg8::EpiMoeScatter E{(const int*)(P.ws + WS_ROWMAP), (const float*)(P.ws + WS_PROW), (pg8::bf16_t*)(P.ws + WS_Y0), (pg8::bf16_t*)(P.ws + WS_U), 4};
                pg8::gemm_phase<pg8::EpiMoeScatter, pg8::MoeOrder, pg8::RowsLinearOff, true, true>(GLDS(P), P.tid, P.ws + WS_P, WSB(P, WS_MD), DFE, S, E, pg8::RowsLinearOff{}, SCL_H, SCL_WD);
            } SEAM(17);
        }
}
__global__ void __launch_bounds__(512, 2) fwd_kernel(Params prm) {
    extern __shared__ __attribute__((aligned(16))) unsigned char lds_raw[];
    Frame F;
    F.lds = (LAS unsigned char*)lds_raw;
    F.tid = threadIdx.x; F.lane = F.tid & 63; F.wave = __builtin_amdgcn_readfirstlane(F.tid >> 6);
    F.G = gridDim.x; F.bid = blockIdx.x; F.vb = F.bid;
    F.in.ka = (karg_t)__builtin_amdgcn_kernarg_segment_ptr(); F.out = prm.out; F.ws = prm.ws;
    volatile LAS unsigned* MISC = (volatile LAS unsigned*)(F.lds + AUX_OFF);
    if (F.tid < 64) MISC[F.tid] = 0u;
    __syncthreads();
    XcdBarrier bar; bar.bar = (unsigned*)(prm.ws + WS_CTL) + 1024; bar.x = 0; bar.st = nullptr;
#if MK_PER_PHASE
    const int lo = prm.ph_lo, hi = prm.ph_hi;
#else
    constexpr int lo = 0, hi = N_PHASES;
#endif
    if (hi - lo > 1) bar = xcd_barrier_post((unsigned*)(prm.ws + WS_CTL) + 1024, MISC + 8);

    if (IN(0)) for (int rep_ = 0; rep_ < NREP(0); ++rep_) { if (rep_) __syncthreads(); Frame P = phase_frame(F); p0_prologue(P); } SEAM(0);
    layer_phases<0>(F, bar);
    layer_phases<1>(F, bar);
    if (IN(PH_FINAL)) { Frame P = phase_frame(F); final_phase(P); }
#undef IN
#undef SEAM
}

extern "C" void kernel_launch(void* const* d_in, const int* in_sizes, int n_in, void* d_out, int out_size, void* d_ws, size_t ws_size, hipStream_t stream) {
    static int grid = 0;
    if (grid == 0) {
        if (n_in != 26 || in_sizes[0] != NLAT * DM || out_size != NLAT * DM || ws_size < WS_END) {
            fprintf(stderr, "kernel_launch: unexpected shapes (n_in %d, in0 %d, out %d, ws %zu, need %zu); nothing launched\n", n_in, n_in > 0 ? in_sizes[0] : -1, out_size, ws_size, (size_t)WS_END); grid = -1; return; }
        int dev = 0, cus = 0, per_cu = 0;
        if (hipGetDevice(&dev) != hipSuccess || hipDeviceGetAttribute(&cus, hipDeviceAttributeMultiprocessorCount, dev) != hipSuccess) { grid = -1; return; }
        if (hipFuncSetAttribute((const void*)fwd_kernel, hipFuncAttributeMaxDynamicSharedMemorySize, LDS_BYTES) != hipSuccess) { fprintf(stderr, "kernel_launch: hipFuncSetAttribute failed\n"); grid = -1; return; }
        if (hipOccupancyMaxActiveBlocksPerMultiprocessor(&per_cu, (const void*)fwd_kernel, 512, LDS_BYTES) != hipSuccess || per_cu < 1)
            fprintf(stderr, "kernel_launch: note: occupancy query reports %d workgroups per CU\n", per_cu);
        (void)hipGetLastError();
        grid = cus;
    }
    if (grid < 0) return;
    if (hipMemsetAsync((char*)d_ws + WS_CTL, 0, CTL_ZERO_BYTES, stream) != hipSuccess) return;
    Params p{};
    for (int i = 0; i < 26; ++i) p.in[i] = (const float*)d_in[i];
    p.out = (float*)d_out; p.ws = (unsigned char*)d_ws;
#if MK_PER_PHASE
    for (int ph = 0; ph < N_PHASES; ++ph) { p.ph_lo = ph; p.ph_hi = ph + 1; hipLaunchKernelGGL(fwd_kernel, dim3(grid), dim3(512), LDS_BYTES, stream, p); }
#else
    p.ph_lo = 0; p.ph_hi = N_PHASES;
    hipLaunchKernelGGL(fwd_kernel, dim3(grid), dim3(512), LDS_BYTES, stream, p);
#endif
}
```

```cpp
#include <hip/hip_runtime.h>
#include <cstdio>
#include <cstdint>

#ifndef PROBE_SUB
#define PROBE_SUB 0
#endif
#ifndef MK_PER_PHASE
#define MK_PER_PHASE 0
#endif

#ifndef STAG_B
#define STAG_B 0
#endif
#ifndef STAG_D
#define STAG_D 0
#endif
#ifndef STAG_E
#define STAG_E 0
#endif
#ifndef STAG_F
#define STAG_F 0
#endif
#ifndef STAG_EM
#define STAG_EM 0
#endif
#ifndef STAG_FM
#define STAG_FM 0
#endif
#define LAS __attribute__((address_space(3)))
#define GAS __attribute__((address_space(1)))
#define DI __device__ __forceinline__
typedef unsigned short bf16;
typedef short bf16x8 __attribute__((ext_vector_type(8)));
typedef short s16x4 __attribute__((ext_vector_type(4)));
typedef float f32x4 __attribute__((ext_vector_type(4)));
typedef float f32x16 __attribute__((ext_vector_type(16)));
typedef unsigned u32x4 __attribute__((ext_vector_type(4)));
typedef unsigned u32x2 __attribute__((ext_vector_type(2)));
typedef float f32x2_t __attribute__((ext_vector_type(2)));
typedef __bf16 bf16x2_t __attribute__((ext_vector_type(2)));
typedef short v4i16_t __attribute__((ext_vector_type(4)));

constexpr int DM = 1024, NB = 16, SEQ = 2048, CTXL = 256, GW = 64;
constexpr int NLAT = NB * SEQ, NCTX = NB * CTXL, NTOK = NLAT + NCTX;
constexpr int INW = 3072, DFF = 2816, NE = 8, DFE = 3584;
constexpr int C_NAQ = 0, C_NAK = 512, C_NAV = 1024, C_CONV = 1536, C_RQ = 2048, C_RK = 2176, C_RV = 2304, C_GF = 2560, C_GB = 2816;
constexpr float EPS = 1e-6f;
constexpr float LOG2E = 1.4426950408889634f;

constexpr size_t MiB = 1u << 20;
constexpr size_t WS_CTL = 0, CTL_ZERO_BYTES = 64 * 1024;
constexpr size_t WS_MODLAT = 1 * MiB;
constexpr size_t WS_MODCTX = WS_MODLAT + 2 * 16 * 6144 * 4;
constexpr size_t WS_ROPE = WS_MODCTX + 2 * 6144 * 4;
constexpr size_t WS_PTOK = 2 * MiB;
constexpr size_t WS_SEGCNT = WS_PTOK + 32768 * 2 * 4;
constexpr size_t WS_META = WS_SEGCNT + 256 * 2 * 8 * 4;
constexpr size_t WS_TAILF = 2 * MiB + 512 * 1024;
constexpr size_t WS_TAILCNT = 32 * 1024;
constexpr size_t WS_SEGLIST = 3 * MiB;
constexpr size_t WS_ROWMAP = 5 * MiB;
constexpr int MOE_ROWS = 34816;
constexpr int MOE_TILES = MOE_ROWS / 256;
constexpr size_t WS_PROW = WS_ROWMAP + 512 * 1024;
constexpr size_t WS_SUMLAT = 6 * MiB;
constexpr size_t WS_SUMCTX = 22 * MiB;
constexpr size_t WS_WIN = 24 * MiB;
constexpr size_t WS_WOUT = WS_WIN + (size_t)2 * 3072 * 1024 * 2;
constexpr size_t WS_WGU = WS_WOUT + (size_t)2 * 1024 * 1024 * 2;
constexpr size_t WS_WD = WS_WGU + (size_t)5632 * 1024 * 2;
constexpr size_t WS_MGU = WS_WD + (size_t)1024 * 2816 * 2;
constexpr size_t WS_MD = WS_MGU + (size_t)8 * 7168 * 1024;
constexpr size_t WS_Y0 = WS_MD + (size_t)8 * 1024 * 3584;
constexpr size_t WS_H = WS_Y0 + (size_t)NLAT * DM * 2;
constexpr size_t WS_U = WS_H + (size_t)NTOK * DM * 2;
constexpr size_t WS_P = WS_U + (size_t)NTOK * DM * 2;
constexpr size_t WS_END = WS_P + (size_t)MOE_ROWS * DFE * 2;
static_assert((size_t)NTOK * INW * 2 <= (size_t)MOE_ROWS * DFE * 2, "P region: px | dense hidden | fp8 hidden of both MoE slots (2 x MOE_ROWS x DFE bytes)");
static_assert(WS_WIN % 256 == 0 && WS_WOUT % 256 == 0 && WS_WGU % 256 == 0 && WS_WD % 256 == 0 && WS_MGU % 256 == 0 && WS_MD % 256 == 0 && WS_Y0 % 256 == 0 && WS_H % 256 == 0 && WS_U % 256 == 0 && WS_P % 256 == 0, "align");

constexpr int RING_BYTES = 131072;
constexpr int AUX_OFF = RING_BYTES;
constexpr int AUX_TAB = AUX_OFF + 1024;
constexpr int LDS_BYTES = 147456;

#ifndef MOE_FP8
#define MOE_FP8 1
#endif
static_assert(MOE_FP8 == 1, "the workspace map holds the MoE weights as fp8");
#ifndef DENSE_FP8
#define DENSE_FP8 2
#endif
constexpr int SCL_U = 0x7c7c7c7c, SCL_WGU = 0x79797979, SCL_H = 0x7c7c7c7c, SCL_WD = 0x78787878;
constexpr float QS_U = 8.0f, QS_WGU = 64.0f, QS_H = 8.0f, QS_WD = 128.0f;
DI unsigned pk2(float lo, float hi) { f32x2_t v = {lo, hi}; bf16x2_t b = __builtin_convertvector(v, bf16x2_t); return __builtin_bit_cast(unsigned, b); }
DI float clamp448(float x) { return __builtin_amdgcn_fmed3f(x, -448.0f, 448.0f); }
DI unsigned pk4_fp8(float a, float b, float c, float d) { int w = 0; w = __builtin_amdgcn_cvt_pk_fp8_f32(clamp448(a), clamp448(b), w, false); w = __builtin_amdgcn_cvt_pk_fp8_f32(clamp448(c), clamp448(d), w, true); return (unsigned)w; }
DI float bflo(unsigned u) { return __uint_as_float(u << 16); }
DI float bfhi(unsigned u) { return __uint_as_float(u & 0xffff0000u); }
DI float wave_sum(float v) {
#pragma unroll
    for (int o = 1; o < 64; o <<= 1) v += __shfl_xor(v, o);
    return v;
}
DI float fast_exp2(float x) { return __builtin_amdgcn_exp2f(x); }
DI float fast_rcp(float x) { return __builtin_amdgcn_rcpf(x); }
DI float sigmoidf_(float x) { return fast_rcp(1.0f + fast_exp2(-x * LOG2E)); }
DI int crow(int reg, int h) { return (reg & 3) + 8 * (reg >> 2) + 4 * h; }
#define MFMA32(a, b, c) __builtin_amdgcn_mfma_f32_32x32x16_bf16((a), (b), (c), 0, 0, 0)
DI s16x4 trread(LAS const unsigned char* p) { return __builtin_bit_cast(s16x4, __builtin_amdgcn_ds_read_tr16_b64_v4i16((LAS v4i16_t*)p)); }
DI int ld_i32_coherent(const int* p) { return (int)__hip_atomic_load((const unsigned*)p, __ATOMIC_RELAXED, __HIP_MEMORY_SCOPE_AGENT); }

namespace pg8 {
#define PG8_LAS __attribute__((address_space(3)))
typedef unsigned short bf16_t;
constexpr int BM = 256, BK = 64, HALF = 128, HTB = HALF * BK * 2, STAGE_BYTES = 8 * HTB, NXCD = 8, WGM = 8;
__host__ __device__ __forceinline__ int lds_byte(int r, int c) { const int st = (r >> 4) * 2 + (c >> 5), rr = r & 15, cc = c & 31, ob = rr * 64 + cc * 2; return st * 1024 + (ob ^ (((ob >> 9) & 1) << 5)); }
__host__ __device__ __forceinline__ void stage_rc(int b, int& R, int& C) { const int st = b / 1024, sb = b % 1024, swz = sb ^ (((sb >> 9) & 1) << 5); R = (st >> 1) * 16 + swz / 64; C = (st & 1) * 32 + (swz % 64) / 2; }
__host__ __device__ __forceinline__ int perm32(int rho) { const int n = rho >> 4, i = rho & 15; return 8 * (i >> 2) + 4 * n + (i & 3); }
struct Unit { int pm, pn; };
struct StaticOrder {
    static constexpr bool HOOK = false;
    int nM, nN, nwg, G, c;
    __device__ void init(int M, int N, int G_, int c_) { nM = M / BM; nN = N / BM; nwg = nM * nN; G = G_; c = c_; }
    __device__ bool next(int i, Unit& u) const {
        const long L = (long)i * G + c; if (L >= nwg) return false;
        int wgid = (int)L; { const int q = nwg / NXCD, r = nwg % NXCD, xcd = wgid % NXCD, off = wgid / NXCD; wgid = (xcd < r ? xcd * (q + 1) : r * (q + 1) + (xcd - r) * q) + off; }
        const int nig = WGM * nN, gid = wgid / nig, fm = gid * WGM, gsz = (nM - fm) < WGM ? (nM - fm) : WGM;
        u.pm = fm + ((wgid % nig) % gsz); u.pn = (wgid % nig) / gsz; return true;
    }
};
struct RowsLinear { static constexpr bool GATHER = false; };
struct RowsLinearOff {
    static constexpr bool GATHER = true;
    __device__ __forceinline__ void fetch(const Unit& u, const int (&R)[2], int (&raw)[2][2]) const {
#pragma unroll
        for (int h = 0; h < 2; ++h)
#pragma unroll
            for (int i = 0; i < 2; ++i) raw[h][i] = u.pm * BM + h * HALF + R[i];
    }
    __device__ __forceinline__ void make(const int (&raw)[2][2], const int (&C)[2], int pitch, unsigned (&o)[2][2]) const {
#pragma unroll
        for (int h = 0; h < 2; ++h)
#pragma unroll
            for (int i = 0; i < 2; ++i) { o[h][i] = (unsigned)raw[h][i] * (unsigned)pitch + (unsigned)C[i] * 2u; asm volatile("" : "+v"(o[h][i])); }
    }
};
struct RowsGather {
    static constexpr bool GATHER = true;
    const int* rowmap; int row_add;
    __device__ __forceinline__ void fetch(const Unit& u, const int (&R)[2], int (&raw)[2][2]) const {
#pragma unroll
        for (int h = 0; h < 2; ++h)
#pragma unroll
            for (int i = 0; i < 2; ++i) raw[h][i] = rowmap[u.pm * BM + h * HALF + R[i]];
    }
    __device__ __forceinline__ void make(const int (&raw)[2][2], const int (&C)[2], int pitch, unsigned (&o)[2][2]) const {
#pragma unroll
        for (int h = 0; h < 2; ++h)
#pragma unroll
            for (int i = 0; i < 2; ++i) { int t = raw[h][i]; t = t < 0 ? 0 : t; o[h][i] = (unsigned)((size_t)(t + row_add) * (size_t)pitch + (size_t)C[i] * 2u); }
#pragma unroll
        for (int h = 0; h < 2; ++h)
#pragma unroll
            for (int i = 0; i < 2; ++i) asm volatile("" : "+v"(o[h][i]));
    }
};

typedef int i32x8 __attribute__((ext_vector_type(8)));
typedef int i32x4v __attribute__((ext_vector_type(4)));
template <class Epi, class Sched, class ARows, bool ALIGN_EPI, bool FP8 = false>
__device__ __forceinline__ void gemm_phase(PG8_LAS unsigned char* lds, int tid, const void* A, const void* Bt, int pitch, const Sched& S, const Epi& E, const ARows& AR, int sclA = 0x7f7f7f7f, int sclB = 0x7f7f7f7f) {
    constexpr bool GATHER = ARows::GATHER;
    const int wid = __builtin_amdgcn_readfirstlane(tid >> 6), lane = tid & 63, wr = wid >> 2, wc = wid & 3, fr = lane & 15, fq = lane >> 4;
    const int nt = pitch / (BK * 2);
    int RA[2], CA[2]; unsigned voffA[2], voffB[2];
#pragma unroll
    for (int i = 0; i < 2; ++i) { int R, C; stage_rc(tid * 16 + i * 8192, R, C); const int Rb = Epi::PERM ? ((R & ~31) + perm32(R & 31)) : R;
        RA[i] = R; CA[i] = C; voffA[i] = (unsigned)(R * pitch + C * 2); voffB[i] = (unsigned)(Rb * pitch + C * 2); }
#pragma unroll
    for (int i = 0; i < 2; ++i) { asm volatile("" : "+v"(voffA[i])); asm volatile("" : "+v"(voffB[i])); }
    const size_t kstep = (size_t)(BK * 2);
    const size_t hstep = (size_t)HALF * pitch;
    const size_t tstep = 2 * hstep;
    const unsigned ldsw = (unsigned)wid * 1024u;
    const int aoff = lds_byte(wr * 64 + fr, fq * 8), boff = lds_byte(wc * 32 + fr, fq * 8);
    const char* Ab = (const char*)A;
#define PG8_SA(b, h) (((b) * 2 + (h)) * HTB)
#define PG8_SB(b, h) ((4 + (b) * 2 + (h)) * HTB)
#define PG8_STAGE(bufoff, gbase, voff) do { _Pragma("unroll") for (int _i = 0; _i < 2; ++_i) \
        __builtin_amdgcn_global_load_lds((const unsigned*)((const char*)(gbase) + (voff)[_i]), (PG8_LAS unsigned*)(lds + (bufoff) + ldsw + _i * 8192), 16, 0, 0); } while (0)
#define PG8_STAGEA(bufoff, h, plin, kb) do { if constexpr (GATHER) PG8_STAGE(bufoff, Ab + (kb), curA[h]); else PG8_STAGE(bufoff, (plin) + (h) * hstep, voffA); } while (0)
#define PG8_LDA(dst, b, h) do { _Pragma("unroll") for (int m = 0; m < 4; ++m) _Pragma("unroll") for (int k = 0; k < 2; ++k) dst[m][k] = *(const PG8_LAS bf16x8*)(lds + PG8_SA(b, h) + aoff + m * 2048 + k * 1024); } while (0)
#define PG8_LDB(dst, b, h) do { _Pragma("unroll") for (int n = 0; n < 2; ++n) _Pragma("unroll") for (int k = 0; k < 2; ++k) dst[n][k] = *(const PG8_LAS bf16x8*)(lds + PG8_SB(b, h) + boff + n * 2048 + k * 1024); } while (0)
#define PG8_CAT(x0, x1) __builtin_shufflevector(__builtin_bit_cast(i32x4v, x0), __builtin_bit_cast(i32x4v, x1), 0, 1, 2, 3, 4, 5, 6, 7)
#define PG8_MMA(ai, bj, At, Bt_) do { __builtin_amdgcn_s_setprio(1); \
        if constexpr (FP8) { _Pragma("unroll") for (int m = 0; m < 4; ++m) _Pragma("unroll") for (int n = 0; n < 2; ++n) \
            acc[ai][bj][m][n] = __builtin_amdgcn_mfma_scale_f32_16x16x128_f8f6f4(PG8_CAT(Bt_[n][0], Bt_[n][1]), PG8_CAT(At[m][0], At[m][1]), acc[ai][bj][m][n], 0, 0, 0, sclB, 0, sclA); } \
        else { _Pragma("unroll") for (int m = 0; m < 4; ++m) _Pragma("unroll") for (int n = 0; n < 2; ++n) _Pragma("unroll") for (int k = 0; k < 2; ++k) \
            acc[ai][bj][m][n] = __builtin_amdgcn_mfma_f32_16x16x32_bf16(Bt_[n][k], At[m][k], acc[ai][bj][m][n], 0, 0, 0); } \
        __builtin_amdgcn_s_setprio(0); } while (0)
#define PG8_WAIT_V(n) asm volatile("s_waitcnt vmcnt(" #n ")" ::: "memory")
#define PG8_WAIT_L(n) asm volatile("s_waitcnt lgkmcnt(" #n ")" ::: "memory")
#define PG8_BAR __builtin_amdgcn_s_barrier()
#define PG8_SCHED __builtin_amdgcn_sched_barrier(0)
    Unit cur, nxt; int ui = 0;
    if (!S.next(0, cur)) return;
    f32x4 acc[2][2][4][2];
#pragma unroll
    for (int a = 0; a < 2; ++a)
#pragma unroll
        for (int b = 0; b < 2; ++b)
#pragma unroll
            for (int m = 0; m < 4; ++m)
#pragma unroll
                for (int n = 0; n < 2; ++n) acc[a][b][m][n] = (f32x4){0.f, 0.f, 0.f, 0.f};
    bf16x8 At[4][2], B0[2][2], B1[2][2];
    unsigned curA[2][2] = {{0u, 0u}, {0u, 0u}}, nxtA[2][2] = {{0u, 0u}, {0u, 0u}};
    int rawN[2][2] = {{0, 0}, {0, 0}};
    if constexpr (GATHER) { int rawC[2][2]; AR.fetch(cur, RA, rawC); AR.make(rawC, CA, pitch, curA); Unit n1; if (S.next(1, n1)) AR.fetch(n1, RA, rawN); }
    const char* cA = GATHER ? Ab : Ab + (size_t)cur.pm * tstep;
    const char* cB = (const char*)Bt + (size_t)cur.pn * tstep;
    PG8_STAGE(PG8_SB(0, 0), cB, voffB); PG8_STAGE(PG8_SB(0, 1), cB + hstep, voffB); PG8_STAGEA(PG8_SA(0, 0), 0, cA, 0); PG8_STAGEA(PG8_SA(0, 1), 1, cA, 0);
    if (wr == 1) PG8_BAR;
    PG8_WAIT_V(2); PG8_BAR;
    PG8_STAGE(PG8_SB(1, 0), cB + kstep, voffB); PG8_STAGEA(PG8_SA(1, 0), 0, cA + kstep, kstep); PG8_STAGE(PG8_SB(1, 1), cB + hstep + kstep, voffB);
    PG8_WAIT_V(6); PG8_BAR;
    for (;;) {
        const bool has_next = S.next(ui + 1, nxt);
        if constexpr (GATHER) {
            if (has_next) { AR.make(rawN, CA, pitch, nxtA); Unit n2; if (S.next(ui + 2, n2)) AR.fetch(n2, RA, rawN); }
            else {
#pragma unroll
                for (int h = 0; h < 2; ++h)
#pragma unroll
                    for (int i = 0; i < 2; ++i) nxtA[h][i] = curA[h][i];
            }
        }
        const char* nA = GATHER ? Ab : (has_next ? Ab + (size_t)nxt.pm * tstep : cA);
        const char* nB = has_next ? (const char*)Bt + (size_t)nxt.pn * tstep : cB;
        for (int t = 0; t < nt; t += 2) {
            const bool last = (t == nt - 2);
            const size_t k1 = (size_t)(t + 1) * kstep, k2 = last ? 0 : (size_t)(t + 2) * kstep, k3 = k2 + kstep;
            const char* a1 = cA + k1;
            const char* a2 = last ? nA : cA + k2; const char* b2 = last ? nB : cB + k2;
            const char* a3 = a2 + kstep; const char* b3 = b2 + kstep;
            PG8_LDB(B0, 0, 0); PG8_LDB(B1, 0, 1); PG8_SCHED; PG8_LDA(At, 0, 0); PG8_STAGEA(PG8_SA(1, 1), 1, a1, k1);
            if constexpr (GATHER) { if (last) {
#pragma unroll
                for (int h = 0; h < 2; ++h)
#pragma unroll
                    for (int i = 0; i < 2; ++i) curA[h][i] = nxtA[h][i]; } }
            PG8_WAIT_V(8); PG8_WAIT_L(0); PG8_BAR; PG8_MMA(0, 0, At, B0); PG8_MMA(0, 1, At, B1); PG8_BAR; PG8_SCHED;
            PG8_LDA(At, 0, 1); PG8_STAGE(PG8_SB(0, 0), b2, voffB); PG8_STAGE(PG8_SB(0, 1), b2 + hstep, voffB); PG8_STAGEA(PG8_SA(0, 0), 0, a2, k2);
            PG8_WAIT_V(8); PG8_WAIT_L(0); PG8_BAR; PG8_MMA(1, 0, At, B0); PG8_MMA(1, 1, At, B1); PG8_BAR; PG8_SCHED;
            PG8_LDB(B0, 1, 0); PG8_LDB(B1, 1, 1); PG8_SCHED; PG8_LDA(At, 1, 0); PG8_STAGEA(PG8_SA(0, 1), 1, a2, k2);
            PG8_WAIT_V(8); PG8_WAIT_L(0); PG8_BAR; PG8_MMA(0, 0, At, B0); PG8_MMA(0, 1, At, B1); PG8_BAR; PG8_SCHED;
            PG8_LDA(At, 1, 1); PG8_STAGE(PG8_SB(1, 0), b3, voffB); PG8_STAGE(PG8_SB(1, 1), b3 + hstep, voffB); PG8_STAGEA(PG8_SA(1, 0), 0, a3, k3);
            PG8_WAIT_V(8); PG8_WAIT_L(0); PG8_BAR; PG8_MMA(1, 0, At, B0); PG8_MMA(1, 1, At, B1); PG8_BAR; PG8_SCHED;
        }
        if constexpr (ALIGN_EPI) { if (wr == 0) PG8_BAR; }
        E(acc, cur, wr, wc, fr, fq);
        if constexpr (Sched::HOOK) S.hook(ui, lane);
        if (!has_next) break;
#pragma unroll
        for (int a = 0; a < 2; ++a)
#pragma unroll
            for (int b = 0; b < 2; ++b)
#pragma unroll
                for (int m = 0; m < 4; ++m)
#pragma unroll
                    for (int n = 0; n < 2; ++n) acc[a][b][m][n] = (f32x4){0.f, 0.f, 0.f, 0.f};
        cur = nxt; cA = nA; cB = nB; ++ui;
        if constexpr (ALIGN_EPI) { if (wr == 1) PG8_BAR; }
    }
    PG8_WAIT_V(0);
    if constexpr (!ALIGN_EPI) { if (wr == 0) PG8_BAR; }
    PG8_BAR;
#undef PG8_SA
#undef PG8_SB
#undef PG8_STAGE
#undef PG8_STAGEA
#undef PG8_LDA
#undef PG8_LDB
#undef PG8_MMA
#undef PG8_CAT
#undef PG8_WAIT_V
#undef PG8_WAIT_L
#undef PG8_BAR
#undef PG8_SCHED
}

#define PG8_OPAQUE(x) asm volatile("" : "+v"(x))
struct EpiNull { static constexpr bool PERM = true; __device__ __forceinline__ void operator()(const f32x4 (&acc)[2][2][4][2], const Unit& u, int wr, int wc, int fr, int fq) const { if (u.pm < 0) {
#pragma unroll
        for (int a = 0; a < 2; ++a)
#pragma unroll
            for (int b = 0; b < 2; ++b)
#pragma unroll
                for (int m = 0; m < 4; ++m)
#pragma unroll
                    for (int n = 0; n < 2; ++n) asm volatile("" :: "v"(acc[a][b][m][n])); } } };
struct EpiStoreBf16 {
    static constexpr bool PERM = true;
    bf16_t* O; int ldc;
    __device__ __forceinline__ void operator()(const f32x4 (&acc)[2][2][4][2], const Unit& u, int wr, int wc, int fr, int fq) const {
        char* base = (char*)(O + (size_t)(u.pm * BM) * ldc + u.pn * BM);
        unsigned lb = (unsigned)((wr * 64 + fr) * ldc + wc * 32 + 8 * fq) * 2u; PG8_OPAQUE(lb);
        const unsigned rstep = (unsigned)ldc * 32u;
#pragma unroll
        for (int ai = 0; ai < 2; ++ai)
#pragma unroll
            for (int m = 0; m < 4; ++m) { const unsigned ro = lb + (unsigned)(ai * 8 + m) * rstep;
#pragma unroll
                for (int bj = 0; bj < 2; ++bj) { const f32x4 v0 = acc[ai][bj][m][0], v1 = acc[ai][bj][m][1];
                    u32x4 w; w.x = pk2(v0[0], v0[1]); w.y = pk2(v0[2], v0[3]); w.z = pk2(v1[0], v1[1]); w.w = pk2(v1[2], v1[3]);
                    *(u32x4*)(base + ro + bj * (HALF * 2)) = w; } }
    }
};
#ifndef RG_W32
#define RG_W32 3
#endif
#ifndef RG_W16
#define RG_W16 4
#endif
template <bool SRC32> struct EpiResGate {
    static constexpr bool PERM = true;
    const float* src_ctx; const float* src_lat; bf16_t* H; const float* gate_lat; const float* gate_ctx; int row_base;
    __device__ __forceinline__ void operator()(const f32x4 (&acc)[2][2][4][2], const Unit& u, int wr, int wc, int fr, int fq) const {
        const int rowu = row_base + u.pm * BM; const bool isctx = rowu < NCTX;
        char* dst = (char*)(H + (size_t)rowu * DM + u.pn * BM);
        const char* src = SRC32 ? (const char*)(isctx ? src_ctx + (size_t)rowu * DM : src_lat + (size_t)(rowu - NCTX) * DM) + u.pn * (BM * 4) : (const char*)dst;
        const float* gate = (isctx ? gate_ctx : gate_lat + (size_t)((rowu - NCTX) / SEQ) * 6144) + u.pn * BM;
        const int cl = wc * 32 + 8 * fq;
        constexpr int SB = SRC32 ? 4 : 2, NL = SRC32 ? 2 : 1, W = SRC32 ? RG_W32 : RG_W16;
        unsigned lb = (unsigned)((wr * 64 + fr) * DM + cl); PG8_OPAQUE(lb);
        u32x4 s[8][2][NL];
#define RG_ISSUE(g) do { _Pragma("unroll") for (int bj = 0; bj < 2; ++bj) _Pragma("unroll") for (int q = 0; q < NL; ++q) \
            s[g][bj][q] = *(const u32x4*)(src + (lb + (unsigned)(((g) >> 2) * 8 + ((g) & 3)) * (16u * DM) + (unsigned)(bj * HALF)) * SB + q * 16); } while (0)
#pragma unroll
        for (int g = 0; g < W; ++g) RG_ISSUE(g);
        f32x4 gvv[2][2];
#pragma unroll
        for (int bj = 0; bj < 2; ++bj)
#pragma unroll
            for (int n = 0; n < 2; ++n) gvv[bj][n] = *(const f32x4*)(gate + cl + bj * HALF + n * 4);
#pragma unroll
        for (int g = 0; g < 8; ++g) { const int ai = g >> 2, m = g & 3;
#pragma unroll
            for (int bj = 0; bj < 2; ++bj) { f32x4 r0, r1;
                if constexpr (SRC32) { r0 = __builtin_bit_cast(f32x4, s[g][bj][0]); r1 = __builtin_bit_cast(f32x4, s[g][bj][NL - 1]); }
                else { const u32x4 t = s[g][bj][0]; r0[0] = bflo(t.x); r0[1] = bfhi(t.x); r0[2] = bflo(t.y); r0[3] = bfhi(t.y); r1[0] = bflo(t.z); r1[1] = bfhi(t.z); r1[2] = bflo(t.w); r1[3] = bfhi(t.w); }
                r0 = r0 + acc[ai][bj][m][0] * gvv[bj][0]; r1 = r1 + acc[ai][bj][m][1] * gvv[bj][1];
                u32x4 w; w.x = pk2(r0[0], r0[1]); w.y = pk2(r0[2], r0[3]); w.z = pk2(r1[0], r1[1]); w.w = pk2(r1[2], r1[3]);
                *(u32x4*)(dst + (lb + (unsigned)((g >> 2) * 8 + (g & 3)) * (16u * DM) + (unsigned)(bj * HALF)) * 2u) = w; }
            if (g + W < 8) RG_ISSUE(g + W); }
#undef RG_ISSUE
    }
};
template <bool MOE> struct EpiSwiglu {
    static constexpr bool PERM = true;
    static constexpr bool OUT8 = MOE ? (MOE_FP8 != 0) : (DENSE_FP8 != 0);
    bf16_t* O; int ldc; int ncol; const float* prow;
    __device__ __forceinline__ void operator()(const f32x4 (&acc)[2][2][4][2], const Unit& u, int wr, int wc, int fr, int fq) const {
        const int pnl = MOE ? (u.pn % ncol) : u.pn;
        constexpr int ES = OUT8 ? 1 : 2;
        char* base = (char*)O + ((size_t)(u.pm * BM) * ldc + pnl * HALF) * ES;
        unsigned lb = (unsigned)((wr * 64 + fr) * ldc + wc * 32 + 8 * fq) * ES; PG8_OPAQUE(lb);
        const unsigned rstep = (unsigned)ldc * 16u * ES;
#pragma unroll
        for (int ai = 0; ai < 2; ++ai)
#pragma unroll
            for (int m = 0; m < 4; ++m) {
                const float pw = OUT8 ? QS_H : 1.0f;
                float hv[8];
#pragma unroll
                for (int n = 0; n < 2; ++n)
#pragma unroll
                    for (int jp = 0; jp < 2; ++jp) { const f32x2_t g = {acc[ai][0][m][n][2 * jp], acc[ai][0][m][n][2 * jp + 1]}, up = {acc[ai][1][m][n][2 * jp], acc[ai][1][m][n][2 * jp + 1]};
                        const f32x2_t a = g * (-LOG2E); f32x2_t d; d.x = fast_exp2(a.x); d.y = fast_exp2(a.y); d = d + 1.0f;
                        f32x2_t r; r.x = fast_rcp(d.x); r.y = fast_rcp(d.y);
                        const f32x2_t hh = (g * up) * (r * pw); hv[n * 4 + 2 * jp] = hh.x; hv[n * 4 + 2 * jp + 1] = hh.y; }
                if constexpr (OUT8) { u32x2 w; w.x = pk4_fp8(hv[0], hv[1], hv[2], hv[3]); w.y = pk4_fp8(hv[4], hv[5], hv[6], hv[7]);
                    *(u32x2*)(base + lb + (unsigned)(ai * 8 + m) * rstep) = w; }
                else { u32x4 w; w.x = pk2(hv[0], hv[1]); w.y = pk2(hv[2], hv[3]); w.z = pk2(hv[4], hv[5]); w.w = pk2(hv[6], hv[7]);
                    *(u32x4*)(base + lb + (unsigned)(ai * 8 + m) * rstep) = w; } }
    }
};
struct EpiMoeScatter {
    static constexpr bool PERM = false;
    const int* rowmap; const float* prow; bf16_t* y0; bf16_t* y1; int ncol;
    __device__ __forceinline__ void operator()(const f32x4 (&acc)[2][2][4][2], const Unit& u, int wr, int wc, int fr, int fq) const {
        const int pnl = u.pn % ncol;
        const int* rm = rowmap + u.pm * BM; const float* pr = prow + u.pm * BM;
        char* yb = (char*)(u.pm >= MOE_TILES ? y1 : y0) + pnl * (BM * 2);
        unsigned pl = (unsigned)(wr * 64 + fr) * 4u; PG8_OPAQUE(pl);
        unsigned cb = (unsigned)(wc * 32 + 4 * fq) * 2u; PG8_OPAQUE(cb);
        int tok[8]; float pw[8];
#pragma unroll
        for (int g = 0; g < 8; ++g) { tok[g] = *(const int*)((const char*)rm + pl + (unsigned)((g >> 2) * 8 + (g & 3)) * 64u); pw[g] = *(const float*)((const char*)pr + pl + (unsigned)((g >> 2) * 8 + (g & 3)) * 64u); }
#pragma unroll
        for (int g = 0; g < 8; ++g) { const int ai = g >> 2, m = g & 3;
            if (tok[g] >= 0) { const unsigned ro = (unsigned)tok[g] * (DM * 2u) + cb;
#pragma unroll
                for (int k = 0; k < 4; ++k) { const f32x4 t = acc[ai][k >> 1][m][k & 1] * pw[g]; u32x2 w; w.x = pk2(t[0], t[1]); w.y = pk2(t[2], t[3]);
                    *(u32x2*)(yb + ro + (unsigned)((k >> 1) * HALF + (k & 1) * 16) * 2u) = w; } } }
    }
};
struct MoeOrder {
    static constexpr bool HOOK = false;
    int NT0, NT1, ncol, G, c; const PG8_LAS int* texp;
    __device__ bool next(int i, Unit& u) const {
        const long L = (long)i * G + c; if (L >= (long)(NT0 + NT1) * ncol) return false;
        const int tq = (int)(L / ncol), pnl = (int)(L % ncol);
        const int T = tq < NT0 ? tq : MOE_TILES + tq - NT0;
        const int e = __builtin_amdgcn_readfirstlane(texp[T]);
        u.pm = T; u.pn = e * ncol + pnl; return true;
    }
};
struct MoeOrderHook : MoeOrder {
    static constexpr bool HOOK = true;
    int hook_ui; unsigned* cnt; unsigned* xcnt; unsigned nloc8;
    __device__ __forceinline__ void hook(int ui, int lane) const {
        if (ui == hook_ui) { asm volatile("s_waitcnt vmcnt(0)" ::: "memory");
            if (lane == 0) { const unsigned old = __hip_atomic_fetch_add(xcnt, 1u, __ATOMIC_RELAXED, __HIP_MEMORY_SCOPE_AGENT);
                if (old + 1u == nloc8) { __builtin_amdgcn_fence(__ATOMIC_RELEASE, "agent"); asm volatile("s_waitcnt vmcnt(0)" ::: "memory"); (void)__hip_atomic_fetch_add(cnt, nloc8, __ATOMIC_RELAXED, __HIP_MEMORY_SCOPE_AGENT); } } }
    }
};
}

#define XB_TMO      128
#define XB_XCNT(j)  (256  + 64 * (j))
#define XB_XSUB(j)  (1280 + 64 * (j))
#define XB_XGEN(j)  (2304 + 64 * (j))
#define XB_TOP      3328
#define XB_TOPGEN   3392
#define XCD_BAR_WORDS 3456
#define XB_SPIN_CAP (1u << 18)
DI unsigned xb_ld(unsigned* p)              { return __hip_atomic_load(p, __ATOMIC_RELAXED, __HIP_MEMORY_SCOPE_AGENT); }
DI unsigned xb_add(unsigned* p, unsigned v) { return __hip_atomic_fetch_add(p, v, __ATOMIC_RELAXED, __HIP_MEMORY_SCOPE_AGENT); }
DI unsigned xb_xcc_id() { return (unsigned)__builtin_amdgcn_s_getreg((3 << 11) | 20) & 0xFu; }
#define XB_SPIN(cond, bar) do { unsigned _sp = 0; while (cond) { __builtin_amdgcn_s_sleep(1); \
    if ((++_sp & 255u) == 0u) { if (xb_ld(&(bar)[XB_TMO])) break; if (_sp > XB_SPIN_CAP) { atomicAdd(&(bar)[XB_TMO], 1u); break; } } } } while (0)
struct XcdBarrier { unsigned* bar; unsigned x; volatile LAS unsigned* st; };
DI XcdBarrier xcd_barrier_post(unsigned* bar, volatile LAS unsigned* st) {
    XcdBarrier b; b.bar = bar; b.x = xb_xcc_id(); b.st = st;
    if (threadIdx.x == 0) (void)xb_add(&bar[XB_XCNT(b.x)], 1u);
    return b;
}
DI void xcd_barrier_complete(unsigned* bar, unsigned x, unsigned& nloc, unsigned& nx) {
    const unsigned G = gridDim.x * gridDim.y * gridDim.z;
    unsigned sum, cnt, mine, sp = 0u;
    for (;;) {
        sum = 0u; cnt = 0u; mine = 0u;
#pragma unroll
        for (unsigned j = 0; j < 16; ++j) { const unsigned c = xb_ld(&bar[XB_XCNT(j)]); sum += c; cnt += (c > 0u) ? 1u : 0u; mine = (j == x) ? c : mine; }
        if (sum == G) break;
        __builtin_amdgcn_s_sleep(1);
        if ((++sp & 255u) == 0u) { if (xb_ld(&bar[XB_TMO])) break; if (sp > XB_SPIN_CAP) { atomicAdd(&bar[XB_TMO], 1u); break; } }
    }
    nloc = mine > 0u ? mine : 1u; nx = cnt > 0u ? cnt : 1u;
}
DI void xcd_barrier(const XcdBarrier& b, int wave) {
    asm volatile("s_waitcnt vmcnt(0)" ::: "memory");
    __syncthreads();
    if (wave == 0 && __builtin_amdgcn_mbcnt_hi(~0u, __builtin_amdgcn_mbcnt_lo(~0u, 0u)) == 0u) {
        unsigned* bar = b.bar;
        __builtin_amdgcn_s_waitcnt(0);
        unsigned nloc = b.st[0], nx = b.st[1];
        if (nloc == 0u) { xcd_barrier_complete(bar, b.x, nloc, nx); b.st[0] = nloc; b.st[1] = nx; }
        const unsigned old = xb_add(&bar[XB_XSUB(b.x)], 1u);
        const unsigned gen = old / nloc;
        if (old + 1u == (gen + 1u) * nloc) {
            __builtin_amdgcn_fence(__ATOMIC_RELEASE, "agent");
            asm volatile("s_waitcnt vmcnt(0)" ::: "memory");
            const unsigned og = xb_add(&bar[XB_TOP], 1u);
            const unsigned tg = og / nx;
            if (og + 1u == (tg + 1u) * nx) xb_add(&bar[XB_TOPGEN], 1u);
            else XB_SPIN(xb_ld(&bar[XB_TOPGEN]) == tg, bar);
            __builtin_amdgcn_fence(__ATOMIC_ACQUIRE, "agent");
            xb_add(&bar[XB_XGEN(b.x)], 1u);
            asm volatile("s_waitcnt vmcnt(0)" ::: "memory");
        } else {
            XB_SPIN(xb_ld(&bar[XB_XGEN(b.x)]) == gen, bar);
            __builtin_amdgcn_fence(__ATOMIC_ACQUIRE, "agent");
            asm volatile("s_waitcnt vmcnt(0)" ::: "memory");
        }
    }
    __syncthreads();
}

struct Params { const float* in[26]; float* out; unsigned char* ws; int ph_lo, ph_hi, pad0, pad1; };
enum { I_X = 0, I_C, I_CTX, I_CCTX, I_WMOD, I_BMOD, I_N1W, I_N2W, I_WIN, I_WOUT, I_RPB, I_CONVW, I_CONVB, I_CLNW, I_CLNB, I_RDEC, I_RGNW,
       I_FG, I_FU, I_FD, I_MR, I_MRB, I_MG, I_MU, I_MDN, I_FNW };
constexpr int PH_P0 = 0, PH_FINAL = 18, N_PHASES = 19;

typedef __attribute__((address_space(4))) const unsigned char* karg_t;
struct KIn {
    karg_t ka;
    DI const float* operator[](int k) const { return *(const float* __attribute__((address_space(4))) const*)(ka + 8 * k); }
};
struct Frame {
    LAS unsigned char* lds;
    int tid, lane, wave, G, bid, vb;
    KIn in; float* out; unsigned char* ws;
};
DI Frame phase_frame(const Frame& F0) {
    Frame F; karg_t ka = F0.in.ka; asm volatile("" : "+s"(ka)); F.in.ka = ka;
    F.out = *(float* __attribute__((address_space(4))) const*)(ka + 208);
    F.ws = *(unsigned char* __attribute__((address_space(4))) const*)(ka + 216);
    int wv = F0.wave; asm volatile("" : "+s"(wv));
    int tid = (wv << 6) + (int)__builtin_amdgcn_mbcnt_hi(~0u, __builtin_amdgcn_mbcnt_lo(~0u, 0u)), G = F0.G, bid = F0.bid; unsigned ldsb = (unsigned)(size_t)F0.lds;
    asm volatile("" : "+v"(tid)); asm volatile("" : "+s"(G)); asm volatile("" : "+s"(bid)); asm volatile("" : "+s"(ldsb));
    F.tid = tid; F.lane = tid & 63; F.wave = __builtin_amdgcn_readfirstlane(tid >> 6); F.G = G; F.bid = bid; F.lds = (LAS unsigned char*)(size_t)ldsb;
    F.vb = (G % 8 == 0) ? (bid % 8) * (G / 8) + bid / 8 : bid;
    return F;
}

DI void p0_transpose_item(const float* W, int K, int N, bf16* WT, int k0, int n0, int dst_row0, LAS float* scr, int lane) {
#pragma unroll 8
    for (int i = 0; i < 32; ++i) { const int kk = 2 * i + (lane >> 5); scr[kk * 33 + (lane & 31)] = W[(size_t)(k0 + kk) * N + n0 + (lane & 31)]; }
    asm volatile("s_waitcnt lgkmcnt(0)" ::: "memory");
    const int c = lane & 7;
#pragma unroll
    for (int j = 0; j < 4; ++j) { const int n = (lane >> 3) + 8 * j; const LAS float* s = scr + (8 * c) * 33 + n;
        u32x4 o; o.x = pk2(s[0 * 33], s[1 * 33]); o.y = pk2(s[2 * 33], s[3 * 33]); o.z = pk2(s[4 * 33], s[5 * 33]); o.w = pk2(s[6 * 33], s[7 * 33]);
        *(u32x4*)(WT + (size_t)(dst_row0 + n) * K + k0 + 8 * c) = o; }
    asm volatile("s_waitcnt lgkmcnt(0)" ::: "memory");
}
DI void p0_convert_plain(Frame& F, const float* W, int K, int N, bf16* WT, int item, LAS float* scr) {
    const int nblk = N / 32, kb = item / nblk, nb = item % nblk;
    p0_transpose_item(W, K, N, WT, 64 * kb, 32 * nb, 32 * nb, scr, F.lane);
}
DI void p0_convert_gu(Frame& F, const float* W, int K, int N, bf16* WT, int item, int up, LAS float* scr) {
    const int nblk = N / 32, kb = item / nblk, nb = item % nblk, n0 = 32 * nb;
    p0_transpose_item(W, K, N, WT, 64 * kb, n0, 256 * (n0 / 128) + (n0 % 128) + (up ? 128 : 0), scr, F.lane);
}
DI void conv_item64(const float* W, int K, int N, bf16* WT, int k0, int n0, int dst_row0, LAS unsigned* scr, int lane) {
    const float* wp = W + (size_t)k0 * N + n0 + lane;
    float v[64];
#pragma unroll
    for (int i = 0; i < 64; ++i) v[i] = wp[(size_t)i * N];
#pragma unroll
    for (int i = 0; i < 32; ++i) scr[i * 65 + lane] = pk2(v[2 * i], v[2 * i + 1]);
    asm volatile("s_waitcnt lgkmcnt(0)" ::: "memory");
    const int c = lane & 7;
#pragma unroll
    for (int j = 0; j < 8; ++j) { const int n = (lane >> 3) + 8 * j; const LAS unsigned* sp = scr + (4 * c) * 65 + n;
        u32x4 o; o.x = sp[0]; o.y = sp[65]; o.z = sp[130]; o.w = sp[195];
        *(u32x4*)(WT + (size_t)(dst_row0 + n) * K + k0 + 8 * c) = o; }
    asm volatile("s_waitcnt lgkmcnt(0)" ::: "memory");
}
DI void conv_item64_fp8(const float* W, int K, int N, unsigned char* WT, int k0, int n0, int dst_row0, float qs, LAS unsigned* scr, int lane) {
    const float* wp = W + (size_t)k0 * N + n0 + lane;
    float v[64];
#pragma unroll
    for (int i = 0; i < 64; ++i) v[i] = wp[(size_t)i * N];
#pragma unroll
    for (int i = 0; i < 16; ++i) scr[i * 65 + lane] = pk4_fp8(v[4 * i] * qs, v[4 * i + 1] * qs, v[4 * i + 2] * qs, v[4 * i + 3] * qs);
    asm volatile("s_waitcnt lgkmcnt(0)" ::: "memory");
    const int c = lane & 3;
#pragma unroll
    for (int j = 0; j < 4; ++j) { const int n = (lane >> 2) + 16 * j; const LAS unsigned* sp = scr + (4 * c) * 65 + n;
        u32x4 o; o.x = sp[0]; o.y = sp[65]; o.z = sp[130]; o.w = sp[195];
        *(u32x4*)(WT + (size_t)(dst_row0 + n) * K + k0 + 16 * c) = o; }
    asm volatile("s_waitcnt lgkmcnt(0)" ::: "memory");
}
constexpr int BG_ITEMS = 21504;
constexpr int BG_B0 = 0, BG_D0 = 1200, BG_E0 = 5200, BG_F0 = 8700, BG_B1 = 17500, BG_CL = 18700;
DI void bg_item(Frame& F, int g, LAS unsigned* scr) {
    if (g < 14336) { const int m = g / 896, e = m >> 1, up = m & 1, r = g % 896, kb = r / 56, nb = r % 56, n0 = 64 * nb; const int drow = 256 * (n0 / 128) + (n0 % 128) + (up ? 128 : 0);
#if MOE_FP8
        conv_item64_fp8(F.in[up ? I_MU : I_MG] + (size_t)e * 1024 * 3584, 1024, 3584, F.ws + WS_MGU + (size_t)e * 7168 * 1024, 64 * kb, n0, drow, QS_WGU, scr, F.lane);
#else
        conv_item64(F.in[up ? I_MU : I_MG] + (size_t)e * 1024 * 3584, 1024, 3584, (bf16*)(F.ws + WS_MGU) + (size_t)e * 7168 * 1024, 64 * kb, n0, drow, scr, F.lane);
#endif
    } else { const int gg = g - 14336, e = gg / 896, r = gg % 896, kb = r / 16, nb = r % 16;
#if MOE_FP8
        conv_item64_fp8(F.in[I_MDN] + (size_t)e * 3584 * 1024, 3584, 1024, F.ws + WS_MD + (size_t)e * 1024 * 3584, 64 * kb, 64 * nb, 64 * nb, QS_WD, scr, F.lane);
#else
        conv_item64(F.in[I_MDN] + (size_t)e * 3584 * 1024, 3584, 1024, (bf16*)(F.ws + WS_MD) + (size_t)e * 1024 * 3584, 64 * kb, 64 * nb, 64 * nb, scr, F.lane);
#endif
    }
}
DI void bg_convert_tail(Frame& F, int nwg, int lo, int hi) {
    const int nmax = (nwg + F.G - 1) / F.G, rem = nwg - (nmax - 1) * F.G;
    if (F.bid < rem || rem >= F.G) return;
    LAS unsigned* scr = (LAS unsigned*)(F.lds + F.wave * 8320);
    const int w = (F.bid - rem) * 8 + F.wave, nw = (F.G - rem) * 8;
    for (int g = lo + w; g < hi; g += nw) bg_item(F, g, scr);
}
DI void bg_convert_all(Frame& F, int lo, int hi) {
    LAS unsigned* scr = (LAS unsigned*)(F.lds + F.wave * 8320);
    for (int g = lo + F.bid * 8 + F.wave; g < hi; g += F.G * 8) bg_item(F, g, scr);
}
DI void split_arrive(Frame& F, int slot);
DI void split_wait(Frame& F, int slot);
DI void p0_prologue(Frame& F) {
    {
        LAS float* Sx = (LAS float*)F.lds;
        LAS float* red = (LAS float*)(F.lds + 81920);
        bool staged = false;
        for (int unit = F.bid; unit < 192; unit += F.G) {
            if (!staged) {
                for (int idx = F.tid; idx < 17 * 1024; idx += 512) { const int r = idx / 1024, k = idx % 1024;
                    const float v = r < 16 ? F.in[I_C][r * 1024 + k] : F.in[I_CCTX][k]; Sx[k * 20 + r] = v * sigmoidf_(v); }
                staged = true; __syncthreads();
            }
            const int l = unit / 96, n0 = (unit % 96) * 64;
            const float* Wm = F.in[I_WMOD] + (size_t)l * 1024 * 6144 + n0 + F.lane;
            float acc[17];
#pragma unroll
            for (int r = 0; r < 17; ++r) acc[r] = 0.f;
            const int kb = F.wave * 128;
#pragma unroll 4
            for (int k = 0; k < 128; ++k) { const float wv = Wm[(size_t)(kb + k) * 6144]; const LAS float* sp = Sx + (kb + k) * 20;
                const f32x4 s0 = *(const LAS f32x4*)(sp), s1 = *(const LAS f32x4*)(sp + 4), s2 = *(const LAS f32x4*)(sp + 8), s3 = *(const LAS f32x4*)(sp + 12); const float s4 = sp[16];
                acc[0] += s0[0] * wv; acc[1] += s0[1] * wv; acc[2] += s0[2] * wv; acc[3] += s0[3] * wv; acc[4] += s1[0] * wv; acc[5] += s1[1] * wv; acc[6] += s1[2] * wv; acc[7] += s1[3] * wv;
                acc[8] += s2[0] * wv; acc[9] += s2[1] * wv; acc[10] += s2[2] * wv; acc[11] += s2[3] * wv; acc[12] += s3[0] * wv; acc[13] += s3[1] * wv; acc[14] += s3[2] * wv; acc[15] += s3[3] * wv;
                acc[16] += s4 * wv; }
#pragma unroll
            for (int r = 0; r < 17; ++r) red[(F.wave * 17 + r) * 64 + F.lane] = acc[r];
            __syncthreads();
            for (int idx = F.tid; idx < 17 * 64; idx += 512) { const int r = idx / 64, ln = idx % 64; float s = F.in[I_BMOD][l * 6144 + n0 + ln];
#pragma unroll
                for (int w = 0; w < 8; ++w) s += red[(w * 17 + r) * 64 + ln];
                if (r < 16) ((float*)(F.ws + WS_MODLAT))[((size_t)l * 16 + r) * 6144 + n0 + ln] = s; else ((float*)(F.ws + WS_MODCTX))[(size_t)l * 6144 + n0 + ln] = s; }
            __syncthreads();
        }
        __syncthreads();
    }
    if (F.bid == 0) { const int pos = F.tid >> 3, j = F.tid & 7; const float inv = exp2f(-(float)j * 0.125f * 13.287712379549449f); const float ang = (float)pos * inv;
        float* tab = (float*)(F.ws + WS_ROPE); tab[(pos * 8 + j) * 2] = cosf(ang); tab[(pos * 8 + j) * 2 + 1] = sinf(ang); }
    split_arrive(F, 3);
    {
        LAS float* scr = (LAS float*)(F.lds + F.wave * 16384);
        const int gw = F.bid * 8 + F.wave, NGW = F.G * 8;
        constexpr int I_IN = 16 * 96, I_OUT = 16 * 32, I_G = 16 * 88, I_D = 44 * 32, I_MGI = 16 * 112, I_MDI = 56 * 32;
        constexpr int NITEMS = 2 * I_IN + 2 * I_OUT + (DENSE_FP8 == 1 ? 3 * 704 : (DENSE_FP8 == 2 ? 2 * I_G + 704 : 2 * I_G + I_D));
        for (int it = gw; it < NITEMS; it += NGW) {
            int r = it;
            if (r < 2 * I_IN) { const int l = r / I_IN; p0_convert_plain(F, F.in[I_WIN] + (size_t)l * 1024 * 3072, 1024, 3072, (bf16*)(F.ws + WS_WIN) + (size_t)l * 3072 * 1024, r % I_IN, scr); continue; } r -= 2 * I_IN;
            if (r < 2 * I_OUT) { const int l = r / I_OUT; p0_convert_plain(F, F.in[I_WOUT] + (size_t)l * 1024 * 1024, 1024, 1024, (bf16*)(F.ws + WS_WOUT) + (size_t)l * 1024 * 1024, r % I_OUT, scr); continue; } r -= 2 * I_OUT;
#if DENSE_FP8 == 2
            if (r < I_G) { p0_convert_gu(F, F.in[I_FG], 1024, 2816, (bf16*)(F.ws + WS_WGU), r, 0, scr); continue; } r -= I_G;
            if (r < I_G) { p0_convert_gu(F, F.in[I_FU], 1024, 2816, (bf16*)(F.ws + WS_WGU), r, 1, scr); continue; } r -= I_G;
            { const int kb = r / 16, nb = r % 16; conv_item64_fp8(F.in[I_FD], 2816, 1024, F.ws + WS_WD, 64 * kb, 64 * nb, 64 * nb, QS_WD, (LAS unsigned*)scr, F.lane); }
#elif DENSE_FP8 == 1
            { LAS unsigned* scr8 = (LAS unsigned*)scr;
              if (r < 1408) { const int up = r / 704, q = r % 704, kb = q / 44, nb = q % 44, n0 = 64 * nb;
                  conv_item64_fp8(F.in[up ? I_FU : I_FG], 1024, 2816, F.ws + WS_WGU, 64 * kb, n0, 256 * (n0 / 128) + (n0 % 128) + (up ? 128 : 0), QS_WGU, scr8, F.lane); }
              else { const int q = r - 1408, kb = q / 16, nb = q % 16; conv_item64_fp8(F.in[I_FD], 2816, 1024, F.ws + WS_WD, 64 * kb, 64 * nb, 64 * nb, QS_WD, scr8, F.lane); } }
#else
            if (r < I_G) { p0_convert_gu(F, F.in[I_FG], 1024, 2816, (bf16*)(F.ws + WS_WGU), r, 0, scr); continue; } r -= I_G;
            if (r < I_G) { p0_convert_gu(F, F.in[I_FU], 1024, 2816, (bf16*)(F.ws + WS_WGU), r, 1, scr); continue; } r -= I_G;
            p0_convert_plain(F, F.in[I_FD], 2816, 1024, (bf16*)(F.ws + WS_WD), r, scr);
#endif
        }
    }
}

struct NormVecs { f32x4 gs[4], sh[4]; };
DI void norm_load_vecs(Frame& F, const float* g, const float* mod, int isc, int ish, NormVecs& V) {
#pragma unroll
    for (int j = 0; j < 4; ++j) { const f32x4 gv = ((const f32x4*)g)[F.lane + 64 * j], sv = ((const f32x4*)(mod + isc * DM))[F.lane + 64 * j]; V.gs[j] = gv * (sv + 1.0f); V.sh[j] = ((const f32x4*)(mod + ish * DM))[F.lane + 64 * j]; }
}
DI void norm_load_row(Frame& F, const float* srow, f32x4 (&v)[4]) {
    const f32x4* xr = (const f32x4*)srow + F.lane;
#pragma unroll
    for (int j = 0; j < 4; ++j) v[j] = xr[64 * j];
}
template <bool S16> struct RowRaw { f32x4 f[4]; };
template <> struct RowRaw<true> { u32x2 h[4]; };
template <bool S16> DI void row_request(Frame& F, const void* base, size_t row, RowRaw<S16>& r) {
    if constexpr (S16) { const u32x2* p = (const u32x2*)((const bf16*)base + row * DM) + F.lane;
#pragma unroll
        for (int j = 0; j < 4; ++j) r.h[j] = p[64 * j]; }
    else { const f32x4* p = (const f32x4*)((const float*)base + row * DM) + F.lane;
#pragma unroll
        for (int j = 0; j < 4; ++j) r.f[j] = p[64 * j]; }
}
template <bool S16> DI void row_get(const RowRaw<S16>& r, f32x4 (&v)[4]) {
#pragma unroll
    for (int j = 0; j < 4; ++j) { if constexpr (S16) { v[j].x = bflo(r.h[j].x); v[j].y = bfhi(r.h[j].x); v[j].z = bflo(r.h[j].y); v[j].w = bfhi(r.h[j].y); } else v[j] = r.f[j]; }
}
DI float norm_ssq(const f32x4 (&v)[4]) { float s = 0.f;
#pragma unroll
    for (int j = 0; j < 4; ++j) s += (v[j].x * v[j].x + v[j].y * v[j].y) + (v[j].z * v[j].z + v[j].w * v[j].w);
    return s; }
DI void norm_finish(Frame& F, const f32x4 (&v)[4], float ssq_total, const NormVecs& V, bf16* orow, f32x4 (&y)[4]) {
    const float rstd = 1.0f / sqrtf(ssq_total * (1.0f / DM) + EPS);
    u32x2* o8 = (u32x2*)orow + F.lane;
#pragma unroll
    for (int j = 0; j < 4; ++j) { y[j] = (v[j] * rstd) * V.gs[j] + V.sh[j]; u32x2 w; w.x = pk2(y[j].x, y[j].y); w.y = pk2(y[j].z, y[j].w); o8[64 * j] = w; }
}
DI void norm_finish8(Frame& F, const f32x4 (&v)[4], float ssq_total, const NormVecs& V, unsigned char* orow, f32x4 (&y)[4]) {
    const float rstd = 1.0f / sqrtf(ssq_total * (1.0f / DM) + EPS);
    unsigned* o4 = (unsigned*)orow + F.lane;
#pragma unroll
    for (int j = 0; j < 4; ++j) { y[j] = (v[j] * rstd) * V.gs[j] + V.sh[j]; o4[64 * j] = pk4_fp8(y[j].x * QS_U, y[j].y * QS_U, y[j].z * QS_U, y[j].w * QS_U); }
}
template <bool S16> DI void norm_pair(Frame& F, const void* sbase, int row, int send, const NormVecs& V, bf16* U, bool out8, const RowRaw<S16>& ca, const RowRaw<S16>& cb, RowRaw<S16>& na, RowRaw<S16>& nb) {
    const bool two = row + 1 < send;
    { const int nr = row + 2 < send ? row + 2 : row, nrb = row + 3 < send ? row + 3 : nr;
      row_request<S16>(F, sbase, (size_t)nr, na); row_request<S16>(F, sbase, (size_t)nrb, nb); }
    f32x4 va[4], vb[4]; row_get<S16>(ca, va); row_get<S16>(cb, vb);
    float sa = norm_ssq(va), sb = norm_ssq(vb);
#pragma unroll
    for (int o = 1; o < 64; o <<= 1) { sa += __shfl_xor(sa, o); sb += __shfl_xor(sb, o); }
    f32x4 y[4];
    if (out8) norm_finish8(F, va, sa, V, (unsigned char*)U + (size_t)row * DM, y); else norm_finish(F, va, sa, V, U + (size_t)row * DM, y);
    if (two) { if (out8) norm_finish8(F, vb, sb, V, (unsigned char*)U + (size_t)(row + 1) * DM, y); else norm_finish(F, vb, sb, V, U + (size_t)(row + 1) * DM, y); }
}
template <bool FIRST> DI void norm_phase(Frame& F, int l, int which, int row_lo, bool out8 = false) {
    constexpr bool S16 = !FIRST;
    const float* g = F.in[which == 1 ? I_N1W : I_N2W] + l * DM;
    const float* modlat = (const float*)(F.ws + WS_MODLAT) + (size_t)l * 16 * 6144;
    const float* modctx = (const float*)(F.ws + WS_MODCTX) + (size_t)l * 6144;
    const int ish = which == 1 ? 0 : 3, isc = which == 1 ? 1 : 4;
    bf16* U = (bf16*)(F.ws + WS_U);
    const int gw = F.bid * 8 + F.wave, NGW = F.G * 8;
    const int rpw = (NTOK - row_lo + NGW - 1) / NGW;
    const int r0 = row_lo + gw * rpw; int r1 = r0 + rpw; if (r1 > NTOK) r1 = NTOK;
    NormVecs V;
    for (int seg = r0; seg < r1;) {
        const int bk = seg < NCTX ? -1 : (seg - NCTX) / SEQ;
        int send = bk < 0 ? NCTX : NCTX + (bk + 1) * SEQ; if (send > r1) send = r1;
        norm_load_vecs(F, g, bk < 0 ? modctx : modlat + (size_t)bk * 6144, isc, ish, V);
        const void* sbase = FIRST ? (const void*)(bk < 0 ? F.in[I_CTX] : F.in[I_X] - (size_t)NCTX * DM) : (const void*)(F.ws + WS_H);
        RowRaw<S16> va, vb, wa, wb;
        row_request<S16>(F, sbase, (size_t)seg, va);
        row_request<S16>(F, sbase, (size_t)(seg + 1 < send ? seg + 1 : seg), vb);
        for (int row = seg; row < send; row += 4) {
            norm_pair<S16>(F, sbase, row, send, V, U, out8, va, vb, wa, wb);
            if (row + 2 < send) norm_pair<S16>(F, sbase, row + 2, send, V, U, out8, wa, wb, va, vb);
        }
        seg = send;
    }
}
DI void moe_route_row(Frame& F, const f32x4 (&y)[4], LAS const float* Rw, const float (&rb)[8], LAS int* sel, int tl, int tok) {
    float lg[8];
#pragma unroll
    for (int e = 0; e < 8; ++e) lg[e] = 0.f;
#pragma unroll
    for (int j = 0; j < 4; ++j)
#pragma unroll
        for (int q = 0; q < 4; ++q) { const int k = 256 * j + 4 * F.lane + q; const f32x4 r0 = *(const LAS f32x4*)(Rw + k * 8), r1 = *(const LAS f32x4*)(Rw + k * 8 + 4); const float yv = y[j][q];
            lg[0] += yv * r0[0]; lg[1] += yv * r0[1]; lg[2] += yv * r0[2]; lg[3] += yv * r0[3]; lg[4] += yv * r1[0]; lg[5] += yv * r1[1]; lg[6] += yv * r1[2]; lg[7] += yv * r1[3]; }
#pragma unroll
    for (int o = 1; o < 64; o <<= 1) {
#pragma unroll
        for (int e = 0; e < 8; ++e) lg[e] += __shfl_xor(lg[e], o); }
#pragma unroll
    for (int e = 0; e < 8; ++e) lg[e] += rb[e];
    int e1 = 0; float v1 = lg[0];
#pragma unroll
    for (int e = 1; e < 8; ++e) if (lg[e] > v1) { v1 = lg[e]; e1 = e; }
    int e2 = -1; float v2 = -3.0e38f;
#pragma unroll
    for (int e = 0; e < 8; ++e) if (e != e1 && lg[e] > v2) { v2 = lg[e]; e2 = e; }
    const float ex = __expf(v2 - v1), p1 = 1.0f / (1.0f + ex), p2 = ex / (1.0f + ex);
    if (F.lane == 0) { sel[tl * 2] = e1; sel[tl * 2 + 1] = e2; float* pt = (float*)(F.ws + WS_PTOK) + (size_t)tok * 2; pt[0] = p1; pt[1] = p2; ((int*)(F.ws + WS_TAILF))[tok] = 0; }
}
DI void norm_moe_phase(Frame& F) {
    const int l = 1;
    const float* g = F.in[I_N2W] + l * DM;
    const float* modlat = (const float*)(F.ws + WS_MODLAT) + (size_t)l * 16 * 6144;
    bf16* U = (bf16*)(F.ws + WS_U);
    LAS float* Rw = (LAS float*)F.lds;
    LAS int* sel = (LAS int*)(F.lds + 32768);
    for (int idx = F.tid; idx < 8192; idx += 512) Rw[idx] = F.in[I_MR][idx];
    __syncthreads();
    float rb[8];
#pragma unroll
    for (int e = 0; e < 8; ++e) rb[e] = F.in[I_MRB][e];
    NormVecs V; int curb = -2;
    for (int seg = F.bid; seg < 256; seg += F.G) {
        const int bk = (seg * 128) / SEQ; if (bk != curb) { norm_load_vecs(F, g, modlat + (size_t)bk * 6144, 4, 3, V); curb = bk; }
        for (int i = 0; i < 16; i += 2) {
            const int tl = F.wave * 16 + i, tok = seg * 128 + tl;
            f32x4 va[4], vb[4];
            { RowRaw<true> ra, rb2; row_request<true>(F, F.ws + WS_H, (size_t)(NCTX + tok), ra); row_request<true>(F, F.ws + WS_H, (size_t)(NCTX + tok + 1), rb2); row_get<true>(ra, va); row_get<true>(rb2, vb); }
            float sa = norm_ssq(va), sb = norm_ssq(vb);
#pragma unroll
            for (int o = 1; o < 64; o <<= 1) { sa += __shfl_xor(sa, o); sb += __shfl_xor(sb, o); }
            f32x4 y[4];
#if MOE_FP8
            norm_finish8(F, va, sa, V, (unsigned char*)U + (size_t)tok * DM, y); moe_route_row(F, y, Rw, rb, sel, tl, tok);
            norm_finish8(F, vb, sb, V, (unsigned char*)U + (size_t)(tok + 1) * DM, y); moe_route_row(F, y, Rw, rb, sel, tl + 1, tok + 1);
#else
            norm_finish(F, va, sa, V, U + (size_t)(NCTX + tok) * DM, y); moe_route_row(F, y, Rw, rb, sel, tl, tok);
            norm_finish(F, vb, sb, V, U + (size_t)(NCTX + tok + 1) * DM, y); moe_route_row(F, y, Rw, rb, sel, tl + 1, tok + 1);
#endif
        }
        __syncthreads();
        if (F.tid < 16) { const int s = F.tid >> 3, e = F.tid & 7; int cnt = 0; int* lst = (int*)(F.ws + WS_SEGLIST) + ((size_t)(seg * 2 + s) * 8 + e) * 128;
            for (int i = 0; i < 128; ++i) if (sel[i * 2 + s] == e) lst[cnt++] = seg * 128 + i;
            ((int*)(F.ws + WS_SEGCNT))[(seg * 2 + s) * 8 + e] = cnt; }
        __syncthreads();
    }
}
DI void moe_route_phase(Frame& F) {
    LAS int* cn = (LAS int*)F.lds;
    LAS int* offs = cn + 2048;
    LAS int* tb = offs + 256;
    LAS int* cn2 = tb + 32;
    for (int unit = F.bid; unit < 16; unit += F.G) {
        const int s = unit >> 3, e = unit & 7;
        const int* segcnt = (const int*)(F.ws + WS_SEGCNT);
        for (int idx = F.tid; idx < 2048; idx += 512) { const int ee = idx >> 8, gsg = idx & 255; cn[idx] = segcnt[(gsg * 2 + s) * 8 + ee]; cn2[idx] = segcnt[(gsg * 2 + (1 - s)) * 8 + ee]; }
        __syncthreads();
        if (F.tid < 8) { int tot = 0; for (int gsg = 0; gsg < 256; ++gsg) tot += cn[F.tid * 256 + gsg]; tb[16 + F.tid] = tot; }
        if (F.tid >= 128 && F.tid < 136) { int tot = 0; for (int gsg = 0; gsg < 256; ++gsg) tot += cn2[(F.tid - 128) * 256 + gsg]; tb[24 + F.tid - 128] = tot; }
        if (F.tid == 64) { int run = 0; for (int gsg = 0; gsg < 256; ++gsg) { offs[gsg] = run; run += cn[e * 256 + gsg]; } }
        __syncthreads();
        if (F.tid == 0) { int run = 0; for (int ee = 0; ee < 8; ++ee) { tb[ee] = run; run += (tb[16 + ee] + 255) / 256; } tb[8] = run;
            int ro = 0; for (int ee = 0; ee < 8; ++ee) ro += (tb[24 + ee] + 255) / 256; tb[9] = ro; }
        __syncthreads();
        const int NT0_ = s == 0 ? tb[8] : tb[9], NT1_ = s == 0 ? tb[9] : tb[8];
        const int tail_tq = (((NT0_ + NT1_) * 4 - 1) / F.G) * F.G / 4;
        const int tq_base = s == 0 ? 0 : NT0_;
        int* tailf = (int*)(F.ws + WS_TAILF);
        int* rowmap = (int*)(F.ws + WS_ROWMAP) + (size_t)s * MOE_ROWS;
        float* prow = (float*)(F.ws + WS_PROW) + (size_t)s * MOE_ROWS;
        const float* ptok = (const float*)(F.ws + WS_PTOK);
        const int base = tb[e] * 256, tot = tb[16 + e], ntile = (tot + 255) / 256;
        if (F.tid < 256) { const int gsg = F.tid; const int c = cn[e * 256 + gsg]; const int* lst = (const int*)(F.ws + WS_SEGLIST) + ((size_t)(gsg * 2 + s) * 8 + e) * 128;
            for (int i = 0; i < c; ++i) { const int tok = lst[i]; const int r = base + offs[gsg] + i; rowmap[r] = tok; prow[r] = ptok[(size_t)tok * 2 + s]; if (tq_base + (r >> 8) >= tail_tq) tailf[tok] = 1; } }
        for (int i = tot + F.tid; i < ntile * 256; i += 512) { rowmap[base + i] = -1; prow[base + i] = 0.f; }
        if (e == 0) { int* meta = (int*)(F.ws + WS_META) + s * 256;
            if (F.tid == 0) meta[0] = tb[8];
            if (F.tid < 8) { const int t0 = tb[F.tid], t1 = tb[F.tid + 1]; for (int t = t0; t < t1; ++t) meta[1 + t] = F.tid; } }
        __syncthreads();
    }
}
DI void final_rows(Frame& F, int r0, int r1, int want) {
    const float* g = F.in[I_FNW];
    const float* gate = (const float*)(F.ws + WS_MODLAT) + (size_t)16 * 6144 + 5 * DM;
    const bf16* y0 = (const bf16*)(F.ws + WS_Y0); const bf16* y1 = (const bf16*)(F.ws + WS_U);
    const int* tailf = (const int*)(F.ws + WS_TAILF);
    f32x4 gv[4], gt[4];
#pragma unroll
    for (int j = 0; j < 4; ++j) { gv[j] = ((const f32x4*)g)[F.lane + 64 * j]; gt[j] = gv[j]; }
    int curb = -1;
    for (int cb = r0; cb < r1; cb += 64) {
        const int n = r1 - cb < 64 ? r1 - cb : 64;
        bool take = F.lane < n;
        if (want >= 0) { const int fl = take ? tailf[cb + F.lane] : 0; take = take && (fl == want); }
        unsigned long long m = __ballot(take);
        while (m) {
            const int ia = __builtin_ctzll(m); m &= m - 1;
            const int row = cb + ia; int rowb = row; bool two = false;
            if (m) { const int ib = __builtin_ctzll(m); if ((cb + ib) / SEQ == row / SEQ) { rowb = cb + ib; two = true; m &= m - 1; } }
            const int bk = row / SEQ;
            if (bk != curb) { curb = bk;
#pragma unroll
                for (int j = 0; j < 4; ++j) gt[j] = ((const f32x4*)(gate + (size_t)bk * 6144))[F.lane + 64 * j]; }
            f32x4 va[4], vb[4]; u32x2 pa[4], pb[4], qa[4], qb[4];
            RowRaw<true> ha, hb; row_request<true>(F, F.ws + WS_H, (size_t)(NCTX + row), ha); row_request<true>(F, F.ws + WS_H, (size_t)(NCTX + rowb), hb);
#pragma unroll
            for (int j = 0; j < 4; ++j) { pa[j] = ((const u32x2*)(y0 + (size_t)row * DM))[F.lane + 64 * j]; qa[j] = ((const u32x2*)(y1 + (size_t)row * DM))[F.lane + 64 * j];
                pb[j] = ((const u32x2*)(y0 + (size_t)rowb * DM))[F.lane + 64 * j]; qb[j] = ((const u32x2*)(y1 + (size_t)rowb * DM))[F.lane + 64 * j]; }
            row_get<true>(ha, va); row_get<true>(hb, vb);
#pragma unroll
            for (int j = 0; j < 4; ++j) { f32x4 fa, fb;
                fa.x = bflo(pa[j].x) + bflo(qa[j].x); fa.y = bfhi(pa[j].x) + bfhi(qa[j].x); fa.z = bflo(pa[j].y) + bflo(qa[j].y); fa.w = bfhi(pa[j].y) + bfhi(qa[j].y);
                fb.x = bflo(pb[j].x) + bflo(qb[j].x); fb.y = bfhi(pb[j].x) + bfhi(qb[j].x); fb.z = bflo(pb[j].y) + bflo(qb[j].y); fb.w = bfhi(pb[j].y) + bfhi(qb[j].y);
                va[j] = va[j] + gt[j] * fa; vb[j] = vb[j] + gt[j] * fb; }
            float sa = norm_ssq(va), sb = norm_ssq(vb);
#pragma unroll
            for (int o = 1; o < 64; o <<= 1) { sa += __shfl_xor(sa, o); sb += __shfl_xor(sb, o); }
            const float ra = 1.0f / sqrtf(sa * (1.0f / DM) + EPS), rbv = 1.0f / sqrtf(sb * (1.0f / DM) + EPS);
            f32x4* xa = (f32x4*)(F.out + (size_t)row * DM) + F.lane; f32x4* xb = (f32x4*)(F.out + (size_t)rowb * DM) + F.lane;
#pragma unroll
            for (int j = 0; j < 4; ++j) xa[64 * j] = (va[j] * ra) * gv[j];
            if (two) {
#pragma unroll
                for (int j = 0; j < 4; ++j) xb[64 * j] = (vb[j] * rbv) * gv[j]; }
        }
    }
}
DI void moe_down_tail(int NT0, int NT1, int G, int& ilast, int& ntail) { const int total = (NT0 + NT1) * 4; ilast = (total - 1) / G; ntail = ilast > 0 ? total - ilast * G : G; }
DI void final_phase(Frame& F) {
    const int* meta = (const int*)(F.ws + WS_META);
    const int NT0 = __builtin_amdgcn_readfirstlane(ld_i32_coherent(meta)), NT1 = __builtin_amdgcn_readfirstlane(ld_i32_coherent(meta + 256));
    int ilast, ntail; moe_down_tail(NT0, NT1, F.G, ilast, ntail);
    const int gw = F.bid * 8 + F.wave, NGW = F.G * 8;
    const int rpw = (NLAT + NGW - 1) / NGW; const int r0 = gw * rpw; int r1 = r0 + rpw; if (r1 > NLAT) r1 = NLAT;
    if (r0 < r1) final_rows(F, r0, r1, ntail < F.G ? 1 : -1);
}
DI void final_overlap(Frame& F, int ntail, unsigned* cnt) {
    if (F.bid < ntail || ntail >= F.G) return;
    if (F.wave == 0 && __builtin_amdgcn_mbcnt_hi(~0u, __builtin_amdgcn_mbcnt_lo(~0u, 0u)) == 0u) {
        const unsigned target = (unsigned)F.G * 8u; unsigned sp = 0;
        while (__hip_atomic_load(cnt, __ATOMIC_RELAXED, __HIP_MEMORY_SCOPE_AGENT) < target) { __builtin_amdgcn_s_sleep(4); if (++sp > (1u << 22)) break; }
        __builtin_amdgcn_fence(__ATOMIC_ACQUIRE, "agent");
    }
    __syncthreads();
    const int NI = F.G - ntail, gw = (F.bid - ntail) * 8 + F.wave, NGW = NI * 8;
    const int rpw = (NLAT + NGW - 1) / NGW; const int r0 = gw * rpw; int r1 = r0 + rpw; if (r1 > NLAT) r1 = NLAT;
    if (r0 < r1) final_rows(F, r0, r1, 0);
}

DI void conv_unit(Frame& F, int l, int row0, int t0, int slen) {
    const bf16* PX = (const bf16*)(F.ws + WS_P);
    bf16* YC = (bf16*)(F.ws + WS_U);
    LAS float* Y = (LAS float*)F.lds;
    { u32x4 av[6], gv[6];
#pragma unroll
      for (int k = 0; k < 6; ++k) { const int it = F.tid + 512 * k; const int rr = it >> 5, cc = it & 31; int t = t0 - 15 + rr; t = t < 0 ? 0 : (t >= slen ? slen - 1 : t);
          const bf16* p = PX + (size_t)(row0 + t) * INW + C_CONV + 8 * cc; av[k] = *(const u32x4*)p; gv[k] = *(const u32x4*)(p + 256); }
      asm volatile("" : "+v"(av[0]), "+v"(av[1]), "+v"(av[2]), "+v"(av[3]), "+v"(av[4]), "+v"(av[5]), "+v"(gv[0]), "+v"(gv[1]), "+v"(gv[2]), "+v"(gv[3]), "+v"(gv[4]), "+v"(gv[5]));
#pragma unroll
      for (int k = 0; k < 6; ++k) { const int it = F.tid + 512 * k; const int rr = it >> 5, cc = it & 31; const int t = t0 - 15 + rr;
          if (it < 94 * 32) { f32x4 o0, o1;
              o0[0] = bflo(av[k].x) * sigmoidf_(bflo(gv[k].x)); o0[1] = bfhi(av[k].x) * sigmoidf_(bfhi(gv[k].x)); o0[2] = bflo(av[k].y) * sigmoidf_(bflo(gv[k].y)); o0[3] = bfhi(av[k].y) * sigmoidf_(bfhi(gv[k].y));
              o1[0] = bflo(av[k].z) * sigmoidf_(bflo(gv[k].z)); o1[1] = bfhi(av[k].z) * sigmoidf_(bfhi(gv[k].z)); o1[2] = bflo(av[k].w) * sigmoidf_(bflo(gv[k].w)); o1[3] = bfhi(av[k].w) * sigmoidf_(bfhi(gv[k].w));
              if (t < 0 || t >= slen) { o0 = (f32x4){0.f, 0.f, 0.f, 0.f}; o1 = o0; }
              *(LAS f32x4*)(Y + rr * 256 + 8 * cc) = o0; *(LAS f32x4*)(Y + rr * 256 + 8 * cc + 4) = o1; } } }
    __syncthreads();
    const int c = F.tid & 255, half = F.tid >> 8;
    float w[31];
#pragma unroll
    for (int k = 0; k < 31; ++k) w[k] = F.in[I_CONVW][(size_t)l * 31 * 256 + k * 256 + c];
    float acc[32];
    const float cb = F.in[I_CONVB][l * 256 + c];
#pragma unroll
    for (int o = 0; o < 32; ++o) acc[o] = cb;
#pragma unroll
    for (int kk = 0; kk < 62; ++kk) { const float yv = Y[(32 * half + kk) * 256 + c];
#pragma unroll
        for (int o = 0; o < 32; ++o) { const int tap = kk - o; if (tap >= 0 && tap < 31) acc[o] += yv * w[tap]; } }
    __syncthreads();
#pragma unroll
    for (int o = 0; o < 32; ++o) Y[(32 * half + o) * 256 + c] = acc[o];
    __syncthreads();
    const f32x4 lw = ((const f32x4*)(F.in[I_CLNW] + l * 256))[F.lane], lb = ((const f32x4*)(F.in[I_CLNB] + l * 256))[F.lane];
    for (int i = 0; i < 8; ++i) { const int tl = F.wave * 8 + i; const f32x4 v = *(const LAS f32x4*)(Y + tl * 256 + 4 * F.lane);
        const float mu = wave_sum((v.x + v.y) + (v.z + v.w)) * (1.0f / 256.0f); const f32x4 d = v - mu;
        const float var = wave_sum((d.x * d.x + d.y * d.y) + (d.z * d.z + d.w * d.w)) * (1.0f / 256.0f); const float rstd = 1.0f / sqrtf(var + EPS);
        f32x4 z = d * rstd * lw + lb; z.x *= sigmoidf_(z.x); z.y *= sigmoidf_(z.y); z.z *= sigmoidf_(z.z); z.w *= sigmoidf_(z.w);
        u32x2 o; o.x = pk2(z.x, z.y); o.y = pk2(z.z, z.w);
        *(u32x2*)(YC + (size_t)(row0 + t0 + tl) * DM + 512 + 4 * F.lane) = o; }
    __syncthreads();
}
DI void ret_consts(Frame& F, int l, int hh, float& lg2f, float& lg2b) {
    const float df = F.in[I_RDEC][(l * 2 + 0) * 4 + hh], db = F.in[I_RDEC][(l * 2 + 1) * 4 + hh];
    lg2f = log2f(1.0f - exp2f(-df)); lg2b = log2f(1.0f - exp2f(-db));
}
constexpr int ROPE_LDS = AUX_OFF + 4096;
DI void rope_to_lds(Frame& F) { const float* tab = (const float*)(F.ws + WS_ROPE); LAS float* rt = (LAS float*)(F.lds + ROPE_LDS); for (int i = F.tid; i < 1024; i += 512) rt[i] = tab[i]; __syncthreads(); }
DI void unpack8(const u32x4& a, float (&x)[8]) { x[0] = bflo(a.x); x[1] = bfhi(a.x); x[2] = bflo(a.y); x[3] = bfhi(a.y); x[4] = bflo(a.z); x[5] = bfhi(a.z); x[6] = bflo(a.w); x[7] = bfhi(a.w); }
DI void rope_apply(Frame& F, const u32x4& a, const u32x4& b, int hp, bool lat, int tg, float (&x1)[8], float (&x2)[8]) {
    unpack8(a, x1); unpack8(b, x2);
    if (lat) { const int pos = hp == 0 ? (tg >> 6) : (tg & 63); LAS const f32x4* tab = (LAS const f32x4*)(F.lds + ROPE_LDS) + pos * 4;
#pragma unroll
        for (int jj = 0; jj < 4; ++jj) { const f32x4 cs = tab[jj];
            { const float a1 = x1[2 * jj], a2 = x2[2 * jj]; x1[2 * jj] = a1 * cs[0] - a2 * cs[1]; x2[2 * jj] = a2 * cs[0] + a1 * cs[1]; }
            { const float a1 = x1[2 * jj + 1], a2 = x2[2 * jj + 1]; x1[2 * jj + 1] = a1 * cs[2] - a2 * cs[3]; x2[2 * jj + 1] = a2 * cs[2] + a1 * cs[3]; } } }
}
DI void ret_unit_decode(int su, bool& isctx, int& b, int& hh, int& n) {
    isctx = su >= 1024; if (!isctx) { b = su >> 6; hh = (su >> 4) & 3; n = su & 15; } else { const int v = su - 1024; b = v >> 3; hh = (v >> 1) & 3; n = v & 1; }
}
DI void ret_summary_pair(Frame& F, int l, int it) {
    const bf16* PX = (const bf16*)(F.ws + WS_P);
    const int sub = F.wave >> 2, st = F.tid & 255, su = 2 * it + sub;
    bool isctx; int b, hh, n; ret_unit_decode(su, isctx, b, hh, n);
    const int row0 = isctx ? (b * CTXL + n * 128) : (NCTX + b * SEQ + n * 128);
    float lg2f, lg2b; ret_consts(F, l, hh, lg2f, lg2b);
    LAS unsigned char* base = F.lds + sub * 40960;
    LAS unsigned char* Vimg = base;
    LAS unsigned char* Kf = base + 18432;
    LAS unsigned char* Kb = base + 18432 + 10240;
    { const int tok = st >> 1, hp = st & 1; float x1[8], x2[8];
      const bf16* kp = PX + (size_t)(row0 + tok) * INW + C_RK + 32 * hh; const bf16* vp = PX + (size_t)(row0 + tok) * INW + C_RV + 64 * hh + 32 * hp;
      const u32x4 kra = *(const u32x4*)(kp + 8 * hp), krb = *(const u32x4*)(kp + 16 + 8 * hp);
      u32x4 vr[4];
#pragma unroll
      for (int q = 0; q < 4; ++q) vr[q] = *(const u32x4*)(vp + 8 * q);
      rope_apply(F, kra, krb, hp, !isctx, n * 128 + tok, x1, x2);
      const float ks = 0.17677669529663687f;
      const float wf = fast_exp2(lg2f * (float)(127 - tok)) * ks, wb = fast_exp2(lg2b * (float)tok) * ks;
      u32x4 o;
      o.x = pk2(x1[0] * wf, x1[1] * wf); o.y = pk2(x1[2] * wf, x1[3] * wf); o.z = pk2(x1[4] * wf, x1[5] * wf); o.w = pk2(x1[6] * wf, x1[7] * wf); *(LAS u32x4*)(Kf + tok * 80 + 16 * hp) = o;
      o.x = pk2(x2[0] * wf, x2[1] * wf); o.y = pk2(x2[2] * wf, x2[3] * wf); o.z = pk2(x2[4] * wf, x2[5] * wf); o.w = pk2(x2[6] * wf, x2[7] * wf); *(LAS u32x4*)(Kf + tok * 80 + 32 + 16 * hp) = o;
      o.x = pk2(x1[0] * wb, x1[1] * wb); o.y = pk2(x1[2] * wb, x1[3] * wb); o.z = pk2(x1[4] * wb, x1[5] * wb); o.w = pk2(x1[6] * wb, x1[7] * wb); *(LAS u32x4*)(Kb + tok * 80 + 16 * hp) = o;
      o.x = pk2(x2[0] * wb, x2[1] * wb); o.y = pk2(x2[2] * wb, x2[3] * wb); o.z = pk2(x2[4] * wb, x2[5] * wb); o.w = pk2(x2[6] * wb, x2[7] * wb); *(LAS u32x4*)(Kb + tok * 80 + 32 + 16 * hp) = o;
#pragma unroll
      for (int q = 0; q < 4; ++q) *(LAS u32x4*)(Vimg + tok * 144 + 64 * hp + 16 * q) = vr[q]; }
    __syncthreads();
    { const int role = F.wave & 3, dir = role >> 1, et = role & 1;
      const int l32 = F.lane & 31, h = F.lane >> 5, grp = (F.lane >> 4) & 1, i16 = F.lane & 15, q = i16 >> 2, p = i16 & 3;
      LAS unsigned char* Kimg = dir ? Kb : Kf;
      f32x16 acc;
#pragma unroll
      for (int i = 0; i < 16; ++i) acc[i] = 0.f;
#pragma unroll
      for (int s = 0; s < 8; ++s) { const int r0 = 16 * s + 8 * h + q;
          const s16x4 alo = trread(Vimg + r0 * 144 + (32 * et + 16 * grp + 4 * p) * 2), ahi = trread(Vimg + (r0 + 4) * 144 + (32 * et + 16 * grp + 4 * p) * 2);
          const s16x4 blo = trread(Kimg + r0 * 80 + (16 * grp + 4 * p) * 2), bhi = trread(Kimg + (r0 + 4) * 80 + (16 * grp + 4 * p) * 2);
          const bf16x8 a = __builtin_shufflevector(alo, ahi, 0, 1, 2, 3, 4, 5, 6, 7), bb = __builtin_shufflevector(blo, bhi, 0, 1, 2, 3, 4, 5, 6, 7);
          acc = MFMA32(a, bb, acc); }
      float* S = isctx ? (float*)(F.ws + WS_SUMCTX) + ((size_t)((b * 4 + hh) * 2 + n) * 2 + dir) * 2048 : (float*)(F.ws + WS_SUMLAT) + ((size_t)((b * 4 + hh) * 16 + n) * 2 + dir) * 2048;
#pragma unroll
      for (int i = 0; i < 16; ++i) S[(32 * et + crow(i, h)) * 32 + l32] = acc[i]; }
    __syncthreads();
}
DI void ca_phase(Frame& F, int l) {
    rope_to_lds(F);
    const int nconv = l == 0 ? 576 : 512;
    for (int u = F.vb; u < nconv; u += F.G) {
        int v = u; if (l != 0) v += 64;
        if (v < 64) conv_unit(F, l, (v >> 2) * CTXL, (v & 3) * 64, CTXL);
        else { v -= 64; conv_unit(F, l, NCTX + (v >> 5) * SEQ, (v & 31) * 64, SEQ); }
    }
    for (int it = (F.vb + F.G - (nconv % F.G)) % F.G; it < 576; it += F.G) ret_summary_pair(F, l, it);
}
DI void split_arrive(Frame& F, int slot);
DI void split_wait(Frame& F, int slot);

constexpr int ATT_KV = 18432, ATT_BUF = 2 * ATT_KV, ATT_BT = 2 * ATT_BUF, ATT_NEG = 640;
struct AttRegs { u32x4 k0, v0, k1, v1; };
DI void attn_fetch(const bf16* PX, int rowA, int rowB, unsigned loff, AttRegs& R) {
    const char* pa = (const char*)(PX + (size_t)rowA * INW) + loff; const char* pb = (const char*)(PX + (size_t)rowB * INW) + loff;
    R.k0 = *(const u32x4*)(pa + C_NAK * 2); R.v0 = *(const u32x4*)(pa + C_NAV * 2); R.k1 = *(const u32x4*)(pb + C_NAK * 2); R.v1 = *(const u32x4*)(pb + C_NAV * 2);
}
DI void attn_put(Frame& F, LAS unsigned char* buf, const AttRegs& R) {
    const int key = F.tid >> 3, ch = F.tid & 7;
    *(LAS u32x4*)(buf + key * 144 + 16 * ch) = R.k0; *(LAS u32x4*)(buf + ATT_KV + key * 144 + 16 * ch) = R.v0;
    *(LAS u32x4*)(buf + (64 + key) * 144 + 16 * ch) = R.k1; *(LAS u32x4*)(buf + ATT_KV + (64 + key) * 144 + 16 * ch) = R.v1;
}
template <bool BIAS, int NT>
DI void attn_tiles(LAS const unsigned char* buf, const int (&koff)[2], const bf16x8 (&qf)[4], f32x16& o0, f32x16& o1, f32x16& o2, float& mrun, int lane,
                   LAS const float* const (&bt)[2]  , const float (&pen)[16]) {
    LAS const unsigned char* Kimg = buf; LAS const unsigned char* Vimg = buf + ATT_KV;
    const int l32 = lane & 31, h = lane >> 5, grp = (lane >> 4) & 1, i16 = lane & 15, q = i16 >> 2, p = i16 & 3;
    f32x16 s[NT];
#pragma unroll
    for (int t = 0; t < NT; ++t)
#pragma unroll
        for (int i = 0; i < 16; ++i) s[t][i] = 0.f;
#pragma unroll
    for (int si = 0; si < 4; ++si)
#pragma unroll
        for (int t = 0; t < NT; ++t) { const bf16x8 a = *(const LAS bf16x8*)(Kimg + (koff[t] + l32) * 144 + (16 * si + 8 * h) * 2); s[t] = MFMA32(a, qf[si], s[t]); }
    const float c = 0.125f * LOG2E;
    float v[NT][16]; float mx = -1.0e30f;
#pragma unroll
    for (int t = 0; t < NT; ++t)
#pragma unroll
        for (int i = 0; i < 16; ++i) { float x;
            if (BIAS) x = __builtin_fmaf(s[t][i], c, bt[t][(i & 3) + 8 * (i >> 2)]) + pen[i]; else x = s[t][i];
            v[t][i] = x; mx = fmaxf(mx, x); }
    if (!BIAS) mx *= c;
    mx = fmaxf(mx, __shfl_xor(mx, 32));
    const float mnew = fmaxf(mrun, mx);
    const float alpha = fast_exp2(mrun - mnew);
    if (__any(alpha != 1.0f)) {
#pragma unroll
        for (int i = 0; i < 16; ++i) { o0[i] *= alpha; o1[i] *= alpha; o2[i] *= alpha; } }
    mrun = mnew;
    bf16x8 pf[NT][2];
#pragma unroll
    for (int t = 0; t < NT; ++t) { float pp[16];
#pragma unroll
        for (int i = 0; i < 16; ++i) pp[i] = BIAS ? fast_exp2(v[t][i] - mnew) : fast_exp2(__builtin_fmaf(v[t][i], c, -mnew));
#pragma unroll
        for (int s2 = 0; s2 < 2; ++s2) { u32x4 w; w.x = pk2(pp[8 * s2], pp[8 * s2 + 1]); w.y = pk2(pp[8 * s2 + 2], pp[8 * s2 + 3]); w.z = pk2(pp[8 * s2 + 4], pp[8 * s2 + 5]); w.w = pk2(pp[8 * s2 + 6], pp[8 * s2 + 7]); pf[t][s2] = __builtin_bit_cast(bf16x8, w); } }
    const u32x4 onesw = (u32x4){0x3f803f80u, 0x3f803f80u, 0x3f803f80u, 0x3f803f80u}; const bf16x8 ones = __builtin_bit_cast(bf16x8, onesw);
#pragma unroll
    for (int t = 0; t < NT; ++t)
#pragma unroll
        for (int s2 = 0; s2 < 2; ++s2) { const int r0 = koff[t] + 16 * s2 + 4 * h + q;
#pragma unroll
            for (int et = 0; et < 2; ++et) { const int cb = (32 * et + 16 * grp + 4 * p) * 2;
                const s16x4 lo = trread(Vimg + r0 * 144 + cb), hi = trread(Vimg + (r0 + 8) * 144 + cb);
                const bf16x8 a = __builtin_shufflevector(lo, hi, 0, 1, 2, 3, 4, 5, 6, 7);
                if (et == 0) o0 = MFMA32(a, pf[t][s2], o0); else o1 = MFMA32(a, pf[t][s2], o1); }
            o2 = MFMA32(ones, pf[t][s2], o2); }
}
DI void attn_unit(Frame& F, int l, bool na, int b, int hh, int rg) {
    const bf16* PX = (const bf16*)(F.ws + WS_P);
    bf16* YC = (bf16*)(F.ws + WS_U);
    LAS float* btab = (LAS float*)(F.lds + ATT_BT);
    const int l32 = F.lane & 31, h = F.lane >> 5;
    int qrow, r = 0, qcol = 0, kc0 = 0, ra = 0;
    float pen[16];
#pragma unroll
    for (int i = 0; i < 16; ++i) pen[i] = 0.f;
    if (na) { const int rp = F.wave >> 2, n = F.wave & 3; ra = 4 * rg + 2 * rp; r = ra + (l32 >> 4); qcol = 16 * n + (l32 & 15); qrow = NCTX + b * SEQ + r * GW + qcol;
        int w0 = qcol - 8; w0 = w0 < 0 ? 0 : (w0 > 48 ? 48 : w0); kc0 = 16 * n - 8; kc0 = kc0 < 0 ? 0 : (kc0 > 32 ? 32 : kc0);
#pragma unroll
        for (int i = 0; i < 16; ++i) pen[i] = ((unsigned)(kc0 + crow(i, h) - w0) < 16u) ? 0.f : -1.0e30f; }
    else qrow = b * CTXL + 32 * F.wave + l32;
    bf16x8 qf[4];
#pragma unroll
    for (int si = 0; si < 4; ++si) qf[si] = *(const bf16x8*)(PX + (size_t)qrow * INW + C_NAQ + 64 * hh + 16 * si + 8 * h);
    if (na) { for (int idx = F.tid; idx < ATT_NEG + 128; idx += 512) { float v = 0.f; if (idx >= 48 && idx < 48 + 465) v = F.in[I_RPB][((size_t)l * 8 + hh) * 465 + (idx - 48)] * LOG2E; if (idx >= ATT_NEG) v = -1.0e30f; btab[idx] = v; } }
    f32x16 o0, o1, o2;
#pragma unroll
    for (int i = 0; i < 16; ++i) { o0[i] = 0.f; o1[i] = 0.f; o2[i] = 0.f; }
    float mrun = -1.0e30f;
    int ylo = 0, yhi = 0, nsteps = 2;
    if (na) { const int rlo = 4 * rg, rhi = 4 * rg + 3;
        ylo = rlo - 4; ylo = ylo < 0 ? 0 : (ylo > 24 ? 24 : ylo);
        yhi = rhi - 4; yhi = yhi < 0 ? 0 : (yhi > 24 ? 24 : yhi); yhi += 8; nsteps = 2 + (yhi - ylo + 1) / 2; }
    int sa = ra - 4; sa = sa < 0 ? 0 : (sa > 24 ? 24 : sa);
    int sb = ra + 1 - 4; sb = sb < 0 ? 0 : (sb > 24 ? 24 : sb);
    const int mylo = (l32 >> 4) ? sb : sa;
    const int cbase = kc0 + 4 * h - qcol + 15;
#define ATT_ROWA(sx) ((sx) < 2 ? b * CTXL + 128 * (sx) : NCTX + b * SEQ + (ylo + 2 * ((sx) - 2)) * GW)
#define ATT_ROWB(sx) ((sx) < 2 ? b * CTXL + 128 * (sx) + 64 : NCTX + b * SEQ + ((ylo + 2 * ((sx) - 2) + 1) < yhi ? (ylo + 2 * ((sx) - 2) + 1) : (yhi - 1)) * GW)
    AttRegs R;
    unsigned loff = (unsigned)(((F.tid >> 3) * INW + 64 * hh + 8 * (F.tid & 7)) * 2); asm volatile("" : "+v"(loff));
    attn_fetch(PX, ATT_ROWA(0), ATT_ROWB(0), loff, R);
    for (int st = 0; st < nsteps; ++st) {
        LAS unsigned char* buf = F.lds + (st & 1) * ATT_BUF;
        attn_put(F, buf, R);
        if (st + 1 < nsteps) attn_fetch(PX, ATT_ROWA(st + 1), ATT_ROWB(st + 1), loff, R);
        __syncthreads();
        if (st < 2) {
            LAS const float* const bt[2] = {btab, btab};
            { const int ko[2] = {0, 32}; attn_tiles<false, 2>(buf, ko, qf, o0, o1, o2, mrun, F.lane, bt, pen); }
            { const int ko[2] = {64, 96}; attn_tiles<false, 2>(buf, ko, qf, o0, o1, o2, mrun, F.lane, bt, pen); }
        } else {
            const int y0 = ylo + 2 * (st - 2), y1 = y0 + 1;
            const bool act0 = (y0 >= sa && y0 < sb + 8), act1 = (y1 < yhi && y1 >= sa && y1 < sb + 8);
            const bool ok0 = (unsigned)(y0 - mylo) < 8u, ok1 = (unsigned)(y1 - mylo) < 8u;
            LAS const float* b0 = btab + (ok0 ? 48 + (y0 - r + 7) * 31 + cbase : ATT_NEG);
            LAS const float* b1 = btab + (ok1 ? 48 + (y1 - r + 7) * 31 + cbase : ATT_NEG);
            if (act0 && act1) { const int ko[2] = {kc0, 64 + kc0}; LAS const float* const bt[2] = {b0, b1}; attn_tiles<true, 2>(buf, ko, qf, o0, o1, o2, mrun, F.lane, bt, pen); }
            else if (act0) { const int ko[2] = {kc0, kc0}; LAS const float* const bt[2] = {b0, b0}; attn_tiles<true, 1>(buf, ko, qf, o0, o1, o2, mrun, F.lane, bt, pen); }
            else if (act1) { const int ko[2] = {64 + kc0, 64 + kc0}; LAS const float* const bt[2] = {b1, b1}; attn_tiles<true, 1>(buf, ko, qf, o0, o1, o2, mrun, F.lane, bt, pen); }
        }
    }
#undef ATT_ROWA
#undef ATT_ROWB
    const float inv = 1.0f / o2[0];
    bf16* orow = YC + (size_t)qrow * DM + 64 * hh;
#pragma unroll
    for (int gq = 0; gq < 4; ++gq) { u32x2 w;
        w.x = pk2(o0[4 * gq] * inv, o0[4 * gq + 1] * inv); w.y = pk2(o0[4 * gq + 2] * inv, o0[4 * gq + 3] * inv); *(u32x2*)(orow + 8 * gq + 4 * h) = w;
        w.x = pk2(o1[4 * gq] * inv, o1[4 * gq + 1] * inv); w.y = pk2(o1[4 * gq + 2] * inv, o1[4 * gq + 3] * inv); *(u32x2*)(orow + 32 + 8 * gq + 4 * h) = w; }
    __syncthreads();
}
struct RetRaw { u32x4 kra, krb, vra, vrb, qra, qrb; u32x2 gg[8]; };
DI void ret_fetch(Frame& F, int su, RetRaw& R) {
    const bf16* PX = (const bf16*)(F.ws + WS_P);
    bool isctx; int b, hh, n; ret_unit_decode(su, isctx, b, hh, n);
    const int row0 = isctx ? (b * CTXL + n * 128) : (NCTX + b * SEQ + n * 128);
    const int dir = F.wave >> 2, qb = F.wave & 3, l32 = F.lane & 31, h = F.lane >> 5; const int iq = 32 * qb + l32;
    const int ktok = (F.tid & 255) >> 1, khp = F.tid & 1;
    const bf16* kp = PX + (size_t)(row0 + ktok) * INW + C_RK + 32 * hh;
    R.kra = *(const u32x4*)(kp + 8 * khp); R.krb = *(const u32x4*)(kp + 16 + 8 * khp);
    const int vtok = F.tid >> 2, vch = F.tid & 3; const bf16* vp = PX + (size_t)(row0 + vtok) * INW + C_RV + 64 * hh + 16 * vch;
    R.vra = *(const u32x4*)vp; R.vrb = *(const u32x4*)(vp + 8);
    const bf16* qp = PX + (size_t)(row0 + iq) * INW + C_RQ + 32 * hh;
    R.qra = *(const u32x4*)(qp + 8 * h); R.qrb = *(const u32x4*)(qp + 16 + 8 * h);
    const bf16* gp = PX + (size_t)(row0 + iq) * INW + (dir ? C_GB : C_GF) + 64 * hh;
#pragma unroll
    for (int et = 0; et < 2; ++et)
#pragma unroll
        for (int gq = 0; gq < 4; ++gq) R.gg[et * 4 + gq] = *(const u32x2*)(gp + 32 * et + 8 * gq + 4 * h);
}
DI void ret_out_units(Frame& F, int l, int nret, int vstart) {
    bf16* YC = (bf16*)(F.ws + WS_U);
    LAS unsigned char* Kimg = F.lds;
    LAS unsigned char* Vimg = F.lds + 10240;
    LAS unsigned char* Stf = F.lds + 28672;
    LAS unsigned char* Stb = F.lds + 33792;
    LAS float* Ob = (LAS float*)(F.lds + 38912);
    const int dir = F.wave >> 2, qb = F.wave & 3, l32 = F.lane & 31, h = F.lane >> 5, grp = (F.lane >> 4) & 1, i16 = F.lane & 15, q = i16 >> 2, p = i16 & 3;
    const int iq = 32 * qb + l32;
    const int ktok = (F.tid & 255) >> 1, khp = F.tid & 1, vtok = F.tid >> 2, vch = F.tid & 3;
    int su = vstart;
    if (su >= nret) return;
    RetRaw R; ret_fetch(F, su, R);
    for (; su < nret; su += F.G) {
        bool isctx; int b, hh, n; ret_unit_decode(su, isctx, b, hh, n);
        const int row0 = isctx ? (b * CTXL + n * 128) : (NCTX + b * SEQ + n * 128);
        float lg2f, lg2b; ret_consts(F, l, hh, lg2f, lg2b);
        if (F.tid < 256) { float x1[8], x2[8]; rope_apply(F, R.kra, R.krb, khp, !isctx, n * 128 + ktok, x1, x2);
            const float ks = 0.17677669529663687f; u32x4 o;
            o.x = pk2(x1[0] * ks, x1[1] * ks); o.y = pk2(x1[2] * ks, x1[3] * ks); o.z = pk2(x1[4] * ks, x1[5] * ks); o.w = pk2(x1[6] * ks, x1[7] * ks); *(LAS u32x4*)(Kimg + ktok * 80 + 16 * khp) = o;
            o.x = pk2(x2[0] * ks, x2[1] * ks); o.y = pk2(x2[2] * ks, x2[3] * ks); o.z = pk2(x2[4] * ks, x2[5] * ks); o.w = pk2(x2[6] * ks, x2[7] * ks); *(LAS u32x4*)(Kimg + ktok * 80 + 32 + 16 * khp) = o; }
        *(LAS u32x4*)(Vimg + vtok * 144 + 32 * vch) = R.vra; *(LAS u32x4*)(Vimg + vtok * 144 + 32 * vch + 16) = R.vrb;
        bf16x8 qf[2], qd[2];
        { float x1[8], x2[8]; rope_apply(F, R.qra, R.qrb, h, !isctx, n * 128 + iq, x1, x2);
          const float dec = dir == 0 ? fast_exp2(lg2f * (float)(iq + 1)) : fast_exp2(lg2b * (float)(128 - iq));
          u32x4 w;
          w.x = pk2(x1[0], x1[1]); w.y = pk2(x1[2], x1[3]); w.z = pk2(x1[4], x1[5]); w.w = pk2(x1[6], x1[7]); qf[0] = __builtin_bit_cast(bf16x8, w);
          w.x = pk2(x2[0], x2[1]); w.y = pk2(x2[2], x2[3]); w.z = pk2(x2[4], x2[5]); w.w = pk2(x2[6], x2[7]); qf[1] = __builtin_bit_cast(bf16x8, w);
          w.x = pk2(x1[0] * dec, x1[1] * dec); w.y = pk2(x1[2] * dec, x1[3] * dec); w.z = pk2(x1[4] * dec, x1[5] * dec); w.w = pk2(x1[6] * dec, x1[7] * dec); qd[0] = __builtin_bit_cast(bf16x8, w);
          w.x = pk2(x2[0] * dec, x2[1] * dec); w.y = pk2(x2[2] * dec, x2[3] * dec); w.z = pk2(x2[4] * dec, x2[5] * dec); w.w = pk2(x2[6] * dec, x2[7] * dec); qd[1] = __builtin_bit_cast(bf16x8, w); }
        u32x2 gcur[8];
#pragma unroll
        for (int i = 0; i < 8; ++i) gcur[i] = R.gg[i];
        const float cf = fast_exp2(lg2f * 128.0f), cb = fast_exp2(lg2b * 128.0f);
        const float* SC = (const float*)(F.ws + WS_SUMCTX) + (size_t)((b * 4 + hh) * 2) * 2 * 2048;
        const float* SL = (const float*)(F.ws + WS_SUMLAT) + (size_t)((b * 4 + hh) * 16) * 2 * 2048;
        const int eo = 4 * F.tid;
        f32x4 t[16], c00, c10, c11, c01;
        if (!isctx) {
#pragma unroll
            for (int m = 0; m < 16; ++m) t[m] = *(const f32x4*)(SL + (size_t)(m * 2 + (m <= n ? 0 : 1)) * 2048 + eo);
            c00 = *(const f32x4*)(SC + (0 * 2 + 0) * 2048 + eo); c10 = *(const f32x4*)(SC + (1 * 2 + 0) * 2048 + eo);
            c11 = *(const f32x4*)(SC + (1 * 2 + 1) * 2048 + eo); c01 = *(const f32x4*)(SC + (0 * 2 + 1) * 2048 + eo);
        } else {
#pragma unroll
            for (int m = 0; m < 16; ++m) t[m] = (f32x4){0.f, 0.f, 0.f, 0.f};
            c00 = *(const f32x4*)(SC + (0 * 2 + 0) * 2048 + eo); c11 = *(const f32x4*)(SC + (1 * 2 + 1) * 2048 + eo); c10 = c00; c01 = c11;
        }
        __syncthreads();
        f32x16 o0, o1;
#pragma unroll
        for (int i = 0; i < 16; ++i) { o0[i] = 0.f; o1[i] = 0.f; }
        const float lgd = dir ? lg2b : lg2f;
        const int kt_lo = dir ? qb : 0, kt_hi = dir ? 3 : qb;
        for (int kt = kt_lo; kt <= kt_hi; ++kt) {
            f32x16 sc;
#pragma unroll
            for (int i = 0; i < 16; ++i) sc[i] = 0.f;
#pragma unroll
            for (int si = 0; si < 2; ++si) { const bf16x8 a = *(const LAS bf16x8*)(Kimg + (32 * kt + l32) * 80 + (16 * si + 8 * h) * 2); sc = MFMA32(a, qf[si], sc); }
            float pp[16];
#pragma unroll
            for (int i = 0; i < 16; ++i) { const int j = 32 * kt + crow(i, h); const int diff = dir ? (j - iq) : (iq - j); pp[i] = diff >= 0 ? sc[i] * fast_exp2(lgd * (float)diff) : 0.f; }
            bf16x8 pf[2];
#pragma unroll
            for (int s2 = 0; s2 < 2; ++s2) { u32x4 w; w.x = pk2(pp[8 * s2], pp[8 * s2 + 1]); w.y = pk2(pp[8 * s2 + 2], pp[8 * s2 + 3]); w.z = pk2(pp[8 * s2 + 4], pp[8 * s2 + 5]); w.w = pk2(pp[8 * s2 + 6], pp[8 * s2 + 7]); pf[s2] = __builtin_bit_cast(bf16x8, w); }
#pragma unroll
            for (int s2 = 0; s2 < 2; ++s2) { const int r0 = 32 * kt + 16 * s2 + 4 * h + q;
#pragma unroll
                for (int et = 0; et < 2; ++et) { const int cbo = (32 * et + 16 * grp + 4 * p) * 2;
                    const s16x4 lo = trread(Vimg + r0 * 144 + cbo), hi = trread(Vimg + (r0 + 8) * 144 + cbo);
                    const bf16x8 a = __builtin_shufflevector(lo, hi, 0, 1, 2, 3, 4, 5, 6, 7);
                    if (et == 0) o0 = MFMA32(a, pf[s2], o0); else o1 = MFMA32(a, pf[s2], o1); } }
        }
        { f32x4 sf = (f32x4){0.f, 0.f, 0.f, 0.f}, sb = sf;
          if (!isctx) {
              sf = c00 * cf + c10;
#pragma unroll
              for (int m = 0; m < 16; ++m) { const f32x4 nv = sf * cf + t[m]; sf = (m < n) ? nv : sf; }
              sb = c11 * cb + c01;
#pragma unroll
              for (int m = 15; m >= 0; --m) { const f32x4 nv = sb * cb + t[m]; sb = (m > n) ? nv : sb; }
          } else { if (n == 1) sf = c00; if (n == 0) sb = c11; }
          const int e = eo >> 5, d = eo & 31; u32x2 w;
          w.x = pk2(sf[0], sf[1]); w.y = pk2(sf[2], sf[3]); *(LAS u32x2*)(Stf + e * 80 + d * 2) = w;
          w.x = pk2(sb[0], sb[1]); w.y = pk2(sb[2], sb[3]); *(LAS u32x2*)(Stb + e * 80 + d * 2) = w; }
        __syncthreads();
        { LAS const unsigned char* St = dir ? Stb : Stf;
#pragma unroll
          for (int s2 = 0; s2 < 2; ++s2) { const bf16x8 a0 = *(const LAS bf16x8*)(St + l32 * 80 + (16 * s2 + 8 * h) * 2), a1 = *(const LAS bf16x8*)(St + (32 + l32) * 80 + (16 * s2 + 8 * h) * 2);
              o0 = MFMA32(a0, qd[s2], o0); o1 = MFMA32(a1, qd[s2], o1); } }
        if (su + F.G < nret) ret_fetch(F, su + F.G, R);
        float sm = 0.f;
#pragma unroll
        for (int i = 0; i < 16; ++i) sm += o0[i] + o1[i];
        sm += __shfl_xor(sm, 32);
        const float mu = sm * (1.0f / 64.0f);
        float vs = 0.f;
#pragma unroll
        for (int i = 0; i < 16; ++i) { const float d0 = o0[i] - mu, d1 = o1[i] - mu; vs += d0 * d0 + d1 * d1; }
        vs += __shfl_xor(vs, 32);
        const float rstd = 1.0f / sqrtf(vs * (1.0f / 64.0f) + EPS);
        const float* gn = F.in[I_RGNW] + l * 256 + 64 * hh;
        float val[32];
#pragma unroll
        for (int et = 0; et < 2; ++et)
#pragma unroll
            for (int gq = 0; gq < 4; ++gq) { const int e0 = 32 * et + 8 * gq + 4 * h; const u32x2 ggv = gcur[et * 4 + gq]; const f32x4 gw = *(const f32x4*)(gn + e0);
                const float g0 = bflo(ggv.x), g1 = bfhi(ggv.x), g2 = bflo(ggv.y), g3 = bfhi(ggv.y);
                const float a0 = et ? o1[4 * gq] : o0[4 * gq], a1 = et ? o1[4 * gq + 1] : o0[4 * gq + 1], a2 = et ? o1[4 * gq + 2] : o0[4 * gq + 2], a3 = et ? o1[4 * gq + 3] : o0[4 * gq + 3];
                val[et * 16 + 4 * gq] = (a0 - mu) * rstd * gw[0] * g0 * sigmoidf_(g0); val[et * 16 + 4 * gq + 1] = (a1 - mu) * rstd * gw[1] * g1 * sigmoidf_(g1);
                val[et * 16 + 4 * gq + 2] = (a2 - mu) * rstd * gw[2] * g2 * sigmoidf_(g2); val[et * 16 + 4 * gq + 3] = (a3 - mu) * rstd * gw[3] * g3 * sigmoidf_(g3); }
        if (dir == 0) {
#pragma unroll
            for (int et = 0; et < 2; ++et)
#pragma unroll
                for (int gq = 0; gq < 4; ++gq)
#pragma unroll
                    for (int j = 0; j < 4; ++j) Ob[iq * 65 + 32 * et + 8 * gq + 4 * h + j] = val[et * 16 + 4 * gq + j];
        }
        __syncthreads();
        if (dir == 1) { bf16* orow = YC + (size_t)(row0 + iq) * DM + 768 + 64 * hh;
#pragma unroll
            for (int et = 0; et < 2; ++et)
#pragma unroll
                for (int gq = 0; gq < 4; ++gq) { const int e0 = 32 * et + 8 * gq + 4 * h; float tt[4];
#pragma unroll
                    for (int j = 0; j < 4; ++j) tt[j] = val[et * 16 + 4 * gq + j] + Ob[iq * 65 + e0 + j];
                    u32x2 w; w.x = pk2(tt[0], tt[1]); w.y = pk2(tt[2], tt[3]); *(u32x2*)(orow + e0) = w; } }
        __syncthreads();
    }
}
#ifndef PROBE_SUB
#define PROBE_SUB 0
#endif
DI void cb_phase(Frame& F, int l) {
    rope_to_lds(F);
    const int nattn = l == 0 ? 1152 : 1024;
    for (int rep = 0; rep < ((PROBE_SUB & 1) ? 2 : 1); ++rep)
    for (int u = F.vb; u < nattn; u += F.G) {
        if (u < 1024) attn_unit(F, l, true, u >> 6, (u >> 3) & 7, u & 7);
        else { const int v = u - 1024; attn_unit(F, l, false, v >> 3, v & 7, 0); }
    }
    split_wait(F, 1 + l);
    const int nret = l == 0 ? 1152 : 1024;
    for (int rep = 0; rep < ((PROBE_SUB & 2) ? 2 : 1); ++rep) ret_out_units(F, l, nret, (F.vb + F.G - (nattn % F.G)) % F.G);
}

static_assert(sizeof(Params) == 240, "kernarg layout: in[26] at 0, out at 208, ws at 216, ph_lo at 224, ph_hi at 228");
#ifdef ONLY_PHASE
#define IN(k) ((k) == ONLY_PHASE && lo <= (k) && (k) < hi)
#else
#define IN(k) (lo <= (k) && (k) < hi)
#endif
#ifndef PROBE_MASK
#define PROBE_MASK 0u
#endif
#define NREP(k) (((PROBE_MASK >> (k)) & 1u) ? 2 : 1)
#define SEAM(k) do { if (IN(k) && IN((k) + 1)) { XcdBarrier bb_ = bar; asm volatile("" : "+s"(bb_.bar)); xcd_barrier(bb_, F.wave); } } while (0)
#define GLDS(P) ((LAS unsigned char*)(P).lds)
#define WSB(P, off) ((const pg8::bf16_t*)((P).ws + (off)))
DI void split_arrive(Frame& F, int slot) {
    asm volatile("s_waitcnt vmcnt(0)" ::: "memory");
    __syncthreads();
    if (F.wave == 0 && __builtin_amdgcn_mbcnt_hi(~0u, __builtin_amdgcn_mbcnt_lo(~0u, 0u)) == 0u) {
        unsigned* w = (unsigned*)(F.ws + WS_CTL + WS_TAILCNT) + slot * 2048;
        volatile LAS unsigned* st = (volatile LAS unsigned*)(F.lds + AUX_OFF) + 8;
        unsigned nloc = st[0], nx = st[1];
        if (nloc == 0u) { xcd_barrier_complete((unsigned*)(F.ws + WS_CTL) + 1024, xb_xcc_id(), nloc, nx); st[0] = nloc; st[1] = nx; }
        const unsigned old = __hip_atomic_fetch_add(w + 64 * (1 + xb_xcc_id()), 1u, __ATOMIC_RELAXED, __HIP_MEMORY_SCOPE_AGENT);
        if (old + 1u == nloc) { __builtin_amdgcn_fence(__ATOMIC_RELEASE, "agent"); asm volatile("s_waitcnt vmcnt(0)" ::: "memory"); (void)__hip_atomic_fetch_add(w, nloc, __ATOMIC_RELAXED, __HIP_MEMORY_SCOPE_AGENT); }
    }
}
DI void split_wait(Frame& F, int slot) {
    if (F.wave == 0 && __builtin_amdgcn_mbcnt_hi(~0u, __builtin_amdgcn_mbcnt_lo(~0u, 0u)) == 0u) {
        unsigned* w = (unsigned*)(F.ws + WS_CTL + WS_TAILCNT) + slot * 2048; unsigned sp = 0;
        while (__hip_atomic_load(w, __ATOMIC_RELAXED, __HIP_MEMORY_SCOPE_AGENT) < (unsigned)F.G) { __builtin_amdgcn_s_sleep(4); if (++sp > (1u << 22)) break; }
        __builtin_amdgcn_fence(__ATOMIC_ACQUIRE, "agent");
        asm volatile("s_waitcnt vmcnt(0)" ::: "memory");
    }
    __syncthreads();
}
DI void stagger_start(const Frame& P, int ticks) {
    const int k = P.bid & 7;
    if (ticks > 0 && k) { const unsigned long long t0 = __builtin_amdgcn_s_memrealtime(); while (__builtin_amdgcn_s_memrealtime() - t0 < (unsigned long long)(k * ticks)) __builtin_amdgcn_s_sleep(8); }
}
template <int l> DI void layer_phases(Frame& F, const XcdBarrier& bar) {
    constexpr int lo = 0, hi = N_PHASES;
        const int pb = l == 0 ? 1 : 9;
        if (IN(pb + 0)) for (int rep_ = 0; rep_ < NREP(pb + 0); ++rep_) { if (rep_) __syncthreads(); Frame P = phase_frame(F); if (l == 0) split_wait(P, 3); norm_phase<(l == 0)>(P, l, 1, 0); } SEAM(pb + 0);
        if (IN(pb + 1)) for (int rep_ = 0; rep_ < NREP(pb + 1); ++rep_) { if (rep_) __syncthreads();
            Frame P = phase_frame(F);
            stagger_start(P, STAG_B);
            pg8::StaticOrder S; S.init(NTOK, INW, P.G, P.bid);
            pg8::EpiStoreBf16 E{(pg8::bf16_t*)(P.ws + WS_P), INW};
            pg8::gemm_phase<pg8::EpiStoreBf16, pg8::StaticOrder, pg8::RowsLinear, true>(GLDS(P), P.tid, WSB(P, WS_U), WSB(P, WS_WIN) + (size_t)l * INW * DM, 2 * DM, S, E, pg8::RowsLinear{});
            if (PROBE_SUB & 4) { __syncthreads(); pg8::gemm_phase<pg8::EpiNull, pg8::StaticOrder, pg8::RowsLinear, true>(GLDS(P), P.tid, WSB(P, WS_U), WSB(P, WS_WIN) + (size_t)l * INW * DM, 2 * DM, S, pg8::EpiNull{}, pg8::RowsLinear{}); }
            if (l == 0) bg_convert_tail(P, S.nwg, BG_B0, BG_D0); else bg_convert_tail(P, S.nwg, BG_B1, BG_CL);
        } SEAM(pb + 1);
        if (IN(pb + 2)) for (int rep_ = 0; rep_ < NREP(pb + 2); ++rep_) { if (rep_) __syncthreads(); Frame P = phase_frame(F); ca_phase(P, l); split_arrive(P, 1 + l); }
        if (IN(pb + 3)) for (int rep_ = 0; rep_ < NREP(pb + 3); ++rep_) { if (rep_) __syncthreads(); Frame P = phase_frame(F); cb_phase(P, l); } SEAM(pb + 3);
        if (IN(pb + 4)) {
            Frame P = phase_frame(F);
            const int rb = l == 0 ? 0 : NCTX;
            const float* modlat = (const float*)(P.ws + WS_MODLAT) + (size_t)l * 16 * 6144;
            const float* modctx = (const float*)(P.ws + WS_MODCTX) + (size_t)l * 6144;
            stagger_start(P, STAG_D);
            pg8::StaticOrder S; S.init(NTOK - rb, DM, P.G, P.bid);
            pg8::EpiResGate<(l == 0)> E{P.in[I_CTX], P.in[I_X], (pg8::bf16_t*)(P.ws + WS_H), modlat + 2 * DM, modctx + 2 * DM, rb};
            pg8::gemm_phase<pg8::EpiResGate<(l == 0)>, pg8::StaticOrder, pg8::RowsLinear, true>(GLDS(P), P.tid, WSB(P, WS_U) + (size_t)rb * DM, WSB(P, WS_WOUT) + (size_t)l * DM * DM, 2 * DM, S, E, pg8::RowsLinear{});
            if (l == 0) bg_convert_tail(P, S.nwg, BG_D0, BG_E0);
        } SEAM(pb + 4);
        if (l == 0) {
            if (IN(6)) for (int rep_ = 0; rep_ < NREP(6); ++rep_) { if (rep_) __syncthreads(); Frame P = phase_frame(F); norm_phase<false>(P, 0, 2, 0, DENSE_FP8 == 1); } SEAM(6);
            if (IN(7)) for (int rep_ = 0; rep_ < NREP(7); ++rep_) { if (rep_) __syncthreads();
                Frame P = phase_frame(F);
                stagger_start(P, STAG_E);
                pg8::StaticOrder S; S.init(NTOK, 2 * DFF, P.G, P.bid);
                pg8::EpiSwiglu<false> E{(pg8::bf16_t*)(P.ws + WS_P), DFF, 0, nullptr};
#if DENSE_FP8 == 1
                pg8::gemm_phase<pg8::EpiSwiglu<false>, pg8::StaticOrder, pg8::RowsLinearOff, true, true>(GLDS(P), P.tid, WSB(P, WS_U), WSB(P, WS_WGU), DM, S, E, pg8::RowsLinearOff{}, SCL_U, SCL_WGU);
#else
                pg8::gemm_phase<pg8::EpiSwiglu<false>, pg8::StaticOrder, pg8::RowsLinear, true>(GLDS(P), P.tid, WSB(P, WS_U), WSB(P, WS_WGU), 2 * DM, S, E, pg8::RowsLinear{});
#endif
                bg_convert_tail(P, S.nwg, BG_E0, BG_F0);
            } SEAM(7);
            if (IN(8)) {
                Frame P = phase_frame(F);
                const float* modlat = (const float*)(P.ws + WS_MODLAT);
                const float* modctx = (const float*)(P.ws + WS_MODCTX);
                stagger_start(P, STAG_F);
                pg8::StaticOrder S; S.init(NTOK, DM, P.G, P.bid);
                pg8::EpiResGate<false> E{nullptr, nullptr, (pg8::bf16_t*)(P.ws + WS_H), modlat + 5 * DM, modctx + 5 * DM, 0};
#if DENSE_FP8
                pg8::gemm_phase<pg8::EpiResGate<false>, pg8::StaticOrder, pg8::RowsLinearOff, true, true>(GLDS(P), P.tid, WSB(P, WS_P), WSB(P, WS_WD), DFF, S, E, pg8::RowsLinearOff{}, SCL_H, SCL_WD);
#else
                pg8::gemm_phase<pg8::EpiResGate<false>, pg8::StaticOrder, pg8::RowsLinear, true>(GLDS(P), P.tid, WSB(P, WS_P), WSB(P, WS_WD), 2 * DFF, S, E, pg8::RowsLinear{});
#endif
                bg_convert_tail(P, S.nwg, BG_F0, BG_B1);
            } SEAM(8);
        } else {
            if (IN(14)) for (int rep_ = 0; rep_ < NREP(14); ++rep_) { if (rep_) __syncthreads(); Frame P = phase_frame(F); norm_moe_phase(P); } SEAM(14);
            if (IN(15)) for (int rep_ = 0; rep_ < NREP(15); ++rep_) { if (rep_) __syncthreads(); Frame P = phase_frame(F); moe_route_phase(P); bg_convert_tail(P, 16, BG_CL, BG_ITEMS); } SEAM(15);
            LAS int* texp = (LAS int*)(F.lds + AUX_TAB);
            if (IN(16) || IN(17)) {
                Frame P = phase_frame(F);
                const int* meta = (const int*)(P.ws + WS_META);
                __syncthreads();
                for (int i = P.tid; i < 2 * MOE_TILES; i += 512) texp[i] = ld_i32_coherent(meta + (i / MOE_TILES) * 256 + 1 + (i % MOE_TILES));
                if (P.tid < 2) texp[2 * MOE_TILES + P.tid] = ld_i32_coherent(meta + P.tid * 256);
                __syncthreads();
            }
            if (IN(16)) for (int rep_ = 0; rep_ < NREP(16); ++rep_) { if (rep_) __syncthreads();
                Frame P = phase_frame(F);
                const int NT0 = __builtin_amdgcn_readfirstlane(texp[2 * MOE_TILES]), NT1 = __builtin_amdgcn_readfirstlane(texp[2 * MOE_TILES + 1]);
                stagger_start(P, STAG_EM);
                pg8::MoeOrder S{NT0, NT1, 28, P.G, P.bid, (const LAS int*)texp};
                pg8::EpiSwiglu<true> E{(pg8::bf16_t*)(P.ws + WS_P), DFE, 28, (const float*)(P.ws + WS_PROW)};
                pg8::gemm_phase<pg8::EpiSwiglu<true>, pg8::MoeOrder, pg8::RowsGather, true, true>(GLDS(P), P.tid, WSB(P, WS_U), WSB(P, WS_MGU), DM, S, E, pg8::RowsGather{(const int*)(P.ws + WS_ROWMAP), 0}, SCL_U, SCL_WGU);
            } SEAM(16);
            if (IN(17)) {
                Frame P = phase_frame(F);
                const int NT0 = __builtin_amdgcn_readfirstlane(texp[2 * MOE_TILES]), NT1 = __builtin_amdgcn_readfirstlane(texp[2 * MOE_TILES + 1]);
                stagger_start(P, STAG_FM);
                int ilast, ntail; moe_down_tail(NT0, NT1, P.G, ilast, ntail);
                unsigned* tcnt = (unsigned*)(P.ws + WS_CTL + WS_TAILCNT);
                const unsigned nloc8 = 8u * (unsigned)__builtin_amdgcn_readfirstlane((int)((volatile LAS unsigned*)(P.lds + AUX_OFF))[8]);
                pg8::MoeOrderHook S{{NT0, NT1, 4, P.G, P.bid, (const LAS int*)texp}, ilast - 1, tcnt, tcnt + 64 * (1 + xb_xcc_id()), nloc8};
                pg8::EpiMoeScatter E{(const int*)(P.ws + WS_ROWMAP), (const float*)(P.ws + WS_PROW), (pg8::bf16_t*)(P.ws + WS_Y0), (pg8::bf16_t*)(P.ws + WS_U), 4};
                pg8::gemm_phase<pg8::EpiMoeScatter, pg8::MoeOrderHook, pg8::RowsLinearOff, true, true>(GLDS(P), P.tid, P.ws + WS_P, WSB(P, WS_MD), DFE, S, E, pg8::RowsLinearOff{}, SCL_H, SCL_WD);
                { Frame Q = phase_frame(F); final_overlap(Q, ntail, tcnt); }
            } SEAM(17);
        }
}
__global__ void __launch_bounds__(512, 2) fwd_kernel(Params prm) {
    extern __shared__ __attribute__((aligned(16))) unsigned char lds_raw[];
    Frame F;
    F.lds = (LAS unsigned char*)lds_raw;
    F.tid = threadIdx.x; F.lane = F.tid & 63; F.wave = __builtin_amdgcn_readfirstlane(F.tid >> 6);
    F.G = gridDim.x; F.bid = blockIdx.x; F.vb = F.bid;
    F.in.ka = (karg_t)__builtin_amdgcn_kernarg_segment_ptr(); F.out = prm.out; F.ws = prm.ws;
    volatile LAS unsigned* MISC = (volatile LAS unsigned*)(F.lds + AUX_OFF);
    if (F.tid < 64) MISC[F.tid] = 0u;
    __syncthreads();
    XcdBarrier bar; bar.bar = (unsigned*)(prm.ws + WS_CTL) + 1024; bar.x = 0; bar.st = nullptr;
#if MK_PER_PHASE
    const int lo = prm.ph_lo, hi = prm.ph_hi;
#else
    constexpr int lo = 0, hi = N_PHASES;
#endif
    if (hi - lo > 1) bar = xcd_barrier_post((unsigned*)(prm.ws + WS_CTL) + 1024, MISC + 8);

    if (IN(0)) for (int rep_ = 0; rep_ < NREP(0); ++rep_) { if (rep_) __syncthreads(); Frame P = phase_frame(F); p0_prologue(P); }
    layer_phases<0>(F, bar);
    layer_phases<1>(F, bar);
    if (IN(PH_FINAL)) { Frame P = phase_frame(F); final_phase(P); }
#undef IN
#undef SEAM
}

extern "C" void kernel_launch(void* const* d_in, const int* in_sizes, int n_in, void* d_out, int out_size, void* d_ws, size_t ws_size, hipStream_t stream) {
    static int grid = 0;
    if (grid == 0) {
        if (n_in != 26 || in_sizes[0] != NLAT * DM || out_size != NLAT * DM || ws_size < WS_END) {
            fprintf(stderr, "kernel_launch: unexpected shapes (n_in %d, in0 %d, out %d, ws %zu, need %zu); nothing launched\n", n_in, n_in > 0 ? in_sizes[0] : -1, out_size, ws_size, (size_t)WS_END); grid = -1; return; }
        int dev = 0, cus = 0, per_cu = 0;
        if (hipGetDevice(&dev) != hipSuccess || hipDeviceGetAttribute(&cus, hipDeviceAttributeMultiprocessorCount, dev) != hipSuccess) { grid = -1; return; }
        if (hipFuncSetAttribute((const void*)fwd_kernel, hipFuncAttributeMaxDynamicSharedMemorySize, LDS_BYTES) != hipSuccess) { fprintf(stderr, "kernel_launch: hipFuncSetAttribute failed\n"); grid = -1; return; }
        if (hipOccupancyMaxActiveBlocksPerMultiprocessor(&per_cu, (const void*)fwd_kernel, 512, LDS_BYTES) != hipSuccess || per_cu < 1)
            fprintf(stderr, "kernel_launch: note: occupancy query reports %d workgroups per CU\n", per_cu);
        (void)hipGetLastError();
        grid = cus;
    }
    if (grid < 0) return;
    if (hipMemsetAsync((char*)d_ws + WS_CTL, 0, CTL_ZERO_BYTES, stream) != hipSuccess) return;
    Params p{};
    for (int i = 0; i < 26; ++i) p.in[i] = (const float*)d_in[i];
    p.out = (float*)d_out; p.ws = (unsigned char*)d_ws;
#if MK_PER_PHASE
    for (int ph = 0; ph < N_PHASES; ++ph) { p.ph_lo = ph; p.ph_hi = ph + 1; hipLaunchKernelGGL(fwd_kernel, dim3(grid), dim3(512), LDS_BYTES, stream, p); }
#else
    p.ph_lo = 0; p.ph_hi = N_PHASES;
    hipLaunchKernelGGL(fwd_kernel, dim3(grid), dim3(512), LDS_BYTES, stream, p);
#endif
}
```
